# Optimizing an MI355X kernel written in HIP

```python
import math
import jax, jax.numpy as jnp
from jax import lax
import numpy as np

D_MODEL = 1024
BATCH = 8
SEQ = 4096
DEPTH = 1

EPS = 1e-6
GDN_HEADS = 4
GDN_DK = 128
GDN_DV = 128
CONV_K = 4
CHUNK = 64
SWA_HEADS = 8
SWA_DH = 64
DILATED_BRANCHES = ((128, 1), (512, 4), (2048, 16))
SWA_BLOCK = 128
REL_BUCKETS = 32
REL_MAX_DIST = 2048
N_EXPERTS = 32
TOP_K = 4
D_FF = D_MODEL
SWIGLU_LIMIT = 7.0
SWIGLU_ALPHA = 1.702
MOE_BLOCK = 256
IN_WIDTHS = (GDN_HEADS * GDN_DK, GDN_HEADS * GDN_DK, GDN_HEADS * GDN_DV, GDN_HEADS * GDN_DV,
             GDN_HEADS, GDN_HEADS, SWA_HEADS * SWA_DH, SWA_HEADS * SWA_DH, SWA_HEADS * SWA_DH)
IN_DIM = sum(IN_WIDTHS)
CONV_DIM = 2 * GDN_HEADS * GDN_DK + GDN_HEADS * GDN_DV
MIX_WIDTH = GDN_HEADS * GDN_DV + SWA_HEADS * SWA_DH

kernel_name = 'hymba_gdn_dilated_swa_moe'


def _rmsnorm(x, w):
    xf = x.astype(jnp.float32)
    y = xf * lax.rsqrt(jnp.mean(xf * xf, axis=-1, keepdims=True) + EPS) * w.astype(jnp.float32)
    return y.astype(x.dtype)


def _l2norm(x):
    return x * lax.rsqrt(jnp.sum(x * x, axis=-1, keepdims=True) + EPS)


def _split_columns(z):
    offsets, acc = [], 0
    for w in IN_WIDTHS[:-1]:
        acc += w
        offsets.append(acc)
    return jnp.split(z, offsets, axis=-1)


def _causal_dwconv(x, w):
    c = x.shape[-1]
    return lax.conv_general_dilated(x, w.astype(x.dtype)[:, None, :], window_strides=(1,),
                                    padding=[(CONV_K - 1, 0)],
                                    dimension_numbers=('NWC', 'WIO', 'NWC'),
                                    feature_group_count=c)


def _gated_deltanet(q, k, v, beta, g):
    b, s, h, dk = q.shape
    dv = v.shape[-1]
    n = s // CHUNK

    def chunks(t):
        return t.reshape(b, n, CHUNK, h, -1).transpose(0, 3, 1, 2, 4)

    q, k, v = chunks(q), chunks(k), chunks(v)
    beta = beta.reshape(b, n, CHUNK, h).transpose(0, 3, 1, 2)
    g = g.reshape(b, n, CHUNK, h).transpose(0, 3, 1, 2)
    gc = jnp.cumsum(g, axis=-1)
    ii = np.arange(CHUNK)[:, None]
    jj = np.arange(CHUNK)[None, :]
    decay = jnp.exp(jnp.where(ii >= jj, gc[..., :, None] - gc[..., None, :], -jnp.inf))
    kb = k * beta[..., None]
    a_kk = jnp.where(ii > jj, jnp.einsum('bhnik,bhnjk->bhnij', kb, k) * decay, 0.0)
    m = a_kk + jnp.eye(CHUNK, dtype=a_kk.dtype)
    rhs = jnp.concatenate([v * beta[..., None], kb * jnp.exp(gc)[..., None]], axis=-1)
    sol = lax.linalg.triangular_solve(m, rhs, left_side=True, lower=True, unit_diagonal=True)
    u, w = sol[..., :dv], sol[..., dv:]
    a_qk = jnp.einsum('bhnik,bhnjk->bhnij', q, k) * decay
    q_dec = q * jnp.exp(gc)[..., None]
    k_dec = k * jnp.exp(gc[..., -1:] - gc)[..., None]
    chunk_decay = jnp.exp(gc[..., -1])

    def step(state, xs):
        u_n, w_n, qd_n, kd_n, a_n, cd_n = xs
        v_new = u_n - jnp.einsum('bhck,bhkv->bhcv', w_n, state)
        o_n = jnp.einsum('bhck,bhkv->bhcv', qd_n, state) + jnp.einsum('bhij,bhjv->bhiv', a_n, v_new)
        state = state * cd_n[..., None, None] + jnp.einsum('bhck,bhcv->bhkv', kd_n, v_new)
        return state, o_n

    xs = tuple(jnp.moveaxis(t, 2, 0) for t in (u, w, q_dec, k_dec, a_qk, chunk_decay))
    state0 = jnp.zeros((b, h, dk, dv), jnp.float32)
    _, o = lax.scan(step, state0, xs)
    return o.transpose(1, 0, 3, 2, 4).reshape(b, s, h, dv)


def _t5_bucket(dist):
    max_exact = REL_BUCKETS // 2
    n = np.maximum(dist, 0)
    large = max_exact + (np.log(np.maximum(n, 1) / max_exact) / math.log(REL_MAX_DIST / max_exact)
                         * (REL_BUCKETS - max_exact)).astype(np.int32)
    large = np.minimum(large, REL_BUCKETS - 1)
    return np.where(n < max_exact, n, large).astype(np.int32)


def _dilated_branch(q, k, v, rel_bias, window, dilation):
    b, s, h, dh = q.shape
    length = s // dilation
    nb = -(-length // SWA_BLOCK)
    lp = nb * SWA_BLOCK

    def split(t):
        t = t.reshape(b, length, dilation, h, dh).transpose(0, 2, 1, 3, 4).reshape(b * dilation, length, h, dh)
        return jnp.pad(t, ((0, 0), (0, lp - length), (0, 0), (0, 0)))

    def band(t):
        tb = t.reshape(-1, nb, SWA_BLOCK, h, dh)
        prev = jnp.pad(tb, ((0, 0), (1, 0), (0, 0), (0, 0), (0, 0)))[:, :-1]
        return jnp.concatenate([prev, tb], axis=2)

    qb = split(q).reshape(-1, nb, SWA_BLOCK, h, dh)
    kb, vb = band(split(k)), band(split(v))
    qi = np.arange(SWA_BLOCK)[:, None]
    kj = np.arange(2 * SWA_BLOCK)[None, :]
    steps = qi + SWA_BLOCK - kj
    valid_local = (steps >= 0) & (steps <= window // dilation)
    valid = np.where((np.arange(nb) == 0)[:, None, None], valid_local & (kj >= SWA_BLOCK), valid_local)
    bias = rel_bias.astype(jnp.float32)[jnp.asarray(_t5_bucket(steps * dilation))].transpose(2, 0, 1)
    scores = jnp.einsum('bnqhe,bnkhe->bhnqk', qb, kb) + bias[:, None]
    scores = jnp.where(valid[None, None], scores, -jnp.inf)
    mx = jnp.max(scores, axis=-1, keepdims=True)
    p = jnp.exp(scores - mx)
    den = jnp.sum(p, axis=-1)
    o = jnp.einsum('bhnqk,bnkhe->bnqhe', p, vb) / den.transpose(0, 2, 3, 1)[..., None]
    lse = (mx[..., 0] + jnp.log(den)).transpose(0, 2, 3, 1)
    o = o.reshape(b, dilation, lp, h, dh)[:, :, :length].transpose(0, 2, 1, 3, 4).reshape(b, s, h, dh)
    lse = lse.reshape(b, dilation, lp, h)[:, :, :length].transpose(0, 2, 1, 3).reshape(b, s, h)
    return o, lse


def _dilated_attention(q, k, v, rel_bias):
    outs, lses = [], []
    for window, dilation in DILATED_BRANCHES:
        o, lse = _dilated_branch(q, k, v, rel_bias, window, dilation)
        outs.append(o)
        lses.append(lse)
    wts = jax.nn.softmax(jnp.stack(lses), axis=0)
    return jnp.sum(wts[..., None] * jnp.stack(outs), axis=0)


def _moe(hn, w_router, b_router, w_gu, b_gu, w_dn, b_dn):
    b, s, d = hn.shape
    t = b * s
    hf = hn.reshape(t, d)
    logits = hf.astype(jnp.float32) @ w_router.astype(jnp.float32) + b_router.astype(jnp.float32)
    top_v, top_e = lax.top_k(logits, TOP_K)
    gates = jax.nn.softmax(top_v, axis=-1)
    e_flat = top_e.reshape(-1)
    tok_flat = jnp.repeat(jnp.arange(t, dtype=jnp.int32), TOP_K)
    g_flat = gates.reshape(-1)
    order = jnp.argsort(e_flat)
    e_s, tok_s, g_s = e_flat[order], tok_flat[order], g_flat[order]
    counts = jnp.bincount(e_flat, length=N_EXPERTS)
    padded = (counts + MOE_BLOCK - 1) // MOE_BLOCK * MOE_BLOCK
    raw_start = jnp.cumsum(counts) - counts
    pad_end = jnp.cumsum(padded)
    pad_start = pad_end - padded
    dest = pad_start[e_s] + jnp.arange(t * TOP_K, dtype=jnp.int32) - raw_start[e_s]
    p_rows = t * TOP_K + N_EXPERTS * MOE_BLOCK
    nblk = p_rows // MOE_BLOCK
    buf_tok = jnp.full((p_rows,), t, jnp.int32).at[dest].set(tok_s)
    buf_gate = jnp.zeros((p_rows,), jnp.float32).at[dest].set(g_s)
    blk_start = jnp.arange(nblk, dtype=jnp.int32) * MOE_BLOCK
    blk_expert = jnp.minimum(jnp.sum(blk_start[:, None] >= pad_end[None, :], axis=1), N_EXPERTS - 1)
    h_pad = jnp.concatenate([hf, jnp.zeros((1, d), hf.dtype)], axis=0)
    xb = h_pad[buf_tok].reshape(nblk, MOE_BLOCK, d)

    def expert_block(args):
        xblk, e = args
        gu = xblk @ w_gu[e] + b_gu[e]
        gate = jnp.minimum(gu[:, :D_FF], SWIGLU_LIMIT)
        up = jnp.clip(gu[:, D_FF:], -SWIGLU_LIMIT, SWIGLU_LIMIT)
        act = (up + 1.0) * gate * jax.nn.sigmoid(SWIGLU_ALPHA * gate)
        return act @ w_dn[e] + b_dn[e]

    yb = lax.map(expert_block, (xb, blk_expert)).reshape(p_rows, d)
    out = jnp.zeros((t + 1, d), jnp.float32).at[buf_tok].add(yb.astype(jnp.float32) * buf_gate[:, None])
    return out[:t].reshape(b, s, d).astype(hn.dtype)


def _layer(x, norm1_w, w_in, conv_w, a_log, dt_bias, gdn_norm_w, q_norm_w, k_norm_w, rel_bias,
           w_out, norm2_w, w_router, b_router, w_gate_up, b_gate_up, w_down, b_down):
    b, s, _ = x.shape
    f32 = jnp.float32
    z = _rmsnorm(x, norm1_w) @ w_in
    qa, ka, va, gate_a, beta_l, alpha_l, qb, kb, vb = _split_columns(z)
    qkv = jax.nn.silu(_causal_dwconv(jnp.concatenate([qa, ka, va], axis=-1), conv_w)).astype(f32)
    qa, ka, va = jnp.split(qkv, [GDN_HEADS * GDN_DK, 2 * GDN_HEADS * GDN_DK], axis=-1)
    qa = _l2norm(qa.reshape(b, s, GDN_HEADS, GDN_DK)) * (GDN_DK ** -0.5)
    ka = _l2norm(ka.reshape(b, s, GDN_HEADS, GDN_DK))
    va = va.reshape(b, s, GDN_HEADS, GDN_DV)
    beta = jax.nn.sigmoid(beta_l.astype(f32))
    g = -jnp.exp(a_log.astype(f32)) * jax.nn.softplus(alpha_l.astype(f32) + dt_bias.astype(f32))
    oa = _gated_deltanet(qa, ka, va, beta, g)
    oa = (oa * lax.rsqrt(jnp.mean(oa * oa, axis=-1, keepdims=True) + EPS) * gdn_norm_w.astype(f32)
          * jax.nn.silu(gate_a.astype(f32).reshape(b, s, GDN_HEADS, GDN_DV)))
    oa = oa.reshape(b, s, GDN_HEADS * GDN_DV)
    qb = _rmsnorm(qb.astype(f32).reshape(b, s, SWA_HEADS, SWA_DH), q_norm_w) * (SWA_DH ** -0.5)
    kb = _rmsnorm(kb.astype(f32).reshape(b, s, SWA_HEADS, SWA_DH), k_norm_w)
    vb = vb.astype(f32).reshape(b, s, SWA_HEADS, SWA_DH)
    ob = _dilated_attention(qb, kb, vb, rel_bias).reshape(b, s, SWA_HEADS * SWA_DH)
    h = x + jnp.concatenate([oa, ob], axis=-1).astype(x.dtype) @ w_out
    return h + _moe(_rmsnorm(h, norm2_w), w_router, b_router, w_gate_up, b_gate_up, w_down, b_down)


def setup_inputs(seed: int = 0) -> dict:
    key = jax.random.key(seed)
    ks = jax.random.split(key, 18)
    f32 = jnp.float32
    L = DEPTH
    nrm = jax.random.normal
    dt = jnp.exp(jax.random.uniform(ks[5], (L, GDN_HEADS), f32, math.log(1e-3), math.log(1e-1)))
    return {
        'x': nrm(ks[0], (BATCH, SEQ, D_MODEL), f32),
        'norm1_w': 1.0 + 0.05 * nrm(ks[1], (L, D_MODEL), f32),
        'w_in': nrm(ks[2], (L, D_MODEL, IN_DIM), f32) * D_MODEL ** -0.5,
        'conv_w': nrm(ks[3], (L, CONV_K, CONV_DIM), f32) * CONV_K ** -0.5,
        'a_log': jnp.log(jax.random.uniform(ks[4], (L, GDN_HEADS), f32, 1.0, 16.0)),
        'dt_bias': dt + jnp.log(-jnp.expm1(-dt)),
        'gdn_norm_w': 1.0 + 0.05 * nrm(ks[6], (L, GDN_DV), f32),
        'q_norm_w': 1.0 + 0.05 * nrm(ks[7], (L, SWA_DH), f32),
        'k_norm_w': 1.0 + 0.05 * nrm(ks[8], (L, SWA_DH), f32),
        'rel_bias': 0.5 * nrm(ks[9], (REL_BUCKETS, SWA_HEADS), f32),
        'w_out': nrm(ks[10], (L, MIX_WIDTH, D_MODEL), f32) * MIX_WIDTH ** -0.5,
        'norm2_w': 1.0 + 0.05 * nrm(ks[11], (L, D_MODEL), f32),
        'w_router': nrm(ks[12], (L, D_MODEL, N_EXPERTS), f32) * D_MODEL ** -0.5,
        'b_router': 0.01 * nrm(ks[13], (L, N_EXPERTS), f32),
        'w_gate_up': nrm(ks[14], (L, N_EXPERTS, D_MODEL, 2 * D_FF), f32) * D_MODEL ** -0.5,
        'b_gate_up': 0.01 * nrm(ks[15], (L, N_EXPERTS, 2 * D_FF), f32),
        'w_down': nrm(ks[16], (L, N_EXPERTS, D_FF, D_MODEL), f32) * D_FF ** -0.5,
        'b_down': 0.01 * nrm(ks[17], (L, N_EXPERTS, D_MODEL), f32),
    }


def reference(x, norm1_w, w_in, conv_w, a_log, dt_bias, gdn_norm_w, q_norm_w, k_norm_w, rel_bias,
              w_out, norm2_w, w_router, b_router, w_gate_up, b_gate_up, w_down, b_down):
    h = x
    for l in range(DEPTH):
        h = _layer(h, norm1_w[l], w_in[l], conv_w[l], a_log[l], dt_bias[l], gdn_norm_w[l],
                   q_norm_w[l], k_norm_w[l], rel_bias, w_out[l], norm2_w[l], w_router[l],
                   b_router[l], w_gate_up[l], b_gate_up[l], w_down[l], b_down[l])
    return h
```

```cpp
#include <hip/hip_runtime.h>
#include <cstdio>
#include <cstdint>

#ifndef MK_N_LAUNCHES
#define MK_N_LAUNCHES 9
#endif
#ifndef SKIP_ATTN
#define SKIP_ATTN 0
#endif
#ifndef ATT_JOBS
#define ATT_JOBS 32
#endif
#ifndef SKIP_MOE
#define SKIP_MOE 0
#endif

#define LAS __attribute__((address_space(3)))
#define GAS __attribute__((address_space(1)))
typedef unsigned short bf16;
typedef short bf16x8 __attribute__((ext_vector_type(8)));
typedef short s16x4 __attribute__((ext_vector_type(4)));
typedef float f32x2 __attribute__((ext_vector_type(2)));
typedef float f32x4 __attribute__((ext_vector_type(4)));
typedef float f32x16 __attribute__((ext_vector_type(16)));
typedef unsigned u32x2 __attribute__((ext_vector_type(2)));
typedef unsigned u32x4 __attribute__((ext_vector_type(4)));
typedef __bf16 bf16x2_t __attribute__((ext_vector_type(2)));

constexpr int NBATCH = 8, SEQ = 4096, D = 1024, T = NBATCH * SEQ;
constexpr int IN_DIM = 3592, NIN = 3584;
constexpr int GH = 4, DK = 128, CHUNK = 64, NCHUNK = SEQ / CHUNK;
constexpr int AH = 8, DH = 64;
constexpr int NE = 32, FF = 1024, LCAP = 32768;
constexpr float EPS = 1e-6f, LOG2E = 1.4426950408889634f;
constexpr int NWAVES = 8, NTHREADS = 512;

constexpr size_t MiB = 1u << 20;
constexpr size_t WS_CTL = 0, CTL_ZERO_BYTES = 1 * MiB;
constexpr size_t WS_WIN = 1 * MiB, WS_WOUT = 8 * MiB, WS_WGU = 10 * MiB, WS_WDN = 138 * MiB;
constexpr size_t WS_TE = 202 * MiB, WS_TSLOT = WS_TE + 512 * 1024, WS_TG = WS_TSLOT + 512 * 1024;
constexpr size_t WS_LIST = 204 * MiB, WS_LRS = 208 * MiB;
constexpr size_t WS_BA = 212 * MiB, WS_WRT = 213 * MiB;
constexpr size_t WS_ZG = 214 * MiB, WS_QB = 342 * MiB, WS_KB = 374 * MiB, WS_VB = 406 * MiB;
constexpr size_t WS_PREP = 438 * MiB;
constexpr int PREP_WP = 0, PREP_QP = 16384, PREP_AP = 32768, PREP_KT = 40960, PREP_UP = 57344, PREP_CD = 90112, PREP_REC = 90368;
constexpr size_t WS_OG = 616 * MiB, WS_MIX = 680 * MiB;
constexpr size_t WS_XN = 760 * MiB, WS_HB = 760 * MiB;
constexpr size_t WS_ACT = 214 * MiB, WS_Y = 486 * MiB, WS_END = 824 * MiB;
static_assert(WS_VB - WS_KB == WS_KB - WS_QB, "q/k/v stride");
static_assert(WS_PREP + (size_t)NBATCH * GH * NCHUNK * PREP_REC <= WS_OG, "prep region");
static_assert(WS_ACT + (size_t)(T * 4 + NE * 256) * FF * 2 <= WS_Y && WS_Y + (size_t)(T * 4 + NE * 256) * D * 2 <= WS_HB, "act/y regions");
constexpr int CW_TMO = 0, CW_CODE = 1, CW_GCNT = 1024  , CW_BAR = 8192;

constexpr int LDS_BYTES = 160 * 1024;
constexpr int RING_BYTES = 131072;
constexpr int TOP_OFF = LDS_BYTES - 4096;
constexpr int MISC_OFF = TOP_OFF;
constexpr int MOE_TAB_OFF = TOP_OFF + 256;
constexpr int MOE_TSTART = MOE_TAB_OFF, MOE_LCNT = MOE_TAB_OFF + 256, MOE_TEXP = MOE_TAB_OFF + 512;

#define RLX_AGENT __ATOMIC_RELAXED, __HIP_MEMORY_SCOPE_AGENT
#define LDS_WAIT() asm volatile("s_waitcnt lgkmcnt(0)" ::: "memory")
#define VM_WAIT() asm volatile("s_waitcnt vmcnt(0)" ::: "memory")
__device__ __forceinline__ unsigned pk2(float lo, float hi) { f32x2 v = {lo, hi}; bf16x2_t b = __builtin_convertvector(v, bf16x2_t); return __builtin_bit_cast(unsigned, b); }
__device__ __forceinline__ float bf2f(unsigned short b) { return __uint_as_float((unsigned)b << 16); }
__device__ __forceinline__ float bflo(unsigned w) { return __uint_as_float(w << 16); }
__device__ __forceinline__ float bfhi(unsigned w) { return __uint_as_float(w & 0xffff0000u); }
__device__ __forceinline__ float wave_sum(float v) {
#pragma unroll
    for (int o = 1; o < 64; o <<= 1) v += __shfl_xor(v, o);
    return v;
}
__device__ __forceinline__ float silu_f(float x) { return x / (1.f + __expf(-x)); }
__device__ __forceinline__ float sigmoid_f(float x) { return 1.f / (1.f + __expf(-x)); }
__device__ __forceinline__ bf16x8 pack8(f32x4 a, f32x4 b) {
    u32x4 w; w.x = pk2(a[0], a[1]); w.y = pk2(a[2], a[3]); w.z = pk2(b[0], b[1]); w.w = pk2(b[2], b[3]); return __builtin_bit_cast(bf16x8, w);
}

namespace pg8 {
constexpr int BM = 256, BK = 64, HALF = 128, HTB = HALF * BK * 2, STAGE_BYTES = 8 * HTB, NXCD = 8, WGM = 8;
__host__ __device__ __forceinline__ int lds_byte(int r, int c) { const int st = (r >> 4) * 2 + (c >> 5), rr = r & 15, cc = c & 31, ob = rr * 64 + cc * 2; return st * 1024 + (ob ^ (((ob >> 9) & 1) << 5)); }
__host__ __device__ __forceinline__ void stage_rc(int b, int& R, int& C) { const int st = b / 1024, sb = b % 1024, swz = sb ^ (((sb >> 9) & 1) << 5); R = (st >> 1) * 16 + swz / 64; C = (st & 1) * 32 + (swz % 64) / 2; }
__host__ __device__ __forceinline__ int perm32(int rho) { const int n = rho >> 4, i = rho & 15; return 8 * (i >> 2) + 4 * n + (i & 3); }

struct Unit { int pm, pn, pb, e, mt; };
struct Gemm { const bf16* A; const bf16* Bt; int K; };

__device__ __forceinline__ bool static_tile(int i, int G, int c, int nM, int nN, int& pm, int& pn) {
    const int nwg = nM * nN; const long L = (long)i * G + c; if (L >= nwg) return false;
    int wgid = (int)L; { const int q = nwg / NXCD, r = nwg % NXCD, xcd = wgid % NXCD, off = wgid / NXCD; wgid = (xcd < r ? xcd * (q + 1) : r * (q + 1) + (xcd - r) * q) + off; }
    const int nig = WGM * nN, gid = wgid / nig, fm = gid * WGM, gsz = (nM - fm) < WGM ? (nM - fm) : WGM;
    pm = fm + ((wgid % nig) % gsz); pn = (wgid % nig) / gsz; return true;
}
struct StaticOrder {
    int nM, nN, G, c;
    __device__ __forceinline__ bool next(int i, Unit& u) const { int pm, pn; if (!static_tile(i, G, c, nM, nN, pm, pn)) return false; u.pm = pm; u.pn = pn; u.pb = pn; u.e = 0; u.mt = 0; return true; }
    __device__ __forceinline__ int row_index(const Unit&, int) const { return 0; }
};
struct MoeOrder {
    int nM, nN, G, c; const LAS int* tstart; const LAS int* lcnt; const LAS int* texp; const int* list;
    __device__ __forceinline__ bool next(int i, Unit& u) const {
        int pm, pn; if (!static_tile(i, G, c, nM, nN, pm, pn)) return false;
        const int e = texp[pm]; u.pm = pm; u.pn = pn; u.e = e; u.pb = e * nN + pn; u.mt = pm - tstart[e]; return true;
    }
    __device__ __forceinline__ int row_index(const Unit& u, int r) const { const int rr = u.mt * 256 + r; return rr < lcnt[u.e] ? list[u.e * LCAP + rr] : 0; }
};

#define PG8_SA(b, h) (((b) * 2 + (h)) * HTB)
#define PG8_SB(b, h) ((4 + (b) * 2 + (h)) * HTB)
#define PG8_GLDS(src, dstoff) __builtin_amdgcn_global_load_lds((const unsigned*)(src), (LAS unsigned*)(lds + (dstoff)), 16, 0, 0)
#define PG8_STAGE_B(bufoff, nx, kb, h) do { _Pragma("unroll") for (int _i = 0; _i < 2; ++_i) \
        PG8_GLDS(((nx) ? nB : cB) + (kb) + (size_t)(h) * hstep + voffB[_i], (bufoff) + ldsw + _i * 8192); } while (0)
#define PG8_STAGE_A(bufoff, nx, kb, h) do { _Pragma("unroll") for (int _i = 0; _i < 2; ++_i) \
        PG8_GLDS(GATHER ? (const char*)g.A + (kb) + ((nx) ? voffN[h][_i] : voffC[h][_i]) : ((nx) ? nA : cA) + (kb) + (size_t)(h) * hstep + voffA[_i], (bufoff) + ldsw + _i * 8192); } while (0)
#define PG8_LDA(dst, b, h) do { _Pragma("unroll") for (int m = 0; m < 4; ++m) _Pragma("unroll") for (int k = 0; k < 2; ++k) dst[m][k] = *(const LAS bf16x8*)(lds + PG8_SA(b, h) + aoff + m * 2048 + k * 1024); } while (0)
#define PG8_LDB(dst, b, h) do { _Pragma("unroll") for (int n = 0; n < 2; ++n) _Pragma("unroll") for (int k = 0; k < 2; ++k) dst[n][k] = *(const LAS bf16x8*)(lds + PG8_SB(b, h) + boff + n * 2048 + k * 1024); } while (0)
#define PG8_MMA(ai, bj, At, Bt) do { __builtin_amdgcn_s_setprio(1); _Pragma("unroll") for (int m = 0; m < 4; ++m) _Pragma("unroll") for (int n = 0; n < 2; ++n) _Pragma("unroll") for (int k = 0; k < 2; ++k) \
        acc[ai][bj][m][n] = __builtin_amdgcn_mfma_f32_16x16x32_bf16(Bt[n][k], At[m][k], acc[ai][bj][m][n], 0, 0, 0); __builtin_amdgcn_s_setprio(0); } while (0)
#define PG8_WAIT_V(n) asm volatile("s_waitcnt vmcnt(" #n ")" ::: "memory")
#define PG8_WAIT_L(n) asm volatile("s_waitcnt lgkmcnt(" #n ")" ::: "memory")
#define PG8_BAR __builtin_amdgcn_s_barrier()
#define PG8_SCHED __builtin_amdgcn_sched_barrier(0)

template <class Epi, class Sched, bool GATHER, bool ALIGN_EPI>
__device__ __forceinline__ void gemm_phase(LAS unsigned char* lds, const Gemm g, const Sched& S, const Epi& E) {
    const int tid = threadIdx.x, wid = __builtin_amdgcn_readfirstlane(tid >> 6), lane = tid & 63, wr = wid >> 2, wc = wid & 3, fr = lane & 15, fq = lane >> 4;
    const int K = g.K, nt = K / BK;
    unsigned voffA[2], voffB[2], voffC[2][2], voffN[2][2]; int RA[2], CA[2];
#pragma unroll
    for (int i = 0; i < 2; ++i) { int R, C; stage_rc(tid * 16 + i * 8192, R, C); const int Rb = Epi::PERM ? ((R & ~31) + perm32(R & 31)) : R;
        RA[i] = R; CA[i] = C; voffA[i] = (unsigned)(R * K + C) * 2u; voffB[i] = (unsigned)(Rb * K + C) * 2u; }
    const size_t kstep = (size_t)(BK * 2), hstep = (size_t)HALF * K * 2, tstep = 2 * hstep;
    const unsigned ldsw = (unsigned)wid * 1024u;
    const int aoff = lds_byte(wr * 64 + fr, fq * 8), boff = lds_byte(wc * 32 + fr, fq * 8);
    Unit cur, nxt; int ui = 0;
    if (!S.next(0, cur)) return;
    f32x4 acc[2][2][4][2];
#pragma unroll
    for (int a = 0; a < 2; ++a)
#pragma unroll
        for (int b = 0; b < 2; ++b)
#pragma unroll
            for (int m = 0; m < 4; ++m)
#pragma unroll
                for (int n = 0; n < 2; ++n) acc[a][b][m][n] = (f32x4){0.f, 0.f, 0.f, 0.f};
    bf16x8 At[4][2], B0[2][2], B1[2][2];
    const char* cA = (const char*)g.A + (size_t)cur.pm * tstep; const char* cB = (const char*)g.Bt + (size_t)cur.pb * tstep;
    if (GATHER) {
#pragma unroll
        for (int h = 0; h < 2; ++h)
#pragma unroll
            for (int i = 0; i < 2; ++i) { voffC[h][i] = (unsigned)(S.row_index(cur, RA[i] + 128 * h) * K + CA[i]) * 2u; voffN[h][i] = voffC[h][i]; }
    }
    const char* nA = cA; const char* nB = cB;
    PG8_STAGE_B(PG8_SB(0, 0), false, 0, 0); PG8_STAGE_B(PG8_SB(0, 1), false, 0, 1); PG8_STAGE_A(PG8_SA(0, 0), false, 0, 0); PG8_STAGE_A(PG8_SA(0, 1), false, 0, 1);
    if (wr == 1) PG8_BAR;
    PG8_WAIT_V(2); PG8_BAR;
    PG8_STAGE_B(PG8_SB(1, 0), false, kstep, 0); PG8_STAGE_A(PG8_SA(1, 0), false, kstep, 0); PG8_STAGE_B(PG8_SB(1, 1), false, kstep, 1);
    PG8_WAIT_V(6); PG8_BAR;
    for (;;) {
        const bool has_next = S.next(ui + 1, nxt);
        nA = has_next ? (const char*)g.A + (size_t)nxt.pm * tstep : cA; nB = has_next ? (const char*)g.Bt + (size_t)nxt.pb * tstep : cB;
        if (GATHER) {
#pragma unroll
            for (int h = 0; h < 2; ++h)
#pragma unroll
                for (int i = 0; i < 2; ++i) voffN[h][i] = has_next ? (unsigned)(S.row_index(nxt, RA[i] + 128 * h) * K + CA[i]) * 2u : voffC[h][i];
        }
        for (int t = 0; t < nt; t += 2) {
            const bool last = (t == nt - 2);
            const size_t k1 = (size_t)(t + 1) * kstep, k2 = last ? 0 : (size_t)(t + 2) * kstep, k3 = k2 + kstep;
            PG8_LDB(B0, 0, 0); PG8_LDB(B1, 0, 1); PG8_SCHED; PG8_LDA(At, 0, 0); PG8_STAGE_A(PG8_SA(1, 1), false, k1, 1);
            PG8_WAIT_V(8); PG8_WAIT_L(0); PG8_BAR; PG8_MMA(0, 0, At, B0); PG8_MMA(0, 1, At, B1); PG8_BAR; PG8_SCHED;
            PG8_LDA(At, 0, 1); PG8_STAGE_B(PG8_SB(0, 0), last, k2, 0); PG8_STAGE_B(PG8_SB(0, 1), last, k2, 1); PG8_STAGE_A(PG8_SA(0, 0), last, k2, 0);
            PG8_WAIT_V(8); PG8_WAIT_L(0); PG8_BAR; PG8_MMA(1, 0, At, B0); PG8_MMA(1, 1, At, B1); PG8_BAR; PG8_SCHED;
            PG8_LDB(B0, 1, 0); PG8_LDB(B1, 1, 1); PG8_SCHED; PG8_LDA(At, 1, 0); PG8_STAGE_A(PG8_SA(0, 1), last, k2, 1);
            PG8_WAIT_V(8); PG8_WAIT_L(0); PG8_BAR; PG8_MMA(0, 0, At, B0); PG8_MMA(0, 1, At, B1); PG8_BAR; PG8_SCHED;
            PG8_LDA(At, 1, 1); PG8_STAGE_B(PG8_SB(1, 0), last, k3, 0); PG8_STAGE_B(PG8_SB(1, 1), last, k3, 1); PG8_STAGE_A(PG8_SA(1, 0), last, k3, 0);
            PG8_WAIT_V(8); PG8_WAIT_L(0); PG8_BAR; PG8_MMA(1, 0, At, B0); PG8_MMA(1, 1, At, B1); PG8_BAR; PG8_SCHED;
        }
        if constexpr (ALIGN_EPI) { if (wr == 0) PG8_BAR; }
        E(acc, cur, wr, wc, fr, fq);
        if (!has_next) break;
#pragma unroll
        for (int a = 0; a < 2; ++a)
#pragma unroll
            for (int b = 0; b < 2; ++b)
#pragma unroll
                for (int m = 0; m < 4; ++m)
#pragma unroll
                    for (int n = 0; n < 2; ++n) acc[a][b][m][n] = (f32x4){0.f, 0.f, 0.f, 0.f};
        cur = nxt; cA = nA; cB = nB; ++ui;
        if (GATHER) {
#pragma unroll
            for (int h = 0; h < 2; ++h)
#pragma unroll
                for (int i = 0; i < 2; ++i) voffC[h][i] = voffN[h][i];
        }
        if constexpr (ALIGN_EPI) { if (wr == 1) PG8_BAR; }
    }
    PG8_WAIT_V(0);
    if constexpr (!ALIGN_EPI) { if (wr == 0) PG8_BAR; }
    PG8_BAR;
}

struct EpiInProj {
    static constexpr bool PERM = true;
    bf16* zg; bf16* qb; bf16* kb; bf16* vb; const float* qn; const float* kn;
    __device__ __forceinline__ void operator()(const f32x4 (&acc)[2][2][4][2], const Unit& u, int wr, int wc, int fr, int fq) const {
        const int row0 = u.pm * BM + wr * 64 + fr;
        if (u.pn < 8) {
            const int col0 = u.pn * BM + wc * 32 + 8 * fq;
#pragma unroll
            for (int ai = 0; ai < 2; ++ai)
#pragma unroll
                for (int m = 0; m < 4; ++m) { bf16* rowp = zg + (size_t)(row0 + ai * HALF + m * 16) * 2048 + col0;
#pragma unroll
                    for (int bj = 0; bj < 2; ++bj) { const f32x4 v0 = acc[ai][bj][m][0], v1 = acc[ai][bj][m][1];
                        u32x4 w; w.x = pk2(v0[0], v0[1]); w.y = pk2(v0[2], v0[3]); w.z = pk2(v1[0], v1[1]); w.w = pk2(v1[2], v1[3]); *(u32x4*)(rowp + bj * HALF) = w; } }
        } else {
            const int sec = (u.pn - 8) >> 1, head = 4 * ((u.pn - 8) & 1) + wc;
            bf16* dst = qb + (size_t)sec * ((WS_KB - WS_QB) / 2); const float* nw = (sec == 1) ? kn : qn;
            f32x4 wv[2][2];
#pragma unroll
            for (int bj = 0; bj < 2; ++bj)
#pragma unroll
                for (int n = 0; n < 2; ++n) wv[bj][n] = sec == 2 ? (f32x4){1.f, 1.f, 1.f, 1.f} : *(const f32x4*)(nw + 32 * bj + 8 * fq + 4 * n);
#pragma unroll
            for (int ai = 0; ai < 2; ++ai)
#pragma unroll
                for (int m = 0; m < 4; ++m) {
                    float sc = 1.f;
                    if (sec < 2) { float ss = 0.f;
#pragma unroll
                        for (int bj = 0; bj < 2; ++bj)
#pragma unroll
                            for (int n = 0; n < 2; ++n) { const f32x4 x = acc[ai][bj][m][n]; ss += (x[0] * x[0] + x[1] * x[1]) + (x[2] * x[2] + x[3] * x[3]); }
                        ss += __shfl_xor(ss, 16); ss += __shfl_xor(ss, 32);
                        sc = rsqrtf(ss * (1.f / 64.f) + EPS) * (sec == 0 ? 0.125f * LOG2E : 1.f); }
                    bf16* rowp = dst + (size_t)(row0 + ai * HALF + m * 16) * 512 + head * 64 + 8 * fq;
#pragma unroll
                    for (int bj = 0; bj < 2; ++bj) { const f32x4 v0 = acc[ai][bj][m][0] * sc * wv[bj][0], v1 = acc[ai][bj][m][1] * sc * wv[bj][1];
                        u32x4 w; w.x = pk2(v0[0], v0[1]); w.y = pk2(v0[2], v0[3]); w.z = pk2(v1[0], v1[1]); w.w = pk2(v1[2], v1[3]); *(u32x4*)(rowp + bj * 32) = w; } }
        }
    }
};
struct EpiOutProj {
    static constexpr bool PERM = false;
    const float* x; float* h; bf16* hb;
    __device__ __forceinline__ void operator()(const f32x4 (&acc)[2][2][4][2], const Unit& u, int wr, int wc, int fr, int fq) const {
        const int row0 = u.pm * BM + wr * 64 + fr, col0 = u.pn * BM + wc * 32 + 4 * fq;
#pragma unroll
        for (int ai = 0; ai < 2; ++ai)
#pragma unroll
            for (int m = 0; m < 4; ++m) { const size_t off = (size_t)(row0 + ai * HALF + m * 16) * D + col0;
#pragma unroll
                for (int bj = 0; bj < 2; ++bj)
#pragma unroll
                    for (int n = 0; n < 2; ++n) { const f32x4 v = *(const f32x4*)(x + off + bj * HALF + n * 16) + acc[ai][bj][m][n];
                        *(f32x4*)(h + off + bj * HALF + n * 16) = v; u32x2 w; w.x = pk2(v[0], v[1]); w.y = pk2(v[2], v[3]); *(u32x2*)(hb + off + bj * HALF + n * 16) = w; } }
    }
};
struct EpiGateUp {
    static constexpr bool PERM = true;
    bf16* act; const float* bgu; const float* lrs; const LAS int* lcnt;
    __device__ __forceinline__ void operator()(const f32x4 (&acc)[2][2][4][2], const Unit& u, int wr, int wc, int fr, int fq) const {
        const int cl = wc * 32 + 8 * fq; const float* bg = bgu + (size_t)u.e * 2048 + 128 * u.pn + cl;
        f32x4 bgv[2], buv[2];
#pragma unroll
        for (int n = 0; n < 2; ++n) { bgv[n] = *(const f32x4*)(bg + 4 * n); buv[n] = *(const f32x4*)(bg + 1024 + 4 * n); }
        const int cnt = lcnt[u.e];
#pragma unroll
        for (int ai = 0; ai < 2; ++ai)
#pragma unroll
            for (int m = 0; m < 4; ++m) { const int r = ai * HALF + wr * 64 + m * 16 + fr, rr = u.mt * 256 + r;
                const float rs = rr < cnt ? lrs[(size_t)u.e * LCAP + rr] : 0.f;
                u32x4 w; unsigned wq[4];
#pragma unroll
                for (int n = 0; n < 2; ++n) { float a[4];
#pragma unroll
                    for (int i = 0; i < 4; ++i) { const float gt = fminf(acc[ai][0][m][n][i] * rs + bgv[n][i], 7.f); const float up = fminf(fmaxf(acc[ai][1][m][n][i] * rs + buv[n][i], -7.f), 7.f);
                        a[i] = (up + 1.f) * gt * sigmoid_f(1.702f * gt); }
                    wq[2 * n] = pk2(a[0], a[1]); wq[2 * n + 1] = pk2(a[2], a[3]); }
                w.x = wq[0]; w.y = wq[1]; w.z = wq[2]; w.w = wq[3];
                *(u32x4*)(act + (size_t)(u.pm * BM + r) * FF + 128 * u.pn + cl) = w; }
    }
};
struct EpiDown {
    static constexpr bool PERM = true;
    bf16* y; const float* bdn;
    __device__ __forceinline__ void operator()(const f32x4 (&acc)[2][2][4][2], const Unit& u, int wr, int wc, int fr, int fq) const {
        const int col0 = u.pn * BM + wc * 32 + 8 * fq; const float* bp = bdn + (size_t)u.e * D + col0;
        f32x4 bv[2][2];
#pragma unroll
        for (int bj = 0; bj < 2; ++bj)
#pragma unroll
            for (int n = 0; n < 2; ++n) bv[bj][n] = *(const f32x4*)(bp + bj * HALF + 4 * n);
#pragma unroll
        for (int ai = 0; ai < 2; ++ai)
#pragma unroll
            for (int m = 0; m < 4; ++m) { bf16* rowp = y + (size_t)(u.pm * BM + ai * HALF + wr * 64 + m * 16 + fr) * D + col0;
#pragma unroll
                for (int bj = 0; bj < 2; ++bj) { const f32x4 v0 = acc[ai][bj][m][0] + bv[bj][0], v1 = acc[ai][bj][m][1] + bv[bj][1];
                    u32x4 w; w.x = pk2(v0[0], v0[1]); w.y = pk2(v0[2], v0[3]); w.z = pk2(v1[0], v1[1]); w.w = pk2(v1[2], v1[3]); *(u32x4*)(rowp + bj * HALF) = w; } }
    }
};
}

#define XB_TMO      128
#define XB_XCNT(j)  (256  + 64 * (j))
#define XB_XSUB(j)  (1280 + 64 * (j))
#define XB_XGEN(j)  (2304 + 64 * (j))
#define XB_TOP      3328
#define XB_TOPGEN   3392
#define XCD_BAR_WORDS 3456
#define XB_SPIN_CAP (1u << 20)
__device__ __forceinline__ unsigned xb_ld(unsigned* p)              { return __hip_atomic_load(p, __ATOMIC_RELAXED, __HIP_MEMORY_SCOPE_AGENT); }
__device__ __forceinline__ unsigned xb_add(unsigned* p, unsigned v) { return __hip_atomic_fetch_add(p, v, __ATOMIC_RELAXED, __HIP_MEMORY_SCOPE_AGENT); }
__device__ __forceinline__ unsigned xb_xcc_id() { return (unsigned)__builtin_amdgcn_s_getreg((3 << 11) | 20) & 0xFu; }
#define XB_SPIN(cond, bar) do { unsigned _sp = 0; while (cond) { __builtin_amdgcn_s_sleep(1); \
    if ((++_sp & 255u) == 0u) { if (xb_ld(&(bar)[XB_TMO])) break; if (_sp > XB_SPIN_CAP) { atomicAdd(&(bar)[XB_TMO], 1u); break; } } } } while (0)
struct XcdBarrier { unsigned* bar; unsigned x; volatile LAS unsigned* st; };
__device__ __forceinline__ XcdBarrier xcd_barrier_post(unsigned* bar, volatile LAS unsigned* st) {
    XcdBarrier b; b.bar = bar; b.x = xb_xcc_id(); b.st = st;
    if (threadIdx.x == 0) (void)xb_add(&bar[XB_XCNT(b.x)], 1u);
    return b;
}
__device__ __forceinline__ void xcd_barrier_complete(unsigned* bar, unsigned x, unsigned& nloc, unsigned& nx) {
    const unsigned G = gridDim.x * gridDim.y * gridDim.z;
    unsigned sum, cnt, mine, sp = 0u;
    for (;;) {
        sum = 0u; cnt = 0u; mine = 0u;
#pragma unroll
        for (unsigned j = 0; j < 16; ++j) { const unsigned c = xb_ld(&bar[XB_XCNT(j)]); sum += c; cnt += (c > 0u) ? 1u : 0u; mine = (j == x) ? c : mine; }
        if (sum == G) break;
        __builtin_amdgcn_s_sleep(1);
        if ((++sp & 255u) == 0u) { if (xb_ld(&bar[XB_TMO])) break; if (sp > XB_SPIN_CAP) { atomicAdd(&bar[XB_TMO], 1u); break; } }
    }
    nloc = mine > 0u ? mine : 1u; nx = cnt > 0u ? cnt : 1u;
}
__device__ __forceinline__ void xcd_barrier(const XcdBarrier& b) {
    asm volatile("s_waitcnt vmcnt(0)" ::: "memory");
    __syncthreads();
    if (threadIdx.x == 0) {
        unsigned* bar = b.bar;
        __builtin_amdgcn_s_waitcnt(0);
        unsigned nloc = b.st[0], nx = b.st[1];
        if (nloc == 0u) { xcd_barrier_complete(bar, b.x, nloc, nx); b.st[0] = nloc; b.st[1] = nx; }
        const unsigned old = xb_add(&bar[XB_XSUB(b.x)], 1u);
        const unsigned gen = old / nloc;
        if (old + 1u == (gen + 1u) * nloc) {
            __builtin_amdgcn_fence(__ATOMIC_RELEASE, "agent");
            asm volatile("s_waitcnt vmcnt(0)" ::: "memory");
            const unsigned og = xb_add(&bar[XB_TOP], 1u);
            const unsigned tg = og / nx;
            if (og + 1u == (tg + 1u) * nx) xb_add(&bar[XB_TOPGEN], 1u);
            else XB_SPIN(xb_ld(&bar[XB_TOPGEN]) == tg, bar);
            __builtin_amdgcn_fence(__ATOMIC_ACQUIRE, "agent");
            xb_add(&bar[XB_XGEN(b.x)], 1u);
            asm volatile("s_waitcnt vmcnt(0)" ::: "memory");
        } else {
            XB_SPIN(xb_ld(&bar[XB_XGEN(b.x)]) == gen, bar);
            __builtin_amdgcn_fence(__ATOMIC_ACQUIRE, "agent");
            asm volatile("s_waitcnt vmcnt(0)" ::: "memory");
        }
    }
    __syncthreads();
}

struct Args { const float* in[18]; float* out; unsigned char* ws; int ph_lo, ph_hi, li, pad; };
struct Frame {
    LAS unsigned char* lds; unsigned char* ws; unsigned* ctl;
    int tid, lane, wave, G, vcu;
};

__device__ const unsigned char T5B[3][132] = {
{0,1,2,3,4,5,6,7,8,9,10,11,12,13,14,15,16,16,16,16,16,16,17,17,17,17,17,17,17,17,18,18,18,18,18,18,18,18,18,18,19,19,19,19,19,19,19,19,19,19,19,19,19,19,20,20,20,20,20,20,20,20,20,20,20,20,20,20,20,20,20,20,20,21,21,21,21,21,21,21,21,21,21,21,21,21,21,21,21,21,21,21,21,21,21,21,21,21,21,22,22,22,22,22,22,22,22,22,22,22,22,22,22,22,22,22,22,22,22,22,22,22,22,22,22,22,22,22,22,0,0,0},
{0,4,8,12,16,16,17,17,18,18,19,19,19,19,20,20,20,20,20,21,21,21,21,21,21,22,22,22,22,22,22,22,22,22,23,23,23,23,23,23,23,23,23,23,23,23,24,24,24,24,24,24,24,24,24,24,24,24,24,24,24,24,25,25,25,25,25,25,25,25,25,25,25,25,25,25,25,25,25,25,25,25,25,26,26,26,26,26,26,26,26,26,26,26,26,26,26,26,26,26,26,26,26,26,26,26,26,26,26,26,26,26,26,27,27,27,27,27,27,27,27,27,27,27,27,27,27,27,27,0,0,0},
{0,16,18,19,20,21,21,22,22,23,23,23,24,24,24,24,25,25,25,25,25,26,26,26,26,26,26,26,26,27,27,27,27,27,27,27,27,27,27,28,28,28,28,28,28,28,28,28,28,28,28,28,29,29,29,29,29,29,29,29,29,29,29,29,29,29,29,29,29,29,30,30,30,30,30,30,30,30,30,30,30,30,30,30,30,30,30,30,30,30,30,30,30,30,30,31,31,31,31,31,31,31,31,31,31,31,31,31,31,31,31,31,31,31,31,31,31,31,31,31,31,31,31,31,31,31,31,31,31,0,0,0}};

__device__ __forceinline__ void p0_transpose_item(const float* W, size_t ldw, int src_col0, bf16* dst, int k0, const float* kscale, LAS float* scr, int lane) {
#pragma unroll 8
    for (int i = 0; i < 32; ++i) { const int kk = 2 * i + (lane >> 5); float v = W[(size_t)(k0 + kk) * ldw + src_col0 + (lane & 31)]; if (kscale) v *= kscale[k0 + kk]; scr[kk * 33 + (lane & 31)] = v; }
    LDS_WAIT(); asm volatile("" ::: "memory");
    const int c = lane & 7;
#pragma unroll
    for (int j = 0; j < 4; ++j) { const int n = (lane >> 3) + 8 * j; const LAS float* s = scr + (8 * c) * 33 + n;
        u32x4 o; o.x = pk2(s[0 * 33], s[1 * 33]); o.y = pk2(s[2 * 33], s[3 * 33]); o.z = pk2(s[4 * 33], s[5 * 33]); o.w = pk2(s[6 * 33], s[7 * 33]);
        *(u32x4*)(dst + (size_t)n * 1024 + k0 + 8 * c) = o; }
    LDS_WAIT(); asm volatile("" ::: "memory");
}
__device__ __forceinline__ void phase0(Frame& F, const Args& a) {
    const float* x = a.in[0]; const float* n1 = a.in[1]; const float* w_in = a.in[2]; const float* w_out = a.in[10]; const float* n2 = a.in[11];
    const float* w_r = a.in[12]; const float* w_gu = a.in[14]; const float* w_dn = a.in[16];
    bf16* Win_t = (bf16*)(F.ws + WS_WIN); bf16* Wout_t = (bf16*)(F.ws + WS_WOUT); bf16* Wgu_t = (bf16*)(F.ws + WS_WGU); bf16* Wdn_t = (bf16*)(F.ws + WS_WDN);
    float* wrT = (float*)(F.ws + WS_WRT); bf16* XN = (bf16*)(F.ws + WS_XN); float* BA = (float*)(F.ws + WS_BA);
    LAS float* scr = (LAS float*)(F.lds + F.wave * 16384);
    const int gw = F.vcu * NWAVES + F.wave, NGW = F.G * NWAVES;
    for (int m = gw; m < T; m += NGW) {
        const f32x4* xr = (const f32x4*)(x + (size_t)m * D) + F.lane; f32x4 v[4]; float s = 0.f;
#pragma unroll
        for (int j = 0; j < 4; ++j) { v[j] = xr[64 * j]; s += (v[j][0] * v[j][0] + v[j][1] * v[j][1]) + (v[j][2] * v[j][2] + v[j][3] * v[j][3]); }
        const float rs = rsqrtf(wave_sum(s) * (1.f / D) + EPS);
        float ba[8];
#pragma unroll
        for (int c = 0; c < 8; ++c) ba[c] = 0.f;
        unsigned long long* o8 = (unsigned long long*)(XN + (size_t)m * D) + F.lane;
#pragma unroll
        for (int j = 0; j < 4; ++j) { const f32x4 w = *((const f32x4*)n1 + F.lane + 64 * j); v[j] = v[j] * rs * w;
            o8[64 * j] = (unsigned long long)pk2(v[j][0], v[j][1]) | ((unsigned long long)pk2(v[j][2], v[j][3]) << 32);
#pragma unroll
            for (int i = 0; i < 4; ++i) { const float* wp = w_in + (size_t)(4 * F.lane + 256 * j + i) * IN_DIM + 2048; const f32x4 w0 = *(const f32x4*)wp, w1 = *(const f32x4*)(wp + 4);
                ba[0] += v[j][i] * w0[0]; ba[1] += v[j][i] * w0[1]; ba[2] += v[j][i] * w0[2]; ba[3] += v[j][i] * w0[3];
                ba[4] += v[j][i] * w1[0]; ba[5] += v[j][i] * w1[1]; ba[6] += v[j][i] * w1[2]; ba[7] += v[j][i] * w1[3]; } }
#pragma unroll
        for (int c = 0; c < 8; ++c) ba[c] = wave_sum(ba[c]);
        if (F.lane == 0) { *(f32x4*)(BA + (size_t)m * 8) = (f32x4){ba[0], ba[1], ba[2], ba[3]}; *(f32x4*)(BA + (size_t)m * 8 + 4) = (f32x4){ba[4], ba[5], ba[6], ba[7]}; }
    }
    for (int i = (F.vcu * NTHREADS + F.tid); i < NE * D; i += F.G * NTHREADS) { const int e = i >> 10, k = i & 1023; wrT[i] = n2[k] * w_r[k * NE + e]; }
    constexpr int I_IN = 16 * (NIN / 32), I_OUT = 16 * 32, I_GU = NE * 16 * 64, I_DN = NE * 16 * 32, NITEMS = I_IN + I_OUT + I_GU + I_DN;
    for (int it = gw; it < NITEMS; it += NGW) {
        int r = it;
        if (r < I_IN) { const int nb = r % (NIN / 32), kb = r / (NIN / 32), np = 32 * nb; int src;
            if (np < 2048) src = np; else { const int q = np - 2048, sec = q >> 9, rem = q & 511, pt = rem >> 8, lc = rem & 255, bj = lc >> 7, wc = (lc & 127) >> 5; src = 2056 + sec * 512 + (4 * pt + wc) * 64 + 32 * bj; }
            p0_transpose_item(w_in, IN_DIM, src, Win_t + (size_t)np * 1024, 64 * kb, nullptr, scr, F.lane); continue; }
        r -= I_IN;
        if (r < I_OUT) { const int nb = r & 31, kb = r >> 5; p0_transpose_item(w_out, D, 32 * nb, Wout_t + (size_t)(32 * nb) * 1024, 64 * kb, nullptr, scr, F.lane); continue; }
        r -= I_OUT;
        if (r < I_GU) { const int e = r >> 10, q = r & 1023, nb = q & 63, kb = q >> 6, np = 32 * nb, ntile = np >> 8, lc = np & 255, bj = lc >> 7, j0 = lc & 127;
            p0_transpose_item(w_gu + (size_t)e * D * 2048, 2048, bj * 1024 + 128 * ntile + j0, Wgu_t + ((size_t)e * 2048 + np) * 1024, 64 * kb, n2, scr, F.lane); continue; }
        r -= I_GU;
        { const int e = r >> 9, q = r & 511, nb = q & 31, kb = q >> 5; p0_transpose_item(w_dn + (size_t)e * FF * D, D, 32 * nb, Wdn_t + ((size_t)e * 1024 + 32 * nb) * 1024, 64 * kb, nullptr, scr, F.lane); }
    }
}

constexpr int GP = 132;
constexpr int GQ_OFF = 0, GK_OFF = 64 * GP * 4, GV_OFF = 2 * 64 * GP * 4, GW_OFF = 3 * 64 * GP * 4, GAT_OFF = 4 * 64 * GP * 4, GAT_P = 68;
constexpr int GGC_OFF = GAT_OFF + 64 * GAT_P * 4, GBETA_OFF = GGC_OFF + 256, GEND = GBETA_OFF + 256;
static_assert(GEND <= TOP_OFF, "gdn prep LDS");
__device__ __forceinline__ int permpos(int cc) { return 8 * ((cc & 15) >> 2) + (cc & 3) + 4 * (cc >> 4); }
__device__ __forceinline__ void gdn_prep_unit(Frame& F, const Args& a, int unit) {
    const bf16* zg = (const bf16*)(F.ws + WS_ZG); const float* BA = (const float*)(F.ws + WS_BA);
    const float* convw = a.in[3]; const float* a_log = a.in[4]; const float* dt_bias = a.in[5];
    const int b = unit >> 8, h = (unit >> 6) & 3, n = unit & 63; const int row0 = b * SEQ + n * CHUNK;
    unsigned char* rec = F.ws + WS_PREP + (size_t)unit * PREP_REC;
    LAS float* Qs = (LAS float*)(F.lds + GQ_OFF); LAS float* Ks = (LAS float*)(F.lds + GK_OFF); LAS float* Vs = (LAS float*)(F.lds + GV_OFF); LAS float* Ws = (LAS float*)(F.lds + GW_OFF);
    LAS float* AT = (LAS float*)(F.lds + GAT_OFF); LAS float* gcs = (LAS float*)(F.lds + GGC_OFF); LAS float* betas = (LAS float*)(F.lds + GBETA_OFF);
    const int tid = F.tid, lane = F.lane, wave = F.wave;
    for (int e = tid; e < 3 * 64 * 64; e += NTHREADS) {
        const int ten = e >> 12, t = (e >> 6) & 63, c = (e & 63) * 2; const int ch = ten * 512 + h * 128 + c;
        float a0 = 0.f, a1 = 0.f;
#pragma unroll
        for (int k = 0; k < 4; ++k) { const int tt = n * CHUNK + t - 3 + k; if (tt >= 0) { const unsigned w = *(const unsigned*)(zg + (size_t)(row0 + t - 3 + k) * 2048 + ch); const f32x2 cw = *(const f32x2*)(convw + k * 1536 + ch);
                a0 += bflo(w) * cw[0]; a1 += bfhi(w) * cw[1]; } }
        LAS float* dstp = (ten == 0 ? Qs : (ten == 1 ? Ks : Vs)) + t * GP + c; dstp[0] = silu_f(a0); dstp[1] = silu_f(a1);
    }
    if (wave == 0) {
        const float bl = BA[(size_t)(row0 + lane) * 8 + h], al = BA[(size_t)(row0 + lane) * 8 + 4 + h];
        const float xx = al + dt_bias[h]; const float sp = xx > 20.f ? xx : log1pf(__expf(xx));
        float g = -__expf(a_log[h]) * sp;
#pragma unroll
        for (int o = 1; o < 64; o <<= 1) { const float u = __shfl_up(g, o); if (lane >= o) g += u; }
        gcs[lane] = g; betas[lane] = sigmoid_f(bl);
    }
    __syncthreads();
    for (int rr = 0; rr < 8; ++rr) { const int t = wave * 8 + rr;
        f32x2 q = *(LAS f32x2*)(Qs + t * GP + 2 * lane), k = *(LAS f32x2*)(Ks + t * GP + 2 * lane);
        const float sq = wave_sum(q[0] * q[0] + q[1] * q[1]), sk = wave_sum(k[0] * k[0] + k[1] * k[1]);
        const float fq_ = rsqrtf(sq + EPS) * 0.08838834764831845f, fk_ = rsqrtf(sk + EPS);
        *(LAS f32x2*)(Qs + t * GP + 2 * lane) = q * fq_; *(LAS f32x2*)(Ks + t * GP + 2 * lane) = k * fk_; }
    __syncthreads();
    {
        const int which = wave >> 2, ti = (wave >> 1) & 1, tj = wave & 1, r32 = lane & 31, hh = lane >> 5;
        const LAS float* Xa = (which ? Qs : Ks) + (32 * ti + r32) * GP + 8 * hh; const LAS float* Xb = Ks + (32 * tj + r32) * GP + 8 * hh;
        f32x16 acc = {};
#pragma unroll
        for (int ks = 0; ks < 8; ++ks) { const bf16x8 af = pack8(*(const LAS f32x4*)(Xa + 16 * ks), *(const LAS f32x4*)(Xa + 16 * ks + 4)), bf = pack8(*(const LAS f32x4*)(Xb + 16 * ks), *(const LAS f32x4*)(Xb + 16 * ks + 4));
            acc = __builtin_amdgcn_mfma_f32_32x32x16_bf16(af, bf, acc, 0, 0, 0); }
        const int j = 32 * tj + r32; const float gj = gcs[j];
        bf16* Ap = (bf16*)(rec + PREP_AP);
#pragma unroll
        for (int q = 0; q < 4; ++q) { float vals[4];
#pragma unroll
            for (int rr = 0; rr < 4; ++rr) { const int i = 32 * ti + 8 * q + 4 * hh + rr; const float dec = __expf(fminf(gcs[i] - gj, 0.f));
                if (which == 0) vals[rr] = i > j ? betas[i] * acc[4 * q + rr] * dec : 0.f;
                else { const float v = i >= j ? acc[4 * q + rr] * dec : 0.f; Ap[i * 64 + 32 * (j >> 5) + permpos(j & 31)] = (bf16)(pk2(v, 0.f) & 0xffffu); } }
            if (which == 0) *(LAS f32x4*)(AT + j * GAT_P + 32 * ti + 8 * q + 4 * hh) = (f32x4){vals[0], vals[1], vals[2], vals[3]}; }
        for (int e = tid; e < 64 * 32; e += NTHREADS) { const int t = e >> 5, c = (e & 31) * 4; const float bt = betas[t], eg = bt * __expf(gcs[t]);
            *(LAS f32x4*)(Vs + t * GP + c) = *(LAS f32x4*)(Vs + t * GP + c) * bt; *(LAS f32x4*)(Ws + t * GP + c) = *(LAS f32x4*)(Ks + t * GP + c) * eg; }
    }
    __syncthreads();
    if (tid < 256) {
        LAS float* X = (tid < 128 ? Vs : Ws) + (tid & 127);
#pragma unroll 1
        for (int ib = 0; ib < 4; ++ib) { const int i0 = 16 * ib; float r[16];
#pragma unroll
            for (int ii = 0; ii < 16; ++ii) r[ii] = X[(i0 + ii) * GP];
#pragma unroll 1
            for (int j = 0; j < i0; ++j) { const float xj = X[j * GP]; const LAS f32x4* ap = (const LAS f32x4*)(AT + j * GAT_P + i0);
#pragma unroll
                for (int q = 0; q < 4; ++q) { const f32x4 av = ap[q]; r[4 * q] -= av[0] * xj; r[4 * q + 1] -= av[1] * xj; r[4 * q + 2] -= av[2] * xj; r[4 * q + 3] -= av[3] * xj; } }
#pragma unroll
            for (int j = 0; j < 16; ++j) { const float xj = r[j]; const LAS f32x4* ap = (const LAS f32x4*)(AT + (i0 + j) * GAT_P + i0); float av[16];
#pragma unroll
                for (int q = 0; q < 4; ++q) { const f32x4 t4 = ap[q]; av[4 * q] = t4[0]; av[4 * q + 1] = t4[1]; av[4 * q + 2] = t4[2]; av[4 * q + 3] = t4[3]; }
#pragma unroll
                for (int ii = 0; ii < 16; ++ii) if (ii > j) r[ii] -= av[ii] * xj; }
#pragma unroll
            for (int ii = 0; ii < 16; ++ii) X[(i0 + ii) * GP] = r[ii]; }
    } else {
        const int t2 = tid - 256; bf16* Qp = (bf16*)(rec + PREP_QP); bf16* Kt = (bf16*)(rec + PREP_KT); const float gl = gcs[63];
        for (int it = t2; it < 1024; it += 256) { const int c = it >> 4, ks = (it >> 2) & 3, g = it & 3; const float eg = __expf(gcs[c]);
            const f32x4 lo = *(LAS f32x4*)(Qs + c * GP + 32 * ks + 4 * g) * eg, hi = *(LAS f32x4*)(Qs + c * GP + 32 * ks + 16 + 4 * g) * eg;
            *(bf16x8*)(Qp + c * 128 + 32 * ks + 8 * g) = pack8(lo, hi); }
        for (int it = t2; it < 1024; it += 256) { const int dk = it & 127, ks2 = (it >> 7) & 1, g = it >> 8; float v[8];
#pragma unroll
            for (int j = 0; j < 8; ++j) { const int c = 32 * ks2 + (j < 4 ? 4 * g + j : 16 + 4 * g + (j - 4)); v[j] = Ks[c * GP + dk] * __expf(gl - gcs[c]); }
            *(bf16x8*)(Kt + dk * 64 + 32 * ks2 + 8 * g) = pack8((f32x4){v[0], v[1], v[2], v[3]}, (f32x4){v[4], v[5], v[6], v[7]}); }
        if (t2 == 0) *(float*)(rec + PREP_CD) = __expf(gl);
    }
    __syncthreads();
    { float* Up = (float*)(rec + PREP_UP); bf16* Wp = (bf16*)(rec + PREP_WP);
        for (int it = tid; it < 2048; it += NTHREADS) { const int dv = it & 127, g = (it >> 7) & 3, mi = it >> 9; const int c0 = 16 * mi + 4 * g;
            *(f32x4*)(Up + (size_t)it * 4) = (f32x4){Vs[c0 * GP + dv], Vs[(c0 + 1) * GP + dv], Vs[(c0 + 2) * GP + dv], Vs[(c0 + 3) * GP + dv]}; }
        for (int it = tid; it < 1024; it += NTHREADS) { const int c = it >> 4, ks = (it >> 2) & 3, g = it & 3;
            *(bf16x8*)(Wp + c * 128 + 32 * ks + 8 * g) = pack8(*(LAS f32x4*)(Ws + c * GP + 32 * ks + 4 * g), *(LAS f32x4*)(Ws + c * GP + 32 * ks + 16 + 4 * g)); }
    }
    __syncthreads();
}

__device__ __forceinline__ void gdn_scan(Frame& F, const Args& a, int bh) {
    const int lane = F.lane, w = F.wave, fr = lane & 15, g = lane >> 4; const int b = bh >> 2, h = bh & 3;
    float* og = (float*)(F.ws + WS_OG);
    f32x4 S[8];
#pragma unroll
    for (int i = 0; i < 8; ++i) S[i] = (f32x4){0.f, 0.f, 0.f, 0.f};
#pragma unroll 1
    for (int n = 0; n < NCHUNK; ++n) {
        const unsigned char* rec = F.ws + WS_PREP + (size_t)(bh * NCHUNK + n) * PREP_REC;
        const bf16* Wp = (const bf16*)(rec + PREP_WP); const bf16* Qp = (const bf16*)(rec + PREP_QP); const bf16* Ap = (const bf16*)(rec + PREP_AP); const bf16* Kt = (const bf16*)(rec + PREP_KT);
        const float* Up = (const float*)(rec + PREP_UP); const float cd = *(const float*)(rec + PREP_CD);
        bf16x8 Sb[4];
#pragma unroll
        for (int ks = 0; ks < 4; ++ks) Sb[ks] = pack8(S[2 * ks], S[2 * ks + 1]);
        f32x4 vn[4], o[4];
#pragma unroll
        for (int mi = 0; mi < 4; ++mi) { f32x4 t1 = {0.f, 0.f, 0.f, 0.f}, oo = {0.f, 0.f, 0.f, 0.f};
#pragma unroll
            for (int ks = 0; ks < 4; ++ks) { const bf16x8 wf = *(const bf16x8*)(Wp + (16 * mi + fr) * 128 + 32 * ks + 8 * g), qf = *(const bf16x8*)(Qp + (16 * mi + fr) * 128 + 32 * ks + 8 * g);
                t1 = __builtin_amdgcn_mfma_f32_16x16x32_bf16(wf, Sb[ks], t1, 0, 0, 0); oo = __builtin_amdgcn_mfma_f32_16x16x32_bf16(qf, Sb[ks], oo, 0, 0, 0); }
            const f32x4 u = *(const f32x4*)(Up + (size_t)((mi * 4 + g) * 128 + 16 * w + fr) * 4);
            vn[mi] = u - t1; o[mi] = oo; }
        bf16x8 Vb[2];
#pragma unroll
        for (int ks = 0; ks < 2; ++ks) Vb[ks] = pack8(vn[2 * ks], vn[2 * ks + 1]);
#pragma unroll
        for (int mi = 0; mi < 4; ++mi) {
#pragma unroll
            for (int ks = 0; ks < 2; ++ks) { const bf16x8 af = *(const bf16x8*)(Ap + (16 * mi + fr) * 64 + 32 * ks + 8 * g); o[mi] = __builtin_amdgcn_mfma_f32_16x16x32_bf16(af, Vb[ks], o[mi], 0, 0, 0); }
            float* op = og + (size_t)(b * SEQ + n * CHUNK + 16 * mi + 4 * g) * 512 + h * 128 + 16 * w + fr;
            op[0] = o[mi][0]; op[512] = o[mi][1]; op[1024] = o[mi][2]; op[1536] = o[mi][3]; }
#pragma unroll
        for (int ti = 0; ti < 8; ++ti) { f32x4 s = S[ti] * cd;
#pragma unroll
            for (int ks = 0; ks < 2; ++ks) { const bf16x8 kf = *(const bf16x8*)(Kt + (16 * ti + fr) * 64 + 32 * ks + 8 * g); s = __builtin_amdgcn_mfma_f32_16x16x32_bf16(kf, Vb[ks], s, 0, 0, 0); }
            S[ti] = s; }
    }
    VM_WAIT(); __syncthreads();
    const float* gnw = a.in[6]; const bf16* zg = (const bf16*)(F.ws + WS_ZG); bf16* mix = (bf16*)(F.ws + WS_MIX);
    const f32x2 gw2 = *(const f32x2*)(gnw + 2 * lane);
    for (int t = w; t < SEQ; t += NWAVES) { const size_t row = (size_t)b * SEQ + t;
        const f32x2 v = *(const f32x2*)(og + row * 512 + h * 128 + 2 * lane); const unsigned gz = *(const unsigned*)(zg + row * 2048 + 1536 + h * 128 + 2 * lane);
        const float sc = rsqrtf(wave_sum(v[0] * v[0] + v[1] * v[1]) * (1.f / 128.f) + EPS);
        *(unsigned*)(mix + row * 1024 + h * 128 + 2 * lane) = pk2(v[0] * sc * gw2[0] * silu_f(bflo(gz)), v[1] * sc * gw2[1] * silu_f(bfhi(gz))); }
}

constexpr int AT_OACC = 0, AT_LACC = 65536, AT_BIAS = 66560, AT_VST = 68608, AT_END = AT_VST + 8 * 4096;
__device__ __forceinline__ void attn_unit(Frame& F, const Args& a, int unit) {
    const int b = unit >> 7, h = (unit >> 4) & 7, i0 = (unit & 15) * 256; const size_t brow = (size_t)b * SEQ;
    const bf16* qb = (const bf16*)(F.ws + WS_QB); const bf16* kb = (const bf16*)(F.ws + WS_KB); const bf16* vb = (const bf16*)(F.ws + WS_VB); bf16* mix = (bf16*)(F.ws + WS_MIX);
    const float* relb = a.in[9];
    LAS float* Oacc = (LAS float*)(F.lds + AT_OACC); LAS float* lacc = (LAS float*)(F.lds + AT_LACC); LAS float* biasL = (LAS float*)(F.lds + AT_BIAS);
    LAS unsigned char* vst = F.lds + AT_VST + F.wave * 4096;
    const int tid = F.tid, lane = F.lane, c = lane & 31, hh = lane >> 5;
    for (int i = tid; i < 256 * 64 / 4; i += NTHREADS) ((LAS f32x4*)Oacc)[i] = (f32x4){0.f, 0.f, 0.f, 0.f};
    if (tid < 256) lacc[tid] = 0.f;
    if (tid < 3 * 132) { const int br = tid / 132, s = tid % 132; biasL[tid] = relb[(int)T5B[br][s] * AH + h] * LOG2E; }
    __syncthreads();
    for (int job = F.wave; job < ATT_JOBS; job += NWAVES) {
        int d, dsh, br, r, ii_base, nq;
        if (job < 8) { d = 1; dsh = 0; br = 0; r = 0; ii_base = i0 + 32 * job; nq = 32; }
        else if (job < 16) { const int jj = job - 8; d = 4; dsh = 2; br = 1; r = jj >> 1; ii_base = (i0 >> 2) + 32 * (jj & 1); nq = 32; }
        else { d = 16; dsh = 4; br = 2; r = job - 16; ii_base = i0 >> 4; nq = 16; }
        const int qi = ii_base + (c < nq ? c : nq - 1);
        const bf16* qp = qb + (brow + (size_t)(qi << dsh) + r) * 512 + h * 64 + 8 * hh;
        bf16x8 Qf[4];
#pragma unroll
        for (int ks = 0; ks < 4; ++ks) Qf[ks] = *(const bf16x8*)(qp + 16 * ks);
        f32x16 O0 = {}, O1 = {}; float lsum = 0.f;
        const LAS float* bl = biasL + br * 132;
#pragma unroll 1
        for (int kt = 0; kt < 5; ++kt) {
            const int jj_base = ii_base - 128 + 32 * kt;
            if (jj_base + 31 < 0) continue;
            const int lmax = (SEQ >> dsh) - 1; const int jk = jj_base + c, jkc = jk < 0 ? 0 : (jk > lmax ? lmax : jk);
            const bf16* kp = kb + (brow + (size_t)(jkc << dsh) + r) * 512 + h * 64 + 8 * hh;
            u32x4 vreg[4];
#pragma unroll
            for (int i = 0; i < 4; ++i) { const int vr = (lane >> 3) + 8 * i; int jv = jj_base + vr; jv = jv < 0 ? 0 : (jv > lmax ? lmax : jv);
                vreg[i] = *(const u32x4*)(vb + (brow + (size_t)(jv << dsh) + r) * 512 + h * 64 + 8 * (lane & 7)); }
            f32x16 sT = {};
#pragma unroll
            for (int ks = 0; ks < 4; ++ks) { const bf16x8 kf = *(const bf16x8*)(kp + 16 * ks); sT = __builtin_amdgcn_mfma_f32_32x32x16_bf16(kf, Qf[ks], sT, 0, 0, 0); }
#pragma unroll
            for (int i = 0; i < 4; ++i) *(LAS u32x4*)(vst + ((lane >> 3) + 8 * i) * 128 + 16 * (lane & 7)) = vreg[i];
            float p[16];
#pragma unroll
            for (int reg = 0; reg < 16; ++reg) { const int kr = (reg & 3) + 8 * (reg >> 2) + 4 * hh; const int jr = jj_base + kr; const int s = (ii_base + c) - jr;
                const bool ok = (s >= 0) && (s <= 128) && (jr >= 0) && (c < nq); const int sc_ = s < 0 ? 0 : (s > 128 ? 128 : s);
                const float e = __builtin_amdgcn_exp2f(sT[reg] + bl[sc_]); p[reg] = ok ? e : 0.f; lsum += p[reg]; }
            bf16x8 Pf[2];
#pragma unroll
            for (int s2 = 0; s2 < 2; ++s2) { u32x4 wv; wv.x = pk2(p[8 * s2], p[8 * s2 + 1]); wv.y = pk2(p[8 * s2 + 2], p[8 * s2 + 3]); wv.z = pk2(p[8 * s2 + 4], p[8 * s2 + 5]); wv.w = pk2(p[8 * s2 + 6], p[8 * s2 + 7]); Pf[s2] = __builtin_bit_cast(bf16x8, wv); }
            const int li = lane & 15, gq = lane >> 4;
#pragma unroll
            for (int s2 = 0; s2 < 2; ++s2)
#pragma unroll
                for (int ntl = 0; ntl < 2; ++ntl) {
                    const LAS unsigned char* p0 = vst + (16 * s2 + 4 * hh + (li >> 2)) * 128 + (32 * ntl + 16 * (gq & 1) + 4 * (li & 3)) * 2;
                    const s16x4 lo = __builtin_bit_cast(s16x4, __builtin_amdgcn_ds_read_tr16_b64_v4i16((LAS s16x4*)p0));
                    const s16x4 hi = __builtin_bit_cast(s16x4, __builtin_amdgcn_ds_read_tr16_b64_v4i16((LAS s16x4*)(p0 + 8 * 128)));
                    const bf16x8 vf = (bf16x8){lo[0], lo[1], lo[2], lo[3], hi[0], hi[1], hi[2], hi[3]};
                    if (ntl == 0) O0 = __builtin_amdgcn_mfma_f32_32x32x16_bf16(Pf[s2], vf, O0, 0, 0, 0); else O1 = __builtin_amdgcn_mfma_f32_32x32x16_bf16(Pf[s2], vf, O1, 0, 0, 0);
                }
        }
#pragma unroll
        for (int reg = 0; reg < 16; ++reg) { const int qrow = (reg & 3) + 8 * (reg >> 2) + 4 * hh;
            if (qrow < nq) { const int tl = (((ii_base + qrow) << dsh) + r) - i0; atomicAdd((float*)(Oacc + tl * 64 + c), O0[reg]); atomicAdd((float*)(Oacc + tl * 64 + 32 + c), O1[reg]); } }
        lsum += __shfl_xor(lsum, 32);
        if (hh == 0 && c < nq) { const int tl = (((ii_base + c) << dsh) + r) - i0; atomicAdd((float*)(lacc + tl), lsum); }
    }
    __syncthreads();
    { const int tl = tid >> 1, half = tid & 1; const float inv = ATT_JOBS ? 1.f / lacc[tl] : 1.f; const LAS f32x4* op = (const LAS f32x4*)(Oacc + tl * 64 + 32 * half);
        bf16* dst = mix + (brow + i0 + tl) * 1024 + 512 + h * 64 + 32 * half;
#pragma unroll
        for (int q = 0; q < 4; ++q) { const f32x4 x0 = op[2 * q] * inv, x1 = op[2 * q + 1] * inv; *(bf16x8*)(dst + 8 * q) = pack8(x0, x1); } }
    __syncthreads();
}

constexpr int RT_LCNT = 0, RT_BASE = 256, RT_RANK = 512;
__device__ __forceinline__ void route_phase(Frame& F, const Args& a) {
    const float* hsrc = a.out; const float* wrT = (const float*)(F.ws + WS_WRT); const float* b_r = a.in[13];
    int* te = (int*)(F.ws + WS_TE); int* tslot = (int*)(F.ws + WS_TSLOT); float* tg = (float*)(F.ws + WS_TG); int* list = (int*)(F.ws + WS_LIST); float* lrs = (float*)(F.ws + WS_LRS);
    LAS int* lcnt = (LAS int*)(F.lds + RT_LCNT); LAS int* lbase = (LAS int*)(F.lds + RT_BASE); LAS int* lrank = (LAS int*)(F.lds + RT_RANK);
    const int lane = F.lane, c = lane & 31, hh = lane >> 5;
    for (int blk = F.vcu; blk < T / 128; blk += F.G) {
        if (F.tid < 32) lcnt[F.tid] = 0;
        __syncthreads();
        int e4[4] = {0, 0, 0, 0}, rk[4] = {0, 0, 0, 0}; float g4[4] = {0.f, 0.f, 0.f, 0.f}; float rs = 0.f; const int tok = blk * 128 + (F.wave & 3) * 32 + c;
        if (F.wave < 4) {
            f32x16 acc = {}; float ss = 0.f; const float* hp = hsrc + (size_t)tok * D + 4 * hh; const float* wp = wrT + (size_t)c * D + 4 * hh;
#pragma unroll 4
            for (int q = 0; q < 128; ++q) { const f32x4 hv = *(const f32x4*)(hp + 8 * q), wv = *(const f32x4*)(wp + 8 * q);
                ss += (hv[0] * hv[0] + hv[1] * hv[1]) + (hv[2] * hv[2] + hv[3] * hv[3]);
#pragma unroll
                for (int i = 0; i < 4; ++i) acc = __builtin_amdgcn_mfma_f32_32x32x2f32(wv[i], hv[i], acc, 0, 0, 0); }
            ss += __shfl_xor(ss, 32); rs = rsqrtf(ss * (1.f / D) + EPS);
            float tv[4] = {-3.0e38f, -3.0e38f, -3.0e38f, -3.0e38f}; int tix[4] = {0, 1, 2, 3};
#pragma unroll
            for (int reg = 0; reg < 16; ++reg) { const int e = (reg & 3) + 8 * (reg >> 2) + 4 * hh; float v = acc[reg] * rs + b_r[e]; int ix = e;
#pragma unroll
                for (int s = 0; s < 4; ++s) { const bool gt = (v > tv[s]) || (v == tv[s] && ix < tix[s]); const float ov = tv[s]; const int oi = tix[s]; tv[s] = gt ? v : ov; tix[s] = gt ? ix : oi; v = gt ? ov : v; ix = gt ? oi : ix; } }
            float pv[4]; int pi[4];
#pragma unroll
            for (int s = 0; s < 4; ++s) { pv[s] = __shfl_xor(tv[s], 32); pi[s] = __shfl_xor(tix[s], 32); }
#pragma unroll
            for (int t2 = 0; t2 < 4; ++t2) { float v = pv[t2]; int ix = pi[t2];
#pragma unroll
                for (int s = 0; s < 4; ++s) { const bool gt = (v > tv[s]) || (v == tv[s] && ix < tix[s]); const float ov = tv[s]; const int oi = tix[s]; tv[s] = gt ? v : ov; tix[s] = gt ? ix : oi; v = gt ? ov : v; ix = gt ? oi : ix; } }
            const float e0 = 1.f, e1 = __expf(tv[1] - tv[0]), e2 = __expf(tv[2] - tv[0]), e3 = __expf(tv[3] - tv[0]); const float inv = 1.f / (e0 + e1 + e2 + e3);
            g4[0] = e0 * inv; g4[1] = e1 * inv; g4[2] = e2 * inv; g4[3] = e3 * inv;
#pragma unroll
            for (int s = 0; s < 4; ++s) e4[s] = tix[s];
            if (hh == 0) {
#pragma unroll
                for (int s = 0; s < 4; ++s) rk[s] = atomicAdd((int*)(lcnt + e4[s]), 1);
            }
        }
        __syncthreads();
        if (F.tid < 32) lbase[F.tid] = (int)__hip_atomic_fetch_add(F.ctl + CW_GCNT + 64 * F.tid, (unsigned)lcnt[F.tid], RLX_AGENT);
        __syncthreads();
        if (F.wave < 4 && hh == 0) {
#pragma unroll
            for (int s = 0; s < 4; ++s) { const int slot = lbase[e4[s]] + rk[s]; te[tok * 4 + s] = e4[s]; tslot[tok * 4 + s] = slot; tg[tok * 4 + s] = g4[s];
                list[(size_t)e4[s] * LCAP + slot] = tok; lrs[(size_t)e4[s] * LCAP + slot] = rs; }
        }
        __syncthreads();
    }
}
__device__ __forceinline__ int moe_tables(Frame& F) {
    LAS int* tstart = (LAS int*)(F.lds + MOE_TSTART); LAS int* lcnt = (LAS int*)(F.lds + MOE_LCNT); LAS int* texp = (LAS int*)(F.lds + MOE_TEXP);
    if (F.tid == 0) { int acc = 0; for (int e = 0; e < NE; ++e) { const int cnt = (int)__hip_atomic_load(F.ctl + CW_GCNT + 64 * e, RLX_AGENT); lcnt[e] = cnt; tstart[e] = acc; const int nt = (cnt + 255) >> 8; for (int i = 0; i < nt; ++i) texp[acc + i] = e; acc += nt; } tstart[NE] = acc; }
    __syncthreads();
    return tstart[NE];
}
__device__ __forceinline__ void combine_phase(Frame& F, const Args& a) {
    LAS int* tstart = (LAS int*)(F.lds + MOE_TSTART);
    const int* te = (const int*)(F.ws + WS_TE); const int* tslot = (const int*)(F.ws + WS_TSLOT); const float* tg = (const float*)(F.ws + WS_TG); const bf16* Y = (const bf16*)(F.ws + WS_Y);
    float* out = a.out; const int gw = F.vcu * NWAVES + F.wave, NGW = F.G * NWAVES, lane = F.lane;
    for (int t = gw; t < T; t += NGW) {
        float* op = out + (size_t)t * D + 8 * lane;
        f32x4 o[2][2];
#pragma unroll
        for (int j = 0; j < 2; ++j) { o[j][0] = *(const f32x4*)(op + 512 * j); o[j][1] = *(const f32x4*)(op + 512 * j + 4); }
#pragma unroll
        for (int s = 0; s < 4; ++s) { const int e = te[t * 4 + s]; const size_t pos = (size_t)tstart[e] * 256 + tslot[t * 4 + s]; const float gt = tg[t * 4 + s]; const bf16* yp = Y + pos * D + 8 * lane;
#pragma unroll
            for (int j = 0; j < 2; ++j) { const u32x4 w = *(const u32x4*)(yp + 512 * j);
                o[j][0] += (f32x4){bflo(w.x), bfhi(w.x), bflo(w.y), bfhi(w.y)} * gt; o[j][1] += (f32x4){bflo(w.z), bfhi(w.z), bflo(w.w), bfhi(w.w)} * gt; } }
#pragma unroll
        for (int j = 0; j < 2; ++j) { *(f32x4*)(op + 512 * j) = o[j][0]; *(f32x4*)(op + 512 * j + 4) = o[j][1]; }
    }
}

constexpr int NPHASE = 9;
__global__ void __launch_bounds__(NTHREADS, 2) hymba_fwd(Args args) {
    extern __shared__ __attribute__((aligned(16))) unsigned char lds_raw[];
    Frame F; F.lds = (LAS unsigned char*)lds_raw; F.ws = args.ws; F.ctl = (unsigned*)(args.ws + WS_CTL);
    F.tid = threadIdx.x; F.lane = F.tid & 63; F.wave = __builtin_amdgcn_readfirstlane(F.tid >> 6);
    F.G = gridDim.x; { const int bx = blockIdx.x; F.vcu = (F.G % 8 == 0) ? (bx % 8) * (F.G / 8) + bx / 8 : bx; }
    volatile LAS unsigned* MISC = (volatile LAS unsigned*)(F.lds + MISC_OFF);
    if (F.tid < 32) MISC[F.tid] = 0u;
    __syncthreads();
    XcdBarrier bar; bar.bar = F.ctl + CW_BAR; bar.x = 0; bar.st = nullptr;
    if (MK_N_LAUNCHES == 1) bar = xcd_barrier_post(F.ctl + CW_BAR, MISC + 8);
    const int lo = args.ph_lo, hi = args.ph_hi;
#define IN(k) (lo <= (k) && (k) < hi)
#define SEAM(k) do { if (IN(k) && IN((k) + 1)) xcd_barrier(bar); } while (0)

    if (IN(0)) { phase0(F, args); SEAM(0); }
    if (IN(1)) {
        pg8::Gemm g{(const bf16*)(F.ws + WS_XN), (const bf16*)(F.ws + WS_WIN), D}; pg8::StaticOrder S{T / 256, NIN / 256, F.G, (int)blockIdx.x};
        pg8::EpiInProj E{(bf16*)(F.ws + WS_ZG), (bf16*)(F.ws + WS_QB), (bf16*)(F.ws + WS_KB), (bf16*)(F.ws + WS_VB), args.in[7], args.in[8]};
        pg8::gemm_phase<pg8::EpiInProj, pg8::StaticOrder, false, true>(F.lds, g, S, E);
        SEAM(1);
    }
    if (IN(2)) {
        for (int u = F.vcu; u < NBATCH * GH * NCHUNK; u += F.G) gdn_prep_unit(F, args, u);
#if !SKIP_ATTN
        for (int u = F.vcu; u < NBATCH * AH * 16; u += F.G) attn_unit(F, args, u);
#else
        { bf16* mix = (bf16*)(F.ws + WS_MIX); for (size_t i = (size_t)F.vcu * NTHREADS + F.tid; i < (size_t)T * 64; i += (size_t)F.G * NTHREADS) { const size_t row = i >> 6, cc = i & 63; *(u32x4*)(mix + row * 1024 + 512 + cc * 8) = (u32x4){0u, 0u, 0u, 0u}; } }
#endif
        SEAM(2);
    }
    if (IN(3)) {
        for (int bh = blockIdx.x; bh < NBATCH * GH; bh += F.G) gdn_scan(F, args, bh);
        SEAM(3);
    }
    if (IN(4)) {
        pg8::Gemm g{(const bf16*)(F.ws + WS_MIX), (const bf16*)(F.ws + WS_WOUT), D}; pg8::StaticOrder S{T / 256, D / 256, F.G, (int)blockIdx.x};
        pg8::EpiOutProj E{args.in[0], args.out, (bf16*)(F.ws + WS_HB)};
        pg8::gemm_phase<pg8::EpiOutProj, pg8::StaticOrder, false, true>(F.lds, g, S, E);
        SEAM(4);
    }
#if !SKIP_MOE
    if (IN(5)) { route_phase(F, args); SEAM(5); }
    if (IN(6)) {
        const int nM = moe_tables(F);
        pg8::Gemm g{(const bf16*)(F.ws + WS_HB), (const bf16*)(F.ws + WS_WGU), D};
        pg8::MoeOrder S{nM, 8, F.G, (int)blockIdx.x, (const LAS int*)(F.lds + MOE_TSTART), (const LAS int*)(F.lds + MOE_LCNT), (const LAS int*)(F.lds + MOE_TEXP), (const int*)(F.ws + WS_LIST)};
        pg8::EpiGateUp E{(bf16*)(F.ws + WS_ACT), args.in[15], (const float*)(F.ws + WS_LRS), (const LAS int*)(F.lds + MOE_LCNT)};
        pg8::gemm_phase<pg8::EpiGateUp, pg8::MoeOrder, true, true>(F.lds, g, S, E);
        SEAM(6);
    }
    if (IN(7)) {
        const int nM = moe_tables(F);
        pg8::Gemm g{(const bf16*)(F.ws + WS_ACT), (const bf16*)(F.ws + WS_WDN), FF};
        pg8::MoeOrder S{nM, 4, F.G, (int)blockIdx.x, (const LAS int*)(F.lds + MOE_TSTART), (const LAS int*)(F.lds + MOE_LCNT), (const LAS int*)(F.lds + MOE_TEXP), (const int*)(F.ws + WS_LIST)};
        pg8::EpiDown E{(bf16*)(F.ws + WS_Y), args.in[17]};
        pg8::gemm_phase<pg8::EpiDown, pg8::MoeOrder, false, true>(F.lds, g, S, E);
        SEAM(7);
    }
    if (IN(8)) { (void)moe_tables(F); combine_phase(F, args); }
#endif
#undef IN
#undef SEAM
}

extern "C" void kernel_launch(void* const* d_in, const int* in_sizes, int n_in, void* d_out, int out_size, void* d_ws, size_t ws_size, hipStream_t stream) {
    static int grid = 0;
    if (grid == 0) {
        if (n_in != 18 || in_sizes[0] != T * D || out_size != T * D || ws_size < WS_END) { fprintf(stderr, "kernel_launch: unexpected shapes (n_in %d, in0 %d, out %d, ws %zu)\n", n_in, n_in > 0 ? in_sizes[0] : -1, out_size, ws_size); grid = -1; return; }
        int dev = 0, cus = 0, per_cu = 0;
        if (hipGetDevice(&dev) != hipSuccess || hipDeviceGetAttribute(&cus, hipDeviceAttributeMultiprocessorCount, dev) != hipSuccess) { grid = -1; return; }
        if (hipFuncSetAttribute((const void*)hymba_fwd, hipFuncAttributeMaxDynamicSharedMemorySize, LDS_BYTES) != hipSuccess) { fprintf(stderr, "kernel_launch: hipFuncSetAttribute failed\n"); grid = -1; return; }
        if (hipOccupancyMaxActiveBlocksPerMultiprocessor(&per_cu, (const void*)hymba_fwd, NTHREADS, LDS_BYTES) != hipSuccess || per_cu < 1) { fprintf(stderr, "kernel_launch: occupancy query says %d\n", per_cu); per_cu = 1; }
        (void)hipGetLastError();
        grid = cus;
    }
    if (grid < 0) return;
    (void)hipMemsetAsync((char*)d_ws + WS_CTL, 0, CTL_ZERO_BYTES, stream);
    Args a{};
    for (int i = 0; i < 18; ++i) a.in[i] = (const float*)d_in[i];
    a.out = (float*)d_out; a.ws = (unsigned char*)d_ws;
    if (MK_N_LAUNCHES == 1) {
        a.ph_lo = 0; a.ph_hi = NPHASE; a.li = 0;
        void* kargs[] = {&a};
        hipError_t e = hipLaunchCooperativeKernel((const void*)hymba_fwd, dim3(grid), dim3(NTHREADS), kargs, LDS_BYTES, stream);
        if (e != hipSuccess) fprintf(stderr, "kernel_launch: cooperative launch failed: %s (grid %d)\n", hipGetErrorString(e), grid);
    } else {
        for (int p = 0; p < NPHASE; ++p) { a.ph_lo = p; a.ph_hi = p + 1; a.li = p; hipLaunchKernelGGL(hymba_fwd, dim3(grid), dim3(NTHREADS), LDS_BYTES, stream, a); }
    }
}
```

```cpp
#include <hip/hip_runtime.h>
#include <cstdio>
#include <cstdint>

#ifndef MK_N_LAUNCHES
#define MK_N_LAUNCHES 1
#endif
#ifndef SKIP_ATTN
#define SKIP_ATTN 0
#endif
#ifndef DUP
#define DUP 0
#endif
#ifndef ATT_JOBS
#define ATT_JOBS 32
#endif
#ifndef SKIP_MOE
#define SKIP_MOE 0
#endif

#define LAS __attribute__((address_space(3)))
#define GAS __attribute__((address_space(1)))
typedef unsigned short bf16;
typedef short bf16x8 __attribute__((ext_vector_type(8)));
typedef short s16x4 __attribute__((ext_vector_type(4)));
typedef float f32x2 __attribute__((ext_vector_type(2)));
typedef float f32x4 __attribute__((ext_vector_type(4)));
typedef float f32x16 __attribute__((ext_vector_type(16)));
typedef unsigned u32x2 __attribute__((ext_vector_type(2)));
typedef unsigned u32x4 __attribute__((ext_vector_type(4)));
typedef __bf16 bf16x2_t __attribute__((ext_vector_type(2)));

constexpr int NBATCH = 8, SEQ = 4096, D = 1024, T = NBATCH * SEQ;
constexpr int IN_DIM = 3592, NIN = 3584;
constexpr int GH = 4, DK = 128, CHUNK = 64, NCHUNK = SEQ / CHUNK;
constexpr int AH = 8, DH = 64;
constexpr int NE = 32, FF = 1024, LCAP = 32768;
constexpr float EPS = 1e-6f, LOG2E = 1.4426950408889634f;
constexpr int NWAVES = 8, NTHREADS = 512;

constexpr size_t MiB = 1u << 20;
constexpr size_t WS_CTL = 0, CTL_ZERO_BYTES = 1 * MiB;
constexpr size_t WS_WIN = 1 * MiB, WS_WOUT = 8 * MiB, WS_WGU = 10 * MiB, WS_WDN = 138 * MiB;
constexpr size_t WS_TE = 202 * MiB, WS_TSLOT = WS_TE + 512 * 1024, WS_TG = WS_TSLOT + 512 * 1024;
constexpr size_t WS_LIST = 204 * MiB, WS_LRS = 208 * MiB;
constexpr size_t WS_BA = 212 * MiB, WS_WRT = 213 * MiB;
constexpr size_t WS_ZG = 214 * MiB, WS_QB = 342 * MiB, WS_KB = 374 * MiB, WS_VB = 406 * MiB;
constexpr size_t WS_PREP = 438 * MiB;
constexpr int PREP_WP = 0, PREP_QP = 16384, PREP_AP = 32768, PREP_KT = 40960, PREP_UP = 57344, PREP_CD = 90112, PREP_REC = 90368;
constexpr size_t WS_OG = 616 * MiB, WS_MIX = 680 * MiB;
constexpr size_t WS_XN = 760 * MiB, WS_HB = 760 * MiB;
constexpr size_t WS_ACT = 214 * MiB, WS_Y = 486 * MiB, WS_END = 824 * MiB;
static_assert(WS_VB - WS_KB == WS_KB - WS_QB, "q/k/v stride");
static_assert(WS_PREP + (size_t)NBATCH * GH * NCHUNK * PREP_REC <= WS_OG, "prep region");
static_assert(WS_ACT + (size_t)(T * 4 + NE * 256) * FF * 2 <= WS_Y && WS_Y + (size_t)(T * 4 + NE * 256) * D * 2 <= WS_HB, "act/y regions");
constexpr int CW_TMO = 0, CW_CODE = 1, CW_GCNT = 1024  , CW_BAR = 8192;

constexpr int LDS_BYTES = 160 * 1024;
constexpr int RING_BYTES = 131072;
constexpr int TOP_OFF = LDS_BYTES - 4096;
constexpr int MISC_OFF = TOP_OFF;
constexpr int MOE_TAB_OFF = TOP_OFF + 256;
constexpr int MOE_TSTART = MOE_TAB_OFF, MOE_LCNT = MOE_TAB_OFF + 256, MOE_TEXP = MOE_TAB_OFF + 512;

#define RLX_AGENT __ATOMIC_RELAXED, __HIP_MEMORY_SCOPE_AGENT
#define LDS_WAIT() asm volatile("s_waitcnt lgkmcnt(0)" ::: "memory")
#define VM_WAIT() asm volatile("s_waitcnt vmcnt(0)" ::: "memory")
__device__ __forceinline__ unsigned pk2(float lo, float hi) { f32x2 v = {lo, hi}; bf16x2_t b = __builtin_convertvector(v, bf16x2_t); return __builtin_bit_cast(unsigned, b); }
__device__ __forceinline__ float bf2f(unsigned short b) { return __uint_as_float((unsigned)b << 16); }
__device__ __forceinline__ float bflo(unsigned w) { return __uint_as_float(w << 16); }
__device__ __forceinline__ float bfhi(unsigned w) { return __uint_as_float(w & 0xffff0000u); }
__device__ __forceinline__ float wave_sum(float v) {
#pragma unroll
    for (int o = 1; o < 64; o <<= 1) v += __shfl_xor(v, o);
    return v;
}
__device__ __forceinline__ float silu_f(float x) { return x / (1.f + __expf(-x)); }
__device__ __forceinline__ float sigmoid_f(float x) { return 1.f / (1.f + __expf(-x)); }
__device__ __forceinline__ bf16x8 pack8(f32x4 a, f32x4 b) {
    u32x4 w; w.x = pk2(a[0], a[1]); w.y = pk2(a[2], a[3]); w.z = pk2(b[0], b[1]); w.w = pk2(b[2], b[3]); return __builtin_bit_cast(bf16x8, w);
}

namespace pg8 {
constexpr int BM = 256, BK = 64, HALF = 128, HTB = HALF * BK * 2, STAGE_BYTES = 8 * HTB, NXCD = 8, WGM = 8;
__host__ __device__ __forceinline__ int lds_byte(int r, int c) { const int st = (r >> 4) * 2 + (c >> 5), rr = r & 15, cc = c & 31, ob = rr * 64 + cc * 2; return st * 1024 + (ob ^ (((ob >> 9) & 1) << 5)); }
__host__ __device__ __forceinline__ void stage_rc(int b, int& R, int& C) { const int st = b / 1024, sb = b % 1024, swz = sb ^ (((sb >> 9) & 1) << 5); R = (st >> 1) * 16 + swz / 64; C = (st & 1) * 32 + (swz % 64) / 2; }
__host__ __device__ __forceinline__ int perm32(int rho) { const int n = rho >> 4, i = rho & 15; return 8 * (i >> 2) + 4 * n + (i & 3); }

struct Unit { int pm, pn, pb, e, mt; };
struct Gemm { const bf16* A; const bf16* Bt; int K; };

__device__ __forceinline__ bool static_tile(int i, int G, int c, int nM, int nN, int& pm, int& pn) {
    const int nwg = nM * nN; const long L = (long)i * G + c; if (L >= nwg) return false;
    int wgid = (int)L; { const int q = nwg / NXCD, r = nwg % NXCD, xcd = wgid % NXCD, off = wgid / NXCD; wgid = (xcd < r ? xcd * (q + 1) : r * (q + 1) + (xcd - r) * q) + off; }
    const int nig = WGM * nN, gid = wgid / nig, fm = gid * WGM, gsz = (nM - fm) < WGM ? (nM - fm) : WGM;
    pm = fm + ((wgid % nig) % gsz); pn = (wgid % nig) / gsz; return true;
}
struct StaticOrder {
    int nM, nN, G, c;
    __device__ __forceinline__ bool next(int i, Unit& u) const { int pm, pn; if (!static_tile(i, G, c, nM, nN, pm, pn)) return false; u.pm = pm; u.pn = pn; u.pb = pn; u.e = 0; u.mt = 0; return true; }
    __device__ __forceinline__ int row_index(const Unit&, int) const { return 0; }
};
struct MoeOrder {
    int nM, nN, G, c; const LAS int* tstart; const LAS int* lcnt; const LAS int* texp; const int* list;
    __device__ __forceinline__ bool next(int i, Unit& u) const {
        int pm, pn; if (!static_tile(i, G, c, nM, nN, pm, pn)) return false;
        const int e = texp[pm]; u.pm = pm; u.pn = pn; u.e = e; u.pb = e * nN + pn; u.mt = pm - tstart[e]; return true;
    }
    __device__ __forceinline__ int row_index(const Unit& u, int r) const { const int rr = u.mt * 256 + r; return rr < lcnt[u.e] ? list[u.e * LCAP + rr] : 0; }
};

#define PG8_SA(b, h) (((b) * 2 + (h)) * HTB)
#define PG8_SB(b, h) ((4 + (b) * 2 + (h)) * HTB)
#define PG8_GLDS(src, dstoff) __builtin_amdgcn_global_load_lds((const unsigned*)(src), (LAS unsigned*)(lds + (dstoff)), 16, 0, 0)
#define PG8_STAGE_B(bufoff, nx, kb, h) do { _Pragma("unroll") for (int _i = 0; _i < 2; ++_i) \
        PG8_GLDS(((nx) ? nB : cB) + (kb) + (size_t)(h) * hstep + voffB[_i], (bufoff) + ldsw + _i * 8192); } while (0)
#define PG8_STAGE_A(bufoff, nx, kb, h) do { _Pragma("unroll") for (int _i = 0; _i < 2; ++_i) \
        PG8_GLDS(GATHER ? (const char*)g.A + (kb) + ((nx) ? voffN[h][_i] : voffC[h][_i]) : ((nx) ? nA : cA) + (kb) + (size_t)(h) * hstep + voffA[_i], (bufoff) + ldsw + _i * 8192); } while (0)
#define PG8_LDA(dst, b, h) do { _Pragma("unroll") for (int m = 0; m < 4; ++m) _Pragma("unroll") for (int k = 0; k < 2; ++k) dst[m][k] = *(const LAS bf16x8*)(lds + PG8_SA(b, h) + aoff + m * 2048 + k * 1024); } while (0)
#define PG8_LDB(dst, b, h) do { _Pragma("unroll") for (int n = 0; n < 2; ++n) _Pragma("unroll") for (int k = 0; k < 2; ++k) dst[n][k] = *(const LAS bf16x8*)(lds + PG8_SB(b, h) + boff + n * 2048 + k * 1024); } while (0)
#define PG8_MMA(ai, bj, At, Bt) do { __builtin_amdgcn_s_setprio(1); _Pragma("unroll") for (int m = 0; m < 4; ++m) _Pragma("unroll") for (int n = 0; n < 2; ++n) _Pragma("unroll") for (int k = 0; k < 2; ++k) \
        acc[ai][bj][m][n] = __builtin_amdgcn_mfma_f32_16x16x32_bf16(Bt[n][k], At[m][k], acc[ai][bj][m][n], 0, 0, 0); __builtin_amdgcn_s_setprio(0); } while (0)
#define PG8_WAIT_V(n) asm volatile("s_waitcnt vmcnt(" #n ")" ::: "memory")
#define PG8_WAIT_L(n) asm volatile("s_waitcnt lgkmcnt(" #n ")" ::: "memory")
#define PG8_BAR __builtin_amdgcn_s_barrier()
#define PG8_SCHED __builtin_amdgcn_sched_barrier(0)

template <class Epi, class Sched, bool GATHER, bool ALIGN_EPI>
__device__ __forceinline__ void gemm_phase(LAS unsigned char* lds, const Gemm g, const Sched& S, const Epi& E) {
    const int tid = threadIdx.x, wid = __builtin_amdgcn_readfirstlane(tid >> 6), lane = tid & 63, wr = wid >> 2, wc = wid & 3, fr = lane & 15, fq = lane >> 4;
    const int K = g.K, nt = K / BK;
    unsigned voffA[2], voffB[2], voffC[2][2], voffN[2][2]; int RA[2], CA[2];
#pragma unroll
    for (int i = 0; i < 2; ++i) { int R, C; stage_rc(tid * 16 + i * 8192, R, C); const int Rb = Epi::PERM ? ((R & ~31) + perm32(R & 31)) : R;
        RA[i] = R; CA[i] = C; voffA[i] = (unsigned)(R * K + C) * 2u; voffB[i] = (unsigned)(Rb * K + C) * 2u; }
    const size_t kstep = (size_t)(BK * 2), hstep = (size_t)HALF * K * 2, tstep = 2 * hstep;
    const unsigned ldsw = (unsigned)wid * 1024u;
    const int aoff = lds_byte(wr * 64 + fr, fq * 8), boff = lds_byte(wc * 32 + fr, fq * 8);
    Unit cur, nxt; int ui = 0;
    if (!S.next(0, cur)) return;
    f32x4 acc[2][2][4][2];
#pragma unroll
    for (int a = 0; a < 2; ++a)
#pragma unroll
        for (int b = 0; b < 2; ++b)
#pragma unroll
            for (int m = 0; m < 4; ++m)
#pragma unroll
                for (int n = 0; n < 2; ++n) acc[a][b][m][n] = (f32x4){0.f, 0.f, 0.f, 0.f};
    bf16x8 At[4][2], B0[2][2], B1[2][2];
    const char* cA = (const char*)g.A + (size_t)cur.pm * tstep; const char* cB = (const char*)g.Bt + (size_t)cur.pb * tstep;
    if (GATHER) {
#pragma unroll
        for (int h = 0; h < 2; ++h)
#pragma unroll
            for (int i = 0; i < 2; ++i) { voffC[h][i] = (unsigned)(S.row_index(cur, RA[i] + 128 * h) * K + CA[i]) * 2u; voffN[h][i] = voffC[h][i]; }
    }
    const char* nA = cA; const char* nB = cB;
    PG8_STAGE_B(PG8_SB(0, 0), false, 0, 0); PG8_STAGE_B(PG8_SB(0, 1), false, 0, 1); PG8_STAGE_A(PG8_SA(0, 0), false, 0, 0); PG8_STAGE_A(PG8_SA(0, 1), false, 0, 1);
    if (wr == 1) PG8_BAR;
    PG8_WAIT_V(2); PG8_BAR;
    PG8_STAGE_B(PG8_SB(1, 0), false, kstep, 0); PG8_STAGE_A(PG8_SA(1, 0), false, kstep, 0); PG8_STAGE_B(PG8_SB(1, 1), false, kstep, 1);
    PG8_WAIT_V(6); PG8_BAR;
    for (;;) {
        const bool has_next = S.next(ui + 1, nxt);
        nA = has_next ? (const char*)g.A + (size_t)nxt.pm * tstep : cA; nB = has_next ? (const char*)g.Bt + (size_t)nxt.pb * tstep : cB;
        if (GATHER) {
#pragma unroll
            for (int h = 0; h < 2; ++h)
#pragma unroll
                for (int i = 0; i < 2; ++i) voffN[h][i] = has_next ? (unsigned)(S.row_index(nxt, RA[i] + 128 * h) * K + CA[i]) * 2u : voffC[h][i];
        }
        for (int t = 0; t < nt; t += 2) {
            const bool last = (t == nt - 2);
            const size_t k1 = (size_t)(t + 1) * kstep, k2 = last ? 0 : (size_t)(t + 2) * kstep, k3 = k2 + kstep;
            PG8_LDB(B0, 0, 0); PG8_LDB(B1, 0, 1); PG8_SCHED; PG8_LDA(At, 0, 0); PG8_STAGE_A(PG8_SA(1, 1), false, k1, 1);
            PG8_WAIT_V(8); PG8_WAIT_L(0); PG8_BAR; PG8_MMA(0, 0, At, B0); PG8_MMA(0, 1, At, B1); PG8_BAR; PG8_SCHED;
            PG8_LDA(At, 0, 1); PG8_STAGE_B(PG8_SB(0, 0), last, k2, 0); PG8_STAGE_B(PG8_SB(0, 1), last, k2, 1); PG8_STAGE_A(PG8_SA(0, 0), last, k2, 0);
            PG8_WAIT_V(8); PG8_WAIT_L(0); PG8_BAR; PG8_MMA(1, 0, At, B0); PG8_MMA(1, 1, At, B1); PG8_BAR; PG8_SCHED;
            PG8_LDB(B0, 1, 0); PG8_LDB(B1, 1, 1); PG8_SCHED; PG8_LDA(At, 1, 0); PG8_STAGE_A(PG8_SA(0, 1), last, k2, 1);
            PG8_WAIT_V(8); PG8_WAIT_L(0); PG8_BAR; PG8_MMA(0, 0, At, B0); PG8_MMA(0, 1, At, B1); PG8_BAR; PG8_SCHED;
            PG8_LDA(At, 1, 1); PG8_STAGE_B(PG8_SB(1, 0), last, k3, 0); PG8_STAGE_B(PG8_SB(1, 1), last, k3, 1); PG8_STAGE_A(PG8_SA(1, 0), last, k3, 0);
            PG8_WAIT_V(8); PG8_WAIT_L(0); PG8_BAR; PG8_MMA(1, 0, At, B0); PG8_MMA(1, 1, At, B1); PG8_BAR; PG8_SCHED;
        }
        if constexpr (ALIGN_EPI) { if (wr == 0) PG8_BAR; }
        E(acc, cur, wr, wc, fr, fq);
        if (!has_next) break;
#pragma unroll
        for (int a = 0; a < 2; ++a)
#pragma unroll
            for (int b = 0; b < 2; ++b)
#pragma unroll
                for (int m = 0; m < 4; ++m)
#pragma unroll
                    for (int n = 0; n < 2; ++n) acc[a][b][m][n] = (f32x4){0.f, 0.f, 0.f, 0.f};
        cur = nxt; cA = nA; cB = nB; ++ui;
        if (GATHER) {
#pragma unroll
            for (int h = 0; h < 2; ++h)
#pragma unroll
                for (int i = 0; i < 2; ++i) voffC[h][i] = voffN[h][i];
        }
        if constexpr (ALIGN_EPI) { if (wr == 1) PG8_BAR; }
    }
    PG8_WAIT_V(0);
    if constexpr (!ALIGN_EPI) { if (wr == 0) PG8_BAR; }
    PG8_BAR;
}

struct EpiInProj {
    static constexpr bool PERM = true;
    bf16* zg; bf16* qb; bf16* kb; bf16* vb; const float* qn; const float* kn;
    __device__ __forceinline__ void operator()(const f32x4 (&acc)[2][2][4][2], const Unit& u, int wr, int wc, int fr, int fq) const {
        const int row0 = u.pm * BM + wr * 64 + fr;
        if (u.pn < 8) {
            const int col0 = u.pn * BM + wc * 32 + 8 * fq;
#pragma unroll
            for (int ai = 0; ai < 2; ++ai)
#pragma unroll
                for (int m = 0; m < 4; ++m) { bf16* rowp = zg + (size_t)(row0 + ai * HALF + m * 16) * 2048 + col0;
#pragma unroll
                    for (int bj = 0; bj < 2; ++bj) { const f32x4 v0 = acc[ai][bj][m][0], v1 = acc[ai][bj][m][1];
                        u32x4 w; w.x = pk2(v0[0], v0[1]); w.y = pk2(v0[2], v0[3]); w.z = pk2(v1[0], v1[1]); w.w = pk2(v1[2], v1[3]); *(u32x4*)(rowp + bj * HALF) = w; } }
        } else {
            const int sec = (u.pn - 8) >> 1, head = 4 * ((u.pn - 8) & 1) + wc;
            bf16* dst = qb + (size_t)sec * ((WS_KB - WS_QB) / 2); const float* nw = (sec == 1) ? kn : qn;
            f32x4 wv[2][2];
#pragma unroll
            for (int bj = 0; bj < 2; ++bj)
#pragma unroll
                for (int n = 0; n < 2; ++n) wv[bj][n] = sec == 2 ? (f32x4){1.f, 1.f, 1.f, 1.f} : *(const f32x4*)(nw + 32 * bj + 8 * fq + 4 * n);
#pragma unroll
            for (int ai = 0; ai < 2; ++ai)
#pragma unroll
                for (int m = 0; m < 4; ++m) {
                    float sc = 1.f;
                    if (sec < 2) { float ss = 0.f;
#pragma unroll
                        for (int bj = 0; bj < 2; ++bj)
#pragma unroll
                            for (int n = 0; n < 2; ++n) { const f32x4 x = acc[ai][bj][m][n]; ss += (x[0] * x[0] + x[1] * x[1]) + (x[2] * x[2] + x[3] * x[3]); }
                        ss += __shfl_xor(ss, 16); ss += __shfl_xor(ss, 32);
                        sc = rsqrtf(ss * (1.f / 64.f) + EPS) * (sec == 0 ? 0.125f * LOG2E : 1.f); }
                    bf16* rowp = dst + (size_t)(row0 + ai * HALF + m * 16) * 512 + head * 64 + 8 * fq;
#pragma unroll
                    for (int bj = 0; bj < 2; ++bj) { const f32x4 v0 = acc[ai][bj][m][0] * sc * wv[bj][0], v1 = acc[ai][bj][m][1] * sc * wv[bj][1];
                        u32x4 w; w.x = pk2(v0[0], v0[1]); w.y = pk2(v0[2], v0[3]); w.z = pk2(v1[0], v1[1]); w.w = pk2(v1[2], v1[3]); *(u32x4*)(rowp + bj * 32) = w; } }
        }
    }
};
struct EpiOutProj {
    static constexpr bool PERM = false;
    const float* x; float* h; bf16* hb;
    __device__ __forceinline__ void operator()(const f32x4 (&acc)[2][2][4][2], const Unit& u, int wr, int wc, int fr, int fq) const {
        const int row0 = u.pm * BM + wr * 64 + fr, col0 = u.pn * BM + wc * 32 + 4 * fq;
#pragma unroll
        for (int ai = 0; ai < 2; ++ai)
#pragma unroll
            for (int m = 0; m < 4; ++m) { const size_t off = (size_t)(row0 + ai * HALF + m * 16) * D + col0;
#pragma unroll
                for (int bj = 0; bj < 2; ++bj)
#pragma unroll
                    for (int n = 0; n < 2; ++n) { const f32x4 v = *(const f32x4*)(x + off + bj * HALF + n * 16) + acc[ai][bj][m][n];
                        *(f32x4*)(h + off + bj * HALF + n * 16) = v; u32x2 w; w.x = pk2(v[0], v[1]); w.y = pk2(v[2], v[3]); *(u32x2*)(hb + off + bj * HALF + n * 16) = w; } }
    }
};
struct EpiGateUp {
    static constexpr bool PERM = true;
    bf16* act; const float* bgu; const float* lrs; const LAS int* lcnt;
    __device__ __forceinline__ void operator()(const f32x4 (&acc)[2][2][4][2], const Unit& u, int wr, int wc, int fr, int fq) const {
        const int cl = wc * 32 + 8 * fq; const float* bg = bgu + (size_t)u.e * 2048 + 128 * u.pn + cl;
        f32x4 bgv[2], buv[2];
#pragma unroll
        for (int n = 0; n < 2; ++n) { bgv[n] = *(const f32x4*)(bg + 4 * n); buv[n] = *(const f32x4*)(bg + 1024 + 4 * n); }
        const int cnt = lcnt[u.e];
#pragma unroll
        for (int ai = 0; ai < 2; ++ai)
#pragma unroll
            for (int m = 0; m < 4; ++m) { const int r = ai * HALF + wr * 64 + m * 16 + fr, rr = u.mt * 256 + r;
                const float rs = rr < cnt ? lrs[(size_t)u.e * LCAP + rr] : 0.f;
                u32x4 w; unsigned wq[4];
#pragma unroll
                for (int n = 0; n < 2; ++n) { float a[4];
#pragma unroll
                    for (int i = 0; i < 4; ++i) { const float gt = fminf(acc[ai][0][m][n][i] * rs + bgv[n][i], 7.f); const float up = fminf(fmaxf(acc[ai][1][m][n][i] * rs + buv[n][i], -7.f), 7.f);
                        a[i] = (up + 1.f) * gt * sigmoid_f(1.702f * gt); }
                    wq[2 * n] = pk2(a[0], a[1]); wq[2 * n + 1] = pk2(a[2], a[3]); }
                w.x = wq[0]; w.y = wq[1]; w.z = wq[2]; w.w = wq[3];
                *(u32x4*)(act + (size_t)(u.pm * BM + r) * FF + 128 * u.pn + cl) = w; }
    }
};
struct EpiDown {
    static constexpr bool PERM = true;
    bf16* y; const float* bdn;
    __device__ __forceinline__ void operator()(const f32x4 (&acc)[2][2][4][2], const Unit& u, int wr, int wc, int fr, int fq) const {
        const int col0 = u.pn * BM + wc * 32 + 8 * fq; const float* bp = bdn + (size_t)u.e * D + col0;
        f32x4 bv[2][2];
#pragma unroll
        for (int bj = 0; bj < 2; ++bj)
#pragma unroll
            for (int n = 0; n < 2; ++n) bv[bj][n] = *(const f32x4*)(bp + bj * HALF + 4 * n);
#pragma unroll
        for (int ai = 0; ai < 2; ++ai)
#pragma unroll
            for (int m = 0; m < 4; ++m) { bf16* rowp = y + (size_t)(u.pm * BM + ai * HALF + wr * 64 + m * 16 + fr) * D + col0;
#pragma unroll
                for (int bj = 0; bj < 2; ++bj) { const f32x4 v0 = acc[ai][bj][m][0] + bv[bj][0], v1 = acc[ai][bj][m][1] + bv[bj][1];
                    u32x4 w; w.x = pk2(v0[0], v0[1]); w.y = pk2(v0[2], v0[3]); w.z = pk2(v1[0], v1[1]); w.w = pk2(v1[2], v1[3]); *(u32x4*)(rowp + bj * HALF) = w; } }
    }
};
}

#define XB_TMO      128
#define XB_XCNT(j)  (256  + 64 * (j))
#define XB_XSUB(j)  (1280 + 64 * (j))
#define XB_XGEN(j)  (2304 + 64 * (j))
#define XB_TOP      3328
#define XB_TOPGEN   3392
#define XCD_BAR_WORDS 3456
#define XB_SPIN_CAP (1u << 20)
__device__ __forceinline__ unsigned xb_ld(unsigned* p)              { return __hip_atomic_load(p, __ATOMIC_RELAXED, __HIP_MEMORY_SCOPE_AGENT); }
__device__ __forceinline__ unsigned xb_add(unsigned* p, unsigned v) { return __hip_atomic_fetch_add(p, v, __ATOMIC_RELAXED, __HIP_MEMORY_SCOPE_AGENT); }
__device__ __forceinline__ unsigned xb_xcc_id() { return (unsigned)__builtin_amdgcn_s_getreg((3 << 11) | 20) & 0xFu; }
#define XB_SPIN(cond, bar) do { unsigned _sp = 0; while (cond) { __builtin_amdgcn_s_sleep(1); \
    if ((++_sp & 255u) == 0u) { if (xb_ld(&(bar)[XB_TMO])) break; if (_sp > XB_SPIN_CAP) { atomicAdd(&(bar)[XB_TMO], 1u); break; } } } } while (0)
struct XcdBarrier { unsigned* bar; unsigned x; volatile LAS unsigned* st; };
__device__ __forceinline__ XcdBarrier xcd_barrier_post(unsigned* bar, volatile LAS unsigned* st) {
    XcdBarrier b; b.bar = bar; b.x = xb_xcc_id(); b.st = st;
    if (threadIdx.x == 0) (void)xb_add(&bar[XB_XCNT(b.x)], 1u);
    return b;
}
__device__ __forceinline__ void xcd_barrier_complete(unsigned* bar, unsigned x, unsigned& nloc, unsigned& nx) {
    const unsigned G = gridDim.x * gridDim.y * gridDim.z;
    unsigned sum, cnt, mine, sp = 0u;
    for (;;) {
        sum = 0u; cnt = 0u; mine = 0u;
#pragma unroll
        for (unsigned j = 0; j < 16; ++j) { const unsigned c = xb_ld(&bar[XB_XCNT(j)]); sum += c; cnt += (c > 0u) ? 1u : 0u; mine = (j == x) ? c : mine; }
        if (sum == G) break;
        __builtin_amdgcn_s_sleep(1);
        if ((++sp & 255u) == 0u) { if (xb_ld(&bar[XB_TMO])) break; if (sp > XB_SPIN_CAP) { atomicAdd(&bar[XB_TMO], 1u); break; } }
    }
    nloc = mine > 0u ? mine : 1u; nx = cnt > 0u ? cnt : 1u;
}
__device__ __forceinline__ void xcd_barrier(const XcdBarrier& b) {
    asm volatile("s_waitcnt vmcnt(0)" ::: "memory");
    __syncthreads();
    if (threadIdx.x == 0) {
        unsigned* bar = b.bar;
        __builtin_amdgcn_s_waitcnt(0);
        unsigned nloc = b.st[0], nx = b.st[1];
        if (nloc == 0u) { xcd_barrier_complete(bar, b.x, nloc, nx); b.st[0] = nloc; b.st[1] = nx; }
        const unsigned old = xb_add(&bar[XB_XSUB(b.x)], 1u);
        const unsigned gen = old / nloc;
        if (old + 1u == (gen + 1u) * nloc) {
            __builtin_amdgcn_fence(__ATOMIC_RELEASE, "agent");
            asm volatile("s_waitcnt vmcnt(0)" ::: "memory");
            const unsigned og = xb_add(&bar[XB_TOP], 1u);
            const unsigned tg = og / nx;
            if (og + 1u == (tg + 1u) * nx) xb_add(&bar[XB_TOPGEN], 1u);
            else XB_SPIN(xb_ld(&bar[XB_TOPGEN]) == tg, bar);
            __builtin_amdgcn_fence(__ATOMIC_ACQUIRE, "agent");
            xb_add(&bar[XB_XGEN(b.x)], 1u);
            asm volatile("s_waitcnt vmcnt(0)" ::: "memory");
        } else {
            XB_SPIN(xb_ld(&bar[XB_XGEN(b.x)]) == gen, bar);
            __builtin_amdgcn_fence(__ATOMIC_ACQUIRE, "agent");
            asm volatile("s_waitcnt vmcnt(0)" ::: "memory");
        }
    }
    __syncthreads();
}

struct Args { const float* in[18]; float* out; unsigned char* ws; int ph_lo, ph_hi, li, pad; };
struct Frame {
    LAS unsigned char* lds; unsigned char* ws; unsigned* ctl;
    int tid, lane, wave, G, vcu;
};

__device__ const unsigned char T5B[3][132] = {
{0,1,2,3,4,5,6,7,8,9,10,11,12,13,14,15,16,16,16,16,16,16,17,17,17,17,17,17,17,17,18,18,18,18,18,18,18,18,18,18,19,19,19,19,19,19,19,19,19,19,19,19,19,19,20,20,20,20,20,20,20,20,20,20,20,20,20,20,20,20,20,20,20,21,21,21,21,21,21,21,21,21,21,21,21,21,21,21,21,21,21,21,21,21,21,21,21,21,21,22,22,22,22,22,22,22,22,22,22,22,22,22,22,22,22,22,22,22,22,22,22,22,22,22,22,22,22,22,22,0,0,0},
{0,4,8,12,16,16,17,17,18,18,19,19,19,19,20,20,20,20,20,21,21,21,21,21,21,22,22,22,22,22,22,22,22,22,23,23,23,23,23,23,23,23,23,23,23,23,24,24,24,24,24,24,24,24,24,24,24,24,24,24,24,24,25,25,25,25,25,25,25,25,25,25,25,25,25,25,25,25,25,25,25,25,25,26,26,26,26,26,26,26,26,26,26,26,26,26,26,26,26,26,26,26,26,26,26,26,26,26,26,26,26,26,26,27,27,27,27,27,27,27,27,27,27,27,27,27,27,27,27,0,0,0},
{0,16,18,19,20,21,21,22,22,23,23,23,24,24,24,24,25,25,25,25,25,26,26,26,26,26,26,26,26,27,27,27,27,27,27,27,27,27,27,28,28,28,28,28,28,28,28,28,28,28,28,28,29,29,29,29,29,29,29,29,29,29,29,29,29,29,29,29,29,29,30,30,30,30,30,30,30,30,30,30,30,30,30,30,30,30,30,30,30,30,30,30,30,30,30,31,31,31,31,31,31,31,31,31,31,31,31,31,31,31,31,31,31,31,31,31,31,31,31,31,31,31,31,31,31,31,31,31,31,0,0,0}};

__device__ __forceinline__ void p0_transpose_item(const float* W, size_t ldw, int src_col0, bf16* dst, int k0, const float* kscale, LAS float* scr, int lane) {
#pragma unroll 8
    for (int i = 0; i < 32; ++i) { const int kk = 2 * i + (lane >> 5); float v = W[(size_t)(k0 + kk) * ldw + src_col0 + (lane & 31)]; if (kscale) v *= kscale[k0 + kk]; scr[kk * 33 + (lane & 31)] = v; }
    LDS_WAIT(); asm volatile("" ::: "memory");
    const int c = lane & 7;
#pragma unroll
    for (int j = 0; j < 4; ++j) { const int n = (lane >> 3) + 8 * j; const LAS float* s = scr + (8 * c) * 33 + n;
        u32x4 o; o.x = pk2(s[0 * 33], s[1 * 33]); o.y = pk2(s[2 * 33], s[3 * 33]); o.z = pk2(s[4 * 33], s[5 * 33]); o.w = pk2(s[6 * 33], s[7 * 33]);
        *(u32x4*)(dst + (size_t)n * 1024 + k0 + 8 * c) = o; }
    LDS_WAIT(); asm volatile("" ::: "memory");
}
__device__ __forceinline__ void phase0(Frame& F, const Args& a) {
    const float* x = a.in[0]; const float* n1 = a.in[1]; const float* w_in = a.in[2]; const float* w_out = a.in[10]; const float* n2 = a.in[11];
    const float* w_r = a.in[12]; const float* w_gu = a.in[14]; const float* w_dn = a.in[16];
    bf16* Win_t = (bf16*)(F.ws + WS_WIN); bf16* Wout_t = (bf16*)(F.ws + WS_WOUT); bf16* Wgu_t = (bf16*)(F.ws + WS_WGU); bf16* Wdn_t = (bf16*)(F.ws + WS_WDN);
    float* wrT = (float*)(F.ws + WS_WRT); bf16* XN = (bf16*)(F.ws + WS_XN); float* BA = (float*)(F.ws + WS_BA);
    LAS float* scr = (LAS float*)(F.lds + F.wave * 16384);
    const int gw = F.vcu * NWAVES + F.wave, NGW = F.G * NWAVES;
    for (int m = gw; m < T; m += NGW) {
        const f32x4* xr = (const f32x4*)(x + (size_t)m * D) + F.lane; f32x4 v[4]; float s = 0.f;
#pragma unroll
        for (int j = 0; j < 4; ++j) { v[j] = xr[64 * j]; s += (v[j][0] * v[j][0] + v[j][1] * v[j][1]) + (v[j][2] * v[j][2] + v[j][3] * v[j][3]); }
        const float rs = rsqrtf(wave_sum(s) * (1.f / D) + EPS);
        float ba[8];
#pragma unroll
        for (int c = 0; c < 8; ++c) ba[c] = 0.f;
        unsigned long long* o8 = (unsigned long long*)(XN + (size_t)m * D) + F.lane;
#pragma unroll
        for (int j = 0; j < 4; ++j) { const f32x4 w = *((const f32x4*)n1 + F.lane + 64 * j); v[j] = v[j] * rs * w;
            o8[64 * j] = (unsigned long long)pk2(v[j][0], v[j][1]) | ((unsigned long long)pk2(v[j][2], v[j][3]) << 32);
#pragma unroll
            for (int i = 0; i < 4; ++i) { const float* wp = w_in + (size_t)(4 * F.lane + 256 * j + i) * IN_DIM + 2048; const f32x4 w0 = *(const f32x4*)wp, w1 = *(const f32x4*)(wp + 4);
                ba[0] += v[j][i] * w0[0]; ba[1] += v[j][i] * w0[1]; ba[2] += v[j][i] * w0[2]; ba[3] += v[j][i] * w0[3];
                ba[4] += v[j][i] * w1[0]; ba[5] += v[j][i] * w1[1]; ba[6] += v[j][i] * w1[2]; ba[7] += v[j][i] * w1[3]; } }
#pragma unroll
        for (int c = 0; c < 8; ++c) ba[c] = wave_sum(ba[c]);
        if (F.lane == 0) { *(f32x4*)(BA + (size_t)m * 8) = (f32x4){ba[0], ba[1], ba[2], ba[3]}; *(f32x4*)(BA + (size_t)m * 8 + 4) = (f32x4){ba[4], ba[5], ba[6], ba[7]}; }
    }
    for (int i = (F.vcu * NTHREADS + F.tid); i < NE * D; i += F.G * NTHREADS) { const int e = i >> 10, k = i & 1023; wrT[i] = n2[k] * w_r[k * NE + e]; }
    constexpr int I_IN = 16 * (NIN / 32), I_OUT = 16 * 32, I_GU = NE * 16 * 64, I_DN = NE * 16 * 32, NITEMS = I_IN + I_OUT + I_GU + I_DN;
    for (int it = gw; it < NITEMS; it += NGW) {
        int r = it;
        if (r < I_IN) { const int nb = r % (NIN / 32), kb = r / (NIN / 32), np = 32 * nb; int src;
            if (np < 2048) src = np; else { const int q = np - 2048, sec = q >> 9, rem = q & 511, pt = rem >> 8, lc = rem & 255, bj = lc >> 7, wc = (lc & 127) >> 5; src = 2056 + sec * 512 + (4 * pt + wc) * 64 + 32 * bj; }
            p0_transpose_item(w_in, IN_DIM, src, Win_t + (size_t)np * 1024, 64 * kb, nullptr, scr, F.lane); continue; }
        r -= I_IN;
        if (r < I_OUT) { const int nb = r & 31, kb = r >> 5; p0_transpose_item(w_out, D, 32 * nb, Wout_t + (size_t)(32 * nb) * 1024, 64 * kb, nullptr, scr, F.lane); continue; }
        r -= I_OUT;
        if (r < I_GU) { const int e = r >> 10, q = r & 1023, nb = q & 63, kb = q >> 6, np = 32 * nb, ntile = np >> 8, lc = np & 255, bj = lc >> 7, j0 = lc & 127;
            p0_transpose_item(w_gu + (size_t)e * D * 2048, 2048, bj * 1024 + 128 * ntile + j0, Wgu_t + ((size_t)e * 2048 + np) * 1024, 64 * kb, n2, scr, F.lane); continue; }
        r -= I_GU;
        { const int e = r >> 9, q = r & 511, nb = q & 31, kb = q >> 5; p0_transpose_item(w_dn + (size_t)e * FF * D, D, 32 * nb, Wdn_t + ((size_t)e * 1024 + 32 * nb) * 1024, 64 * kb, nullptr, scr, F.lane); }
    }
}

constexpr int GP = 132;
constexpr int GQ_OFF = 0, GK_OFF = 64 * GP * 4, GV_OFF = 2 * 64 * GP * 4, GW_OFF = 3 * 64 * GP * 4, GAT_OFF = 4 * 64 * GP * 4, GAT_P = 68;
constexpr int GRAW_OFF = GW_OFF, GRAW_BYTES = 67 * 768;
constexpr int GGC_OFF = GRAW_OFF + GRAW_BYTES, GBETA_OFF = GGC_OFF + 256, GEND = GBETA_OFF + 256;
static_assert(GAT_OFF + 64 * GAT_P * 4 <= GGC_OFF && GEND <= TOP_OFF, "gdn prep LDS");
__device__ __forceinline__ int permpos(int cc) { return 8 * ((cc & 15) >> 2) + (cc & 3) + 4 * (cc >> 4); }
__device__ __forceinline__ void gdn_prep_unit(Frame& F, const Args& a, int unit) {
    const bf16* zg = (const bf16*)(F.ws + WS_ZG); const float* BA = (const float*)(F.ws + WS_BA);
    const float* convw = a.in[3]; const float* a_log = a.in[4]; const float* dt_bias = a.in[5];
    const int b = unit >> 8, h = (unit >> 6) & 3, n = unit & 63; const int row0 = b * SEQ + n * CHUNK;
    unsigned char* rec = F.ws + WS_PREP + (size_t)unit * PREP_REC;
    LAS float* Qs = (LAS float*)(F.lds + GQ_OFF); LAS float* Ks = (LAS float*)(F.lds + GK_OFF); LAS float* Vs = (LAS float*)(F.lds + GV_OFF); LAS float* Ws = (LAS float*)(F.lds + GW_OFF);
    LAS float* AT = (LAS float*)(F.lds + GAT_OFF); LAS float* gcs = (LAS float*)(F.lds + GGC_OFF); LAS float* betas = (LAS float*)(F.lds + GBETA_OFF);
    LAS unsigned char* raw = F.lds + GRAW_OFF;
    const int tid = F.tid, lane = F.lane, wave = F.wave;
    for (int e = tid; e < 67 * 48; e += NTHREADS) { const int rr = e / 48, ch = e % 48; const int tt = n * CHUNK + rr - 3;
        u32x4 v = {0u, 0u, 0u, 0u}; if (tt >= 0) v = *(const u32x4*)(zg + (size_t)(row0 + rr - 3) * 2048 + (ch >> 4) * 512 + h * 128 + (ch & 15) * 8);
        *(LAS u32x4*)(raw + rr * 768 + ch * 16) = v; }
    if (wave == 0) {
        const float bl = BA[(size_t)(row0 + lane) * 8 + h], al = BA[(size_t)(row0 + lane) * 8 + 4 + h];
        const float xx = al + dt_bias[h]; const float sp = xx > 20.f ? xx : log1pf(__expf(xx));
        float g = -__expf(a_log[h]) * sp;
#pragma unroll
        for (int o = 1; o < 64; o <<= 1) { const float u = __shfl_up(g, o); if (lane >= o) g += u; }
        gcs[lane] = g; betas[lane] = sigmoid_f(bl);
    }
    __syncthreads();
    if (tid < 384) { const int cp = tid % 192, tp = tid / 192; const int ten = cp >> 6, c = (cp & 63) * 2; const int ch = ten * 512 + h * 128 + c;
        f32x2 cw[4];
#pragma unroll
        for (int k = 0; k < 4; ++k) cw[k] = *(const f32x2*)(convw + k * 1536 + ch);
        LAS float* dst = (ten == 0 ? Qs : (ten == 1 ? Ks : Vs)) + c;
        for (int t = tp; t < 64; t += 2) { float a0 = 0.f, a1 = 0.f;
#pragma unroll
            for (int k = 0; k < 4; ++k) { const unsigned w = *(const LAS unsigned*)(raw + (t + k) * 768 + cp * 4); a0 += bflo(w) * cw[k][0]; a1 += bfhi(w) * cw[k][1]; }
            *(LAS f32x2*)(dst + t * GP) = (f32x2){silu_f(a0), silu_f(a1)}; } }
    __syncthreads();
    for (int rr = 0; rr < 8; ++rr) { const int t = wave * 8 + rr;
        f32x2 q = *(LAS f32x2*)(Qs + t * GP + 2 * lane), k = *(LAS f32x2*)(Ks + t * GP + 2 * lane);
        const float sq = wave_sum(q[0] * q[0] + q[1] * q[1]), sk = wave_sum(k[0] * k[0] + k[1] * k[1]);
        const float fq_ = rsqrtf(sq + EPS) * 0.08838834764831845f, fk_ = rsqrtf(sk + EPS);
        *(LAS f32x2*)(Qs + t * GP + 2 * lane) = q * fq_; *(LAS f32x2*)(Ks + t * GP + 2 * lane) = k * fk_; }
    __syncthreads();
    {
        const int which = wave >> 2, ti = (wave >> 1) & 1, tj = wave & 1, r32 = lane & 31, hh = lane >> 5;
        const LAS float* Xa = (which ? Qs : Ks) + (32 * ti + r32) * GP + 8 * hh; const LAS float* Xb = Ks + (32 * tj + r32) * GP + 8 * hh;
        f32x16 acc = {};
#pragma unroll
        for (int ks = 0; ks < 8; ++ks) { const bf16x8 af = pack8(*(const LAS f32x4*)(Xa + 16 * ks), *(const LAS f32x4*)(Xa + 16 * ks + 4)), bf = pack8(*(const LAS f32x4*)(Xb + 16 * ks), *(const LAS f32x4*)(Xb + 16 * ks + 4));
            acc = __builtin_amdgcn_mfma_f32_32x32x16_bf16(af, bf, acc, 0, 0, 0); }
        const int j = 32 * tj + r32; const float gj = gcs[j];
        bf16* Af = (bf16*)(rec + PREP_AP); const int jpos = permpos(j & 31); const int afo = (j >> 5) * 512 + (jpos >> 3) * 128 + (jpos & 7);
#pragma unroll
        for (int q = 0; q < 4; ++q) { float vals[4];
#pragma unroll
            for (int rr = 0; rr < 4; ++rr) { const int i = 32 * ti + 8 * q + 4 * hh + rr; const float dec = __expf(fminf(gcs[i] - gj, 0.f));
                if (which == 0) vals[rr] = i > j ? betas[i] * acc[4 * q + rr] * dec : 0.f;
                else { const float v = i >= j ? acc[4 * q + rr] * dec : 0.f; Af[(i >> 4) * 1024 + (i & 15) * 8 + afo] = (bf16)(pk2(v, 0.f) & 0xffffu); } }
            if (which == 0) *(LAS f32x4*)(AT + j * GAT_P + 32 * ti + 8 * q + 4 * hh) = (f32x4){vals[0], vals[1], vals[2], vals[3]}; }
        for (int e = tid; e < 64 * 32; e += NTHREADS) { const int t = e >> 5, c = (e & 31) * 4; const float bt = betas[t], eg = bt * __expf(gcs[t]);
            *(LAS f32x4*)(Vs + t * GP + c) = *(LAS f32x4*)(Vs + t * GP + c) * bt; *(LAS f32x4*)(Ws + t * GP + c) = *(LAS f32x4*)(Ks + t * GP + c) * eg; }
    }
    __syncthreads();
    if (tid < 256) {
        LAS float* X = (tid < 128 ? Vs : Ws) + (tid & 127);
#pragma unroll 1
        for (int ib = 0; ib < 4; ++ib) { const int i0 = 16 * ib; float r[16];
#pragma unroll
            for (int ii = 0; ii < 16; ++ii) r[ii] = X[(i0 + ii) * GP];
#pragma unroll 1
            for (int j = 0; j < i0; ++j) { const float xj = X[j * GP]; const LAS f32x4* ap = (const LAS f32x4*)(AT + j * GAT_P + i0);
#pragma unroll
                for (int q = 0; q < 4; ++q) { const f32x4 av = ap[q]; r[4 * q] -= av[0] * xj; r[4 * q + 1] -= av[1] * xj; r[4 * q + 2] -= av[2] * xj; r[4 * q + 3] -= av[3] * xj; } }
#pragma unroll
            for (int j = 0; j < 16; ++j) { const float xj = r[j]; const LAS f32x4* ap = (const LAS f32x4*)(AT + (i0 + j) * GAT_P + i0); float av[16];
#pragma unroll
                for (int q = 0; q < 4; ++q) { const f32x4 t4 = ap[q]; av[4 * q] = t4[0]; av[4 * q + 1] = t4[1]; av[4 * q + 2] = t4[2]; av[4 * q + 3] = t4[3]; }
#pragma unroll
                for (int ii = 0; ii < 16; ++ii) if (ii > j) r[ii] -= av[ii] * xj; }
#pragma unroll
            for (int ii = 0; ii < 16; ++ii) X[(i0 + ii) * GP] = r[ii]; }
    } else {
        const int t2 = tid - 256; bf16* Qf = (bf16*)(rec + PREP_QP); bf16* Kf = (bf16*)(rec + PREP_KT); const float gl = gcs[63];
        for (int it = t2; it < 1024; it += 256) { const int blk = it >> 6, l = it & 63, mi = blk >> 2, ks = blk & 3, g = l >> 4, c = 16 * mi + (l & 15); const float eg = __expf(gcs[c]);
            const f32x4 lo = *(LAS f32x4*)(Qs + c * GP + 32 * ks + 4 * g) * eg, hi = *(LAS f32x4*)(Qs + c * GP + 32 * ks + 16 + 4 * g) * eg;
            *(bf16x8*)(Qf + it * 8) = pack8(lo, hi); }
        for (int it = t2; it < 1024; it += 256) { const int blk = it >> 6, l = it & 63, ti = blk >> 1, ks2 = blk & 1, g = l >> 4, dk = 16 * ti + (l & 15); float v[8];
#pragma unroll
            for (int j = 0; j < 8; ++j) { const int c = 32 * ks2 + (j < 4 ? 4 * g + j : 16 + 4 * g + (j - 4)); v[j] = Ks[c * GP + dk] * __expf(gl - gcs[c]); }
            *(bf16x8*)(Kf + it * 8) = pack8((f32x4){v[0], v[1], v[2], v[3]}, (f32x4){v[4], v[5], v[6], v[7]}); }
        if (t2 == 0) *(float*)(rec + PREP_CD) = __expf(gl);
    }
    __syncthreads();
    { float* Up = (float*)(rec + PREP_UP); bf16* Wf = (bf16*)(rec + PREP_WP);
        for (int it = tid; it < 2048; it += NTHREADS) { const int dv = it & 127, g = (it >> 7) & 3, mi = it >> 9; const int c0 = 16 * mi + 4 * g;
            *(f32x4*)(Up + (size_t)it * 4) = (f32x4){Vs[c0 * GP + dv], Vs[(c0 + 1) * GP + dv], Vs[(c0 + 2) * GP + dv], Vs[(c0 + 3) * GP + dv]}; }
        for (int it = tid; it < 1024; it += NTHREADS) { const int blk = it >> 6, l = it & 63, mi = blk >> 2, ks = blk & 3, g = l >> 4, c = 16 * mi + (l & 15);
            *(bf16x8*)(Wf + it * 8) = pack8(*(LAS f32x4*)(Ws + c * GP + 32 * ks + 4 * g), *(LAS f32x4*)(Ws + c * GP + 32 * ks + 16 + 4 * g)); }
    }
    __syncthreads();
}

constexpr int SC_BUFSZ = 57344, SC_OT = 2 * SC_BUFSZ, SC_OTSZ = 64 * 128 * 2, SC_END = SC_OT + 2 * SC_OTSZ;
static_assert(SC_END <= TOP_OFF, "scan LDS");
__device__ __forceinline__ void gdn_scan(Frame& F, const Args& a, int bh) {
    const int tid = F.tid, lane = F.lane, w = F.wave, fr = lane & 15, g = lane >> 4; const int b = bh >> 2, h = bh & 3;
    const unsigned char* rec0 = F.ws + WS_PREP + (size_t)bh * NCHUNK * PREP_REC;
    const float* gnw = a.in[6]; const bf16* zg = (const bf16*)(F.ws + WS_ZG); bf16* mix = (bf16*)(F.ws + WS_MIX);
    const f32x2 gw2 = *(const f32x2*)(gnw + 2 * lane);
    const size_t rowb = (size_t)b * SEQ;
#define SC_DMA(n_, buf_) do { const unsigned char* src_ = rec0 + (size_t)(n_) * PREP_REC + tid * 16; _Pragma("unroll") for (int r_ = 0; r_ < 7; ++r_) \
        __builtin_amdgcn_global_load_lds((const unsigned*)(src_ + r_ * 8192), (LAS unsigned*)(F.lds + (buf_) * SC_BUFSZ + r_ * 8192 + w * 1024), 16, 0, 0); } while (0)
    f32x4 S[8];
#pragma unroll
    for (int i = 0; i < 8; ++i) S[i] = (f32x4){0.f, 0.f, 0.f, 0.f};
    f32x4 Uc[4], Un[4]; unsigned gc_[8], gn_[8];
    SC_DMA(0, 0);
#pragma unroll
    for (int mi = 0; mi < 4; ++mi) Uc[mi] = *(const f32x4*)((const float*)(rec0 + PREP_UP) + (size_t)((mi * 4 + g) * 128 + 16 * w + fr) * 4);
#pragma unroll
    for (int rr = 0; rr < 8; ++rr) gc_[rr] = 0u;
    __syncthreads();
#pragma unroll 1
    for (int n = 0; n < NCHUNK; ++n) {
        const unsigned char* rec = rec0 + (size_t)n * PREP_REC;
        const float cd = *(const float*)(rec + PREP_CD);
        { const int nn = n + 1 < NCHUNK ? n + 1 : n;
#pragma unroll
            for (int mi = 0; mi < 4; ++mi) Un[mi] = *(const f32x4*)((const float*)(rec0 + (size_t)nn * PREP_REC + PREP_UP) + (size_t)((mi * 4 + g) * 128 + 16 * w + fr) * 4);
#pragma unroll
            for (int rr = 0; rr < 8; ++rr) gn_[rr] = *(const unsigned*)(zg + (rowb + n * CHUNK + 8 * w + rr) * 2048 + 1536 + h * 128 + 2 * lane);
            if (n + 1 < NCHUNK) SC_DMA(n + 1, (n + 1) & 1); }
        if (n > 0) { const LAS unsigned* ot = (const LAS unsigned*)(F.lds + SC_OT + ((n - 1) & 1) * SC_OTSZ);
#pragma unroll
            for (int rr = 0; rr < 8; ++rr) { const int t = 8 * w + rr; const unsigned ov = ot[t * 64 + lane]; const float v0 = bflo(ov), v1 = bfhi(ov);
                const float sc = rsqrtf(wave_sum(v0 * v0 + v1 * v1) * (1.f / 128.f) + EPS);
                *(unsigned*)(mix + (rowb + (n - 1) * CHUNK + t) * 1024 + h * 128 + 2 * lane) = pk2(v0 * sc * gw2[0] * silu_f(bflo(gc_[rr])), v1 * sc * gw2[1] * silu_f(bfhi(gc_[rr]))); } }
        const LAS unsigned char* B = F.lds + (n & 1) * SC_BUFSZ + lane * 16;
        bf16x8 Sb[4];
#pragma unroll
        for (int ks = 0; ks < 4; ++ks) Sb[ks] = pack8(S[2 * ks], S[2 * ks + 1]);
        f32x4 vn[4], o[4];
#pragma unroll
        for (int mi = 0; mi < 4; ++mi) { f32x4 t1 = {0.f, 0.f, 0.f, 0.f}, oo = {0.f, 0.f, 0.f, 0.f};
#pragma unroll
            for (int ks = 0; ks < 4; ++ks) { const bf16x8 wf = *(const LAS bf16x8*)(B + PREP_WP + (mi * 4 + ks) * 1024), qf = *(const LAS bf16x8*)(B + PREP_QP + (mi * 4 + ks) * 1024);
                t1 = __builtin_amdgcn_mfma_f32_16x16x32_bf16(wf, Sb[ks], t1, 0, 0, 0); oo = __builtin_amdgcn_mfma_f32_16x16x32_bf16(qf, Sb[ks], oo, 0, 0, 0); }
            vn[mi] = Uc[mi] - t1; o[mi] = oo; }
        bf16x8 Vb[2];
#pragma unroll
        for (int ks = 0; ks < 2; ++ks) Vb[ks] = pack8(vn[2 * ks], vn[2 * ks + 1]);
        LAS bf16* otw = (LAS bf16*)(F.lds + SC_OT + (n & 1) * SC_OTSZ) + 16 * w + fr;
#pragma unroll
        for (int mi = 0; mi < 4; ++mi) {
#pragma unroll
            for (int ks = 0; ks < 2; ++ks) { const bf16x8 af = *(const LAS bf16x8*)(B + PREP_AP + (mi * 2 + ks) * 1024); o[mi] = __builtin_amdgcn_mfma_f32_16x16x32_bf16(af, Vb[ks], o[mi], 0, 0, 0); }
            const unsigned p01 = pk2(o[mi][0], o[mi][1]), p23 = pk2(o[mi][2], o[mi][3]);
            otw[(16 * mi + 4 * g) * 128] = (bf16)(p01 & 0xffffu); otw[(16 * mi + 4 * g + 1) * 128] = (bf16)(p01 >> 16); otw[(16 * mi + 4 * g + 2) * 128] = (bf16)(p23 & 0xffffu); otw[(16 * mi + 4 * g + 3) * 128] = (bf16)(p23 >> 16); }
#pragma unroll
        for (int ti = 0; ti < 8; ++ti) { f32x4 s = S[ti] * cd;
#pragma unroll
            for (int ks = 0; ks < 2; ++ks) { const bf16x8 kf = *(const LAS bf16x8*)(B + PREP_KT + (ti * 2 + ks) * 1024); s = __builtin_amdgcn_mfma_f32_16x16x32_bf16(kf, Vb[ks], s, 0, 0, 0); }
            S[ti] = s; }
        __syncthreads();
#pragma unroll
        for (int mi = 0; mi < 4; ++mi) Uc[mi] = Un[mi];
#pragma unroll
        for (int rr = 0; rr < 8; ++rr) gc_[rr] = gn_[rr];
    }
    { const LAS unsigned* ot = (const LAS unsigned*)(F.lds + SC_OT + ((NCHUNK - 1) & 1) * SC_OTSZ);
#pragma unroll
        for (int rr = 0; rr < 8; ++rr) { const int t = 8 * w + rr; const unsigned ov = ot[t * 64 + lane]; const float v0 = bflo(ov), v1 = bfhi(ov);
            const float sc = rsqrtf(wave_sum(v0 * v0 + v1 * v1) * (1.f / 128.f) + EPS);
            *(unsigned*)(mix + (rowb + (NCHUNK - 1) * CHUNK + t) * 1024 + h * 128 + 2 * lane) = pk2(v0 * sc * gw2[0] * silu_f(bflo(gc_[rr])), v1 * sc * gw2[1] * silu_f(bfhi(gc_[rr]))); } }
    __syncthreads();
#undef SC_DMA
}

constexpr int AT_OACC = 0, AT_LACC = 65536, AT_BIAS = 66560, AT_VST = 68608, AT_END = AT_VST + 8 * 4096;
__device__ __forceinline__ void attn_unit(Frame& F, const Args& a, int unit) {
    const int b = unit >> 7, h = (unit >> 4) & 7, i0 = (unit & 15) * 256; const size_t brow = (size_t)b * SEQ;
    const bf16* qb = (const bf16*)(F.ws + WS_QB); const bf16* kb = (const bf16*)(F.ws + WS_KB); const bf16* vb = (const bf16*)(F.ws + WS_VB); bf16* mix = (bf16*)(F.ws + WS_MIX);
    const float* relb = a.in[9];
    LAS float* Oacc = (LAS float*)(F.lds + AT_OACC); LAS float* lacc = (LAS float*)(F.lds + AT_LACC); LAS float* biasL = (LAS float*)(F.lds + AT_BIAS);
    LAS unsigned char* vst = F.lds + AT_VST + F.wave * 4096;
    const int tid = F.tid, lane = F.lane, c = lane & 31, hh = lane >> 5;
    for (int i = tid; i < 256 * 64 / 4; i += NTHREADS) ((LAS f32x4*)Oacc)[i] = (f32x4){0.f, 0.f, 0.f, 0.f};
    if (tid < 256) lacc[tid] = 0.f;
    if (tid < 3 * 132) { const int br = tid / 132, s = tid % 132; biasL[tid] = relb[(int)T5B[br][s] * AH + h] * LOG2E; }
    __syncthreads();
    for (int job = F.wave; job < ATT_JOBS; job += NWAVES) {
        int d, dsh, br, r, ii_base, nq;
        if (job < 8) { d = 1; dsh = 0; br = 0; r = 0; ii_base = i0 + 32 * job; nq = 32; }
        else if (job < 16) { const int jj = job - 8; d = 4; dsh = 2; br = 1; r = jj >> 1; ii_base = (i0 >> 2) + 32 * (jj & 1); nq = 32; }
        else { d = 16; dsh = 4; br = 2; r = job - 16; ii_base = i0 >> 4; nq = 16; }
        const int qi = ii_base + (c < nq ? c : nq - 1);
        const bf16* qp = qb + (brow + (size_t)(qi << dsh) + r) * 512 + h * 64 + 8 * hh;
        bf16x8 Qf[4];
#pragma unroll
        for (int ks = 0; ks < 4; ++ks) Qf[ks] = *(const bf16x8*)(qp + 16 * ks);
        f32x16 O0 = {}, O1 = {}; float lsum = 0.f;
        const LAS float* bl = biasL + br * 132;
#pragma unroll 1
        for (int kt = 0; kt < 5; ++kt) {
            const int jj_base = ii_base - 128 + 32 * kt;
            if (jj_base + 31 < 0) continue;
            const int lmax = (SEQ >> dsh) - 1; const int jk = jj_base + c, jkc = jk < 0 ? 0 : (jk > lmax ? lmax : jk);
            const bf16* kp = kb + (brow + (size_t)(jkc << dsh) + r) * 512 + h * 64 + 8 * hh;
            u32x4 vreg[4];
#pragma unroll
            for (int i = 0; i < 4; ++i) { const int vr = (lane >> 3) + 8 * i; int jv = jj_base + vr; jv = jv < 0 ? 0 : (jv > lmax ? lmax : jv);
                vreg[i] = *(const u32x4*)(vb + (brow + (size_t)(jv << dsh) + r) * 512 + h * 64 + 8 * (lane & 7)); }
            f32x16 sT = {};
#pragma unroll
            for (int ks = 0; ks < 4; ++ks) { const bf16x8 kf = *(const bf16x8*)(kp + 16 * ks); sT = __builtin_amdgcn_mfma_f32_32x32x16_bf16(kf, Qf[ks], sT, 0, 0, 0); }
#pragma unroll
            for (int i = 0; i < 4; ++i) *(LAS u32x4*)(vst + ((lane >> 3) + 8 * i) * 128 + 16 * (lane & 7)) = vreg[i];
            float p[16];
#pragma unroll
            for (int reg = 0; reg < 16; ++reg) { const int kr = (reg & 3) + 8 * (reg >> 2) + 4 * hh; const int jr = jj_base + kr; const int s = (ii_base + c) - jr;
                const bool ok = (s >= 0) && (s <= 128) && (jr >= 0) && (c < nq); const int sc_ = s < 0 ? 0 : (s > 128 ? 128 : s);
                const float e = __builtin_amdgcn_exp2f(sT[reg] + bl[sc_]); p[reg] = ok ? e : 0.f; lsum += p[reg]; }
            bf16x8 Pf[2];
#pragma unroll
            for (int s2 = 0; s2 < 2; ++s2) { u32x4 wv; wv.x = pk2(p[8 * s2], p[8 * s2 + 1]); wv.y = pk2(p[8 * s2 + 2], p[8 * s2 + 3]); wv.z = pk2(p[8 * s2 + 4], p[8 * s2 + 5]); wv.w = pk2(p[8 * s2 + 6], p[8 * s2 + 7]); Pf[s2] = __builtin_bit_cast(bf16x8, wv); }
            const int li = lane & 15, gq = lane >> 4;
#pragma unroll
            for (int s2 = 0; s2 < 2; ++s2)
#pragma unroll
                for (int ntl = 0; ntl < 2; ++ntl) {
                    const LAS unsigned char* p0 = vst + (16 * s2 + 4 * hh + (li >> 2)) * 128 + (32 * ntl + 16 * (gq & 1) + 4 * (li & 3)) * 2;
                    const s16x4 lo = __builtin_bit_cast(s16x4, __builtin_amdgcn_ds_read_tr16_b64_v4i16((LAS s16x4*)p0));
                    const s16x4 hi = __builtin_bit_cast(s16x4, __builtin_amdgcn_ds_read_tr16_b64_v4i16((LAS s16x4*)(p0 + 8 * 128)));
                    const bf16x8 vf = (bf16x8){lo[0], lo[1], lo[2], lo[3], hi[0], hi[1], hi[2], hi[3]};
                    if (ntl == 0) O0 = __builtin_amdgcn_mfma_f32_32x32x16_bf16(Pf[s2], vf, O0, 0, 0, 0); else O1 = __builtin_amdgcn_mfma_f32_32x32x16_bf16(Pf[s2], vf, O1, 0, 0, 0);
                }
        }
#pragma unroll
        for (int reg = 0; reg < 16; ++reg) { const int qrow = (reg & 3) + 8 * (reg >> 2) + 4 * hh;
            if (qrow < nq) { const int tl = (((ii_base + qrow) << dsh) + r) - i0; atomicAdd((float*)(Oacc + tl * 64 + c), O0[reg]); atomicAdd((float*)(Oacc + tl * 64 + 32 + c), O1[reg]); } }
        lsum += __shfl_xor(lsum, 32);
        if (hh == 0 && c < nq) { const int tl = (((ii_base + c) << dsh) + r) - i0; atomicAdd((float*)(lacc + tl), lsum); }
    }
    __syncthreads();
    { const int tl = tid >> 1, half = tid & 1; const float inv = ATT_JOBS ? 1.f / lacc[tl] : 1.f; const LAS f32x4* op = (const LAS f32x4*)(Oacc + tl * 64 + 32 * half);
        bf16* dst = mix + (brow + i0 + tl) * 1024 + 512 + h * 64 + 32 * half;
#pragma unroll
        for (int q = 0; q < 4; ++q) { const f32x4 x0 = op[2 * q] * inv, x1 = op[2 * q + 1] * inv; *(bf16x8*)(dst + 8 * q) = pack8(x0, x1); } }
    __syncthreads();
}

constexpr int RT_LCNT = 0, RT_BASE = 256, RT_RANK = 512;
__device__ __forceinline__ void route_phase(Frame& F, const Args& a) {
    const float* hsrc = a.out; const float* wrT = (const float*)(F.ws + WS_WRT); const float* b_r = a.in[13];
    int* te = (int*)(F.ws + WS_TE); int* tslot = (int*)(F.ws + WS_TSLOT); float* tg = (float*)(F.ws + WS_TG); int* list = (int*)(F.ws + WS_LIST); float* lrs = (float*)(F.ws + WS_LRS);
    LAS int* lcnt = (LAS int*)(F.lds + RT_LCNT); LAS int* lbase = (LAS int*)(F.lds + RT_BASE); LAS int* lrank = (LAS int*)(F.lds + RT_RANK);
    const int lane = F.lane, c = lane & 31, hh = lane >> 5;
    for (int blk = F.vcu; blk < T / 128; blk += F.G) {
        if (F.tid < 32) lcnt[F.tid] = 0;
        __syncthreads();
        int e4[4] = {0, 0, 0, 0}, rk[4] = {0, 0, 0, 0}; float g4[4] = {0.f, 0.f, 0.f, 0.f}; float rs = 0.f; const int tok = blk * 128 + (F.wave & 3) * 32 + c;
        if (F.wave < 4) {
            f32x16 acc = {}; float ss = 0.f; const float* hp = hsrc + (size_t)tok * D + 4 * hh; const float* wp = wrT + (size_t)c * D + 4 * hh;
#pragma unroll 4
            for (int q = 0; q < 128; ++q) { const f32x4 hv = *(const f32x4*)(hp + 8 * q), wv = *(const f32x4*)(wp + 8 * q);
                ss += (hv[0] * hv[0] + hv[1] * hv[1]) + (hv[2] * hv[2] + hv[3] * hv[3]);
#pragma unroll
                for (int i = 0; i < 4; ++i) acc = __builtin_amdgcn_mfma_f32_32x32x2f32(wv[i], hv[i], acc, 0, 0, 0); }
            ss += __shfl_xor(ss, 32); rs = rsqrtf(ss * (1.f / D) + EPS);
            float tv[4] = {-3.0e38f, -3.0e38f, -3.0e38f, -3.0e38f}; int tix[4] = {0, 1, 2, 3};
#pragma unroll
            for (int reg = 0; reg < 16; ++reg) { const int e = (reg & 3) + 8 * (reg >> 2) + 4 * hh; float v = acc[reg] * rs + b_r[e]; int ix = e;
#pragma unroll
                for (int s = 0; s < 4; ++s) { const bool gt = (v > tv[s]) || (v == tv[s] && ix < tix[s]); const float ov = tv[s]; const int oi = tix[s]; tv[s] = gt ? v : ov; tix[s] = gt ? ix : oi; v = gt ? ov : v; ix = gt ? oi : ix; } }
            float pv[4]; int pi[4];
#pragma unroll
            for (int s = 0; s < 4; ++s) { pv[s] = __shfl_xor(tv[s], 32); pi[s] = __shfl_xor(tix[s], 32); }
#pragma unroll
            for (int t2 = 0; t2 < 4; ++t2) { float v = pv[t2]; int ix = pi[t2];
#pragma unroll
                for (int s = 0; s < 4; ++s) { const bool gt = (v > tv[s]) || (v == tv[s] && ix < tix[s]); const float ov = tv[s]; const int oi = tix[s]; tv[s] = gt ? v : ov; tix[s] = gt ? ix : oi; v = gt ? ov : v; ix = gt ? oi : ix; } }
            const float e0 = 1.f, e1 = __expf(tv[1] - tv[0]), e2 = __expf(tv[2] - tv[0]), e3 = __expf(tv[3] - tv[0]); const float inv = 1.f / (e0 + e1 + e2 + e3);
            g4[0] = e0 * inv; g4[1] = e1 * inv; g4[2] = e2 * inv; g4[3] = e3 * inv;
#pragma unroll
            for (int s = 0; s < 4; ++s) e4[s] = tix[s];
            if (hh == 0) {
#pragma unroll
                for (int s = 0; s < 4; ++s) rk[s] = atomicAdd((int*)(lcnt + e4[s]), 1);
            }
        }
        __syncthreads();
        if (F.tid < 32) lbase[F.tid] = (int)__hip_atomic_fetch_add(F.ctl + CW_GCNT + 64 * F.tid, (unsigned)lcnt[F.tid], RLX_AGENT);
        __syncthreads();
        if (F.wave < 4 && hh == 0) {
#pragma unroll
            for (int s = 0; s < 4; ++s) { const int slot = lbase[e4[s]] + rk[s]; te[tok * 4 + s] = e4[s]; tslot[tok * 4 + s] = slot; tg[tok * 4 + s] = g4[s];
                list[(size_t)e4[s] * LCAP + slot] = tok; lrs[(size_t)e4[s] * LCAP + slot] = rs; }
        }
        __syncthreads();
    }
}
__device__ __forceinline__ int moe_tables(Frame& F) {
    LAS int* tstart = (LAS int*)(F.lds + MOE_TSTART); LAS int* lcnt = (LAS int*)(F.lds + MOE_LCNT); LAS int* texp = (LAS int*)(F.lds + MOE_TEXP);
    if (F.tid == 0) { int acc = 0; for (int e = 0; e < NE; ++e) { const int cnt = (int)__hip_atomic_load(F.ctl + CW_GCNT + 64 * e, RLX_AGENT); lcnt[e] = cnt; tstart[e] = acc; const int nt = (cnt + 255) >> 8; for (int i = 0; i < nt; ++i) texp[acc + i] = e; acc += nt; } tstart[NE] = acc; }
    __syncthreads();
    return tstart[NE];
}
__device__ __forceinline__ void combine_phase(Frame& F, const Args& a) {
    LAS int* tstart = (LAS int*)(F.lds + MOE_TSTART);
    const int* te = (const int*)(F.ws + WS_TE); const int* tslot = (const int*)(F.ws + WS_TSLOT); const float* tg = (const float*)(F.ws + WS_TG); const bf16* Y = (const bf16*)(F.ws + WS_Y);
    float* out = a.out; const int gw = F.vcu * NWAVES + F.wave, NGW = F.G * NWAVES, lane = F.lane;
    for (int t = gw; t < T; t += NGW) {
        float* op = out + (size_t)t * D + 8 * lane;
        f32x4 o[2][2];
#pragma unroll
        for (int j = 0; j < 2; ++j) { o[j][0] = *(const f32x4*)(op + 512 * j); o[j][1] = *(const f32x4*)(op + 512 * j + 4); }
#pragma unroll
        for (int s = 0; s < 4; ++s) { const int e = te[t * 4 + s]; const size_t pos = (size_t)tstart[e] * 256 + tslot[t * 4 + s]; const float gt = tg[t * 4 + s]; const bf16* yp = Y + pos * D + 8 * lane;
#pragma unroll
            for (int j = 0; j < 2; ++j) { const u32x4 w = *(const u32x4*)(yp + 512 * j);
                o[j][0] += (f32x4){bflo(w.x), bfhi(w.x), bflo(w.y), bfhi(w.y)} * gt; o[j][1] += (f32x4){bflo(w.z), bfhi(w.z), bflo(w.w), bfhi(w.w)} * gt; } }
#pragma unroll
        for (int j = 0; j < 2; ++j) { *(f32x4*)(op + 512 * j) = o[j][0]; *(f32x4*)(op + 512 * j + 4) = o[j][1]; }
    }
}

constexpr int NPHASE = 9;
__global__ void __launch_bounds__(NTHREADS, 2) hymba_fwd(Args args) {
    extern __shared__ __attribute__((aligned(16))) unsigned char lds_raw[];
    Frame F; F.lds = (LAS unsigned char*)lds_raw; F.ws = args.ws; F.ctl = (unsigned*)(args.ws + WS_CTL);
    F.tid = threadIdx.x; F.lane = F.tid & 63; F.wave = __builtin_amdgcn_readfirstlane(F.tid >> 6);
    F.G = gridDim.x; { const int bx = blockIdx.x; F.vcu = (F.G % 8 == 0) ? (bx % 8) * (F.G / 8) + bx / 8 : bx; }
    volatile LAS unsigned* MISC = (volatile LAS unsigned*)(F.lds + MISC_OFF);
    if (F.tid < 32) MISC[F.tid] = 0u;
    __syncthreads();
    XcdBarrier bar; bar.bar = F.ctl + CW_BAR; bar.x = 0; bar.st = nullptr;
    if (MK_N_LAUNCHES == 1) bar = xcd_barrier_post(F.ctl + CW_BAR, MISC + 8);
    const int lo = args.ph_lo, hi = args.ph_hi;
#define IN(k) (lo <= (k) && (k) < hi)
#define SEAM(k) do { if (IN(k) && IN((k) + 1)) xcd_barrier(bar); } while (0)

    if (IN(0)) { phase0(F, args); SEAM(0); }
    if (IN(1)) {
        pg8::Gemm g{(const bf16*)(F.ws + WS_XN), (const bf16*)(F.ws + WS_WIN), D}; pg8::StaticOrder S{T / 256, NIN / 256, F.G, (int)blockIdx.x};
        pg8::EpiInProj E{(bf16*)(F.ws + WS_ZG), (bf16*)(F.ws + WS_QB), (bf16*)(F.ws + WS_KB), (bf16*)(F.ws + WS_VB), args.in[7], args.in[8]};
        pg8::gemm_phase<pg8::EpiInProj, pg8::StaticOrder, false, true>(F.lds, g, S, E);
        SEAM(1);
    }
    if (IN(2)) {
        for (int rep = 0; rep < (DUP == 1 ? 2 : 1); ++rep)
        for (int u = F.vcu; u < NBATCH * GH * NCHUNK; u += F.G) gdn_prep_unit(F, args, u);
        SEAM(2);
    }
    if (IN(3)) {
        const int nscan = NBATCH * GH;
        if ((int)blockIdx.x < nscan && F.G > nscan) {
            for (int rep = 0; rep < (DUP == 3 ? 2 : 1); ++rep) gdn_scan(F, args, (int)blockIdx.x);
        } else if (F.G > nscan) {
            for (int rep = 0; rep < (DUP == 2 ? 2 : 1); ++rep)
            for (int u = (int)blockIdx.x - nscan; u < NBATCH * AH * 16; u += F.G - nscan) attn_unit(F, args, u);
        } else {
            for (int bh = blockIdx.x; bh < nscan; bh += F.G) gdn_scan(F, args, bh);
            for (int u = blockIdx.x; u < NBATCH * AH * 16; u += F.G) attn_unit(F, args, u);
        }
        SEAM(3);
    }
    if (IN(4)) {
        pg8::Gemm g{(const bf16*)(F.ws + WS_MIX), (const bf16*)(F.ws + WS_WOUT), D}; pg8::StaticOrder S{T / 256, D / 256, F.G, (int)blockIdx.x};
        pg8::EpiOutProj E{args.in[0], args.out, (bf16*)(F.ws + WS_HB)};
        pg8::gemm_phase<pg8::EpiOutProj, pg8::StaticOrder, false, true>(F.lds, g, S, E);
        SEAM(4);
    }
#if !SKIP_MOE
    if (IN(5)) { route_phase(F, args); SEAM(5); }
    if (IN(6)) {
        const int nM = moe_tables(F);
        pg8::Gemm g{(const bf16*)(F.ws + WS_HB), (const bf16*)(F.ws + WS_WGU), D};
        pg8::MoeOrder S{nM, 8, F.G, (int)blockIdx.x, (const LAS int*)(F.lds + MOE_TSTART), (const LAS int*)(F.lds + MOE_LCNT), (const LAS int*)(F.lds + MOE_TEXP), (const int*)(F.ws + WS_LIST)};
        pg8::EpiGateUp E{(bf16*)(F.ws + WS_ACT), args.in[15], (const float*)(F.ws + WS_LRS), (const LAS int*)(F.lds + MOE_LCNT)};
        pg8::gemm_phase<pg8::EpiGateUp, pg8::MoeOrder, true, true>(F.lds, g, S, E);
        SEAM(6);
    }
    if (IN(7)) {
        const int nM = moe_tables(F);
        pg8::Gemm g{(const bf16*)(F.ws + WS_ACT), (const bf16*)(F.ws + WS_WDN), FF};
        pg8::MoeOrder S{nM, 4, F.G, (int)blockIdx.x, (const LAS int*)(F.lds + MOE_TSTART), (const LAS int*)(F.lds + MOE_LCNT), (const LAS int*)(F.lds + MOE_TEXP), (const int*)(F.ws + WS_LIST)};
        pg8::EpiDown E{(bf16*)(F.ws + WS_Y), args.in[17]};
        pg8::gemm_phase<pg8::EpiDown, pg8::MoeOrder, false, true>(F.lds, g, S, E);
        SEAM(7);
    }
    if (IN(8)) { (void)moe_tables(F); combine_phase(F, args); }
#endif
#undef IN
#undef SEAM
}

extern "C" void kernel_launch(void* const* d_in, const int* in_sizes, int n_in, void* d_out, int out_size, void* d_ws, size_t ws_size, hipStream_t stream) {
    static int grid = 0;
    if (grid == 0) {
        if (n_in != 18 || in_sizes[0] != T * D || out_size != T * D || ws_size < WS_END) { fprintf(stderr, "kernel_launch: unexpected shapes (n_in %d, in0 %d, out %d, ws %zu)\n", n_in, n_in > 0 ? in_sizes[0] : -1, out_size, ws_size); grid = -1; return; }
        int dev = 0, cus = 0, per_cu = 0;
        if (hipGetDevice(&dev) != hipSuccess || hipDeviceGetAttribute(&cus, hipDeviceAttributeMultiprocessorCount, dev) != hipSuccess) { grid = -1; return; }
        if (hipFuncSetAttribute((const void*)hymba_fwd, hipFuncAttributeMaxDynamicSharedMemorySize, LDS_BYTES) != hipSuccess) { fprintf(stderr, "kernel_launch: hipFuncSetAttribute failed\n"); grid = -1; return; }
        if (hipOccupancyMaxActiveBlocksPerMultiprocessor(&per_cu, (const void*)hymba_fwd, NTHREADS, LDS_BYTES) != hipSuccess || per_cu < 1) { fprintf(stderr, "kernel_launch: occupancy query says %d\n", per_cu); per_cu = 1; }
        (void)hipGetLastError();
        grid = cus;
    }
    if (grid < 0) return;
    (void)hipMemsetAsync((char*)d_ws + WS_CTL, 0, CTL_ZERO_BYTES, stream);
    Args a{};
    for (int i = 0; i < 18; ++i) a.in[i] = (const float*)d_in[i];
    a.out = (float*)d_out; a.ws = (unsigned char*)d_ws;
    if (MK_N_LAUNCHES == 1) {
        a.ph_lo = 0; a.ph_hi = NPHASE; a.li = 0;
        void* kargs[] = {&a};
        hipError_t e = hipLaunchCooperativeKernel((const void*)hymba_fwd, dim3(grid), dim3(NTHREADS), kargs, LDS_BYTES, stream);
        if (e != hipSuccess) fprintf(stderr, "kernel_launch: cooperative launch failed: %s (grid %d)\n", hipGetErrorString(e), grid);
    } else {
        for (int p = 0; p < NPHASE; ++p) { a.ph_lo = p; a.ph_hi = p + 1; a.li = p; hipLaunchKernelGGL(hymba_fwd, dim3(grid), dim3(NTHREADS), LDS_BYTES, stream, a); }
    }
}
```

```cpp
#include <hip/hip_runtime.h>
#include <cstdio>
#include <cstdint>

#ifndef MK_N_LAUNCHES
#define MK_N_LAUNCHES 1
#endif
#ifndef SKIP_ATTN
#define SKIP_ATTN 0
#endif
#ifndef DUP
#define DUP 0
#endif
#ifndef ATT_JOBS
#define ATT_JOBS 32
#endif
#ifndef SKIP_MOE
#define SKIP_MOE 0
#endif

#define LAS __attribute__((address_space(3)))
#define GAS __attribute__((address_space(1)))
typedef unsigned short bf16;
typedef short bf16x8 __attribute__((ext_vector_type(8)));
typedef short s16x4 __attribute__((ext_vector_type(4)));
typedef float f32x2 __attribute__((ext_vector_type(2)));
typedef float f32x4 __attribute__((ext_vector_type(4)));
typedef float f32x16 __attribute__((ext_vector_type(16)));
typedef unsigned u32x2 __attribute__((ext_vector_type(2)));
typedef unsigned u32x4 __attribute__((ext_vector_type(4)));
typedef __bf16 bf16x2_t __attribute__((ext_vector_type(2)));
typedef int v4i_t __attribute__((ext_vector_type(4)));
typedef int v8i_t __attribute__((ext_vector_type(8)));

constexpr int NBATCH = 8, SEQ = 4096, D = 1024, T = NBATCH * SEQ;
constexpr int IN_DIM = 3592, NIN = 3584;
constexpr int GH = 4, DK = 128, CHUNK = 64, NCHUNK = SEQ / CHUNK;
constexpr int AH = 8, DH = 64;
constexpr int NE = 32, FF = 1024, LCAP = 32768;
constexpr float EPS = 1e-6f, LOG2E = 1.4426950408889634f;
constexpr int NWAVES = 8, NTHREADS = 512;

constexpr size_t MiB = 1u << 20;
constexpr size_t WS_CTL = 0, CTL_ZERO_BYTES = 1 * MiB;
constexpr size_t WS_WIN = 1 * MiB, WS_WOUT = 8 * MiB, WS_WGU = 10 * MiB, WS_WDN = 138 * MiB;
constexpr size_t WS_TE = 202 * MiB, WS_TSLOT = WS_TE + 512 * 1024, WS_TG = WS_TSLOT + 512 * 1024;
constexpr size_t WS_LIST = 204 * MiB, WS_LRS = 208 * MiB;
constexpr size_t WS_BA = 212 * MiB, WS_WRT = 213 * MiB;
constexpr size_t WS_ZG = 214 * MiB, WS_QB = 342 * MiB, WS_KB = 374 * MiB, WS_VB = 406 * MiB;
constexpr size_t WS_PREP = 438 * MiB;
constexpr int PREP_WP = 0, PREP_QP = 16384, PREP_AP = 32768, PREP_KT = 40960, PREP_UP = 57344, PREP_CD = 90112, PREP_REC = 90368;
constexpr size_t WS_OG = 616 * MiB, WS_MIX = 680 * MiB;
constexpr size_t WS_XN = 760 * MiB, WS_HB = 760 * MiB;
constexpr size_t WS_ACT = 214 * MiB, WS_Y = 486 * MiB, WS_END = 824 * MiB;
static_assert(WS_VB - WS_KB == WS_KB - WS_QB, "q/k/v stride");
static_assert(WS_PREP + (size_t)NBATCH * GH * NCHUNK * PREP_REC <= WS_OG, "prep region");
static_assert(WS_ACT + (size_t)(T * 4 + NE * 256) * FF * 2 <= WS_Y && WS_Y + (size_t)(T * 4 + NE * 256) * D * 2 <= WS_HB, "act/y regions");
constexpr int CW_TMO = 0, CW_CODE = 1, CW_ATTQ = 512, CW_GCNT = 1024  , CW_BAR = 8192;

constexpr int LDS_BYTES = 160 * 1024;
constexpr int RING_BYTES = 131072;
constexpr int TOP_OFF = LDS_BYTES - 4096;
constexpr int MISC_OFF = TOP_OFF;
constexpr int MOE_TAB_OFF = TOP_OFF + 256;
constexpr int MOE_TSTART = MOE_TAB_OFF, MOE_LCNT = MOE_TAB_OFF + 256, MOE_TEXP = MOE_TAB_OFF + 512;

#define RLX_AGENT __ATOMIC_RELAXED, __HIP_MEMORY_SCOPE_AGENT
#define LDS_WAIT() asm volatile("s_waitcnt lgkmcnt(0)" ::: "memory")
#define VM_WAIT() asm volatile("s_waitcnt vmcnt(0)" ::: "memory")
__device__ __forceinline__ unsigned pk2(float lo, float hi) { f32x2 v = {lo, hi}; bf16x2_t b = __builtin_convertvector(v, bf16x2_t); return __builtin_bit_cast(unsigned, b); }
__device__ __forceinline__ unsigned pk4_fp8(float a, float b, float c, float d) { int w = 0; w = __builtin_amdgcn_cvt_pk_fp8_f32(a, b, w, false); w = __builtin_amdgcn_cvt_pk_fp8_f32(c, d, w, true); return (unsigned)w; }
__device__ __forceinline__ float bf2f(unsigned short b) { return __uint_as_float((unsigned)b << 16); }
__device__ __forceinline__ float bflo(unsigned w) { return __uint_as_float(w << 16); }
__device__ __forceinline__ float bfhi(unsigned w) { return __uint_as_float(w & 0xffff0000u); }
__device__ __forceinline__ float wave_sum(float v) {
#pragma unroll
    for (int o = 1; o < 64; o <<= 1) v += __shfl_xor(v, o);
    return v;
}
__device__ __forceinline__ float silu_f(float x) { return x / (1.f + __expf(-x)); }
__device__ __forceinline__ float sigmoid_f(float x) { return 1.f / (1.f + __expf(-x)); }
__device__ __forceinline__ bf16x8 pack8(f32x4 a, f32x4 b) {
    u32x4 w; w.x = pk2(a[0], a[1]); w.y = pk2(a[2], a[3]); w.z = pk2(b[0], b[1]); w.w = pk2(b[2], b[3]); return __builtin_bit_cast(bf16x8, w);
}

__device__ __forceinline__ void glds16_asm(const void* gsrc, unsigned lds_dst) { unsigned keep;
    asm volatile("s_mov_b32 %0, m0\n\ts_mov_b32 m0, %2\n\ts_nop 0\n\tglobal_load_lds_dwordx4 %1, off\n\ts_mov_b32 m0, %0" : "=&s"(keep) : "v"(gsrc), "s"(lds_dst) : "memory"); }

namespace pg8 {
constexpr int BM = 256, BK = 64, HALF = 128, HTB = HALF * BK * 2, STAGE_BYTES = 8 * HTB, NXCD = 8, WGM = 8;
__host__ __device__ __forceinline__ int lds_byte(int r, int c) { const int st = (r >> 4) * 2 + (c >> 5), rr = r & 15, cc = c & 31, ob = rr * 64 + cc * 2; return st * 1024 + (ob ^ (((ob >> 9) & 1) << 5)); }
__host__ __device__ __forceinline__ void stage_rc(int b, int& R, int& C) { const int st = b / 1024, sb = b % 1024, swz = sb ^ (((sb >> 9) & 1) << 5); R = (st >> 1) * 16 + swz / 64; C = (st & 1) * 32 + (swz % 64) / 2; }
__host__ __device__ __forceinline__ int perm32(int rho) { const int n = rho >> 4, i = rho & 15; return 8 * (i >> 2) + 4 * n + (i & 3); }

struct Unit { int pm, pn, pb, e, mt; };
struct Gemm { const bf16* A; const bf16* Bt; int K; };

__device__ __forceinline__ bool static_tile(int i, int G, int c, int nM, int nN, int& pm, int& pn) {
    const int nwg = nM * nN; const long L = (long)i * G + c; if (L >= nwg) return false;
    int wgid = (int)L; { const int q = nwg / NXCD, r = nwg % NXCD, xcd = wgid % NXCD, off = wgid / NXCD; wgid = (xcd < r ? xcd * (q + 1) : r * (q + 1) + (xcd - r) * q) + off; }
    const int nig = WGM * nN, gid = wgid / nig, fm = gid * WGM, gsz = (nM - fm) < WGM ? (nM - fm) : WGM;
    pm = fm + ((wgid % nig) % gsz); pn = (wgid % nig) / gsz; return true;
}
struct StaticOrder {
    int nM, nN, G, c;
    __device__ __forceinline__ bool next(int i, Unit& u) const { int pm, pn; if (!static_tile(i, G, c, nM, nN, pm, pn)) return false; u.pm = pm; u.pn = pn; u.pb = pn; u.e = 0; u.mt = 0; return true; }
    __device__ __forceinline__ int row_index(const Unit&, int) const { return 0; }
};
struct MoeOrder {
    int nM, nN, G, c; const LAS int* tstart; const LAS int* lcnt; const LAS int* texp; const int* list;
    __device__ __forceinline__ bool next(int i, Unit& u) const {
        int pm, pn; if (!static_tile(i, G, c, nM, nN, pm, pn)) return false;
        const int e = texp[pm]; u.pm = pm; u.pn = pn; u.e = e; u.pb = e * nN + pn; u.mt = pm - tstart[e]; return true;
    }
    __device__ __forceinline__ int row_index(const Unit& u, int r) const { const int rr = u.mt * 256 + r; return rr < lcnt[u.e] ? list[u.e * LCAP + rr] : 0; }
};

#define PG8_SA(b, h) (((b) * 2 + (h)) * HTB)
#define PG8_SB(b, h) ((4 + (b) * 2 + (h)) * HTB)
#define PG8_GLDS(src, dstoff) __builtin_amdgcn_global_load_lds((const unsigned*)(src), (LAS unsigned*)(lds + (dstoff)), 16, 0, 0)
#define PG8_STAGE_B(bufoff, nx, kb, h) do { _Pragma("unroll") for (int _i = 0; _i < 2; ++_i) \
        PG8_GLDS(((nx) ? nB : cB) + (kb) + (size_t)(h) * hstep + voffB[_i], (bufoff) + ldsw + _i * 8192); } while (0)
#define PG8_STAGE_A(bufoff, nx, kb, h) do { _Pragma("unroll") for (int _i = 0; _i < 2; ++_i) \
        PG8_GLDS(GATHER ? (const char*)g.A + (kb) + ((nx) ? voffN[h][_i] : voffC[h][_i]) : ((nx) ? nA : cA) + (kb) + (size_t)(h) * hstep + voffA[_i], (bufoff) + ldsw + _i * 8192); } while (0)
#define PG8_LDA8(dst, b, h) do { _Pragma("unroll") for (int m = 0; m < 4; ++m) { const v4i_t lo_ = *(const LAS v4i_t*)(lds + PG8_SA(b, h) + aoff + m * 2048), hi_ = *(const LAS v4i_t*)(lds + PG8_SA(b, h) + aoff + m * 2048 + 1024); dst[m] = __builtin_shufflevector(lo_, hi_, 0, 1, 2, 3, 4, 5, 6, 7); } } while (0)
#define PG8_LDB8(dst, b, h) do { _Pragma("unroll") for (int n = 0; n < 2; ++n) { const v4i_t lo_ = *(const LAS v4i_t*)(lds + PG8_SB(b, h) + boff + n * 2048), hi_ = *(const LAS v4i_t*)(lds + PG8_SB(b, h) + boff + n * 2048 + 1024); dst[n] = __builtin_shufflevector(lo_, hi_, 0, 1, 2, 3, 4, 5, 6, 7); } } while (0)
#define PG8_LDA(dst, b, h) do { _Pragma("unroll") for (int m = 0; m < 4; ++m) _Pragma("unroll") for (int k = 0; k < 2; ++k) dst[m][k] = *(const LAS bf16x8*)(lds + PG8_SA(b, h) + aoff + m * 2048 + k * 1024); } while (0)
#define PG8_LDB(dst, b, h) do { _Pragma("unroll") for (int n = 0; n < 2; ++n) _Pragma("unroll") for (int k = 0; k < 2; ++k) dst[n][k] = *(const LAS bf16x8*)(lds + PG8_SB(b, h) + boff + n * 2048 + k * 1024); } while (0)
#define PG8_MMA(ai, bj, At, Bt) do { __builtin_amdgcn_s_setprio(1); _Pragma("unroll") for (int m = 0; m < 4; ++m) _Pragma("unroll") for (int n = 0; n < 2; ++n) _Pragma("unroll") for (int k = 0; k < 2; ++k) \
        acc[ai][bj][m][n] = __builtin_amdgcn_mfma_f32_16x16x32_bf16(Bt[n][k], At[m][k], acc[ai][bj][m][n], 0, 0, 0); __builtin_amdgcn_s_setprio(0); } while (0)
#define PG8_MMA8(ai, bj, At, Bt) do { __builtin_amdgcn_s_setprio(1); _Pragma("unroll") for (int m = 0; m < 4; ++m) _Pragma("unroll") for (int n = 0; n < 2; ++n) \
        asm volatile("v_mfma_scale_f32_16x16x128_f8f6f4 %0, %1, %2, %0, %3, %4 op_sel_hi:[0,0,0]" : "+v"(acc[ai][bj][m][n]) : "v"(Bt[n]), "v"(At[m]), "v"(sc_w), "v"(sc_a)); __builtin_amdgcn_s_setprio(0); } while (0)
#define XLDA(b, h) do { if constexpr (FP8) PG8_LDA8(At8, b, h); else PG8_LDA(At, b, h); } while (0)
#define XLDB0(b, h) do { if constexpr (FP8) PG8_LDB8(B08, b, h); else PG8_LDB(B0, b, h); } while (0)
#define XLDB1(b, h) do { if constexpr (FP8) PG8_LDB8(B18, b, h); else PG8_LDB(B1, b, h); } while (0)
#define XMMA0(ai, bj) do { if constexpr (FP8) PG8_MMA8(ai, bj, At8, B08); else PG8_MMA(ai, bj, At, B0); } while (0)
#define XMMA1(ai, bj) do { if constexpr (FP8) PG8_MMA8(ai, bj, At8, B18); else PG8_MMA(ai, bj, At, B1); } while (0)
#define PG8_WAIT_V(n) asm volatile("s_waitcnt vmcnt(" #n ")" ::: "memory")
#define PG8_WAIT_L(n) asm volatile("s_waitcnt lgkmcnt(" #n ")" ::: "memory")
#define PG8_BAR __builtin_amdgcn_s_barrier()
#define PG8_SCHED __builtin_amdgcn_sched_barrier(0)

template <class Epi, class Sched, bool GATHER, bool ALIGN_EPI, bool FP8 = false>
__device__ __forceinline__ void gemm_phase(LAS unsigned char* lds, const Gemm g, const Sched& S, const Epi& E) {
    const int tid = threadIdx.x, wid = __builtin_amdgcn_readfirstlane(tid >> 6), lane = tid & 63, wr = wid >> 2, wc = wid & 3, fr = lane & 15, fq = lane >> 4;
    const int K = g.K, rowb = FP8 ? K : 2 * K, nt = rowb / 128;
    unsigned voffA[2], voffB[2], voffC[2][2], voffN[2][2]; int RA[2], CA[2];
#pragma unroll
    for (int i = 0; i < 2; ++i) { int R, C; stage_rc(tid * 16 + i * 8192, R, C); const int Rb = Epi::PERM ? ((R & ~31) + perm32(R & 31)) : R;
        RA[i] = R; CA[i] = C; voffA[i] = (unsigned)(R * rowb + C * 2); voffB[i] = (unsigned)(Rb * rowb + C * 2); }
    const size_t kstep = (size_t)(BK * 2), hstep = (size_t)HALF * rowb, tstep = 2 * hstep;
    const unsigned ldsw = (unsigned)wid * 1024u;
    const int aoff = lds_byte(wr * 64 + fr, fq * 8), boff = lds_byte(wc * 32 + fr, fq * 8);
    Unit cur, nxt; int ui = 0;
    if (!S.next(0, cur)) return;
    f32x4 acc[2][2][4][2];
#pragma unroll
    for (int a = 0; a < 2; ++a)
#pragma unroll
        for (int b = 0; b < 2; ++b)
#pragma unroll
            for (int m = 0; m < 4; ++m)
#pragma unroll
                for (int n = 0; n < 2; ++n) acc[a][b][m][n] = (f32x4){0.f, 0.f, 0.f, 0.f};
    bf16x8 At[4][2], B0[2][2], B1[2][2]; v8i_t At8[4], B08[2], B18[2]; int sc_w = 0x7a7a7a7a, sc_a = 0x7f7f7f7f; asm volatile("" : "+v"(sc_w), "+v"(sc_a));
    const char* cA = (const char*)g.A + (size_t)cur.pm * tstep; const char* cB = (const char*)g.Bt + (size_t)cur.pb * tstep;
    if (GATHER) {
#pragma unroll
        for (int h = 0; h < 2; ++h)
#pragma unroll
            for (int i = 0; i < 2; ++i) { voffC[h][i] = (unsigned)(S.row_index(cur, RA[i] + 128 * h) * rowb + CA[i] * 2); voffN[h][i] = voffC[h][i]; }
    }
    const char* nA = cA; const char* nB = cB;
    PG8_STAGE_B(PG8_SB(0, 0), false, 0, 0); PG8_STAGE_B(PG8_SB(0, 1), false, 0, 1); PG8_STAGE_A(PG8_SA(0, 0), false, 0, 0); PG8_STAGE_A(PG8_SA(0, 1), false, 0, 1);
    if (wr == 1) PG8_BAR;
    PG8_WAIT_V(2); PG8_BAR;
    PG8_STAGE_B(PG8_SB(1, 0), false, kstep, 0); PG8_STAGE_A(PG8_SA(1, 0), false, kstep, 0); PG8_STAGE_B(PG8_SB(1, 1), false, kstep, 1);
    PG8_WAIT_V(6); PG8_BAR;
    for (;;) {
        const bool has_next = S.next(ui + 1, nxt);
        nA = has_next ? (const char*)g.A + (size_t)nxt.pm * tstep : cA; nB = has_next ? (const char*)g.Bt + (size_t)nxt.pb * tstep : cB;
        if (GATHER) {
#pragma unroll
            for (int h = 0; h < 2; ++h)
#pragma unroll
                for (int i = 0; i < 2; ++i) voffN[h][i] = has_next ? (unsigned)(S.row_index(nxt, RA[i] + 128 * h) * rowb + CA[i] * 2) : voffC[h][i];
        }
        for (int t = 0; t < nt; t += 2) {
            const bool last = (t == nt - 2);
            const size_t k1 = (size_t)(t + 1) * kstep, k2 = last ? 0 : (size_t)(t + 2) * kstep, k3 = k2 + kstep;
            XLDB0(0, 0); XLDB1(0, 1); PG8_SCHED; XLDA(0, 0); PG8_STAGE_A(PG8_SA(1, 1), false, k1, 1);
            PG8_WAIT_V(8); PG8_WAIT_L(0); PG8_BAR; XMMA0(0, 0); XMMA1(0, 1); PG8_BAR; PG8_SCHED;
            XLDA(0, 1); PG8_STAGE_B(PG8_SB(0, 0), last, k2, 0); PG8_STAGE_B(PG8_SB(0, 1), last, k2, 1); PG8_STAGE_A(PG8_SA(0, 0), last, k2, 0);
            PG8_WAIT_V(8); PG8_WAIT_L(0); PG8_BAR; XMMA0(1, 0); XMMA1(1, 1); PG8_BAR; PG8_SCHED;
            XLDB0(1, 0); XLDB1(1, 1); PG8_SCHED; XLDA(1, 0); PG8_STAGE_A(PG8_SA(0, 1), last, k2, 1);
            PG8_WAIT_V(8); PG8_WAIT_L(0); PG8_BAR; XMMA0(0, 0); XMMA1(0, 1); PG8_BAR; PG8_SCHED;
            XLDA(1, 1); PG8_STAGE_B(PG8_SB(1, 0), last, k3, 0); PG8_STAGE_B(PG8_SB(1, 1), last, k3, 1); PG8_STAGE_A(PG8_SA(1, 0), last, k3, 0);
            PG8_WAIT_V(8); PG8_WAIT_L(0); PG8_BAR; XMMA0(1, 0); XMMA1(1, 1); PG8_BAR; PG8_SCHED;
        }
        if constexpr (ALIGN_EPI) { if (wr == 0) PG8_BAR; }
        if constexpr (FP8) asm volatile("s_nop 15\n\ts_nop 15" ::: "memory");
        E(acc, cur, wr, wc, fr, fq);
        if (!has_next) break;
#pragma unroll
        for (int a = 0; a < 2; ++a)
#pragma unroll
            for (int b = 0; b < 2; ++b)
#pragma unroll
                for (int m = 0; m < 4; ++m)
#pragma unroll
                    for (int n = 0; n < 2; ++n) acc[a][b][m][n] = (f32x4){0.f, 0.f, 0.f, 0.f};
        cur = nxt; cA = nA; cB = nB; ++ui;
        if (GATHER) {
#pragma unroll
            for (int h = 0; h < 2; ++h)
#pragma unroll
                for (int i = 0; i < 2; ++i) voffC[h][i] = voffN[h][i];
        }
        if constexpr (ALIGN_EPI) { if (wr == 1) PG8_BAR; }
    }
    PG8_WAIT_V(0);
    if constexpr (!ALIGN_EPI) { if (wr == 0) PG8_BAR; }
    PG8_BAR;
}

struct EpiInProj {
    static constexpr bool PERM = true;
    bf16* zg; bf16* qb; bf16* kb; bf16* vb; const float* qn; const float* kn;
    __device__ __forceinline__ void operator()(const f32x4 (&acc)[2][2][4][2], const Unit& u, int wr, int wc, int fr, int fq) const {
        const int row0 = u.pm * BM + wr * 64 + fr;
        if (u.pn < 8) {
            const int col0 = u.pn * BM + wc * 32 + 8 * fq;
#pragma unroll
            for (int ai = 0; ai < 2; ++ai)
#pragma unroll
                for (int m = 0; m < 4; ++m) { bf16* rowp = zg + (size_t)(row0 + ai * HALF + m * 16) * 2048 + col0;
#pragma unroll
                    for (int bj = 0; bj < 2; ++bj) { const f32x4 v0 = acc[ai][bj][m][0], v1 = acc[ai][bj][m][1];
                        u32x4 w; w.x = pk2(v0[0], v0[1]); w.y = pk2(v0[2], v0[3]); w.z = pk2(v1[0], v1[1]); w.w = pk2(v1[2], v1[3]); *(u32x4*)(rowp + bj * HALF) = w; } }
        } else {
            const int sec = (u.pn - 8) >> 1, head = 4 * ((u.pn - 8) & 1) + wc;
            bf16* dst = qb + (size_t)sec * ((WS_KB - WS_QB) / 2); const float* nw = (sec == 1) ? kn : qn;
            f32x4 wv[2][2];
#pragma unroll
            for (int bj = 0; bj < 2; ++bj)
#pragma unroll
                for (int n = 0; n < 2; ++n) { const f32x4 t_ = *(const f32x4*)(nw + 32 * bj + 8 * fq + 4 * n); wv[bj][n] = sec == 2 ? (f32x4){1.f, 1.f, 1.f, 1.f} : t_; }
#pragma unroll
            for (int ai = 0; ai < 2; ++ai)
#pragma unroll
                for (int m = 0; m < 4; ++m) {
                    float sc = 1.f;
                    if (sec < 2) { float ss = 0.f;
#pragma unroll
                        for (int bj = 0; bj < 2; ++bj)
#pragma unroll
                            for (int n = 0; n < 2; ++n) { const f32x4 x = acc[ai][bj][m][n]; ss += (x[0] * x[0] + x[1] * x[1]) + (x[2] * x[2] + x[3] * x[3]); }
                        ss += __shfl_xor(ss, 16); ss += __shfl_xor(ss, 32);
                        sc = rsqrtf(ss * (1.f / 64.f) + EPS) * (sec == 0 ? 0.125f * LOG2E : 1.f); }
                    const int row_ = row0 + ai * HALF + m * 16; bf16* rowp = dst + ((size_t)((row_ >> 12) * AH + head) * SEQ + (row_ & (SEQ - 1))) * 64 + 8 * fq;
#pragma unroll
                    for (int bj = 0; bj < 2; ++bj) { const f32x4 v0 = acc[ai][bj][m][0] * sc * wv[bj][0], v1 = acc[ai][bj][m][1] * sc * wv[bj][1];
                        u32x4 w; w.x = pk2(v0[0], v0[1]); w.y = pk2(v0[2], v0[3]); w.z = pk2(v1[0], v1[1]); w.w = pk2(v1[2], v1[3]); *(u32x4*)(rowp + bj * 32) = w; } }
        }
    }
};
struct EpiOutProj {
    static constexpr bool PERM = false;
    const float* x; float* h; unsigned char* hb;
    __device__ __forceinline__ void operator()(const f32x4 (&acc)[2][2][4][2], const Unit& u, int wr, int wc, int fr, int fq) const {
        const int row0 = u.pm * BM + wr * 64 + fr, col0 = u.pn * BM + wc * 32 + 4 * fq;
#pragma unroll
        for (int ai = 0; ai < 2; ++ai)
#pragma unroll
            for (int m = 0; m < 4; ++m) { const size_t off = (size_t)(row0 + ai * HALF + m * 16) * D + col0;
#pragma unroll
                for (int bj = 0; bj < 2; ++bj)
#pragma unroll
                    for (int n = 0; n < 2; ++n) { const f32x4 v = *(const f32x4*)(x + off + bj * HALF + n * 16) + acc[ai][bj][m][n];
                        *(f32x4*)(h + off + bj * HALF + n * 16) = v; *(unsigned*)(hb + off + bj * HALF + n * 16) = pk4_fp8(v[0], v[1], v[2], v[3]); } }
    }
};
struct EpiGateUp {
    static constexpr bool PERM = true;
    unsigned char* act; const float* bgu; const float* lrs; const LAS int* lcnt;
    __device__ __forceinline__ void operator()(const f32x4 (&acc)[2][2][4][2], const Unit& u, int wr, int wc, int fr, int fq) const {
        const int cl = wc * 32 + 8 * fq; const float* bg = bgu + (size_t)u.e * 2048 + 128 * u.pn + cl;
        f32x4 bgv[2], buv[2];
#pragma unroll
        for (int n = 0; n < 2; ++n) { bgv[n] = *(const f32x4*)(bg + 4 * n); buv[n] = *(const f32x4*)(bg + 1024 + 4 * n); }
        const int cnt = lcnt[u.e];
#pragma unroll
        for (int ai = 0; ai < 2; ++ai)
#pragma unroll
            for (int m = 0; m < 4; ++m) { const int r = ai * HALF + wr * 64 + m * 16 + fr, rr = u.mt * 256 + r;
                const float rs = rr < cnt ? lrs[(size_t)u.e * LCAP + rr] : 0.f;
                unsigned wq[2];
#pragma unroll
                for (int n = 0; n < 2; ++n) { float a[4];
#pragma unroll
                    for (int i = 0; i < 4; ++i) { const float gt = fminf(acc[ai][0][m][n][i] * rs + bgv[n][i], 7.f); const float up = fminf(fmaxf(acc[ai][1][m][n][i] * rs + buv[n][i], -7.f), 7.f);
                        a[i] = (up + 1.f) * gt * sigmoid_f(1.702f * gt); }
                    wq[n] = pk4_fp8(a[0], a[1], a[2], a[3]); }
                *(u32x2*)(act + (size_t)(u.pm * BM + r) * FF + 128 * u.pn + cl) = (u32x2){wq[0], wq[1]}; }
    }
};
struct EpiDown {
    static constexpr bool PERM = true;
    bf16* y; const float* bdn;
    __device__ __forceinline__ void operator()(const f32x4 (&acc)[2][2][4][2], const Unit& u, int wr, int wc, int fr, int fq) const {
        const int col0 = u.pn * BM + wc * 32 + 8 * fq; const float* bp = bdn + (size_t)u.e * D + col0;
        f32x4 bv[2][2];
#pragma unroll
        for (int bj = 0; bj < 2; ++bj)
#pragma unroll
            for (int n = 0; n < 2; ++n) bv[bj][n] = *(const f32x4*)(bp + bj * HALF + 4 * n);
#pragma unroll
        for (int ai = 0; ai < 2; ++ai)
#pragma unroll
            for (int m = 0; m < 4; ++m) { bf16* rowp = y + (size_t)(u.pm * BM + ai * HALF + wr * 64 + m * 16 + fr) * D + col0;
#pragma unroll
                for (int bj = 0; bj < 2; ++bj) { const f32x4 v0 = acc[ai][bj][m][0] + bv[bj][0], v1 = acc[ai][bj][m][1] + bv[bj][1];
                    u32x4 w; w.x = pk2(v0[0], v0[1]); w.y = pk2(v0[2], v0[3]); w.z = pk2(v1[0], v1[1]); w.w = pk2(v1[2], v1[3]); *(u32x4*)(rowp + bj * HALF) = w; } }
    }
};
}

#define XB_TMO      128
#define XB_XCNT(j)  (256  + 64 * (j))
#define XB_XSUB(j)  (1280 + 64 * (j))
#define XB_XGEN(j)  (2304 + 64 * (j))
#define XB_TOP      3328
#define XB_TOPGEN   3392
#define XCD_BAR_WORDS 3456
#define XB_SPIN_CAP (1u << 20)
__device__ __forceinline__ unsigned xb_ld(unsigned* p)              { return __hip_atomic_load(p, __ATOMIC_RELAXED, __HIP_MEMORY_SCOPE_AGENT); }
__device__ __forceinline__ unsigned xb_add(unsigned* p, unsigned v) { return __hip_atomic_fetch_add(p, v, __ATOMIC_RELAXED, __HIP_MEMORY_SCOPE_AGENT); }
__device__ __forceinline__ unsigned xb_xcc_id() { return (unsigned)__builtin_amdgcn_s_getreg((3 << 11) | 20) & 0xFu; }
#define XB_SPIN(cond, bar) do { unsigned _sp = 0; while (cond) { __builtin_amdgcn_s_sleep(1); \
    if ((++_sp & 255u) == 0u) { if (xb_ld(&(bar)[XB_TMO])) break; if (_sp > XB_SPIN_CAP) { atomicAdd(&(bar)[XB_TMO], 1u); break; } } } } while (0)
struct XcdBarrier { unsigned* bar; unsigned x; volatile LAS unsigned* st; };
__device__ __forceinline__ XcdBarrier xcd_barrier_post(unsigned* bar, volatile LAS unsigned* st) {
    XcdBarrier b; b.bar = bar; b.x = xb_xcc_id(); b.st = st;
    if (threadIdx.x == 0) (void)xb_add(&bar[XB_XCNT(b.x)], 1u);
    return b;
}
__device__ __forceinline__ void xcd_barrier_complete(unsigned* bar, unsigned x, unsigned& nloc, unsigned& nx) {
    const unsigned G = gridDim.x * gridDim.y * gridDim.z;
    unsigned sum, cnt, mine, sp = 0u;
    for (;;) {
        sum = 0u; cnt = 0u; mine = 0u;
#pragma unroll
        for (unsigned j = 0; j < 16; ++j) { const unsigned c = xb_ld(&bar[XB_XCNT(j)]); sum += c; cnt += (c > 0u) ? 1u : 0u; mine = (j == x) ? c : mine; }
        if (sum == G) break;
        __builtin_amdgcn_s_sleep(1);
        if ((++sp & 255u) == 0u) { if (xb_ld(&bar[XB_TMO])) break; if (sp > XB_SPIN_CAP) { atomicAdd(&bar[XB_TMO], 1u); break; } }
    }
    nloc = mine > 0u ? mine : 1u; nx = cnt > 0u ? cnt : 1u;
}
__device__ __forceinline__ void xcd_barrier(const XcdBarrier& b) {
    asm volatile("s_waitcnt vmcnt(0)" ::: "memory");
    __syncthreads();
    if (threadIdx.x == 0) {
        unsigned* bar = b.bar;
        __builtin_amdgcn_s_waitcnt(0);
        unsigned nloc = b.st[0], nx = b.st[1];
        if (nloc == 0u) { xcd_barrier_complete(bar, b.x, nloc, nx); b.st[0] = nloc; b.st[1] = nx; }
        const unsigned old = xb_add(&bar[XB_XSUB(b.x)], 1u);
        const unsigned gen = old / nloc;
        if (old + 1u == (gen + 1u) * nloc) {
            __builtin_amdgcn_fence(__ATOMIC_RELEASE, "agent");
            asm volatile("s_waitcnt vmcnt(0)" ::: "memory");
            const unsigned og = xb_add(&bar[XB_TOP], 1u);
            const unsigned tg = og / nx;
            if (og + 1u == (tg + 1u) * nx) xb_add(&bar[XB_TOPGEN], 1u);
            else XB_SPIN(xb_ld(&bar[XB_TOPGEN]) == tg, bar);
            __builtin_amdgcn_fence(__ATOMIC_ACQUIRE, "agent");
            xb_add(&bar[XB_XGEN(b.x)], 1u);
            asm volatile("s_waitcnt vmcnt(0)" ::: "memory");
        } else {
            XB_SPIN(xb_ld(&bar[XB_XGEN(b.x)]) == gen, bar);
            __builtin_amdgcn_fence(__ATOMIC_ACQUIRE, "agent");
            asm volatile("s_waitcnt vmcnt(0)" ::: "memory");
        }
    }
    __syncthreads();
}

struct Args { const float* in[18]; float* out; unsigned char* ws; int ph_lo, ph_hi, li, pad; };
struct Frame {
    LAS unsigned char* lds; unsigned char* ws; unsigned* ctl;
    int tid, lane, wave, G, vcu;
};

__device__ const unsigned char T5B[3][132] = {
{0,1,2,3,4,5,6,7,8,9,10,11,12,13,14,15,16,16,16,16,16,16,17,17,17,17,17,17,17,17,18,18,18,18,18,18,18,18,18,18,19,19,19,19,19,19,19,19,19,19,19,19,19,19,20,20,20,20,20,20,20,20,20,20,20,20,20,20,20,20,20,20,20,21,21,21,21,21,21,21,21,21,21,21,21,21,21,21,21,21,21,21,21,21,21,21,21,21,21,22,22,22,22,22,22,22,22,22,22,22,22,22,22,22,22,22,22,22,22,22,22,22,22,22,22,22,22,22,22,0,0,0},
{0,4,8,12,16,16,17,17,18,18,19,19,19,19,20,20,20,20,20,21,21,21,21,21,21,22,22,22,22,22,22,22,22,22,23,23,23,23,23,23,23,23,23,23,23,23,24,24,24,24,24,24,24,24,24,24,24,24,24,24,24,24,25,25,25,25,25,25,25,25,25,25,25,25,25,25,25,25,25,25,25,25,25,26,26,26,26,26,26,26,26,26,26,26,26,26,26,26,26,26,26,26,26,26,26,26,26,26,26,26,26,26,26,27,27,27,27,27,27,27,27,27,27,27,27,27,27,27,27,0,0,0},
{0,16,18,19,20,21,21,22,22,23,23,23,24,24,24,24,25,25,25,25,25,26,26,26,26,26,26,26,26,27,27,27,27,27,27,27,27,27,27,28,28,28,28,28,28,28,28,28,28,28,28,28,29,29,29,29,29,29,29,29,29,29,29,29,29,29,29,29,29,29,30,30,30,30,30,30,30,30,30,30,30,30,30,30,30,30,30,30,30,30,30,30,30,30,30,31,31,31,31,31,31,31,31,31,31,31,31,31,31,31,31,31,31,31,31,31,31,31,31,31,31,31,31,31,31,31,31,31,31,0,0,0}};

template <bool SCALE, bool OUT8> __device__ __forceinline__ void p0_transpose_item(const float* W, size_t ldw, int src_col0, void* dstv, int k0, const float* kscale, LAS float* scr, int lane) {
    { const int n4 = (lane & 7) * 4, kr = lane >> 3; f32x4 v[8];
#pragma unroll
        for (int i = 0; i < 8; ++i) v[i] = *(const f32x4*)(W + (size_t)(k0 + 8 * i + kr) * ldw + src_col0 + n4);
#pragma unroll
        for (int i = 0; i < 8; ++i) { const int kk = 8 * i + kr; f32x4 x = v[i]; if (SCALE) x = x * kscale[k0 + kk]; if (OUT8) x = x * 32.f;
            scr[kk * 33 + n4] = x[0]; scr[kk * 33 + n4 + 1] = x[1]; scr[kk * 33 + n4 + 2] = x[2]; scr[kk * 33 + n4 + 3] = x[3]; } }
    LDS_WAIT(); asm volatile("" ::: "memory");
    if (OUT8) { unsigned char* dst = (unsigned char*)dstv; const int n = lane >> 1, kh = lane & 1; const LAS float* sp = scr + (32 * kh) * 33 + n; unsigned w[8];
#pragma unroll
        for (int q = 0; q < 8; ++q) w[q] = pk4_fp8(sp[(4 * q) * 33], sp[(4 * q + 1) * 33], sp[(4 * q + 2) * 33], sp[(4 * q + 3) * 33]);
        *(u32x4*)(dst + (size_t)n * 1024 + k0 + 32 * kh) = (u32x4){w[0], w[1], w[2], w[3]}; *(u32x4*)(dst + (size_t)n * 1024 + k0 + 32 * kh + 16) = (u32x4){w[4], w[5], w[6], w[7]};
    } else { bf16* dst = (bf16*)dstv; const int c = lane & 7;
#pragma unroll
        for (int j = 0; j < 4; ++j) { const int n = (lane >> 3) + 8 * j; const LAS float* sp = scr + (8 * c) * 33 + n;
            u32x4 o; o.x = pk2(sp[0 * 33], sp[1 * 33]); o.y = pk2(sp[2 * 33], sp[3 * 33]); o.z = pk2(sp[4 * 33], sp[5 * 33]); o.w = pk2(sp[6 * 33], sp[7 * 33]);
            *(u32x4*)(dst + (size_t)n * 1024 + k0 + 8 * c) = o; } }
    LDS_WAIT(); asm volatile("" ::: "memory");
}
__device__ __forceinline__ void phase0(Frame& F, const Args& a) {
    const float* x = a.in[0]; const float* n1 = a.in[1]; const float* w_in = a.in[2]; const float* w_out = a.in[10]; const float* n2 = a.in[11];
    const float* w_r = a.in[12]; const float* w_gu = a.in[14]; const float* w_dn = a.in[16];
    bf16* Win_t = (bf16*)(F.ws + WS_WIN); bf16* Wout_t = (bf16*)(F.ws + WS_WOUT); bf16* Wgu_t = (bf16*)(F.ws + WS_WGU); bf16* Wdn_t = (bf16*)(F.ws + WS_WDN);
    float* wrT = (float*)(F.ws + WS_WRT); bf16* XN = (bf16*)(F.ws + WS_XN); float* BA = (float*)(F.ws + WS_BA);
    LAS float* scr = (LAS float*)(F.lds + F.wave * 16384);
    const int gw = F.vcu * NWAVES + F.wave, NGW = F.G * NWAVES;
    for (int m = gw; m < T; m += NGW) {
        const f32x4* xr = (const f32x4*)(x + (size_t)m * D) + F.lane; f32x4 v[4]; float s = 0.f;
#pragma unroll
        for (int j = 0; j < 4; ++j) { v[j] = xr[64 * j]; s += (v[j][0] * v[j][0] + v[j][1] * v[j][1]) + (v[j][2] * v[j][2] + v[j][3] * v[j][3]); }
        const float rs = rsqrtf(wave_sum(s) * (1.f / D) + EPS);
        float ba[8];
#pragma unroll
        for (int c = 0; c < 8; ++c) ba[c] = 0.f;
        unsigned long long* o8 = (unsigned long long*)(XN + (size_t)m * D) + F.lane;
#pragma unroll
        for (int j = 0; j < 4; ++j) { const f32x4 w = *((const f32x4*)n1 + F.lane + 64 * j); v[j] = v[j] * rs * w;
            o8[64 * j] = (unsigned long long)pk2(v[j][0], v[j][1]) | ((unsigned long long)pk2(v[j][2], v[j][3]) << 32);
#pragma unroll
            for (int i = 0; i < 4; ++i) { const float* wp = w_in + (size_t)(4 * F.lane + 256 * j + i) * IN_DIM + 2048; const f32x4 w0 = *(const f32x4*)wp, w1 = *(const f32x4*)(wp + 4);
                ba[0] += v[j][i] * w0[0]; ba[1] += v[j][i] * w0[1]; ba[2] += v[j][i] * w0[2]; ba[3] += v[j][i] * w0[3];
                ba[4] += v[j][i] * w1[0]; ba[5] += v[j][i] * w1[1]; ba[6] += v[j][i] * w1[2]; ba[7] += v[j][i] * w1[3]; } }
#pragma unroll
        for (int c = 0; c < 8; ++c) ba[c] = wave_sum(ba[c]);
        if (F.lane == 0) { *(f32x4*)(BA + (size_t)m * 8) = (f32x4){ba[0], ba[1], ba[2], ba[3]}; *(f32x4*)(BA + (size_t)m * 8 + 4) = (f32x4){ba[4], ba[5], ba[6], ba[7]}; }
    }
    for (int i = (F.vcu * NTHREADS + F.tid); i < NE * D; i += F.G * NTHREADS) { const int e = i >> 10, k = i & 1023; wrT[i] = n2[k] * w_r[k * NE + e]; }
    constexpr int I_IN = 16 * (NIN / 32), I_OUT = 16 * 32, I_GU = NE * 16 * 64, I_DN = NE * 16 * 32, NITEMS = I_IN + I_OUT + I_GU + I_DN;
    for (int it = gw; it < NITEMS; it += NGW) {
        int r = it;
        if (r < I_IN) { const int nb = r % (NIN / 32), kb = r / (NIN / 32), np = 32 * nb; int src;
            if (np < 2048) src = np; else { const int q = np - 2048, sec = q >> 9, rem = q & 511, pt = rem >> 8, lc = rem & 255, bj = lc >> 7, wc = (lc & 127) >> 5; src = 2056 + sec * 512 + (4 * pt + wc) * 64 + 32 * bj; }
            p0_transpose_item<false, false>(w_in, IN_DIM, src, Win_t + (size_t)np * 1024, 64 * kb, nullptr, scr, F.lane); continue; }
        r -= I_IN;
        if (r < I_OUT) { const int nb = r & 31, kb = r >> 5; p0_transpose_item<false, false>(w_out, D, 32 * nb, Wout_t + (size_t)(32 * nb) * 1024, 64 * kb, nullptr, scr, F.lane); continue; }
        r -= I_OUT;
        if (r < I_GU) { const int e = r >> 10, q = r & 1023, nb = q & 63, kb = q >> 6, np = 32 * nb, ntile = np >> 8, lc = np & 255, bj = lc >> 7, j0 = lc & 127;
            p0_transpose_item<true, true>(w_gu + (size_t)e * D * 2048, 2048, bj * 1024 + 128 * ntile + j0, (unsigned char*)Wgu_t + ((size_t)e * 2048 + np) * 1024, 64 * kb, n2, scr, F.lane); continue; }
        r -= I_GU;
        { const int e = r >> 9, q = r & 511, nb = q & 31, kb = q >> 5; p0_transpose_item<false, true>(w_dn + (size_t)e * FF * D, D, 32 * nb, (unsigned char*)Wdn_t + ((size_t)e * 1024 + 32 * nb) * 1024, 64 * kb, nullptr, scr, F.lane); }
    }
}

constexpr int GP = 132;
constexpr int GQ_OFF = 0, GK_OFF = 64 * GP * 4, GV_OFF = 2 * 64 * GP * 4, GW_OFF = 3 * 64 * GP * 4, GAT_OFF = 4 * 64 * GP * 4, GAT_P = 68;
constexpr int GRAW_OFF = GW_OFF, GRAW_BYTES = 67 * 768;
constexpr int GGC_OFF = GRAW_OFF + GRAW_BYTES, GBETA_OFF = GGC_OFF + 256, GEND = GBETA_OFF + 256;
static_assert(GAT_OFF + 64 * GAT_P * 4 <= GGC_OFF && GEND <= TOP_OFF, "gdn prep LDS");
__device__ __forceinline__ int permpos(int cc) { return 8 * ((cc & 15) >> 2) + (cc & 3) + 4 * (cc >> 4); }
__device__ __forceinline__ void gdn_prep_unit(Frame& F, const Args& a, int unit) {
    const bf16* zg = (const bf16*)(F.ws + WS_ZG); const float* BA = (const float*)(F.ws + WS_BA);
    const float* convw = a.in[3]; const float* a_log = a.in[4]; const float* dt_bias = a.in[5];
    const int b = unit >> 8, h = (unit >> 6) & 3, n = unit & 63; const int row0 = b * SEQ + n * CHUNK;
    unsigned char* rec = F.ws + WS_PREP + (size_t)unit * PREP_REC;
    LAS float* Qs = (LAS float*)(F.lds + GQ_OFF); LAS float* Ks = (LAS float*)(F.lds + GK_OFF); LAS float* Vs = (LAS float*)(F.lds + GV_OFF); LAS float* Ws = (LAS float*)(F.lds + GW_OFF);
    LAS float* AT = (LAS float*)(F.lds + GAT_OFF); LAS float* gcs = (LAS float*)(F.lds + GGC_OFF); LAS float* betas = (LAS float*)(F.lds + GBETA_OFF);
    LAS unsigned char* raw = F.lds + GRAW_OFF;
    const int tid = F.tid, lane = F.lane, wave = F.wave;
    for (int e = tid; e < 67 * 48; e += NTHREADS) { const int rr = e / 48, ch = e % 48; const int tt = n * CHUNK + rr - 3;
        u32x4 v = {0u, 0u, 0u, 0u}; if (tt >= 0) v = *(const u32x4*)(zg + (size_t)(row0 + rr - 3) * 2048 + (ch >> 4) * 512 + h * 128 + (ch & 15) * 8);
        *(LAS u32x4*)(raw + rr * 768 + ch * 16) = v; }
    if (wave == 0) {
        const float bl = BA[(size_t)(row0 + lane) * 8 + h], al = BA[(size_t)(row0 + lane) * 8 + 4 + h];
        const float xx = al + dt_bias[h]; const float sp = xx > 20.f ? xx : log1pf(__expf(xx));
        float g = -__expf(a_log[h]) * sp;
#pragma unroll
        for (int o = 1; o < 64; o <<= 1) { const float u = __shfl_up(g, o); if (lane >= o) g += u; }
        gcs[lane] = g; betas[lane] = sigmoid_f(bl);
    }
    __syncthreads();
    if (tid < 384) { const int cp = tid % 192, tp = tid / 192; const int ten = cp >> 6, c = (cp & 63) * 2; const int ch = ten * 512 + h * 128 + c;
        f32x2 cw[4];
#pragma unroll
        for (int k = 0; k < 4; ++k) cw[k] = *(const f32x2*)(convw + k * 1536 + ch);
        LAS float* dst = (ten == 0 ? Qs : (ten == 1 ? Ks : Vs)) + c;
        for (int t = tp; t < 64; t += 2) { float a0 = 0.f, a1 = 0.f;
#pragma unroll
            for (int k = 0; k < 4; ++k) { const unsigned w = *(const LAS unsigned*)(raw + (t + k) * 768 + cp * 4); a0 += bflo(w) * cw[k][0]; a1 += bfhi(w) * cw[k][1]; }
            *(LAS f32x2*)(dst + t * GP) = (f32x2){silu_f(a0), silu_f(a1)}; } }
    __syncthreads();
    for (int rr = 0; rr < 8; ++rr) { const int t = wave * 8 + rr;
        f32x2 q = *(LAS f32x2*)(Qs + t * GP + 2 * lane), k = *(LAS f32x2*)(Ks + t * GP + 2 * lane);
        const float sq = wave_sum(q[0] * q[0] + q[1] * q[1]), sk = wave_sum(k[0] * k[0] + k[1] * k[1]);
        const float fq_ = rsqrtf(sq + EPS) * 0.08838834764831845f, fk_ = rsqrtf(sk + EPS);
        *(LAS f32x2*)(Qs + t * GP + 2 * lane) = q * fq_; *(LAS f32x2*)(Ks + t * GP + 2 * lane) = k * fk_; }
    __syncthreads();
    {
        const int which = wave >> 2, ti = (wave >> 1) & 1, tj = wave & 1, r32 = lane & 31, hh = lane >> 5;
        const LAS float* Xa = (which ? Qs : Ks) + (32 * ti + r32) * GP + 8 * hh; const LAS float* Xb = Ks + (32 * tj + r32) * GP + 8 * hh;
        f32x16 acc = {};
#pragma unroll
        for (int ks = 0; ks < 8; ++ks) { const bf16x8 af = pack8(*(const LAS f32x4*)(Xa + 16 * ks), *(const LAS f32x4*)(Xa + 16 * ks + 4)), bf = pack8(*(const LAS f32x4*)(Xb + 16 * ks), *(const LAS f32x4*)(Xb + 16 * ks + 4));
            acc = __builtin_amdgcn_mfma_f32_32x32x16_bf16(af, bf, acc, 0, 0, 0); }
        const int j = 32 * tj + r32; const float gj = gcs[j];
        bf16* Af = (bf16*)(rec + PREP_AP); const int jpos = permpos(j & 31); const int afo = (j >> 5) * 512 + (jpos >> 3) * 128 + (jpos & 7);
#pragma unroll
        for (int q = 0; q < 4; ++q) { float vals[4];
#pragma unroll
            for (int rr = 0; rr < 4; ++rr) { const int i = 32 * ti + 8 * q + 4 * hh + rr; const float dec = __expf(fminf(gcs[i] - gj, 0.f));
                if (which == 0) vals[rr] = i > j ? betas[i] * acc[4 * q + rr] * dec : 0.f;
                else { const float v = i >= j ? acc[4 * q + rr] * dec : 0.f; Af[(i >> 4) * 1024 + (i & 15) * 8 + afo] = (bf16)(pk2(v, 0.f) & 0xffffu); } }
            if (which == 0) *(LAS f32x4*)(AT + j * GAT_P + 32 * ti + 8 * q + 4 * hh) = (f32x4){vals[0], vals[1], vals[2], vals[3]}; }
        for (int e = tid; e < 64 * 32; e += NTHREADS) { const int t = e >> 5, c = (e & 31) * 4; const float bt = betas[t], eg = bt * __expf(gcs[t]);
            *(LAS f32x4*)(Vs + t * GP + c) = *(LAS f32x4*)(Vs + t * GP + c) * bt; *(LAS f32x4*)(Ws + t * GP + c) = *(LAS f32x4*)(Ks + t * GP + c) * eg; }
    }
    __syncthreads();
    if (tid < 256) {
        LAS float* X = (tid < 128 ? Vs : Ws) + (tid & 127);
#pragma unroll 1
        for (int ib = 0; ib < 4; ++ib) { const int i0 = 16 * ib; float r[16];
#pragma unroll
            for (int ii = 0; ii < 16; ++ii) r[ii] = X[(i0 + ii) * GP];
#pragma unroll 1
            for (int j = 0; j < i0; ++j) { const float xj = X[j * GP]; const LAS f32x4* ap = (const LAS f32x4*)(AT + j * GAT_P + i0);
#pragma unroll
                for (int q = 0; q < 4; ++q) { const f32x4 av = ap[q]; r[4 * q] -= av[0] * xj; r[4 * q + 1] -= av[1] * xj; r[4 * q + 2] -= av[2] * xj; r[4 * q + 3] -= av[3] * xj; } }
#pragma unroll
            for (int j = 0; j < 16; ++j) { const float xj = r[j]; const LAS f32x4* ap = (const LAS f32x4*)(AT + (i0 + j) * GAT_P + i0); float av[16];
#pragma unroll
                for (int q = 0; q < 4; ++q) { const f32x4 t4 = ap[q]; av[4 * q] = t4[0]; av[4 * q + 1] = t4[1]; av[4 * q + 2] = t4[2]; av[4 * q + 3] = t4[3]; }
#pragma unroll
                for (int ii = 0; ii < 16; ++ii) if (ii > j) r[ii] -= av[ii] * xj; }
#pragma unroll
            for (int ii = 0; ii < 16; ++ii) X[(i0 + ii) * GP] = r[ii]; }
    } else {
        const int t2 = tid - 256; bf16* Qf = (bf16*)(rec + PREP_QP); bf16* Kf = (bf16*)(rec + PREP_KT); const float gl = gcs[63];
        for (int it = t2; it < 1024; it += 256) { const int blk = it >> 6, l = it & 63, mi = blk >> 2, ks = blk & 3, g = l >> 4, c = 16 * mi + (l & 15); const float eg = __expf(gcs[c]);
            const f32x4 lo = *(LAS f32x4*)(Qs + c * GP + 32 * ks + 4 * g) * eg, hi = *(LAS f32x4*)(Qs + c * GP + 32 * ks + 16 + 4 * g) * eg;
            *(bf16x8*)(Qf + it * 8) = pack8(lo, hi); }
        for (int it = t2; it < 1024; it += 256) { const int blk = it >> 6, l = it & 63, ti = blk >> 1, ks2 = blk & 1, g = l >> 4, dk = 16 * ti + (l & 15); float v[8];
#pragma unroll
            for (int j = 0; j < 8; ++j) { const int c = 32 * ks2 + (j < 4 ? 4 * g + j : 16 + 4 * g + (j - 4)); v[j] = Ks[c * GP + dk] * __expf(gl - gcs[c]); }
            *(bf16x8*)(Kf + it * 8) = pack8((f32x4){v[0], v[1], v[2], v[3]}, (f32x4){v[4], v[5], v[6], v[7]}); }
        if (t2 == 0) *(float*)(rec + PREP_CD) = __expf(gl);
    }
    __syncthreads();
    { float* Up = (float*)(rec + PREP_UP); bf16* Wf = (bf16*)(rec + PREP_WP);
        for (int it = tid; it < 2048; it += NTHREADS) { const int dv = it & 127, g = (it >> 7) & 3, mi = it >> 9; const int c0 = 16 * mi + 4 * g;
            *(f32x4*)(Up + (size_t)it * 4) = (f32x4){Vs[c0 * GP + dv], Vs[(c0 + 1) * GP + dv], Vs[(c0 + 2) * GP + dv], Vs[(c0 + 3) * GP + dv]}; }
        for (int it = tid; it < 1024; it += NTHREADS) { const int blk = it >> 6, l = it & 63, mi = blk >> 2, ks = blk & 3, g = l >> 4, c = 16 * mi + (l & 15);
            *(bf16x8*)(Wf + it * 8) = pack8(*(LAS f32x4*)(Ws + c * GP + 32 * ks + 4 * g), *(LAS f32x4*)(Ws + c * GP + 32 * ks + 16 + 4 * g)); }
    }
    __syncthreads();
}

constexpr int SC_BUFSZ = 57344, SC_OT = 2 * SC_BUFSZ, SC_OTSZ = 64 * 128 * 2, SC_END = SC_OT + 2 * SC_OTSZ;
static_assert(SC_END <= TOP_OFF, "scan LDS");
__device__ __forceinline__ void gdn_scan(Frame& F, const Args& a, int bh) {
    const int tid = F.tid, lane = F.lane, w = F.wave, fr = lane & 15, g = lane >> 4; const int b = bh >> 2, h = bh & 3;
    const unsigned char* rec0 = F.ws + WS_PREP + (size_t)bh * NCHUNK * PREP_REC;
    const float* gnw = a.in[6]; const bf16* zg = (const bf16*)(F.ws + WS_ZG); bf16* mix = (bf16*)(F.ws + WS_MIX);
    const f32x2 gw2 = *(const f32x2*)(gnw + 2 * lane);
    const size_t rowb = (size_t)b * SEQ; const unsigned lds0 = (unsigned)(uintptr_t)F.lds;
#define SC_DMA(n_, buf_) do { const unsigned char* src_ = rec0 + (size_t)(n_) * PREP_REC + tid * 16; _Pragma("unroll") for (int r_ = 0; r_ < 7; ++r_) \
        glds16_asm(src_ + r_ * 8192, (unsigned)__builtin_amdgcn_readfirstlane((int)(lds0 + (buf_) * SC_BUFSZ + r_ * 8192 + w * 1024))); } while (0)
    f32x4 S[8];
#pragma unroll
    for (int i = 0; i < 8; ++i) S[i] = (f32x4){0.f, 0.f, 0.f, 0.f};
    f32x4 Uc[4], Un[4]; unsigned gc_[8], gn_[8]; float cd = *(const float*)(rec0 + PREP_CD), cdn;
    SC_DMA(0, 0);
#pragma unroll
    for (int mi = 0; mi < 4; ++mi) Uc[mi] = *(const f32x4*)((const float*)(rec0 + PREP_UP) + (size_t)((mi * 4 + g) * 128 + 16 * w + fr) * 4);
#pragma unroll
    for (int rr = 0; rr < 8; ++rr) gc_[rr] = 0u;
    VM_WAIT(); __syncthreads();
#pragma unroll 1
    for (int n = 0; n < NCHUNK; ++n) {
        { const int nn = n + 1 < NCHUNK ? n + 1 : n; cdn = *(const float*)(rec0 + (size_t)nn * PREP_REC + PREP_CD);
#pragma unroll
            for (int mi = 0; mi < 4; ++mi) Un[mi] = *(const f32x4*)((const float*)(rec0 + (size_t)nn * PREP_REC + PREP_UP) + (size_t)((mi * 4 + g) * 128 + 16 * w + fr) * 4);
#pragma unroll
            for (int rr = 0; rr < 8; ++rr) gn_[rr] = *(const unsigned*)(zg + (rowb + n * CHUNK + 8 * w + rr) * 2048 + 1536 + h * 128 + 2 * lane);
            if (n + 1 < NCHUNK) SC_DMA(n + 1, (n + 1) & 1); }
        if (n > 0) { const LAS unsigned* ot = (const LAS unsigned*)(F.lds + SC_OT + ((n - 1) & 1) * SC_OTSZ);
#pragma unroll
            for (int rr = 0; rr < 8; ++rr) { const int t = 8 * w + rr; const unsigned ov = ot[t * 64 + lane]; const float v0 = bflo(ov), v1 = bfhi(ov);
                const float sc = rsqrtf(wave_sum(v0 * v0 + v1 * v1) * (1.f / 128.f) + EPS);
                *(unsigned*)(mix + (rowb + (n - 1) * CHUNK + t) * 1024 + h * 128 + 2 * lane) = pk2(v0 * sc * gw2[0] * silu_f(bflo(gc_[rr])), v1 * sc * gw2[1] * silu_f(bfhi(gc_[rr]))); } }
        const LAS unsigned char* B = F.lds + (n & 1) * SC_BUFSZ + lane * 16;
        bf16x8 Sb[4];
#pragma unroll
        for (int ks = 0; ks < 4; ++ks) Sb[ks] = pack8(S[2 * ks], S[2 * ks + 1]);
        f32x4 vn[4], o[4];
#pragma unroll
        for (int mi = 0; mi < 4; ++mi) { f32x4 t1 = {0.f, 0.f, 0.f, 0.f}, oo = {0.f, 0.f, 0.f, 0.f};
#pragma unroll
            for (int ks = 0; ks < 4; ++ks) { const bf16x8 wf = *(const LAS bf16x8*)(B + PREP_WP + (mi * 4 + ks) * 1024), qf = *(const LAS bf16x8*)(B + PREP_QP + (mi * 4 + ks) * 1024);
                t1 = __builtin_amdgcn_mfma_f32_16x16x32_bf16(wf, Sb[ks], t1, 0, 0, 0); oo = __builtin_amdgcn_mfma_f32_16x16x32_bf16(qf, Sb[ks], oo, 0, 0, 0); }
            vn[mi] = Uc[mi] - t1; o[mi] = oo; }
        bf16x8 Vb[2];
#pragma unroll
        for (int ks = 0; ks < 2; ++ks) Vb[ks] = pack8(vn[2 * ks], vn[2 * ks + 1]);
        LAS bf16* otw = (LAS bf16*)(F.lds + SC_OT + (n & 1) * SC_OTSZ) + 16 * w + fr;
#pragma unroll
        for (int mi = 0; mi < 4; ++mi) {
#pragma unroll
            for (int ks = 0; ks < 2; ++ks) { const bf16x8 af = *(const LAS bf16x8*)(B + PREP_AP + (mi * 2 + ks) * 1024); o[mi] = __builtin_amdgcn_mfma_f32_16x16x32_bf16(af, Vb[ks], o[mi], 0, 0, 0); }
            const unsigned p01 = pk2(o[mi][0], o[mi][1]), p23 = pk2(o[mi][2], o[mi][3]);
            otw[(16 * mi + 4 * g) * 128] = (bf16)(p01 & 0xffffu); otw[(16 * mi + 4 * g + 1) * 128] = (bf16)(p01 >> 16); otw[(16 * mi + 4 * g + 2) * 128] = (bf16)(p23 & 0xffffu); otw[(16 * mi + 4 * g + 3) * 128] = (bf16)(p23 >> 16); }
#pragma unroll
        for (int ti = 0; ti < 8; ++ti) { f32x4 s = S[ti] * cd;
#pragma unroll
            for (int ks = 0; ks < 2; ++ks) { const bf16x8 kf = *(const LAS bf16x8*)(B + PREP_KT + (ti * 2 + ks) * 1024); s = __builtin_amdgcn_mfma_f32_16x16x32_bf16(kf, Vb[ks], s, 0, 0, 0); }
            S[ti] = s; }
        VM_WAIT(); __syncthreads();
#pragma unroll
        for (int mi = 0; mi < 4; ++mi) Uc[mi] = Un[mi];
#pragma unroll
        for (int rr = 0; rr < 8; ++rr) gc_[rr] = gn_[rr];
        cd = cdn;
    }
    { const LAS unsigned* ot = (const LAS unsigned*)(F.lds + SC_OT + ((NCHUNK - 1) & 1) * SC_OTSZ);
#pragma unroll
        for (int rr = 0; rr < 8; ++rr) { const int t = 8 * w + rr; const unsigned ov = ot[t * 64 + lane]; const float v0 = bflo(ov), v1 = bfhi(ov);
            const float sc = rsqrtf(wave_sum(v0 * v0 + v1 * v1) * (1.f / 128.f) + EPS);
            *(unsigned*)(mix + (rowb + (NCHUNK - 1) * CHUNK + t) * 1024 + h * 128 + 2 * lane) = pk2(v0 * sc * gw2[0] * silu_f(bflo(gc_[rr])), v1 * sc * gw2[1] * silu_f(bfhi(gc_[rr]))); } }
    __syncthreads();
#undef SC_DMA
}

constexpr int AT_OACC = 0, AT_LACC = 65536, AT_BIAS = 66560, AT_VST = 68608, AT_END = AT_VST + 8 * 4096;
__device__ __forceinline__ void attn_unit(Frame& F, const Args& a, int unit) {
    const int b = unit >> 7, h = (unit >> 4) & 7, i0 = (unit & 15) * 256; const size_t brow = (size_t)b * SEQ;
    const bf16* qb = (const bf16*)(F.ws + WS_QB); const bf16* kb = (const bf16*)(F.ws + WS_KB); const bf16* vb = (const bf16*)(F.ws + WS_VB); bf16* mix = (bf16*)(F.ws + WS_MIX);
    const float* relb = a.in[9];
    LAS float* Oacc = (LAS float*)(F.lds + AT_OACC); LAS float* lacc = (LAS float*)(F.lds + AT_LACC); LAS float* biasL = (LAS float*)(F.lds + AT_BIAS);
    LAS unsigned char* vst = F.lds + AT_VST + F.wave * 4096;
    const int tid = F.tid, lane = F.lane, c = lane & 31, hh = lane >> 5;
    for (int i = tid; i < 256 * 64 / 4; i += NTHREADS) ((LAS f32x4*)Oacc)[i] = (f32x4){0.f, 0.f, 0.f, 0.f};
    if (tid < 256) lacc[tid] = 0.f;
    if (tid < 3 * 132) { const int br = tid / 132, s = tid % 132; biasL[tid] = relb[(int)T5B[br][s] * AH + h] * LOG2E; }
    __syncthreads();
    for (int job = F.wave; job < ATT_JOBS; job += NWAVES) {
        int d, dsh, br, r, ii_base, nq;
        if (job < 8) { d = 1; dsh = 0; br = 0; r = 0; ii_base = i0 + 32 * job; nq = 32; }
        else if (job < 16) { const int jj = job - 8; d = 4; dsh = 2; br = 1; r = jj >> 1; ii_base = (i0 >> 2) + 32 * (jj & 1); nq = 32; }
        else { d = 16; dsh = 4; br = 2; r = job - 16; ii_base = i0 >> 4; nq = 16; }
        const int qi = ii_base + (c < nq ? c : nq - 1);
        const size_t hrow = (size_t)(b * AH + h) * SEQ;
        const bf16* qp = qb + (hrow + (size_t)(qi << dsh) + r) * 64 + 8 * hh;
        bf16x8 Qf[4];
#pragma unroll
        for (int ks = 0; ks < 4; ++ks) Qf[ks] = *(const bf16x8*)(qp + 16 * ks);
        f32x16 O0 = {}, O1 = {}; float lsum = 0.f;
        const LAS float* bl = biasL + br * 132;
        const int lmax = (SEQ >> dsh) - 1; const int kt0 = (128 - ii_base) > 0 ? ((128 - ii_base) >> 5) : 0;
        const bf16* kbase = kb + (hrow + r) * 64 + 8 * hh; const bf16* vbase = vb + (hrow + r) * 64 + 8 * (lane & 7);
#define AT_LOADKV(kt_, Kd, Vd) do { const int jb_ = ii_base - 128 + 32 * (kt_); int jk_ = jb_ + c; jk_ = jk_ < 0 ? 0 : (jk_ > lmax ? lmax : jk_); const bf16* kp_ = kbase + ((size_t)(jk_ << dsh)) * 64; \
            _Pragma("unroll") for (int ks = 0; ks < 4; ++ks) Kd[ks] = *(const bf16x8*)(kp_ + 16 * ks); \
            _Pragma("unroll") for (int i = 0; i < 4; ++i) { int jv_ = jb_ + (lane >> 3) + 8 * i; jv_ = jv_ < 0 ? 0 : (jv_ > lmax ? lmax : jv_); Vd[i] = *(const u32x4*)(vbase + ((size_t)(jv_ << dsh)) * 64); } } while (0)
        bf16x8 Kc[4], Kn[4]; u32x4 Vc[4], Vn[4];
        AT_LOADKV(kt0, Kc, Vc);
#pragma unroll 1
        for (int kt = kt0; kt < 5; ++kt) {
            const int jj_base = ii_base - 128 + 32 * kt;
            if (kt + 1 < 5) AT_LOADKV(kt + 1, Kn, Vn);
            f32x16 sT = {};
#pragma unroll
            for (int ks = 0; ks < 4; ++ks) sT = __builtin_amdgcn_mfma_f32_32x32x16_bf16(Kc[ks], Qf[ks], sT, 0, 0, 0);
#pragma unroll
            for (int i = 0; i < 4; ++i) *(LAS u32x4*)(vst + ((lane >> 3) + 8 * i) * 128 + 16 * (lane & 7)) = Vc[i];
            float p[16];
#pragma unroll
            for (int reg = 0; reg < 16; ++reg) { const int kr = (reg & 3) + 8 * (reg >> 2) + 4 * hh; const int jr = jj_base + kr; const int s = (ii_base + c) - jr;
                const bool ok = (s >= 0) && (s <= 128) && (jr >= 0) && (c < nq); const int sc_ = s < 0 ? 0 : (s > 128 ? 128 : s);
                const float e = __builtin_amdgcn_exp2f(sT[reg] + bl[sc_]); p[reg] = ok ? e : 0.f; lsum += p[reg]; }
            bf16x8 Pf[2];
#pragma unroll
            for (int s2 = 0; s2 < 2; ++s2) { u32x4 wv; wv.x = pk2(p[8 * s2], p[8 * s2 + 1]); wv.y = pk2(p[8 * s2 + 2], p[8 * s2 + 3]); wv.z = pk2(p[8 * s2 + 4], p[8 * s2 + 5]); wv.w = pk2(p[8 * s2 + 6], p[8 * s2 + 7]); Pf[s2] = __builtin_bit_cast(bf16x8, wv); }
            const int li = lane & 15, gq = lane >> 4;
#pragma unroll
            for (int s2 = 0; s2 < 2; ++s2)
#pragma unroll
                for (int ntl = 0; ntl < 2; ++ntl) {
                    const LAS unsigned char* p0 = vst + (16 * s2 + 4 * hh + (li >> 2)) * 128 + (32 * ntl + 16 * (gq & 1) + 4 * (li & 3)) * 2;
                    const s16x4 lo = __builtin_bit_cast(s16x4, __builtin_amdgcn_ds_read_tr16_b64_v4i16((LAS s16x4*)p0));
                    const s16x4 hi = __builtin_bit_cast(s16x4, __builtin_amdgcn_ds_read_tr16_b64_v4i16((LAS s16x4*)(p0 + 8 * 128)));
                    const bf16x8 vf = (bf16x8){lo[0], lo[1], lo[2], lo[3], hi[0], hi[1], hi[2], hi[3]};
                    if (ntl == 0) O0 = __builtin_amdgcn_mfma_f32_32x32x16_bf16(Pf[s2], vf, O0, 0, 0, 0); else O1 = __builtin_amdgcn_mfma_f32_32x32x16_bf16(Pf[s2], vf, O1, 0, 0, 0);
                }
#pragma unroll
            for (int i = 0; i < 4; ++i) { Kc[i] = Kn[i]; Vc[i] = Vn[i]; }
        }
#undef AT_LOADKV
#pragma unroll
        for (int reg = 0; reg < 16; ++reg) { const int qrow = (reg & 3) + 8 * (reg >> 2) + 4 * hh;
            if (qrow < nq) { const int tl = (((ii_base + qrow) << dsh) + r) - i0; atomicAdd((float*)(Oacc + tl * 64 + c), O0[reg]); atomicAdd((float*)(Oacc + tl * 64 + 32 + c), O1[reg]); } }
        lsum += __shfl_xor(lsum, 32);
        if (hh == 0 && c < nq) { const int tl = (((ii_base + c) << dsh) + r) - i0; atomicAdd((float*)(lacc + tl), lsum); }
    }
    __syncthreads();
    { const int tl = tid >> 1, half = tid & 1; const float inv = ATT_JOBS ? 1.f / lacc[tl] : 1.f; const LAS f32x4* op = (const LAS f32x4*)(Oacc + tl * 64 + 32 * half);
        bf16* dst = mix + (brow + i0 + tl) * 1024 + 512 + h * 64 + 32 * half;
#pragma unroll
        for (int q = 0; q < 4; ++q) { const f32x4 x0 = op[2 * q] * inv, x1 = op[2 * q + 1] * inv; *(bf16x8*)(dst + 8 * q) = pack8(x0, x1); } }
    __syncthreads();
}

constexpr int RT_LCNT = 0, RT_BASE = 256, RT_RANK = 512;
__device__ __forceinline__ void route_phase(Frame& F, const Args& a) {
    const float* hsrc = a.out; const float* wrT = (const float*)(F.ws + WS_WRT); const float* b_r = a.in[13];
    int* te = (int*)(F.ws + WS_TE); int* tslot = (int*)(F.ws + WS_TSLOT); float* tg = (float*)(F.ws + WS_TG); int* list = (int*)(F.ws + WS_LIST); float* lrs = (float*)(F.ws + WS_LRS);
    LAS int* lcnt = (LAS int*)(F.lds + RT_LCNT); LAS int* lbase = (LAS int*)(F.lds + RT_BASE); LAS int* lrank = (LAS int*)(F.lds + RT_RANK);
    const int lane = F.lane, c = lane & 31, hh = lane >> 5;
    for (int blk = F.vcu; blk < T / 128; blk += F.G) {
        if (F.tid < 32) lcnt[F.tid] = 0;
        __syncthreads();
        int e4[4] = {0, 0, 0, 0}, rk[4] = {0, 0, 0, 0}; float g4[4] = {0.f, 0.f, 0.f, 0.f}; float rs = 0.f; const int tok = blk * 128 + (F.wave & 3) * 32 + c;
        if (F.wave < 4) {
            f32x16 acc = {}; float ss = 0.f; const float* hp = hsrc + (size_t)tok * D + 4 * hh; const float* wp = wrT + (size_t)c * D + 4 * hh;
#pragma unroll 4
            for (int q = 0; q < 128; ++q) { const f32x4 hv = *(const f32x4*)(hp + 8 * q), wv = *(const f32x4*)(wp + 8 * q);
                ss += (hv[0] * hv[0] + hv[1] * hv[1]) + (hv[2] * hv[2] + hv[3] * hv[3]);
#pragma unroll
                for (int i = 0; i < 4; ++i) acc = __builtin_amdgcn_mfma_f32_32x32x2f32(wv[i], hv[i], acc, 0, 0, 0); }
            ss += __shfl_xor(ss, 32); rs = rsqrtf(ss * (1.f / D) + EPS);
            float tv[4] = {-3.0e38f, -3.0e38f, -3.0e38f, -3.0e38f}; int tix[4] = {0, 1, 2, 3};
#pragma unroll
            for (int reg = 0; reg < 16; ++reg) { const int e = (reg & 3) + 8 * (reg >> 2) + 4 * hh; float v = acc[reg] * rs + b_r[e]; int ix = e;
#pragma unroll
                for (int s = 0; s < 4; ++s) { const bool gt = (v > tv[s]) || (v == tv[s] && ix < tix[s]); const float ov = tv[s]; const int oi = tix[s]; tv[s] = gt ? v : ov; tix[s] = gt ? ix : oi; v = gt ? ov : v; ix = gt ? oi : ix; } }
            float pv[4]; int pi[4];
#pragma unroll
            for (int s = 0; s < 4; ++s) { pv[s] = __shfl_xor(tv[s], 32); pi[s] = __shfl_xor(tix[s], 32); }
#pragma unroll
            for (int t2 = 0; t2 < 4; ++t2) { float v = pv[t2]; int ix = pi[t2];
#pragma unroll
                for (int s = 0; s < 4; ++s) { const bool gt = (v > tv[s]) || (v == tv[s] && ix < tix[s]); const float ov = tv[s]; const int oi = tix[s]; tv[s] = gt ? v : ov; tix[s] = gt ? ix : oi; v = gt ? ov : v; ix = gt ? oi : ix; } }
            const float e0 = 1.f, e1 = __expf(tv[1] - tv[0]), e2 = __expf(tv[2] - tv[0]), e3 = __expf(tv[3] - tv[0]); const float inv = 1.f / (e0 + e1 + e2 + e3);
            g4[0] = e0 * inv; g4[1] = e1 * inv; g4[2] = e2 * inv; g4[3] = e3 * inv;
#pragma unroll
            for (int s = 0; s < 4; ++s) e4[s] = tix[s];
            if (hh == 0) {
#pragma unroll
                for (int s = 0; s < 4; ++s) rk[s] = atomicAdd((int*)(lcnt + e4[s]), 1);
            }
        }
        __syncthreads();
        if (F.tid < 32) lbase[F.tid] = (int)__hip_atomic_fetch_add(F.ctl + CW_GCNT + 64 * F.tid, (unsigned)lcnt[F.tid], RLX_AGENT);
        __syncthreads();
        if (F.wave < 4 && hh == 0) {
#pragma unroll
            for (int s = 0; s < 4; ++s) { const int slot = lbase[e4[s]] + rk[s]; te[tok * 4 + s] = e4[s]; tslot[tok * 4 + s] = slot; tg[tok * 4 + s] = g4[s];
                list[(size_t)e4[s] * LCAP + slot] = tok; lrs[(size_t)e4[s] * LCAP + slot] = rs; }
        }
        __syncthreads();
    }
}
__device__ __forceinline__ int moe_tables(Frame& F) {
    LAS int* tstart = (LAS int*)(F.lds + MOE_TSTART); LAS int* lcnt = (LAS int*)(F.lds + MOE_LCNT); LAS int* texp = (LAS int*)(F.lds + MOE_TEXP);
    if (F.tid == 0) { int acc = 0; for (int e = 0; e < NE; ++e) { const int cnt = (int)__hip_atomic_load(F.ctl + CW_GCNT + 64 * e, RLX_AGENT); lcnt[e] = cnt; tstart[e] = acc; const int nt = (cnt + 255) >> 8; for (int i = 0; i < nt; ++i) texp[acc + i] = e; acc += nt; } tstart[NE] = acc; }
    __syncthreads();
    return tstart[NE];
}
__device__ __forceinline__ void combine_phase(Frame& F, const Args& a) {
    LAS int* tstart = (LAS int*)(F.lds + MOE_TSTART);
    const int* te = (const int*)(F.ws + WS_TE); const int* tslot = (const int*)(F.ws + WS_TSLOT); const float* tg = (const float*)(F.ws + WS_TG); const bf16* Y = (const bf16*)(F.ws + WS_Y);
    float* out = a.out; const int gw = F.vcu * NWAVES + F.wave, NGW = F.G * NWAVES, lane = F.lane;
    for (int t = gw; t < T; t += NGW) {
        float* op = out + (size_t)t * D + 8 * lane;
        f32x4 o[2][2];
#pragma unroll
        for (int j = 0; j < 2; ++j) { o[j][0] = *(const f32x4*)(op + 512 * j); o[j][1] = *(const f32x4*)(op + 512 * j + 4); }
#pragma unroll
        for (int s = 0; s < 4; ++s) { const int e = te[t * 4 + s]; const size_t pos = (size_t)tstart[e] * 256 + tslot[t * 4 + s]; const float gt = tg[t * 4 + s]; const bf16* yp = Y + pos * D + 8 * lane;
#pragma unroll
            for (int j = 0; j < 2; ++j) { const u32x4 w = *(const u32x4*)(yp + 512 * j);
                o[j][0] += (f32x4){bflo(w.x), bfhi(w.x), bflo(w.y), bfhi(w.y)} * gt; o[j][1] += (f32x4){bflo(w.z), bfhi(w.z), bflo(w.w), bfhi(w.w)} * gt; } }
#pragma unroll
        for (int j = 0; j < 2; ++j) { *(f32x4*)(op + 512 * j) = o[j][0]; *(f32x4*)(op + 512 * j + 4) = o[j][1]; }
    }
}

constexpr int NPHASE = 9;
__global__ void __launch_bounds__(NTHREADS, 2) hymba_fwd(Args args) {
    extern __shared__ __attribute__((aligned(16))) unsigned char lds_raw[];
    Frame F; F.lds = (LAS unsigned char*)lds_raw; F.ws = args.ws; F.ctl = (unsigned*)(args.ws + WS_CTL);
    F.tid = threadIdx.x; F.lane = F.tid & 63; F.wave = __builtin_amdgcn_readfirstlane(F.tid >> 6);
    F.G = gridDim.x; { const int bx = blockIdx.x; F.vcu = (F.G % 8 == 0) ? (bx % 8) * (F.G / 8) + bx / 8 : bx; }
    volatile LAS unsigned* MISC = (volatile LAS unsigned*)(F.lds + MISC_OFF);
    if (F.tid < 32) MISC[F.tid] = 0u;
    __syncthreads();
    XcdBarrier bar; bar.bar = F.ctl + CW_BAR; bar.x = 0; bar.st = nullptr;
    if (MK_N_LAUNCHES == 1) bar = xcd_barrier_post(F.ctl + CW_BAR, MISC + 8);
    const int lo = args.ph_lo, hi = args.ph_hi;
#define IN(k) (lo <= (k) && (k) < hi)
#define SEAM(k) do { if (IN(k) && IN((k) + 1)) xcd_barrier(bar); } while (0)

    if (IN(0)) { for (int rep = 0; rep < (DUP == 4 ? 2 : 1); ++rep) phase0(F, args); SEAM(0); }
    if (IN(1)) {
        pg8::Gemm g{(const bf16*)(F.ws + WS_XN), (const bf16*)(F.ws + WS_WIN), D}; pg8::StaticOrder S{T / 256, NIN / 256, F.G, (int)blockIdx.x};
        pg8::EpiInProj E{(bf16*)(F.ws + WS_ZG), (bf16*)(F.ws + WS_QB), (bf16*)(F.ws + WS_KB), (bf16*)(F.ws + WS_VB), args.in[7], args.in[8]};
        for (int rep = 0; rep < (DUP == 5 ? 2 : 1); ++rep) { pg8::gemm_phase<pg8::EpiInProj, pg8::StaticOrder, false, true>(F.lds, g, S, E); __syncthreads(); }
        SEAM(1);
    }
    if (IN(2)) {
        for (int rep = 0; rep < (DUP == 1 ? 2 : 1); ++rep)
        for (int u = F.vcu; u < NBATCH * GH * NCHUNK; u += F.G) gdn_prep_unit(F, args, u);
        SEAM(2);
    }
    if (IN(3)) {
        const int nscan = NBATCH * GH;
        for (int bh = blockIdx.x; bh < nscan; bh += F.G) for (int rep = 0; rep < (DUP == 3 ? 2 : 1); ++rep) gdn_scan(F, args, bh);
        for (int rep = 0; rep < (DUP == 2 ? 2 : 1); ++rep)
        for (;;) {
            if (F.tid == 0) MISC[16] = __hip_atomic_fetch_add(F.ctl + CW_ATTQ + 64 * rep, 1u, RLX_AGENT);
            __syncthreads();
            const int u = (int)MISC[16];
            __syncthreads();
            if (u >= NBATCH * AH * 16) break;
            attn_unit(F, args, u);
        }
        SEAM(3);
    }
    if (IN(4)) {
        pg8::Gemm g{(const bf16*)(F.ws + WS_MIX), (const bf16*)(F.ws + WS_WOUT), D}; pg8::StaticOrder S{T / 256, D / 256, F.G, (int)blockIdx.x};
        pg8::EpiOutProj E{args.in[0], args.out, F.ws + WS_HB};
        for (int rep = 0; rep < (DUP == 6 ? 2 : 1); ++rep) { pg8::gemm_phase<pg8::EpiOutProj, pg8::StaticOrder, false, true>(F.lds, g, S, E); __syncthreads(); }
        SEAM(4);
    }
#if !SKIP_MOE
    if (IN(5)) { route_phase(F, args); SEAM(5); }
    if (IN(6)) {
        const int nM = moe_tables(F);
        pg8::Gemm g{(const bf16*)(F.ws + WS_HB), (const bf16*)(F.ws + WS_WGU), D};
        pg8::MoeOrder S{nM, 8, F.G, (int)blockIdx.x, (const LAS int*)(F.lds + MOE_TSTART), (const LAS int*)(F.lds + MOE_LCNT), (const LAS int*)(F.lds + MOE_TEXP), (const int*)(F.ws + WS_LIST)};
        pg8::EpiGateUp E{F.ws + WS_ACT, args.in[15], (const float*)(F.ws + WS_LRS), (const LAS int*)(F.lds + MOE_LCNT)};
        for (int rep = 0; rep < (DUP == 7 ? 2 : 1); ++rep) { pg8::gemm_phase<pg8::EpiGateUp, pg8::MoeOrder, true, true, true>(F.lds, g, S, E); __syncthreads(); }
        SEAM(6);
    }
    if (IN(7)) {
        const int nM = moe_tables(F);
        pg8::Gemm g{(const bf16*)(F.ws + WS_ACT), (const bf16*)(F.ws + WS_WDN), FF};
        pg8::MoeOrder S{nM, 4, F.G, (int)blockIdx.x, (const LAS int*)(F.lds + MOE_TSTART), (const LAS int*)(F.lds + MOE_LCNT), (const LAS int*)(F.lds + MOE_TEXP), (const int*)(F.ws + WS_LIST)};
        pg8::EpiDown E{(bf16*)(F.ws + WS_Y), args.in[17]};
        for (int rep = 0; rep < (DUP == 8 ? 2 : 1); ++rep) { pg8::gemm_phase<pg8::EpiDown, pg8::MoeOrder, false, true, true>(F.lds, g, S, E); __syncthreads(); }
        SEAM(7);
    }
    if (IN(8)) { (void)moe_tables(F); combine_phase(F, args); }
#endif
#undef IN
#undef SEAM
}

extern "C" void kernel_launch(void* const* d_in, const int* in_sizes, int n_in, void* d_out, int out_size, void* d_ws, size_t ws_size, hipStream_t stream) {
    static int grid = 0;
    if (grid == 0) {
        if (n_in != 18 || in_sizes[0] != T * D || out_size != T * D || ws_size < WS_END) { fprintf(stderr, "kernel_launch: unexpected shapes (n_in %d, in0 %d, out %d, ws %zu)\n", n_in, n_in > 0 ? in_sizes[0] : -1, out_size, ws_size); grid = -1; return; }
        int dev = 0, cus = 0, per_cu = 0;
        if (hipGetDevice(&dev) != hipSuccess || hipDeviceGetAttribute(&cus, hipDeviceAttributeMultiprocessorCount, dev) != hipSuccess) { grid = -1; return; }
        if (hipFuncSetAttribute((const void*)hymba_fwd, hipFuncAttributeMaxDynamicSharedMemorySize, LDS_BYTES) != hipSuccess) { fprintf(stderr, "kernel_launch: hipFuncSetAttribute failed\n"); grid = -1; return; }
        if (hipOccupancyMaxActiveBlocksPerMultiprocessor(&per_cu, (const void*)hymba_fwd, NTHREADS, LDS_BYTES) != hipSuccess || per_cu < 1) { fprintf(stderr, "kernel_launch: occupancy query says %d\n", per_cu); per_cu = 1; }
        (void)hipGetLastError();
        grid = cus;
    }
    if (grid < 0) return;
    (void)hipMemsetAsync((char*)d_ws + WS_CTL, 0, CTL_ZERO_BYTES, stream);
    Args a{};
    for (int i = 0; i < 18; ++i) a.in[i] = (const float*)d_in[i];
    a.out = (float*)d_out; a.ws = (unsigned char*)d_ws;
    if (MK_N_LAUNCHES == 1) {
        a.ph_lo = 0; a.ph_hi = NPHASE; a.li = 0;
        void* kargs[] = {&a};
        hipError_t e = hipLaunchCooperativeKernel((const void*)hymba_fwd, dim3(grid), dim3(NTHREADS), kargs, LDS_BYTES, stream);
        if (e != hipSuccess) fprintf(stderr, "kernel_launch: cooperative launch failed: %s (grid %d)\n", hipGetErrorString(e), grid);
    } else {
        for (int p = 0; p < NPHASE; ++p) { a.ph_lo = p; a.ph_hi = p + 1; a.li = p; hipLaunchKernelGGL(hymba_fwd, dim3(grid), dim3(NTHREADS), LDS_BYTES, stream, a); }
    }
}
```

```cpp
#include <hip/hip_runtime.h>
#include <cstdio>
#include <cstdint>

#ifndef MK_N_LAUNCHES
#define MK_N_LAUNCHES 1
#endif
#ifndef SKIP_ATTN
#define SKIP_ATTN 0
#endif
#ifndef DUP
#define DUP 0
#endif
#ifndef ATT_JOBS
#define ATT_JOBS 32
#endif
#ifndef SKIP_MOE
#define SKIP_MOE 0
#endif

#define LAS __attribute__((address_space(3)))
#define GAS __attribute__((address_space(1)))
typedef unsigned short bf16;
typedef short bf16x8 __attribute__((ext_vector_type(8)));
typedef short s16x4 __attribute__((ext_vector_type(4)));
typedef float f32x2 __attribute__((ext_vector_type(2)));
typedef float f32x4 __attribute__((ext_vector_type(4)));
typedef float f32x16 __attribute__((ext_vector_type(16)));
typedef unsigned u32x2 __attribute__((ext_vector_type(2)));
typedef unsigned u32x4 __attribute__((ext_vector_type(4)));
typedef __bf16 bf16x2_t __attribute__((ext_vector_type(2)));
typedef int v4i_t __attribute__((ext_vector_type(4)));
typedef int v8i_t __attribute__((ext_vector_type(8)));

constexpr int NBATCH = 8, SEQ = 4096, D = 1024, T = NBATCH * SEQ;
constexpr int IN_DIM = 3592, NIN = 3584;
constexpr int GH = 4, DK = 128, CHUNK = 64, NCHUNK = SEQ / CHUNK;
constexpr int AH = 8, DH = 64;
constexpr int NE = 32, FF = 1024, LCAP = 32768;
constexpr float EPS = 1e-6f, LOG2E = 1.4426950408889634f;
constexpr int NWAVES = 8, NTHREADS = 512;

constexpr size_t MiB = 1u << 20;
constexpr size_t WS_CTL = 0, CTL_ZERO_BYTES = 1 * MiB;
constexpr size_t WS_WIN = 1 * MiB, WS_WOUT = 8 * MiB, WS_WGU = 10 * MiB, WS_WDN = 138 * MiB;
constexpr size_t WS_TE = 202 * MiB, WS_TSLOT = WS_TE + 512 * 1024, WS_TG = WS_TSLOT + 512 * 1024;
constexpr size_t WS_LIST = 204 * MiB, WS_LRS = 208 * MiB;
constexpr size_t WS_BA = 212 * MiB, WS_WRT = 213 * MiB;
constexpr size_t WS_ZG = 214 * MiB, WS_QB = 342 * MiB, WS_KB = 374 * MiB, WS_VB = 406 * MiB;
constexpr size_t WS_PREP = 438 * MiB;
constexpr int PREP_WP = 0, PREP_QP = 16384, PREP_AP = 32768, PREP_KT = 40960, PREP_UP = 57344, PREP_CD = 90112, PREP_REC = 90368;
constexpr size_t WS_OG = 616 * MiB, WS_MIX = 680 * MiB;
constexpr size_t WS_XN = 760 * MiB, WS_HB = 760 * MiB;
constexpr size_t WS_ACT = 214 * MiB, WS_Y = 486 * MiB, WS_END = 824 * MiB;
static_assert(WS_VB - WS_KB == WS_KB - WS_QB, "q/k/v stride");
static_assert(WS_PREP + (size_t)NBATCH * GH * NCHUNK * PREP_REC <= WS_OG, "prep region");
static_assert(WS_ACT + (size_t)(T * 4 + NE * 256) * FF * 2 <= WS_Y && WS_Y + (size_t)(T * 4 + NE * 256) * D * 2 <= WS_HB, "act/y regions");
constexpr int CW_TMO = 0, CW_CODE = 1, CW_ATTQ = 512, CW_GCNT = 1024  , CW_BAR = 8192;

constexpr int LDS_BYTES = 160 * 1024;
constexpr int RING_BYTES = 131072;
constexpr int TOP_OFF = LDS_BYTES - 4096;
constexpr int MISC_OFF = TOP_OFF;
constexpr int MOE_TAB_OFF = TOP_OFF + 256;
constexpr int MOE_TSTART = MOE_TAB_OFF, MOE_LCNT = MOE_TAB_OFF + 256, MOE_TEXP = MOE_TAB_OFF + 512;

#define RLX_AGENT __ATOMIC_RELAXED, __HIP_MEMORY_SCOPE_AGENT
#define LDS_WAIT() asm volatile("s_waitcnt lgkmcnt(0)" ::: "memory")
#define VM_WAIT() asm volatile("s_waitcnt vmcnt(0)" ::: "memory")
__device__ __forceinline__ unsigned pk2(float lo, float hi) { f32x2 v = {lo, hi}; bf16x2_t b = __builtin_convertvector(v, bf16x2_t); return __builtin_bit_cast(unsigned, b); }
__device__ __forceinline__ unsigned pk4_fp8(float a, float b, float c, float d) { int w = 0; w = __builtin_amdgcn_cvt_pk_fp8_f32(a, b, w, false); w = __builtin_amdgcn_cvt_pk_fp8_f32(c, d, w, true); return (unsigned)w; }
__device__ __forceinline__ float bf2f(unsigned short b) { return __uint_as_float((unsigned)b << 16); }
__device__ __forceinline__ float bflo(unsigned w) { return __uint_as_float(w << 16); }
__device__ __forceinline__ float bfhi(unsigned w) { return __uint_as_float(w & 0xffff0000u); }
__device__ __forceinline__ float wave_sum(float v) {
#pragma unroll
    for (int o = 1; o < 64; o <<= 1) v += __shfl_xor(v, o);
    return v;
}
__device__ __forceinline__ float silu_f(float x) { return x / (1.f + __expf(-x)); }
__device__ __forceinline__ float sigmoid_f(float x) { return 1.f / (1.f + __expf(-x)); }
__device__ __forceinline__ bf16x8 pack8(f32x4 a, f32x4 b) {
    u32x4 w; w.x = pk2(a[0], a[1]); w.y = pk2(a[2], a[3]); w.z = pk2(b[0], b[1]); w.w = pk2(b[2], b[3]); return __builtin_bit_cast(bf16x8, w);
}

__device__ __forceinline__ void glds16_asm(const void* gsrc, unsigned lds_dst) { unsigned keep;
    asm volatile("s_mov_b32 %0, m0\n\ts_mov_b32 m0, %2\n\ts_nop 0\n\tglobal_load_lds_dwordx4 %1, off\n\ts_mov_b32 m0, %0" : "=&s"(keep) : "v"(gsrc), "s"(lds_dst) : "memory"); }

namespace pg8 {
constexpr int BM = 256, BK = 64, HALF = 128, HTB = HALF * BK * 2, STAGE_BYTES = 8 * HTB, NXCD = 8, WGM = 8;
__host__ __device__ __forceinline__ int lds_byte(int r, int c) { const int st = (r >> 4) * 2 + (c >> 5), rr = r & 15, cc = c & 31, ob = rr * 64 + cc * 2; return st * 1024 + (ob ^ (((ob >> 9) & 1) << 5)); }
__host__ __device__ __forceinline__ void stage_rc(int b, int& R, int& C) { const int st = b / 1024, sb = b % 1024, swz = sb ^ (((sb >> 9) & 1) << 5); R = (st >> 1) * 16 + swz / 64; C = (st & 1) * 32 + (swz % 64) / 2; }
__host__ __device__ __forceinline__ int perm32(int rho) { const int n = rho >> 4, i = rho & 15; return 8 * (i >> 2) + 4 * n + (i & 3); }

struct Unit { int pm, pn, pb, e, mt; };
struct Gemm { const bf16* A; const bf16* Bt; int K; };

__device__ __forceinline__ bool static_tile(int i, int G, int c, int nM, int nN, int& pm, int& pn) {
    const int nwg = nM * nN; const long L = (long)i * G + c; if (L >= nwg) return false;
    int wgid = (int)L; { const int q = nwg / NXCD, r = nwg % NXCD, xcd = wgid % NXCD, off = wgid / NXCD; wgid = (xcd < r ? xcd * (q + 1) : r * (q + 1) + (xcd - r) * q) + off; }
    const int nig = WGM * nN, gid = wgid / nig, fm = gid * WGM, gsz = (nM - fm) < WGM ? (nM - fm) : WGM;
    pm = fm + ((wgid % nig) % gsz); pn = (wgid % nig) / gsz; return true;
}
struct StaticOrder {
    int nM, nN, G, c;
    __device__ __forceinline__ bool next(int i, Unit& u) const { int pm, pn; if (!static_tile(i, G, c, nM, nN, pm, pn)) return false; u.pm = pm; u.pn = pn; u.pb = pn; u.e = 0; u.mt = 0; return true; }
    __device__ __forceinline__ int row_index(const Unit&, int) const { return 0; }
};
struct MoeOrder {
    int nM, nN, G, c; const LAS int* tstart; const LAS int* lcnt; const LAS int* texp; const int* list;
    __device__ __forceinline__ bool next(int i, Unit& u) const {
        int pm, pn; if (!static_tile(i, G, c, nM, nN, pm, pn)) return false;
        const int e = texp[pm]; u.pm = pm; u.pn = pn; u.e = e; u.pb = e * nN + pn; u.mt = pm - tstart[e]; return true;
    }
    __device__ __forceinline__ int row_index(const Unit& u, int r) const { const int rr = u.mt * 256 + r; return rr < lcnt[u.e] ? list[u.e * LCAP + rr] : 0; }
};

#define PG8_SA(b, h) (((b) * 2 + (h)) * HTB)
#define PG8_SB(b, h) ((4 + (b) * 2 + (h)) * HTB)
#define PG8_GLDS(src, dstoff) __builtin_amdgcn_global_load_lds((const unsigned*)(src), (LAS unsigned*)(lds + (dstoff)), 16, 0, 0)
#define PG8_STAGE_B(bufoff, nx, kb, h) do { _Pragma("unroll") for (int _i = 0; _i < 2; ++_i) \
        PG8_GLDS(((nx) ? nB : cB) + (kb) + (size_t)(h) * hstep + voffB[_i], (bufoff) + ldsw + _i * 8192); } while (0)
#define PG8_STAGE_A(bufoff, nx, kb, h) do { _Pragma("unroll") for (int _i = 0; _i < 2; ++_i) \
        PG8_GLDS(GATHER ? (const char*)g.A + (kb) + ((nx) ? voffN[h][_i] : voffC[h][_i]) : ((nx) ? nA : cA) + (kb) + (size_t)(h) * hstep + voffA[_i], (bufoff) + ldsw + _i * 8192); } while (0)
#define PG8_LDA8(dst, b, h) do { _Pragma("unroll") for (int m = 0; m < 4; ++m) { const v4i_t lo_ = *(const LAS v4i_t*)(lds + PG8_SA(b, h) + aoff + m * 2048), hi_ = *(const LAS v4i_t*)(lds + PG8_SA(b, h) + aoff + m * 2048 + 1024); dst[m] = __builtin_shufflevector(lo_, hi_, 0, 1, 2, 3, 4, 5, 6, 7); } } while (0)
#define PG8_LDB8(dst, b, h) do { _Pragma("unroll") for (int n = 0; n < 2; ++n) { const v4i_t lo_ = *(const LAS v4i_t*)(lds + PG8_SB(b, h) + boff + n * 2048), hi_ = *(const LAS v4i_t*)(lds + PG8_SB(b, h) + boff + n * 2048 + 1024); dst[n] = __builtin_shufflevector(lo_, hi_, 0, 1, 2, 3, 4, 5, 6, 7); } } while (0)
#define PG8_LDA(dst, b, h) do { _Pragma("unroll") for (int m = 0; m < 4; ++m) _Pragma("unroll") for (int k = 0; k < 2; ++k) dst[m][k] = *(const LAS bf16x8*)(lds + PG8_SA(b, h) + aoff + m * 2048 + k * 1024); } while (0)
#define PG8_LDB(dst, b, h) do { _Pragma("unroll") for (int n = 0; n < 2; ++n) _Pragma("unroll") for (int k = 0; k < 2; ++k) dst[n][k] = *(const LAS bf16x8*)(lds + PG8_SB(b, h) + boff + n * 2048 + k * 1024); } while (0)
#define PG8_MMA(ai, bj, At, Bt) do { __builtin_amdgcn_s_setprio(1); _Pragma("unroll") for (int m = 0; m < 4; ++m) _Pragma("unroll") for (int n = 0; n < 2; ++n) _Pragma("unroll") for (int k = 0; k < 2; ++k) \
        acc[ai][bj][m][n] = __builtin_amdgcn_mfma_f32_16x16x32_bf16(Bt[n][k], At[m][k], acc[ai][bj][m][n], 0, 0, 0); __builtin_amdgcn_s_setprio(0); } while (0)
#define PG8_MMA8(ai, bj, At, Bt) do { __builtin_amdgcn_s_setprio(1); _Pragma("unroll") for (int m = 0; m < 4; ++m) _Pragma("unroll") for (int n = 0; n < 2; ++n) \
        asm volatile("v_mfma_scale_f32_16x16x128_f8f6f4 %0, %1, %2, %0, %3, %4 op_sel_hi:[0,0,0]" : "+v"(acc[ai][bj][m][n]) : "v"(Bt[n]), "v"(At[m]), "v"(sc_w), "v"(sc_a)); __builtin_amdgcn_s_setprio(0); } while (0)
#define XLDA(b, h) do { if constexpr (FP8) PG8_LDA8(At8, b, h); else PG8_LDA(At, b, h); } while (0)
#define XLDB0(b, h) do { if constexpr (FP8) PG8_LDB8(B08, b, h); else PG8_LDB(B0, b, h); } while (0)
#define XLDB1(b, h) do { if constexpr (FP8) PG8_LDB8(B18, b, h); else PG8_LDB(B1, b, h); } while (0)
#define XMMA0(ai, bj) do { if constexpr (FP8) PG8_MMA8(ai, bj, At8, B08); else PG8_MMA(ai, bj, At, B0); } while (0)
#define XMMA1(ai, bj) do { if constexpr (FP8) PG8_MMA8(ai, bj, At8, B18); else PG8_MMA(ai, bj, At, B1); } while (0)
#define PG8_WAIT_V(n) asm volatile("s_waitcnt vmcnt(" #n ")" ::: "memory")
#define PG8_WAIT_L(n) asm volatile("s_waitcnt lgkmcnt(" #n ")" ::: "memory")
#define PG8_BAR __builtin_amdgcn_s_barrier()
#define PG8_SCHED __builtin_amdgcn_sched_barrier(0)

template <class Epi, class Sched, bool GATHER, bool ALIGN_EPI, bool FP8 = false>
__device__ __forceinline__ void gemm_phase(LAS unsigned char* lds, const Gemm g, const Sched& S, const Epi& E) {
    const int tid = threadIdx.x, wid = __builtin_amdgcn_readfirstlane(tid >> 6), lane = tid & 63, wr = wid >> 2, wc = wid & 3, fr = lane & 15, fq = lane >> 4;
    const int K = g.K, rowb = FP8 ? K : 2 * K, nt = rowb / 128;
    unsigned voffA[2], voffB[2], voffC[2][2], voffN[2][2]; int RA[2], CA[2];
#pragma unroll
    for (int i = 0; i < 2; ++i) { int R, C; stage_rc(tid * 16 + i * 8192, R, C); const int Rb = Epi::PERM ? ((R & ~31) + perm32(R & 31)) : R;
        RA[i] = R; CA[i] = C; voffA[i] = (unsigned)(R * rowb + C * 2); voffB[i] = (unsigned)(Rb * rowb + C * 2); }
    const size_t kstep = (size_t)(BK * 2), hstep = (size_t)HALF * rowb, tstep = 2 * hstep;
    const unsigned ldsw = (unsigned)wid * 1024u;
    const int aoff = lds_byte(wr * 64 + fr, fq * 8), boff = lds_byte(wc * 32 + fr, fq * 8);
    Unit cur, nxt; int ui = 0;
    if (!S.next(0, cur)) return;
    f32x4 acc[2][2][4][2];
#pragma unroll
    for (int a = 0; a < 2; ++a)
#pragma unroll
        for (int b = 0; b < 2; ++b)
#pragma unroll
            for (int m = 0; m < 4; ++m)
#pragma unroll
                for (int n = 0; n < 2; ++n) acc[a][b][m][n] = (f32x4){0.f, 0.f, 0.f, 0.f};
    bf16x8 At[4][2], B0[2][2], B1[2][2]; v8i_t At8[4], B08[2], B18[2]; int sc_w = 0x7a7a7a7a, sc_a = 0x7f7f7f7f; asm volatile("" : "+v"(sc_w), "+v"(sc_a));
    const char* cA = (const char*)g.A + (size_t)cur.pm * tstep; const char* cB = (const char*)g.Bt + (size_t)cur.pb * tstep;
    if (GATHER) {
#pragma unroll
        for (int h = 0; h < 2; ++h)
#pragma unroll
            for (int i = 0; i < 2; ++i) { voffC[h][i] = (unsigned)(S.row_index(cur, RA[i] + 128 * h) * rowb + CA[i] * 2); voffN[h][i] = voffC[h][i]; }
    }
    const char* nA = cA; const char* nB = cB;
    PG8_STAGE_B(PG8_SB(0, 0), false, 0, 0); PG8_STAGE_B(PG8_SB(0, 1), false, 0, 1); PG8_STAGE_A(PG8_SA(0, 0), false, 0, 0); PG8_STAGE_A(PG8_SA(0, 1), false, 0, 1);
    if (wr == 1) PG8_BAR;
    PG8_WAIT_V(2); PG8_BAR;
    PG8_STAGE_B(PG8_SB(1, 0), false, kstep, 0); PG8_STAGE_A(PG8_SA(1, 0), false, kstep, 0); PG8_STAGE_B(PG8_SB(1, 1), false, kstep, 1);
    PG8_WAIT_V(6); PG8_BAR;
    for (;;) {
        const bool has_next = S.next(ui + 1, nxt);
        nA = has_next ? (const char*)g.A + (size_t)nxt.pm * tstep : cA; nB = has_next ? (const char*)g.Bt + (size_t)nxt.pb * tstep : cB;
        if (GATHER) {
#pragma unroll
            for (int h = 0; h < 2; ++h)
#pragma unroll
                for (int i = 0; i < 2; ++i) voffN[h][i] = has_next ? (unsigned)(S.row_index(nxt, RA[i] + 128 * h) * rowb + CA[i] * 2) : voffC[h][i];
        }
        for (int t = 0; t < nt; t += 2) {
            const bool last = (t == nt - 2);
            const size_t k1 = (size_t)(t + 1) * kstep, k2 = last ? 0 : (size_t)(t + 2) * kstep, k3 = k2 + kstep;
            XLDB0(0, 0); XLDB1(0, 1); PG8_SCHED; XLDA(0, 0); PG8_STAGE_A(PG8_SA(1, 1), false, k1, 1);
            PG8_WAIT_V(8); PG8_WAIT_L(0); PG8_BAR; XMMA0(0, 0); XMMA1(0, 1); PG8_BAR; PG8_SCHED;
            XLDA(0, 1); PG8_STAGE_B(PG8_SB(0, 0), last, k2, 0); PG8_STAGE_B(PG8_SB(0, 1), last, k2, 1); PG8_STAGE_A(PG8_SA(0, 0), last, k2, 0);
            PG8_WAIT_V(8); PG8_WAIT_L(0); PG8_BAR; XMMA0(1, 0); XMMA1(1, 1); PG8_BAR; PG8_SCHED;
            XLDB0(1, 0); XLDB1(1, 1); PG8_SCHED; XLDA(1, 0); PG8_STAGE_A(PG8_SA(0, 1), last, k2, 1);
            PG8_WAIT_V(8); PG8_WAIT_L(0); PG8_BAR; XMMA0(0, 0); XMMA1(0, 1); PG8_BAR; PG8_SCHED;
            XLDA(1, 1); PG8_STAGE_B(PG8_SB(1, 0), last, k3, 0); PG8_STAGE_B(PG8_SB(1, 1), last, k3, 1); PG8_STAGE_A(PG8_SA(1, 0), last, k3, 0);
            PG8_WAIT_V(8); PG8_WAIT_L(0); PG8_BAR; XMMA0(1, 0); XMMA1(1, 1); PG8_BAR; PG8_SCHED;
        }
        if constexpr (ALIGN_EPI) { if (wr == 0) PG8_BAR; }
        if constexpr (FP8) asm volatile("s_nop 15\n\ts_nop 15" ::: "memory");
        E(acc, cur, wr, wc, fr, fq);
        if (!has_next) break;
#pragma unroll
        for (int a = 0; a < 2; ++a)
#pragma unroll
            for (int b = 0; b < 2; ++b)
#pragma unroll
                for (int m = 0; m < 4; ++m)
#pragma unroll
                    for (int n = 0; n < 2; ++n) acc[a][b][m][n] = (f32x4){0.f, 0.f, 0.f, 0.f};
        cur = nxt; cA = nA; cB = nB; ++ui;
        if (GATHER) {
#pragma unroll
            for (int h = 0; h < 2; ++h)
#pragma unroll
                for (int i = 0; i < 2; ++i) voffC[h][i] = voffN[h][i];
        }
        if constexpr (ALIGN_EPI) { if (wr == 1) PG8_BAR; }
    }
    PG8_WAIT_V(0);
    if constexpr (!ALIGN_EPI) { if (wr == 0) PG8_BAR; }
    PG8_BAR;
}

struct EpiInProj {
    static constexpr bool PERM = true;
    bf16* zg; bf16* qb; bf16* kb; bf16* vb; const float* qn; const float* kn;
    __device__ __forceinline__ void operator()(const f32x4 (&acc)[2][2][4][2], const Unit& u, int wr, int wc, int fr, int fq) const {
        const int row0 = u.pm * BM + wr * 64 + fr;
        if (u.pn < 8) {
            const int col0 = u.pn * BM + wc * 32 + 8 * fq;
#pragma unroll
            for (int ai = 0; ai < 2; ++ai)
#pragma unroll
                for (int m = 0; m < 4; ++m) { bf16* rowp = zg + (size_t)(row0 + ai * HALF + m * 16) * 2048 + col0;
#pragma unroll
                    for (int bj = 0; bj < 2; ++bj) { const f32x4 v0 = acc[ai][bj][m][0], v1 = acc[ai][bj][m][1];
                        u32x4 w; w.x = pk2(v0[0], v0[1]); w.y = pk2(v0[2], v0[3]); w.z = pk2(v1[0], v1[1]); w.w = pk2(v1[2], v1[3]); *(u32x4*)(rowp + bj * HALF) = w; } }
        } else {
            const int sec = (u.pn - 8) >> 1, head = 4 * ((u.pn - 8) & 1) + wc;
            bf16* dst = qb + (size_t)sec * ((WS_KB - WS_QB) / 2); const float* nw = (sec == 1) ? kn : qn;
            f32x4 wv[2][2];
#pragma unroll
            for (int bj = 0; bj < 2; ++bj)
#pragma unroll
                for (int n = 0; n < 2; ++n) { const f32x4 t_ = *(const f32x4*)(nw + 32 * bj + 8 * fq + 4 * n); wv[bj][n] = sec == 2 ? (f32x4){1.f, 1.f, 1.f, 1.f} : t_; }
#pragma unroll
            for (int ai = 0; ai < 2; ++ai)
#pragma unroll
                for (int m = 0; m < 4; ++m) {
                    float sc = 1.f;
                    if (sec < 2) { float ss = 0.f;
#pragma unroll
                        for (int bj = 0; bj < 2; ++bj)
#pragma unroll
                            for (int n = 0; n < 2; ++n) { const f32x4 x = acc[ai][bj][m][n]; ss += (x[0] * x[0] + x[1] * x[1]) + (x[2] * x[2] + x[3] * x[3]); }
                        ss += __shfl_xor(ss, 16); ss += __shfl_xor(ss, 32);
                        sc = rsqrtf(ss * (1.f / 64.f) + EPS) * (sec == 0 ? 0.125f * LOG2E : 1.f); }
                    const int row_ = row0 + ai * HALF + m * 16; bf16* rowp = dst + ((size_t)((row_ >> 12) * AH + head) * SEQ + (row_ & (SEQ - 1))) * 64 + 8 * fq;
#pragma unroll
                    for (int bj = 0; bj < 2; ++bj) { const f32x4 v0 = acc[ai][bj][m][0] * sc * wv[bj][0], v1 = acc[ai][bj][m][1] * sc * wv[bj][1];
                        u32x4 w; w.x = pk2(v0[0], v0[1]); w.y = pk2(v0[2], v0[3]); w.z = pk2(v1[0], v1[1]); w.w = pk2(v1[2], v1[3]); *(u32x4*)(rowp + bj * 32) = w; } }
        }
    }
};
struct EpiOutProj {
    static constexpr bool PERM = false;
    const float* x; float* h; unsigned char* hb;
    __device__ __forceinline__ void operator()(const f32x4 (&acc)[2][2][4][2], const Unit& u, int wr, int wc, int fr, int fq) const {
        const int row0 = u.pm * BM + wr * 64 + fr, col0 = u.pn * BM + wc * 32 + 4 * fq;
#pragma unroll
        for (int ai = 0; ai < 2; ++ai)
#pragma unroll
            for (int m = 0; m < 4; ++m) { const size_t off = (size_t)(row0 + ai * HALF + m * 16) * D + col0;
#pragma unroll
                for (int bj = 0; bj < 2; ++bj)
#pragma unroll
                    for (int n = 0; n < 2; ++n) { const f32x4 v = *(const f32x4*)(x + off + bj * HALF + n * 16) + acc[ai][bj][m][n];
                        *(f32x4*)(h + off + bj * HALF + n * 16) = v; *(unsigned*)(hb + off + bj * HALF + n * 16) = pk4_fp8(v[0], v[1], v[2], v[3]); } }
    }
};
struct EpiGateUp {
    static constexpr bool PERM = true;
    unsigned char* act; const float* bgu; const float* lrs; const LAS int* lcnt;
    __device__ __forceinline__ void operator()(const f32x4 (&acc)[2][2][4][2], const Unit& u, int wr, int wc, int fr, int fq) const {
        const int cl = wc * 32 + 8 * fq; const float* bg = bgu + (size_t)u.e * 2048 + 128 * u.pn + cl;
        f32x4 bgv[2], buv[2];
#pragma unroll
        for (int n = 0; n < 2; ++n) { bgv[n] = *(const f32x4*)(bg + 4 * n); buv[n] = *(const f32x4*)(bg + 1024 + 4 * n); }
        const int cnt = lcnt[u.e];
#pragma unroll
        for (int ai = 0; ai < 2; ++ai)
#pragma unroll
            for (int m = 0; m < 4; ++m) { const int r = ai * HALF + wr * 64 + m * 16 + fr, rr = u.mt * 256 + r;
                const float rs = rr < cnt ? lrs[(size_t)u.e * LCAP + rr] : 0.f;
                unsigned wq[2];
#pragma unroll
                for (int n = 0; n < 2; ++n) { float a[4];
#pragma unroll
                    for (int i = 0; i < 4; ++i) { const float gt = fminf(acc[ai][0][m][n][i] * rs + bgv[n][i], 7.f); const float up = fminf(fmaxf(acc[ai][1][m][n][i] * rs + buv[n][i], -7.f), 7.f);
                        a[i] = (up + 1.f) * gt * sigmoid_f(1.702f * gt); }
                    wq[n] = pk4_fp8(a[0], a[1], a[2], a[3]); }
                *(u32x2*)(act + (size_t)(u.pm * BM + r) * FF + 128 * u.pn + cl) = (u32x2){wq[0], wq[1]}; }
    }
};
struct EpiDown {
    static constexpr bool PERM = true;
    bf16* y; const float* bdn;
    __device__ __forceinline__ void operator()(const f32x4 (&acc)[2][2][4][2], const Unit& u, int wr, int wc, int fr, int fq) const {
        const int col0 = u.pn * BM + wc * 32 + 8 * fq; const float* bp = bdn + (size_t)u.e * D + col0;
        f32x4 bv[2][2];
#pragma unroll
        for (int bj = 0; bj < 2; ++bj)
#pragma unroll
            for (int n = 0; n < 2; ++n) bv[bj][n] = *(const f32x4*)(bp + bj * HALF + 4 * n);
#pragma unroll
        for (int ai = 0; ai < 2; ++ai)
#pragma unroll
            for (int m = 0; m < 4; ++m) { bf16* rowp = y + (size_t)(u.pm * BM + ai * HALF + wr * 64 + m * 16 + fr) * D + col0;
#pragma unroll
                for (int bj = 0; bj < 2; ++bj) { const f32x4 v0 = acc[ai][bj][m][0] + bv[bj][0], v1 = acc[ai][bj][m][1] + bv[bj][1];
                    u32x4 w; w.x = pk2(v0[0], v0[1]); w.y = pk2(v0[2], v0[3]); w.z = pk2(v1[0], v1[1]); w.w = pk2(v1[2], v1[3]); *(u32x4*)(rowp + bj * HALF) = w; } }
    }
};
}

#define XB_TMO      128
#define XB_XCNT(j)  (256  + 64 * (j))
#define XB_XSUB(j)  (1280 + 64 * (j))
#define XB_XGEN(j)  (2304 + 64 * (j))
#define XB_TOP      3328
#define XB_TOPGEN   3392
#define XCD_BAR_WORDS 3456
#define XB_SPIN_CAP (1u << 20)
__device__ __forceinline__ unsigned xb_ld(unsigned* p)              { return __hip_atomic_load(p, __ATOMIC_RELAXED, __HIP_MEMORY_SCOPE_AGENT); }
__device__ __forceinline__ unsigned xb_add(unsigned* p, unsigned v) { return __hip_atomic_fetch_add(p, v, __ATOMIC_RELAXED, __HIP_MEMORY_SCOPE_AGENT); }
__device__ __forceinline__ unsigned xb_xcc_id() { return (unsigned)__builtin_amdgcn_s_getreg((3 << 11) | 20) & 0xFu; }
#define XB_SPIN(cond, bar) do { unsigned _sp = 0; while (cond) { __builtin_amdgcn_s_sleep(1); \
    if ((++_sp & 255u) == 0u) { if (xb_ld(&(bar)[XB_TMO])) break; if (_sp > XB_SPIN_CAP) { atomicAdd(&(bar)[XB_TMO], 1u); break; } } } } while (0)
struct XcdBarrier { unsigned* bar; unsigned x; volatile LAS unsigned* st; };
__device__ __forceinline__ XcdBarrier xcd_barrier_post(unsigned* bar, volatile LAS unsigned* st) {
    XcdBarrier b; b.bar = bar; b.x = xb_xcc_id(); b.st = st;
    if (threadIdx.x == 0) (void)xb_add(&bar[XB_XCNT(b.x)], 1u);
    return b;
}
__device__ __forceinline__ void xcd_barrier_complete(unsigned* bar, unsigned x, unsigned& nloc, unsigned& nx) {
    const unsigned G = gridDim.x * gridDim.y * gridDim.z;
    unsigned sum, cnt, mine, sp = 0u;
    for (;;) {
        sum = 0u; cnt = 0u; mine = 0u;
#pragma unroll
        for (unsigned j = 0; j < 16; ++j) { const unsigned c = xb_ld(&bar[XB_XCNT(j)]); sum += c; cnt += (c > 0u) ? 1u : 0u; mine = (j == x) ? c : mine; }
        if (sum == G) break;
        __builtin_amdgcn_s_sleep(1);
        if ((++sp & 255u) == 0u) { if (xb_ld(&bar[XB_TMO])) break; if (sp > XB_SPIN_CAP) { atomicAdd(&bar[XB_TMO], 1u); break; } }
    }
    nloc = mine > 0u ? mine : 1u; nx = cnt > 0u ? cnt : 1u;
}
__device__ __forceinline__ void xcd_barrier(const XcdBarrier& b) {
    asm volatile("s_waitcnt vmcnt(0)" ::: "memory");
    __syncthreads();
    if (threadIdx.x == 0) {
        unsigned* bar = b.bar;
        __builtin_amdgcn_s_waitcnt(0);
        unsigned nloc = b.st[0], nx = b.st[1];
        if (nloc == 0u) { xcd_barrier_complete(bar, b.x, nloc, nx); b.st[0] = nloc; b.st[1] = nx; }
        const unsigned old = xb_add(&bar[XB_XSUB(b.x)], 1u);
        const unsigned gen = old / nloc;
        if (old + 1u == (gen + 1u) * nloc) {
            __builtin_amdgcn_fence(__ATOMIC_RELEASE, "agent");
            asm volatile("s_waitcnt vmcnt(0)" ::: "memory");
            const unsigned og = xb_add(&bar[XB_TOP], 1u);
            const unsigned tg = og / nx;
            if (og + 1u == (tg + 1u) * nx) xb_add(&bar[XB_TOPGEN], 1u);
            else XB_SPIN(xb_ld(&bar[XB_TOPGEN]) == tg, bar);
            __builtin_amdgcn_fence(__ATOMIC_ACQUIRE, "agent");
            xb_add(&bar[XB_XGEN(b.x)], 1u);
            asm volatile("s_waitcnt vmcnt(0)" ::: "memory");
        } else {
            XB_SPIN(xb_ld(&bar[XB_XGEN(b.x)]) == gen, bar);
            __builtin_amdgcn_fence(__ATOMIC_ACQUIRE, "agent");
            asm volatile("s_waitcnt vmcnt(0)" ::: "memory");
        }
    }
    __syncthreads();
}

struct Args { const float* in[18]; float* out; unsigned char* ws; int ph_lo, ph_hi, li, pad; };
struct Frame {
    LAS unsigned char* lds; unsigned char* ws; unsigned* ctl;
    int tid, lane, wave, G, vcu;
};

__device__ const unsigned char T5B[3][132] = {
{0,1,2,3,4,5,6,7,8,9,10,11,12,13,14,15,16,16,16,16,16,16,17,17,17,17,17,17,17,17,18,18,18,18,18,18,18,18,18,18,19,19,19,19,19,19,19,19,19,19,19,19,19,19,20,20,20,20,20,20,20,20,20,20,20,20,20,20,20,20,20,20,20,21,21,21,21,21,21,21,21,21,21,21,21,21,21,21,21,21,21,21,21,21,21,21,21,21,21,22,22,22,22,22,22,22,22,22,22,22,22,22,22,22,22,22,22,22,22,22,22,22,22,22,22,22,22,22,22,0,0,0},
{0,4,8,12,16,16,17,17,18,18,19,19,19,19,20,20,20,20,20,21,21,21,21,21,21,22,22,22,22,22,22,22,22,22,23,23,23,23,23,23,23,23,23,23,23,23,24,24,24,24,24,24,24,24,24,24,24,24,24,24,24,24,25,25,25,25,25,25,25,25,25,25,25,25,25,25,25,25,25,25,25,25,25,26,26,26,26,26,26,26,26,26,26,26,26,26,26,26,26,26,26,26,26,26,26,26,26,26,26,26,26,26,26,27,27,27,27,27,27,27,27,27,27,27,27,27,27,27,27,0,0,0},
{0,16,18,19,20,21,21,22,22,23,23,23,24,24,24,24,25,25,25,25,25,26,26,26,26,26,26,26,26,27,27,27,27,27,27,27,27,27,27,28,28,28,28,28,28,28,28,28,28,28,28,28,29,29,29,29,29,29,29,29,29,29,29,29,29,29,29,29,29,29,30,30,30,30,30,30,30,30,30,30,30,30,30,30,30,30,30,30,30,30,30,30,30,30,30,31,31,31,31,31,31,31,31,31,31,31,31,31,31,31,31,31,31,31,31,31,31,31,31,31,31,31,31,31,31,31,31,31,31,0,0,0}};

__device__ __forceinline__ void p0_load8(const float* W, size_t ldw, int src_col0, int k0, int lane, f32x4 (&v)[8]) {
    const int n4 = (lane & 7) * 4, kr = lane >> 3;
#pragma unroll
    for (int i = 0; i < 8; ++i) v[i] = *(const f32x4*)(W + (size_t)(k0 + 8 * i + kr) * ldw + src_col0 + n4);
}
template <bool SCALE, bool OUT8> __device__ __forceinline__ void p0_finish(const f32x4 (&v)[8], void* dstv, int k0, const float* kscale, LAS float* scr, int lane) {
    { const int n4 = (lane & 7) * 4, kr = lane >> 3;
#pragma unroll
        for (int i = 0; i < 8; ++i) { const int kk = 8 * i + kr; f32x4 x = v[i]; if (SCALE) x = x * kscale[k0 + kk]; if (OUT8) x = x * 32.f;
            scr[kk * 33 + n4] = x[0]; scr[kk * 33 + n4 + 1] = x[1]; scr[kk * 33 + n4 + 2] = x[2]; scr[kk * 33 + n4 + 3] = x[3]; } }
    LDS_WAIT(); asm volatile("" ::: "memory");
    if (OUT8) { unsigned char* dst = (unsigned char*)dstv; const int n = lane >> 1, kh = lane & 1; const LAS float* sp = scr + (32 * kh) * 33 + n; unsigned w[8];
#pragma unroll
        for (int q = 0; q < 8; ++q) w[q] = pk4_fp8(sp[(4 * q) * 33], sp[(4 * q + 1) * 33], sp[(4 * q + 2) * 33], sp[(4 * q + 3) * 33]);
        *(u32x4*)(dst + (size_t)n * 1024 + k0 + 32 * kh) = (u32x4){w[0], w[1], w[2], w[3]}; *(u32x4*)(dst + (size_t)n * 1024 + k0 + 32 * kh + 16) = (u32x4){w[4], w[5], w[6], w[7]};
    } else { bf16* dst = (bf16*)dstv; const int c = lane & 7;
#pragma unroll
        for (int j = 0; j < 4; ++j) { const int n = (lane >> 3) + 8 * j; const LAS float* sp = scr + (8 * c) * 33 + n;
            u32x4 o; o.x = pk2(sp[0 * 33], sp[1 * 33]); o.y = pk2(sp[2 * 33], sp[3 * 33]); o.z = pk2(sp[4 * 33], sp[5 * 33]); o.w = pk2(sp[6 * 33], sp[7 * 33]);
            *(u32x4*)(dst + (size_t)n * 1024 + k0 + 8 * c) = o; } }
    LDS_WAIT(); asm volatile("" ::: "memory");
}
template <bool SCALE, bool OUT8> __device__ __forceinline__ void p0_transpose_item(const float* W, size_t ldw, int src_col0, void* dstv, int k0, const float* kscale, LAS float* scr, int lane) {
    f32x4 v[8]; p0_load8(W, ldw, src_col0, k0, lane, v); p0_finish<SCALE, OUT8>(v, dstv, k0, kscale, scr, lane);
}
__device__ __forceinline__ void p0_experts(Frame& F, const Args& a, int gw, int NGW) {
    const float* n2 = a.in[11]; const float* w_gu = a.in[14]; const float* w_dn = a.in[16];
    bf16* Wgu_t = (bf16*)(F.ws + WS_WGU); bf16* Wdn_t = (bf16*)(F.ws + WS_WDN);
    LAS float* scr = (LAS float*)(F.lds + F.wave * 8448);
    constexpr int I_GU = NE * 16 * 64, I_DN = NE * 16 * 32;
#define P0_GU_ARGS(r_) const int e_ = (r_) >> 10, q_ = (r_) & 1023, nb_ = q_ & 63, kb_ = q_ >> 6, np_ = 32 * nb_, ntile_ = np_ >> 8, lc_ = np_ & 255, bj_ = lc_ >> 7, j0_ = lc_ & 127
    for (int it = gw; it < I_GU; it += 2 * NGW) { f32x4 va[8], vb2[8]; const int it2 = it + NGW; const bool two = it2 < I_GU;
        { P0_GU_ARGS(it); p0_load8(w_gu + (size_t)e_ * D * 2048, 2048, bj_ * 1024 + 128 * ntile_ + j0_, 64 * kb_, F.lane, va); }
        if (two) { P0_GU_ARGS(it2); p0_load8(w_gu + (size_t)e_ * D * 2048, 2048, bj_ * 1024 + 128 * ntile_ + j0_, 64 * kb_, F.lane, vb2); }
        { P0_GU_ARGS(it); p0_finish<true, true>(va, (unsigned char*)Wgu_t + ((size_t)e_ * 2048 + np_) * 1024, 64 * kb_, n2, scr, F.lane); }
        if (two) { P0_GU_ARGS(it2); p0_finish<true, true>(vb2, (unsigned char*)Wgu_t + ((size_t)e_ * 2048 + np_) * 1024, 64 * kb_, n2, scr, F.lane); } }
#undef P0_GU_ARGS
#define P0_DN_ARGS(r_) const int e_ = (r_) >> 9, q_ = (r_) & 511, nb_ = q_ & 31, kb_ = q_ >> 5
    for (int it = gw; it < I_DN; it += 2 * NGW) { f32x4 va[8], vb2[8]; const int it2 = it + NGW; const bool two = it2 < I_DN;
        { P0_DN_ARGS(it); p0_load8(w_dn + (size_t)e_ * FF * D, D, 32 * nb_, 64 * kb_, F.lane, va); }
        if (two) { P0_DN_ARGS(it2); p0_load8(w_dn + (size_t)e_ * FF * D, D, 32 * nb_, 64 * kb_, F.lane, vb2); }
        { P0_DN_ARGS(it); p0_finish<false, true>(va, (unsigned char*)Wdn_t + ((size_t)e_ * 1024 + 32 * nb_) * 1024, 64 * kb_, nullptr, scr, F.lane); }
        if (two) { P0_DN_ARGS(it2); p0_finish<false, true>(vb2, (unsigned char*)Wdn_t + ((size_t)e_ * 1024 + 32 * nb_) * 1024, 64 * kb_, nullptr, scr, F.lane); } }
#undef P0_DN_ARGS
}
__device__ __forceinline__ void phase0(Frame& F, const Args& a) {
    const float* x = a.in[0]; const float* n1 = a.in[1]; const float* w_in = a.in[2]; const float* w_out = a.in[10]; const float* n2 = a.in[11];
    const float* w_r = a.in[12]; const float* w_gu = a.in[14]; const float* w_dn = a.in[16];
    bf16* Win_t = (bf16*)(F.ws + WS_WIN); bf16* Wout_t = (bf16*)(F.ws + WS_WOUT); bf16* Wgu_t = (bf16*)(F.ws + WS_WGU); bf16* Wdn_t = (bf16*)(F.ws + WS_WDN);
    float* wrT = (float*)(F.ws + WS_WRT); bf16* XN = (bf16*)(F.ws + WS_XN); float* BA = (float*)(F.ws + WS_BA);
    LAS float* scr = (LAS float*)(F.lds + F.wave * 8448);
    const int gw = F.vcu * NWAVES + F.wave, NGW = F.G * NWAVES;
    for (int i = (F.vcu * NTHREADS + F.tid); i < NE * D; i += F.G * NTHREADS) { const int e = i >> 10, k = i & 1023; wrT[i] = n2[k] * w_r[k * NE + e]; }
    constexpr int I_IN = 16 * (NIN / 32), I_OUT = 16 * 32;
    for (int it = gw; it < I_IN + I_OUT; it += NGW) {
        int r = it;
        if (r < I_IN) { const int nb = r % (NIN / 32), kb = r / (NIN / 32), np = 32 * nb; int src;
            if (np < 2048) src = np; else { const int q = np - 2048, sec = q >> 9, rem = q & 511, pt = rem >> 8, lc = rem & 255, bj = lc >> 7, wc = (lc & 127) >> 5; src = 2056 + sec * 512 + (4 * pt + wc) * 64 + 32 * bj; }
            p0_transpose_item<false, false>(w_in, IN_DIM, src, Win_t + (size_t)np * 1024, 64 * kb, nullptr, scr, F.lane); continue; }
        r -= I_IN;
        { const int nb = r & 31, kb = r >> 5; p0_transpose_item<false, false>(w_out, D, 32 * nb, Wout_t + (size_t)(32 * nb) * 1024, 64 * kb, nullptr, scr, F.lane); }
    }
    __syncthreads();
    { LAS float* wb = (LAS float*)(F.lds + 69632);
        for (int k = F.tid; k < D; k += NTHREADS) { const float* wp = w_in + (size_t)k * IN_DIM + 2048; LAS float* dp = wb + (k >> 2) * 36 + (k & 3) * 8;
            *(LAS f32x4*)dp = *(const f32x4*)wp; *(LAS f32x4*)(dp + 4) = *(const f32x4*)(wp + 4); }
        __syncthreads();
        f32x4 n1v[4];
#pragma unroll
        for (int j = 0; j < 4; ++j) n1v[j] = *((const f32x4*)n1 + F.lane + 64 * j);
        for (int rep9 = 0; rep9 < (DUP == 9 ? 2 : 1); ++rep9)
        for (int m0 = gw * 4; m0 < T; m0 += NGW * 4) {
            f32x4 v[4][4]; float rs[4];
#pragma unroll
            for (int r = 0; r < 4; ++r)
#pragma unroll
                for (int j = 0; j < 4; ++j) v[r][j] = *((const f32x4*)(x + (size_t)(m0 + r) * D) + F.lane + 64 * j);
#pragma unroll
            for (int r = 0; r < 4; ++r) { float sq = 0.f;
#pragma unroll
                for (int j = 0; j < 4; ++j) sq += (v[r][j][0] * v[r][j][0] + v[r][j][1] * v[r][j][1]) + (v[r][j][2] * v[r][j][2] + v[r][j][3] * v[r][j][3]);
                rs[r] = rsqrtf(wave_sum(sq) * (1.f / D) + EPS); }
            float ba[4][8];
#pragma unroll
            for (int r = 0; r < 4; ++r)
#pragma unroll
                for (int c = 0; c < 8; ++c) ba[r][c] = 0.f;
#pragma unroll
            for (int j = 0; j < 4; ++j) {
#pragma unroll
                for (int r = 0; r < 4; ++r) { v[r][j] = v[r][j] * rs[r] * n1v[j];
                    *((unsigned long long*)(XN + (size_t)(m0 + r) * D) + F.lane + 64 * j) = (unsigned long long)pk2(v[r][j][0], v[r][j][1]) | ((unsigned long long)pk2(v[r][j][2], v[r][j][3]) << 32); }
#pragma unroll
                for (int i = 0; i < 4; ++i) { const LAS float* wp = wb + (F.lane + 64 * j) * 36 + i * 8; const f32x4 w0 = *(const LAS f32x4*)wp, w1 = *(const LAS f32x4*)(wp + 4);
#pragma unroll
                    for (int r = 0; r < 4; ++r) { const float xv = v[r][j][i];
                        ba[r][0] += xv * w0[0]; ba[r][1] += xv * w0[1]; ba[r][2] += xv * w0[2]; ba[r][3] += xv * w0[3];
                        ba[r][4] += xv * w1[0]; ba[r][5] += xv * w1[1]; ba[r][6] += xv * w1[2]; ba[r][7] += xv * w1[3]; } } }
#pragma unroll
            for (int r = 0; r < 4; ++r) {
#pragma unroll
                for (int c = 0; c < 8; ++c) ba[r][c] = wave_sum(ba[r][c]);
                if (F.lane == 0) { *(f32x4*)(BA + (size_t)(m0 + r) * 8) = (f32x4){ba[r][0], ba[r][1], ba[r][2], ba[r][3]}; *(f32x4*)(BA + (size_t)(m0 + r) * 8 + 4) = (f32x4){ba[r][4], ba[r][5], ba[r][6], ba[r][7]}; } }
        }
        __syncthreads();
    }
}

constexpr int GP = 132;
constexpr int GQ_OFF = 0, GK_OFF = 64 * GP * 4, GV_OFF = 2 * 64 * GP * 4, GW_OFF = 3 * 64 * GP * 4, GAT_OFF = 4 * 64 * GP * 4, GAT_P = 68;
constexpr int GRAW_OFF = GW_OFF, GRAW_BYTES = 67 * 768;
constexpr int GGC_OFF = GRAW_OFF + GRAW_BYTES, GBETA_OFF = GGC_OFF + 256, GEND = GBETA_OFF + 256;
static_assert(GAT_OFF + 64 * GAT_P * 4 <= GGC_OFF && GEND <= TOP_OFF, "gdn prep LDS");
__device__ __forceinline__ int permpos(int cc) { return 8 * ((cc & 15) >> 2) + (cc & 3) + 4 * (cc >> 4); }
__device__ __forceinline__ void gdn_prep_unit(Frame& F, const Args& a, int unit) {
    const bf16* zg = (const bf16*)(F.ws + WS_ZG); const float* BA = (const float*)(F.ws + WS_BA);
    const float* convw = a.in[3]; const float* a_log = a.in[4]; const float* dt_bias = a.in[5];
    const int b = unit >> 8, h = (unit >> 6) & 3, n = unit & 63; const int row0 = b * SEQ + n * CHUNK;
    unsigned char* rec = F.ws + WS_PREP + (size_t)unit * PREP_REC;
    LAS float* Qs = (LAS float*)(F.lds + GQ_OFF); LAS float* Ks = (LAS float*)(F.lds + GK_OFF); LAS float* Vs = (LAS float*)(F.lds + GV_OFF); LAS float* Ws = (LAS float*)(F.lds + GW_OFF);
    LAS float* AT = (LAS float*)(F.lds + GAT_OFF); LAS float* gcs = (LAS float*)(F.lds + GGC_OFF); LAS float* betas = (LAS float*)(F.lds + GBETA_OFF);
    LAS unsigned char* raw = F.lds + GRAW_OFF;
    const int tid = F.tid, lane = F.lane, wave = F.wave;
    for (int e = tid; e < 67 * 48; e += NTHREADS) { const int rr = e / 48, ch = e % 48; const int tt = n * CHUNK + rr - 3;
        u32x4 v = {0u, 0u, 0u, 0u}; if (tt >= 0) v = *(const u32x4*)(zg + (size_t)(row0 + rr - 3) * 2048 + (ch >> 4) * 512 + h * 128 + (ch & 15) * 8);
        *(LAS u32x4*)(raw + rr * 768 + ch * 16) = v; }
    if (wave == 0) {
        const float bl = BA[(size_t)(row0 + lane) * 8 + h], al = BA[(size_t)(row0 + lane) * 8 + 4 + h];
        const float xx = al + dt_bias[h]; const float sp = xx > 20.f ? xx : log1pf(__expf(xx));
        float g = -__expf(a_log[h]) * sp;
#pragma unroll
        for (int o = 1; o < 64; o <<= 1) { const float u = __shfl_up(g, o); if (lane >= o) g += u; }
        gcs[lane] = g; betas[lane] = sigmoid_f(bl);
    }
    __syncthreads();
    if (tid < 384) { const int cp = tid % 192, tp = tid / 192; const int ten = cp >> 6, c = (cp & 63) * 2; const int ch = ten * 512 + h * 128 + c;
        f32x2 cw[4];
#pragma unroll
        for (int k = 0; k < 4; ++k) cw[k] = *(const f32x2*)(convw + k * 1536 + ch);
        LAS float* dst = (ten == 0 ? Qs : (ten == 1 ? Ks : Vs)) + c;
        for (int t = tp; t < 64; t += 2) { float a0 = 0.f, a1 = 0.f;
#pragma unroll
            for (int k = 0; k < 4; ++k) { const unsigned w = *(const LAS unsigned*)(raw + (t + k) * 768 + cp * 4); a0 += bflo(w) * cw[k][0]; a1 += bfhi(w) * cw[k][1]; }
            *(LAS f32x2*)(dst + t * GP) = (f32x2){silu_f(a0), silu_f(a1)}; } }
    __syncthreads();
    for (int rr = 0; rr < 8; ++rr) { const int t = wave * 8 + rr;
        f32x2 q = *(LAS f32x2*)(Qs + t * GP + 2 * lane), k = *(LAS f32x2*)(Ks + t * GP + 2 * lane);
        const float sq = wave_sum(q[0] * q[0] + q[1] * q[1]), sk = wave_sum(k[0] * k[0] + k[1] * k[1]);
        const float fq_ = rsqrtf(sq + EPS) * 0.08838834764831845f, fk_ = rsqrtf(sk + EPS);
        *(LAS f32x2*)(Qs + t * GP + 2 * lane) = q * fq_; *(LAS f32x2*)(Ks + t * GP + 2 * lane) = k * fk_; }
    __syncthreads();
    {
        const int which = wave >> 2, ti = (wave >> 1) & 1, tj = wave & 1, r32 = lane & 31, hh = lane >> 5;
        const LAS float* Xa = (which ? Qs : Ks) + (32 * ti + r32) * GP + 8 * hh; const LAS float* Xb = Ks + (32 * tj + r32) * GP + 8 * hh;
        f32x16 acc = {};
#pragma unroll
        for (int ks = 0; ks < 8; ++ks) { const bf16x8 af = pack8(*(const LAS f32x4*)(Xa + 16 * ks), *(const LAS f32x4*)(Xa + 16 * ks + 4)), bf = pack8(*(const LAS f32x4*)(Xb + 16 * ks), *(const LAS f32x4*)(Xb + 16 * ks + 4));
            acc = __builtin_amdgcn_mfma_f32_32x32x16_bf16(af, bf, acc, 0, 0, 0); }
        const int j = 32 * tj + r32; const float gj = gcs[j];
        bf16* Af = (bf16*)(rec + PREP_AP); const int jpos = permpos(j & 31); const int afo = (j >> 5) * 512 + (jpos >> 3) * 128 + (jpos & 7);
#pragma unroll
        for (int q = 0; q < 4; ++q) { float vals[4];
#pragma unroll
            for (int rr = 0; rr < 4; ++rr) { const int i = 32 * ti + 8 * q + 4 * hh + rr; const float dec = __expf(fminf(gcs[i] - gj, 0.f));
                if (which == 0) vals[rr] = i > j ? betas[i] * acc[4 * q + rr] * dec : 0.f;
                else { const float v = i >= j ? acc[4 * q + rr] * dec : 0.f; Af[(i >> 4) * 1024 + (i & 15) * 8 + afo] = (bf16)(pk2(v, 0.f) & 0xffffu); } }
            if (which == 0) *(LAS f32x4*)(AT + j * GAT_P + 32 * ti + 8 * q + 4 * hh) = (f32x4){vals[0], vals[1], vals[2], vals[3]}; }
        for (int e = tid; e < 64 * 32; e += NTHREADS) { const int t = e >> 5, c = (e & 31) * 4; const float bt = betas[t], eg = bt * __expf(gcs[t]);
            *(LAS f32x4*)(Vs + t * GP + c) = *(LAS f32x4*)(Vs + t * GP + c) * bt; *(LAS f32x4*)(Ws + t * GP + c) = *(LAS f32x4*)(Ks + t * GP + c) * eg; }
    }
    __syncthreads();
    if (tid < 256) {
        LAS float* X = (tid < 128 ? Vs : Ws) + (tid & 127);
#pragma unroll 1
        for (int ib = 0; ib < 4; ++ib) { const int i0 = 16 * ib; float r[16];
#pragma unroll
            for (int ii = 0; ii < 16; ++ii) r[ii] = X[(i0 + ii) * GP];
#pragma unroll 1
            for (int j = 0; j < i0; ++j) { const float xj = X[j * GP]; const LAS f32x4* ap = (const LAS f32x4*)(AT + j * GAT_P + i0);
#pragma unroll
                for (int q = 0; q < 4; ++q) { const f32x4 av = ap[q]; r[4 * q] -= av[0] * xj; r[4 * q + 1] -= av[1] * xj; r[4 * q + 2] -= av[2] * xj; r[4 * q + 3] -= av[3] * xj; } }
#pragma unroll
            for (int j = 0; j < 16; ++j) { const float xj = r[j]; const LAS f32x4* ap = (const LAS f32x4*)(AT + (i0 + j) * GAT_P + i0); float av[16];
#pragma unroll
                for (int q = 0; q < 4; ++q) { const f32x4 t4 = ap[q]; av[4 * q] = t4[0]; av[4 * q + 1] = t4[1]; av[4 * q + 2] = t4[2]; av[4 * q + 3] = t4[3]; }
#pragma unroll
                for (int ii = 0; ii < 16; ++ii) if (ii > j) r[ii] -= av[ii] * xj; }
#pragma unroll
            for (int ii = 0; ii < 16; ++ii) X[(i0 + ii) * GP] = r[ii]; }
    } else {
        const int t2 = tid - 256; bf16* Qf = (bf16*)(rec + PREP_QP); bf16* Kf = (bf16*)(rec + PREP_KT); const float gl = gcs[63];
        for (int it = t2; it < 1024; it += 256) { const int blk = it >> 6, l = it & 63, mi = blk >> 2, ks = blk & 3, g = l >> 4, c = 16 * mi + (l & 15); const float eg = __expf(gcs[c]);
            const f32x4 lo = *(LAS f32x4*)(Qs + c * GP + 32 * ks + 4 * g) * eg, hi = *(LAS f32x4*)(Qs + c * GP + 32 * ks + 16 + 4 * g) * eg;
            *(bf16x8*)(Qf + it * 8) = pack8(lo, hi); }
        for (int it = t2; it < 1024; it += 256) { const int blk = it >> 6, l = it & 63, ti = blk >> 1, ks2 = blk & 1, g = l >> 4, dk = 16 * ti + (l & 15); float v[8];
#pragma unroll
            for (int j = 0; j < 8; ++j) { const int c = 32 * ks2 + (j < 4 ? 4 * g + j : 16 + 4 * g + (j - 4)); v[j] = Ks[c * GP + dk] * __expf(gl - gcs[c]); }
            *(bf16x8*)(Kf + it * 8) = pack8((f32x4){v[0], v[1], v[2], v[3]}, (f32x4){v[4], v[5], v[6], v[7]}); }
        if (t2 == 0) *(float*)(rec + PREP_CD) = __expf(gl);
    }
    __syncthreads();
    { float* Up = (float*)(rec + PREP_UP); bf16* Wf = (bf16*)(rec + PREP_WP);
        for (int it = tid; it < 2048; it += NTHREADS) { const int dv = it & 127, g = (it >> 7) & 3, mi = it >> 9; const int c0 = 16 * mi + 4 * g;
            *(f32x4*)(Up + (size_t)it * 4) = (f32x4){Vs[c0 * GP + dv], Vs[(c0 + 1) * GP + dv], Vs[(c0 + 2) * GP + dv], Vs[(c0 + 3) * GP + dv]}; }
        for (int it = tid; it < 1024; it += NTHREADS) { const int blk = it >> 6, l = it & 63, mi = blk >> 2, ks = blk & 3, g = l >> 4, c = 16 * mi + (l & 15);
            *(bf16x8*)(Wf + it * 8) = pack8(*(LAS f32x4*)(Ws + c * GP + 32 * ks + 4 * g), *(LAS f32x4*)(Ws + c * GP + 32 * ks + 16 + 4 * g)); }
    }
    __syncthreads();
}

constexpr int SC_BUFSZ = 57344, SC_OT = 2 * SC_BUFSZ, SC_OTSZ = 64 * 128 * 2, SC_END = SC_OT + 2 * SC_OTSZ;
static_assert(SC_END <= TOP_OFF, "scan LDS");
__device__ __forceinline__ void gdn_scan(Frame& F, const Args& a, int bh) {
    const int tid = F.tid, lane = F.lane, w = F.wave, fr = lane & 15, g = lane >> 4; const int b = bh >> 2, h = bh & 3;
    const unsigned char* rec0 = F.ws + WS_PREP + (size_t)bh * NCHUNK * PREP_REC;
    const float* gnw = a.in[6]; const bf16* zg = (const bf16*)(F.ws + WS_ZG); bf16* mix = (bf16*)(F.ws + WS_MIX);
    const size_t rowb = (size_t)b * SEQ; const unsigned lds0 = (unsigned)(uintptr_t)F.lds;
    if (w >= 4) {
        const int hw = w - 4, l16 = lane & 15, rq = lane >> 4;
        const f32x4 gwa = *(const f32x4*)(gnw + 8 * l16), gwb = *(const f32x4*)(gnw + 8 * l16 + 4);
#define SC_DMA(n_, buf_) do { const unsigned char* src_ = rec0 + (size_t)(n_) * PREP_REC + hw * 14336 + lane * 16; _Pragma("unroll") for (int r_ = 0; r_ < 14; ++r_) \
        glds16_asm(src_ + r_ * 1024, (unsigned)__builtin_amdgcn_readfirstlane((int)(lds0 + (buf_) * SC_BUFSZ + hw * 14336 + r_ * 1024))); } while (0)
#define SC_NORM(n_, gv) do { const LAS unsigned char* ot = F.lds + SC_OT + ((n_) & 1) * SC_OTSZ; _Pragma("unroll") for (int q_ = 0; q_ < 4; ++q_) { const int t = 16 * hw + 4 * q_ + rq; \
            const u32x4 ov = *(const LAS u32x4*)(ot + t * 256 + l16 * 16); const f32x4 xa = {bflo(ov.x), bfhi(ov.x), bflo(ov.y), bfhi(ov.y)}, xb = {bflo(ov.z), bfhi(ov.z), bflo(ov.w), bfhi(ov.w)}; \
            float ss_ = (xa[0] * xa[0] + xa[1] * xa[1]) + (xa[2] * xa[2] + xa[3] * xa[3]) + (xb[0] * xb[0] + xb[1] * xb[1]) + (xb[2] * xb[2] + xb[3] * xb[3]); \
            ss_ += __shfl_xor(ss_, 1); ss_ += __shfl_xor(ss_, 2); ss_ += __shfl_xor(ss_, 4); ss_ += __shfl_xor(ss_, 8); const float sc = rsqrtf(ss_ * (1.f / 128.f) + EPS); \
            const u32x4 gz = gv[q_]; const f32x4 ga = {silu_f(bflo(gz.x)), silu_f(bfhi(gz.x)), silu_f(bflo(gz.y)), silu_f(bfhi(gz.y))}, gb = {silu_f(bflo(gz.z)), silu_f(bfhi(gz.z)), silu_f(bflo(gz.w)), silu_f(bfhi(gz.w))}; \
            *(bf16x8*)(mix + (rowb + (n_) * CHUNK + t) * 1024 + h * 128 + 8 * l16) = pack8(xa * sc * gwa * ga, xb * sc * gwb * gb); } } while (0)
        u32x4 gc_[4], gn_[4];
        SC_DMA(0, 0);
#pragma unroll
        for (int q = 0; q < 4; ++q) gc_[q] = (u32x4){0u, 0u, 0u, 0u};
        VM_WAIT(); __syncthreads();
#pragma unroll 1
        for (int n = 0; n < NCHUNK; ++n) {
#pragma unroll
            for (int q = 0; q < 4; ++q) gn_[q] = *(const u32x4*)(zg + (rowb + n * CHUNK + 16 * hw + 4 * q + rq) * 2048 + 1536 + h * 128 + 8 * l16);
            if (n + 1 < NCHUNK) SC_DMA(n + 1, (n + 1) & 1);
            if (n > 0) SC_NORM(n - 1, gc_);
            VM_WAIT(); __syncthreads();
#pragma unroll
            for (int q = 0; q < 4; ++q) gc_[q] = gn_[q];
        }
        SC_NORM(NCHUNK - 1, gc_);
#undef SC_DMA
#undef SC_NORM
    } else {
        f32x4 S[2][8];
#pragma unroll
        for (int sl = 0; sl < 2; ++sl)
#pragma unroll
            for (int i = 0; i < 8; ++i) S[sl][i] = (f32x4){0.f, 0.f, 0.f, 0.f};
        f32x4 Un[2][4]; float cd = *(const float*)(rec0 + PREP_CD), cdn;
#pragma unroll
        for (int sl = 0; sl < 2; ++sl)
#pragma unroll
            for (int mi = 0; mi < 4; ++mi) Un[sl][mi] = *(const f32x4*)((const float*)(rec0 + PREP_UP) + (size_t)((mi * 4 + g) * 128 + 32 * w + 16 * sl + fr) * 4);
        __syncthreads();
#pragma unroll 1
        for (int n = 0; n < NCHUNK; ++n) {
            const LAS unsigned char* B = F.lds + (n & 1) * SC_BUFSZ + lane * 16;
            f32x4 vn[2][4], o[2][4];
            { bf16x8 Sb[2][4];
#pragma unroll
                for (int sl = 0; sl < 2; ++sl)
#pragma unroll
                    for (int ks = 0; ks < 4; ++ks) Sb[sl][ks] = pack8(S[sl][2 * ks], S[sl][2 * ks + 1]);
#pragma unroll
                for (int mi = 0; mi < 4; ++mi) { f32x4 t1[2], oo[2];
#pragma unroll
                    for (int sl = 0; sl < 2; ++sl) { t1[sl] = (f32x4){0.f, 0.f, 0.f, 0.f}; oo[sl] = (f32x4){0.f, 0.f, 0.f, 0.f}; }
#pragma unroll
                    for (int ks = 0; ks < 4; ++ks) { const bf16x8 wf = *(const LAS bf16x8*)(B + PREP_WP + (mi * 4 + ks) * 1024), qf = *(const LAS bf16x8*)(B + PREP_QP + (mi * 4 + ks) * 1024);
#pragma unroll
                        for (int sl = 0; sl < 2; ++sl) { t1[sl] = __builtin_amdgcn_mfma_f32_16x16x32_bf16(wf, Sb[sl][ks], t1[sl], 0, 0, 0); oo[sl] = __builtin_amdgcn_mfma_f32_16x16x32_bf16(qf, Sb[sl][ks], oo[sl], 0, 0, 0); } }
#pragma unroll
                    for (int sl = 0; sl < 2; ++sl) { vn[sl][mi] = Un[sl][mi] - t1[sl]; o[sl][mi] = oo[sl]; } } }
            { const int nn = n + 1 < NCHUNK ? n + 1 : n; cdn = *(const float*)(rec0 + (size_t)nn * PREP_REC + PREP_CD);
#pragma unroll
                for (int sl = 0; sl < 2; ++sl)
#pragma unroll
                    for (int mi = 0; mi < 4; ++mi) Un[sl][mi] = *(const f32x4*)((const float*)(rec0 + (size_t)nn * PREP_REC + PREP_UP) + (size_t)((mi * 4 + g) * 128 + 32 * w + 16 * sl + fr) * 4); }
            bf16x8 Vb[2][2];
#pragma unroll
            for (int sl = 0; sl < 2; ++sl)
#pragma unroll
                for (int ks = 0; ks < 2; ++ks) Vb[sl][ks] = pack8(vn[sl][2 * ks], vn[sl][2 * ks + 1]);
#pragma unroll
            for (int mi = 0; mi < 4; ++mi) {
#pragma unroll
                for (int ks = 0; ks < 2; ++ks) { const bf16x8 af = *(const LAS bf16x8*)(B + PREP_AP + (mi * 2 + ks) * 1024);
#pragma unroll
                    for (int sl = 0; sl < 2; ++sl) o[sl][mi] = __builtin_amdgcn_mfma_f32_16x16x32_bf16(af, Vb[sl][ks], o[sl][mi], 0, 0, 0); }
#pragma unroll
                for (int sl = 0; sl < 2; ++sl) { LAS bf16* otw = (LAS bf16*)(F.lds + SC_OT + (n & 1) * SC_OTSZ) + 32 * w + 16 * sl + fr;
                    const unsigned p01 = pk2(o[sl][mi][0], o[sl][mi][1]), p23 = pk2(o[sl][mi][2], o[sl][mi][3]);
                    otw[(16 * mi + 4 * g) * 128] = (bf16)(p01 & 0xffffu); otw[(16 * mi + 4 * g + 1) * 128] = (bf16)(p01 >> 16); otw[(16 * mi + 4 * g + 2) * 128] = (bf16)(p23 & 0xffffu); otw[(16 * mi + 4 * g + 3) * 128] = (bf16)(p23 >> 16); } }
#pragma unroll
            for (int ti = 0; ti < 8; ++ti) { f32x4 s0 = S[0][ti] * cd, s1 = S[1][ti] * cd;
#pragma unroll
                for (int ks = 0; ks < 2; ++ks) { const bf16x8 kf = *(const LAS bf16x8*)(B + PREP_KT + (ti * 2 + ks) * 1024);
                    s0 = __builtin_amdgcn_mfma_f32_16x16x32_bf16(kf, Vb[0][ks], s0, 0, 0, 0); s1 = __builtin_amdgcn_mfma_f32_16x16x32_bf16(kf, Vb[1][ks], s1, 0, 0, 0); }
                S[0][ti] = s0; S[1][ti] = s1; }
            __syncthreads();
            cd = cdn;
        }
    }
    __syncthreads();
}

constexpr int AT_K = 0, AT_V = 49152, AT_BIAS = 98304, AT_LW = 98304 + 1024, AT_END = AT_LW + 1024;
constexpr size_t WS_P4 = 616 * MiB, WS_P16 = 648 * MiB, WS_L4 = 744 * MiB, WS_L16 = 745 * MiB;
static_assert(WS_P16 + (size_t)T * 512 * 2 <= WS_MIX && WS_L16 + (size_t)T * 8 * 4 <= WS_XN, "attention partial buffers");
__device__ __forceinline__ void attn_unit(Frame& F, const Args& a, int u) {
    int kind, b, h, r, q0;
    if (u < 1024) { kind = 2; b = u >> 7; h = (u >> 4) & 7; r = u & 15; q0 = 0; }
    else if (u < 2048) { const int v = u - 1024; kind = 1; b = v >> 7; h = (v >> 4) & 7; r = (v >> 2) & 3; q0 = (v & 3) * 256; }
    else { const int v = u - 2048; kind = 0; b = v >> 7; h = (v >> 4) & 7; r = 0; q0 = (v & 15) * 256; }
    const int dsh = 2 * kind, lmax = (SEQ >> dsh) - 1;
    const bf16* qb = (const bf16*)(F.ws + WS_QB); const bf16* kb = (const bf16*)(F.ws + WS_KB); const bf16* vb = (const bf16*)(F.ws + WS_VB); bf16* mix = (bf16*)(F.ws + WS_MIX);
    const float* relb = a.in[9];
    LAS float* biasL = (LAS float*)(F.lds + AT_BIAS); LAS float* lw = (LAS float*)(F.lds + AT_LW) + F.wave * 32;
    const int tid = F.tid, lane = F.lane, w = F.wave, c = lane & 31, hh = lane >> 5;
    const size_t hrow = (size_t)(b * AH + h) * SEQ; const unsigned lds0 = (unsigned)(uintptr_t)F.lds;
    { const int ro = lane >> 3, p = lane & 7;
#pragma unroll
        for (int i = 0; i < 6; ++i) { const int lr = 48 * w + 8 * i + ro; int pos = q0 - 128 + lr; pos = pos < 0 ? 0 : (pos > lmax ? lmax : pos);
            const size_t eo = (hrow + (size_t)(pos << dsh) + r) * 64 + (size_t)((p ^ (lr & 7)) * 8);
            glds16_asm(kb + eo, (unsigned)__builtin_amdgcn_readfirstlane((int)(lds0 + AT_K + (48 * w + 8 * i) * 128)));
            glds16_asm(vb + eo, (unsigned)__builtin_amdgcn_readfirstlane((int)(lds0 + AT_V + (48 * w + 8 * i) * 128))); } }
    if (tid < 132) biasL[tid] = relb[(int)T5B[kind][tid] * AH + h] * LOG2E;
    const int qi = q0 + 32 * w + c;
    bf16x8 Qf[4];
    { const bf16* qp = qb + (hrow + (size_t)(qi << dsh) + r) * 64 + 8 * hh;
#pragma unroll
        for (int ks = 0; ks < 4; ++ks) Qf[ks] = *(const bf16x8*)(qp + 16 * ks); }
    VM_WAIT(); __syncthreads();
    f32x16 O0 = {}, O1 = {}; float lsum = 0.f;
    const int kt0 = (128 - q0 - 32 * w) > 0 ? ((128 - q0 - 32 * w) >> 5) : 0;
    const int li = lane & 15, gq = lane >> 4;
#pragma unroll 1
    for (int kt = kt0; kt < 5; ++kt) {
        const int lr0 = 32 * (w + kt);
        f32x16 sT = {};
        { const int lr = lr0 + c; const LAS unsigned char* kp = F.lds + AT_K + lr * 128;
#pragma unroll
            for (int ks = 0; ks < 4; ++ks) { const bf16x8 kf = *(const LAS bf16x8*)(kp + (((2 * ks + hh) ^ (lr & 7)) * 16)); sT = __builtin_amdgcn_mfma_f32_32x32x16_bf16(kf, Qf[ks], sT, 0, 0, 0); } }
        float p[16];
#pragma unroll
        for (int reg = 0; reg < 16; ++reg) { const int kr = (reg & 3) + 8 * (reg >> 2) + 4 * hh; const int s = 128 + c - 32 * kt - kr; const int kpos = q0 - 128 + lr0 + kr;
            const bool ok = (s >= 0) && (s <= 128) && (kpos >= 0); const int sc_ = s < 0 ? 0 : (s > 128 ? 128 : s);
            const float e = __builtin_amdgcn_exp2f(sT[reg] + biasL[sc_]); p[reg] = ok ? e : 0.f; lsum += p[reg]; }
        bf16x8 Pf[2];
#pragma unroll
        for (int s2 = 0; s2 < 2; ++s2) { u32x4 wv; wv.x = pk2(p[8 * s2], p[8 * s2 + 1]); wv.y = pk2(p[8 * s2 + 2], p[8 * s2 + 3]); wv.z = pk2(p[8 * s2 + 4], p[8 * s2 + 5]); wv.w = pk2(p[8 * s2 + 6], p[8 * s2 + 7]); Pf[s2] = __builtin_bit_cast(bf16x8, wv); }
#pragma unroll
        for (int s2 = 0; s2 < 2; ++s2)
#pragma unroll
            for (int ntl = 0; ntl < 2; ++ntl) {
                const int rowl = lr0 + 16 * s2 + 4 * hh + (li >> 2), rowh = rowl + 8; const int ch = 4 * ntl + 2 * (gq & 1) + ((li & 3) >> 1), sub = (li & 1) * 8;
                const s16x4 lo = __builtin_bit_cast(s16x4, __builtin_amdgcn_ds_read_tr16_b64_v4i16((LAS s16x4*)(F.lds + AT_V + rowl * 128 + ((ch ^ (rowl & 7)) * 16) + sub)));
                const s16x4 hi = __builtin_bit_cast(s16x4, __builtin_amdgcn_ds_read_tr16_b64_v4i16((LAS s16x4*)(F.lds + AT_V + rowh * 128 + ((ch ^ (rowh & 7)) * 16) + sub)));
                const bf16x8 vf = (bf16x8){lo[0], lo[1], lo[2], lo[3], hi[0], hi[1], hi[2], hi[3]};
                if (ntl == 0) O0 = __builtin_amdgcn_mfma_f32_32x32x16_bf16(Pf[s2], vf, O0, 0, 0, 0); else O1 = __builtin_amdgcn_mfma_f32_32x32x16_bf16(Pf[s2], vf, O1, 0, 0, 0);
            }
    }
    lsum += __shfl_xor(lsum, 32);
    if (hh == 0) lw[c] = lsum;
    __syncthreads();
    { LAS float* ost = (LAS float*)(F.lds + w * 8192);
#pragma unroll
        for (int reg = 0; reg < 16; ++reg) { const int qrow = (reg & 3) + 8 * (reg >> 2) + 4 * hh; ost[qrow * 64 + c] = O0[reg]; ost[qrow * 64 + 32 + c] = O1[reg]; }
        LDS_WAIT();
        const int row = lane >> 1, half = lane & 1; const float l1 = lw[row]; const LAS f32x4* op = (const LAS f32x4*)(ost + row * 64 + 32 * half);
        const size_t tok = (size_t)b * SEQ + (size_t)((q0 + 32 * w + row) << dsh) + r;
        if (kind != 0) {
            bf16* pp = (bf16*)(F.ws + (kind == 1 ? WS_P4 : WS_P16)) + (tok * 8 + h) * 64 + 32 * half; const float inv = 1.f / l1;
#pragma unroll
            for (int q = 0; q < 4; ++q) *(bf16x8*)(pp + 8 * q) = pack8(op[2 * q] * inv, op[2 * q + 1] * inv);
            if (half == 0) ((float*)(F.ws + (kind == 1 ? WS_L4 : WS_L16)))[tok * 8 + h] = l1;
        } else {
            const bf16* p4 = (const bf16*)(F.ws + WS_P4) + (tok * 8 + h) * 64 + 32 * half; const bf16* p16 = (const bf16*)(F.ws + WS_P16) + (tok * 8 + h) * 64 + 32 * half;
            const float l4 = ((const float*)(F.ws + WS_L4))[tok * 8 + h], l16 = ((const float*)(F.ws + WS_L16))[tok * 8 + h]; const float inv = 1.f / (l1 + l4 + l16);
            bf16* dst = mix + tok * 1024 + 512 + h * 64 + 32 * half;
#pragma unroll
            for (int q = 0; q < 4; ++q) { const u32x4 a4 = *(const u32x4*)(p4 + 8 * q), a16 = *(const u32x4*)(p16 + 8 * q);
                const f32x4 x0 = (op[2 * q] + (f32x4){bflo(a4.x), bfhi(a4.x), bflo(a4.y), bfhi(a4.y)} * l4 + (f32x4){bflo(a16.x), bfhi(a16.x), bflo(a16.y), bfhi(a16.y)} * l16) * inv;
                const f32x4 x1 = (op[2 * q + 1] + (f32x4){bflo(a4.z), bfhi(a4.z), bflo(a4.w), bfhi(a4.w)} * l4 + (f32x4){bflo(a16.z), bfhi(a16.z), bflo(a16.w), bfhi(a16.w)} * l16) * inv;
                *(bf16x8*)(dst + 8 * q) = pack8(x0, x1); }
        }
    }
    __syncthreads();
}

constexpr int RT_LCNT = 0, RT_BASE = 256, RT_RANK = 512;
__device__ __forceinline__ void route_phase(Frame& F, const Args& a) {
    const float* hsrc = a.out; const float* wrT = (const float*)(F.ws + WS_WRT); const float* b_r = a.in[13];
    int* te = (int*)(F.ws + WS_TE); int* tslot = (int*)(F.ws + WS_TSLOT); float* tg = (float*)(F.ws + WS_TG); int* list = (int*)(F.ws + WS_LIST); float* lrs = (float*)(F.ws + WS_LRS);
    LAS int* lcnt = (LAS int*)(F.lds + RT_LCNT); LAS int* lbase = (LAS int*)(F.lds + RT_BASE); LAS int* lrank = (LAS int*)(F.lds + RT_RANK);
    const int lane = F.lane, c = lane & 31, hh = lane >> 5;
    for (int blk = F.vcu; blk < T / 128; blk += F.G) {
        if (F.tid < 32) lcnt[F.tid] = 0;
        __syncthreads();
        int e4[4] = {0, 0, 0, 0}, rk[4] = {0, 0, 0, 0}; float g4[4] = {0.f, 0.f, 0.f, 0.f}; float rs = 0.f; const int tok = blk * 128 + (F.wave & 3) * 32 + c;
        f32x16 acc = {}; float ss = 0.f;
        { const int kh = F.wave >> 2; const float* hp = hsrc + (size_t)tok * D + 4 * hh + 512 * kh; const float* wp = wrT + (size_t)c * D + 4 * hh + 512 * kh;
#pragma unroll 8
            for (int q = 0; q < 64; ++q) { const f32x4 hv = *(const f32x4*)(hp + 8 * q), wv = *(const f32x4*)(wp + 8 * q);
                ss += (hv[0] * hv[0] + hv[1] * hv[1]) + (hv[2] * hv[2] + hv[3] * hv[3]);
#pragma unroll
                for (int i = 0; i < 4; ++i) acc = __builtin_amdgcn_mfma_f32_32x32x2f32(wv[i], hv[i], acc, 0, 0, 0); }
            LAS float* px = (LAS float*)(F.lds + 4096) + ((F.wave & 3) * 64 + lane) * 17;
            if (F.wave >= 4) {
#pragma unroll
                for (int r = 0; r < 16; ++r) px[r] = acc[r];
                px[16] = ss; }
            __syncthreads();
            if (F.wave < 4) {
#pragma unroll
                for (int r = 0; r < 16; ++r) acc[r] += px[r];
                ss += px[16]; } }
        if (F.wave < 4) {
            ss += __shfl_xor(ss, 32); rs = rsqrtf(ss * (1.f / D) + EPS);
            float tv[4] = {-3.0e38f, -3.0e38f, -3.0e38f, -3.0e38f}; int tix[4] = {0, 1, 2, 3};
#pragma unroll
            for (int reg = 0; reg < 16; ++reg) { const int e = (reg & 3) + 8 * (reg >> 2) + 4 * hh; float v = acc[reg] * rs + b_r[e]; int ix = e;
#pragma unroll
                for (int s = 0; s < 4; ++s) { const bool gt = (v > tv[s]) || (v == tv[s] && ix < tix[s]); const float ov = tv[s]; const int oi = tix[s]; tv[s] = gt ? v : ov; tix[s] = gt ? ix : oi; v = gt ? ov : v; ix = gt ? oi : ix; } }
            float pv[4]; int pi[4];
#pragma unroll
            for (int s = 0; s < 4; ++s) { pv[s] = __shfl_xor(tv[s], 32); pi[s] = __shfl_xor(tix[s], 32); }
#pragma unroll
            for (int t2 = 0; t2 < 4; ++t2) { float v = pv[t2]; int ix = pi[t2];
#pragma unroll
                for (int s = 0; s < 4; ++s) { const bool gt = (v > tv[s]) || (v == tv[s] && ix < tix[s]); const float ov = tv[s]; const int oi = tix[s]; tv[s] = gt ? v : ov; tix[s] = gt ? ix : oi; v = gt ? ov : v; ix = gt ? oi : ix; } }
            const float e0 = 1.f, e1 = __expf(tv[1] - tv[0]), e2 = __expf(tv[2] - tv[0]), e3 = __expf(tv[3] - tv[0]); const float inv = 1.f / (e0 + e1 + e2 + e3);
            g4[0] = e0 * inv; g4[1] = e1 * inv; g4[2] = e2 * inv; g4[3] = e3 * inv;
#pragma unroll
            for (int s = 0; s < 4; ++s) e4[s] = tix[s];
            if (hh == 0) {
#pragma unroll
                for (int s = 0; s < 4; ++s) rk[s] = atomicAdd((int*)(lcnt + e4[s]), 1);
            }
        }
        __syncthreads();
        if (F.tid < 32) lbase[F.tid] = (int)__hip_atomic_fetch_add(F.ctl + CW_GCNT + 64 * F.tid, (unsigned)lcnt[F.tid], RLX_AGENT);
        __syncthreads();
        if (F.wave < 4 && hh == 0) {
#pragma unroll
            for (int s = 0; s < 4; ++s) { const int slot = lbase[e4[s]] + rk[s]; te[tok * 4 + s] = e4[s]; tslot[tok * 4 + s] = slot; tg[tok * 4 + s] = g4[s];
                list[(size_t)e4[s] * LCAP + slot] = tok; lrs[(size_t)e4[s] * LCAP + slot] = rs; }
        }
        __syncthreads();
    }
}
__device__ __forceinline__ int moe_tables(Frame& F) {
    LAS int* tstart = (LAS int*)(F.lds + MOE_TSTART); LAS int* lcnt = (LAS int*)(F.lds + MOE_LCNT); LAS int* texp = (LAS int*)(F.lds + MOE_TEXP);
    if (F.tid == 0) { int acc = 0; for (int e = 0; e < NE; ++e) { const int cnt = (int)__hip_atomic_load(F.ctl + CW_GCNT + 64 * e, RLX_AGENT); lcnt[e] = cnt; tstart[e] = acc; const int nt = (cnt + 255) >> 8; for (int i = 0; i < nt; ++i) texp[acc + i] = e; acc += nt; } tstart[NE] = acc; }
    __syncthreads();
    return tstart[NE];
}
__device__ __forceinline__ void combine_phase(Frame& F, const Args& a, float* dst) {
    LAS int* tstart = (LAS int*)(F.lds + MOE_TSTART);
    const int* te = (const int*)(F.ws + WS_TE); const int* tslot = (const int*)(F.ws + WS_TSLOT); const float* tg = (const float*)(F.ws + WS_TG); const bf16* Y = (const bf16*)(F.ws + WS_Y);
    const float* out = a.out; const int gw = F.vcu * NWAVES + F.wave, NGW = F.G * NWAVES, lane = F.lane;
    for (int t0 = gw * 16; t0 < T; t0 += NGW * 16) {
        int pos[4]; float gt[4];
        { const int tl = t0 + (lane & 15);
#pragma unroll
            for (int s = 0; s < 4; ++s) { const int e = te[tl * 4 + s]; pos[s] = tstart[e] * 256 + tslot[tl * 4 + s]; gt[s] = tg[tl * 4 + s]; } }
#pragma unroll 1
        for (int i = 0; i < 16; i += 2) {
            f32x4 o[2][2][2]; u32x4 w[2][4][2];
#pragma unroll
            for (int q = 0; q < 2; ++q) { const float* op = out + (size_t)(t0 + i + q) * D + 8 * lane;
#pragma unroll
                for (int j = 0; j < 2; ++j) { o[q][j][0] = *(const f32x4*)(op + 512 * j); o[q][j][1] = *(const f32x4*)(op + 512 * j + 4); }
#pragma unroll
                for (int s = 0; s < 4; ++s) { const size_t p = (size_t)__builtin_amdgcn_readlane(pos[s], i + q); const bf16* yp = Y + p * D + 8 * lane;
#pragma unroll
                    for (int j = 0; j < 2; ++j) w[q][s][j] = *(const u32x4*)(yp + 512 * j); } }
#pragma unroll
            for (int q = 0; q < 2; ++q) { float* op = dst + (size_t)(t0 + i + q) * D + 8 * lane;
#pragma unroll
                for (int s = 0; s < 4; ++s) { const float g = __builtin_bit_cast(float, __builtin_amdgcn_readlane(__builtin_bit_cast(int, gt[s]), i + q));
#pragma unroll
                    for (int j = 0; j < 2; ++j) { const u32x4 ww = w[q][s][j];
                        o[q][j][0] += (f32x4){bflo(ww.x), bfhi(ww.x), bflo(ww.y), bfhi(ww.y)} * g; o[q][j][1] += (f32x4){bflo(ww.z), bfhi(ww.z), bflo(ww.w), bfhi(ww.w)} * g; } }
#pragma unroll
                for (int j = 0; j < 2; ++j) { *(f32x4*)(op + 512 * j) = o[q][j][0]; *(f32x4*)(op + 512 * j + 4) = o[q][j][1]; } }
        }
    }
}

constexpr int NPHASE = 9;
__global__ void __launch_bounds__(NTHREADS, 2) hymba_fwd(Args args) {
    extern __shared__ __attribute__((aligned(16))) unsigned char lds_raw[];
    Frame F; F.lds = (LAS unsigned char*)lds_raw; F.ws = args.ws; F.ctl = (unsigned*)(args.ws + WS_CTL);
    F.tid = threadIdx.x; F.lane = F.tid & 63; F.wave = __builtin_amdgcn_readfirstlane(F.tid >> 6);
    F.G = gridDim.x; { const int bx = blockIdx.x; F.vcu = (F.G % 8 == 0) ? (bx % 8) * (F.G / 8) + bx / 8 : bx; }
    volatile LAS unsigned* MISC = (volatile LAS unsigned*)(F.lds + MISC_OFF);
    if (F.tid < 32) MISC[F.tid] = 0u;
    __syncthreads();
    XcdBarrier bar; bar.bar = F.ctl + CW_BAR; bar.x = 0; bar.st = nullptr;
    if (MK_N_LAUNCHES == 1) bar = xcd_barrier_post(F.ctl + CW_BAR, MISC + 8);
    const int lo = args.ph_lo, hi = args.ph_hi;
#define IN(k) (lo <= (k) && (k) < hi)
#define SEAM(k) do { if (IN(k) && IN((k) + 1)) xcd_barrier(bar); } while (0)

    if (IN(0)) { for (int rep = 0; rep < (DUP == 4 ? 2 : 1); ++rep) phase0(F, args); SEAM(0); }
    if (IN(1)) {
        pg8::Gemm g{(const bf16*)(F.ws + WS_XN), (const bf16*)(F.ws + WS_WIN), D}; pg8::StaticOrder S{T / 256, NIN / 256, F.G, (int)blockIdx.x};
        pg8::EpiInProj E{(bf16*)(F.ws + WS_ZG), (bf16*)(F.ws + WS_QB), (bf16*)(F.ws + WS_KB), (bf16*)(F.ws + WS_VB), args.in[7], args.in[8]};
        pg8::gemm_phase<pg8::EpiInProj, pg8::StaticOrder, false, true>(F.lds, g, S, E);
        SEAM(1);
    }
    if (IN(2)) {
        for (int rep = 0; rep < (DUP == 1 ? 2 : 1); ++rep)
        for (int u = F.vcu; u < NBATCH * GH * NCHUNK; u += F.G) gdn_prep_unit(F, args, u);
        SEAM(2);
    }
    if (IN(3)) {
        const int nscan = NBATCH * GH;
        for (int rep3 = 0; rep3 < (DUP == 13 ? 2 : 1); ++rep3) {
        for (int bh = blockIdx.x; bh < nscan; bh += F.G) for (int rep = 0; rep < (DUP == 3 ? 2 : 1); ++rep) gdn_scan(F, args, bh);
        if (rep3 == 0) { if (F.G > nscan) { if ((int)blockIdx.x >= nscan) p0_experts(F, args, ((int)blockIdx.x - nscan) * NWAVES + F.wave, (F.G - nscan) * NWAVES); } else p0_experts(F, args, (int)blockIdx.x * NWAVES + F.wave, F.G * NWAVES); __syncthreads(); }
        for (int pass = 0; pass < 2; ++pass) {
            for (int rep = 0; rep < (DUP == 2 ? 2 : 1); ++rep)
            for (;;) {
                if (F.tid == 0) MISC[16] = __hip_atomic_fetch_add(F.ctl + CW_ATTQ + 64 * (pass + 2 * rep + 4 * rep3), 1u, RLX_AGENT);
                __syncthreads();
                const int u = (int)MISC[16] + (pass ? 2048 : 0);
                __syncthreads();
                if (u >= (pass ? 3072 : 2048)) break;
                attn_unit(F, args, u);
            }
            if (pass == 0 || DUP == 13) xcd_barrier(bar);
        } }
        SEAM(3);
    }
    if (IN(4)) {
        pg8::Gemm g{(const bf16*)(F.ws + WS_MIX), (const bf16*)(F.ws + WS_WOUT), D}; pg8::StaticOrder S{T / 256, D / 256, F.G, (int)blockIdx.x};
        pg8::EpiOutProj E{args.in[0], args.out, F.ws + WS_HB};
        for (int rep = 0; rep < (DUP == 6 ? 2 : 1); ++rep) { pg8::gemm_phase<pg8::EpiOutProj, pg8::StaticOrder, false, true>(F.lds, g, S, E); __syncthreads(); }
        SEAM(4);
    }
#if !SKIP_MOE
    if (IN(5)) {
        if (DUP == 10) { route_phase(F, args); xcd_barrier(bar); if (blockIdx.x == 0 && F.tid < 32) __hip_atomic_store(F.ctl + CW_GCNT + 64 * F.tid, 0u, RLX_AGENT); xcd_barrier(bar); }
        route_phase(F, args); SEAM(5); }
    if (IN(6)) {
        const int nM = moe_tables(F);
        pg8::Gemm g{(const bf16*)(F.ws + WS_HB), (const bf16*)(F.ws + WS_WGU), D};
        pg8::MoeOrder S{nM, 8, F.G, (int)blockIdx.x, (const LAS int*)(F.lds + MOE_TSTART), (const LAS int*)(F.lds + MOE_LCNT), (const LAS int*)(F.lds + MOE_TEXP), (const int*)(F.ws + WS_LIST)};
        pg8::EpiGateUp E{F.ws + WS_ACT, args.in[15], (const float*)(F.ws + WS_LRS), (const LAS int*)(F.lds + MOE_LCNT)};
        for (int rep = 0; rep < (DUP == 7 ? 2 : 1); ++rep) { pg8::gemm_phase<pg8::EpiGateUp, pg8::MoeOrder, true, true, true>(F.lds, g, S, E); __syncthreads(); }
        SEAM(6);
    }
    if (IN(7)) {
        const int nM = moe_tables(F);
        pg8::Gemm g{(const bf16*)(F.ws + WS_ACT), (const bf16*)(F.ws + WS_WDN), FF};
        pg8::MoeOrder S{nM, 4, F.G, (int)blockIdx.x, (const LAS int*)(F.lds + MOE_TSTART), (const LAS int*)(F.lds + MOE_LCNT), (const LAS int*)(F.lds + MOE_TEXP), (const int*)(F.ws + WS_LIST)};
        pg8::EpiDown E{(bf16*)(F.ws + WS_Y), args.in[17]};
        for (int rep = 0; rep < (DUP == 8 ? 2 : 1); ++rep) { pg8::gemm_phase<pg8::EpiDown, pg8::MoeOrder, false, true, true>(F.lds, g, S, E); __syncthreads(); }
        SEAM(7);
    }
    if (IN(8)) { (void)moe_tables(F); if (DUP == 11) combine_phase(F, args, (float*)(F.ws + WS_ZG)); combine_phase(F, args, args.out); }
#endif
#undef IN
#undef SEAM
}

extern "C" void kernel_launch(void* const* d_in, const int* in_sizes, int n_in, void* d_out, int out_size, void* d_ws, size_t ws_size, hipStream_t stream) {
    static int grid = 0;
    if (grid == 0) {
        if (n_in != 18 || in_sizes[0] != T * D || out_size != T * D || ws_size < WS_END) { fprintf(stderr, "kernel_launch: unexpected shapes (n_in %d, in0 %d, out %d, ws %zu)\n", n_in, n_in > 0 ? in_sizes[0] : -1, out_size, ws_size); grid = -1; return; }
        int dev = 0, cus = 0, per_cu = 0;
        if (hipGetDevice(&dev) != hipSuccess || hipDeviceGetAttribute(&cus, hipDeviceAttributeMultiprocessorCount, dev) != hipSuccess) { grid = -1; return; }
        if (hipFuncSetAttribute((const void*)hymba_fwd, hipFuncAttributeMaxDynamicSharedMemorySize, LDS_BYTES) != hipSuccess) { fprintf(stderr, "kernel_launch: hipFuncSetAttribute failed\n"); grid = -1; return; }
        if (hipOccupancyMaxActiveBlocksPerMultiprocessor(&per_cu, (const void*)hymba_fwd, NTHREADS, LDS_BYTES) != hipSuccess || per_cu < 1) { fprintf(stderr, "kernel_launch: occupancy query says %d\n", per_cu); per_cu = 1; }
        (void)hipGetLastError();
        grid = cus;
    }
    if (grid < 0) return;
    (void)hipMemsetAsync((char*)d_ws + WS_CTL, 0, CTL_ZERO_BYTES, stream);
    Args a{};
    for (int i = 0; i < 18; ++i) a.in[i] = (const float*)d_in[i];
    a.out = (float*)d_out; a.ws = (unsigned char*)d_ws;
    if (MK_N_LAUNCHES == 1) {
        a.ph_lo = 0; a.ph_hi = NPHASE; a.li = 0;
        void* kargs[] = {&a};
        hipError_t e = hipLaunchCooperativeKernel((const void*)hymba_fwd, dim3(grid), dim3(NTHREADS), kargs, LDS_BYTES, stream);
        if (e != hipSuccess) fprintf(stderr, "kernel_launch: cooperative launch failed: %s (grid %d)\n", hipGetErrorString(e), grid);
    } else {
        for (int p = 0; p < NPHASE; ++p) { a.ph_lo = p; a.ph_hi = p + 1; a.li = p; hipLaunchKernelGGL(hymba_fwd, dim3(grid), dim3(NTHREADS), LDS_BYTES, stream, a); }
    }
}
```

```cpp
#include <hip/hip_runtime.h>
#include <cstdio>
#include <cstdint>

#ifndef MK_N_LAUNCHES
#define MK_N_LAUNCHES 1
#endif
#ifndef SKIP_ATTN
#define SKIP_ATTN 0
#endif
#ifndef DUP
#define DUP 0
#endif
#ifndef ATT_JOBS
#define ATT_JOBS 32
#endif
#ifndef SKIP_MOE
#define SKIP_MOE 0
#endif

#define LAS __attribute__((address_space(3)))
#define GAS __attribute__((address_space(1)))
typedef unsigned short bf16;
typedef short bf16x8 __attribute__((ext_vector_type(8)));
typedef short s16x4 __attribute__((ext_vector_type(4)));
typedef float f32x2 __attribute__((ext_vector_type(2)));
typedef float f32x4 __attribute__((ext_vector_type(4)));
typedef float f32x16 __attribute__((ext_vector_type(16)));
typedef unsigned u32x2 __attribute__((ext_vector_type(2)));
typedef unsigned u32x4 __attribute__((ext_vector_type(4)));
typedef __bf16 bf16x2_t __attribute__((ext_vector_type(2)));
typedef int v4i_t __attribute__((ext_vector_type(4)));
typedef int v8i_t __attribute__((ext_vector_type(8)));

constexpr int NBATCH = 8, SEQ = 4096, D = 1024, T = NBATCH * SEQ;
constexpr int IN_DIM = 3592, NIN = 3584;
constexpr int GH = 4, DK = 128, CHUNK = 64, NCHUNK = SEQ / CHUNK;
constexpr int AH = 8, DH = 64;
constexpr int NE = 32, FF = 1024, LCAP = 32768;
constexpr float EPS = 1e-6f, LOG2E = 1.4426950408889634f;
constexpr int NWAVES = 8, NTHREADS = 512;

constexpr size_t MiB = 1u << 20;
constexpr size_t WS_CTL = 0, CTL_ZERO_BYTES = 1 * MiB;
constexpr size_t WS_WIN = 1 * MiB, WS_WOUT = 8 * MiB, WS_WGU = 10 * MiB, WS_WDN = 138 * MiB;
constexpr size_t WS_TE = 202 * MiB, WS_TSLOT = WS_TE + 512 * 1024, WS_TG = WS_TSLOT + 512 * 1024;
constexpr size_t WS_LIST = 204 * MiB, WS_LRS = 208 * MiB;
constexpr size_t WS_BA = 212 * MiB, WS_WRT = 213 * MiB;
constexpr size_t WS_ZG = 214 * MiB, WS_QB = 342 * MiB, WS_KB = 374 * MiB, WS_VB = 406 * MiB;
constexpr size_t WS_PREP = 438 * MiB;
constexpr int PREP_WP = 0, PREP_QP = 16384, PREP_AP = 32768, PREP_KT = 40960, PREP_UP = 57344, PREP_CD = 90112, PREP_REC = 90368;
constexpr size_t WS_OG = 616 * MiB, WS_MIX = 680 * MiB;
constexpr size_t WS_XN = 760 * MiB, WS_HB = 760 * MiB;
constexpr size_t WS_ACT = 214 * MiB, WS_Y = 486 * MiB, WS_END = 824 * MiB;
static_assert(WS_VB - WS_KB == WS_KB - WS_QB, "q/k/v stride");
static_assert(WS_PREP + (size_t)NBATCH * GH * NCHUNK * PREP_REC <= WS_OG, "prep region");
static_assert(WS_ACT + (size_t)(T * 4 + NE * 256) * FF * 2 <= WS_Y && WS_Y + (size_t)(T * 4 + NE * 256) * D * 2 <= WS_HB, "act/y regions");
constexpr int CW_TMO = 0, CW_CODE = 1, CW_ATTQ = 512, CW_GCNT = 1024  , CW_BAR = 8192;

constexpr int LDS_BYTES = 160 * 1024;
constexpr int RING_BYTES = 131072;
constexpr int TOP_OFF = LDS_BYTES - 4096;
constexpr int MISC_OFF = TOP_OFF;
constexpr int MOE_TAB_OFF = TOP_OFF + 256;
constexpr int MOE_TSTART = MOE_TAB_OFF, MOE_LCNT = MOE_TAB_OFF + 256, MOE_TEXP = MOE_TAB_OFF + 512;

#define RLX_AGENT __ATOMIC_RELAXED, __HIP_MEMORY_SCOPE_AGENT
#define LDS_WAIT() asm volatile("s_waitcnt lgkmcnt(0)" ::: "memory")
#define VM_WAIT() asm volatile("s_waitcnt vmcnt(0)" ::: "memory")
__device__ __forceinline__ unsigned pk2(float lo, float hi) { f32x2 v = {lo, hi}; bf16x2_t b = __builtin_convertvector(v, bf16x2_t); return __builtin_bit_cast(unsigned, b); }
__device__ __forceinline__ unsigned pk4_fp8(float a, float b, float c, float d) { int w = 0; w = __builtin_amdgcn_cvt_pk_fp8_f32(a, b, w, false); w = __builtin_amdgcn_cvt_pk_fp8_f32(c, d, w, true); return (unsigned)w; }
__device__ __forceinline__ float bf2f(unsigned short b) { return __uint_as_float((unsigned)b << 16); }
__device__ __forceinline__ float bflo(unsigned w) { return __uint_as_float(w << 16); }
__device__ __forceinline__ float bfhi(unsigned w) { return __uint_as_float(w & 0xffff0000u); }
__device__ __forceinline__ float wave_sum(float v) {
#pragma unroll
    for (int o = 1; o < 64; o <<= 1) v += __shfl_xor(v, o);
    return v;
}
__device__ __forceinline__ float silu_f(float x) { return x / (1.f + __expf(-x)); }
__device__ __forceinline__ float sigmoid_f(float x) { return 1.f / (1.f + __expf(-x)); }
__device__ __forceinline__ bf16x8 pack8(f32x4 a, f32x4 b) {
    u32x4 w; w.x = pk2(a[0], a[1]); w.y = pk2(a[2], a[3]); w.z = pk2(b[0], b[1]); w.w = pk2(b[2], b[3]); return __builtin_bit_cast(bf16x8, w);
}

__device__ __forceinline__ void glds16_asm(const void* gsrc, unsigned lds_dst) { unsigned keep;
    asm volatile("s_mov_b32 %0, m0\n\ts_mov_b32 m0, %2\n\ts_nop 0\n\tglobal_load_lds_dwordx4 %1, off\n\ts_mov_b32 m0, %0" : "=&s"(keep) : "v"(gsrc), "s"(lds_dst) : "memory"); }

namespace pg8 {
constexpr int BM = 256, BK = 64, HALF = 128, HTB = HALF * BK * 2, STAGE_BYTES = 8 * HTB, NXCD = 8, WGM = 8;
__host__ __device__ __forceinline__ int lds_byte(int r, int c) { const int st = (r >> 4) * 2 + (c >> 5), rr = r & 15, cc = c & 31, ob = rr * 64 + cc * 2; return st * 1024 + (ob ^ (((ob >> 9) & 1) << 5)); }
__host__ __device__ __forceinline__ void stage_rc(int b, int& R, int& C) { const int st = b / 1024, sb = b % 1024, swz = sb ^ (((sb >> 9) & 1) << 5); R = (st >> 1) * 16 + swz / 64; C = (st & 1) * 32 + (swz % 64) / 2; }
__host__ __device__ __forceinline__ int perm32(int rho) { const int n = rho >> 4, i = rho & 15; return 8 * (i >> 2) + 4 * n + (i & 3); }

struct Unit { int pm, pn, pb, e, mt; };
struct Gemm { const bf16* A; const bf16* Bt; int K; };

__device__ __forceinline__ bool static_tile(int i, int G, int c, int nM, int nN, int& pm, int& pn) {
    const int nwg = nM * nN; const long L = (long)i * G + c; if (L >= nwg) return false;
    int wgid = (int)L; { const int q = nwg / NXCD, r = nwg % NXCD, xcd = wgid % NXCD, off = wgid / NXCD; wgid = (xcd < r ? xcd * (q + 1) : r * (q + 1) + (xcd - r) * q) + off; }
    const int nig = WGM * nN, gid = wgid / nig, fm = gid * WGM, gsz = (nM - fm) < WGM ? (nM - fm) : WGM;
    pm = fm + ((wgid % nig) % gsz); pn = (wgid % nig) / gsz; return true;
}
struct StaticOrder {
    int nM, nN, G, c;
    __device__ __forceinline__ bool next(int i, Unit& u) const { int pm, pn; if (!static_tile(i, G, c, nM, nN, pm, pn)) return false; u.pm = pm; u.pn = pn; u.pb = pn; u.e = 0; u.mt = 0; return true; }
    __device__ __forceinline__ int row_index(const Unit&, int) const { return 0; }
};
struct MoeOrder {
    int nM, nN, G, c; const LAS int* tstart; const LAS int* lcnt; const LAS int* texp; const int* list;
    __device__ __forceinline__ bool next(int i, Unit& u) const {
        int pm, pn; if (!static_tile(i, G, c, nM, nN, pm, pn)) return false;
        const int e = texp[pm]; u.pm = pm; u.pn = pn; u.e = e; u.pb = e * nN + pn; u.mt = pm - tstart[e]; return true;
    }
    __device__ __forceinline__ int row_index(const Unit& u, int r) const { const int rr = u.mt * 256 + r; return rr < lcnt[u.e] ? list[u.e * LCAP + rr] : 0; }
};

#define PG8_SA(b, h) (((b) * 2 + (h)) * HTB)
#define PG8_SB(b, h) ((4 + (b) * 2 + (h)) * HTB)
#define PG8_GLDS(src, dstoff) __builtin_amdgcn_global_load_lds((const unsigned*)(src), (LAS unsigned*)(lds + (dstoff)), 16, 0, 0)
#define PG8_STAGE_B(bufoff, nx, kb, h) do { _Pragma("unroll") for (int _i = 0; _i < 2; ++_i) \
        PG8_GLDS(((nx) ? nB : cB) + (kb) + (Epi::WIDE ? (size_t)voffBW[h][_i] : (size_t)(h) * hstep + voffB[_i]), (bufoff) + ldsw + _i * 8192); } while (0)
#define PG8_STAGE_A(bufoff, nx, kb, h) do { _Pragma("unroll") for (int _i = 0; _i < 2; ++_i) \
        PG8_GLDS(GATHER ? (const char*)g.A + (kb) + ((nx) ? voffN[h][_i] : voffC[h][_i]) : ((nx) ? nA : cA) + (kb) + (size_t)(h) * hstep + voffA[_i], (bufoff) + ldsw + _i * 8192); } while (0)
#define PG8_LDA8(dst, b, h) do { _Pragma("unroll") for (int m = 0; m < 4; ++m) { const v4i_t lo_ = *(const LAS v4i_t*)(lds + PG8_SA(b, h) + aoff + m * 2048), hi_ = *(const LAS v4i_t*)(lds + PG8_SA(b, h) + aoff + m * 2048 + 1024); dst[m] = __builtin_shufflevector(lo_, hi_, 0, 1, 2, 3, 4, 5, 6, 7); } } while (0)
#define PG8_LDB8(dst, b, h) do { _Pragma("unroll") for (int n = 0; n < 2; ++n) { const v4i_t lo_ = *(const LAS v4i_t*)(lds + PG8_SB(b, h) + boff + n * 2048), hi_ = *(const LAS v4i_t*)(lds + PG8_SB(b, h) + boff + n * 2048 + 1024); dst[n] = __builtin_shufflevector(lo_, hi_, 0, 1, 2, 3, 4, 5, 6, 7); } } while (0)
#define PG8_LDA(dst, b, h) do { _Pragma("unroll") for (int m = 0; m < 4; ++m) _Pragma("unroll") for (int k = 0; k < 2; ++k) dst[m][k] = *(const LAS bf16x8*)(lds + PG8_SA(b, h) + aoff + m * 2048 + k * 1024); } while (0)
#define PG8_LDB(dst, b, h) do { _Pragma("unroll") for (int n = 0; n < 2; ++n) _Pragma("unroll") for (int k = 0; k < 2; ++k) dst[n][k] = *(const LAS bf16x8*)(lds + PG8_SB(b, h) + boff + n * 2048 + k * 1024); } while (0)
#define PG8_MMA(ai, bj, At, Bt) do { __builtin_amdgcn_s_setprio(1); _Pragma("unroll") for (int m = 0; m < 4; ++m) _Pragma("unroll") for (int n = 0; n < 2; ++n) _Pragma("unroll") for (int k = 0; k < 2; ++k) \
        acc[ai][bj][m][n] = __builtin_amdgcn_mfma_f32_16x16x32_bf16(Bt[n][k], At[m][k], acc[ai][bj][m][n], 0, 0, 0); __builtin_amdgcn_s_setprio(0); } while (0)
#define PG8_MMA8(ai, bj, At, Bt) do { __builtin_amdgcn_s_setprio(1); _Pragma("unroll") for (int m = 0; m < 4; ++m) _Pragma("unroll") for (int n = 0; n < 2; ++n) \
        asm volatile("v_mfma_scale_f32_16x16x128_f8f6f4 %0, %1, %2, %0, %3, %4 op_sel_hi:[0,0,0]" : "+v"(acc[ai][bj][m][n]) : "v"(Bt[n]), "v"(At[m]), "v"(sc_w), "v"(sc_a)); __builtin_amdgcn_s_setprio(0); } while (0)
#define XLDA(b, h) do { if constexpr (FP8) PG8_LDA8(At8, b, h); else PG8_LDA(At, b, h); } while (0)
#define XLDB0(b, h) do { if constexpr (FP8) PG8_LDB8(B08, b, h); else PG8_LDB(B0, b, h); } while (0)
#define XLDB1(b, h) do { if constexpr (FP8) PG8_LDB8(B18, b, h); else PG8_LDB(B1, b, h); } while (0)
#define XMMA0(ai, bj) do { if constexpr (FP8) PG8_MMA8(ai, bj, At8, B08); else PG8_MMA(ai, bj, At, B0); } while (0)
#define XMMA1(ai, bj) do { if constexpr (FP8) PG8_MMA8(ai, bj, At8, B18); else PG8_MMA(ai, bj, At, B1); } while (0)
#define PG8_WAIT_V(n) asm volatile("s_waitcnt vmcnt(" #n ")" ::: "memory")
#define PG8_WAIT_L(n) asm volatile("s_waitcnt lgkmcnt(" #n ")" ::: "memory")
#define PG8_BAR __builtin_amdgcn_s_barrier()
#define PG8_SCHED __builtin_amdgcn_sched_barrier(0)

template <class Epi, class Sched, bool GATHER, bool ALIGN_EPI, bool FP8 = false>
__device__ __forceinline__ void gemm_phase(LAS unsigned char* lds, const Gemm g, const Sched& S, const Epi& E) {
    const int tid = threadIdx.x, wid = __builtin_amdgcn_readfirstlane(tid >> 6), lane = tid & 63, wr = wid >> 2, wc = wid & 3, fr = lane & 15, fq = lane >> 4;
    const int K = g.K, rowb = FP8 ? K : 2 * K, nt = rowb / 128;
    unsigned voffA[2], voffB[2], voffBW[2][2], voffC[2][2], voffN[2][2]; int RA[2], CA[2];
#pragma unroll
    for (int i = 0; i < 2; ++i) { int R, C; stage_rc(tid * 16 + i * 8192, R, C); const int Rb = Epi::PERM ? ((R & ~31) + perm32(R & 31)) : R;
        RA[i] = R; CA[i] = C; voffA[i] = (unsigned)(R * rowb + C * 2); voffB[i] = (unsigned)(Rb * rowb + C * 2);
        voffBW[0][i] = (unsigned)((64 * (R >> 5) + perm32(R & 31)) * rowb + C * 2); voffBW[1][i] = (unsigned)((64 * (R >> 5) + 32 + perm32(R & 31)) * rowb + C * 2); }
    const size_t kstep = (size_t)(BK * 2), hstep = (size_t)HALF * rowb, tstep = 2 * hstep;
    const unsigned ldsw = (unsigned)wid * 1024u;
    const int aoff = lds_byte(wr * 64 + fr, fq * 8), boff = lds_byte(wc * 32 + fr, fq * 8);
    Unit cur, nxt; int ui = 0;
    if (!S.next(0, cur)) return;
    f32x4 acc[2][2][4][2];
#pragma unroll
    for (int a = 0; a < 2; ++a)
#pragma unroll
        for (int b = 0; b < 2; ++b)
#pragma unroll
            for (int m = 0; m < 4; ++m)
#pragma unroll
                for (int n = 0; n < 2; ++n) acc[a][b][m][n] = (f32x4){0.f, 0.f, 0.f, 0.f};
    bf16x8 At[4][2], B0[2][2], B1[2][2]; v8i_t At8[4], B08[2], B18[2]; int sc_w = 0x7a7a7a7a, sc_a = 0x7f7f7f7f; asm volatile("" : "+v"(sc_w), "+v"(sc_a));
    const char* cA = (const char*)g.A + (size_t)cur.pm * tstep; const char* cB = (const char*)g.Bt + (size_t)cur.pb * tstep;
    if (GATHER) {
#pragma unroll
        for (int h = 0; h < 2; ++h)
#pragma unroll
            for (int i = 0; i < 2; ++i) { voffC[h][i] = (unsigned)(S.row_index(cur, RA[i] + 128 * h) * rowb + CA[i] * 2); voffN[h][i] = voffC[h][i]; }
    }
    const char* nA = cA; const char* nB = cB;
    PG8_STAGE_B(PG8_SB(0, 0), false, 0, 0); PG8_STAGE_B(PG8_SB(0, 1), false, 0, 1); PG8_STAGE_A(PG8_SA(0, 0), false, 0, 0); PG8_STAGE_A(PG8_SA(0, 1), false, 0, 1);
    if (wr == 1) PG8_BAR;
    PG8_WAIT_V(2); PG8_BAR;
    PG8_STAGE_B(PG8_SB(1, 0), false, kstep, 0); PG8_STAGE_A(PG8_SA(1, 0), false, kstep, 0); PG8_STAGE_B(PG8_SB(1, 1), false, kstep, 1);
    PG8_WAIT_V(6); PG8_BAR;
    for (;;) {
        const bool has_next = S.next(ui + 1, nxt);
        nA = has_next ? (const char*)g.A + (size_t)nxt.pm * tstep : cA; nB = has_next ? (const char*)g.Bt + (size_t)nxt.pb * tstep : cB;
        if (GATHER) {
#pragma unroll
            for (int h = 0; h < 2; ++h)
#pragma unroll
                for (int i = 0; i < 2; ++i) voffN[h][i] = has_next ? (unsigned)(S.row_index(nxt, RA[i] + 128 * h) * rowb + CA[i] * 2) : voffC[h][i];
        }
        for (int t = 0; t < nt; t += 2) {
            const bool last = (t == nt - 2);
            const size_t k1 = (size_t)(t + 1) * kstep, k2 = last ? 0 : (size_t)(t + 2) * kstep, k3 = k2 + kstep;
            XLDB0(0, 0); XLDB1(0, 1); PG8_SCHED; XLDA(0, 0); PG8_STAGE_A(PG8_SA(1, 1), false, k1, 1);
            PG8_WAIT_V(8); PG8_WAIT_L(0); PG8_BAR; XMMA0(0, 0); XMMA1(0, 1); PG8_BAR; PG8_SCHED;
            XLDA(0, 1); PG8_STAGE_B(PG8_SB(0, 0), last, k2, 0); PG8_STAGE_B(PG8_SB(0, 1), last, k2, 1); PG8_STAGE_A(PG8_SA(0, 0), last, k2, 0);
            PG8_WAIT_V(8); PG8_WAIT_L(0); PG8_BAR; XMMA0(1, 0); XMMA1(1, 1); PG8_BAR; PG8_SCHED;
            XLDB0(1, 0); XLDB1(1, 1); PG8_SCHED; XLDA(1, 0); PG8_STAGE_A(PG8_SA(0, 1), last, k2, 1);
            PG8_WAIT_V(8); PG8_WAIT_L(0); PG8_BAR; XMMA0(0, 0); XMMA1(0, 1); PG8_BAR; PG8_SCHED;
            XLDA(1, 1); PG8_STAGE_B(PG8_SB(1, 0), last, k3, 0); PG8_STAGE_B(PG8_SB(1, 1), last, k3, 1); PG8_STAGE_A(PG8_SA(1, 0), last, k3, 0);
            PG8_WAIT_V(8); PG8_WAIT_L(0); PG8_BAR; XMMA0(1, 0); XMMA1(1, 1); PG8_BAR; PG8_SCHED;
        }
        if constexpr (ALIGN_EPI) { if (wr == 0) PG8_BAR; }
        if constexpr (FP8) asm volatile("s_nop 15\n\ts_nop 15" ::: "memory");
        E(acc, cur, wr, wc, fr, fq);
        if (DUP == 14) { asm volatile("" ::: "memory"); E(acc, cur, wr, wc, fr, fq); }
        if (!has_next) break;
#pragma unroll
        for (int a = 0; a < 2; ++a)
#pragma unroll
            for (int b = 0; b < 2; ++b)
#pragma unroll
                for (int m = 0; m < 4; ++m)
#pragma unroll
                    for (int n = 0; n < 2; ++n) acc[a][b][m][n] = (f32x4){0.f, 0.f, 0.f, 0.f};
        cur = nxt; cA = nA; cB = nB; ++ui;
        if (GATHER) {
#pragma unroll
            for (int h = 0; h < 2; ++h)
#pragma unroll
                for (int i = 0; i < 2; ++i) voffC[h][i] = voffN[h][i];
        }
        if constexpr (ALIGN_EPI) { if (wr == 1) PG8_BAR; }
    }
    PG8_WAIT_V(0);
    if constexpr (!ALIGN_EPI) { if (wr == 0) PG8_BAR; }
    PG8_BAR;
}

struct EpiInProj {
    static constexpr bool PERM = true, WIDE = true;
    bf16* zg; bf16* qb; bf16* kb; bf16* vb; const float* qn; const float* kn; LAS unsigned char* stage;
    __device__ __forceinline__ void operator()(const f32x4 (&acc)[2][2][4][2], const Unit& u, int wr, int wc, int fr, int fq) const {
        const int lane = fq * 16 + fr; LAS unsigned char* stg = stage + (wr * 4 + wc) * 3584;
        const bool swa = u.pn >= 8; const int sec = swa ? (u.pn - 8) >> 1 : 0, head = 4 * ((u.pn - 8) & 1) + wc;
        bf16* dst = qb + (size_t)sec * ((WS_KB - WS_QB) / 2); const float* nw = (sec == 1) ? kn : qn;
        f32x4 wv[2][2];
#pragma unroll
        for (int bj = 0; bj < 2; ++bj)
#pragma unroll
            for (int n = 0; n < 2; ++n) { const f32x4 t_ = *(const f32x4*)(nw + 32 * bj + 8 * fq + 4 * n); wv[bj][n] = (swa && sec < 2) ? t_ : (f32x4){1.f, 1.f, 1.f, 1.f}; }
#pragma unroll
        for (int ai = 0; ai < 2; ++ai)
#pragma unroll
            for (int m = 0; m < 4; ++m) {
                float sc = 1.f;
                if (swa && sec < 2) { float ss = 0.f;
#pragma unroll
                    for (int bj = 0; bj < 2; ++bj)
#pragma unroll
                        for (int n = 0; n < 2; ++n) { const f32x4 x = acc[ai][bj][m][n]; ss += (x[0] * x[0] + x[1] * x[1]) + (x[2] * x[2] + x[3] * x[3]); }
                    ss += __shfl_xor(ss, 16); ss += __shfl_xor(ss, 32);
                    sc = rsqrtf(ss * (1.f / 64.f) + EPS) * (sec == 0 ? 0.125f * LOG2E : 1.f); }
#pragma unroll
                for (int bj = 0; bj < 2; ++bj) { const f32x4 v0 = acc[ai][bj][m][0] * sc * wv[bj][0], v1 = acc[ai][bj][m][1] * sc * wv[bj][1];
                    u32x4 w; w.x = pk2(v0[0], v0[1]); w.y = pk2(v0[2], v0[3]); w.z = pk2(v1[0], v1[1]); w.w = pk2(v1[2], v1[3]); *(LAS u32x4*)(stg + fr * 144 + bj * 64 + fq * 16) = w; }
                asm volatile("s_waitcnt lgkmcnt(0)" ::: "memory");
                const int row0 = u.pm * BM + ai * HALF + wr * 64 + m * 16;
#pragma unroll
                for (int hf = 0; hf < 2; ++hf) { const int rr = hf * 8 + (lane >> 3), c16 = lane & 7, row_ = row0 + rr; const u32x4 w = *(const LAS u32x4*)(stg + rr * 144 + c16 * 16);
                    bf16* gp = swa ? dst + ((size_t)((row_ >> 12) * AH + head) * SEQ + (row_ & (SEQ - 1))) * 64 + 8 * c16 : zg + (size_t)row_ * 2048 + u.pn * BM + wc * 64 + 8 * c16;
                    *(u32x4*)gp = w; }
                asm volatile("s_waitcnt lgkmcnt(0)" ::: "memory"); }
    }
};
struct EpiOutProj {
    static constexpr bool PERM = false, WIDE = false;
    const float* x; float* h; unsigned char* hb;
    __device__ __forceinline__ void operator()(const f32x4 (&acc)[2][2][4][2], const Unit& u, int wr, int wc, int fr, int fq) const {
        const int row0 = u.pm * BM + wr * 64 + fr, col0 = u.pn * BM + wc * 32 + 4 * fq;
#pragma unroll
        for (int ai = 0; ai < 2; ++ai)
#pragma unroll
            for (int m = 0; m < 4; ++m) { const size_t off = (size_t)(row0 + ai * HALF + m * 16) * D + col0;
#pragma unroll
                for (int bj = 0; bj < 2; ++bj)
#pragma unroll
                    for (int n = 0; n < 2; ++n) { const f32x4 v = *(const f32x4*)(x + off + bj * HALF + n * 16) + acc[ai][bj][m][n];
                        *(f32x4*)(h + off + bj * HALF + n * 16) = v; *(unsigned*)(hb + off + bj * HALF + n * 16) = pk4_fp8(v[0], v[1], v[2], v[3]); } }
    }
};
struct EpiGateUp {
    static constexpr bool PERM = true, WIDE = false;
    unsigned char* act; const float* bgu; const float* lrs; const LAS int* lcnt;
    __device__ __forceinline__ void operator()(const f32x4 (&acc)[2][2][4][2], const Unit& u, int wr, int wc, int fr, int fq) const {
        const int cl = wc * 32 + 8 * fq; const float* bg = bgu + (size_t)u.e * 2048 + 128 * u.pn + cl;
        f32x4 bgv[2], buv[2];
#pragma unroll
        for (int n = 0; n < 2; ++n) { bgv[n] = *(const f32x4*)(bg + 4 * n); buv[n] = *(const f32x4*)(bg + 1024 + 4 * n); }
        const int cnt = lcnt[u.e];
#pragma unroll
        for (int ai = 0; ai < 2; ++ai)
#pragma unroll
            for (int m = 0; m < 4; ++m) { const int r = ai * HALF + wr * 64 + m * 16 + fr, rr = u.mt * 256 + r;
                const float rs = rr < cnt ? lrs[(size_t)u.e * LCAP + rr] : 0.f;
                unsigned wq[2];
#pragma unroll
                for (int n = 0; n < 2; ++n) { float a[4];
#pragma unroll
                    for (int i = 0; i < 4; ++i) { const float gt = fminf(acc[ai][0][m][n][i] * rs + bgv[n][i], 7.f); const float up = fminf(fmaxf(acc[ai][1][m][n][i] * rs + buv[n][i], -7.f), 7.f);
                        a[i] = (up + 1.f) * gt * sigmoid_f(1.702f * gt); }
                    wq[n] = pk4_fp8(a[0], a[1], a[2], a[3]); }
                *(u32x2*)(act + (size_t)(u.pm * BM + r) * FF + 128 * u.pn + cl) = (u32x2){wq[0], wq[1]}; }
    }
};
struct EpiDown {
    static constexpr bool PERM = true, WIDE = true;
    unsigned char* y; const float* bdn; LAS unsigned char* stage;
    __device__ __forceinline__ void operator()(const f32x4 (&acc)[2][2][4][2], const Unit& u, int wr, int wc, int fr, int fq) const {
        const int colw = u.pn * BM + wc * 64; const float* bp = bdn + (size_t)u.e * D + colw + 8 * fq;
        f32x4 bv[2][2];
#pragma unroll
        for (int bj = 0; bj < 2; ++bj)
#pragma unroll
            for (int n = 0; n < 2; ++n) bv[bj][n] = *(const f32x4*)(bp + 32 * bj + 4 * n);
        const int lane = fq * 16 + fr; LAS unsigned char* stg = stage + (wr * 4 + wc) * 3584;
#pragma unroll
        for (int ai = 0; ai < 2; ++ai)
#pragma unroll
            for (int mp = 0; mp < 2; ++mp) {
#pragma unroll
                for (int mm = 0; mm < 2; ++mm) { const int m = 2 * mp + mm;
#pragma unroll
                    for (int bj = 0; bj < 2; ++bj) { const f32x4 v0 = acc[ai][bj][m][0] + bv[bj][0], v1 = acc[ai][bj][m][1] + bv[bj][1];
                        *(LAS u32x2*)(stg + (16 * mm + fr) * 80 + bj * 32 + fq * 8) = (u32x2){pk4_fp8(v0[0], v0[1], v0[2], v0[3]), pk4_fp8(v1[0], v1[1], v1[2], v1[3])}; } }
                asm volatile("s_waitcnt lgkmcnt(0)" ::: "memory");
                { const int rr = lane >> 2, c16 = lane & 3; const u32x4 w = *(const LAS u32x4*)(stg + rr * 80 + c16 * 16);
                  const int rowa = u.pm * BM + ai * HALF + wr * 64 + (2 * mp) * 16 + rr; *(u32x4*)(y + (size_t)rowa * D + colw + 16 * c16) = w;
                  const u32x4 w2 = *(const LAS u32x4*)(stg + (16 + rr) * 80 + c16 * 16); *(u32x4*)(y + (size_t)(rowa + 16) * D + colw + 16 * c16) = w2; }
                asm volatile("s_waitcnt lgkmcnt(0)" ::: "memory"); }
    }
};
}

#define XB_TMO      128
#define XB_XCNT(j)  (256  + 64 * (j))
#define XB_XSUB(j)  (1280 + 64 * (j))
#define XB_XGEN(j)  (2304 + 64 * (j))
#define XB_TOP      3328
#define XB_TOPGEN   3392
#define XCD_BAR_WORDS 3456
#define XB_SPIN_CAP (1u << 20)
__device__ __forceinline__ unsigned xb_ld(unsigned* p)              { return __hip_atomic_load(p, __ATOMIC_RELAXED, __HIP_MEMORY_SCOPE_AGENT); }
__device__ __forceinline__ unsigned xb_add(unsigned* p, unsigned v) { return __hip_atomic_fetch_add(p, v, __ATOMIC_RELAXED, __HIP_MEMORY_SCOPE_AGENT); }
__device__ __forceinline__ unsigned xb_xcc_id() { return (unsigned)__builtin_amdgcn_s_getreg((3 << 11) | 20) & 0xFu; }
#define XB_SPIN(cond, bar) do { unsigned _sp = 0; while (cond) { __builtin_amdgcn_s_sleep(1); \
    if ((++_sp & 255u) == 0u) { if (xb_ld(&(bar)[XB_TMO])) break; if (_sp > XB_SPIN_CAP) { atomicAdd(&(bar)[XB_TMO], 1u); break; } } } } while (0)
struct XcdBarrier { unsigned* bar; unsigned x; volatile LAS unsigned* st; };
__device__ __forceinline__ XcdBarrier xcd_barrier_post(unsigned* bar, volatile LAS unsigned* st) {
    XcdBarrier b; b.bar = bar; b.x = xb_xcc_id(); b.st = st;
    if (threadIdx.x == 0) (void)xb_add(&bar[XB_XCNT(b.x)], 1u);
    return b;
}
__device__ __forceinline__ void xcd_barrier_complete(unsigned* bar, unsigned x, unsigned& nloc, unsigned& nx) {
    const unsigned G = gridDim.x * gridDim.y * gridDim.z;
    unsigned sum, cnt, mine, sp = 0u;
    for (;;) {
        sum = 0u; cnt = 0u; mine = 0u;
#pragma unroll
        for (unsigned j = 0; j < 16; ++j) { const unsigned c = xb_ld(&bar[XB_XCNT(j)]); sum += c; cnt += (c > 0u) ? 1u : 0u; mine = (j == x) ? c : mine; }
        if (sum == G) break;
        __builtin_amdgcn_s_sleep(1);
        if ((++sp & 255u) == 0u) { if (xb_ld(&bar[XB_TMO])) break; if (sp > XB_SPIN_CAP) { atomicAdd(&bar[XB_TMO], 1u); break; } }
    }
    nloc = mine > 0u ? mine : 1u; nx = cnt > 0u ? cnt : 1u;
}
__device__ __forceinline__ void xcd_barrier(const XcdBarrier& b) {
    asm volatile("s_waitcnt vmcnt(0)" ::: "memory");
    __syncthreads();
    if (threadIdx.x == 0) {
        unsigned* bar = b.bar;
        __builtin_amdgcn_s_waitcnt(0);
        unsigned nloc = b.st[0], nx = b.st[1];
        if (nloc == 0u) { xcd_barrier_complete(bar, b.x, nloc, nx); b.st[0] = nloc; b.st[1] = nx; }
        const unsigned old = xb_add(&bar[XB_XSUB(b.x)], 1u);
        const unsigned gen = old / nloc;
        if (old + 1u == (gen + 1u) * nloc) {
            __builtin_amdgcn_fence(__ATOMIC_RELEASE, "agent");
            asm volatile("s_waitcnt vmcnt(0)" ::: "memory");
            const unsigned og = xb_add(&bar[XB_TOP], 1u);
            const unsigned tg = og / nx;
            if (og + 1u == (tg + 1u) * nx) xb_add(&bar[XB_TOPGEN], 1u);
            else XB_SPIN(xb_ld(&bar[XB_TOPGEN]) == tg, bar);
            __builtin_amdgcn_fence(__ATOMIC_ACQUIRE, "agent");
            xb_add(&bar[XB_XGEN(b.x)], 1u);
            asm volatile("s_waitcnt vmcnt(0)" ::: "memory");
        } else {
            XB_SPIN(xb_ld(&bar[XB_XGEN(b.x)]) == gen, bar);
            __builtin_amdgcn_fence(__ATOMIC_ACQUIRE, "agent");
            asm volatile("s_waitcnt vmcnt(0)" ::: "memory");
        }
    }
    __syncthreads();
}

struct Args { const float* in[18]; float* out; unsigned char* ws; int ph_lo, ph_hi, li, pad; };
struct Frame {
    LAS unsigned char* lds; unsigned char* ws; unsigned* ctl;
    int tid, lane, wave, G, vcu;
};

__device__ const unsigned char T5B[3][132] = {
{0,1,2,3,4,5,6,7,8,9,10,11,12,13,14,15,16,16,16,16,16,16,17,17,17,17,17,17,17,17,18,18,18,18,18,18,18,18,18,18,19,19,19,19,19,19,19,19,19,19,19,19,19,19,20,20,20,20,20,20,20,20,20,20,20,20,20,20,20,20,20,20,20,21,21,21,21,21,21,21,21,21,21,21,21,21,21,21,21,21,21,21,21,21,21,21,21,21,21,22,22,22,22,22,22,22,22,22,22,22,22,22,22,22,22,22,22,22,22,22,22,22,22,22,22,22,22,22,22,0,0,0},
{0,4,8,12,16,16,17,17,18,18,19,19,19,19,20,20,20,20,20,21,21,21,21,21,21,22,22,22,22,22,22,22,22,22,23,23,23,23,23,23,23,23,23,23,23,23,24,24,24,24,24,24,24,24,24,24,24,24,24,24,24,24,25,25,25,25,25,25,25,25,25,25,25,25,25,25,25,25,25,25,25,25,25,26,26,26,26,26,26,26,26,26,26,26,26,26,26,26,26,26,26,26,26,26,26,26,26,26,26,26,26,26,26,27,27,27,27,27,27,27,27,27,27,27,27,27,27,27,27,0,0,0},
{0,16,18,19,20,21,21,22,22,23,23,23,24,24,24,24,25,25,25,25,25,26,26,26,26,26,26,26,26,27,27,27,27,27,27,27,27,27,27,28,28,28,28,28,28,28,28,28,28,28,28,28,29,29,29,29,29,29,29,29,29,29,29,29,29,29,29,29,29,29,30,30,30,30,30,30,30,30,30,30,30,30,30,30,30,30,30,30,30,30,30,30,30,30,30,31,31,31,31,31,31,31,31,31,31,31,31,31,31,31,31,31,31,31,31,31,31,31,31,31,31,31,31,31,31,31,31,31,31,0,0,0}};

__device__ __forceinline__ void p0_load8(const float* W, size_t ldw, int src_col0, int k0, int lane, f32x4 (&v)[8]) {
    const int n4 = (lane & 7) * 4, kr = lane >> 3;
#pragma unroll
    for (int i = 0; i < 8; ++i) v[i] = *(const f32x4*)(W + (size_t)(k0 + 8 * i + kr) * ldw + src_col0 + n4);
}
template <bool SCALE, bool OUT8> __device__ __forceinline__ void p0_finish(const f32x4 (&v)[8], void* dstv, int k0, const float* kscale, LAS float* scr, int lane) {
    { const int n4 = (lane & 7) * 4, kr = lane >> 3;
#pragma unroll
        for (int i = 0; i < 8; ++i) { const int kk = 8 * i + kr; f32x4 x = v[i]; if (SCALE) x = x * kscale[k0 + kk]; if (OUT8) x = x * 32.f;
            scr[kk * 33 + n4] = x[0]; scr[kk * 33 + n4 + 1] = x[1]; scr[kk * 33 + n4 + 2] = x[2]; scr[kk * 33 + n4 + 3] = x[3]; } }
    LDS_WAIT(); asm volatile("" ::: "memory");
    if (OUT8) { unsigned char* dst = (unsigned char*)dstv; const int n = lane >> 1, kh = lane & 1; const LAS float* sp = scr + (32 * kh) * 33 + n; unsigned w[8];
#pragma unroll
        for (int q = 0; q < 8; ++q) w[q] = pk4_fp8(sp[(4 * q) * 33], sp[(4 * q + 1) * 33], sp[(4 * q + 2) * 33], sp[(4 * q + 3) * 33]);
        *(u32x4*)(dst + (size_t)n * 1024 + k0 + 32 * kh) = (u32x4){w[0], w[1], w[2], w[3]}; *(u32x4*)(dst + (size_t)n * 1024 + k0 + 32 * kh + 16) = (u32x4){w[4], w[5], w[6], w[7]};
    } else { bf16* dst = (bf16*)dstv; const int c = lane & 7;
#pragma unroll
        for (int j = 0; j < 4; ++j) { const int n = (lane >> 3) + 8 * j; const LAS float* sp = scr + (8 * c) * 33 + n;
            u32x4 o; o.x = pk2(sp[0 * 33], sp[1 * 33]); o.y = pk2(sp[2 * 33], sp[3 * 33]); o.z = pk2(sp[4 * 33], sp[5 * 33]); o.w = pk2(sp[6 * 33], sp[7 * 33]);
            *(u32x4*)(dst + (size_t)n * 1024 + k0 + 8 * c) = o; } }
    LDS_WAIT(); asm volatile("" ::: "memory");
}
template <bool SCALE, bool OUT8> __device__ __forceinline__ void p0_transpose_item(const float* W, size_t ldw, int src_col0, void* dstv, int k0, const float* kscale, LAS float* scr, int lane) {
    f32x4 v[8]; p0_load8(W, ldw, src_col0, k0, lane, v); p0_finish<SCALE, OUT8>(v, dstv, k0, kscale, scr, lane);
}
__device__ __forceinline__ void p0_experts(Frame& F, const Args& a, int gw, int NGW) {
    const float* n2 = a.in[11]; const float* w_gu = a.in[14]; const float* w_dn = a.in[16];
    bf16* Wgu_t = (bf16*)(F.ws + WS_WGU); bf16* Wdn_t = (bf16*)(F.ws + WS_WDN);
    LAS float* scr = (LAS float*)(F.lds + F.wave * 8448);
    constexpr int I_GU = NE * 16 * 64, I_DN = NE * 16 * 32;
#define P0_GU_ARGS(r_) const int e_ = (r_) >> 10, q_ = (r_) & 1023, nb_ = q_ & 63, kb_ = q_ >> 6, np_ = 32 * nb_, ntile_ = np_ >> 8, lc_ = np_ & 255, bj_ = lc_ >> 7, j0_ = lc_ & 127
    for (int it = gw; it < I_GU; it += 2 * NGW) { f32x4 va[8], vb2[8]; const int it2 = it + NGW; const bool two = it2 < I_GU;
        { P0_GU_ARGS(it); p0_load8(w_gu + (size_t)e_ * D * 2048, 2048, bj_ * 1024 + 128 * ntile_ + j0_, 64 * kb_, F.lane, va); }
        if (two) { P0_GU_ARGS(it2); p0_load8(w_gu + (size_t)e_ * D * 2048, 2048, bj_ * 1024 + 128 * ntile_ + j0_, 64 * kb_, F.lane, vb2); }
        { P0_GU_ARGS(it); p0_finish<true, true>(va, (unsigned char*)Wgu_t + ((size_t)e_ * 2048 + np_) * 1024, 64 * kb_, n2, scr, F.lane); }
        if (two) { P0_GU_ARGS(it2); p0_finish<true, true>(vb2, (unsigned char*)Wgu_t + ((size_t)e_ * 2048 + np_) * 1024, 64 * kb_, n2, scr, F.lane); } }
#undef P0_GU_ARGS
#define P0_DN_ARGS(r_) const int e_ = (r_) >> 9, q_ = (r_) & 511, nb_ = q_ & 31, kb_ = q_ >> 5
    for (int it = gw; it < I_DN; it += 2 * NGW) { f32x4 va[8], vb2[8]; const int it2 = it + NGW; const bool two = it2 < I_DN;
        { P0_DN_ARGS(it); p0_load8(w_dn + (size_t)e_ * FF * D, D, 32 * nb_, 64 * kb_, F.lane, va); }
        if (two) { P0_DN_ARGS(it2); p0_load8(w_dn + (size_t)e_ * FF * D, D, 32 * nb_, 64 * kb_, F.lane, vb2); }
        { P0_DN_ARGS(it); p0_finish<false, true>(va, (unsigned char*)Wdn_t + ((size_t)e_ * 1024 + 32 * nb_) * 1024, 64 * kb_, nullptr, scr, F.lane); }
        if (two) { P0_DN_ARGS(it2); p0_finish<false, true>(vb2, (unsigned char*)Wdn_t + ((size_t)e_ * 1024 + 32 * nb_) * 1024, 64 * kb_, nullptr, scr, F.lane); } }
#undef P0_DN_ARGS
}
__device__ __forceinline__ void phase0(Frame& F, const Args& a) {
    const float* x = a.in[0]; const float* n1 = a.in[1]; const float* w_in = a.in[2]; const float* w_out = a.in[10]; const float* n2 = a.in[11];
    const float* w_r = a.in[12]; const float* w_gu = a.in[14]; const float* w_dn = a.in[16];
    bf16* Win_t = (bf16*)(F.ws + WS_WIN); bf16* Wout_t = (bf16*)(F.ws + WS_WOUT); bf16* Wgu_t = (bf16*)(F.ws + WS_WGU); bf16* Wdn_t = (bf16*)(F.ws + WS_WDN);
    float* wrT = (float*)(F.ws + WS_WRT); bf16* XN = (bf16*)(F.ws + WS_XN); float* BA = (float*)(F.ws + WS_BA);
    LAS float* scr = (LAS float*)(F.lds + F.wave * 8448);
    const int gw = F.vcu * NWAVES + F.wave, NGW = F.G * NWAVES;
    for (int i = (F.vcu * NTHREADS + F.tid); i < NE * D; i += F.G * NTHREADS) { const int e = i >> 10, k = i & 1023; wrT[i] = n2[k] * w_r[k * NE + e]; }
    constexpr int I_IN = 16 * (NIN / 32), I_OUT = 16 * 32;
    for (int it = gw; it < I_IN + I_OUT; it += NGW) {
        int r = it;
        if (r < I_IN) { const int nb = r % (NIN / 32), kb = r / (NIN / 32), np = 32 * nb; int src;
            src = np < 2048 ? np : np + 8;
            p0_transpose_item<false, false>(w_in, IN_DIM, src, Win_t + (size_t)np * 1024, 64 * kb, nullptr, scr, F.lane); continue; }
        r -= I_IN;
        { const int nb = r & 31, kb = r >> 5; p0_transpose_item<false, false>(w_out, D, 32 * nb, Wout_t + (size_t)(32 * nb) * 1024, 64 * kb, nullptr, scr, F.lane); }
    }
    __syncthreads();
    { LAS float* wb = (LAS float*)(F.lds + 69632);
        for (int k = F.tid; k < D; k += NTHREADS) { const float* wp = w_in + (size_t)k * IN_DIM + 2048; LAS float* dp = wb + (k >> 2) * 36 + (k & 3) * 8;
            *(LAS f32x4*)dp = *(const f32x4*)wp; *(LAS f32x4*)(dp + 4) = *(const f32x4*)(wp + 4); }
        __syncthreads();
        f32x4 n1v[4];
#pragma unroll
        for (int j = 0; j < 4; ++j) n1v[j] = *((const f32x4*)n1 + F.lane + 64 * j);
        for (int rep9 = 0; rep9 < (DUP == 9 ? 2 : 1); ++rep9)
        for (int m0 = gw * 4; m0 < T; m0 += NGW * 4) {
            f32x4 v[4][4]; float rs[4];
#pragma unroll
            for (int r = 0; r < 4; ++r)
#pragma unroll
                for (int j = 0; j < 4; ++j) v[r][j] = *((const f32x4*)(x + (size_t)(m0 + r) * D) + F.lane + 64 * j);
#pragma unroll
            for (int r = 0; r < 4; ++r) { float sq = 0.f;
#pragma unroll
                for (int j = 0; j < 4; ++j) sq += (v[r][j][0] * v[r][j][0] + v[r][j][1] * v[r][j][1]) + (v[r][j][2] * v[r][j][2] + v[r][j][3] * v[r][j][3]);
                rs[r] = rsqrtf(wave_sum(sq) * (1.f / D) + EPS); }
            float ba[4][8];
#pragma unroll
            for (int r = 0; r < 4; ++r)
#pragma unroll
                for (int c = 0; c < 8; ++c) ba[r][c] = 0.f;
#pragma unroll
            for (int j = 0; j < 4; ++j) {
#pragma unroll
                for (int r = 0; r < 4; ++r) { v[r][j] = v[r][j] * rs[r] * n1v[j];
                    *((unsigned long long*)(XN + (size_t)(m0 + r) * D) + F.lane + 64 * j) = (unsigned long long)pk2(v[r][j][0], v[r][j][1]) | ((unsigned long long)pk2(v[r][j][2], v[r][j][3]) << 32); }
#pragma unroll
                for (int i = 0; i < 4; ++i) { const LAS float* wp = wb + (F.lane + 64 * j) * 36 + i * 8; const f32x4 w0 = *(const LAS f32x4*)wp, w1 = *(const LAS f32x4*)(wp + 4);
#pragma unroll
                    for (int r = 0; r < 4; ++r) { const float xv = v[r][j][i];
                        ba[r][0] += xv * w0[0]; ba[r][1] += xv * w0[1]; ba[r][2] += xv * w0[2]; ba[r][3] += xv * w0[3];
                        ba[r][4] += xv * w1[0]; ba[r][5] += xv * w1[1]; ba[r][6] += xv * w1[2]; ba[r][7] += xv * w1[3]; } } }
#pragma unroll
            for (int r = 0; r < 4; ++r) {
#pragma unroll
                for (int c = 0; c < 8; ++c) ba[r][c] = wave_sum(ba[r][c]);
                if (F.lane == 0) { *(f32x4*)(BA + (size_t)(m0 + r) * 8) = (f32x4){ba[r][0], ba[r][1], ba[r][2], ba[r][3]}; *(f32x4*)(BA + (size_t)(m0 + r) * 8 + 4) = (f32x4){ba[r][4], ba[r][5], ba[r][6], ba[r][7]}; } }
        }
        __syncthreads();
    }
}

constexpr int GP = 132;
constexpr int GQ_OFF = 0, GK_OFF = 64 * GP * 4, GV_OFF = 2 * 64 * GP * 4, GW_OFF = 3 * 64 * GP * 4, GAT_OFF = 4 * 64 * GP * 4, GAT_P = 68;
constexpr int GRAW_OFF = GW_OFF, GRAW_BYTES = 67 * 768;
constexpr int GGC_OFF = GRAW_OFF + GRAW_BYTES, GBETA_OFF = GGC_OFF + 256, GEND = GBETA_OFF + 256;
static_assert(GAT_OFF + 64 * GAT_P * 4 <= GGC_OFF && GEND <= TOP_OFF, "gdn prep LDS");
__device__ __forceinline__ int permpos(int cc) { return 8 * ((cc & 15) >> 2) + (cc & 3) + 4 * (cc >> 4); }
__device__ __forceinline__ void gdn_prep_unit(Frame& F, const Args& a, int unit) {
    const bf16* zg = (const bf16*)(F.ws + WS_ZG); const float* BA = (const float*)(F.ws + WS_BA);
    const float* convw = a.in[3]; const float* a_log = a.in[4]; const float* dt_bias = a.in[5];
    const int b = unit >> 8, h = (unit >> 6) & 3, n = unit & 63; const int row0 = b * SEQ + n * CHUNK;
    unsigned char* rec = F.ws + WS_PREP + (size_t)unit * PREP_REC;
    LAS float* Qs = (LAS float*)(F.lds + GQ_OFF); LAS float* Ks = (LAS float*)(F.lds + GK_OFF); LAS float* Vs = (LAS float*)(F.lds + GV_OFF); LAS float* Ws = (LAS float*)(F.lds + GW_OFF);
    LAS float* AT = (LAS float*)(F.lds + GAT_OFF); LAS float* gcs = (LAS float*)(F.lds + GGC_OFF); LAS float* betas = (LAS float*)(F.lds + GBETA_OFF);
    LAS unsigned char* raw = F.lds + GRAW_OFF;
    const int tid = F.tid, lane = F.lane, wave = F.wave;
    for (int e = tid; e < 67 * 48; e += NTHREADS) { const int rr = e / 48, ch = e % 48; const int tt = n * CHUNK + rr - 3;
        u32x4 v = {0u, 0u, 0u, 0u}; if (tt >= 0) v = *(const u32x4*)(zg + (size_t)(row0 + rr - 3) * 2048 + (ch >> 4) * 512 + h * 128 + (ch & 15) * 8);
        *(LAS u32x4*)(raw + rr * 768 + ch * 16) = v; }
    if (wave == 0) {
        const float bl = BA[(size_t)(row0 + lane) * 8 + h], al = BA[(size_t)(row0 + lane) * 8 + 4 + h];
        const float xx = al + dt_bias[h]; const float sp = xx > 20.f ? xx : log1pf(__expf(xx));
        float g = -__expf(a_log[h]) * sp;
#pragma unroll
        for (int o = 1; o < 64; o <<= 1) { const float u = __shfl_up(g, o); if (lane >= o) g += u; }
        gcs[lane] = g; betas[lane] = sigmoid_f(bl);
    }
    __syncthreads();
    if (tid < 384) { const int cp = tid % 192, tp = tid / 192; const int ten = cp >> 6, c = (cp & 63) * 2; const int ch = ten * 512 + h * 128 + c;
        f32x2 cw[4];
#pragma unroll
        for (int k = 0; k < 4; ++k) cw[k] = *(const f32x2*)(convw + k * 1536 + ch);
        LAS float* dst = (ten == 0 ? Qs : (ten == 1 ? Ks : Vs)) + c;
#pragma unroll 4
        for (int t = tp; t < 64; t += 2) { float a0 = 0.f, a1 = 0.f;
#pragma unroll
            for (int k = 0; k < 4; ++k) { const unsigned w = *(const LAS unsigned*)(raw + (t + k) * 768 + cp * 4); a0 += bflo(w) * cw[k][0]; a1 += bfhi(w) * cw[k][1]; }
            *(LAS f32x2*)(dst + t * GP) = (f32x2){silu_f(a0), silu_f(a1)}; } }
    __syncthreads();
    for (int rr = 0; rr < 8; ++rr) { const int t = wave * 8 + rr;
        f32x2 q = *(LAS f32x2*)(Qs + t * GP + 2 * lane), k = *(LAS f32x2*)(Ks + t * GP + 2 * lane);
        const float sq = wave_sum(q[0] * q[0] + q[1] * q[1]), sk = wave_sum(k[0] * k[0] + k[1] * k[1]);
        const float fq_ = rsqrtf(sq + EPS) * 0.08838834764831845f, fk_ = rsqrtf(sk + EPS);
        *(LAS f32x2*)(Qs + t * GP + 2 * lane) = q * fq_; *(LAS f32x2*)(Ks + t * GP + 2 * lane) = k * fk_; }
    __syncthreads();
    {
        const int which = wave >> 2, ti = (wave >> 1) & 1, tj = wave & 1, r32 = lane & 31, hh = lane >> 5;
        const LAS float* Xa = (which ? Ks + (32 * tj + r32) * GP : Ks + (32 * ti + r32) * GP) + 8 * hh; const LAS float* Xb = (which ? Qs + (32 * ti + r32) * GP : Ks + (32 * tj + r32) * GP) + 8 * hh;
        f32x16 acc = {};
#pragma unroll
        for (int ks = 0; ks < 8; ++ks) { const bf16x8 af = pack8(*(const LAS f32x4*)(Xa + 16 * ks), *(const LAS f32x4*)(Xa + 16 * ks + 4)), bf = pack8(*(const LAS f32x4*)(Xb + 16 * ks), *(const LAS f32x4*)(Xb + 16 * ks + 4));
            acc = __builtin_amdgcn_mfma_f32_32x32x16_bf16(af, bf, acc, 0, 0, 0); }
        if (which == 0) {
            const int j = 32 * tj + r32; const float gj = gcs[j];
#pragma unroll
            for (int q = 0; q < 4; ++q) { float vals[4];
#pragma unroll
                for (int rr = 0; rr < 4; ++rr) { const int i = 32 * ti + 8 * q + 4 * hh + rr; const float dec = __expf(fminf(gcs[i] - gj, 0.f)); vals[rr] = i > j ? betas[i] * acc[4 * q + rr] * dec : 0.f; }
                *(LAS f32x4*)(AT + j * GAT_P + 32 * ti + 8 * q + 4 * hh) = (f32x4){vals[0], vals[1], vals[2], vals[3]}; }
        } else {
            const int i = 32 * ti + r32; const float gi = gcs[i]; bf16* Af = (bf16*)(rec + PREP_AP) + (i >> 4) * 1024 + (i & 15) * 8 + tj * 512;
#pragma unroll
            for (int q = 0; q < 4; ++q) { float vals[4]; const int cc0 = 8 * q + 4 * hh;
#pragma unroll
                for (int rr = 0; rr < 4; ++rr) { const int j = 32 * tj + cc0 + rr; const float dec = __expf(fminf(gi - gcs[j], 0.f)); vals[rr] = i >= j ? acc[4 * q + rr] * dec : 0.f; }
                const int jpos = permpos(cc0); *(u32x2*)(Af + (jpos >> 3) * 128 + (jpos & 7)) = (u32x2){pk2(vals[0], vals[1]), pk2(vals[2], vals[3])}; }
        }
        for (int e = tid; e < 64 * 32; e += NTHREADS) { const int t = e >> 5, c = (e & 31) * 4; const float bt = betas[t], eg = bt * __expf(gcs[t]);
            *(LAS f32x4*)(Vs + t * GP + c) = *(LAS f32x4*)(Vs + t * GP + c) * bt; *(LAS f32x4*)(Ws + t * GP + c) = *(LAS f32x4*)(Ks + t * GP + c) * eg; }
    }
    __syncthreads();
    if (tid < 256) {
        LAS float* X = (tid < 128 ? Vs : Ws) + (tid & 127);
#pragma unroll 1
        for (int ib = 0; ib < 4; ++ib) { const int i0 = 16 * ib; float r[16];
#pragma unroll
            for (int ii = 0; ii < 16; ++ii) r[ii] = X[(i0 + ii) * GP];
#pragma unroll 8
            for (int j = 0; j < i0; ++j) { const float xj = X[j * GP]; const LAS f32x4* ap = (const LAS f32x4*)(AT + j * GAT_P + i0);
#pragma unroll
                for (int q = 0; q < 4; ++q) { const f32x4 av = ap[q]; r[4 * q] -= av[0] * xj; r[4 * q + 1] -= av[1] * xj; r[4 * q + 2] -= av[2] * xj; r[4 * q + 3] -= av[3] * xj; } }
#pragma unroll
            for (int j = 0; j < 16; ++j) { const float xj = r[j]; const LAS f32x4* ap = (const LAS f32x4*)(AT + (i0 + j) * GAT_P + i0); float av[16];
#pragma unroll
                for (int q = 0; q < 4; ++q) { const f32x4 t4 = ap[q]; av[4 * q] = t4[0]; av[4 * q + 1] = t4[1]; av[4 * q + 2] = t4[2]; av[4 * q + 3] = t4[3]; }
#pragma unroll
                for (int ii = 0; ii < 16; ++ii) if (ii > j) r[ii] -= av[ii] * xj; }
#pragma unroll
            for (int ii = 0; ii < 16; ++ii) X[(i0 + ii) * GP] = r[ii]; }
    } else {
        const int t2 = tid - 256; bf16* Qf = (bf16*)(rec + PREP_QP); bf16* Kf = (bf16*)(rec + PREP_KT); const float gl = gcs[63];
        for (int it = t2; it < 1024; it += 256) { const int blk = it >> 6, l = it & 63, mi = blk >> 2, ks = blk & 3, g = l >> 4, c = 16 * mi + (l & 15); const float eg = __expf(gcs[c]);
            const f32x4 lo = *(LAS f32x4*)(Qs + c * GP + 32 * ks + 4 * g) * eg, hi = *(LAS f32x4*)(Qs + c * GP + 32 * ks + 16 + 4 * g) * eg;
            *(bf16x8*)(Qf + it * 8) = pack8(lo, hi); }
        for (int it = t2; it < 1024; it += 256) { const int blk = it >> 6, l = it & 63, ti = blk >> 1, ks2 = blk & 1, g = l >> 4, dk = 16 * ti + (l & 15); float v[8];
#pragma unroll
            for (int j = 0; j < 8; ++j) { const int c = 32 * ks2 + (j < 4 ? 4 * g + j : 16 + 4 * g + (j - 4)); v[j] = Ks[c * GP + dk] * __expf(gl - gcs[c]); }
            *(bf16x8*)(Kf + it * 8) = pack8((f32x4){v[0], v[1], v[2], v[3]}, (f32x4){v[4], v[5], v[6], v[7]}); }
        if (t2 == 0) *(float*)(rec + PREP_CD) = __expf(gl);
    }
    __syncthreads();
    { float* Up = (float*)(rec + PREP_UP); bf16* Wf = (bf16*)(rec + PREP_WP);
        for (int it = tid; it < 2048; it += NTHREADS) { const int dv = it & 127, g = (it >> 7) & 3, mi = it >> 9; const int c0 = 16 * mi + 4 * g;
            *(f32x4*)(Up + (size_t)it * 4) = (f32x4){Vs[c0 * GP + dv], Vs[(c0 + 1) * GP + dv], Vs[(c0 + 2) * GP + dv], Vs[(c0 + 3) * GP + dv]}; }
        for (int it = tid; it < 1024; it += NTHREADS) { const int blk = it >> 6, l = it & 63, mi = blk >> 2, ks = blk & 3, g = l >> 4, c = 16 * mi + (l & 15);
            *(bf16x8*)(Wf + it * 8) = pack8(*(LAS f32x4*)(Ws + c * GP + 32 * ks + 4 * g), *(LAS f32x4*)(Ws + c * GP + 32 * ks + 16 + 4 * g)); }
    }
    __syncthreads();
}

constexpr int SC_BUFSZ = 57344, SC_OT = 2 * SC_BUFSZ, SC_OTSZ = 64 * 128 * 2, SC_END = SC_OT + 2 * SC_OTSZ;
static_assert(SC_END <= TOP_OFF, "scan LDS");
__device__ __forceinline__ void gdn_scan(Frame& F, const Args& a, int bh) {
    const int tid = F.tid, lane = F.lane, w = F.wave, fr = lane & 15, g = lane >> 4; const int b = bh >> 2, h = bh & 3;
    const unsigned char* rec0 = F.ws + WS_PREP + (size_t)bh * NCHUNK * PREP_REC;
    const float* gnw = a.in[6]; const bf16* zg = (const bf16*)(F.ws + WS_ZG); bf16* mix = (bf16*)(F.ws + WS_MIX);
    const size_t rowb = (size_t)b * SEQ; const unsigned lds0 = (unsigned)(uintptr_t)F.lds;
    if (w >= 4) {
        const int hw = w - 4, l16 = lane & 15, rq = lane >> 4;
        const f32x4 gwa = *(const f32x4*)(gnw + 8 * l16), gwb = *(const f32x4*)(gnw + 8 * l16 + 4);
#define SC_DMA(n_, buf_) do { const unsigned char* src_ = rec0 + (size_t)(n_) * PREP_REC + hw * 14336 + lane * 16; _Pragma("unroll") for (int r_ = 0; r_ < 14; ++r_) \
        glds16_asm(src_ + r_ * 1024, (unsigned)__builtin_amdgcn_readfirstlane((int)(lds0 + (buf_) * SC_BUFSZ + hw * 14336 + r_ * 1024))); } while (0)
#define SC_NORM(n_, gv) do { const LAS unsigned char* ot = F.lds + SC_OT + ((n_) & 1) * SC_OTSZ; _Pragma("unroll") for (int q_ = 0; q_ < 4; ++q_) { const int t = 16 * hw + 4 * q_ + rq; \
            const u32x4 ov = *(const LAS u32x4*)(ot + t * 256 + l16 * 16); const f32x4 xa = {bflo(ov.x), bfhi(ov.x), bflo(ov.y), bfhi(ov.y)}, xb = {bflo(ov.z), bfhi(ov.z), bflo(ov.w), bfhi(ov.w)}; \
            float ss_ = (xa[0] * xa[0] + xa[1] * xa[1]) + (xa[2] * xa[2] + xa[3] * xa[3]) + (xb[0] * xb[0] + xb[1] * xb[1]) + (xb[2] * xb[2] + xb[3] * xb[3]); \
            ss_ += __shfl_xor(ss_, 1); ss_ += __shfl_xor(ss_, 2); ss_ += __shfl_xor(ss_, 4); ss_ += __shfl_xor(ss_, 8); const float sc = rsqrtf(ss_ * (1.f / 128.f) + EPS); \
            const u32x4 gz = gv[q_]; const f32x4 ga = {silu_f(bflo(gz.x)), silu_f(bfhi(gz.x)), silu_f(bflo(gz.y)), silu_f(bfhi(gz.y))}, gb = {silu_f(bflo(gz.z)), silu_f(bfhi(gz.z)), silu_f(bflo(gz.w)), silu_f(bfhi(gz.w))}; \
            *(bf16x8*)(mix + (rowb + (n_) * CHUNK + t) * 1024 + h * 128 + 8 * l16) = pack8(xa * sc * gwa * ga, xb * sc * gwb * gb); } } while (0)
        u32x4 gc_[4], gn_[4];
        SC_DMA(0, 0);
#pragma unroll
        for (int q = 0; q < 4; ++q) gc_[q] = (u32x4){0u, 0u, 0u, 0u};
        VM_WAIT(); __syncthreads();
#pragma unroll 1
        for (int n = 0; n < NCHUNK; ++n) {
#pragma unroll
            for (int q = 0; q < 4; ++q) gn_[q] = *(const u32x4*)(zg + (rowb + n * CHUNK + 16 * hw + 4 * q + rq) * 2048 + 1536 + h * 128 + 8 * l16);
            if (n + 1 < NCHUNK) SC_DMA(n + 1, (n + 1) & 1);
            if (n > 0) SC_NORM(n - 1, gc_);
            VM_WAIT(); __syncthreads();
#pragma unroll
            for (int q = 0; q < 4; ++q) gc_[q] = gn_[q];
        }
        SC_NORM(NCHUNK - 1, gc_);
#undef SC_DMA
#undef SC_NORM
    } else {
        f32x4 S[2][8];
#pragma unroll
        for (int sl = 0; sl < 2; ++sl)
#pragma unroll
            for (int i = 0; i < 8; ++i) S[sl][i] = (f32x4){0.f, 0.f, 0.f, 0.f};
        f32x4 Un[2][4]; float cd = *(const float*)(rec0 + PREP_CD), cdn;
#pragma unroll
        for (int sl = 0; sl < 2; ++sl)
#pragma unroll
            for (int mi = 0; mi < 4; ++mi) Un[sl][mi] = *(const f32x4*)((const float*)(rec0 + PREP_UP) + (size_t)((mi * 4 + g) * 128 + 32 * w + 16 * sl + fr) * 4);
        __syncthreads();
#pragma unroll 1
        for (int n = 0; n < NCHUNK; ++n) {
            const LAS unsigned char* B = F.lds + (n & 1) * SC_BUFSZ + lane * 16;
            f32x4 vn[2][4], o[2][4];
            { bf16x8 Sb[2][4];
#pragma unroll
                for (int sl = 0; sl < 2; ++sl)
#pragma unroll
                    for (int ks = 0; ks < 4; ++ks) Sb[sl][ks] = pack8(S[sl][2 * ks], S[sl][2 * ks + 1]);
#pragma unroll
                for (int mi = 0; mi < 4; ++mi) { f32x4 t1[2], oo[2];
#pragma unroll
                    for (int sl = 0; sl < 2; ++sl) { t1[sl] = (f32x4){0.f, 0.f, 0.f, 0.f}; oo[sl] = (f32x4){0.f, 0.f, 0.f, 0.f}; }
#pragma unroll
                    for (int ks = 0; ks < 4; ++ks) { const bf16x8 wf = *(const LAS bf16x8*)(B + PREP_WP + (mi * 4 + ks) * 1024), qf = *(const LAS bf16x8*)(B + PREP_QP + (mi * 4 + ks) * 1024);
#pragma unroll
                        for (int sl = 0; sl < 2; ++sl) { t1[sl] = __builtin_amdgcn_mfma_f32_16x16x32_bf16(wf, Sb[sl][ks], t1[sl], 0, 0, 0); oo[sl] = __builtin_amdgcn_mfma_f32_16x16x32_bf16(qf, Sb[sl][ks], oo[sl], 0, 0, 0); } }
#pragma unroll
                    for (int sl = 0; sl < 2; ++sl) { vn[sl][mi] = Un[sl][mi] - t1[sl]; o[sl][mi] = oo[sl]; } } }
            { const int nn = n + 1 < NCHUNK ? n + 1 : n; cdn = *(const float*)(rec0 + (size_t)nn * PREP_REC + PREP_CD);
#pragma unroll
                for (int sl = 0; sl < 2; ++sl)
#pragma unroll
                    for (int mi = 0; mi < 4; ++mi) Un[sl][mi] = *(const f32x4*)((const float*)(rec0 + (size_t)nn * PREP_REC + PREP_UP) + (size_t)((mi * 4 + g) * 128 + 32 * w + 16 * sl + fr) * 4); }
            bf16x8 Vb[2][2];
#pragma unroll
            for (int sl = 0; sl < 2; ++sl)
#pragma unroll
                for (int ks = 0; ks < 2; ++ks) Vb[sl][ks] = pack8(vn[sl][2 * ks], vn[sl][2 * ks + 1]);
#pragma unroll
            for (int mi = 0; mi < 4; ++mi) {
#pragma unroll
                for (int ks = 0; ks < 2; ++ks) { const bf16x8 af = *(const LAS bf16x8*)(B + PREP_AP + (mi * 2 + ks) * 1024);
#pragma unroll
                    for (int sl = 0; sl < 2; ++sl) o[sl][mi] = __builtin_amdgcn_mfma_f32_16x16x32_bf16(af, Vb[sl][ks], o[sl][mi], 0, 0, 0); }
#pragma unroll
                for (int sl = 0; sl < 2; ++sl) { LAS bf16* otw = (LAS bf16*)(F.lds + SC_OT + (n & 1) * SC_OTSZ) + 32 * w + 16 * sl + fr;
                    const unsigned p01 = pk2(o[sl][mi][0], o[sl][mi][1]), p23 = pk2(o[sl][mi][2], o[sl][mi][3]);
                    otw[(16 * mi + 4 * g) * 128] = (bf16)(p01 & 0xffffu); otw[(16 * mi + 4 * g + 1) * 128] = (bf16)(p01 >> 16); otw[(16 * mi + 4 * g + 2) * 128] = (bf16)(p23 & 0xffffu); otw[(16 * mi + 4 * g + 3) * 128] = (bf16)(p23 >> 16); } }
#pragma unroll
            for (int ti = 0; ti < 8; ++ti) { f32x4 s0 = S[0][ti] * cd, s1 = S[1][ti] * cd;
#pragma unroll
                for (int ks = 0; ks < 2; ++ks) { const bf16x8 kf = *(const LAS bf16x8*)(B + PREP_KT + (ti * 2 + ks) * 1024);
                    s0 = __builtin_amdgcn_mfma_f32_16x16x32_bf16(kf, Vb[0][ks], s0, 0, 0, 0); s1 = __builtin_amdgcn_mfma_f32_16x16x32_bf16(kf, Vb[1][ks], s1, 0, 0, 0); }
                S[0][ti] = s0; S[1][ti] = s1; }
            __syncthreads();
            cd = cdn;
        }
    }
    __syncthreads();
}

constexpr int AT_K = 0, AT_V = 49152, AT_BIAS = 98304, AT_LW = 98304 + 1024, AT_END = AT_LW + 1024;
constexpr size_t WS_P4 = 616 * MiB, WS_P16 = 648 * MiB, WS_L4 = 744 * MiB, WS_L16 = 745 * MiB;
static_assert(WS_P16 + (size_t)T * 512 * 2 <= WS_MIX && WS_L16 + (size_t)T * 8 * 4 <= WS_XN, "attention partial buffers");
__device__ __forceinline__ void attn_unit(Frame& F, const Args& a, int u) {
    int kind, b, h, r, q0;
    if (u < 1024) { kind = 2; b = u >> 7; h = (u >> 4) & 7; r = u & 15; q0 = 0; }
    else if (u < 2048) { const int v = u - 1024; kind = 1; b = v >> 7; h = (v >> 4) & 7; r = (v >> 2) & 3; q0 = (v & 3) * 256; }
    else { const int v = u - 2048; kind = 0; b = v >> 7; h = (v >> 4) & 7; r = 0; q0 = (v & 15) * 256; }
    const int dsh = 2 * kind, lmax = (SEQ >> dsh) - 1;
    const bf16* qb = (const bf16*)(F.ws + WS_QB); const bf16* kb = (const bf16*)(F.ws + WS_KB); const bf16* vb = (const bf16*)(F.ws + WS_VB); bf16* mix = (bf16*)(F.ws + WS_MIX);
    const float* relb = a.in[9];
    LAS float* biasL = (LAS float*)(F.lds + AT_BIAS); LAS float* lw = (LAS float*)(F.lds + AT_LW) + F.wave * 32;
    const int tid = F.tid, lane = F.lane, w = F.wave, c = lane & 31, hh = lane >> 5;
    const size_t hrow = (size_t)(b * AH + h) * SEQ; const unsigned lds0 = (unsigned)(uintptr_t)F.lds;
    { const int ro = lane >> 3, p = lane & 7;
#pragma unroll
        for (int i = 0; i < 6; ++i) { const int lr = 48 * w + 8 * i + ro; int pos = q0 - 128 + lr; pos = pos < 0 ? 0 : (pos > lmax ? lmax : pos);
            const size_t eo = (hrow + (size_t)(pos << dsh) + r) * 64 + (size_t)((p ^ (lr & 7)) * 8);
            glds16_asm(kb + eo, (unsigned)__builtin_amdgcn_readfirstlane((int)(lds0 + AT_K + (48 * w + 8 * i) * 128)));
            glds16_asm(vb + eo, (unsigned)__builtin_amdgcn_readfirstlane((int)(lds0 + AT_V + (48 * w + 8 * i) * 128))); } }
    if (tid < 132) biasL[tid] = relb[(int)T5B[kind][tid] * AH + h] * LOG2E;
    const int qi = q0 + 32 * w + c;
    bf16x8 Qf[4];
    { const bf16* qp = qb + (hrow + (size_t)(qi << dsh) + r) * 64 + 8 * hh;
#pragma unroll
        for (int ks = 0; ks < 4; ++ks) Qf[ks] = *(const bf16x8*)(qp + 16 * ks); }
    VM_WAIT(); __syncthreads();
    f32x16 O0 = {}, O1 = {}; float lsum = 0.f;
    const int kt0 = (128 - q0 - 32 * w) > 0 ? ((128 - q0 - 32 * w) >> 5) : 0;
    const int li = lane & 15, gq = lane >> 4;
#pragma unroll 1
    for (int kt = kt0; kt < 5; ++kt) {
        const int lr0 = 32 * (w + kt);
        f32x16 sT = {};
        { const int lr = lr0 + c; const LAS unsigned char* kp = F.lds + AT_K + lr * 128;
#pragma unroll
            for (int ks = 0; ks < 4; ++ks) { const bf16x8 kf = *(const LAS bf16x8*)(kp + (((2 * ks + hh) ^ (lr & 7)) * 16)); sT = __builtin_amdgcn_mfma_f32_32x32x16_bf16(kf, Qf[ks], sT, 0, 0, 0); } }
        float p[16];
#pragma unroll
        for (int reg = 0; reg < 16; ++reg) { const int kr = (reg & 3) + 8 * (reg >> 2) + 4 * hh; const int s = 128 + c - 32 * kt - kr; const int kpos = q0 - 128 + lr0 + kr;
            const bool ok = (s >= 0) && (s <= 128) && (kpos >= 0); const int sc_ = s < 0 ? 0 : (s > 128 ? 128 : s);
            const float e = __builtin_amdgcn_exp2f(sT[reg] + biasL[sc_]); p[reg] = ok ? e : 0.f; lsum += p[reg]; }
        bf16x8 Pf[2];
#pragma unroll
        for (int s2 = 0; s2 < 2; ++s2) { u32x4 wv; wv.x = pk2(p[8 * s2], p[8 * s2 + 1]); wv.y = pk2(p[8 * s2 + 2], p[8 * s2 + 3]); wv.z = pk2(p[8 * s2 + 4], p[8 * s2 + 5]); wv.w = pk2(p[8 * s2 + 6], p[8 * s2 + 7]); Pf[s2] = __builtin_bit_cast(bf16x8, wv); }
#pragma unroll
        for (int s2 = 0; s2 < 2; ++s2)
#pragma unroll
            for (int ntl = 0; ntl < 2; ++ntl) {
                const int rowl = lr0 + 16 * s2 + 4 * hh + (li >> 2), rowh = rowl + 8; const int ch = 4 * ntl + 2 * (gq & 1) + ((li & 3) >> 1), sub = (li & 1) * 8;
                const s16x4 lo = __builtin_bit_cast(s16x4, __builtin_amdgcn_ds_read_tr16_b64_v4i16((LAS s16x4*)(F.lds + AT_V + rowl * 128 + ((ch ^ (rowl & 7)) * 16) + sub)));
                const s16x4 hi = __builtin_bit_cast(s16x4, __builtin_amdgcn_ds_read_tr16_b64_v4i16((LAS s16x4*)(F.lds + AT_V + rowh * 128 + ((ch ^ (rowh & 7)) * 16) + sub)));
                const bf16x8 vf = (bf16x8){lo[0], lo[1], lo[2], lo[3], hi[0], hi[1], hi[2], hi[3]};
                if (ntl == 0) O0 = __builtin_amdgcn_mfma_f32_32x32x16_bf16(Pf[s2], vf, O0, 0, 0, 0); else O1 = __builtin_amdgcn_mfma_f32_32x32x16_bf16(Pf[s2], vf, O1, 0, 0, 0);
            }
    }
    lsum += __shfl_xor(lsum, 32);
    if (hh == 0) lw[c] = lsum;
    __syncthreads();
    { LAS float* ost = (LAS float*)(F.lds + w * 8192);
#pragma unroll
        for (int reg = 0; reg < 16; ++reg) { const int qrow = (reg & 3) + 8 * (reg >> 2) + 4 * hh; ost[qrow * 64 + c] = O0[reg]; ost[qrow * 64 + 32 + c] = O1[reg]; }
        LDS_WAIT();
        const int row = lane >> 1, half = lane & 1; const float l1 = lw[row]; const LAS f32x4* op = (const LAS f32x4*)(ost + row * 64 + 32 * half);
        const size_t tok = (size_t)b * SEQ + (size_t)((q0 + 32 * w + row) << dsh) + r;
        if (kind != 0) {
            bf16* pp = (bf16*)(F.ws + (kind == 1 ? WS_P4 : WS_P16)) + (tok * 8 + h) * 64 + 32 * half; const float inv = 1.f / l1;
#pragma unroll
            for (int q = 0; q < 4; ++q) *(bf16x8*)(pp + 8 * q) = pack8(op[2 * q] * inv, op[2 * q + 1] * inv);
            if (half == 0) ((float*)(F.ws + (kind == 1 ? WS_L4 : WS_L16)))[tok * 8 + h] = l1;
        } else {
            const bf16* p4 = (const bf16*)(F.ws + WS_P4) + (tok * 8 + h) * 64 + 32 * half; const bf16* p16 = (const bf16*)(F.ws + WS_P16) + (tok * 8 + h) * 64 + 32 * half;
            const float l4 = ((const float*)(F.ws + WS_L4))[tok * 8 + h], l16 = ((const float*)(F.ws + WS_L16))[tok * 8 + h]; const float inv = 1.f / (l1 + l4 + l16);
            bf16* dst = mix + tok * 1024 + 512 + h * 64 + 32 * half;
#pragma unroll
            for (int q = 0; q < 4; ++q) { const u32x4 a4 = *(const u32x4*)(p4 + 8 * q), a16 = *(const u32x4*)(p16 + 8 * q);
                const f32x4 x0 = (op[2 * q] + (f32x4){bflo(a4.x), bfhi(a4.x), bflo(a4.y), bfhi(a4.y)} * l4 + (f32x4){bflo(a16.x), bfhi(a16.x), bflo(a16.y), bfhi(a16.y)} * l16) * inv;
                const f32x4 x1 = (op[2 * q + 1] + (f32x4){bflo(a4.z), bfhi(a4.z), bflo(a4.w), bfhi(a4.w)} * l4 + (f32x4){bflo(a16.z), bfhi(a16.z), bflo(a16.w), bfhi(a16.w)} * l16) * inv;
                *(bf16x8*)(dst + 8 * q) = pack8(x0, x1); }
        }
    }
    __syncthreads();
}

constexpr int RT_LCNT = 0, RT_BASE = 256, RT_RANK = 512;
__device__ __forceinline__ void route_phase(Frame& F, const Args& a) {
    const float* hsrc = a.out; const float* wrT = (const float*)(F.ws + WS_WRT); const float* b_r = a.in[13];
    int* te = (int*)(F.ws + WS_TE); int* tslot = (int*)(F.ws + WS_TSLOT); float* tg = (float*)(F.ws + WS_TG); int* list = (int*)(F.ws + WS_LIST); float* lrs = (float*)(F.ws + WS_LRS);
    LAS int* lcnt = (LAS int*)(F.lds + RT_LCNT); LAS int* lbase = (LAS int*)(F.lds + RT_BASE); LAS int* lrank = (LAS int*)(F.lds + RT_RANK);
    const int lane = F.lane, c = lane & 31, hh = lane >> 5;
    for (int blk = F.vcu; blk < T / 128; blk += F.G) {
        if (F.tid < 32) lcnt[F.tid] = 0;
        __syncthreads();
        int e4[4] = {0, 0, 0, 0}, rk[4] = {0, 0, 0, 0}; float g4[4] = {0.f, 0.f, 0.f, 0.f}; float rs = 0.f; const int tok = blk * 128 + (F.wave & 3) * 32 + c;
        f32x16 acc = {}; float ss = 0.f;
        { const int kh = F.wave >> 2; const float* hp = hsrc + (size_t)tok * D + 4 * hh + 512 * kh; const float* wp = wrT + (size_t)c * D + 4 * hh + 512 * kh;
#pragma unroll 8
            for (int q = 0; q < 64; ++q) { const f32x4 hv = *(const f32x4*)(hp + 8 * q), wv = *(const f32x4*)(wp + 8 * q);
                ss += (hv[0] * hv[0] + hv[1] * hv[1]) + (hv[2] * hv[2] + hv[3] * hv[3]);
#pragma unroll
                for (int i = 0; i < 4; ++i) acc = __builtin_amdgcn_mfma_f32_32x32x2f32(wv[i], hv[i], acc, 0, 0, 0); }
            LAS float* px = (LAS float*)(F.lds + 4096) + ((F.wave & 3) * 64 + lane) * 17;
            if (F.wave >= 4) {
#pragma unroll
                for (int r = 0; r < 16; ++r) px[r] = acc[r];
                px[16] = ss; }
            __syncthreads();
            if (F.wave < 4) {
#pragma unroll
                for (int r = 0; r < 16; ++r) acc[r] += px[r];
                ss += px[16]; } }
        if (F.wave < 4) {
            ss += __shfl_xor(ss, 32); rs = rsqrtf(ss * (1.f / D) + EPS);
            float tv[4] = {-3.0e38f, -3.0e38f, -3.0e38f, -3.0e38f}; int tix[4] = {0, 1, 2, 3};
#pragma unroll
            for (int reg = 0; reg < 16; ++reg) { const int e = (reg & 3) + 8 * (reg >> 2) + 4 * hh; float v = acc[reg] * rs + b_r[e]; int ix = e;
#pragma unroll
                for (int s = 0; s < 4; ++s) { const bool gt = (v > tv[s]) || (v == tv[s] && ix < tix[s]); const float ov = tv[s]; const int oi = tix[s]; tv[s] = gt ? v : ov; tix[s] = gt ? ix : oi; v = gt ? ov : v; ix = gt ? oi : ix; } }
            float pv[4]; int pi[4];
#pragma unroll
            for (int s = 0; s < 4; ++s) { pv[s] = __shfl_xor(tv[s], 32); pi[s] = __shfl_xor(tix[s], 32); }
#pragma unroll
            for (int t2 = 0; t2 < 4; ++t2) { float v = pv[t2]; int ix = pi[t2];
#pragma unroll
                for (int s = 0; s < 4; ++s) { const bool gt = (v > tv[s]) || (v == tv[s] && ix < tix[s]); const float ov = tv[s]; const int oi = tix[s]; tv[s] = gt ? v : ov; tix[s] = gt ? ix : oi; v = gt ? ov : v; ix = gt ? oi : ix; } }
            const float e0 = 1.f, e1 = __expf(tv[1] - tv[0]), e2 = __expf(tv[2] - tv[0]), e3 = __expf(tv[3] - tv[0]); const float inv = 1.f / (e0 + e1 + e2 + e3);
            g4[0] = e0 * inv; g4[1] = e1 * inv; g4[2] = e2 * inv; g4[3] = e3 * inv;
#pragma unroll
            for (int s = 0; s < 4; ++s) e4[s] = tix[s];
            if (hh == 0) {
#pragma unroll
                for (int s = 0; s < 4; ++s) rk[s] = atomicAdd((int*)(lcnt + e4[s]), 1);
            }
        }
        __syncthreads();
        if (F.tid < 32) lbase[F.tid] = (int)__hip_atomic_fetch_add(F.ctl + CW_GCNT + 64 * F.tid, (unsigned)lcnt[F.tid], RLX_AGENT);
        __syncthreads();
        if (F.wave < 4 && hh == 0) {
#pragma unroll
            for (int s = 0; s < 4; ++s) { const int slot = lbase[e4[s]] + rk[s]; te[tok * 4 + s] = e4[s]; tslot[tok * 4 + s] = slot; tg[tok * 4 + s] = g4[s];
                list[(size_t)e4[s] * LCAP + slot] = tok; lrs[(size_t)e4[s] * LCAP + slot] = rs; }
        }
        __syncthreads();
    }
}
__device__ __forceinline__ int moe_tables(Frame& F) {
    LAS int* tstart = (LAS int*)(F.lds + MOE_TSTART); LAS int* lcnt = (LAS int*)(F.lds + MOE_LCNT); LAS int* texp = (LAS int*)(F.lds + MOE_TEXP);
    if (F.tid == 0) { int acc = 0; for (int e = 0; e < NE; ++e) { const int cnt = (int)__hip_atomic_load(F.ctl + CW_GCNT + 64 * e, RLX_AGENT); lcnt[e] = cnt; tstart[e] = acc; const int nt = (cnt + 255) >> 8; for (int i = 0; i < nt; ++i) texp[acc + i] = e; acc += nt; } tstart[NE] = acc; }
    __syncthreads();
    return tstart[NE];
}
__device__ __forceinline__ void combine_phase(Frame& F, const Args& a, float* dst) {
    LAS int* tstart = (LAS int*)(F.lds + MOE_TSTART);
    const int* te = (const int*)(F.ws + WS_TE); const int* tslot = (const int*)(F.ws + WS_TSLOT); const float* tg = (const float*)(F.ws + WS_TG); const unsigned char* Y = F.ws + WS_Y;
    const float* out = a.out; const int gw = F.vcu * NWAVES + F.wave, NGW = F.G * NWAVES, lane = F.lane;
    for (int t0 = gw * 16; t0 < T; t0 += NGW * 16) {
        int pos[4]; float gt[4];
        { const int tl = t0 + (lane & 15);
#pragma unroll
            for (int s = 0; s < 4; ++s) { const int e = te[tl * 4 + s]; pos[s] = tstart[e] * 256 + tslot[tl * 4 + s]; gt[s] = tg[tl * 4 + s]; } }
#pragma unroll 1
        for (int i = 0; i < 16; i += 2) {
            f32x4 o[2][4]; u32x4 w[2][4];
#pragma unroll
            for (int q = 0; q < 2; ++q) { const float* op = out + (size_t)(t0 + i + q) * D + 16 * lane;
#pragma unroll
                for (int j = 0; j < 4; ++j) o[q][j] = *(const f32x4*)(op + 4 * j);
#pragma unroll
                for (int s = 0; s < 4; ++s) { const size_t p = (size_t)__builtin_amdgcn_readlane(pos[s], i + q); w[q][s] = *(const u32x4*)(Y + p * D + 16 * lane); } }
#pragma unroll
            for (int q = 0; q < 2; ++q) { float* op = dst + (size_t)(t0 + i + q) * D + 16 * lane;
#pragma unroll
                for (int s = 0; s < 4; ++s) { const float g = __builtin_bit_cast(float, __builtin_amdgcn_readlane(__builtin_bit_cast(int, gt[s]), i + q));
#pragma unroll
                    for (int j = 0; j < 4; ++j) { const int ww = (int)w[q][s][j]; const f32x2 lo = __builtin_amdgcn_cvt_pk_f32_fp8(ww, false), hi = __builtin_amdgcn_cvt_pk_f32_fp8(ww, true);
                        o[q][j] += (f32x4){lo[0], lo[1], hi[0], hi[1]} * g; } }
#pragma unroll
                for (int j = 0; j < 4; ++j) *(f32x4*)(op + 4 * j) = o[q][j]; }
        }
    }
}

constexpr int NPHASE = 9;
__global__ void __launch_bounds__(NTHREADS, 2) hymba_fwd(Args args) {
    extern __shared__ __attribute__((aligned(16))) unsigned char lds_raw[];
    Frame F; F.lds = (LAS unsigned char*)lds_raw; F.ws = args.ws; F.ctl = (unsigned*)(args.ws + WS_CTL);
    F.tid = threadIdx.x; F.lane = F.tid & 63; F.wave = __builtin_amdgcn_readfirstlane(F.tid >> 6);
    F.G = gridDim.x; { const int bx = blockIdx.x; F.vcu = (F.G % 8 == 0) ? (bx % 8) * (F.G / 8) + bx / 8 : bx; }
    volatile LAS unsigned* MISC = (volatile LAS unsigned*)(F.lds + MISC_OFF);
    if (F.tid < 32) MISC[F.tid] = 0u;
    __syncthreads();
    XcdBarrier bar; bar.bar = F.ctl + CW_BAR; bar.x = 0; bar.st = nullptr;
    if (MK_N_LAUNCHES == 1) bar = xcd_barrier_post(F.ctl + CW_BAR, MISC + 8);
    const int lo = args.ph_lo, hi = args.ph_hi;
#define IN(k) (lo <= (k) && (k) < hi)
#define SEAM(k) do { if (IN(k) && IN((k) + 1)) xcd_barrier(bar); } while (0)

    if (IN(0)) { for (int rep = 0; rep < (DUP == 4 ? 2 : 1); ++rep) phase0(F, args); SEAM(0); }
    if (IN(1)) {
        pg8::Gemm g{(const bf16*)(F.ws + WS_XN), (const bf16*)(F.ws + WS_WIN), D}; pg8::StaticOrder S{T / 256, NIN / 256, F.G, (int)blockIdx.x};
        pg8::EpiInProj E{(bf16*)(F.ws + WS_ZG), (bf16*)(F.ws + WS_QB), (bf16*)(F.ws + WS_KB), (bf16*)(F.ws + WS_VB), args.in[7], args.in[8], F.lds + RING_BYTES};
        pg8::gemm_phase<pg8::EpiInProj, pg8::StaticOrder, false, true>(F.lds, g, S, E);
        SEAM(1);
    }
    if (IN(2)) {
        for (int rep = 0; rep < (DUP == 1 ? 2 : 1); ++rep)
        for (int u = F.vcu; u < NBATCH * GH * NCHUNK; u += F.G) gdn_prep_unit(F, args, u);
        SEAM(2);
    }
    if (IN(3)) {
        const int nscan = NBATCH * GH;
        for (int rep3 = 0; rep3 < (DUP == 13 ? 2 : 1); ++rep3) {
        for (int bh = blockIdx.x; bh < nscan; bh += F.G) for (int rep = 0; rep < (DUP == 3 ? 2 : 1); ++rep) gdn_scan(F, args, bh);
        if (rep3 == 0) { if (F.G > nscan) { if ((int)blockIdx.x >= nscan) p0_experts(F, args, ((int)blockIdx.x - nscan) * NWAVES + F.wave, (F.G - nscan) * NWAVES); } else p0_experts(F, args, (int)blockIdx.x * NWAVES + F.wave, F.G * NWAVES); __syncthreads(); }
        for (int pass = 0; pass < 2; ++pass) {
            for (int rep = 0; rep < (DUP == 2 ? 2 : 1); ++rep)
            for (;;) {
                if (F.tid == 0) MISC[16] = __hip_atomic_fetch_add(F.ctl + CW_ATTQ + 64 * (pass + 2 * rep + 4 * rep3), 1u, RLX_AGENT);
                __syncthreads();
                const int u = (int)MISC[16] + (pass ? 2048 : 0);
                __syncthreads();
                if (u >= (pass ? 3072 : 2048)) break;
                attn_unit(F, args, u);
            }
            if (pass == 0 || DUP == 13) xcd_barrier(bar);
        } }
        SEAM(3);
    }
    if (IN(4)) {
        pg8::Gemm g{(const bf16*)(F.ws + WS_MIX), (const bf16*)(F.ws + WS_WOUT), D}; pg8::StaticOrder S{T / 256, D / 256, F.G, (int)blockIdx.x};
        pg8::EpiOutProj E{args.in[0], args.out, F.ws + WS_HB};
        for (int rep = 0; rep < (DUP == 6 ? 2 : 1); ++rep) { pg8::gemm_phase<pg8::EpiOutProj, pg8::StaticOrder, false, true>(F.lds, g, S, E); __syncthreads(); }
        SEAM(4);
    }
#if !SKIP_MOE
    if (IN(5)) {
        if (DUP == 10) { route_phase(F, args); xcd_barrier(bar); if (blockIdx.x == 0 && F.tid < 32) __hip_atomic_store(F.ctl + CW_GCNT + 64 * F.tid, 0u, RLX_AGENT); xcd_barrier(bar); }
        route_phase(F, args); SEAM(5); }
    if (IN(6)) {
        const int nM = moe_tables(F);
        pg8::Gemm g{(const bf16*)(F.ws + WS_HB), (const bf16*)(F.ws + WS_WGU), D};
        pg8::MoeOrder S{nM, 8, F.G, (int)blockIdx.x, (const LAS int*)(F.lds + MOE_TSTART), (const LAS int*)(F.lds + MOE_LCNT), (const LAS int*)(F.lds + MOE_TEXP), (const int*)(F.ws + WS_LIST)};
        pg8::EpiGateUp E{F.ws + WS_ACT, args.in[15], (const float*)(F.ws + WS_LRS), (const LAS int*)(F.lds + MOE_LCNT)};
        for (int rep = 0; rep < (DUP == 7 ? 2 : 1); ++rep) { pg8::gemm_phase<pg8::EpiGateUp, pg8::MoeOrder, true, true, true>(F.lds, g, S, E); __syncthreads(); }
        SEAM(6);
    }
    if (IN(7)) {
        const int nM = moe_tables(F);
        pg8::Gemm g{(const bf16*)(F.ws + WS_ACT), (const bf16*)(F.ws + WS_WDN), FF};
        pg8::MoeOrder S{nM, 4, F.G, (int)blockIdx.x, (const LAS int*)(F.lds + MOE_TSTART), (const LAS int*)(F.lds + MOE_LCNT), (const LAS int*)(F.lds + MOE_TEXP), (const int*)(F.ws + WS_LIST)};
        pg8::EpiDown E{F.ws + WS_Y, args.in[17], F.lds + RING_BYTES};
        for (int rep = 0; rep < (DUP == 8 ? 2 : 1); ++rep) { pg8::gemm_phase<pg8::EpiDown, pg8::MoeOrder, false, true, true>(F.lds, g, S, E); __syncthreads(); }
        SEAM(7);
    }
    if (IN(8)) { (void)moe_tables(F); if (DUP == 11) combine_phase(F, args, (float*)(F.ws + WS_ZG)); combine_phase(F, args, args.out); }
#endif
#undef IN
#undef SEAM
}

extern "C" void kernel_launch(void* const* d_in, const int* in_sizes, int n_in, void* d_out, int out_size, void* d_ws, size_t ws_size, hipStream_t stream) {
    static int grid = 0;
    if (grid == 0) {
        if (n_in != 18 || in_sizes[0] != T * D || out_size != T * D || ws_size < WS_END) { fprintf(stderr, "kernel_launch: unexpected shapes (n_in %d, in0 %d, out %d, ws %zu)\n", n_in, n_in > 0 ? in_sizes[0] : -1, out_size, ws_size); grid = -1; return; }
        int dev = 0, cus = 0, per_cu = 0;
        if (hipGetDevice(&dev) != hipSuccess || hipDeviceGetAttribute(&cus, hipDeviceAttributeMultiprocessorCount, dev) != hipSuccess) { grid = -1; return; }
        if (hipFuncSetAttribute((const void*)hymba_fwd, hipFuncAttributeMaxDynamicSharedMemorySize, LDS_BYTES) != hipSuccess) { fprintf(stderr, "kernel_launch: hipFuncSetAttribute failed\n"); grid = -1; return; }
        if (hipOccupancyMaxActiveBlocksPerMultiprocessor(&per_cu, (const void*)hymba_fwd, NTHREADS, LDS_BYTES) != hipSuccess || per_cu < 1) { fprintf(stderr, "kernel_launch: occupancy query says %d\n", per_cu); per_cu = 1; }
        (void)hipGetLastError();
        grid = cus;
    }
    if (grid < 0) return;
    (void)hipMemsetAsync((char*)d_ws + WS_CTL, 0, CTL_ZERO_BYTES, stream);
    Args a{};
    for (int i = 0; i < 18; ++i) a.in[i] = (const float*)d_in[i];
    a.out = (float*)d_out; a.ws = (unsigned char*)d_ws;
    if (MK_N_LAUNCHES == 1) {
        a.ph_lo = 0; a.ph_hi = NPHASE; a.li = 0;
        void* kargs[] = {&a};
        hipError_t e = hipLaunchCooperativeKernel((const void*)hymba_fwd, dim3(grid), dim3(NTHREADS), kargs, LDS_BYTES, stream);
        if (e != hipSuccess) fprintf(stderr, "kernel_launch: cooperative launch failed: %s (grid %d)\n", hipGetErrorString(e), grid);
    } else {
        for (int p = 0; p < NPHASE; ++p) { a.ph_lo = p; a.ph_hi = p + 1; a.li = p; hipLaunchKernelGGL(hymba_fwd, dim3(grid), dim3(NTHREADS), LDS_BYTES, stream, a); }
    }
}
```

```cpp
#include <hip/hip_runtime.h>
#include <cstdio>
#include <cstdint>

#ifndef MK_N_LAUNCHES
#define MK_N_LAUNCHES 1
#endif
#ifndef SKIP_ATTN
#define SKIP_ATTN 0
#endif
#ifndef DUP
#define DUP 0
#endif
#ifndef ATT_JOBS
#define ATT_JOBS 32
#endif
#ifndef SKIP_MOE
#define SKIP_MOE 0
#endif

#define LAS __attribute__((address_space(3)))
#define GAS __attribute__((address_space(1)))
typedef unsigned short bf16;
typedef short bf16x8 __attribute__((ext_vector_type(8)));
typedef short s16x4 __attribute__((ext_vector_type(4)));
typedef float f32x2 __attribute__((ext_vector_type(2)));
typedef float f32x4 __attribute__((ext_vector_type(4)));
typedef float f32x16 __attribute__((ext_vector_type(16)));
typedef unsigned u32x2 __attribute__((ext_vector_type(2)));
typedef unsigned u32x4 __attribute__((ext_vector_type(4)));
typedef __bf16 bf16x2_t __attribute__((ext_vector_type(2)));
typedef int v4i_t __attribute__((ext_vector_type(4)));
typedef int v8i_t __attribute__((ext_vector_type(8)));

constexpr int NBATCH = 8, SEQ = 4096, D = 1024, T = NBATCH * SEQ;
constexpr int IN_DIM = 3592, NIN = 3584;
constexpr int GH = 4, DK = 128, CHUNK = 64, NCHUNK = SEQ / CHUNK;
constexpr int AH = 8, DH = 64;
constexpr int NE = 32, FF = 1024, LCAP = 32768;
constexpr float EPS = 1e-6f, LOG2E = 1.4426950408889634f;
constexpr int NWAVES = 8, NTHREADS = 512;

constexpr size_t MiB = 1u << 20;
constexpr size_t WS_CTL = 0, CTL_ZERO_BYTES = 1 * MiB;
constexpr size_t WS_WIN = 1 * MiB, WS_WOUT = 8 * MiB, WS_WGU = 10 * MiB, WS_WDN = 138 * MiB;
constexpr size_t WS_TE = 202 * MiB, WS_TSLOT = WS_TE + 512 * 1024, WS_TG = WS_TSLOT + 512 * 1024;
constexpr size_t WS_LIST = 204 * MiB, WS_LRS = 208 * MiB;
constexpr size_t WS_BA = 212 * MiB, WS_WRT = 213 * MiB;
constexpr size_t WS_ZG = 214 * MiB, WS_QB = 342 * MiB, WS_KB = 374 * MiB, WS_VB = 406 * MiB;
constexpr size_t WS_PREP = 438 * MiB;
constexpr int PREP_WP = 0, PREP_QP = 16384, PREP_AP = 32768, PREP_KT = 40960, PREP_UP = 57344, PREP_CD = 90112, PREP_REC = 90368;
constexpr size_t WS_OG = 616 * MiB, WS_MIX = 680 * MiB;
constexpr size_t WS_XN = 760 * MiB, WS_HB = 760 * MiB;
constexpr size_t WS_ACT = 214 * MiB, WS_Y = 486 * MiB, WS_END = 824 * MiB;
static_assert(WS_VB - WS_KB == WS_KB - WS_QB, "q/k/v stride");
static_assert(WS_PREP + (size_t)NBATCH * GH * NCHUNK * PREP_REC <= WS_OG, "prep region");
static_assert(WS_ACT + (size_t)(T * 4 + NE * 256) * FF * 2 <= WS_Y && WS_Y + (size_t)(T * 4 + NE * 256) * D * 2 <= WS_HB, "act/y regions");
constexpr int CW_TMO = 0, CW_CODE = 1, CW_ATTQ = 512, CW_GCNT = 1024  , CW_BAR = 8192;

constexpr int LDS_BYTES = 160 * 1024;
constexpr int RING_BYTES = 131072;
constexpr int TOP_OFF = LDS_BYTES - 4096;
constexpr int MISC_OFF = TOP_OFF;
constexpr int MOE_TAB_OFF = TOP_OFF + 256;
constexpr int MOE_TSTART = MOE_TAB_OFF, MOE_LCNT = MOE_TAB_OFF + 256, MOE_TEXP = MOE_TAB_OFF + 512;

#define RLX_AGENT __ATOMIC_RELAXED, __HIP_MEMORY_SCOPE_AGENT
#define LDS_WAIT() asm volatile("s_waitcnt lgkmcnt(0)" ::: "memory")
#define VM_WAIT() asm volatile("s_waitcnt vmcnt(0)" ::: "memory")
#define LDS_BARRIER() do { asm volatile("s_waitcnt lgkmcnt(0)" ::: "memory"); __builtin_amdgcn_s_barrier(); asm volatile("" ::: "memory"); } while (0)
__device__ __forceinline__ unsigned pk2(float lo, float hi) { f32x2 v = {lo, hi}; bf16x2_t b = __builtin_convertvector(v, bf16x2_t); return __builtin_bit_cast(unsigned, b); }
__device__ __forceinline__ unsigned pk4_fp8(float a, float b, float c, float d) { int w = 0; w = __builtin_amdgcn_cvt_pk_fp8_f32(a, b, w, false); w = __builtin_amdgcn_cvt_pk_fp8_f32(c, d, w, true); return (unsigned)w; }
__device__ __forceinline__ float bf2f(unsigned short b) { return __uint_as_float((unsigned)b << 16); }
__device__ __forceinline__ float bflo(unsigned w) { return __uint_as_float(w << 16); }
__device__ __forceinline__ float bfhi(unsigned w) { return __uint_as_float(w & 0xffff0000u); }
template <int CTRL> __device__ __forceinline__ float dpp_mov(float v) { return __builtin_bit_cast(float, __builtin_amdgcn_update_dpp(0, __builtin_bit_cast(int, v), CTRL, 0xF, 0xF, true)); }
__device__ __forceinline__ float sum_row16(float v) {
    v += dpp_mov<0xB1>(v);
    v += dpp_mov<0x4E>(v);
    v += dpp_mov<0x141>(v);
    v += dpp_mov<0x140>(v);
    return v; }
__device__ __forceinline__ float sum_xor16(float v) { const unsigned u = __builtin_bit_cast(unsigned, v); auto r = __builtin_amdgcn_permlane16_swap(u, u, false, false); return __builtin_bit_cast(float, (unsigned)r[0]) + __builtin_bit_cast(float, (unsigned)r[1]); }
__device__ __forceinline__ float sum_xor32(float v) { const unsigned u = __builtin_bit_cast(unsigned, v); auto r = __builtin_amdgcn_permlane32_swap(u, u, false, false); return __builtin_bit_cast(float, (unsigned)r[0]) + __builtin_bit_cast(float, (unsigned)r[1]); }
__device__ __forceinline__ float wave_sum(float v) { return sum_xor32(sum_xor16(sum_row16(v))); }
__device__ __forceinline__ float silu_f(float x) { return x * __builtin_amdgcn_rcpf(1.f + __expf(-x)); }
__device__ __forceinline__ float sigmoid_f(float x) { return __builtin_amdgcn_rcpf(1.f + __expf(-x)); }
__device__ __forceinline__ bf16x8 pack8(f32x4 a, f32x4 b) {
    u32x4 w; w.x = pk2(a[0], a[1]); w.y = pk2(a[2], a[3]); w.z = pk2(b[0], b[1]); w.w = pk2(b[2], b[3]); return __builtin_bit_cast(bf16x8, w);
}

__device__ __forceinline__ void glds16_asm(const void* gsrc, unsigned lds_dst) { unsigned keep;
    asm volatile("s_mov_b32 %0, m0\n\ts_mov_b32 m0, %2\n\ts_nop 0\n\tglobal_load_lds_dwordx4 %1, off\n\ts_mov_b32 m0, %0" : "=&s"(keep) : "v"(gsrc), "s"(lds_dst) : "memory"); }

namespace pg8 {
constexpr int BM = 256, BK = 64, HALF = 128, HTB = HALF * BK * 2, STAGE_BYTES = 8 * HTB, NXCD = 8, WGM = 8;
__host__ __device__ __forceinline__ int lds_byte(int r, int c) { const int st = (r >> 4) * 2 + (c >> 5), rr = r & 15, cc = c & 31, ob = rr * 64 + cc * 2; return st * 1024 + (ob ^ (((ob >> 9) & 1) << 5)); }
__host__ __device__ __forceinline__ void stage_rc(int b, int& R, int& C) { const int st = b / 1024, sb = b % 1024, swz = sb ^ (((sb >> 9) & 1) << 5); R = (st >> 1) * 16 + swz / 64; C = (st & 1) * 32 + (swz % 64) / 2; }
__host__ __device__ __forceinline__ int perm32(int rho) { const int n = rho >> 4, i = rho & 15; return 8 * (i >> 2) + 4 * n + (i & 3); }

struct Unit { int pm, pn, pb, e, mt; };
struct Gemm { const bf16* A; const bf16* Bt; int K; };

__device__ __forceinline__ bool static_tile(int i, int G, int c, int nM, int nN, int& pm, int& pn) {
    const int nwg = nM * nN; const long L = (long)i * G + c; if (L >= nwg) return false;
    int wgid = (int)L; { const int q = nwg / NXCD, r = nwg % NXCD, xcd = wgid % NXCD, off = wgid / NXCD; wgid = (xcd < r ? xcd * (q + 1) : r * (q + 1) + (xcd - r) * q) + off; }
    const int nig = WGM * nN, gid = wgid / nig, fm = gid * WGM, gsz = (nM - fm) < WGM ? (nM - fm) : WGM;
    pm = fm + ((wgid % nig) % gsz); pn = (wgid % nig) / gsz; return true;
}
struct StaticOrder {
    int nM, nN, G, c;
    __device__ __forceinline__ bool next(int i, Unit& u) const { int pm, pn; if (!static_tile(i, G, c, nM, nN, pm, pn)) return false; u.pm = pm; u.pn = pn; u.pb = pn; u.e = 0; u.mt = 0; return true; }
    __device__ __forceinline__ int row_index(const Unit&, int) const { return 0; }
};
struct MoeOrder {
    int nM, nN, G, c; const LAS int* tstart; const LAS int* lcnt; const LAS int* texp; const int* list;
    __device__ __forceinline__ bool next(int i, Unit& u) const {
        int pm, pn; if (!static_tile(i, G, c, nM, nN, pm, pn)) return false;
        const int e = texp[pm]; u.pm = pm; u.pn = pn; u.e = e; u.pb = e * nN + pn; u.mt = pm - tstart[e]; return true;
    }
    __device__ __forceinline__ int row_index(const Unit& u, int r) const { const int rr = u.mt * 256 + r; const int v = list[u.e * LCAP + rr]; return rr < lcnt[u.e] ? v : 0; }
};

#define PG8_SA(b, h) (((b) * 2 + (h)) * HTB)
#define PG8_SB(b, h) ((4 + (b) * 2 + (h)) * HTB)
#define PG8_GLDS(src, dstoff) __builtin_amdgcn_global_load_lds((const unsigned*)(src), (LAS unsigned*)(lds + (dstoff)), 16, 0, 0)
#define PG8_STAGE_B(bufoff, nx, kb, h) do { _Pragma("unroll") for (int _i = 0; _i < 2; ++_i) \
        PG8_GLDS(((nx) ? nB : cB) + (kb) + (Epi::WIDE ? (size_t)voffBW[h][_i] : (size_t)(h) * hstep + voffB[_i]), (bufoff) + ldsw + _i * 8192); } while (0)
#define PG8_STAGE_A(bufoff, nx, kb, h) do { _Pragma("unroll") for (int _i = 0; _i < 2; ++_i) \
        PG8_GLDS(GATHER ? (const char*)g.A + (kb) + ((nx) ? voffN[h][_i] : voffC[h][_i]) : ((nx) ? nA : cA) + (kb) + (size_t)(h) * hstep + voffA[_i], (bufoff) + ldsw + _i * 8192); } while (0)
#define PG8_LDA8(dst, b, h) do { _Pragma("unroll") for (int m = 0; m < 4; ++m) { const v4i_t lo_ = *(const LAS v4i_t*)(lds + PG8_SA(b, h) + aoff + m * 2048), hi_ = *(const LAS v4i_t*)(lds + PG8_SA(b, h) + aoff + m * 2048 + 1024); dst[m] = __builtin_shufflevector(lo_, hi_, 0, 1, 2, 3, 4, 5, 6, 7); } } while (0)
#define PG8_LDB8(dst, b, h) do { _Pragma("unroll") for (int n = 0; n < 2; ++n) { const v4i_t lo_ = *(const LAS v4i_t*)(lds + PG8_SB(b, h) + boff + n * 2048), hi_ = *(const LAS v4i_t*)(lds + PG8_SB(b, h) + boff + n * 2048 + 1024); dst[n] = __builtin_shufflevector(lo_, hi_, 0, 1, 2, 3, 4, 5, 6, 7); } } while (0)
#define PG8_LDA(dst, b, h) do { _Pragma("unroll") for (int m = 0; m < 4; ++m) _Pragma("unroll") for (int k = 0; k < 2; ++k) dst[m][k] = *(const LAS bf16x8*)(lds + PG8_SA(b, h) + aoff + m * 2048 + k * 1024); } while (0)
#define PG8_LDB(dst, b, h) do { _Pragma("unroll") for (int n = 0; n < 2; ++n) _Pragma("unroll") for (int k = 0; k < 2; ++k) dst[n][k] = *(const LAS bf16x8*)(lds + PG8_SB(b, h) + boff + n * 2048 + k * 1024); } while (0)
#define PG8_MMA(ai, bj, At, Bt) do { __builtin_amdgcn_s_setprio(1); _Pragma("unroll") for (int m = 0; m < 4; ++m) _Pragma("unroll") for (int n = 0; n < 2; ++n) _Pragma("unroll") for (int k = 0; k < 2; ++k) \
        acc[ai][bj][m][n] = __builtin_amdgcn_mfma_f32_16x16x32_bf16(Bt[n][k], At[m][k], acc[ai][bj][m][n], 0, 0, 0); __builtin_amdgcn_s_setprio(0); } while (0)
#define PG8_MMA8(ai, bj, At, Bt) do { __builtin_amdgcn_s_setprio(1); _Pragma("unroll") for (int m = 0; m < 4; ++m) _Pragma("unroll") for (int n = 0; n < 2; ++n) \
        asm volatile("v_mfma_scale_f32_16x16x128_f8f6f4 %0, %1, %2, %0, %3, %4 op_sel_hi:[0,0,0]" : "+v"(acc[ai][bj][m][n]) : "v"(Bt[n]), "v"(At[m]), "v"(sc_w), "v"(sc_a)); __builtin_amdgcn_s_setprio(0); } while (0)
#define XLDA(b, h) do { if constexpr (FP8) PG8_LDA8(At8, b, h); else PG8_LDA(At, b, h); } while (0)
#define XLDB0(b, h) do { if constexpr (FP8) PG8_LDB8(B08, b, h); else PG8_LDB(B0, b, h); } while (0)
#define XLDB1(b, h) do { if constexpr (FP8) PG8_LDB8(B18, b, h); else PG8_LDB(B1, b, h); } while (0)
#define XMMA0(ai, bj) do { if constexpr (FP8) PG8_MMA8(ai, bj, At8, B08); else PG8_MMA(ai, bj, At, B0); } while (0)
#define XMMA1(ai, bj) do { if constexpr (FP8) PG8_MMA8(ai, bj, At8, B18); else PG8_MMA(ai, bj, At, B1); } while (0)
#define PG8_WAIT_V(n) asm volatile("s_waitcnt vmcnt(" #n ")" ::: "memory")
#define PG8_WAIT_L(n) asm volatile("s_waitcnt lgkmcnt(" #n ")" ::: "memory")
#define PG8_BAR __builtin_amdgcn_s_barrier()
#define PG8_SCHED __builtin_amdgcn_sched_barrier(0)

template <class Epi, class Sched, bool GATHER, bool ALIGN_EPI, bool FP8 = false>
__device__ __forceinline__ void gemm_phase(LAS unsigned char* lds, const Gemm g, const Sched& S, const Epi& E) {
    const int tid = threadIdx.x, wid = __builtin_amdgcn_readfirstlane(tid >> 6), lane = tid & 63, wr = wid >> 2, wc = wid & 3, fr = lane & 15, fq = lane >> 4;
    const int K = g.K, rowb = FP8 ? K : 2 * K, nt = rowb / 128;
    unsigned voffA[2], voffB[2], voffBW[2][2], voffC[2][2], voffN[2][2]; int RA[2], CA[2];
#pragma unroll
    for (int i = 0; i < 2; ++i) { int R, C; stage_rc(tid * 16 + i * 8192, R, C); const int Rb = Epi::PERM ? ((R & ~31) + perm32(R & 31)) : R;
        RA[i] = R; CA[i] = C; voffA[i] = (unsigned)(R * rowb + C * 2); voffB[i] = (unsigned)(Rb * rowb + C * 2);
        voffBW[0][i] = (unsigned)((64 * (R >> 5) + perm32(R & 31)) * rowb + C * 2); voffBW[1][i] = (unsigned)((64 * (R >> 5) + 32 + perm32(R & 31)) * rowb + C * 2); }
    const size_t kstep = (size_t)(BK * 2), hstep = (size_t)HALF * rowb, tstep = 2 * hstep;
    const unsigned ldsw = (unsigned)wid * 1024u;
    const int aoff = lds_byte(wr * 64 + fr, fq * 8), boff = lds_byte(wc * 32 + fr, fq * 8);
    Unit cur, nxt; int ui = 0;
    if (!S.next(0, cur)) return;
    f32x4 acc[2][2][4][2];
#pragma unroll
    for (int a = 0; a < 2; ++a)
#pragma unroll
        for (int b = 0; b < 2; ++b)
#pragma unroll
            for (int m = 0; m < 4; ++m)
#pragma unroll
                for (int n = 0; n < 2; ++n) acc[a][b][m][n] = (f32x4){0.f, 0.f, 0.f, 0.f};
    bf16x8 At[4][2], B0[2][2], B1[2][2]; v8i_t At8[4], B08[2], B18[2]; int sc_w = 0x7a7a7a7a, sc_a = 0x7f7f7f7f; asm volatile("" : "+v"(sc_w), "+v"(sc_a));
    const char* cA = (const char*)g.A + (size_t)cur.pm * tstep; const char* cB = (const char*)g.Bt + (size_t)cur.pb * tstep;
    if (GATHER) {
#pragma unroll
        for (int h = 0; h < 2; ++h)
#pragma unroll
            for (int i = 0; i < 2; ++i) { voffC[h][i] = (unsigned)(S.row_index(cur, RA[i] + 128 * h) * rowb + CA[i] * 2); voffN[h][i] = voffC[h][i]; }
    }
    const char* nA = cA; const char* nB = cB;
    PG8_STAGE_B(PG8_SB(0, 0), false, 0, 0); PG8_STAGE_B(PG8_SB(0, 1), false, 0, 1); PG8_STAGE_A(PG8_SA(0, 0), false, 0, 0); PG8_STAGE_A(PG8_SA(0, 1), false, 0, 1);
    if (wr == 1) PG8_BAR;
    PG8_WAIT_V(2); PG8_BAR;
    PG8_STAGE_B(PG8_SB(1, 0), false, kstep, 0); PG8_STAGE_A(PG8_SA(1, 0), false, kstep, 0); PG8_STAGE_B(PG8_SB(1, 1), false, kstep, 1);
    PG8_WAIT_V(6); PG8_BAR;
    for (;;) {
        const bool has_next = S.next(ui + 1, nxt);
        nA = has_next ? (const char*)g.A + (size_t)nxt.pm * tstep : cA; nB = has_next ? (const char*)g.Bt + (size_t)nxt.pb * tstep : cB;
        if (GATHER) {
            if (has_next) { int ix[2][2];
#pragma unroll
                for (int h = 0; h < 2; ++h)
#pragma unroll
                    for (int i = 0; i < 2; ++i) ix[h][i] = S.row_index(nxt, RA[i] + 128 * h);
#pragma unroll
                for (int h = 0; h < 2; ++h)
#pragma unroll
                    for (int i = 0; i < 2; ++i) voffN[h][i] = (unsigned)(ix[h][i] * rowb + CA[i] * 2);
            } else {
#pragma unroll
                for (int h = 0; h < 2; ++h)
#pragma unroll
                    for (int i = 0; i < 2; ++i) voffN[h][i] = voffC[h][i]; }
        }
        for (int t = 0; t < nt; t += 2) {
            const bool last = (t == nt - 2);
            const size_t k1 = (size_t)(t + 1) * kstep, k2 = last ? 0 : (size_t)(t + 2) * kstep, k3 = k2 + kstep;
            XLDB0(0, 0); XLDB1(0, 1); PG8_SCHED; XLDA(0, 0); PG8_STAGE_A(PG8_SA(1, 1), false, k1, 1);
            PG8_WAIT_V(8); PG8_WAIT_L(0); PG8_BAR; XMMA0(0, 0); XMMA1(0, 1); PG8_BAR; PG8_SCHED;
            XLDA(0, 1); PG8_STAGE_B(PG8_SB(0, 0), last, k2, 0); PG8_STAGE_B(PG8_SB(0, 1), last, k2, 1); PG8_STAGE_A(PG8_SA(0, 0), last, k2, 0);
            PG8_WAIT_V(8); PG8_WAIT_L(0); PG8_BAR; XMMA0(1, 0); XMMA1(1, 1); PG8_BAR; PG8_SCHED;
            XLDB0(1, 0); XLDB1(1, 1); PG8_SCHED; XLDA(1, 0); PG8_STAGE_A(PG8_SA(0, 1), last, k2, 1);
            PG8_WAIT_V(8); PG8_WAIT_L(0); PG8_BAR; XMMA0(0, 0); XMMA1(0, 1); PG8_BAR; PG8_SCHED;
            XLDA(1, 1); PG8_STAGE_B(PG8_SB(1, 0), last, k3, 0); PG8_STAGE_B(PG8_SB(1, 1), last, k3, 1); PG8_STAGE_A(PG8_SA(1, 0), last, k3, 0);
            PG8_WAIT_V(8); PG8_WAIT_L(0); PG8_BAR; XMMA0(1, 0); XMMA1(1, 1); PG8_BAR; PG8_SCHED;
        }
        if constexpr (ALIGN_EPI) { if (wr == 0) PG8_BAR; }
        if constexpr (FP8) asm volatile("s_nop 15\n\ts_nop 15" ::: "memory");
        E(acc, cur, wr, wc, fr, fq);
        if (DUP == 14) { asm volatile("" ::: "memory"); E(acc, cur, wr, wc, fr, fq); }
        if (!has_next) break;
#pragma unroll
        for (int a = 0; a < 2; ++a)
#pragma unroll
            for (int b = 0; b < 2; ++b)
#pragma unroll
                for (int m = 0; m < 4; ++m)
#pragma unroll
                    for (int n = 0; n < 2; ++n) acc[a][b][m][n] = (f32x4){0.f, 0.f, 0.f, 0.f};
        cur = nxt; cA = nA; cB = nB; ++ui;
        if (GATHER) {
#pragma unroll
            for (int h = 0; h < 2; ++h)
#pragma unroll
                for (int i = 0; i < 2; ++i) voffC[h][i] = voffN[h][i];
        }
        if constexpr (ALIGN_EPI) { if (wr == 1) PG8_BAR; }
    }
    PG8_WAIT_V(0);
    if constexpr (!ALIGN_EPI) { if (wr == 0) PG8_BAR; }
    PG8_BAR;
}

struct EpiInProj {
    static constexpr bool PERM = true, WIDE = true;
    bf16* zg; bf16* qb; bf16* kb; bf16* vb; const float* qn; const float* kn; LAS unsigned char* stage; const float* gnw;
    __device__ __forceinline__ void operator()(const f32x4 (&acc)[2][2][4][2], const Unit& u, int wr, int wc, int fr, int fq) const {
        const int lane = fq * 16 + fr; LAS unsigned char* stg = stage + (wr * 4 + wc) * 3584;
        const bool swa = u.pn >= 8; const int sec = swa ? (u.pn - 8) >> 1 : 0, head = 4 * ((u.pn - 8) & 1) + wc; const bool gate = (u.pn == 6) || (u.pn == 7);
        bf16* dst = qb + (size_t)sec * ((WS_KB - WS_QB) / 2); const float* nw = (sec == 1) ? kn : qn;
        f32x4 wv[2][2];
#pragma unroll
        for (int bj = 0; bj < 2; ++bj)
#pragma unroll
            for (int n = 0; n < 2; ++n) { const f32x4 t_ = *(const f32x4*)(nw + 32 * bj + 8 * fq + 4 * n); const f32x4 g_ = *(const f32x4*)(gnw + ((wc & 1) * 64 + 32 * bj + 8 * fq + 4 * n));
                wv[bj][n] = (swa && sec < 2) ? t_ : (gate ? g_ : (f32x4){1.f, 1.f, 1.f, 1.f}); }
#pragma unroll
        for (int ai = 0; ai < 2; ++ai)
#pragma unroll
            for (int m = 0; m < 4; ++m) {
                float sc = 1.f;
                if (swa && sec < 2) { float ss = 0.f;
#pragma unroll
                    for (int bj = 0; bj < 2; ++bj)
#pragma unroll
                        for (int n = 0; n < 2; ++n) { const f32x4 x = acc[ai][bj][m][n]; ss += (x[0] * x[0] + x[1] * x[1]) + (x[2] * x[2] + x[3] * x[3]); }
                    ss = sum_xor32(sum_xor16(ss));
                    sc = rsqrtf(ss * (1.f / 64.f) + EPS) * (sec == 0 ? 0.125f * LOG2E : 1.f); }
#pragma unroll
                for (int bj = 0; bj < 2; ++bj) { f32x4 v0 = acc[ai][bj][m][0] * sc, v1 = acc[ai][bj][m][1] * sc;
                    if (gate) { v0 = (f32x4){silu_f(v0[0]), silu_f(v0[1]), silu_f(v0[2]), silu_f(v0[3])}; v1 = (f32x4){silu_f(v1[0]), silu_f(v1[1]), silu_f(v1[2]), silu_f(v1[3])}; }
                    v0 = v0 * wv[bj][0]; v1 = v1 * wv[bj][1];
                    u32x4 w; w.x = pk2(v0[0], v0[1]); w.y = pk2(v0[2], v0[3]); w.z = pk2(v1[0], v1[1]); w.w = pk2(v1[2], v1[3]); *(LAS u32x4*)(stg + fr * 144 + bj * 64 + fq * 16) = w; }
                asm volatile("s_waitcnt lgkmcnt(0)" ::: "memory");
                const int row0 = u.pm * BM + ai * HALF + wr * 64 + m * 16;
#pragma unroll
                for (int hf = 0; hf < 2; ++hf) { const int rr = hf * 8 + (lane >> 3), c16 = lane & 7, row_ = row0 + rr; const u32x4 w = *(const LAS u32x4*)(stg + rr * 144 + c16 * 16);
                    bf16* gp = swa ? dst + ((size_t)((row_ >> 12) * AH + head) * SEQ + (row_ & (SEQ - 1))) * 64 + 8 * c16 : zg + (size_t)row_ * 2048 + u.pn * BM + wc * 64 + 8 * c16;
                    *(u32x4*)gp = w; }
                asm volatile("s_waitcnt lgkmcnt(0)" ::: "memory"); }
    }
};
struct EpiOutProj {
    static constexpr bool PERM = false, WIDE = false;
    const float* x; float* h; unsigned char* hb;
    __device__ __forceinline__ void operator()(const f32x4 (&acc)[2][2][4][2], const Unit& u, int wr, int wc, int fr, int fq) const {
        const int row0 = u.pm * BM + wr * 64 + fr, col0 = u.pn * BM + wc * 32 + 4 * fq;
#pragma unroll
        for (int ai = 0; ai < 2; ++ai) {
            f32x4 xv[4][2][2];
#pragma unroll
            for (int m = 0; m < 4; ++m) { const size_t off = (size_t)(row0 + ai * HALF + m * 16) * D + col0;
#pragma unroll
                for (int bj = 0; bj < 2; ++bj)
#pragma unroll
                    for (int n = 0; n < 2; ++n) xv[m][bj][n] = *(const f32x4*)(x + off + bj * HALF + n * 16); }
#pragma unroll
            for (int m = 0; m < 4; ++m) { const size_t off = (size_t)(row0 + ai * HALF + m * 16) * D + col0;
#pragma unroll
                for (int bj = 0; bj < 2; ++bj)
#pragma unroll
                    for (int n = 0; n < 2; ++n) { const f32x4 v = xv[m][bj][n] + acc[ai][bj][m][n];
                        *(f32x4*)(h + off + bj * HALF + n * 16) = v; *(unsigned*)(hb + off + bj * HALF + n * 16) = pk4_fp8(v[0], v[1], v[2], v[3]); } } }
    }
};
struct EpiGateUp {
    static constexpr bool PERM = true, WIDE = false;
    unsigned char* act; const float* bgu; const float* lrs; const LAS int* lcnt;
    __device__ __forceinline__ void operator()(const f32x4 (&acc)[2][2][4][2], const Unit& u, int wr, int wc, int fr, int fq) const {
        const int cl = wc * 32 + 8 * fq; const float* bg = bgu + (size_t)u.e * 2048 + 128 * u.pn + cl;
        f32x4 bgv[2], buv[2];
#pragma unroll
        for (int n = 0; n < 2; ++n) { bgv[n] = *(const f32x4*)(bg + 4 * n); buv[n] = *(const f32x4*)(bg + 1024 + 4 * n); }
        const int cnt = lcnt[u.e];
        float rsa[2][4];
#pragma unroll
        for (int ai = 0; ai < 2; ++ai)
#pragma unroll
            for (int m = 0; m < 4; ++m) rsa[ai][m] = lrs[(size_t)u.e * LCAP + u.mt * 256 + ai * HALF + wr * 64 + m * 16 + fr];
#pragma unroll
        for (int ai = 0; ai < 2; ++ai)
#pragma unroll
            for (int m = 0; m < 4; ++m) { const int r = ai * HALF + wr * 64 + m * 16 + fr, rr = u.mt * 256 + r;
                const float rs = rr < cnt ? rsa[ai][m] : 0.f;
                unsigned wq[2];
#pragma unroll
                for (int n = 0; n < 2; ++n) { float a[4];
#pragma unroll
                    for (int i = 0; i < 4; ++i) { const float gt = fminf(acc[ai][0][m][n][i] * rs + bgv[n][i], 7.f); const float up = fminf(fmaxf(acc[ai][1][m][n][i] * rs + buv[n][i], -7.f), 7.f);
                        a[i] = (up + 1.f) * gt * sigmoid_f(1.702f * gt); }
                    wq[n] = pk4_fp8(a[0], a[1], a[2], a[3]); }
                *(u32x2*)(act + (size_t)(u.pm * BM + r) * FF + 128 * u.pn + cl) = (u32x2){wq[0], wq[1]}; }
    }
};
struct EpiDown {
    static constexpr bool PERM = true, WIDE = true;
    unsigned char* y; const float* bdn; LAS unsigned char* stage;
    __device__ __forceinline__ void operator()(const f32x4 (&acc)[2][2][4][2], const Unit& u, int wr, int wc, int fr, int fq) const {
        const int colw = u.pn * BM + wc * 64; const float* bp = bdn + (size_t)u.e * D + colw + 8 * fq;
        f32x4 bv[2][2];
#pragma unroll
        for (int bj = 0; bj < 2; ++bj)
#pragma unroll
            for (int n = 0; n < 2; ++n) bv[bj][n] = *(const f32x4*)(bp + 32 * bj + 4 * n);
        const int lane = fq * 16 + fr; LAS unsigned char* stg = stage + (wr * 4 + wc) * 3584;
#pragma unroll
        for (int ai = 0; ai < 2; ++ai)
#pragma unroll
            for (int mp = 0; mp < 2; ++mp) {
#pragma unroll
                for (int mm = 0; mm < 2; ++mm) { const int m = 2 * mp + mm;
#pragma unroll
                    for (int bj = 0; bj < 2; ++bj) { const f32x4 v0 = acc[ai][bj][m][0] + bv[bj][0], v1 = acc[ai][bj][m][1] + bv[bj][1];
                        *(LAS u32x2*)(stg + (16 * mm + fr) * 80 + bj * 32 + fq * 8) = (u32x2){pk4_fp8(v0[0], v0[1], v0[2], v0[3]), pk4_fp8(v1[0], v1[1], v1[2], v1[3])}; } }
                asm volatile("s_waitcnt lgkmcnt(0)" ::: "memory");
                { const int rr = lane >> 2, c16 = lane & 3; const u32x4 w = *(const LAS u32x4*)(stg + rr * 80 + c16 * 16);
                  const int rowa = u.pm * BM + ai * HALF + wr * 64 + (2 * mp) * 16 + rr; *(u32x4*)(y + (size_t)rowa * D + colw + 16 * c16) = w;
                  const u32x4 w2 = *(const LAS u32x4*)(stg + (16 + rr) * 80 + c16 * 16); *(u32x4*)(y + (size_t)(rowa + 16) * D + colw + 16 * c16) = w2; }
                asm volatile("s_waitcnt lgkmcnt(0)" ::: "memory"); }
    }
};
}

#define XB_TMO      128
#define XB_XCNT(j)  (256  + 64 * (j))
#define XB_XSUB(j)  (1280 + 64 * (j))
#define XB_XGEN(j)  (2304 + 64 * (j))
#define XB_TOP      3328
#define XB_TOPGEN   3392
#define XCD_BAR_WORDS 3456
#define XB_SPIN_CAP (1u << 20)
__device__ __forceinline__ unsigned xb_ld(unsigned* p)              { return __hip_atomic_load(p, __ATOMIC_RELAXED, __HIP_MEMORY_SCOPE_AGENT); }
__device__ __forceinline__ unsigned xb_add(unsigned* p, unsigned v) { return __hip_atomic_fetch_add(p, v, __ATOMIC_RELAXED, __HIP_MEMORY_SCOPE_AGENT); }
__device__ __forceinline__ unsigned xb_xcc_id() { return (unsigned)__builtin_amdgcn_s_getreg((3 << 11) | 20) & 0xFu; }
#define XB_SPIN(cond, bar) do { unsigned _sp = 0; while (cond) { __builtin_amdgcn_s_sleep(1); \
    if ((++_sp & 255u) == 0u) { if (xb_ld(&(bar)[XB_TMO])) break; if (_sp > XB_SPIN_CAP) { atomicAdd(&(bar)[XB_TMO], 1u); break; } } } } while (0)
struct XcdBarrier { unsigned* bar; unsigned x; volatile LAS unsigned* st; };
__device__ __forceinline__ XcdBarrier xcd_barrier_post(unsigned* bar, volatile LAS unsigned* st) {
    XcdBarrier b; b.bar = bar; b.x = xb_xcc_id(); b.st = st;
    if (threadIdx.x == 0) (void)xb_add(&bar[XB_XCNT(b.x)], 1u);
    return b;
}
__device__ __forceinline__ void xcd_barrier_complete(unsigned* bar, unsigned x, unsigned& nloc, unsigned& nx) {
    const unsigned G = gridDim.x * gridDim.y * gridDim.z;
    unsigned sum, cnt, mine, sp = 0u;
    for (;;) {
        sum = 0u; cnt = 0u; mine = 0u;
#pragma unroll
        for (unsigned j = 0; j < 16; ++j) { const unsigned c = xb_ld(&bar[XB_XCNT(j)]); sum += c; cnt += (c > 0u) ? 1u : 0u; mine = (j == x) ? c : mine; }
        if (sum == G) break;
        __builtin_amdgcn_s_sleep(1);
        if ((++sp & 255u) == 0u) { if (xb_ld(&bar[XB_TMO])) break; if (sp > XB_SPIN_CAP) { atomicAdd(&bar[XB_TMO], 1u); break; } }
    }
    nloc = mine > 0u ? mine : 1u; nx = cnt > 0u ? cnt : 1u;
}
__device__ __forceinline__ void xcd_barrier(const XcdBarrier& b) {
    asm volatile("s_waitcnt vmcnt(0)" ::: "memory");
    __syncthreads();
    if (threadIdx.x == 0) {
        unsigned* bar = b.bar;
        __builtin_amdgcn_s_waitcnt(0);
        unsigned nloc = b.st[0], nx = b.st[1];
        if (nloc == 0u) { xcd_barrier_complete(bar, b.x, nloc, nx); b.st[0] = nloc; b.st[1] = nx; }
        const unsigned old = xb_add(&bar[XB_XSUB(b.x)], 1u);
        const unsigned gen = old / nloc;
        if (old + 1u == (gen + 1u) * nloc) {
            __builtin_amdgcn_fence(__ATOMIC_RELEASE, "agent");
            asm volatile("s_waitcnt vmcnt(0)" ::: "memory");
            const unsigned og = xb_add(&bar[XB_TOP], 1u);
            const unsigned tg = og / nx;
            if (og + 1u == (tg + 1u) * nx) xb_add(&bar[XB_TOPGEN], 1u);
            else XB_SPIN(xb_ld(&bar[XB_TOPGEN]) == tg, bar);
            __builtin_amdgcn_fence(__ATOMIC_ACQUIRE, "agent");
            xb_add(&bar[XB_XGEN(b.x)], 1u);
            asm volatile("s_waitcnt vmcnt(0)" ::: "memory");
        } else {
            XB_SPIN(xb_ld(&bar[XB_XGEN(b.x)]) == gen, bar);
            __builtin_amdgcn_fence(__ATOMIC_ACQUIRE, "agent");
            asm volatile("s_waitcnt vmcnt(0)" ::: "memory");
        }
    }
    __syncthreads();
}

struct Args { const float* in[18]; float* out; unsigned char* ws; int ph_lo, ph_hi, li, pad; };
struct Frame {
    LAS unsigned char* lds; unsigned char* ws; unsigned* ctl;
    int tid, lane, wave, G, vcu;
};

__device__ const unsigned char T5B[3][132] = {
{0,1,2,3,4,5,6,7,8,9,10,11,12,13,14,15,16,16,16,16,16,16,17,17,17,17,17,17,17,17,18,18,18,18,18,18,18,18,18,18,19,19,19,19,19,19,19,19,19,19,19,19,19,19,20,20,20,20,20,20,20,20,20,20,20,20,20,20,20,20,20,20,20,21,21,21,21,21,21,21,21,21,21,21,21,21,21,21,21,21,21,21,21,21,21,21,21,21,21,22,22,22,22,22,22,22,22,22,22,22,22,22,22,22,22,22,22,22,22,22,22,22,22,22,22,22,22,22,22,0,0,0},
{0,4,8,12,16,16,17,17,18,18,19,19,19,19,20,20,20,20,20,21,21,21,21,21,21,22,22,22,22,22,22,22,22,22,23,23,23,23,23,23,23,23,23,23,23,23,24,24,24,24,24,24,24,24,24,24,24,24,24,24,24,24,25,25,25,25,25,25,25,25,25,25,25,25,25,25,25,25,25,25,25,25,25,26,26,26,26,26,26,26,26,26,26,26,26,26,26,26,26,26,26,26,26,26,26,26,26,26,26,26,26,26,26,27,27,27,27,27,27,27,27,27,27,27,27,27,27,27,27,0,0,0},
{0,16,18,19,20,21,21,22,22,23,23,23,24,24,24,24,25,25,25,25,25,26,26,26,26,26,26,26,26,27,27,27,27,27,27,27,27,27,27,28,28,28,28,28,28,28,28,28,28,28,28,28,29,29,29,29,29,29,29,29,29,29,29,29,29,29,29,29,29,29,30,30,30,30,30,30,30,30,30,30,30,30,30,30,30,30,30,30,30,30,30,30,30,30,30,31,31,31,31,31,31,31,31,31,31,31,31,31,31,31,31,31,31,31,31,31,31,31,31,31,31,31,31,31,31,31,31,31,31,0,0,0}};

__device__ __forceinline__ void p0_load8(const float* W, size_t ldw, int src_col0, int k0, int lane, f32x4 (&v)[8]) {
    const int n4 = (lane & 7) * 4, kr = lane >> 3;
#pragma unroll
    for (int i = 0; i < 8; ++i) v[i] = *(const f32x4*)(W + (size_t)(k0 + 8 * i + kr) * ldw + src_col0 + n4);
}
template <bool SCALE, bool OUT8> __device__ __forceinline__ void p0_finish(const f32x4 (&v)[8], void* dstv, int k0, const float* kscale, LAS float* scr, int lane) {
    { const int n4 = (lane & 7) * 4, kr = lane >> 3;
#pragma unroll
        for (int i = 0; i < 8; ++i) { const int kk = 8 * i + kr; f32x4 x = v[i]; if (SCALE) x = x * kscale[k0 + kk]; if (OUT8) x = x * 32.f;
            scr[kk * 33 + n4] = x[0]; scr[kk * 33 + n4 + 1] = x[1]; scr[kk * 33 + n4 + 2] = x[2]; scr[kk * 33 + n4 + 3] = x[3]; } }
    LDS_WAIT(); asm volatile("" ::: "memory");
    if (OUT8) { unsigned char* dst = (unsigned char*)dstv; const int n = lane >> 1, kh = lane & 1; const LAS float* sp = scr + (32 * kh) * 33 + n; unsigned w[8];
#pragma unroll
        for (int q = 0; q < 8; ++q) w[q] = pk4_fp8(sp[(4 * q) * 33], sp[(4 * q + 1) * 33], sp[(4 * q + 2) * 33], sp[(4 * q + 3) * 33]);
        *(u32x4*)(dst + (size_t)n * 1024 + k0 + 32 * kh) = (u32x4){w[0], w[1], w[2], w[3]}; *(u32x4*)(dst + (size_t)n * 1024 + k0 + 32 * kh + 16) = (u32x4){w[4], w[5], w[6], w[7]};
    } else { bf16* dst = (bf16*)dstv; const int c = lane & 7;
#pragma unroll
        for (int j = 0; j < 4; ++j) { const int n = (lane >> 3) + 8 * j; const LAS float* sp = scr + (8 * c) * 33 + n;
            u32x4 o; o.x = pk2(sp[0 * 33], sp[1 * 33]); o.y = pk2(sp[2 * 33], sp[3 * 33]); o.z = pk2(sp[4 * 33], sp[5 * 33]); o.w = pk2(sp[6 * 33], sp[7 * 33]);
            *(u32x4*)(dst + (size_t)n * 1024 + k0 + 8 * c) = o; } }
    LDS_WAIT(); asm volatile("" ::: "memory");
}
template <bool SCALE, bool OUT8> __device__ __forceinline__ void p0_transpose_item(const float* W, size_t ldw, int src_col0, void* dstv, int k0, const float* kscale, LAS float* scr, int lane) {
    f32x4 v[8]; p0_load8(W, ldw, src_col0, k0, lane, v); p0_finish<SCALE, OUT8>(v, dstv, k0, kscale, scr, lane);
}
__device__ __forceinline__ void p0_experts(Frame& F, const Args& a, int gw, int NGW) {
    const float* n2 = a.in[11]; const float* w_gu = a.in[14]; const float* w_dn = a.in[16];
    bf16* Wgu_t = (bf16*)(F.ws + WS_WGU); bf16* Wdn_t = (bf16*)(F.ws + WS_WDN);
    LAS float* scr = (LAS float*)(F.lds + F.wave * 8448);
    constexpr int I_GU = NE * 16 * 64, I_DN = NE * 16 * 32;
    constexpr int NI = I_GU + I_DN;
#define P0_X_LOAD(r_, v_) do { if ((r_) < I_GU) { const int e_ = (r_) >> 10, q_ = (r_) & 1023, nb_ = q_ & 63, kb_ = q_ >> 6, np_ = 32 * nb_, ntile_ = np_ >> 8, lc_ = np_ & 255, bj_ = lc_ >> 7, j0_ = lc_ & 127; \
            p0_load8(w_gu + (size_t)e_ * D * 2048, 2048, bj_ * 1024 + 128 * ntile_ + j0_, 64 * kb_, F.lane, v_); } \
        else { const int r2_ = (r_) - I_GU, e_ = r2_ >> 9, q_ = r2_ & 511, nb_ = q_ & 31, kb_ = q_ >> 5; p0_load8(w_dn + (size_t)e_ * FF * D, D, 32 * nb_, 64 * kb_, F.lane, v_); } } while (0)
#define P0_X_FIN(r_, v_) do { if ((r_) < I_GU) { const int e_ = (r_) >> 10, q_ = (r_) & 1023, nb_ = q_ & 63, kb_ = q_ >> 6, np_ = 32 * nb_; \
            p0_finish<true, true>(v_, (unsigned char*)Wgu_t + ((size_t)e_ * 2048 + np_) * 1024, 64 * kb_, n2, scr, F.lane); } \
        else { const int r2_ = (r_) - I_GU, e_ = r2_ >> 9, q_ = r2_ & 511, nb_ = q_ & 31, kb_ = q_ >> 5; p0_finish<false, true>(v_, (unsigned char*)Wdn_t + ((size_t)e_ * 1024 + 32 * nb_) * 1024, 64 * kb_, nullptr, scr, F.lane); } } while (0)
    { f32x4 va[8], vb2[8]; int it = gw;
        if (it < NI) P0_X_LOAD(it, va);
#pragma unroll 1
        for (; it < NI; it += 2 * NGW) { const int it2 = it + NGW, it3 = it + 2 * NGW;
            if (it2 < NI) P0_X_LOAD(it2, vb2);
            P0_X_FIN(it, va);
            if (it3 < NI) P0_X_LOAD(it3, va);
            if (it2 < NI) P0_X_FIN(it2, vb2); } }
#undef P0_X_LOAD
#undef P0_X_FIN
}
__device__ __forceinline__ void phase0(Frame& F, const Args& a) {
    const float* x = a.in[0]; const float* n1 = a.in[1]; const float* w_in = a.in[2]; const float* w_out = a.in[10]; const float* n2 = a.in[11];
    const float* w_r = a.in[12]; const float* w_gu = a.in[14]; const float* w_dn = a.in[16];
    bf16* Win_t = (bf16*)(F.ws + WS_WIN); bf16* Wout_t = (bf16*)(F.ws + WS_WOUT); bf16* Wgu_t = (bf16*)(F.ws + WS_WGU); bf16* Wdn_t = (bf16*)(F.ws + WS_WDN);
    float* wrT = (float*)(F.ws + WS_WRT); bf16* XN = (bf16*)(F.ws + WS_XN); float* BA = (float*)(F.ws + WS_BA);
    LAS float* scr = (LAS float*)(F.lds + F.wave * 8448);
    const int gw = F.vcu * NWAVES + F.wave, NGW = F.G * NWAVES;
    for (int i = (F.vcu * NTHREADS + F.tid); i < NE * D; i += F.G * NTHREADS) { const int e = i >> 10, k = i & 1023; wrT[i] = n2[k] * w_r[k * NE + e]; }
    constexpr int I_IN = 16 * (NIN / 32), I_OUT = 16 * 32;
    for (int it = gw; it < I_IN + I_OUT; it += NGW) {
        int r = it;
        if (r < I_IN) { const int nb = r % (NIN / 32), kb = r / (NIN / 32), np = 32 * nb; int src;
            src = np < 2048 ? np : np + 8;
            p0_transpose_item<false, false>(w_in, IN_DIM, src, Win_t + (size_t)np * 1024, 64 * kb, nullptr, scr, F.lane); continue; }
        r -= I_IN;
        { const int nb = r & 31, kb = r >> 5; p0_transpose_item<false, false>(w_out, D, 32 * nb, Wout_t + (size_t)(32 * nb) * 1024, 64 * kb, nullptr, scr, F.lane); }
    }
    __syncthreads();
    { LAS float* wb = (LAS float*)(F.lds + 69632);
        for (int k = F.tid; k < D; k += NTHREADS) { const float* wp = w_in + (size_t)k * IN_DIM + 2048; LAS float* dp = wb + (k >> 2) * 36 + (k & 3) * 8;
            *(LAS f32x4*)dp = *(const f32x4*)wp; *(LAS f32x4*)(dp + 4) = *(const f32x4*)(wp + 4); }
        __syncthreads();
        f32x4 n1v[4];
#pragma unroll
        for (int j = 0; j < 4; ++j) n1v[j] = *((const f32x4*)n1 + F.lane + 64 * j);
        for (int rep9 = 0; rep9 < (DUP == 9 ? 2 : 1); ++rep9)
        for (int m0 = gw * 4; m0 < T; m0 += NGW * 4) {
            f32x4 v[4][4]; float rs[4];
#pragma unroll
            for (int r = 0; r < 4; ++r)
#pragma unroll
                for (int j = 0; j < 4; ++j) v[r][j] = *((const f32x4*)(x + (size_t)(m0 + r) * D) + F.lane + 64 * j);
#pragma unroll
            for (int r = 0; r < 4; ++r) { float sq = 0.f;
#pragma unroll
                for (int j = 0; j < 4; ++j) sq += (v[r][j][0] * v[r][j][0] + v[r][j][1] * v[r][j][1]) + (v[r][j][2] * v[r][j][2] + v[r][j][3] * v[r][j][3]);
                rs[r] = rsqrtf(wave_sum(sq) * (1.f / D) + EPS); }
            float ba[4][8];
#pragma unroll
            for (int r = 0; r < 4; ++r)
#pragma unroll
                for (int c = 0; c < 8; ++c) ba[r][c] = 0.f;
#pragma unroll
            for (int j = 0; j < 4; ++j) {
#pragma unroll
                for (int r = 0; r < 4; ++r) { v[r][j] = v[r][j] * rs[r] * n1v[j];
                    *((unsigned long long*)(XN + (size_t)(m0 + r) * D) + F.lane + 64 * j) = (unsigned long long)pk2(v[r][j][0], v[r][j][1]) | ((unsigned long long)pk2(v[r][j][2], v[r][j][3]) << 32); }
#pragma unroll
                for (int i = 0; i < 4; ++i) { const LAS float* wp = wb + (F.lane + 64 * j) * 36 + i * 8; const f32x4 w0 = *(const LAS f32x4*)wp, w1 = *(const LAS f32x4*)(wp + 4);
#pragma unroll
                    for (int r = 0; r < 4; ++r) { const float xv = v[r][j][i];
                        ba[r][0] += xv * w0[0]; ba[r][1] += xv * w0[1]; ba[r][2] += xv * w0[2]; ba[r][3] += xv * w0[3];
                        ba[r][4] += xv * w1[0]; ba[r][5] += xv * w1[1]; ba[r][6] += xv * w1[2]; ba[r][7] += xv * w1[3]; } } }
#pragma unroll
            for (int r = 0; r < 4; ++r) {
#pragma unroll
                for (int c = 0; c < 8; ++c) ba[r][c] = wave_sum(ba[r][c]);
                if (F.lane == 0) { *(f32x4*)(BA + (size_t)(m0 + r) * 8) = (f32x4){ba[r][0], ba[r][1], ba[r][2], ba[r][3]}; *(f32x4*)(BA + (size_t)(m0 + r) * 8 + 4) = (f32x4){ba[r][4], ba[r][5], ba[r][6], ba[r][7]}; } }
        }
        __syncthreads();
    }
}

constexpr int GP = 132;
constexpr int GQ_OFF = 0, GK_OFF = 64 * GP * 4, GV_OFF = 2 * 64 * GP * 4, GW_OFF = 3 * 64 * GP * 4, GAT_OFF = 4 * 64 * GP * 4, GAT_P = 68;
constexpr int GRAW_OFF = GW_OFF, GRAW_BYTES = 67 * 768;
constexpr int GGC_OFF = GRAW_OFF + GRAW_BYTES, GBETA_OFF = GGC_OFF + 256, GDM_OFF = GBETA_OFF + 256, GEND = GDM_OFF + 4096;
static_assert(GAT_OFF + 64 * GAT_P * 4 <= GGC_OFF && GEND <= TOP_OFF, "gdn prep LDS");
__device__ __forceinline__ int permpos(int cc) { return 8 * ((cc & 15) >> 2) + (cc & 3) + 4 * (cc >> 4); }
__device__ __forceinline__ void gdn_prep_unit(Frame& F, const Args& a, int unit, int next_unit) {
    const bf16* zg = (const bf16*)(F.ws + WS_ZG); const float* BA = (const float*)(F.ws + WS_BA);
    const float* convw = a.in[3]; const float* a_log = a.in[4]; const float* dt_bias = a.in[5];
    const int b = unit >> 8, h = (unit >> 6) & 3, n = unit & 63; const int row0 = b * SEQ + n * CHUNK;
    unsigned char* rec = F.ws + WS_PREP + (size_t)unit * PREP_REC;
    LAS float* Qs = (LAS float*)(F.lds + GQ_OFF); LAS float* Ks = (LAS float*)(F.lds + GK_OFF); LAS float* Vs = (LAS float*)(F.lds + GV_OFF); LAS float* Ws = (LAS float*)(F.lds + GW_OFF);
    LAS float* AT = (LAS float*)(F.lds + GAT_OFF); LAS float* gcs = (LAS float*)(F.lds + GGC_OFF); LAS float* betas = (LAS float*)(F.lds + GBETA_OFF);
    LAS unsigned char* raw = F.lds + GRAW_OFF;
    const int tid = F.tid, lane = F.lane, wave = F.wave;
    for (int e = tid; e < 67 * 48; e += NTHREADS) { const int rr = e / 48, ch = e % 48; const int tt = n * CHUNK + rr - 3;
        u32x4 v = {0u, 0u, 0u, 0u}; if (tt >= 0) v = *(const u32x4*)(zg + (size_t)(row0 + rr - 3) * 2048 + (ch >> 4) * 512 + h * 128 + (ch & 15) * 8);
        *(LAS u32x4*)(raw + rr * 768 + ch * 16) = v; }
    if (wave == 0) {
        const float bl = BA[(size_t)(row0 + lane) * 8 + h], al = BA[(size_t)(row0 + lane) * 8 + 4 + h];
        const float xx = al + dt_bias[h]; const float sp = xx > 20.f ? xx : log1pf(__expf(xx));
        float g = -__expf(a_log[h]) * sp;
#pragma unroll
        for (int o = 1; o < 64; o <<= 1) { const float u = __shfl_up(g, o); if (lane >= o) g += u; }
        gcs[lane] = g; betas[lane] = sigmoid_f(bl);
    }
    LDS_BARRIER();
    if (tid < 384) { const int cp = tid % 192, tp = tid / 192; const int ten = cp >> 6, c = (cp & 63) * 2; const int ch = ten * 512 + h * 128 + c;
        f32x2 cw[4];
#pragma unroll
        for (int k = 0; k < 4; ++k) cw[k] = *(const f32x2*)(convw + k * 1536 + ch);
        LAS float* dst = (ten == 0 ? Qs : (ten == 1 ? Ks : Vs)) + c;
#pragma unroll 4
        for (int t = tp; t < 64; t += 2) { float a0 = 0.f, a1 = 0.f;
#pragma unroll
            for (int k = 0; k < 4; ++k) { const unsigned w = *(const LAS unsigned*)(raw + (t + k) * 768 + cp * 4); a0 += bflo(w) * cw[k][0]; a1 += bfhi(w) * cw[k][1]; }
            *(LAS f32x2*)(dst + t * GP) = (f32x2){silu_f(a0), silu_f(a1)}; } }
    LDS_BARRIER();
    for (int rr = 0; rr < 8; ++rr) { const int t = wave * 8 + rr;
        f32x2 q = *(LAS f32x2*)(Qs + t * GP + 2 * lane), k = *(LAS f32x2*)(Ks + t * GP + 2 * lane);
        const float sq = wave_sum(q[0] * q[0] + q[1] * q[1]), sk = wave_sum(k[0] * k[0] + k[1] * k[1]);
        const float fq_ = rsqrtf(sq + EPS) * 0.08838834764831845f, fk_ = rsqrtf(sk + EPS);
        *(LAS f32x2*)(Qs + t * GP + 2 * lane) = q * fq_; *(LAS f32x2*)(Ks + t * GP + 2 * lane) = k * fk_; }
    LDS_BARRIER();
    {
        const int which = wave >> 2, ti = (wave >> 1) & 1, tj = wave & 1, r32 = lane & 31, hh = lane >> 5;
        const LAS float* Xa = (which ? Ks + (32 * tj + r32) * GP : Ks + (32 * ti + r32) * GP) + 8 * hh; const LAS float* Xb = (which ? Qs + (32 * ti + r32) * GP : Ks + (32 * tj + r32) * GP) + 8 * hh;
        f32x16 acc = {};
#pragma unroll
        for (int ks = 0; ks < 8; ++ks) { const bf16x8 af = pack8(*(const LAS f32x4*)(Xa + 16 * ks), *(const LAS f32x4*)(Xa + 16 * ks + 4)), bf = pack8(*(const LAS f32x4*)(Xb + 16 * ks), *(const LAS f32x4*)(Xb + 16 * ks + 4));
            acc = __builtin_amdgcn_mfma_f32_32x32x16_bf16(af, bf, acc, 0, 0, 0); }
        if (which == 0) {
            const int j = 32 * tj + r32; const float gj = gcs[j];
#pragma unroll
            for (int q = 0; q < 4; ++q) { float vals[4];
#pragma unroll
                for (int rr = 0; rr < 4; ++rr) { const int i = 32 * ti + 8 * q + 4 * hh + rr; const float dec = __expf(fminf(gcs[i] - gj, 0.f)); vals[rr] = i > j ? betas[i] * acc[4 * q + rr] * dec : 0.f; }
                *(LAS f32x4*)(AT + j * GAT_P + 32 * ti + 8 * q + 4 * hh) = (f32x4){vals[0], vals[1], vals[2], vals[3]}; }
        } else {
            const int i = 32 * ti + r32; const float gi = gcs[i]; bf16* Af = (bf16*)(rec + PREP_AP) + (i >> 4) * 1024 + (i & 15) * 8 + tj * 512;
#pragma unroll
            for (int q = 0; q < 4; ++q) { float vals[4]; const int cc0 = 8 * q + 4 * hh;
#pragma unroll
                for (int rr = 0; rr < 4; ++rr) { const int j = 32 * tj + cc0 + rr; const float dec = __expf(fminf(gi - gcs[j], 0.f)); vals[rr] = i >= j ? acc[4 * q + rr] * dec : 0.f; }
                const int jpos = permpos(cc0); *(u32x2*)(Af + (jpos >> 3) * 128 + (jpos & 7)) = (u32x2){pk2(vals[0], vals[1]), pk2(vals[2], vals[3])}; }
        }
        for (int e = tid; e < 64 * 32; e += NTHREADS) { const int t = e >> 5, c = (e & 31) * 4; const float bt = betas[t], eg = bt * __expf(gcs[t]);
            *(LAS f32x4*)(Vs + t * GP + c) = *(LAS f32x4*)(Vs + t * GP + c) * bt; *(LAS f32x4*)(Ws + t * GP + c) = *(LAS f32x4*)(Ks + t * GP + c) * eg; }
    }
    LDS_BARRIER();
    unsigned pfx = 0u;
    if (next_unit >= 0) { const int nb_ = next_unit >> 8, nh_ = (next_unit >> 6) & 3, nn_ = next_unit & 63; const int nrow0 = nb_ * SEQ + nn_ * CHUNK;
        if (tid < 402) { const int rr = tid / 6, sg = tid % 6; if (nn_ * CHUNK + rr - 3 >= 0) pfx = *(const unsigned*)(zg + (size_t)(nrow0 + rr - 3) * 2048 + (sg >> 1) * 512 + nh_ * 128 + (sg & 1) * 64); }
        else if (tid < 418) pfx = *(const unsigned*)(BA + (size_t)nrow0 * 8 + (tid - 402) * 32); }
    LAS float* Dm = (LAS float*)(F.lds + GDM_OFF);
    if (wave < 4) {
        if (lane < 16) { const int i0 = 16 * wave; float r[16];
#pragma unroll
            for (int ii = 0; ii < 16; ++ii) r[ii] = (ii == lane) ? 1.f : 0.f;
#pragma unroll
            for (int j = 0; j < 16; ++j) { const float xj = r[j]; const LAS f32x4* ap = (const LAS f32x4*)(AT + (i0 + j) * GAT_P + i0); float av[16];
#pragma unroll
                for (int q = 0; q < 4; ++q) { const f32x4 t4 = ap[q]; av[4 * q] = t4[0]; av[4 * q + 1] = t4[1]; av[4 * q + 2] = t4[2]; av[4 * q + 3] = t4[3]; }
#pragma unroll
                for (int ii = 0; ii < 16; ++ii) if (ii > j) r[ii] -= av[ii] * xj; }
#pragma unroll
            for (int ii = 0; ii < 16; ++ii) Dm[wave * 256 + ii * 16 + lane] = r[ii]; }
    } else {
        const int t2 = tid - 256; bf16* Qf = (bf16*)(rec + PREP_QP); bf16* Kf = (bf16*)(rec + PREP_KT); const float gl = gcs[63];
        for (int it = t2; it < 1024; it += 256) { const int blk = it >> 6, l = it & 63, mi = blk >> 2, ks = blk & 3, g = l >> 4, c = 16 * mi + (l & 15); const float eg = __expf(gcs[c]);
            const f32x4 lo = *(LAS f32x4*)(Qs + c * GP + 32 * ks + 4 * g) * eg, hi = *(LAS f32x4*)(Qs + c * GP + 32 * ks + 16 + 4 * g) * eg;
            *(bf16x8*)(Qf + it * 8) = pack8(lo, hi); }
        for (int it = t2; it < 1024; it += 256) { const int blk = it >> 6, l = it & 63, ti = blk >> 1, ks2 = blk & 1, g = l >> 4, dk = 16 * ti + (l & 15); float v[8];
#pragma unroll
            for (int j = 0; j < 8; ++j) { const int c = 32 * ks2 + (j < 4 ? 4 * g + j : 16 + 4 * g + (j - 4)); v[j] = Ks[c * GP + dk] * __expf(gl - gcs[c]); }
            *(bf16x8*)(Kf + it * 8) = pack8((f32x4){v[0], v[1], v[2], v[3]}, (f32x4){v[4], v[5], v[6], v[7]}); }
        if (t2 == 0) *(float*)(rec + PREP_CD) = __expf(gl);
    }
    LDS_BARRIER();
    {
        const int fr = lane & 15, g = lane >> 4;
#pragma unroll 1
        for (int bb = 0; bb < 4; ++bb) {
            const int i0 = 16 * bb;
            bf16x8 Af[2];
#pragma unroll
            for (int ks = 0; ks < 2; ++ks) { float av[8];
#pragma unroll
                for (int j = 0; j < 8; ++j) { const int kr = 32 * ks + 8 * g + j; av[j] = kr < i0 ? -AT[kr * GAT_P + i0 + fr] : 0.f; }
                Af[ks] = pack8((f32x4){av[0], av[1], av[2], av[3]}, (f32x4){av[4], av[5], av[6], av[7]}); }
            const f32x4 dv4 = *(const LAS f32x4*)(Dm + bb * 256 + fr * 16 + 4 * g);
            const bf16x8 Df = pack8(dv4, (f32x4){0.f, 0.f, 0.f, 0.f});
#pragma unroll
            for (int nt = 0; nt < 2; ++nt) { const int col = 32 * wave + 16 * nt + fr; LAS float* X = (col < 128 ? Vs + col : Ws + (col - 128));
                f32x4 acc;
#pragma unroll
                for (int rg = 0; rg < 4; ++rg) acc[rg] = X[(i0 + 4 * g + rg) * GP];
                if (bb > 0) {
#pragma unroll
                    for (int ks = 0; ks < 2; ++ks) { if (32 * ks < i0) { float xv[8];
#pragma unroll
                        for (int j = 0; j < 8; ++j) xv[j] = X[(32 * ks + 8 * g + j) * GP];
                        acc = __builtin_amdgcn_mfma_f32_16x16x32_bf16(Af[ks], pack8((f32x4){xv[0], xv[1], xv[2], xv[3]}, (f32x4){xv[4], xv[5], xv[6], xv[7]}), acc, 0, 0, 0); } } }
                const f32x4 xb = __builtin_amdgcn_mfma_f32_16x16x32_bf16(Df, pack8(acc, (f32x4){0.f, 0.f, 0.f, 0.f}), (f32x4){0.f, 0.f, 0.f, 0.f}, 0, 0, 0);
#pragma unroll
                for (int rg = 0; rg < 4; ++rg) X[(i0 + 4 * g + rg) * GP] = xb[rg]; }
        }
    }
    LDS_BARRIER();
    { float* Up = (float*)(rec + PREP_UP); bf16* Wf = (bf16*)(rec + PREP_WP);
        for (int it = tid; it < 2048; it += NTHREADS) { const int dv = it & 127, g = (it >> 7) & 3, mi = it >> 9; const int c0 = 16 * mi + 4 * g;
            *(f32x4*)(Up + (size_t)it * 4) = (f32x4){Vs[c0 * GP + dv], Vs[(c0 + 1) * GP + dv], Vs[(c0 + 2) * GP + dv], Vs[(c0 + 3) * GP + dv]}; }
        for (int it = tid; it < 1024; it += NTHREADS) { const int blk = it >> 6, l = it & 63, mi = blk >> 2, ks = blk & 3, g = l >> 4, c = 16 * mi + (l & 15);
            *(bf16x8*)(Wf + it * 8) = pack8(*(LAS f32x4*)(Ws + c * GP + 32 * ks + 4 * g), *(LAS f32x4*)(Ws + c * GP + 32 * ks + 16 + 4 * g)); }
    }
    asm volatile("" :: "v"(pfx));
    LDS_BARRIER();
}

constexpr int SC_BUFSZ = 57344, SC_OT = 2 * SC_BUFSZ, SC_OTSZ = 64 * 128 * 2, SC_END = SC_OT + 2 * SC_OTSZ;
static_assert(SC_END <= TOP_OFF, "scan LDS");
__device__ __forceinline__ void gdn_scan(Frame& F, const Args& a, int bh) {
    const int tid = F.tid, lane = F.lane, w = F.wave, fr = lane & 15, g = lane >> 4; const int b = bh >> 2, h = bh & 3;
    const unsigned char* rec0 = F.ws + WS_PREP + (size_t)bh * NCHUNK * PREP_REC;
    const float* gnw = a.in[6]; const bf16* zg = (const bf16*)(F.ws + WS_ZG); bf16* mix = (bf16*)(F.ws + WS_MIX);
    const size_t rowb = (size_t)b * SEQ; const unsigned lds0 = (unsigned)(uintptr_t)F.lds;
    if (w >= 4) {
        const int hw = w - 4, l16 = lane & 15, rq = lane >> 4;
#define SC_DMA(n_, buf_) do { const unsigned char* src_ = rec0 + (size_t)(n_) * PREP_REC + hw * 14336 + lane * 16; _Pragma("unroll") for (int r_ = 0; r_ < 14; ++r_) \
        glds16_asm(src_ + r_ * 1024, (unsigned)__builtin_amdgcn_readfirstlane((int)(lds0 + (buf_) * SC_BUFSZ + hw * 14336 + r_ * 1024))); } while (0)
#define SC_NORM(n_, gv) do { const LAS unsigned char* ot = F.lds + SC_OT + ((n_) & 1) * SC_OTSZ; _Pragma("unroll") for (int q_ = 0; q_ < 4; ++q_) { const int t = 16 * hw + 4 * q_ + rq; \
            const u32x4 ov = *(const LAS u32x4*)(ot + t * 256 + l16 * 16); const f32x4 xa = {bflo(ov.x), bfhi(ov.x), bflo(ov.y), bfhi(ov.y)}, xb = {bflo(ov.z), bfhi(ov.z), bflo(ov.w), bfhi(ov.w)}; \
            float ss_ = (xa[0] * xa[0] + xa[1] * xa[1]) + (xa[2] * xa[2] + xa[3] * xa[3]) + (xb[0] * xb[0] + xb[1] * xb[1]) + (xb[2] * xb[2] + xb[3] * xb[3]); \
            ss_ = sum_row16(ss_); const float sc = rsqrtf(ss_ * (1.f / 128.f) + EPS); \
            const u32x4 gz = gv[q_]; const f32x4 ga = {bflo(gz.x), bfhi(gz.x), bflo(gz.y), bfhi(gz.y)}, gb = {bflo(gz.z), bfhi(gz.z), bflo(gz.w), bfhi(gz.w)}; \
            *(bf16x8*)(mix + (rowb + (n_) * CHUNK + t) * 1024 + h * 128 + 8 * l16) = pack8(xa * sc * ga, xb * sc * gb); } } while (0)
        u32x4 gc_[4], gn_[4];
        SC_DMA(0, 0);
#pragma unroll
        for (int q = 0; q < 4; ++q) gc_[q] = (u32x4){0u, 0u, 0u, 0u};
        VM_WAIT(); __syncthreads();
#pragma unroll 1
        for (int n = 0; n < NCHUNK; ++n) {
#pragma unroll
            for (int q = 0; q < 4; ++q) gn_[q] = *(const u32x4*)(zg + (rowb + n * CHUNK + 16 * hw + 4 * q + rq) * 2048 + 1536 + h * 128 + 8 * l16);
            if (n + 1 < NCHUNK) SC_DMA(n + 1, (n + 1) & 1);
            if (n > 0) SC_NORM(n - 1, gc_);
            VM_WAIT(); __syncthreads();
#pragma unroll
            for (int q = 0; q < 4; ++q) gc_[q] = gn_[q];
        }
        SC_NORM(NCHUNK - 1, gc_);
#undef SC_DMA
#undef SC_NORM
    } else {
        f32x4 S[2][8];
#pragma unroll
        for (int sl = 0; sl < 2; ++sl)
#pragma unroll
            for (int i = 0; i < 8; ++i) S[sl][i] = (f32x4){0.f, 0.f, 0.f, 0.f};
        f32x4 Un[2][4]; float cd = *(const float*)(rec0 + PREP_CD), cdn;
#pragma unroll
        for (int sl = 0; sl < 2; ++sl)
#pragma unroll
            for (int mi = 0; mi < 4; ++mi) Un[sl][mi] = *(const f32x4*)((const float*)(rec0 + PREP_UP) + (size_t)((mi * 4 + g) * 128 + 32 * w + 16 * sl + fr) * 4);
        __syncthreads();
#pragma unroll 1
        for (int n = 0; n < NCHUNK; ++n) {
            const LAS unsigned char* B = F.lds + (n & 1) * SC_BUFSZ + lane * 16;
            f32x4 vn[2][4], o[2][4];
            { bf16x8 Sb[2][4];
#pragma unroll
                for (int sl = 0; sl < 2; ++sl)
#pragma unroll
                    for (int ks = 0; ks < 4; ++ks) Sb[sl][ks] = pack8(S[sl][2 * ks], S[sl][2 * ks + 1]);
#pragma unroll
                for (int mi = 0; mi < 4; ++mi) { f32x4 t1[2], oo[2];
#pragma unroll
                    for (int sl = 0; sl < 2; ++sl) { t1[sl] = (f32x4){0.f, 0.f, 0.f, 0.f}; oo[sl] = (f32x4){0.f, 0.f, 0.f, 0.f}; }
#pragma unroll
                    for (int ks = 0; ks < 4; ++ks) { const bf16x8 wf = *(const LAS bf16x8*)(B + PREP_WP + (mi * 4 + ks) * 1024), qf = *(const LAS bf16x8*)(B + PREP_QP + (mi * 4 + ks) * 1024);
#pragma unroll
                        for (int sl = 0; sl < 2; ++sl) { t1[sl] = __builtin_amdgcn_mfma_f32_16x16x32_bf16(wf, Sb[sl][ks], t1[sl], 0, 0, 0); oo[sl] = __builtin_amdgcn_mfma_f32_16x16x32_bf16(qf, Sb[sl][ks], oo[sl], 0, 0, 0); } }
#pragma unroll
                    for (int sl = 0; sl < 2; ++sl) { vn[sl][mi] = Un[sl][mi] - t1[sl]; o[sl][mi] = oo[sl]; } } }
            { const int nn = n + 1 < NCHUNK ? n + 1 : n; cdn = *(const float*)(rec0 + (size_t)nn * PREP_REC + PREP_CD);
#pragma unroll
                for (int sl = 0; sl < 2; ++sl)
#pragma unroll
                    for (int mi = 0; mi < 4; ++mi) Un[sl][mi] = *(const f32x4*)((const float*)(rec0 + (size_t)nn * PREP_REC + PREP_UP) + (size_t)((mi * 4 + g) * 128 + 32 * w + 16 * sl + fr) * 4); }
            bf16x8 Vb[2][2];
#pragma unroll
            for (int sl = 0; sl < 2; ++sl)
#pragma unroll
                for (int ks = 0; ks < 2; ++ks) Vb[sl][ks] = pack8(vn[sl][2 * ks], vn[sl][2 * ks + 1]);
#pragma unroll
            for (int mi = 0; mi < 4; ++mi) {
#pragma unroll
                for (int ks = 0; ks < 2; ++ks) { const bf16x8 af = *(const LAS bf16x8*)(B + PREP_AP + (mi * 2 + ks) * 1024);
#pragma unroll
                    for (int sl = 0; sl < 2; ++sl) o[sl][mi] = __builtin_amdgcn_mfma_f32_16x16x32_bf16(af, Vb[sl][ks], o[sl][mi], 0, 0, 0); }
#pragma unroll
                for (int sl = 0; sl < 2; ++sl) { LAS bf16* otw = (LAS bf16*)(F.lds + SC_OT + (n & 1) * SC_OTSZ) + 32 * w + 16 * sl + fr;
                    const unsigned p01 = pk2(o[sl][mi][0], o[sl][mi][1]), p23 = pk2(o[sl][mi][2], o[sl][mi][3]);
                    otw[(16 * mi + 4 * g) * 128] = (bf16)(p01 & 0xffffu); otw[(16 * mi + 4 * g + 1) * 128] = (bf16)(p01 >> 16); otw[(16 * mi + 4 * g + 2) * 128] = (bf16)(p23 & 0xffffu); otw[(16 * mi + 4 * g + 3) * 128] = (bf16)(p23 >> 16); } }
#pragma unroll
            for (int ti = 0; ti < 8; ++ti) { f32x4 s0 = S[0][ti] * cd, s1 = S[1][ti] * cd;
#pragma unroll
                for (int ks = 0; ks < 2; ++ks) { const bf16x8 kf = *(const LAS bf16x8*)(B + PREP_KT + (ti * 2 + ks) * 1024);
                    s0 = __builtin_amdgcn_mfma_f32_16x16x32_bf16(kf, Vb[0][ks], s0, 0, 0, 0); s1 = __builtin_amdgcn_mfma_f32_16x16x32_bf16(kf, Vb[1][ks], s1, 0, 0, 0); }
                S[0][ti] = s0; S[1][ti] = s1; }
            __syncthreads();
            cd = cdn;
        }
    }
    __syncthreads();
}

constexpr int AT_K = 0, AT_V = 49152, AT_BIAS = 98304, AT_LW = 98304 + 1024, AT_END = AT_LW + 1024;
constexpr size_t WS_P4 = 616 * MiB, WS_P16 = 648 * MiB, WS_L4 = 744 * MiB, WS_L16 = 745 * MiB;
static_assert(WS_P16 + (size_t)T * 512 * 2 <= WS_MIX && WS_L16 + (size_t)T * 8 * 4 <= WS_XN, "attention partial buffers");
__device__ __forceinline__ void attn_unit(Frame& F, const Args& a, int u) {
    int kind, b, h, r, q0;
    if (u < 1024) { kind = 2; b = u >> 7; h = (u >> 4) & 7; r = u & 15; q0 = 0; }
    else if (u < 2048) { const int v = u - 1024; kind = 1; b = v >> 7; h = (v >> 4) & 7; r = (v >> 2) & 3; q0 = (v & 3) * 256; }
    else { const int v = u - 2048; kind = 0; b = v >> 7; h = (v >> 4) & 7; r = 0; q0 = (v & 15) * 256; }
    const int dsh = 2 * kind, lmax = (SEQ >> dsh) - 1;
    const bf16* qb = (const bf16*)(F.ws + WS_QB); const bf16* kb = (const bf16*)(F.ws + WS_KB); const bf16* vb = (const bf16*)(F.ws + WS_VB); bf16* mix = (bf16*)(F.ws + WS_MIX);
    const float* relb = a.in[9];
    LAS float* biasL = (LAS float*)(F.lds + AT_BIAS); LAS float* lw = (LAS float*)(F.lds + AT_LW) + F.wave * 32;
    const int tid = F.tid, lane = F.lane, w = F.wave, c = lane & 31, hh = lane >> 5;
    const size_t hrow = (size_t)(b * AH + h) * SEQ; const unsigned lds0 = (unsigned)(uintptr_t)F.lds;
    { const int ro = lane >> 3, p = lane & 7;
#pragma unroll
        for (int i = 0; i < 6; ++i) { const int lr = 48 * w + 8 * i + ro; int pos = q0 - 128 + lr; pos = pos < 0 ? 0 : (pos > lmax ? lmax : pos);
            const size_t eo = (hrow + (size_t)(pos << dsh) + r) * 64 + (size_t)((p ^ (lr & 7)) * 8);
            glds16_asm(kb + eo, (unsigned)__builtin_amdgcn_readfirstlane((int)(lds0 + AT_K + (48 * w + 8 * i) * 128)));
            glds16_asm(vb + eo, (unsigned)__builtin_amdgcn_readfirstlane((int)(lds0 + AT_V + (48 * w + 8 * i) * 128))); } }
    if (tid < 132) biasL[tid] = relb[(int)T5B[kind][tid] * AH + h] * LOG2E;
    const int qi = q0 + 32 * w + c;
    bf16x8 Qf[4];
    { const bf16* qp = qb + (hrow + (size_t)(qi << dsh) + r) * 64 + 8 * hh;
#pragma unroll
        for (int ks = 0; ks < 4; ++ks) Qf[ks] = *(const bf16x8*)(qp + 16 * ks); }
    VM_WAIT(); __syncthreads();
    f32x16 O0 = {}, O1 = {}; float lsum = 0.f;
    const int kt0 = (128 - q0 - 32 * w) > 0 ? ((128 - q0 - 32 * w) >> 5) : 0;
    const int li = lane & 15, gq = lane >> 4;
#pragma unroll 1
    for (int kt = kt0; kt < 5; ++kt) {
        const int lr0 = 32 * (w + kt);
        f32x16 sT = {};
        { const int lr = lr0 + c; const LAS unsigned char* kp = F.lds + AT_K + lr * 128;
#pragma unroll
            for (int ks = 0; ks < 4; ++ks) { const bf16x8 kf = *(const LAS bf16x8*)(kp + (((2 * ks + hh) ^ (lr & 7)) * 16)); sT = __builtin_amdgcn_mfma_f32_32x32x16_bf16(kf, Qf[ks], sT, 0, 0, 0); } }
        float p[16];
#pragma unroll
        for (int reg = 0; reg < 16; ++reg) { const int kr = (reg & 3) + 8 * (reg >> 2) + 4 * hh; const int s = 128 + c - 32 * kt - kr; const int kpos = q0 - 128 + lr0 + kr;
            const bool ok = (s >= 0) && (s <= 128) && (kpos >= 0); const int sc_ = s < 0 ? 0 : (s > 128 ? 128 : s);
            const float e = __builtin_amdgcn_exp2f(sT[reg] + biasL[sc_]); p[reg] = ok ? e : 0.f; lsum += p[reg]; }
        bf16x8 Pf[2];
#pragma unroll
        for (int s2 = 0; s2 < 2; ++s2) { u32x4 wv; wv.x = pk2(p[8 * s2], p[8 * s2 + 1]); wv.y = pk2(p[8 * s2 + 2], p[8 * s2 + 3]); wv.z = pk2(p[8 * s2 + 4], p[8 * s2 + 5]); wv.w = pk2(p[8 * s2 + 6], p[8 * s2 + 7]); Pf[s2] = __builtin_bit_cast(bf16x8, wv); }
#pragma unroll
        for (int s2 = 0; s2 < 2; ++s2)
#pragma unroll
            for (int ntl = 0; ntl < 2; ++ntl) {
                const int rowl = lr0 + 16 * s2 + 4 * hh + (li >> 2), rowh = rowl + 8; const int ch = 4 * ntl + 2 * (gq & 1) + ((li & 3) >> 1), sub = (li & 1) * 8;
                const s16x4 lo = __builtin_bit_cast(s16x4, __builtin_amdgcn_ds_read_tr16_b64_v4i16((LAS s16x4*)(F.lds + AT_V + rowl * 128 + ((ch ^ (rowl & 7)) * 16) + sub)));
                const s16x4 hi = __builtin_bit_cast(s16x4, __builtin_amdgcn_ds_read_tr16_b64_v4i16((LAS s16x4*)(F.lds + AT_V + rowh * 128 + ((ch ^ (rowh & 7)) * 16) + sub)));
                const bf16x8 vf = (bf16x8){lo[0], lo[1], lo[2], lo[3], hi[0], hi[1], hi[2], hi[3]};
                if (ntl == 0) O0 = __builtin_amdgcn_mfma_f32_32x32x16_bf16(Pf[s2], vf, O0, 0, 0, 0); else O1 = __builtin_amdgcn_mfma_f32_32x32x16_bf16(Pf[s2], vf, O1, 0, 0, 0);
            }
    }
    lsum = sum_xor32(lsum);
    if (hh == 0) lw[c] = lsum;
    LDS_BARRIER();
    { LAS float* ost = (LAS float*)(F.lds + w * 8192);
#pragma unroll
        for (int reg = 0; reg < 16; ++reg) { const int qrow = (reg & 3) + 8 * (reg >> 2) + 4 * hh; ost[qrow * 64 + c] = O0[reg]; ost[qrow * 64 + 32 + c] = O1[reg]; }
        LDS_WAIT();
        const int row = lane >> 1, half = lane & 1; const float l1 = lw[row]; const LAS f32x4* op = (const LAS f32x4*)(ost + row * 64 + 32 * half);
        const size_t tok = (size_t)b * SEQ + (size_t)((q0 + 32 * w + row) << dsh) + r;
        if (kind != 0) {
            bf16* pp = (bf16*)(F.ws + (kind == 1 ? WS_P4 : WS_P16)) + (tok * 8 + h) * 64 + 32 * half; const float inv = 1.f / l1;
#pragma unroll
            for (int q = 0; q < 4; ++q) *(bf16x8*)(pp + 8 * q) = pack8(op[2 * q] * inv, op[2 * q + 1] * inv);
            if (half == 0) ((float*)(F.ws + (kind == 1 ? WS_L4 : WS_L16)))[tok * 8 + h] = l1;
        } else {
            const bf16* p4 = (const bf16*)(F.ws + WS_P4) + (tok * 8 + h) * 64 + 32 * half; const bf16* p16 = (const bf16*)(F.ws + WS_P16) + (tok * 8 + h) * 64 + 32 * half;
            const float l4 = ((const float*)(F.ws + WS_L4))[tok * 8 + h], l16 = ((const float*)(F.ws + WS_L16))[tok * 8 + h]; const float inv = 1.f / (l1 + l4 + l16);
            bf16* dst = mix + tok * 1024 + 512 + h * 64 + 32 * half;
#pragma unroll
            for (int q = 0; q < 4; ++q) { const u32x4 a4 = *(const u32x4*)(p4 + 8 * q), a16 = *(const u32x4*)(p16 + 8 * q);
                const f32x4 x0 = (op[2 * q] + (f32x4){bflo(a4.x), bfhi(a4.x), bflo(a4.y), bfhi(a4.y)} * l4 + (f32x4){bflo(a16.x), bfhi(a16.x), bflo(a16.y), bfhi(a16.y)} * l16) * inv;
                const f32x4 x1 = (op[2 * q + 1] + (f32x4){bflo(a4.z), bfhi(a4.z), bflo(a4.w), bfhi(a4.w)} * l4 + (f32x4){bflo(a16.z), bfhi(a16.z), bflo(a16.w), bfhi(a16.w)} * l16) * inv;
                *(bf16x8*)(dst + 8 * q) = pack8(x0, x1); }
        }
    }
    LDS_BARRIER();
}

constexpr int RT_LCNT = 0, RT_BASE = 256, RT_RANK = 512;
__device__ __forceinline__ void route_phase(Frame& F, const Args& a) {
    const float* hsrc = a.out; const float* wrT = (const float*)(F.ws + WS_WRT); const float* b_r = a.in[13];
    int* te = (int*)(F.ws + WS_TE); int* tslot = (int*)(F.ws + WS_TSLOT); float* tg = (float*)(F.ws + WS_TG); int* list = (int*)(F.ws + WS_LIST); float* lrs = (float*)(F.ws + WS_LRS);
    LAS int* lcnt = (LAS int*)(F.lds + RT_LCNT); LAS int* lbase = (LAS int*)(F.lds + RT_BASE); LAS int* lrank = (LAS int*)(F.lds + RT_RANK);
    const int lane = F.lane, c = lane & 31, hh = lane >> 5;
    for (int blk = F.vcu; blk < T / 128; blk += F.G) {
        if (F.tid < 32) lcnt[F.tid] = 0;
        __syncthreads();
        int e4[4] = {0, 0, 0, 0}, rk[4] = {0, 0, 0, 0}; float g4[4] = {0.f, 0.f, 0.f, 0.f}; float rs = 0.f; const int tok = blk * 128 + (F.wave & 3) * 32 + c;
        f32x16 acc = {}; float ss = 0.f;
        { const int kh = F.wave >> 2; const float* hp = hsrc + (size_t)tok * D + 4 * hh + 512 * kh; const float* wp = wrT + (size_t)c * D + 4 * hh + 512 * kh;
#pragma unroll 8
            for (int q = 0; q < 64; ++q) { const f32x4 hv = *(const f32x4*)(hp + 8 * q), wv = *(const f32x4*)(wp + 8 * q);
                ss += (hv[0] * hv[0] + hv[1] * hv[1]) + (hv[2] * hv[2] + hv[3] * hv[3]);
#pragma unroll
                for (int i = 0; i < 4; ++i) acc = __builtin_amdgcn_mfma_f32_32x32x2f32(wv[i], hv[i], acc, 0, 0, 0); }
            LAS float* px = (LAS float*)(F.lds + 4096) + ((F.wave & 3) * 64 + lane) * 17;
            if (F.wave >= 4) {
#pragma unroll
                for (int r = 0; r < 16; ++r) px[r] = acc[r];
                px[16] = ss; }
            __syncthreads();
            if (F.wave < 4) {
#pragma unroll
                for (int r = 0; r < 16; ++r) acc[r] += px[r];
                ss += px[16]; } }
        if (F.wave < 4) {
            ss = sum_xor32(ss); rs = rsqrtf(ss * (1.f / D) + EPS);
            float tv[4] = {-3.0e38f, -3.0e38f, -3.0e38f, -3.0e38f}; int tix[4] = {0, 1, 2, 3};
            f32x4 brv[4];
#pragma unroll
            for (int q = 0; q < 4; ++q) brv[q] = *(const f32x4*)(b_r + 8 * q + 4 * hh);
#pragma unroll
            for (int reg = 0; reg < 16; ++reg) { const int e = (reg & 3) + 8 * (reg >> 2) + 4 * hh; float v = acc[reg] * rs + brv[reg >> 2][reg & 3]; int ix = e;
#pragma unroll
                for (int s = 0; s < 4; ++s) { const bool gt = (v > tv[s]) || (v == tv[s] && ix < tix[s]); const float ov = tv[s]; const int oi = tix[s]; tv[s] = gt ? v : ov; tix[s] = gt ? ix : oi; v = gt ? ov : v; ix = gt ? oi : ix; } }
            float pv[4]; int pi[4];
#pragma unroll
            for (int s = 0; s < 4; ++s) { pv[s] = __shfl_xor(tv[s], 32); pi[s] = __shfl_xor(tix[s], 32); }
#pragma unroll
            for (int t2 = 0; t2 < 4; ++t2) { float v = pv[t2]; int ix = pi[t2];
#pragma unroll
                for (int s = 0; s < 4; ++s) { const bool gt = (v > tv[s]) || (v == tv[s] && ix < tix[s]); const float ov = tv[s]; const int oi = tix[s]; tv[s] = gt ? v : ov; tix[s] = gt ? ix : oi; v = gt ? ov : v; ix = gt ? oi : ix; } }
            const float e0 = 1.f, e1 = __expf(tv[1] - tv[0]), e2 = __expf(tv[2] - tv[0]), e3 = __expf(tv[3] - tv[0]); const float inv = 1.f / (e0 + e1 + e2 + e3);
            g4[0] = e0 * inv; g4[1] = e1 * inv; g4[2] = e2 * inv; g4[3] = e3 * inv;
#pragma unroll
            for (int s = 0; s < 4; ++s) e4[s] = tix[s];
            if (hh == 0) {
#pragma unroll
                for (int s = 0; s < 4; ++s) rk[s] = atomicAdd((int*)(lcnt + e4[s]), 1);
            }
        }
        __syncthreads();
        if (F.tid < 32) lbase[F.tid] = (int)__hip_atomic_fetch_add(F.ctl + CW_GCNT + 64 * F.tid, (unsigned)lcnt[F.tid], RLX_AGENT);
        __syncthreads();
        if (F.wave < 4 && hh == 0) {
#pragma unroll
            for (int s = 0; s < 4; ++s) { const int slot = lbase[e4[s]] + rk[s]; te[tok * 4 + s] = e4[s]; tslot[tok * 4 + s] = slot; tg[tok * 4 + s] = g4[s];
                list[(size_t)e4[s] * LCAP + slot] = tok; lrs[(size_t)e4[s] * LCAP + slot] = rs; }
        }
        __syncthreads();
    }
}
__device__ __forceinline__ int moe_tables(Frame& F) {
    LAS int* tstart = (LAS int*)(F.lds + MOE_TSTART); LAS int* lcnt = (LAS int*)(F.lds + MOE_LCNT); LAS int* texp = (LAS int*)(F.lds + MOE_TEXP);
    if (F.tid < 64) {
        const int lane = F.lane; const int cnt = lane < NE ? (int)__hip_atomic_load(F.ctl + CW_GCNT + 64 * (lane & 31), RLX_AGENT) : 0; const int nt = (cnt + 255) >> 8;
        int inc = nt;
#pragma unroll
        for (int o = 1; o < 32; o <<= 1) { const int up = __shfl_up(inc, o); if (lane >= o) inc += up; }
        if (lane < NE) { const int start = inc - nt; lcnt[lane] = cnt; tstart[lane] = start; for (int i = 0; i < nt; ++i) texp[start + i] = lane; if (lane == NE - 1) tstart[NE] = inc; }
    }
    __syncthreads();
    return tstart[NE];
}
__device__ __forceinline__ void combine_phase(Frame& F, const Args& a, float* dst) {
    LAS int* tstart = (LAS int*)(F.lds + MOE_TSTART);
    const int* te = (const int*)(F.ws + WS_TE); const int* tslot = (const int*)(F.ws + WS_TSLOT); const float* tg = (const float*)(F.ws + WS_TG); const unsigned char* Y = F.ws + WS_Y;
    const float* out = a.out; const int gw = F.vcu * NWAVES + F.wave, NGW = F.G * NWAVES, lane = F.lane;
    for (int t0 = gw * 16; t0 < T; t0 += NGW * 16) {
        int pos[4]; float gt[4];
        { const int tl = t0 + (lane & 15);
#pragma unroll
            for (int s = 0; s < 4; ++s) { const int e = te[tl * 4 + s]; pos[s] = tstart[e] * 256 + tslot[tl * 4 + s]; gt[s] = tg[tl * 4 + s]; } }
#pragma unroll 1
        for (int i = 0; i < 16; i += 2) {
            f32x4 o[2][4]; u32x4 w[2][4];
#pragma unroll
            for (int q = 0; q < 2; ++q) { const float* op = out + (size_t)(t0 + i + q) * D + 16 * lane;
#pragma unroll
                for (int j = 0; j < 4; ++j) o[q][j] = *(const f32x4*)(op + 4 * j);
#pragma unroll
                for (int s = 0; s < 4; ++s) { const size_t p = (size_t)__builtin_amdgcn_readlane(pos[s], i + q); w[q][s] = *(const u32x4*)(Y + p * D + 16 * lane); } }
#pragma unroll
            for (int q = 0; q < 2; ++q) { float* op = dst + (size_t)(t0 + i + q) * D + 16 * lane;
#pragma unroll
                for (int s = 0; s < 4; ++s) { const float g = __builtin_bit_cast(float, __builtin_amdgcn_readlane(__builtin_bit_cast(int, gt[s]), i + q));
#pragma unroll
                    for (int j = 0; j < 4; ++j) { const int ww = (int)w[q][s][j]; const f32x2 lo = __builtin_amdgcn_cvt_pk_f32_fp8(ww, false), hi = __builtin_amdgcn_cvt_pk_f32_fp8(ww, true);
                        o[q][j] += (f32x4){lo[0], lo[1], hi[0], hi[1]} * g; } }
#pragma unroll
                for (int j = 0; j < 4; ++j) *(f32x4*)(op + 4 * j) = o[q][j]; }
        }
    }
}

constexpr int NPHASE = 9;
__global__ void __launch_bounds__(NTHREADS, 2) hymba_fwd(Args args) {
    extern __shared__ __attribute__((aligned(16))) unsigned char lds_raw[];
    Frame F; F.lds = (LAS unsigned char*)lds_raw; F.ws = args.ws; F.ctl = (unsigned*)(args.ws + WS_CTL);
    F.tid = threadIdx.x; F.lane = F.tid & 63; F.wave = __builtin_amdgcn_readfirstlane(F.tid >> 6);
    F.G = gridDim.x; { const int bx = blockIdx.x; F.vcu = (F.G % 8 == 0) ? (bx % 8) * (F.G / 8) + bx / 8 : bx; }
    volatile LAS unsigned* MISC = (volatile LAS unsigned*)(F.lds + MISC_OFF);
    if (F.tid < 32) MISC[F.tid] = 0u;
    __syncthreads();
    XcdBarrier bar; bar.bar = F.ctl + CW_BAR; bar.x = 0; bar.st = nullptr;
    if (MK_N_LAUNCHES == 1) bar = xcd_barrier_post(F.ctl + CW_BAR, MISC + 8);
    const int lo = args.ph_lo, hi = args.ph_hi;
#define IN(k) (lo <= (k) && (k) < hi)
#define SEAM(k) do { if (IN(k) && IN((k) + 1)) xcd_barrier(bar); } while (0)

    if (IN(0)) { for (int rep = 0; rep < (DUP == 4 ? 2 : 1); ++rep) phase0(F, args); SEAM(0); }
    if (IN(1)) {
        pg8::Gemm g{(const bf16*)(F.ws + WS_XN), (const bf16*)(F.ws + WS_WIN), D}; pg8::StaticOrder S{T / 256, NIN / 256, F.G, (int)blockIdx.x};
        pg8::EpiInProj E{(bf16*)(F.ws + WS_ZG), (bf16*)(F.ws + WS_QB), (bf16*)(F.ws + WS_KB), (bf16*)(F.ws + WS_VB), args.in[7], args.in[8], F.lds + RING_BYTES, args.in[6]};
        pg8::gemm_phase<pg8::EpiInProj, pg8::StaticOrder, false, true>(F.lds, g, S, E);
        SEAM(1);
    }
    if (IN(2)) {
        for (int rep = 0; rep < (DUP == 1 ? 2 : 1); ++rep)
        for (int u = F.vcu; u < NBATCH * GH * NCHUNK; u += F.G) gdn_prep_unit(F, args, u, u + F.G < NBATCH * GH * NCHUNK ? u + F.G : -1);
        SEAM(2);
    }
    if (IN(3)) {
        const int nscan = NBATCH * GH;
        for (int rep3 = 0; rep3 < (DUP == 13 ? 2 : 1); ++rep3) {
        for (int bh = blockIdx.x; bh < nscan; bh += F.G) for (int rep = 0; rep < (DUP == 3 ? 2 : 1); ++rep) gdn_scan(F, args, bh);
        if (rep3 == 0) { if (F.G > nscan) { if ((int)blockIdx.x >= nscan) p0_experts(F, args, ((int)blockIdx.x - nscan) * NWAVES + F.wave, (F.G - nscan) * NWAVES); } else p0_experts(F, args, (int)blockIdx.x * NWAVES + F.wave, F.G * NWAVES); __syncthreads(); }
        for (int pass = 0; pass < 2; ++pass) {
            for (int rep = 0; rep < (DUP == 2 ? 2 : 1); ++rep)
            for (;;) {
                if (F.tid == 0) MISC[16] = __hip_atomic_fetch_add(F.ctl + CW_ATTQ + 64 * (pass + 2 * rep + 4 * rep3), 1u, RLX_AGENT);
                __syncthreads();
                const int u = (int)MISC[16] + (pass ? 2048 : 0);
                __syncthreads();
                if (u >= (pass ? 3072 : 2048)) break;
                attn_unit(F, args, u);
            }
            if (pass == 0 || DUP == 13) xcd_barrier(bar);
        } }
        SEAM(3);
    }
    if (IN(4)) {
        pg8::Gemm g{(const bf16*)(F.ws + WS_MIX), (const bf16*)(F.ws + WS_WOUT), D}; pg8::StaticOrder S{T / 256, D / 256, F.G, (int)blockIdx.x};
        pg8::EpiOutProj E{args.in[0], args.out, F.ws + WS_HB};
        for (int rep = 0; rep < (DUP == 6 ? 2 : 1); ++rep) { pg8::gemm_phase<pg8::EpiOutProj, pg8::StaticOrder, false, true>(F.lds, g, S, E); __syncthreads(); }
        SEAM(4);
    }
#if !SKIP_MOE
    if (IN(5)) {
        if (DUP == 10) { route_phase(F, args); xcd_barrier(bar); if (blockIdx.x == 0 && F.tid < 32) __hip_atomic_store(F.ctl + CW_GCNT + 64 * F.tid, 0u, RLX_AGENT); xcd_barrier(bar); }
        route_phase(F, args); SEAM(5); }
    if (IN(6)) {
        const int nM = moe_tables(F);
        pg8::Gemm g{(const bf16*)(F.ws + WS_HB), (const bf16*)(F.ws + WS_WGU), D};
        pg8::MoeOrder S{nM, 8, F.G, (int)blockIdx.x, (const LAS int*)(F.lds + MOE_TSTART), (const LAS int*)(F.lds + MOE_LCNT), (const LAS int*)(F.lds + MOE_TEXP), (const int*)(F.ws + WS_LIST)};
        pg8::EpiGateUp E{F.ws + WS_ACT, args.in[15], (const float*)(F.ws + WS_LRS), (const LAS int*)(F.lds + MOE_LCNT)};
        for (int rep = 0; rep < (DUP == 7 ? 2 : 1); ++rep) { pg8::gemm_phase<pg8::EpiGateUp, pg8::MoeOrder, true, true, true>(F.lds, g, S, E); __syncthreads(); }
        SEAM(6);
    }
    if (IN(7)) {
        const int nM = moe_tables(F);
        pg8::Gemm g{(const bf16*)(F.ws + WS_ACT), (const bf16*)(F.ws + WS_WDN), FF};
        pg8::MoeOrder S{nM, 4, F.G, (int)blockIdx.x, (const LAS int*)(F.lds + MOE_TSTART), (const LAS int*)(F.lds + MOE_LCNT), (const LAS int*)(F.lds + MOE_TEXP), (const int*)(F.ws + WS_LIST)};
        pg8::EpiDown E{F.ws + WS_Y, args.in[17], F.lds + RING_BYTES};
        for (int rep = 0; rep < (DUP == 8 ? 2 : 1); ++rep) { pg8::gemm_phase<pg8::EpiDown, pg8::MoeOrder, false, true, true>(F.lds, g, S, E); __syncthreads(); }
        SEAM(7);
    }
    if (IN(8)) { (void)moe_tables(F); if (DUP == 11) combine_phase(F, args, (float*)(F.ws + WS_ZG)); combine_phase(F, args, args.out); }
#endif
#undef IN
#undef SEAM
}

extern "C" void kernel_launch(void* const* d_in, const int* in_sizes, int n_in, void* d_out, int out_size, void* d_ws, size_t ws_size, hipStream_t stream) {
    static int grid = 0;
    if (grid == 0) {
        if (n_in != 18 || in_sizes[0] != T * D || out_size != T * D || ws_size < WS_END) { fprintf(stderr, "kernel_launch: unexpected shapes (n_in %d, in0 %d, out %d, ws %zu)\n", n_in, n_in > 0 ? in_sizes[0] : -1, out_size, ws_size); grid = -1; return; }
        int dev = 0, cus = 0, per_cu = 0;
        if (hipGetDevice(&dev) != hipSuccess || hipDeviceGetAttribute(&cus, hipDeviceAttributeMultiprocessorCount, dev) != hipSuccess) { grid = -1; return; }
        if (hipFuncSetAttribute((const void*)hymba_fwd, hipFuncAttributeMaxDynamicSharedMemorySize, LDS_BYTES) != hipSuccess) { fprintf(stderr, "kernel_launch: hipFuncSetAttribute failed\n"); grid = -1; return; }
        if (hipOccupancyMaxActiveBlocksPerMultiprocessor(&per_cu, (const void*)hymba_fwd, NTHREADS, LDS_BYTES) != hipSuccess || per_cu < 1) { fprintf(stderr, "kernel_launch: occupancy query says %d\n", per_cu); per_cu = 1; }
        (void)hipGetLastError();
        grid = cus;
    }
    if (grid < 0) return;
    (void)hipMemsetAsync((char*)d_ws + WS_CTL, 0, CTL_ZERO_BYTES, stream);
    Args a{};
    for (int i = 0; i < 18; ++i) a.in[i] = (const float*)d_in[i];
    a.out = (float*)d_out; a.ws = (unsigned char*)d_ws;
    if (MK_N_LAUNCHES == 1) {
        a.ph_lo = 0; a.ph_hi = NPHASE; a.li = 0;
        void* kargs[] = {&a};
        hipError_t e = hipLaunchCooperativeKernel((const void*)hymba_fwd, dim3(grid), dim3(NTHREADS), kargs, LDS_BYTES, stream);
        if (e != hipSuccess) fprintf(stderr, "kernel_launch: cooperative launch failed: %s (grid %d)\n", hipGetErrorString(e), grid);
    } else {
        for (int p = 0; p < NPHASE; ++p) { a.ph_lo = p; a.ph_hi = p + 1; a.li = p; hipLaunchKernelGGL(hymba_fwd, dim3(grid), dim3(NTHREADS), LDS_BYTES, stream, a); }
    }
}
```

```cpp
#include <hip/hip_runtime.h>
#include <cstdio>
#include <cstdint>

#ifndef MK_N_LAUNCHES
#define MK_N_LAUNCHES 1
#endif
#ifndef SKIP_ATTN
#define SKIP_ATTN 0
#endif
#ifndef DUP
#define DUP 0
#endif
#ifndef ATT_JOBS
#define ATT_JOBS 32
#endif
#ifndef SKIP_MOE
#define SKIP_MOE 0
#endif

#define LAS __attribute__((address_space(3)))
#define GAS __attribute__((address_space(1)))
typedef unsigned short bf16;
typedef short bf16x8 __attribute__((ext_vector_type(8)));
typedef short s16x4 __attribute__((ext_vector_type(4)));
typedef float f32x2 __attribute__((ext_vector_type(2)));
typedef float f32x4 __attribute__((ext_vector_type(4)));
typedef float f32x16 __attribute__((ext_vector_type(16)));
typedef unsigned u32x2 __attribute__((ext_vector_type(2)));
typedef unsigned u32x4 __attribute__((ext_vector_type(4)));
typedef __bf16 bf16x2_t __attribute__((ext_vector_type(2)));
typedef int v4i_t __attribute__((ext_vector_type(4)));
typedef int v8i_t __attribute__((ext_vector_type(8)));

constexpr int NBATCH = 8, SEQ = 4096, D = 1024, T = NBATCH * SEQ;
constexpr int IN_DIM = 3592, NIN = 3584;
constexpr int GH = 4, DK = 128, CHUNK = 64, NCHUNK = SEQ / CHUNK;
constexpr int AH = 8, DH = 64;
constexpr int NE = 32, FF = 1024, LCAP = 32768;
constexpr float EPS = 1e-6f, LOG2E = 1.4426950408889634f;
constexpr int NWAVES = 8, NTHREADS = 512;

constexpr size_t MiB = 1u << 20;
constexpr size_t WS_CTL = 0, CTL_ZERO_BYTES = 1 * MiB;
constexpr size_t WS_WIN = 1 * MiB, WS_WOUT = 8 * MiB, WS_WGU = 10 * MiB, WS_WDN = 138 * MiB;
constexpr size_t WS_TE = 202 * MiB, WS_TSLOT = WS_TE + 512 * 1024, WS_TG = WS_TSLOT + 512 * 1024;
constexpr size_t WS_LIST = 204 * MiB, WS_LRS = 208 * MiB;
constexpr size_t WS_BA = 212 * MiB, WS_WRT = 213 * MiB;
constexpr size_t WS_ZG = 214 * MiB, WS_QB = 342 * MiB, WS_KB = 374 * MiB, WS_VB = 406 * MiB;
constexpr size_t WS_PREP = 438 * MiB;
constexpr int PREP_WP = 0, PREP_QP = 16384, PREP_AP = 32768, PREP_KT = 40960, PREP_UP = 57344, PREP_CD = 90112, PREP_REC = 90368;
constexpr size_t WS_OG = 616 * MiB, WS_MIX = 680 * MiB;
constexpr size_t WS_XN = 760 * MiB, WS_HB = 760 * MiB;
constexpr size_t WS_ACT = 214 * MiB, WS_Y = 352 * MiB, WS_HBF = 488 * MiB, WS_END = 824 * MiB;
static_assert(WS_VB - WS_KB == WS_KB - WS_QB, "q/k/v stride");
static_assert(WS_PREP + (size_t)NBATCH * GH * NCHUNK * PREP_REC <= WS_OG, "prep region");
static_assert(WS_ACT + (size_t)(T * 4 + NE * 256) * FF <= WS_Y && WS_Y + (size_t)(T * 4 + NE * 256) * D <= WS_HBF && WS_HBF + (size_t)T * D * 2 <= 616 * MiB, "act/y/h regions");
constexpr int CW_TMO = 0, CW_CODE = 1, CW_ATTQ = 512, CW_GCNT = 1024  , CW_BAR = 8192;

constexpr int LDS_BYTES = 160 * 1024;
constexpr int RING_BYTES = 131072;
constexpr int TOP_OFF = LDS_BYTES - 4096;
constexpr int MISC_OFF = TOP_OFF;
constexpr int MOE_TAB_OFF = TOP_OFF + 256;
constexpr int MOE_TSTART = MOE_TAB_OFF, MOE_LCNT = MOE_TAB_OFF + 256, MOE_TEXP = MOE_TAB_OFF + 512;

#define RLX_AGENT __ATOMIC_RELAXED, __HIP_MEMORY_SCOPE_AGENT
#define LDS_WAIT() asm volatile("s_waitcnt lgkmcnt(0)" ::: "memory")
#define VM_WAIT() asm volatile("s_waitcnt vmcnt(0)" ::: "memory")
#define LDS_BARRIER() do { asm volatile("s_waitcnt lgkmcnt(0)" ::: "memory"); __builtin_amdgcn_s_barrier(); asm volatile("" ::: "memory"); } while (0)
__device__ __forceinline__ unsigned pk2(float lo, float hi) { f32x2 v = {lo, hi}; bf16x2_t b = __builtin_convertvector(v, bf16x2_t); return __builtin_bit_cast(unsigned, b); }
__device__ __forceinline__ unsigned pk4_fp8(float a, float b, float c, float d) { int w = 0; w = __builtin_amdgcn_cvt_pk_fp8_f32(a, b, w, false); w = __builtin_amdgcn_cvt_pk_fp8_f32(c, d, w, true); return (unsigned)w; }
__device__ __forceinline__ float bf2f(unsigned short b) { return __uint_as_float((unsigned)b << 16); }
__device__ __forceinline__ float bflo(unsigned w) { return __uint_as_float(w << 16); }
__device__ __forceinline__ float bfhi(unsigned w) { return __uint_as_float(w & 0xffff0000u); }
template <int CTRL> __device__ __forceinline__ float dpp_mov(float v) { return __builtin_bit_cast(float, __builtin_amdgcn_update_dpp(0, __builtin_bit_cast(int, v), CTRL, 0xF, 0xF, true)); }
__device__ __forceinline__ float sum_row16(float v) {
    v += dpp_mov<0xB1>(v);
    v += dpp_mov<0x4E>(v);
    v += dpp_mov<0x141>(v);
    v += dpp_mov<0x140>(v);
    return v; }
__device__ __forceinline__ float sum_xor16(float v) { const unsigned u = __builtin_bit_cast(unsigned, v); auto r = __builtin_amdgcn_permlane16_swap(u, u, false, false); return __builtin_bit_cast(float, (unsigned)r[0]) + __builtin_bit_cast(float, (unsigned)r[1]); }
__device__ __forceinline__ float sum_xor32(float v) { const unsigned u = __builtin_bit_cast(unsigned, v); auto r = __builtin_amdgcn_permlane32_swap(u, u, false, false); return __builtin_bit_cast(float, (unsigned)r[0]) + __builtin_bit_cast(float, (unsigned)r[1]); }
__device__ __forceinline__ float wave_sum(float v) { return sum_xor32(sum_xor16(sum_row16(v))); }
__device__ __forceinline__ float silu_f(float x) { return x * __builtin_amdgcn_rcpf(1.f + __expf(-x)); }
__device__ __forceinline__ float sigmoid_f(float x) { return __builtin_amdgcn_rcpf(1.f + __expf(-x)); }
__device__ __forceinline__ bf16x8 pack8(f32x4 a, f32x4 b) {
    u32x4 w; w.x = pk2(a[0], a[1]); w.y = pk2(a[2], a[3]); w.z = pk2(b[0], b[1]); w.w = pk2(b[2], b[3]); return __builtin_bit_cast(bf16x8, w);
}

__device__ __forceinline__ void glds16_asm(const void* gsrc, unsigned lds_dst) { unsigned keep;
    asm volatile("s_mov_b32 %0, m0\n\ts_mov_b32 m0, %2\n\ts_nop 0\n\tglobal_load_lds_dwordx4 %1, off\n\ts_mov_b32 m0, %0" : "=&s"(keep) : "v"(gsrc), "s"(lds_dst) : "memory"); }

namespace pg8 {
constexpr int BM = 256, BK = 64, HALF = 128, HTB = HALF * BK * 2, STAGE_BYTES = 8 * HTB, NXCD = 8, WGM = 8;
__host__ __device__ __forceinline__ int lds_byte(int r, int c) { const int st = (r >> 4) * 2 + (c >> 5), rr = r & 15, cc = c & 31, ob = rr * 64 + cc * 2; return st * 1024 + (ob ^ (((ob >> 9) & 1) << 5)); }
__host__ __device__ __forceinline__ void stage_rc(int b, int& R, int& C) { const int st = b / 1024, sb = b % 1024, swz = sb ^ (((sb >> 9) & 1) << 5); R = (st >> 1) * 16 + swz / 64; C = (st & 1) * 32 + (swz % 64) / 2; }
__host__ __device__ __forceinline__ int perm32(int rho) { const int n = rho >> 4, i = rho & 15; return 8 * (i >> 2) + 4 * n + (i & 3); }

struct Unit { int pm, pn, pb, e, mt; };
struct Gemm { const bf16* A; const bf16* Bt; int K; };

__device__ __forceinline__ bool static_tile(int i, int G, int c, int nM, int nN, int& pm, int& pn) {
    const int nwg = nM * nN; const long L = (long)i * G + c; if (L >= nwg) return false;
    int wgid = (int)L; { const int q = nwg / NXCD, r = nwg % NXCD, xcd = wgid % NXCD, off = wgid / NXCD; wgid = (xcd < r ? xcd * (q + 1) : r * (q + 1) + (xcd - r) * q) + off; }
    const int nig = WGM * nN, gid = wgid / nig, fm = gid * WGM, gsz = (nM - fm) < WGM ? (nM - fm) : WGM;
    pm = fm + ((wgid % nig) % gsz); pn = (wgid % nig) / gsz; return true;
}
struct StaticOrder {
    int nM, nN, G, c;
    __device__ __forceinline__ bool next(int i, Unit& u) const { int pm, pn; if (!static_tile(i, G, c, nM, nN, pm, pn)) return false; u.pm = pm; u.pn = pn; u.pb = pn; u.e = 0; u.mt = 0; return true; }
    __device__ __forceinline__ int row_index(const Unit&, int) const { return 0; }
};
struct MoeOrder {
    int nM, nN, G, c; const LAS int* tstart; const LAS int* lcnt; const LAS int* texp; const int* list;
    __device__ __forceinline__ bool next(int i, Unit& u) const {
        int pm, pn; if (!static_tile(i, G, c, nM, nN, pm, pn)) return false;
        const int e = texp[pm]; u.pm = pm; u.pn = pn; u.e = e; u.pb = e * nN + pn; u.mt = pm - tstart[e]; return true;
    }
    __device__ __forceinline__ int row_index(const Unit& u, int r) const { const int rr = u.mt * 256 + r; const int v = list[u.e * LCAP + rr]; return rr < lcnt[u.e] ? v : 0; }
};

#define PG8_SA(b, h) (((b) * 2 + (h)) * HTB)
#define PG8_SB(b, h) ((4 + (b) * 2 + (h)) * HTB)
#define PG8_GLDS(src, dstoff) __builtin_amdgcn_global_load_lds((const unsigned*)(src), (LAS unsigned*)(lds + (dstoff)), 16, 0, 0)
#define PG8_STAGE_B(bufoff, nx, kb, h) do { _Pragma("unroll") for (int _i = 0; _i < 2; ++_i) \
        PG8_GLDS(((nx) ? nB : cB) + (kb) + (Epi::WIDE ? (size_t)voffBW[h][_i] : (size_t)(h) * hstep + voffB[_i]), (bufoff) + ldsw + _i * 8192); } while (0)
#define PG8_STAGE_A(bufoff, nx, kb, h) do { _Pragma("unroll") for (int _i = 0; _i < 2; ++_i) \
        PG8_GLDS(GATHER ? (const char*)g.A + (kb) + ((nx) ? voffN[h][_i] : voffC[h][_i]) : ((nx) ? nA : cA) + (kb) + (size_t)(h) * hstep + voffA[_i], (bufoff) + ldsw + _i * 8192); } while (0)
#define PG8_LDA8(dst, b, h) do { _Pragma("unroll") for (int m = 0; m < 4; ++m) { const v4i_t lo_ = *(const LAS v4i_t*)(lds + PG8_SA(b, h) + aoff + m * 2048), hi_ = *(const LAS v4i_t*)(lds + PG8_SA(b, h) + aoff + m * 2048 + 1024); dst[m] = __builtin_shufflevector(lo_, hi_, 0, 1, 2, 3, 4, 5, 6, 7); } } while (0)
#define PG8_LDB8(dst, b, h) do { _Pragma("unroll") for (int n = 0; n < 2; ++n) { const v4i_t lo_ = *(const LAS v4i_t*)(lds + PG8_SB(b, h) + boff + n * 2048), hi_ = *(const LAS v4i_t*)(lds + PG8_SB(b, h) + boff + n * 2048 + 1024); dst[n] = __builtin_shufflevector(lo_, hi_, 0, 1, 2, 3, 4, 5, 6, 7); } } while (0)
#define PG8_LDA(dst, b, h) do { _Pragma("unroll") for (int m = 0; m < 4; ++m) _Pragma("unroll") for (int k = 0; k < 2; ++k) dst[m][k] = *(const LAS bf16x8*)(lds + PG8_SA(b, h) + aoff + m * 2048 + k * 1024); } while (0)
#define PG8_LDB(dst, b, h) do { _Pragma("unroll") for (int n = 0; n < 2; ++n) _Pragma("unroll") for (int k = 0; k < 2; ++k) dst[n][k] = *(const LAS bf16x8*)(lds + PG8_SB(b, h) + boff + n * 2048 + k * 1024); } while (0)
#define PG8_MMA(ai, bj, At, Bt) do { __builtin_amdgcn_s_setprio(1); _Pragma("unroll") for (int m = 0; m < 4; ++m) _Pragma("unroll") for (int n = 0; n < 2; ++n) _Pragma("unroll") for (int k = 0; k < 2; ++k) \
        acc[ai][bj][m][n] = __builtin_amdgcn_mfma_f32_16x16x32_bf16(Bt[n][k], At[m][k], acc[ai][bj][m][n], 0, 0, 0); __builtin_amdgcn_s_setprio(0); } while (0)
#define PG8_MMA8(ai, bj, At, Bt) do { __builtin_amdgcn_s_setprio(1); _Pragma("unroll") for (int m = 0; m < 4; ++m) _Pragma("unroll") for (int n = 0; n < 2; ++n) \
        asm volatile("v_mfma_scale_f32_16x16x128_f8f6f4 %0, %1, %2, %0, %3, %4 op_sel_hi:[0,0,0]" : "+v"(acc[ai][bj][m][n]) : "v"(Bt[n]), "v"(At[m]), "v"(sc_w), "v"(sc_a)); __builtin_amdgcn_s_setprio(0); } while (0)
#define XLDA(b, h) do { if constexpr (FP8) PG8_LDA8(At8, b, h); else PG8_LDA(At, b, h); } while (0)
#define XLDB0(b, h) do { if constexpr (FP8) PG8_LDB8(B08, b, h); else PG8_LDB(B0, b, h); } while (0)
#define XLDB1(b, h) do { if constexpr (FP8) PG8_LDB8(B18, b, h); else PG8_LDB(B1, b, h); } while (0)
#define XMMA0(ai, bj) do { if constexpr (FP8) PG8_MMA8(ai, bj, At8, B08); else PG8_MMA(ai, bj, At, B0); } while (0)
#define XMMA1(ai, bj) do { if constexpr (FP8) PG8_MMA8(ai, bj, At8, B18); else PG8_MMA(ai, bj, At, B1); } while (0)
#define PG8_WAIT_V(n) asm volatile("s_waitcnt vmcnt(" #n ")" ::: "memory")
#define PG8_WAIT_L(n) asm volatile("s_waitcnt lgkmcnt(" #n ")" ::: "memory")
#define PG8_BAR __builtin_amdgcn_s_barrier()
#define PG8_SCHED __builtin_amdgcn_sched_barrier(0)

template <class Epi, class Sched, bool GATHER, bool ALIGN_EPI, bool FP8 = false>
__device__ __forceinline__ void gemm_phase(LAS unsigned char* lds, const Gemm g, const Sched& S, const Epi& E) {
    const int tid = threadIdx.x, wid = __builtin_amdgcn_readfirstlane(tid >> 6), lane = tid & 63, wr = wid >> 2, wc = wid & 3, fr = lane & 15, fq = lane >> 4;
    const int K = g.K, rowb = FP8 ? K : 2 * K, nt = rowb / 128;
    unsigned voffA[2], voffB[2], voffBW[2][2], voffC[2][2], voffN[2][2]; int RA[2], CA[2];
#pragma unroll
    for (int i = 0; i < 2; ++i) { int R, C; stage_rc(tid * 16 + i * 8192, R, C); const int Rb = Epi::PERM ? ((R & ~31) + perm32(R & 31)) : R;
        RA[i] = R; CA[i] = C; voffA[i] = (unsigned)(R * rowb + C * 2); voffB[i] = (unsigned)(Rb * rowb + C * 2);
        voffBW[0][i] = (unsigned)((64 * (R >> 5) + perm32(R & 31)) * rowb + C * 2); voffBW[1][i] = (unsigned)((64 * (R >> 5) + 32 + perm32(R & 31)) * rowb + C * 2); }
    const size_t kstep = (size_t)(BK * 2), hstep = (size_t)HALF * rowb, tstep = 2 * hstep;
    const unsigned ldsw = (unsigned)wid * 1024u;
    const int aoff = lds_byte(wr * 64 + fr, fq * 8), boff = lds_byte(wc * 32 + fr, fq * 8);
    Unit cur, nxt; int ui = 0;
    if (!S.next(0, cur)) return;
    f32x4 acc[2][2][4][2];
#pragma unroll
    for (int a = 0; a < 2; ++a)
#pragma unroll
        for (int b = 0; b < 2; ++b)
#pragma unroll
            for (int m = 0; m < 4; ++m)
#pragma unroll
                for (int n = 0; n < 2; ++n) acc[a][b][m][n] = (f32x4){0.f, 0.f, 0.f, 0.f};
    bf16x8 At[4][2], B0[2][2], B1[2][2]; v8i_t At8[4], B08[2], B18[2]; int sc_w = 0x7a7a7a7a, sc_a = 0x7f7f7f7f; asm volatile("" : "+v"(sc_w), "+v"(sc_a));
    const char* cA = (const char*)g.A + (size_t)cur.pm * tstep; const char* cB = (const char*)g.Bt + (size_t)cur.pb * tstep;
    if (GATHER) {
#pragma unroll
        for (int h = 0; h < 2; ++h)
#pragma unroll
            for (int i = 0; i < 2; ++i) { voffC[h][i] = (unsigned)(S.row_index(cur, RA[i] + 128 * h) * rowb + CA[i] * 2); voffN[h][i] = voffC[h][i]; }
    }
    const char* nA = cA; const char* nB = cB;
    PG8_STAGE_B(PG8_SB(0, 0), false, 0, 0); PG8_STAGE_B(PG8_SB(0, 1), false, 0, 1); PG8_STAGE_A(PG8_SA(0, 0), false, 0, 0); PG8_STAGE_A(PG8_SA(0, 1), false, 0, 1);
    if (wr == 1) PG8_BAR;
    PG8_WAIT_V(2); PG8_BAR;
    PG8_STAGE_B(PG8_SB(1, 0), false, kstep, 0); PG8_STAGE_A(PG8_SA(1, 0), false, kstep, 0); PG8_STAGE_B(PG8_SB(1, 1), false, kstep, 1);
    PG8_WAIT_V(6); PG8_BAR;
    for (;;) {
        const bool has_next = S.next(ui + 1, nxt);
        nA = has_next ? (const char*)g.A + (size_t)nxt.pm * tstep : cA; nB = has_next ? (const char*)g.Bt + (size_t)nxt.pb * tstep : cB;
        if (GATHER) {
            if (has_next) { int ix[2][2];
#pragma unroll
                for (int h = 0; h < 2; ++h)
#pragma unroll
                    for (int i = 0; i < 2; ++i) ix[h][i] = S.row_index(nxt, RA[i] + 128 * h);
#pragma unroll
                for (int h = 0; h < 2; ++h)
#pragma unroll
                    for (int i = 0; i < 2; ++i) voffN[h][i] = (unsigned)(ix[h][i] * rowb + CA[i] * 2);
            } else {
#pragma unroll
                for (int h = 0; h < 2; ++h)
#pragma unroll
                    for (int i = 0; i < 2; ++i) voffN[h][i] = voffC[h][i]; }
        }
        for (int t = 0; t < nt; t += 2) {
            const bool last = (t == nt - 2);
            const size_t k1 = (size_t)(t + 1) * kstep, k2 = last ? 0 : (size_t)(t + 2) * kstep, k3 = k2 + kstep;
            XLDB0(0, 0); XLDB1(0, 1); PG8_SCHED; XLDA(0, 0); PG8_STAGE_A(PG8_SA(1, 1), false, k1, 1);
            PG8_WAIT_V(8); PG8_WAIT_L(0); PG8_BAR; XMMA0(0, 0); XMMA1(0, 1); PG8_BAR; PG8_SCHED;
            XLDA(0, 1); PG8_STAGE_B(PG8_SB(0, 0), last, k2, 0); PG8_STAGE_B(PG8_SB(0, 1), last, k2, 1); PG8_STAGE_A(PG8_SA(0, 0), last, k2, 0);
            PG8_WAIT_V(8); PG8_WAIT_L(0); PG8_BAR; XMMA0(1, 0); XMMA1(1, 1); PG8_BAR; PG8_SCHED;
            XLDB0(1, 0); XLDB1(1, 1); PG8_SCHED; XLDA(1, 0); PG8_STAGE_A(PG8_SA(0, 1), last, k2, 1);
            PG8_WAIT_V(8); PG8_WAIT_L(0); PG8_BAR; XMMA0(0, 0); XMMA1(0, 1); PG8_BAR; PG8_SCHED;
            XLDA(1, 1); PG8_STAGE_B(PG8_SB(1, 0), last, k3, 0); PG8_STAGE_B(PG8_SB(1, 1), last, k3, 1); PG8_STAGE_A(PG8_SA(1, 0), last, k3, 0);
            PG8_WAIT_V(8); PG8_WAIT_L(0); PG8_BAR; XMMA0(1, 0); XMMA1(1, 1); PG8_BAR; PG8_SCHED;
        }
        if constexpr (ALIGN_EPI) { if (wr == 0) PG8_BAR; }
        if constexpr (FP8) asm volatile("s_nop 15\n\ts_nop 15" ::: "memory");
        E(acc, cur, wr, wc, fr, fq);
        if (DUP == 14) { asm volatile("" ::: "memory"); E(acc, cur, wr, wc, fr, fq); }
        if (!has_next) break;
#pragma unroll
        for (int a = 0; a < 2; ++a)
#pragma unroll
            for (int b = 0; b < 2; ++b)
#pragma unroll
                for (int m = 0; m < 4; ++m)
#pragma unroll
                    for (int n = 0; n < 2; ++n) acc[a][b][m][n] = (f32x4){0.f, 0.f, 0.f, 0.f};
        cur = nxt; cA = nA; cB = nB; ++ui;
        if (GATHER) {
#pragma unroll
            for (int h = 0; h < 2; ++h)
#pragma unroll
                for (int i = 0; i < 2; ++i) voffC[h][i] = voffN[h][i];
        }
        if constexpr (ALIGN_EPI) { if (wr == 1) PG8_BAR; }
    }
    PG8_WAIT_V(0);
    if constexpr (!ALIGN_EPI) { if (wr == 0) PG8_BAR; }
    PG8_BAR;
}

struct EpiInProj {
    static constexpr bool PERM = true, WIDE = true;
    bf16* zg; bf16* qb; bf16* kb; bf16* vb; const float* qn; const float* kn; LAS unsigned char* stage; const float* gnw;
    __device__ __forceinline__ void operator()(const f32x4 (&acc)[2][2][4][2], const Unit& u, int wr, int wc, int fr, int fq) const {
        const int lane = fq * 16 + fr; LAS unsigned char* stg = stage + (wr * 4 + wc) * 3584;
        const bool swa = u.pn >= 8; const int sec = swa ? (u.pn - 8) >> 1 : 0, head = 4 * ((u.pn - 8) & 1) + wc; const bool gate = (u.pn == 6) || (u.pn == 7);
        bf16* dst = qb + (size_t)sec * ((WS_KB - WS_QB) / 2); const float* nw = (sec == 1) ? kn : qn;
        f32x4 wv[2][2];
#pragma unroll
        for (int bj = 0; bj < 2; ++bj)
#pragma unroll
            for (int n = 0; n < 2; ++n) { const f32x4 t_ = *(const f32x4*)(nw + 32 * bj + 8 * fq + 4 * n); const f32x4 g_ = *(const f32x4*)(gnw + ((wc & 1) * 64 + 32 * bj + 8 * fq + 4 * n));
                wv[bj][n] = (swa && sec < 2) ? t_ : (gate ? g_ : (f32x4){1.f, 1.f, 1.f, 1.f}); }
#pragma unroll
        for (int ai = 0; ai < 2; ++ai)
#pragma unroll
            for (int m = 0; m < 4; ++m) {
                float sc = 1.f;
                if (swa && sec < 2) { float ss = 0.f;
#pragma unroll
                    for (int bj = 0; bj < 2; ++bj)
#pragma unroll
                        for (int n = 0; n < 2; ++n) { const f32x4 x = acc[ai][bj][m][n]; ss += (x[0] * x[0] + x[1] * x[1]) + (x[2] * x[2] + x[3] * x[3]); }
                    ss = sum_xor32(sum_xor16(ss));
                    sc = rsqrtf(ss * (1.f / 64.f) + EPS) * (sec == 0 ? 0.125f * LOG2E : 1.f); }
#pragma unroll
                for (int bj = 0; bj < 2; ++bj) { f32x4 v0 = acc[ai][bj][m][0] * sc, v1 = acc[ai][bj][m][1] * sc;
                    if (gate) { v0 = (f32x4){silu_f(v0[0]), silu_f(v0[1]), silu_f(v0[2]), silu_f(v0[3])}; v1 = (f32x4){silu_f(v1[0]), silu_f(v1[1]), silu_f(v1[2]), silu_f(v1[3])}; }
                    v0 = v0 * wv[bj][0]; v1 = v1 * wv[bj][1];
                    u32x4 w; w.x = pk2(v0[0], v0[1]); w.y = pk2(v0[2], v0[3]); w.z = pk2(v1[0], v1[1]); w.w = pk2(v1[2], v1[3]); *(LAS u32x4*)(stg + fr * 144 + bj * 64 + fq * 16) = w; }
                asm volatile("s_waitcnt lgkmcnt(0)" ::: "memory");
                const int row0 = u.pm * BM + ai * HALF + wr * 64 + m * 16;
#pragma unroll
                for (int hf = 0; hf < 2; ++hf) { const int rr = hf * 8 + (lane >> 3), c16 = lane & 7, row_ = row0 + rr; const u32x4 w = *(const LAS u32x4*)(stg + rr * 144 + c16 * 16);
                    bf16* gp = swa ? dst + ((size_t)((row_ >> 12) * AH + head) * SEQ + (row_ & (SEQ - 1))) * 64 + 8 * c16 : zg + (size_t)row_ * 2048 + u.pn * BM + wc * 64 + 8 * c16;
                    *(u32x4*)gp = w; }
                asm volatile("s_waitcnt lgkmcnt(0)" ::: "memory"); }
    }
};
struct EpiOutProj {
    static constexpr bool PERM = true, WIDE = true;
    const float* x; bf16* h; unsigned char* hb; LAS unsigned char* stage;
    __device__ __forceinline__ void operator()(const f32x4 (&acc)[2][2][4][2], const Unit& u, int wr, int wc, int fr, int fq) const {
        const int lane = fq * 16 + fr; LAS unsigned char* stg = stage + (wr * 4 + wc) * 3584; const int colw = u.pn * BM + wc * 64;
        const int r8 = lane >> 3, c16 = lane & 7;
#pragma unroll
        for (int ai = 0; ai < 2; ++ai)
#pragma unroll
            for (int mp = 0; mp < 2; ++mp) {
                f32x4 xv[2][2][2];
#pragma unroll
                for (int mm = 0; mm < 2; ++mm) { const int row0 = u.pm * BM + ai * HALF + wr * 64 + (2 * mp + mm) * 16;
#pragma unroll
                    for (int bj = 0; bj < 2; ++bj)
#pragma unroll
                        for (int hf = 0; hf < 2; ++hf) xv[mm][bj][hf] = *(const f32x4*)(x + (size_t)(row0 + 8 * hf + r8) * D + colw + 32 * bj + 4 * c16); }
                unsigned h8[2][2][2];
#pragma unroll
                for (int mm = 0; mm < 2; ++mm) { const int m = 2 * mp + mm; const int row0 = u.pm * BM + ai * HALF + wr * 64 + m * 16; u32x4 hw[2];
#pragma unroll
                    for (int bj = 0; bj < 2; ++bj) {
#pragma unroll
                        for (int hf = 0; hf < 2; ++hf) *(LAS f32x4*)(stg + (8 * hf + r8) * 144 + c16 * 16) = xv[mm][bj][hf];
                        asm volatile("s_waitcnt lgkmcnt(0)" ::: "memory");
                        const f32x4 x0 = *(const LAS f32x4*)(stg + fr * 144 + fq * 32), x1 = *(const LAS f32x4*)(stg + fr * 144 + fq * 32 + 16);
                        const f32x4 v0 = acc[ai][bj][m][0] + x0, v1 = acc[ai][bj][m][1] + x1;
                        h8[mm][bj][0] = pk4_fp8(v0[0], v0[1], v0[2], v0[3]); h8[mm][bj][1] = pk4_fp8(v1[0], v1[1], v1[2], v1[3]);
                        hw[bj] = (u32x4){pk2(v0[0], v0[1]), pk2(v0[2], v0[3]), pk2(v1[0], v1[1]), pk2(v1[2], v1[3])};
                        asm volatile("s_waitcnt lgkmcnt(0)" ::: "memory"); }
#pragma unroll
                    for (int bj = 0; bj < 2; ++bj) *(LAS u32x4*)(stg + fr * 144 + bj * 64 + fq * 16) = hw[bj];
                    asm volatile("s_waitcnt lgkmcnt(0)" ::: "memory");
#pragma unroll
                    for (int hf = 0; hf < 2; ++hf) { const u32x4 w = *(const LAS u32x4*)(stg + (8 * hf + r8) * 144 + c16 * 16); *(u32x4*)(h + (size_t)(row0 + 8 * hf + r8) * D + colw + 8 * c16) = w; }
                    asm volatile("s_waitcnt lgkmcnt(0)" ::: "memory"); }
#pragma unroll
                for (int mm = 0; mm < 2; ++mm)
#pragma unroll
                    for (int bj = 0; bj < 2; ++bj) *(LAS u32x2*)(stg + (16 * mm + fr) * 80 + bj * 32 + fq * 8) = (u32x2){h8[mm][bj][0], h8[mm][bj][1]};
                asm volatile("s_waitcnt lgkmcnt(0)" ::: "memory");
                { const int rr = lane >> 2, q16 = lane & 3; const int rowa = u.pm * BM + ai * HALF + wr * 64 + (2 * mp) * 16;
                  const u32x4 w0 = *(const LAS u32x4*)(stg + rr * 80 + q16 * 16), w1 = *(const LAS u32x4*)(stg + (16 + rr) * 80 + q16 * 16);
                  *(u32x4*)(hb + (size_t)(rowa + rr) * D + colw + 16 * q16) = w0; *(u32x4*)(hb + (size_t)(rowa + 16 + rr) * D + colw + 16 * q16) = w1; }
                asm volatile("s_waitcnt lgkmcnt(0)" ::: "memory"); }
    }
};
struct EpiGateUp {
    static constexpr bool PERM = true, WIDE = false;
    unsigned char* act; const float* bgu; const float* lrs; const LAS int* lcnt;
    __device__ __forceinline__ void operator()(const f32x4 (&acc)[2][2][4][2], const Unit& u, int wr, int wc, int fr, int fq) const {
        const int cl = wc * 32 + 8 * fq; const float* bg = bgu + (size_t)u.e * 2048 + 128 * u.pn + cl;
        f32x4 bgv[2], buv[2];
#pragma unroll
        for (int n = 0; n < 2; ++n) { bgv[n] = *(const f32x4*)(bg + 4 * n); buv[n] = *(const f32x4*)(bg + 1024 + 4 * n); }
        const int cnt = lcnt[u.e];
        float rsa[2][4];
#pragma unroll
        for (int ai = 0; ai < 2; ++ai)
#pragma unroll
            for (int m = 0; m < 4; ++m) rsa[ai][m] = lrs[(size_t)u.e * LCAP + u.mt * 256 + ai * HALF + wr * 64 + m * 16 + fr];
#pragma unroll
        for (int ai = 0; ai < 2; ++ai)
#pragma unroll
            for (int m = 0; m < 4; ++m) { const int r = ai * HALF + wr * 64 + m * 16 + fr, rr = u.mt * 256 + r;
                const float rs = rr < cnt ? rsa[ai][m] : 0.f;
                unsigned wq[2];
#pragma unroll
                for (int n = 0; n < 2; ++n) { float a[4];
#pragma unroll
                    for (int i = 0; i < 4; ++i) { const float gt = fminf(acc[ai][0][m][n][i] * rs + bgv[n][i], 7.f); const float up = fminf(fmaxf(acc[ai][1][m][n][i] * rs + buv[n][i], -7.f), 7.f);
                        a[i] = (up + 1.f) * gt * sigmoid_f(1.702f * gt); }
                    wq[n] = pk4_fp8(a[0], a[1], a[2], a[3]); }
                *(u32x2*)(act + (size_t)(u.pm * BM + r) * FF + 128 * u.pn + cl) = (u32x2){wq[0], wq[1]}; }
    }
};
struct EpiDown {
    static constexpr bool PERM = true, WIDE = true;
    unsigned char* y; const float* bdn; LAS unsigned char* stage;
    __device__ __forceinline__ void operator()(const f32x4 (&acc)[2][2][4][2], const Unit& u, int wr, int wc, int fr, int fq) const {
        const int colw = u.pn * BM + wc * 64; const float* bp = bdn + (size_t)u.e * D + colw + 8 * fq;
        f32x4 bv[2][2];
#pragma unroll
        for (int bj = 0; bj < 2; ++bj)
#pragma unroll
            for (int n = 0; n < 2; ++n) bv[bj][n] = *(const f32x4*)(bp + 32 * bj + 4 * n);
        const int lane = fq * 16 + fr; LAS unsigned char* stg = stage + (wr * 4 + wc) * 3584;
#pragma unroll
        for (int ai = 0; ai < 2; ++ai)
#pragma unroll
            for (int mp = 0; mp < 2; ++mp) {
#pragma unroll
                for (int mm = 0; mm < 2; ++mm) { const int m = 2 * mp + mm;
#pragma unroll
                    for (int bj = 0; bj < 2; ++bj) { const f32x4 v0 = acc[ai][bj][m][0] + bv[bj][0], v1 = acc[ai][bj][m][1] + bv[bj][1];
                        *(LAS u32x2*)(stg + (16 * mm + fr) * 80 + bj * 32 + fq * 8) = (u32x2){pk4_fp8(v0[0], v0[1], v0[2], v0[3]), pk4_fp8(v1[0], v1[1], v1[2], v1[3])}; } }
                asm volatile("s_waitcnt lgkmcnt(0)" ::: "memory");
                { const int rr = lane >> 2, c16 = lane & 3; const u32x4 w = *(const LAS u32x4*)(stg + rr * 80 + c16 * 16);
                  const int rowa = u.pm * BM + ai * HALF + wr * 64 + (2 * mp) * 16 + rr; *(u32x4*)(y + (size_t)rowa * D + colw + 16 * c16) = w;
                  const u32x4 w2 = *(const LAS u32x4*)(stg + (16 + rr) * 80 + c16 * 16); *(u32x4*)(y + (size_t)(rowa + 16) * D + colw + 16 * c16) = w2; }
                asm volatile("s_waitcnt lgkmcnt(0)" ::: "memory"); }
    }
};
}

#define XB_TMO      128
#define XB_XCNT(j)  (256  + 64 * (j))
#define XB_XSUB(j)  (1280 + 64 * (j))
#define XB_XGEN(j)  (2304 + 64 * (j))
#define XB_TOP      3328
#define XB_TOPGEN   3392
#define XCD_BAR_WORDS 3456
#define XB_SPIN_CAP (1u << 20)
__device__ __forceinline__ unsigned xb_ld(unsigned* p)              { return __hip_atomic_load(p, __ATOMIC_RELAXED, __HIP_MEMORY_SCOPE_AGENT); }
__device__ __forceinline__ unsigned xb_add(unsigned* p, unsigned v) { return __hip_atomic_fetch_add(p, v, __ATOMIC_RELAXED, __HIP_MEMORY_SCOPE_AGENT); }
__device__ __forceinline__ unsigned xb_xcc_id() { return (unsigned)__builtin_amdgcn_s_getreg((3 << 11) | 20) & 0xFu; }
#define XB_SPIN(cond, bar) do { unsigned _sp = 0; while (cond) { __builtin_amdgcn_s_sleep(1); \
    if ((++_sp & 255u) == 0u) { if (xb_ld(&(bar)[XB_TMO])) break; if (_sp > XB_SPIN_CAP) { atomicAdd(&(bar)[XB_TMO], 1u); break; } } } } while (0)
struct XcdBarrier { unsigned* bar; unsigned x; volatile LAS unsigned* st; };
__device__ __forceinline__ XcdBarrier xcd_barrier_post(unsigned* bar, volatile LAS unsigned* st) {
    XcdBarrier b; b.bar = bar; b.x = xb_xcc_id(); b.st = st;
    if (threadIdx.x == 0) (void)xb_add(&bar[XB_XCNT(b.x)], 1u);
    return b;
}
__device__ __forceinline__ void xcd_barrier_complete(unsigned* bar, unsigned x, unsigned& nloc, unsigned& nx) {
    const unsigned G = gridDim.x * gridDim.y * gridDim.z;
    unsigned sum, cnt, mine, sp = 0u;
    for (;;) {
        sum = 0u; cnt = 0u; mine = 0u;
#pragma unroll
        for (unsigned j = 0; j < 16; ++j) { const unsigned c = xb_ld(&bar[XB_XCNT(j)]); sum += c; cnt += (c > 0u) ? 1u : 0u; mine = (j == x) ? c : mine; }
        if (sum == G) break;
        __builtin_amdgcn_s_sleep(1);
        if ((++sp & 255u) == 0u) { if (xb_ld(&bar[XB_TMO])) break; if (sp > XB_SPIN_CAP) { atomicAdd(&bar[XB_TMO], 1u); break; } }
    }
    nloc = mine > 0u ? mine : 1u; nx = cnt > 0u ? cnt : 1u;
}
__device__ __forceinline__ void xcd_barrier(const XcdBarrier& b) {
    asm volatile("s_waitcnt vmcnt(0)" ::: "memory");
    __syncthreads();
    if (threadIdx.x == 0) {
        unsigned* bar = b.bar;
        __builtin_amdgcn_s_waitcnt(0);
        unsigned nloc = b.st[0], nx = b.st[1];
        if (nloc == 0u) { xcd_barrier_complete(bar, b.x, nloc, nx); b.st[0] = nloc; b.st[1] = nx; }
        const unsigned old = xb_add(&bar[XB_XSUB(b.x)], 1u);
        const unsigned gen = old / nloc;
        if (old + 1u == (gen + 1u) * nloc) {
            __builtin_amdgcn_fence(__ATOMIC_RELEASE, "agent");
            asm volatile("s_waitcnt vmcnt(0)" ::: "memory");
            const unsigned og = xb_add(&bar[XB_TOP], 1u);
            const unsigned tg = og / nx;
            if (og + 1u == (tg + 1u) * nx) xb_add(&bar[XB_TOPGEN], 1u);
            else XB_SPIN(xb_ld(&bar[XB_TOPGEN]) == tg, bar);
            __builtin_amdgcn_fence(__ATOMIC_ACQUIRE, "agent");
            xb_add(&bar[XB_XGEN(b.x)], 1u);
            asm volatile("s_waitcnt vmcnt(0)" ::: "memory");
        } else {
            XB_SPIN(xb_ld(&bar[XB_XGEN(b.x)]) == gen, bar);
            __builtin_amdgcn_fence(__ATOMIC_ACQUIRE, "agent");
            asm volatile("s_waitcnt vmcnt(0)" ::: "memory");
        }
    }
    __syncthreads();
}

struct Args { const float* in[18]; float* out; unsigned char* ws; int ph_lo, ph_hi, li, pad; };
struct Frame {
    LAS unsigned char* lds; unsigned char* ws; unsigned* ctl;
    int tid, lane, wave, G, vcu;
};

__device__ const unsigned char T5B[3][132] = {
{0,1,2,3,4,5,6,7,8,9,10,11,12,13,14,15,16,16,16,16,16,16,17,17,17,17,17,17,17,17,18,18,18,18,18,18,18,18,18,18,19,19,19,19,19,19,19,19,19,19,19,19,19,19,20,20,20,20,20,20,20,20,20,20,20,20,20,20,20,20,20,20,20,21,21,21,21,21,21,21,21,21,21,21,21,21,21,21,21,21,21,21,21,21,21,21,21,21,21,22,22,22,22,22,22,22,22,22,22,22,22,22,22,22,22,22,22,22,22,22,22,22,22,22,22,22,22,22,22,0,0,0},
{0,4,8,12,16,16,17,17,18,18,19,19,19,19,20,20,20,20,20,21,21,21,21,21,21,22,22,22,22,22,22,22,22,22,23,23,23,23,23,23,23,23,23,23,23,23,24,24,24,24,24,24,24,24,24,24,24,24,24,24,24,24,25,25,25,25,25,25,25,25,25,25,25,25,25,25,25,25,25,25,25,25,25,26,26,26,26,26,26,26,26,26,26,26,26,26,26,26,26,26,26,26,26,26,26,26,26,26,26,26,26,26,26,27,27,27,27,27,27,27,27,27,27,27,27,27,27,27,27,0,0,0},
{0,16,18,19,20,21,21,22,22,23,23,23,24,24,24,24,25,25,25,25,25,26,26,26,26,26,26,26,26,27,27,27,27,27,27,27,27,27,27,28,28,28,28,28,28,28,28,28,28,28,28,28,29,29,29,29,29,29,29,29,29,29,29,29,29,29,29,29,29,29,30,30,30,30,30,30,30,30,30,30,30,30,30,30,30,30,30,30,30,30,30,30,30,30,30,31,31,31,31,31,31,31,31,31,31,31,31,31,31,31,31,31,31,31,31,31,31,31,31,31,31,31,31,31,31,31,31,31,31,0,0,0}};

__device__ __forceinline__ void p0_load8(const float* W, size_t ldw, int src_col0, int k0, int lane, f32x4 (&v)[8]) {
    const int n4 = (lane & 7) * 4, kr = lane >> 3;
#pragma unroll
    for (int i = 0; i < 8; ++i) v[i] = *(const f32x4*)(W + (size_t)(k0 + 8 * i + kr) * ldw + src_col0 + n4);
}
template <bool SCALE, bool OUT8> __device__ __forceinline__ void p0_finish(const f32x4 (&v)[8], void* dstv, int k0, const float* kscale, LAS float* scr, int lane) {
    { const int n4 = (lane & 7) * 4, kr = lane >> 3;
#pragma unroll
        for (int i = 0; i < 8; ++i) { const int kk = 8 * i + kr; f32x4 x = v[i]; if (SCALE) x = x * kscale[k0 + kk]; if (OUT8) x = x * 32.f;
            scr[kk * 33 + n4] = x[0]; scr[kk * 33 + n4 + 1] = x[1]; scr[kk * 33 + n4 + 2] = x[2]; scr[kk * 33 + n4 + 3] = x[3]; } }
    LDS_WAIT(); asm volatile("" ::: "memory");
    if (OUT8) { unsigned char* dst = (unsigned char*)dstv; const int n = lane >> 1, kh = lane & 1; const LAS float* sp = scr + (32 * kh) * 33 + n; unsigned w[8];
#pragma unroll
        for (int q = 0; q < 8; ++q) w[q] = pk4_fp8(sp[(4 * q) * 33], sp[(4 * q + 1) * 33], sp[(4 * q + 2) * 33], sp[(4 * q + 3) * 33]);
        *(u32x4*)(dst + (size_t)n * 1024 + k0 + 32 * kh) = (u32x4){w[0], w[1], w[2], w[3]}; *(u32x4*)(dst + (size_t)n * 1024 + k0 + 32 * kh + 16) = (u32x4){w[4], w[5], w[6], w[7]};
    } else { bf16* dst = (bf16*)dstv; const int c = lane & 7;
#pragma unroll
        for (int j = 0; j < 4; ++j) { const int n = (lane >> 3) + 8 * j; const LAS float* sp = scr + (8 * c) * 33 + n;
            u32x4 o; o.x = pk2(sp[0 * 33], sp[1 * 33]); o.y = pk2(sp[2 * 33], sp[3 * 33]); o.z = pk2(sp[4 * 33], sp[5 * 33]); o.w = pk2(sp[6 * 33], sp[7 * 33]);
            *(u32x4*)(dst + (size_t)n * 1024 + k0 + 8 * c) = o; } }
    LDS_WAIT(); asm volatile("" ::: "memory");
}
template <bool SCALE, bool OUT8> __device__ __forceinline__ void p0_transpose_item(const float* W, size_t ldw, int src_col0, void* dstv, int k0, const float* kscale, LAS float* scr, int lane) {
    f32x4 v[8]; p0_load8(W, ldw, src_col0, k0, lane, v); p0_finish<SCALE, OUT8>(v, dstv, k0, kscale, scr, lane);
}
__device__ __forceinline__ void p0_experts(Frame& F, const Args& a, int gw, int NGW) {
    const float* n2 = a.in[11]; const float* w_gu = a.in[14]; const float* w_dn = a.in[16];
    unsigned char* Wgu8 = F.ws + WS_WGU; unsigned char* Wdn8 = F.ws + WS_WDN;
    LAS float* scr = (LAS float*)(F.lds + F.wave * 16896);
    constexpr int I_GU = NE * 8 * 64, I_DN = NE * 8 * 32, NI = I_GU + I_DN;
#define P0_X_ARGS(r_) const bool gu_ = (r_) < I_GU; const int r2_ = gu_ ? (r_) : (r_) - I_GU; const int e_ = gu_ ? (r2_ >> 9) : (r2_ >> 8), q_ = gu_ ? (r2_ & 511) : (r2_ & 255), nb_ = gu_ ? (q_ & 63) : (q_ & 31), kb_ = gu_ ? (q_ >> 6) : (q_ >> 5), \
        np_ = 32 * nb_, ntile_ = np_ >> 8, lc_ = np_ & 255; const int col_ = gu_ ? ((lc_ >> 7) * 1024 + 128 * ntile_ + (lc_ & 127)) : np_; const float* W_ = gu_ ? w_gu + (size_t)e_ * D * 2048 : w_dn + (size_t)e_ * FF * D; const size_t ldw_ = gu_ ? 2048 : D; \
        unsigned char* dst_ = gu_ ? Wgu8 + ((size_t)e_ * 2048 + np_) * 1024 : Wdn8 + ((size_t)e_ * 1024 + np_) * 1024; const int k0_ = 128 * kb_
#define P0_X_LOAD(r_, v_) do { P0_X_ARGS(r_); (void)dst_; const int n4 = (F.lane & 7) * 4, kr = F.lane >> 3; \
        _Pragma("unroll") for (int i = 0; i < 16; ++i) v_[i] = *(const f32x4*)(W_ + (size_t)(k0_ + 8 * i + kr) * ldw_ + col_ + n4); } while (0)
#define P0_X_FIN(r_, v_) do { P0_X_ARGS(r_); (void)W_; (void)ldw_; (void)col_; { const int n4 = (F.lane & 7) * 4, kr = F.lane >> 3; \
        _Pragma("unroll") for (int i = 0; i < 16; ++i) { const int kk = 8 * i + kr; f32x4 x = v_[i] * 32.f; if (gu_) x = x * n2[k0_ + kk]; \
            scr[kk * 33 + n4] = x[0]; scr[kk * 33 + n4 + 1] = x[1]; scr[kk * 33 + n4 + 2] = x[2]; scr[kk * 33 + n4 + 3] = x[3]; } } \
        LDS_WAIT(); asm volatile("" ::: "memory"); \
        { const int n = F.lane >> 1, kh = F.lane & 1; const LAS float* sp = scr + (64 * kh) * 33 + n; \
          _Pragma("unroll") for (int c = 0; c < 4; ++c) { unsigned w_[4]; _Pragma("unroll") for (int q = 0; q < 4; ++q) w_[q] = pk4_fp8(sp[(16 * c + 4 * q) * 33], sp[(16 * c + 4 * q + 1) * 33], sp[(16 * c + 4 * q + 2) * 33], sp[(16 * c + 4 * q + 3) * 33]); \
              *(u32x4*)(dst_ + (size_t)n * 1024 + k0_ + 64 * kh + 16 * c) = (u32x4){w_[0], w_[1], w_[2], w_[3]}; } } \
        LDS_WAIT(); asm volatile("" ::: "memory"); } while (0)
    { f32x4 va[16], vb2[16]; int it = gw;
        if (it < NI) P0_X_LOAD(it, va);
#pragma unroll 1
        for (; it < NI; it += 2 * NGW) { const int it2 = it + NGW, it3 = it + 2 * NGW;
            if (it2 < NI) P0_X_LOAD(it2, vb2);
            P0_X_FIN(it, va);
            if (it3 < NI) P0_X_LOAD(it3, va);
            if (it2 < NI) P0_X_FIN(it2, vb2); } }
#undef P0_X_LOAD
#undef P0_X_FIN
#undef P0_X_ARGS
}
__device__ __forceinline__ void phase0(Frame& F, const Args& a) {
    const float* x = a.in[0]; const float* n1 = a.in[1]; const float* w_in = a.in[2]; const float* w_out = a.in[10]; const float* n2 = a.in[11];
    const float* w_r = a.in[12]; const float* w_gu = a.in[14]; const float* w_dn = a.in[16];
    bf16* Win_t = (bf16*)(F.ws + WS_WIN); bf16* Wout_t = (bf16*)(F.ws + WS_WOUT); bf16* Wgu_t = (bf16*)(F.ws + WS_WGU); bf16* Wdn_t = (bf16*)(F.ws + WS_WDN);
    float* wrT = (float*)(F.ws + WS_WRT); bf16* XN = (bf16*)(F.ws + WS_XN); float* BA = (float*)(F.ws + WS_BA);
    LAS float* scr = (LAS float*)(F.lds + F.wave * 8448);
    const int gw = F.vcu * NWAVES + F.wave, NGW = F.G * NWAVES;
    for (int i = (F.vcu * NTHREADS + F.tid); i < NE * D; i += F.G * NTHREADS) { const int e = i >> 10, k = i & 1023; wrT[i] = n2[k] * w_r[k * NE + e]; }
    constexpr int I_IN = 16 * (NIN / 32), I_OUT = 16 * 32;
    for (int it = gw; it < I_IN + I_OUT; it += NGW) {
        int r = it;
        if (r < I_IN) { const int nb = r % (NIN / 32), kb = r / (NIN / 32), np = 32 * nb; int src;
            src = np < 2048 ? np : np + 8;
            p0_transpose_item<false, false>(w_in, IN_DIM, src, Win_t + (size_t)np * 1024, 64 * kb, nullptr, scr, F.lane); continue; }
        r -= I_IN;
        { const int nb = r & 31, kb = r >> 5; p0_transpose_item<false, false>(w_out, D, 32 * nb, Wout_t + (size_t)(32 * nb) * 1024, 64 * kb, nullptr, scr, F.lane); }
    }
    __syncthreads();
    { LAS float* wb = (LAS float*)(F.lds + 69632);
        for (int k = F.tid; k < D; k += NTHREADS) { const float* wp = w_in + (size_t)k * IN_DIM + 2048; LAS float* dp = wb + (k >> 2) * 36 + (k & 3) * 8;
            *(LAS f32x4*)dp = *(const f32x4*)wp; *(LAS f32x4*)(dp + 4) = *(const f32x4*)(wp + 4); }
        __syncthreads();
        f32x4 n1v[4];
#pragma unroll
        for (int j = 0; j < 4; ++j) n1v[j] = *((const f32x4*)n1 + F.lane + 64 * j);
        for (int rep9 = 0; rep9 < (DUP == 9 ? 2 : 1); ++rep9)
        for (int m0 = gw * 4; m0 < T; m0 += NGW * 4) {
            f32x4 v[4][4]; float rs[4];
#pragma unroll
            for (int r = 0; r < 4; ++r)
#pragma unroll
                for (int j = 0; j < 4; ++j) v[r][j] = *((const f32x4*)(x + (size_t)(m0 + r) * D) + F.lane + 64 * j);
#pragma unroll
            for (int r = 0; r < 4; ++r) { float sq = 0.f;
#pragma unroll
                for (int j = 0; j < 4; ++j) sq += (v[r][j][0] * v[r][j][0] + v[r][j][1] * v[r][j][1]) + (v[r][j][2] * v[r][j][2] + v[r][j][3] * v[r][j][3]);
                rs[r] = rsqrtf(wave_sum(sq) * (1.f / D) + EPS); }
            float ba[4][8];
#pragma unroll
            for (int r = 0; r < 4; ++r)
#pragma unroll
                for (int c = 0; c < 8; ++c) ba[r][c] = 0.f;
#pragma unroll
            for (int j = 0; j < 4; ++j) {
#pragma unroll
                for (int r = 0; r < 4; ++r) { v[r][j] = v[r][j] * rs[r] * n1v[j];
                    *((unsigned long long*)(XN + (size_t)(m0 + r) * D) + F.lane + 64 * j) = (unsigned long long)pk2(v[r][j][0], v[r][j][1]) | ((unsigned long long)pk2(v[r][j][2], v[r][j][3]) << 32); }
#pragma unroll
                for (int i = 0; i < 4; ++i) { const LAS float* wp = wb + (F.lane + 64 * j) * 36 + i * 8; const f32x4 w0 = *(const LAS f32x4*)wp, w1 = *(const LAS f32x4*)(wp + 4);
#pragma unroll
                    for (int r = 0; r < 4; ++r) { const float xv = v[r][j][i];
                        ba[r][0] += xv * w0[0]; ba[r][1] += xv * w0[1]; ba[r][2] += xv * w0[2]; ba[r][3] += xv * w0[3];
                        ba[r][4] += xv * w1[0]; ba[r][5] += xv * w1[1]; ba[r][6] += xv * w1[2]; ba[r][7] += xv * w1[3]; } } }
#pragma unroll
            for (int r = 0; r < 4; ++r) {
#pragma unroll
                for (int c = 0; c < 8; ++c) ba[r][c] = wave_sum(ba[r][c]);
                if (F.lane == 0) { *(f32x4*)(BA + (size_t)(m0 + r) * 8) = (f32x4){ba[r][0], ba[r][1], ba[r][2], ba[r][3]}; *(f32x4*)(BA + (size_t)(m0 + r) * 8 + 4) = (f32x4){ba[r][4], ba[r][5], ba[r][6], ba[r][7]}; } }
        }
        __syncthreads();
    }
}

constexpr int GP = 132;
constexpr int GQ_OFF = 0, GK_OFF = 64 * GP * 4, GV_OFF = 2 * 64 * GP * 4, GW_OFF = 3 * 64 * GP * 4, GAT_OFF = 4 * 64 * GP * 4, GAT_P = 68;
constexpr int GRAW_OFF = GW_OFF, GRAW_BYTES = 67 * 768;
constexpr int GGC_OFF = GRAW_OFF + GRAW_BYTES, GBETA_OFF = GGC_OFF + 256, GDM_OFF = GBETA_OFF + 256, GEND = GDM_OFF + 4096;
static_assert(GAT_OFF + 64 * GAT_P * 4 <= GGC_OFF && GEND <= TOP_OFF, "gdn prep LDS");
__device__ __forceinline__ int permpos(int cc) { return 8 * ((cc & 15) >> 2) + (cc & 3) + 4 * (cc >> 4); }
__device__ __forceinline__ void gdn_prep_unit(Frame& F, const Args& a, int unit, int next_unit) {
    const bf16* zg = (const bf16*)(F.ws + WS_ZG); const float* BA = (const float*)(F.ws + WS_BA);
    const float* convw = a.in[3]; const float* a_log = a.in[4]; const float* dt_bias = a.in[5];
    const int b = unit >> 8, h = (unit >> 6) & 3, n = unit & 63; const int row0 = b * SEQ + n * CHUNK;
    unsigned char* rec = F.ws + WS_PREP + (size_t)unit * PREP_REC;
    LAS float* Qs = (LAS float*)(F.lds + GQ_OFF); LAS float* Ks = (LAS float*)(F.lds + GK_OFF); LAS float* Vs = (LAS float*)(F.lds + GV_OFF); LAS float* Ws = (LAS float*)(F.lds + GW_OFF);
    LAS float* AT = (LAS float*)(F.lds + GAT_OFF); LAS float* gcs = (LAS float*)(F.lds + GGC_OFF); LAS float* betas = (LAS float*)(F.lds + GBETA_OFF);
    LAS unsigned char* raw = F.lds + GRAW_OFF;
    const int tid = F.tid, lane = F.lane, wave = F.wave;
    for (int e = tid; e < 67 * 48; e += NTHREADS) { const int rr = e / 48, ch = e % 48; const int tt = n * CHUNK + rr - 3;
        u32x4 v = {0u, 0u, 0u, 0u}; if (tt >= 0) v = *(const u32x4*)(zg + (size_t)(row0 + rr - 3) * 2048 + (ch >> 4) * 512 + h * 128 + (ch & 15) * 8);
        *(LAS u32x4*)(raw + rr * 768 + ch * 16) = v; }
    if (wave == 0) {
        const float bl = BA[(size_t)(row0 + lane) * 8 + h], al = BA[(size_t)(row0 + lane) * 8 + 4 + h];
        const float xx = al + dt_bias[h]; const float sp = xx > 20.f ? xx : log1pf(__expf(xx));
        float g = -__expf(a_log[h]) * sp;
#pragma unroll
        for (int o = 1; o < 64; o <<= 1) { const float u = __shfl_up(g, o); if (lane >= o) g += u; }
        gcs[lane] = g; betas[lane] = sigmoid_f(bl);
    }
    LDS_BARRIER();
    if (tid < 384) { const int cp = tid % 192, tp = tid / 192; const int ten = cp >> 6, c = (cp & 63) * 2; const int ch = ten * 512 + h * 128 + c;
        f32x2 cw[4];
#pragma unroll
        for (int k = 0; k < 4; ++k) cw[k] = *(const f32x2*)(convw + k * 1536 + ch);
        LAS float* dst = (ten == 0 ? Qs : (ten == 1 ? Ks : Vs)) + c;
#pragma unroll 4
        for (int t = tp; t < 64; t += 2) { float a0 = 0.f, a1 = 0.f;
#pragma unroll
            for (int k = 0; k < 4; ++k) { const unsigned w = *(const LAS unsigned*)(raw + (t + k) * 768 + cp * 4); a0 += bflo(w) * cw[k][0]; a1 += bfhi(w) * cw[k][1]; }
            *(LAS f32x2*)(dst + t * GP) = (f32x2){silu_f(a0), silu_f(a1)}; } }
    LDS_BARRIER();
    for (int rr = 0; rr < 8; ++rr) { const int t = wave * 8 + rr;
        f32x2 q = *(LAS f32x2*)(Qs + t * GP + 2 * lane), k = *(LAS f32x2*)(Ks + t * GP + 2 * lane);
        const float sq = wave_sum(q[0] * q[0] + q[1] * q[1]), sk = wave_sum(k[0] * k[0] + k[1] * k[1]);
        const float fq_ = rsqrtf(sq + EPS) * 0.08838834764831845f, fk_ = rsqrtf(sk + EPS);
        *(LAS f32x2*)(Qs + t * GP + 2 * lane) = q * fq_; *(LAS f32x2*)(Ks + t * GP + 2 * lane) = k * fk_; }
    LDS_BARRIER();
    {
        const int which = wave >> 2, ti = (wave >> 1) & 1, tj = wave & 1, r32 = lane & 31, hh = lane >> 5;
        const LAS float* Xa = (which ? Ks + (32 * tj + r32) * GP : Ks + (32 * ti + r32) * GP) + 8 * hh; const LAS float* Xb = (which ? Qs + (32 * ti + r32) * GP : Ks + (32 * tj + r32) * GP) + 8 * hh;
        f32x16 acc = {};
#pragma unroll
        for (int ks = 0; ks < 8; ++ks) { const bf16x8 af = pack8(*(const LAS f32x4*)(Xa + 16 * ks), *(const LAS f32x4*)(Xa + 16 * ks + 4)), bf = pack8(*(const LAS f32x4*)(Xb + 16 * ks), *(const LAS f32x4*)(Xb + 16 * ks + 4));
            acc = __builtin_amdgcn_mfma_f32_32x32x16_bf16(af, bf, acc, 0, 0, 0); }
        if (which == 0) {
            const int j = 32 * tj + r32; const float gj = gcs[j];
#pragma unroll
            for (int q = 0; q < 4; ++q) { float vals[4];
#pragma unroll
                for (int rr = 0; rr < 4; ++rr) { const int i = 32 * ti + 8 * q + 4 * hh + rr; const float dec = __expf(fminf(gcs[i] - gj, 0.f)); vals[rr] = i > j ? betas[i] * acc[4 * q + rr] * dec : 0.f; }
                *(LAS f32x4*)(AT + j * GAT_P + 32 * ti + 8 * q + 4 * hh) = (f32x4){vals[0], vals[1], vals[2], vals[3]}; }
        } else {
            const int i = 32 * ti + r32; const float gi = gcs[i]; bf16* Af = (bf16*)(rec + PREP_AP) + (i >> 4) * 1024 + (i & 15) * 8 + tj * 512;
#pragma unroll
            for (int q = 0; q < 4; ++q) { float vals[4]; const int cc0 = 8 * q + 4 * hh;
#pragma unroll
                for (int rr = 0; rr < 4; ++rr) { const int j = 32 * tj + cc0 + rr; const float dec = __expf(fminf(gi - gcs[j], 0.f)); vals[rr] = i >= j ? acc[4 * q + rr] * dec : 0.f; }
                const int jpos = permpos(cc0); *(u32x2*)(Af + (jpos >> 3) * 128 + (jpos & 7)) = (u32x2){pk2(vals[0], vals[1]), pk2(vals[2], vals[3])}; }
        }
        for (int e = tid; e < 64 * 32; e += NTHREADS) { const int t = e >> 5, c = (e & 31) * 4; const float bt = betas[t], eg = bt * __expf(gcs[t]);
            *(LAS f32x4*)(Vs + t * GP + c) = *(LAS f32x4*)(Vs + t * GP + c) * bt; *(LAS f32x4*)(Ws + t * GP + c) = *(LAS f32x4*)(Ks + t * GP + c) * eg; }
    }
    LDS_BARRIER();
    unsigned pfx = 0u;
    if (next_unit >= 0) { const int nb_ = next_unit >> 8, nh_ = (next_unit >> 6) & 3, nn_ = next_unit & 63; const int nrow0 = nb_ * SEQ + nn_ * CHUNK;
        if (tid < 402) { const int rr = tid / 6, sg = tid % 6; if (nn_ * CHUNK + rr - 3 >= 0) pfx = *(const unsigned*)(zg + (size_t)(nrow0 + rr - 3) * 2048 + (sg >> 1) * 512 + nh_ * 128 + (sg & 1) * 64); }
        else if (tid < 418) pfx = *(const unsigned*)(BA + (size_t)nrow0 * 8 + (tid - 402) * 32); }
    LAS float* Dm = (LAS float*)(F.lds + GDM_OFF);
    if (wave < 4) {
        if (lane < 16) { const int i0 = 16 * wave; float r[16];
#pragma unroll
            for (int ii = 0; ii < 16; ++ii) r[ii] = (ii == lane) ? 1.f : 0.f;
#pragma unroll
            for (int j = 0; j < 16; ++j) { const float xj = r[j]; const LAS f32x4* ap = (const LAS f32x4*)(AT + (i0 + j) * GAT_P + i0); float av[16];
#pragma unroll
                for (int q = 0; q < 4; ++q) { const f32x4 t4 = ap[q]; av[4 * q] = t4[0]; av[4 * q + 1] = t4[1]; av[4 * q + 2] = t4[2]; av[4 * q + 3] = t4[3]; }
#pragma unroll
                for (int ii = 0; ii < 16; ++ii) if (ii > j) r[ii] -= av[ii] * xj; }
#pragma unroll
            for (int ii = 0; ii < 16; ++ii) Dm[wave * 256 + ii * 16 + lane] = r[ii]; }
    } else {
        const int t2 = tid - 256; bf16* Qf = (bf16*)(rec + PREP_QP); bf16* Kf = (bf16*)(rec + PREP_KT); const float gl = gcs[63];
        for (int it = t2; it < 1024; it += 256) { const int blk = it >> 6, l = it & 63, mi = blk >> 2, ks = blk & 3, g = l >> 4, c = 16 * mi + (l & 15); const float eg = __expf(gcs[c]);
            const f32x4 lo = *(LAS f32x4*)(Qs + c * GP + 32 * ks + 4 * g) * eg, hi = *(LAS f32x4*)(Qs + c * GP + 32 * ks + 16 + 4 * g) * eg;
            *(bf16x8*)(Qf + it * 8) = pack8(lo, hi); }
        for (int it = t2; it < 1024; it += 256) { const int blk = it >> 6, l = it & 63, ti = blk >> 1, ks2 = blk & 1, g = l >> 4, dk = 16 * ti + (l & 15); float v[8];
#pragma unroll
            for (int j = 0; j < 8; ++j) { const int c = 32 * ks2 + (j < 4 ? 4 * g + j : 16 + 4 * g + (j - 4)); v[j] = Ks[c * GP + dk] * __expf(gl - gcs[c]); }
            *(bf16x8*)(Kf + it * 8) = pack8((f32x4){v[0], v[1], v[2], v[3]}, (f32x4){v[4], v[5], v[6], v[7]}); }
        if (t2 == 0) *(float*)(rec + PREP_CD) = __expf(gl);
    }
    LDS_BARRIER();
    {
        const int fr = lane & 15, g = lane >> 4;
#pragma unroll 1
        for (int bb = 0; bb < 4; ++bb) {
            const int i0 = 16 * bb;
            bf16x8 Af[2];
#pragma unroll
            for (int ks = 0; ks < 2; ++ks) { float av[8];
#pragma unroll
                for (int j = 0; j < 8; ++j) { const int kr = 32 * ks + 8 * g + j; av[j] = kr < i0 ? -AT[kr * GAT_P + i0 + fr] : 0.f; }
                Af[ks] = pack8((f32x4){av[0], av[1], av[2], av[3]}, (f32x4){av[4], av[5], av[6], av[7]}); }
            const f32x4 dv4 = *(const LAS f32x4*)(Dm + bb * 256 + fr * 16 + 4 * g);
            const bf16x8 Df = pack8(dv4, (f32x4){0.f, 0.f, 0.f, 0.f});
#pragma unroll
            for (int nt = 0; nt < 2; ++nt) { const int col = 32 * wave + 16 * nt + fr; LAS float* X = (col < 128 ? Vs + col : Ws + (col - 128));
                f32x4 acc;
#pragma unroll
                for (int rg = 0; rg < 4; ++rg) acc[rg] = X[(i0 + 4 * g + rg) * GP];
                if (bb > 0) {
#pragma unroll
                    for (int ks = 0; ks < 2; ++ks) { if (32 * ks < i0) { float xv[8];
#pragma unroll
                        for (int j = 0; j < 8; ++j) xv[j] = X[(32 * ks + 8 * g + j) * GP];
                        acc = __builtin_amdgcn_mfma_f32_16x16x32_bf16(Af[ks], pack8((f32x4){xv[0], xv[1], xv[2], xv[3]}, (f32x4){xv[4], xv[5], xv[6], xv[7]}), acc, 0, 0, 0); } } }
                const f32x4 xb = __builtin_amdgcn_mfma_f32_16x16x32_bf16(Df, pack8(acc, (f32x4){0.f, 0.f, 0.f, 0.f}), (f32x4){0.f, 0.f, 0.f, 0.f}, 0, 0, 0);
#pragma unroll
                for (int rg = 0; rg < 4; ++rg) X[(i0 + 4 * g + rg) * GP] = xb[rg]; }
        }
    }
    LDS_BARRIER();
    { float* Up = (float*)(rec + PREP_UP); bf16* Wf = (bf16*)(rec + PREP_WP);
        for (int it = tid; it < 2048; it += NTHREADS) { const int dv = it & 127, g = (it >> 7) & 3, mi = it >> 9; const int c0 = 16 * mi + 4 * g;
            *(f32x4*)(Up + (size_t)it * 4) = (f32x4){Vs[c0 * GP + dv], Vs[(c0 + 1) * GP + dv], Vs[(c0 + 2) * GP + dv], Vs[(c0 + 3) * GP + dv]}; }
        for (int it = tid; it < 1024; it += NTHREADS) { const int blk = it >> 6, l = it & 63, mi = blk >> 2, ks = blk & 3, g = l >> 4, c = 16 * mi + (l & 15);
            *(bf16x8*)(Wf + it * 8) = pack8(*(LAS f32x4*)(Ws + c * GP + 32 * ks + 4 * g), *(LAS f32x4*)(Ws + c * GP + 32 * ks + 16 + 4 * g)); }
    }
    asm volatile("" :: "v"(pfx));
    LDS_BARRIER();
}

constexpr int SC_BUFSZ = 57344, SC_OT = 2 * SC_BUFSZ, SC_OTSZ = 64 * 128 * 2, SC_END = SC_OT + 2 * SC_OTSZ;
static_assert(SC_END <= TOP_OFF, "scan LDS");
__device__ __forceinline__ void gdn_scan(Frame& F, const Args& a, int bh) {
    const int tid = F.tid, lane = F.lane, w = F.wave, fr = lane & 15, g = lane >> 4; const int b = bh >> 2, h = bh & 3;
    const unsigned char* rec0 = F.ws + WS_PREP + (size_t)bh * NCHUNK * PREP_REC;
    const float* gnw = a.in[6]; const bf16* zg = (const bf16*)(F.ws + WS_ZG); bf16* mix = (bf16*)(F.ws + WS_MIX);
    const size_t rowb = (size_t)b * SEQ; const unsigned lds0 = (unsigned)(uintptr_t)F.lds;
    if (w >= 4) {
        const int hw = w - 4, l16 = lane & 15, rq = lane >> 4;
#define SC_DMA(n_, buf_) do { const unsigned char* src_ = rec0 + (size_t)(n_) * PREP_REC + hw * 14336 + lane * 16; _Pragma("unroll") for (int r_ = 0; r_ < 14; ++r_) \
        glds16_asm(src_ + r_ * 1024, (unsigned)__builtin_amdgcn_readfirstlane((int)(lds0 + (buf_) * SC_BUFSZ + hw * 14336 + r_ * 1024))); } while (0)
#define SC_NORM(n_, gv) do { const LAS unsigned char* ot = F.lds + SC_OT + ((n_) & 1) * SC_OTSZ; _Pragma("unroll") for (int q_ = 0; q_ < 4; ++q_) { const int t = 16 * hw + 4 * q_ + rq; \
            const u32x4 ov = *(const LAS u32x4*)(ot + t * 256 + l16 * 16); const f32x4 xa = {bflo(ov.x), bfhi(ov.x), bflo(ov.y), bfhi(ov.y)}, xb = {bflo(ov.z), bfhi(ov.z), bflo(ov.w), bfhi(ov.w)}; \
            float ss_ = (xa[0] * xa[0] + xa[1] * xa[1]) + (xa[2] * xa[2] + xa[3] * xa[3]) + (xb[0] * xb[0] + xb[1] * xb[1]) + (xb[2] * xb[2] + xb[3] * xb[3]); \
            ss_ = sum_row16(ss_); const float sc = rsqrtf(ss_ * (1.f / 128.f) + EPS); \
            const u32x4 gz = gv[q_]; const f32x4 ga = {bflo(gz.x), bfhi(gz.x), bflo(gz.y), bfhi(gz.y)}, gb = {bflo(gz.z), bfhi(gz.z), bflo(gz.w), bfhi(gz.w)}; \
            *(bf16x8*)(mix + (rowb + (n_) * CHUNK + t) * 1024 + h * 128 + 8 * l16) = pack8(xa * sc * ga, xb * sc * gb); } } while (0)
        u32x4 gc_[4], gn_[4];
        SC_DMA(0, 0);
#pragma unroll
        for (int q = 0; q < 4; ++q) gc_[q] = (u32x4){0u, 0u, 0u, 0u};
        VM_WAIT(); __syncthreads();
#pragma unroll 1
        for (int n = 0; n < NCHUNK; ++n) {
#pragma unroll
            for (int q = 0; q < 4; ++q) gn_[q] = *(const u32x4*)(zg + (rowb + n * CHUNK + 16 * hw + 4 * q + rq) * 2048 + 1536 + h * 128 + 8 * l16);
            if (n + 1 < NCHUNK) SC_DMA(n + 1, (n + 1) & 1);
            if (n > 0) SC_NORM(n - 1, gc_);
            VM_WAIT(); __syncthreads();
#pragma unroll
            for (int q = 0; q < 4; ++q) gc_[q] = gn_[q];
        }
        SC_NORM(NCHUNK - 1, gc_);
#undef SC_DMA
#undef SC_NORM
    } else {
        f32x4 S[2][8];
#pragma unroll
        for (int sl = 0; sl < 2; ++sl)
#pragma unroll
            for (int i = 0; i < 8; ++i) S[sl][i] = (f32x4){0.f, 0.f, 0.f, 0.f};
        f32x4 Un[2][4]; float cd = *(const float*)(rec0 + PREP_CD), cdn;
#pragma unroll
        for (int sl = 0; sl < 2; ++sl)
#pragma unroll
            for (int mi = 0; mi < 4; ++mi) Un[sl][mi] = *(const f32x4*)((const float*)(rec0 + PREP_UP) + (size_t)((mi * 4 + g) * 128 + 32 * w + 16 * sl + fr) * 4);
        __syncthreads();
#pragma unroll 1
        for (int n = 0; n < NCHUNK; ++n) {
            const LAS unsigned char* B = F.lds + (n & 1) * SC_BUFSZ + lane * 16;
            f32x4 vn[2][4], o[2][4];
            { bf16x8 Sb[2][4];
#pragma unroll
                for (int sl = 0; sl < 2; ++sl)
#pragma unroll
                    for (int ks = 0; ks < 4; ++ks) Sb[sl][ks] = pack8(S[sl][2 * ks], S[sl][2 * ks + 1]);
#pragma unroll
                for (int mi = 0; mi < 4; ++mi) { f32x4 t1[2], oo[2];
#pragma unroll
                    for (int sl = 0; sl < 2; ++sl) { t1[sl] = (f32x4){0.f, 0.f, 0.f, 0.f}; oo[sl] = (f32x4){0.f, 0.f, 0.f, 0.f}; }
#pragma unroll
                    for (int ks = 0; ks < 4; ++ks) { const bf16x8 wf = *(const LAS bf16x8*)(B + PREP_WP + (mi * 4 + ks) * 1024), qf = *(const LAS bf16x8*)(B + PREP_QP + (mi * 4 + ks) * 1024);
#pragma unroll
                        for (int sl = 0; sl < 2; ++sl) { t1[sl] = __builtin_amdgcn_mfma_f32_16x16x32_bf16(wf, Sb[sl][ks], t1[sl], 0, 0, 0); oo[sl] = __builtin_amdgcn_mfma_f32_16x16x32_bf16(qf, Sb[sl][ks], oo[sl], 0, 0, 0); } }
#pragma unroll
                    for (int sl = 0; sl < 2; ++sl) { vn[sl][mi] = Un[sl][mi] - t1[sl]; o[sl][mi] = oo[sl]; } } }
            { const int nn = n + 1 < NCHUNK ? n + 1 : n; cdn = *(const float*)(rec0 + (size_t)nn * PREP_REC + PREP_CD);
#pragma unroll
                for (int sl = 0; sl < 2; ++sl)
#pragma unroll
                    for (int mi = 0; mi < 4; ++mi) Un[sl][mi] = *(const f32x4*)((const float*)(rec0 + (size_t)nn * PREP_REC + PREP_UP) + (size_t)((mi * 4 + g) * 128 + 32 * w + 16 * sl + fr) * 4); }
            bf16x8 Vb[2][2];
#pragma unroll
            for (int sl = 0; sl < 2; ++sl)
#pragma unroll
                for (int ks = 0; ks < 2; ++ks) Vb[sl][ks] = pack8(vn[sl][2 * ks], vn[sl][2 * ks + 1]);
#pragma unroll
            for (int mi = 0; mi < 4; ++mi) {
#pragma unroll
                for (int ks = 0; ks < 2; ++ks) { const bf16x8 af = *(const LAS bf16x8*)(B + PREP_AP + (mi * 2 + ks) * 1024);
#pragma unroll
                    for (int sl = 0; sl < 2; ++sl) o[sl][mi] = __builtin_amdgcn_mfma_f32_16x16x32_bf16(af, Vb[sl][ks], o[sl][mi], 0, 0, 0); }
#pragma unroll
                for (int sl = 0; sl < 2; ++sl) { LAS bf16* otw = (LAS bf16*)(F.lds + SC_OT + (n & 1) * SC_OTSZ) + 32 * w + 16 * sl + fr;
                    const unsigned p01 = pk2(o[sl][mi][0], o[sl][mi][1]), p23 = pk2(o[sl][mi][2], o[sl][mi][3]);
                    otw[(16 * mi + 4 * g) * 128] = (bf16)(p01 & 0xffffu); otw[(16 * mi + 4 * g + 1) * 128] = (bf16)(p01 >> 16); otw[(16 * mi + 4 * g + 2) * 128] = (bf16)(p23 & 0xffffu); otw[(16 * mi + 4 * g + 3) * 128] = (bf16)(p23 >> 16); } }
#pragma unroll
            for (int ti = 0; ti < 8; ++ti) { f32x4 s0 = S[0][ti] * cd, s1 = S[1][ti] * cd;
#pragma unroll
                for (int ks = 0; ks < 2; ++ks) { const bf16x8 kf = *(const LAS bf16x8*)(B + PREP_KT + (ti * 2 + ks) * 1024);
                    s0 = __builtin_amdgcn_mfma_f32_16x16x32_bf16(kf, Vb[0][ks], s0, 0, 0, 0); s1 = __builtin_amdgcn_mfma_f32_16x16x32_bf16(kf, Vb[1][ks], s1, 0, 0, 0); }
                S[0][ti] = s0; S[1][ti] = s1; }
            __syncthreads();
            cd = cdn;
        }
    }
    __syncthreads();
}

constexpr int AT_K = 0, AT_V = 49152, AT_BIAS = 98304, AT_LW = 98304 + 1024, AT_END = AT_LW + 1024;
constexpr size_t WS_P4 = 616 * MiB, WS_P16 = 648 * MiB, WS_L4 = 744 * MiB, WS_L16 = 745 * MiB;
static_assert(WS_P16 + (size_t)T * 512 * 2 <= WS_MIX && WS_L16 + (size_t)T * 8 * 4 <= WS_XN, "attention partial buffers");
__device__ __forceinline__ void attn_unit(Frame& F, const Args& a, int u) {
    int kind, b, h, r, q0;
    if (u < 1024) { kind = 2; b = u >> 7; h = (u >> 4) & 7; r = u & 15; q0 = 0; }
    else if (u < 2048) { const int v = u - 1024; kind = 1; b = v >> 7; h = (v >> 4) & 7; r = (v >> 2) & 3; q0 = (v & 3) * 256; }
    else { const int v = u - 2048; kind = 0; b = v >> 7; h = (v >> 4) & 7; r = 0; q0 = (v & 15) * 256; }
    const int dsh = 2 * kind, lmax = (SEQ >> dsh) - 1;
    const bf16* qb = (const bf16*)(F.ws + WS_QB); const bf16* kb = (const bf16*)(F.ws + WS_KB); const bf16* vb = (const bf16*)(F.ws + WS_VB); bf16* mix = (bf16*)(F.ws + WS_MIX);
    const float* relb = a.in[9];
    LAS float* biasL = (LAS float*)(F.lds + AT_BIAS); LAS float* lw = (LAS float*)(F.lds + AT_LW) + F.wave * 32;
    const int tid = F.tid, lane = F.lane, w = F.wave, c = lane & 31, hh = lane >> 5;
    const size_t hrow = (size_t)(b * AH + h) * SEQ; const unsigned lds0 = (unsigned)(uintptr_t)F.lds;
    { const int ro = lane >> 3, p = lane & 7;
#pragma unroll
        for (int i = 0; i < 6; ++i) { const int lr = 48 * w + 8 * i + ro; int pos = q0 - 128 + lr; pos = pos < 0 ? 0 : (pos > lmax ? lmax : pos);
            const size_t eo = (hrow + (size_t)(pos << dsh) + r) * 64 + (size_t)((p ^ (lr & 7)) * 8);
            glds16_asm(kb + eo, (unsigned)__builtin_amdgcn_readfirstlane((int)(lds0 + AT_K + (48 * w + 8 * i) * 128)));
            glds16_asm(vb + eo, (unsigned)__builtin_amdgcn_readfirstlane((int)(lds0 + AT_V + (48 * w + 8 * i) * 128))); } }
    if (tid < 132) biasL[tid] = relb[(int)T5B[kind][tid] * AH + h] * LOG2E;
    const int qi = q0 + 32 * w + c;
    bf16x8 Qf[4];
    { const bf16* qp = qb + (hrow + (size_t)(qi << dsh) + r) * 64 + 8 * hh;
#pragma unroll
        for (int ks = 0; ks < 4; ++ks) Qf[ks] = *(const bf16x8*)(qp + 16 * ks); }
    VM_WAIT(); __syncthreads();
    f32x16 O0 = {}, O1 = {}; float lsum = 0.f;
    const int kt0 = (128 - q0 - 32 * w) > 0 ? ((128 - q0 - 32 * w) >> 5) : 0;
    const int li = lane & 15, gq = lane >> 4;
#pragma unroll 1
    for (int kt = kt0; kt < 5; ++kt) {
        const int lr0 = 32 * (w + kt);
        f32x16 sT = {};
        { const int lr = lr0 + c; const LAS unsigned char* kp = F.lds + AT_K + lr * 128;
#pragma unroll
            for (int ks = 0; ks < 4; ++ks) { const bf16x8 kf = *(const LAS bf16x8*)(kp + (((2 * ks + hh) ^ (lr & 7)) * 16)); sT = __builtin_amdgcn_mfma_f32_32x32x16_bf16(kf, Qf[ks], sT, 0, 0, 0); } }
        float p[16];
#pragma unroll
        for (int reg = 0; reg < 16; ++reg) { const int kr = (reg & 3) + 8 * (reg >> 2) + 4 * hh; const int s = 128 + c - 32 * kt - kr; const int kpos = q0 - 128 + lr0 + kr;
            const bool ok = (s >= 0) && (s <= 128) && (kpos >= 0); const int sc_ = s < 0 ? 0 : (s > 128 ? 128 : s);
            const float e = __builtin_amdgcn_exp2f(sT[reg] + biasL[sc_]); p[reg] = ok ? e : 0.f; lsum += p[reg]; }
        bf16x8 Pf[2];
#pragma unroll
        for (int s2 = 0; s2 < 2; ++s2) { u32x4 wv; wv.x = pk2(p[8 * s2], p[8 * s2 + 1]); wv.y = pk2(p[8 * s2 + 2], p[8 * s2 + 3]); wv.z = pk2(p[8 * s2 + 4], p[8 * s2 + 5]); wv.w = pk2(p[8 * s2 + 6], p[8 * s2 + 7]); Pf[s2] = __builtin_bit_cast(bf16x8, wv); }
#pragma unroll
        for (int s2 = 0; s2 < 2; ++s2)
#pragma unroll
            for (int ntl = 0; ntl < 2; ++ntl) {
                const int rowl = lr0 + 16 * s2 + 4 * hh + (li >> 2), rowh = rowl + 8; const int ch = 4 * ntl + 2 * (gq & 1) + ((li & 3) >> 1), sub = (li & 1) * 8;
                const s16x4 lo = __builtin_bit_cast(s16x4, __builtin_amdgcn_ds_read_tr16_b64_v4i16((LAS s16x4*)(F.lds + AT_V + rowl * 128 + ((ch ^ (rowl & 7)) * 16) + sub)));
                const s16x4 hi = __builtin_bit_cast(s16x4, __builtin_amdgcn_ds_read_tr16_b64_v4i16((LAS s16x4*)(F.lds + AT_V + rowh * 128 + ((ch ^ (rowh & 7)) * 16) + sub)));
                const bf16x8 vf = (bf16x8){lo[0], lo[1], lo[2], lo[3], hi[0], hi[1], hi[2], hi[3]};
                if (ntl == 0) O0 = __builtin_amdgcn_mfma_f32_32x32x16_bf16(Pf[s2], vf, O0, 0, 0, 0); else O1 = __builtin_amdgcn_mfma_f32_32x32x16_bf16(Pf[s2], vf, O1, 0, 0, 0);
            }
    }
    lsum = sum_xor32(lsum);
    if (hh == 0) lw[c] = lsum;
    LDS_BARRIER();
    { LAS float* ost = (LAS float*)(F.lds + w * 8192);
#pragma unroll
        for (int reg = 0; reg < 16; ++reg) { const int qrow = (reg & 3) + 8 * (reg >> 2) + 4 * hh; ost[qrow * 64 + c] = O0[reg]; ost[qrow * 64 + 32 + c] = O1[reg]; }
        LDS_WAIT();
        const int row = lane >> 1, half = lane & 1; const float l1 = lw[row]; const LAS f32x4* op = (const LAS f32x4*)(ost + row * 64 + 32 * half);
        const size_t tok = (size_t)b * SEQ + (size_t)((q0 + 32 * w + row) << dsh) + r;
        if (kind != 0) {
            bf16* pp = (bf16*)(F.ws + (kind == 1 ? WS_P4 : WS_P16)) + (tok * 8 + h) * 64 + 32 * half; const float inv = 1.f / l1;
#pragma unroll
            for (int q = 0; q < 4; ++q) *(bf16x8*)(pp + 8 * q) = pack8(op[2 * q] * inv, op[2 * q + 1] * inv);
            if (half == 0) ((float*)(F.ws + (kind == 1 ? WS_L4 : WS_L16)))[tok * 8 + h] = l1;
        } else {
            const bf16* p4 = (const bf16*)(F.ws + WS_P4) + (tok * 8 + h) * 64 + 32 * half; const bf16* p16 = (const bf16*)(F.ws + WS_P16) + (tok * 8 + h) * 64 + 32 * half;
            const float l4 = ((const float*)(F.ws + WS_L4))[tok * 8 + h], l16 = ((const float*)(F.ws + WS_L16))[tok * 8 + h]; const float inv = 1.f / (l1 + l4 + l16);
            bf16* dst = mix + tok * 1024 + 512 + h * 64 + 32 * half;
#pragma unroll
            for (int q = 0; q < 4; ++q) { const u32x4 a4 = *(const u32x4*)(p4 + 8 * q), a16 = *(const u32x4*)(p16 + 8 * q);
                const f32x4 x0 = (op[2 * q] + (f32x4){bflo(a4.x), bfhi(a4.x), bflo(a4.y), bfhi(a4.y)} * l4 + (f32x4){bflo(a16.x), bfhi(a16.x), bflo(a16.y), bfhi(a16.y)} * l16) * inv;
                const f32x4 x1 = (op[2 * q + 1] + (f32x4){bflo(a4.z), bfhi(a4.z), bflo(a4.w), bfhi(a4.w)} * l4 + (f32x4){bflo(a16.z), bfhi(a16.z), bflo(a16.w), bfhi(a16.w)} * l16) * inv;
                *(bf16x8*)(dst + 8 * q) = pack8(x0, x1); }
        }
    }
    LDS_BARRIER();
}

constexpr int RT_LCNT = 0, RT_BASE = 256, RT_RANK = 512;
__device__ __forceinline__ void route_phase(Frame& F, const Args& a) {
    const bf16* hsrc = (const bf16*)(F.ws + WS_HBF); const float* wrT = (const float*)(F.ws + WS_WRT); const float* b_r = a.in[13];
    int* te = (int*)(F.ws + WS_TE); int* tslot = (int*)(F.ws + WS_TSLOT); float* tg = (float*)(F.ws + WS_TG); int* list = (int*)(F.ws + WS_LIST); float* lrs = (float*)(F.ws + WS_LRS);
    LAS int* lcnt = (LAS int*)(F.lds + RT_LCNT); LAS int* lbase = (LAS int*)(F.lds + RT_BASE); LAS int* lrank = (LAS int*)(F.lds + RT_RANK);
    const int lane = F.lane, c = lane & 31, hh = lane >> 5;
    for (int blk = F.vcu; blk < T / 128; blk += F.G) {
        if (F.tid < 32) lcnt[F.tid] = 0;
        __syncthreads();
        int e4[4] = {0, 0, 0, 0}, rk[4] = {0, 0, 0, 0}; float g4[4] = {0.f, 0.f, 0.f, 0.f}; float rs = 0.f; const int tok = blk * 128 + (F.wave & 3) * 32 + c;
        f32x16 acc = {}; float ss = 0.f;
        { const int kh = F.wave >> 2; const bf16* hp = hsrc + (size_t)tok * D + 4 * hh + 512 * kh; const float* wp = wrT + (size_t)c * D + 4 * hh + 512 * kh;
#pragma unroll 8
            for (int q = 0; q < 64; ++q) { const u32x2 hr = *(const u32x2*)(hp + 8 * q); const f32x4 hv = {bflo(hr.x), bfhi(hr.x), bflo(hr.y), bfhi(hr.y)}, wv = *(const f32x4*)(wp + 8 * q);
                ss += (hv[0] * hv[0] + hv[1] * hv[1]) + (hv[2] * hv[2] + hv[3] * hv[3]);
#pragma unroll
                for (int i = 0; i < 4; ++i) acc = __builtin_amdgcn_mfma_f32_32x32x2f32(wv[i], hv[i], acc, 0, 0, 0); }
            LAS float* px = (LAS float*)(F.lds + 4096) + ((F.wave & 3) * 64 + lane) * 17;
            if (F.wave >= 4) {
#pragma unroll
                for (int r = 0; r < 16; ++r) px[r] = acc[r];
                px[16] = ss; }
            __syncthreads();
            if (F.wave < 4) {
#pragma unroll
                for (int r = 0; r < 16; ++r) acc[r] += px[r];
                ss += px[16]; } }
        if (F.wave < 4) {
            ss = sum_xor32(ss); rs = rsqrtf(ss * (1.f / D) + EPS);
            float tv[4] = {-3.0e38f, -3.0e38f, -3.0e38f, -3.0e38f}; int tix[4] = {0, 1, 2, 3};
            f32x4 brv[4];
#pragma unroll
            for (int q = 0; q < 4; ++q) brv[q] = *(const f32x4*)(b_r + 8 * q + 4 * hh);
#pragma unroll
            for (int reg = 0; reg < 16; ++reg) { const int e = (reg & 3) + 8 * (reg >> 2) + 4 * hh; float v = acc[reg] * rs + brv[reg >> 2][reg & 3]; int ix = e;
#pragma unroll
                for (int s = 0; s < 4; ++s) { const bool gt = (v > tv[s]) || (v == tv[s] && ix < tix[s]); const float ov = tv[s]; const int oi = tix[s]; tv[s] = gt ? v : ov; tix[s] = gt ? ix : oi; v = gt ? ov : v; ix = gt ? oi : ix; } }
            float pv[4]; int pi[4];
#pragma unroll
            for (int s = 0; s < 4; ++s) { pv[s] = __shfl_xor(tv[s], 32); pi[s] = __shfl_xor(tix[s], 32); }
#pragma unroll
            for (int t2 = 0; t2 < 4; ++t2) { float v = pv[t2]; int ix = pi[t2];
#pragma unroll
                for (int s = 0; s < 4; ++s) { const bool gt = (v > tv[s]) || (v == tv[s] && ix < tix[s]); const float ov = tv[s]; const int oi = tix[s]; tv[s] = gt ? v : ov; tix[s] = gt ? ix : oi; v = gt ? ov : v; ix = gt ? oi : ix; } }
            const float e0 = 1.f, e1 = __expf(tv[1] - tv[0]), e2 = __expf(tv[2] - tv[0]), e3 = __expf(tv[3] - tv[0]); const float inv = 1.f / (e0 + e1 + e2 + e3);
            g4[0] = e0 * inv; g4[1] = e1 * inv; g4[2] = e2 * inv; g4[3] = e3 * inv;
#pragma unroll
            for (int s = 0; s < 4; ++s) e4[s] = tix[s];
            if (hh == 0) {
#pragma unroll
                for (int s = 0; s < 4; ++s) rk[s] = atomicAdd((int*)(lcnt + e4[s]), 1);
            }
        }
        __syncthreads();
        if (F.tid < 32) lbase[F.tid] = (int)__hip_atomic_fetch_add(F.ctl + CW_GCNT + 64 * F.tid, (unsigned)lcnt[F.tid], RLX_AGENT);
        __syncthreads();
        if (F.wave < 4 && hh == 0) {
#pragma unroll
            for (int s = 0; s < 4; ++s) { const int slot = lbase[e4[s]] + rk[s]; te[tok * 4 + s] = e4[s]; tslot[tok * 4 + s] = slot; tg[tok * 4 + s] = g4[s];
                list[(size_t)e4[s] * LCAP + slot] = tok; lrs[(size_t)e4[s] * LCAP + slot] = rs; }
        }
        __syncthreads();
    }
}
__device__ __forceinline__ int moe_tables(Frame& F) {
    LAS int* tstart = (LAS int*)(F.lds + MOE_TSTART); LAS int* lcnt = (LAS int*)(F.lds + MOE_LCNT); LAS int* texp = (LAS int*)(F.lds + MOE_TEXP);
    if (F.tid < 64) {
        const int lane = F.lane; const int cnt = lane < NE ? (int)__hip_atomic_load(F.ctl + CW_GCNT + 64 * (lane & 31), RLX_AGENT) : 0; const int nt = (cnt + 255) >> 8;
        int inc = nt;
#pragma unroll
        for (int o = 1; o < 32; o <<= 1) { const int up = __shfl_up(inc, o); if (lane >= o) inc += up; }
        if (lane < NE) { const int start = inc - nt; lcnt[lane] = cnt; tstart[lane] = start; for (int i = 0; i < nt; ++i) texp[start + i] = lane; if (lane == NE - 1) tstart[NE] = inc; }
    }
    __syncthreads();
    return tstart[NE];
}
__device__ __forceinline__ void combine_phase(Frame& F, const Args& a, float* dst) {
    LAS int* tstart = (LAS int*)(F.lds + MOE_TSTART);
    const int* te = (const int*)(F.ws + WS_TE); const int* tslot = (const int*)(F.ws + WS_TSLOT); const float* tg = (const float*)(F.ws + WS_TG); const unsigned char* Y = F.ws + WS_Y;
    const bf16* hbf = (const bf16*)(F.ws + WS_HBF); const int gw = F.vcu * NWAVES + F.wave, NGW = F.G * NWAVES, lane = F.lane;
    for (int t0 = gw * 16; t0 < T; t0 += NGW * 16) {
        int pos[4]; float gt[4];
        { const int tl = t0 + (lane & 15);
#pragma unroll
            for (int s = 0; s < 4; ++s) { const int e = te[tl * 4 + s]; pos[s] = tstart[e] * 256 + tslot[tl * 4 + s]; gt[s] = tg[tl * 4 + s]; } }
#pragma unroll 1
        for (int i = 0; i < 16; i += 2) {
            f32x4 o[2][4]; u32x4 w[2][4];
#pragma unroll
            for (int q = 0; q < 2; ++q) { const bf16* hp = hbf + (size_t)(t0 + i + q) * D + 16 * lane;
#pragma unroll
                for (int j = 0; j < 2; ++j) { const u32x4 hr = *(const u32x4*)(hp + 8 * j); o[q][2 * j] = (f32x4){bflo(hr.x), bfhi(hr.x), bflo(hr.y), bfhi(hr.y)}; o[q][2 * j + 1] = (f32x4){bflo(hr.z), bfhi(hr.z), bflo(hr.w), bfhi(hr.w)}; }
#pragma unroll
                for (int s = 0; s < 4; ++s) { const size_t p = (size_t)__builtin_amdgcn_readlane(pos[s], i + q); w[q][s] = *(const u32x4*)(Y + p * D + 16 * lane); } }
#pragma unroll
            for (int q = 0; q < 2; ++q) { float* op = dst + (size_t)(t0 + i + q) * D + 16 * lane;
#pragma unroll
                for (int s = 0; s < 4; ++s) { const float g = __builtin_bit_cast(float, __builtin_amdgcn_readlane(__builtin_bit_cast(int, gt[s]), i + q));
#pragma unroll
                    for (int j = 0; j < 4; ++j) { const int ww = (int)w[q][s][j]; const f32x2 lo = __builtin_amdgcn_cvt_pk_f32_fp8(ww, false), hi = __builtin_amdgcn_cvt_pk_f32_fp8(ww, true);
                        o[q][j] += (f32x4){lo[0], lo[1], hi[0], hi[1]} * g; } }
#pragma unroll
                for (int j = 0; j < 4; ++j) *(f32x4*)(op + 4 * j) = o[q][j]; }
        }
    }
}

constexpr int NPHASE = 9;
__global__ void __launch_bounds__(NTHREADS, 2) hymba_fwd(Args args) {
    extern __shared__ __attribute__((aligned(16))) unsigned char lds_raw[];
    Frame F; F.lds = (LAS unsigned char*)lds_raw; F.ws = args.ws; F.ctl = (unsigned*)(args.ws + WS_CTL);
    F.tid = threadIdx.x; F.lane = F.tid & 63; F.wave = __builtin_amdgcn_readfirstlane(F.tid >> 6);
    F.G = gridDim.x; { const int bx = blockIdx.x; F.vcu = (F.G % 8 == 0) ? (bx % 8) * (F.G / 8) + bx / 8 : bx; }
    volatile LAS unsigned* MISC = (volatile LAS unsigned*)(F.lds + MISC_OFF);
    if (F.tid < 32) MISC[F.tid] = 0u;
    __syncthreads();
    XcdBarrier bar; bar.bar = F.ctl + CW_BAR; bar.x = 0; bar.st = nullptr;
    if (MK_N_LAUNCHES == 1) bar = xcd_barrier_post(F.ctl + CW_BAR, MISC + 8);
    const int lo = args.ph_lo, hi = args.ph_hi;
#define IN(k) (lo <= (k) && (k) < hi)
#define SEAM(k) do { if (IN(k) && IN((k) + 1)) xcd_barrier(bar); } while (0)

    if (IN(0)) { for (int rep = 0; rep < (DUP == 4 ? 2 : 1); ++rep) phase0(F, args); SEAM(0); }
    if (IN(1)) {
        pg8::Gemm g{(const bf16*)(F.ws + WS_XN), (const bf16*)(F.ws + WS_WIN), D}; pg8::StaticOrder S{T / 256, NIN / 256, F.G, (int)blockIdx.x};
        pg8::EpiInProj E{(bf16*)(F.ws + WS_ZG), (bf16*)(F.ws + WS_QB), (bf16*)(F.ws + WS_KB), (bf16*)(F.ws + WS_VB), args.in[7], args.in[8], F.lds + RING_BYTES, args.in[6]};
        pg8::gemm_phase<pg8::EpiInProj, pg8::StaticOrder, false, true>(F.lds, g, S, E);
#if DUP == 5
        __syncthreads(); pg8::gemm_phase<pg8::EpiInProj, pg8::StaticOrder, false, true>(F.lds, g, S, E);
#endif
        SEAM(1);
    }
    if (IN(2)) {
        for (int rep = 0; rep < (DUP == 1 ? 2 : 1); ++rep)
        for (int u = F.vcu; u < NBATCH * GH * NCHUNK; u += F.G) gdn_prep_unit(F, args, u, u + F.G < NBATCH * GH * NCHUNK ? u + F.G : -1);
        SEAM(2);
    }
    if (IN(3)) {
        const int nscan = NBATCH * GH;
        for (int rep3 = 0; rep3 < (DUP == 13 ? 2 : 1); ++rep3) {
        for (int bh = blockIdx.x; bh < nscan; bh += F.G) { gdn_scan(F, args, bh);
#if DUP == 3
            gdn_scan(F, args, bh);
#endif
        }
        if (rep3 == 0) { if (F.G > nscan) { if ((int)blockIdx.x >= nscan) { p0_experts(F, args, ((int)blockIdx.x - nscan) * NWAVES + F.wave, (F.G - nscan) * NWAVES);
#if DUP == 15
            __syncthreads(); p0_experts(F, args, ((int)blockIdx.x - nscan) * NWAVES + F.wave, (F.G - nscan) * NWAVES);
#endif
            } } else p0_experts(F, args, (int)blockIdx.x * NWAVES + F.wave, F.G * NWAVES); __syncthreads(); }
        for (int pass = 0; pass < 2; ++pass) {
            for (int rep = 0; rep < (DUP == 2 ? 2 : 1); ++rep)
            for (;;) {
                if (F.tid == 0) MISC[16] = __hip_atomic_fetch_add(F.ctl + CW_ATTQ + 64 * (pass + 2 * rep + 4 * rep3), 1u, RLX_AGENT);
                __syncthreads();
                const int u = (int)MISC[16] + (pass ? 2048 : 0);
                __syncthreads();
                if (u >= (pass ? 3072 : 2048)) break;
                attn_unit(F, args, u);
            }
            if (pass == 0 || DUP == 13) xcd_barrier(bar);
        } }
        SEAM(3);
    }
    if (IN(4)) {
        pg8::Gemm g{(const bf16*)(F.ws + WS_MIX), (const bf16*)(F.ws + WS_WOUT), D}; pg8::StaticOrder S{T / 256, D / 256, F.G, (int)blockIdx.x};
        pg8::EpiOutProj E{args.in[0], (bf16*)(F.ws + WS_HBF), F.ws + WS_HB, F.lds + RING_BYTES};
        pg8::gemm_phase<pg8::EpiOutProj, pg8::StaticOrder, false, true>(F.lds, g, S, E);
#if DUP == 6
        __syncthreads(); pg8::gemm_phase<pg8::EpiOutProj, pg8::StaticOrder, false, true>(F.lds, g, S, E);
#endif
        SEAM(4);
    }
#if !SKIP_MOE
    if (IN(5)) {
        if (DUP == 10) { route_phase(F, args); xcd_barrier(bar); if (blockIdx.x == 0 && F.tid < 32) __hip_atomic_store(F.ctl + CW_GCNT + 64 * F.tid, 0u, RLX_AGENT); xcd_barrier(bar); }
        route_phase(F, args); SEAM(5); }
    if (IN(6)) {
        const int nM = moe_tables(F);
        pg8::Gemm g{(const bf16*)(F.ws + WS_HB), (const bf16*)(F.ws + WS_WGU), D};
        pg8::MoeOrder S{nM, 8, F.G, (int)blockIdx.x, (const LAS int*)(F.lds + MOE_TSTART), (const LAS int*)(F.lds + MOE_LCNT), (const LAS int*)(F.lds + MOE_TEXP), (const int*)(F.ws + WS_LIST)};
        pg8::EpiGateUp E{F.ws + WS_ACT, args.in[15], (const float*)(F.ws + WS_LRS), (const LAS int*)(F.lds + MOE_LCNT)};
        pg8::gemm_phase<pg8::EpiGateUp, pg8::MoeOrder, true, true, true>(F.lds, g, S, E);
#if DUP == 7
        __syncthreads(); pg8::gemm_phase<pg8::EpiGateUp, pg8::MoeOrder, true, true, true>(F.lds, g, S, E);
#endif
        SEAM(6);
    }
    if (IN(7)) {
        const int nM = moe_tables(F);
        pg8::Gemm g{(const bf16*)(F.ws + WS_ACT), (const bf16*)(F.ws + WS_WDN), FF};
        pg8::MoeOrder S{nM, 4, F.G, (int)blockIdx.x, (const LAS int*)(F.lds + MOE_TSTART), (const LAS int*)(F.lds + MOE_LCNT), (const LAS int*)(F.lds + MOE_TEXP), (const int*)(F.ws + WS_LIST)};
        pg8::EpiDown E{F.ws + WS_Y, args.in[17], F.lds + RING_BYTES};
        pg8::gemm_phase<pg8::EpiDown, pg8::MoeOrder, false, true, true>(F.lds, g, S, E);
#if DUP == 8
        __syncthreads(); pg8::gemm_phase<pg8::EpiDown, pg8::MoeOrder, false, true, true>(F.lds, g, S, E);
#endif
        SEAM(7);
    }
#if DUP == 16
    if (IN(8)) { for (int i_ = 0; i_ < 8; ++i_) xcd_barrier(bar); }
#endif
    if (IN(8)) { (void)moe_tables(F); if (DUP == 11) combine_phase(F, args, (float*)(F.ws + WS_ZG)); combine_phase(F, args, args.out); }
#endif
#undef IN
#undef SEAM
}

extern "C" void kernel_launch(void* const* d_in, const int* in_sizes, int n_in, void* d_out, int out_size, void* d_ws, size_t ws_size, hipStream_t stream) {
    static int grid = 0;
    if (grid == 0) {
        if (n_in != 18 || in_sizes[0] != T * D || out_size != T * D || ws_size < WS_END) { fprintf(stderr, "kernel_launch: unexpected shapes (n_in %d, in0 %d, out %d, ws %zu)\n", n_in, n_in > 0 ? in_sizes[0] : -1, out_size, ws_size); grid = -1; return; }
        int dev = 0, cus = 0, per_cu = 0;
        if (hipGetDevice(&dev) != hipSuccess || hipDeviceGetAttribute(&cus, hipDeviceAttributeMultiprocessorCount, dev) != hipSuccess) { grid = -1; return; }
        if (hipFuncSetAttribute((const void*)hymba_fwd, hipFuncAttributeMaxDynamicSharedMemorySize, LDS_BYTES) != hipSuccess) { fprintf(stderr, "kernel_launch: hipFuncSetAttribute failed\n"); grid = -1; return; }
        if (hipOccupancyMaxActiveBlocksPerMultiprocessor(&per_cu, (const void*)hymba_fwd, NTHREADS, LDS_BYTES) != hipSuccess || per_cu < 1) { fprintf(stderr, "kernel_launch: occupancy query says %d\n", per_cu); per_cu = 1; }
        (void)hipGetLastError();
        grid = cus;
    }
    if (grid < 0) return;
    (void)hipMemsetAsync((char*)d_ws + WS_CTL, 0, CTL_ZERO_BYTES, stream);
    Args a{};
    for (int i = 0; i < 18; ++i) a.in[i] = (const float*)d_in[i];
    a.out = (float*)d_out; a.ws = (unsigned char*)d_ws;
    if (MK_N_LAUNCHES == 1) {
        a.ph_lo = 0; a.ph_hi = NPHASE; a.li = 0;
        void* kargs[] = {&a};
        hipError_t e = hipLaunchCooperativeKernel((const void*)hymba_fwd, dim3(grid), dim3(NTHREADS), kargs, LDS_BYTES, stream);
        if (e != hipSuccess) fprintf(stderr, "kernel_launch: cooperative launch failed: %s (grid %d)\n", hipGetErrorString(e), grid);
    } else {
        for (int p = 0; p < NPHASE; ++p) { a.ph_lo = p; a.ph_hi = p + 1; a.li = p; hipLaunchKernelGGL(hymba_fwd, dim3(grid), dim3(NTHREADS), LDS_BYTES, stream, a); }
    }
}
```

```cpp
#include <hip/hip_runtime.h>
#include <cstdio>
#include <cstdint>

#ifndef MK_N_LAUNCHES
#define MK_N_LAUNCHES 1
#endif
#ifndef SKIP_ATTN
#define SKIP_ATTN 0
#endif
#ifndef DUP
#define DUP 0
#endif
#ifndef ATT_JOBS
#define ATT_JOBS 32
#endif
#ifndef SKIP_MOE
#define SKIP_MOE 0
#endif

#define LAS __attribute__((address_space(3)))
#define GAS __attribute__((address_space(1)))
typedef unsigned short bf16;
typedef short bf16x8 __attribute__((ext_vector_type(8)));
typedef short s16x4 __attribute__((ext_vector_type(4)));
typedef float f32x2 __attribute__((ext_vector_type(2)));
typedef float f32x4 __attribute__((ext_vector_type(4)));
typedef float f32x16 __attribute__((ext_vector_type(16)));
typedef unsigned u32x2 __attribute__((ext_vector_type(2)));
typedef unsigned u32x4 __attribute__((ext_vector_type(4)));
typedef __bf16 bf16x2_t __attribute__((ext_vector_type(2)));
typedef int v4i_t __attribute__((ext_vector_type(4)));
typedef int v8i_t __attribute__((ext_vector_type(8)));

constexpr int NBATCH = 8, SEQ = 4096, D = 1024, T = NBATCH * SEQ;
constexpr int IN_DIM = 3592, NIN = 3584;
constexpr int GH = 4, DK = 128, CHUNK = 64, NCHUNK = SEQ / CHUNK;
constexpr int AH = 8, DH = 64;
constexpr int NE = 32, FF = 1024, LCAP = 32768;
constexpr float EPS = 1e-6f, LOG2E = 1.4426950408889634f;
constexpr int NWAVES = 8, NTHREADS = 512;

constexpr size_t MiB = 1u << 20;
constexpr size_t WS_CTL = 0, CTL_ZERO_BYTES = 64 * 1024;
constexpr size_t WS_WIN = 1 * MiB, WS_WOUT = 8 * MiB, WS_WGU = 10 * MiB, WS_WDN = 138 * MiB;
constexpr size_t WS_TE = 202 * MiB, WS_TSLOT = WS_TE + 512 * 1024, WS_TG = WS_TSLOT + 512 * 1024;
constexpr size_t WS_LIST = 204 * MiB, WS_LRS = 208 * MiB;
constexpr size_t WS_BA = 212 * MiB, WS_WRT = 213 * MiB;
constexpr size_t WS_ZG = 214 * MiB, WS_QB = 342 * MiB, WS_KB = 374 * MiB, WS_VB = 406 * MiB;
constexpr size_t WS_PREP = 438 * MiB;
constexpr int PREP_WP = 0, PREP_QP = 16384, PREP_AP = 32768, PREP_KT = 40960, PREP_UP = 57344, PREP_CD = 90112, PREP_REC = 90368;
constexpr size_t WS_OG = 616 * MiB, WS_MIX = 680 * MiB;
constexpr size_t WS_XN = 760 * MiB, WS_HB = 760 * MiB;
constexpr size_t WS_ACT = 214 * MiB, WS_Y = 352 * MiB, WS_HBF = 488 * MiB, WS_END = 824 * MiB;
static_assert(WS_VB - WS_KB == WS_KB - WS_QB, "q/k/v stride");
static_assert(WS_PREP + (size_t)NBATCH * GH * NCHUNK * PREP_REC <= WS_OG, "prep region");
static_assert(WS_ACT + (size_t)(T * 4 + NE * 256) * FF <= WS_Y && WS_Y + (size_t)(T * 4 + NE * 256) * D <= WS_HBF && WS_HBF + (size_t)T * D * 2 <= 616 * MiB, "act/y/h regions");
constexpr int CW_TMO = 0, CW_CODE = 1, CW_ATTQ = 512, CW_GCNT = 1024  , CW_BAR = 8192;
static_assert((CW_BAR + 3456) * 4 <= (int)CTL_ZERO_BYTES && CW_GCNT + 64 * 32 <= CW_BAR, "control words inside the zeroed region");

constexpr int LDS_BYTES = 160 * 1024;
constexpr int RING_BYTES = 131072;
constexpr int TOP_OFF = LDS_BYTES - 4096;
constexpr int MISC_OFF = TOP_OFF;
constexpr int MOE_TAB_OFF = TOP_OFF + 256;
constexpr int MOE_TSTART = MOE_TAB_OFF, MOE_LCNT = MOE_TAB_OFF + 256, MOE_TEXP = MOE_TAB_OFF + 512;

#define RLX_AGENT __ATOMIC_RELAXED, __HIP_MEMORY_SCOPE_AGENT
#define LDS_WAIT() asm volatile("s_waitcnt lgkmcnt(0)" ::: "memory")
#define VM_WAIT() asm volatile("s_waitcnt vmcnt(0)" ::: "memory")
#define LDS_BARRIER() do { asm volatile("s_waitcnt lgkmcnt(0)" ::: "memory"); __builtin_amdgcn_s_barrier(); asm volatile("" ::: "memory"); } while (0)
__device__ __forceinline__ unsigned pk2(float lo, float hi) { f32x2 v = {lo, hi}; bf16x2_t b = __builtin_convertvector(v, bf16x2_t); return __builtin_bit_cast(unsigned, b); }
__device__ __forceinline__ unsigned pk4_fp8(float a, float b, float c, float d) { int w = 0; w = __builtin_amdgcn_cvt_pk_fp8_f32(a, b, w, false); w = __builtin_amdgcn_cvt_pk_fp8_f32(c, d, w, true); return (unsigned)w; }
__device__ __forceinline__ float bf2f(unsigned short b) { return __uint_as_float((unsigned)b << 16); }
__device__ __forceinline__ float bflo(unsigned w) { return __uint_as_float(w << 16); }
__device__ __forceinline__ float bfhi(unsigned w) { return __uint_as_float(w & 0xffff0000u); }
template <int CTRL> __device__ __forceinline__ float dpp_mov(float v) { return __builtin_bit_cast(float, __builtin_amdgcn_update_dpp(0, __builtin_bit_cast(int, v), CTRL, 0xF, 0xF, true)); }
__device__ __forceinline__ float sum_row16(float v) {
    v += dpp_mov<0xB1>(v);
    v += dpp_mov<0x4E>(v);
    v += dpp_mov<0x141>(v);
    v += dpp_mov<0x140>(v);
    return v; }
__device__ __forceinline__ float sum_xor16(float v) { const unsigned u = __builtin_bit_cast(unsigned, v); auto r = __builtin_amdgcn_permlane16_swap(u, u, false, false); return __builtin_bit_cast(float, (unsigned)r[0]) + __builtin_bit_cast(float, (unsigned)r[1]); }
__device__ __forceinline__ float sum_xor32(float v) { const unsigned u = __builtin_bit_cast(unsigned, v); auto r = __builtin_amdgcn_permlane32_swap(u, u, false, false); return __builtin_bit_cast(float, (unsigned)r[0]) + __builtin_bit_cast(float, (unsigned)r[1]); }
__device__ __forceinline__ float wave_sum(float v) { return sum_xor32(sum_xor16(sum_row16(v))); }
__device__ __forceinline__ float silu_f(float x) { return x * __builtin_amdgcn_rcpf(1.f + __expf(-x)); }
__device__ __forceinline__ float sigmoid_f(float x) { return __builtin_amdgcn_rcpf(1.f + __expf(-x)); }
__device__ __forceinline__ bf16x8 pack8(f32x4 a, f32x4 b) {
    u32x4 w; w.x = pk2(a[0], a[1]); w.y = pk2(a[2], a[3]); w.z = pk2(b[0], b[1]); w.w = pk2(b[2], b[3]); return __builtin_bit_cast(bf16x8, w);
}

__device__ __forceinline__ void glds16_asm(const void* gsrc, unsigned lds_dst) { unsigned keep;
    asm volatile("s_mov_b32 %0, m0\n\ts_mov_b32 m0, %2\n\ts_nop 0\n\tglobal_load_lds_dwordx4 %1, off\n\ts_mov_b32 m0, %0\n\ts_nop 0" : "=&s"(keep) : "v"(gsrc), "s"(lds_dst) : "memory"); }

namespace pg8 {
constexpr int BM = 256, BK = 64, HALF = 128, HTB = HALF * BK * 2, STAGE_BYTES = 8 * HTB, NXCD = 8, WGM = 8;
__host__ __device__ __forceinline__ int lds_byte(int r, int c) { const int st = (r >> 4) * 2 + (c >> 5), rr = r & 15, cc = c & 31, ob = rr * 64 + cc * 2; return st * 1024 + (ob ^ (((ob >> 9) & 1) << 5)); }
__host__ __device__ __forceinline__ void stage_rc(int b, int& R, int& C) { const int st = b / 1024, sb = b % 1024, swz = sb ^ (((sb >> 9) & 1) << 5); R = (st >> 1) * 16 + swz / 64; C = (st & 1) * 32 + (swz % 64) / 2; }
__host__ __device__ __forceinline__ int perm32(int rho) { const int n = rho >> 4, i = rho & 15; return 8 * (i >> 2) + 4 * n + (i & 3); }

struct Unit { int pm, pn, pb, e, mt; };
struct Gemm { const bf16* A; const bf16* Bt; int K; };

__device__ __forceinline__ bool static_tile(int i, int G, int c, int nM, int nN, int& pm, int& pn) {
    const int nwg = nM * nN; const long L = (long)i * G + c; if (L >= nwg) return false;
    int wgid = (int)L; { const int q = nwg / NXCD, r = nwg % NXCD, xcd = wgid % NXCD, off = wgid / NXCD; wgid = (xcd < r ? xcd * (q + 1) : r * (q + 1) + (xcd - r) * q) + off; }
    const int nig = WGM * nN, gid = wgid / nig, fm = gid * WGM, gsz = (nM - fm) < WGM ? (nM - fm) : WGM;
    pm = fm + ((wgid % nig) % gsz); pn = (wgid % nig) / gsz; return true;
}
struct StaticOrder {
    int nM, nN, G, c;
    __device__ __forceinline__ bool next(int i, Unit& u) const { int pm, pn; if (!static_tile(i, G, c, nM, nN, pm, pn)) return false; u.pm = pm; u.pn = pn; u.pb = pn; u.e = 0; u.mt = 0; return true; }
    __device__ __forceinline__ int row_index(const Unit&, int) const { return 0; }
};
struct MoeOrder {
    int nM, nN, G, c; const LAS int* tstart; const LAS int* lcnt; const LAS int* texp; const int* list;
    __device__ __forceinline__ bool next(int i, Unit& u) const {
        int pm, pn; if (!static_tile(i, G, c, nM, nN, pm, pn)) return false;
        const int e = texp[pm]; u.pm = pm; u.pn = pn; u.e = e; u.pb = e * nN + pn; u.mt = pm - tstart[e]; return true;
    }
    __device__ __forceinline__ int row_index(const Unit& u, int r) const { const int rr = u.mt * 256 + r; const int v = list[u.e * LCAP + rr]; return rr < lcnt[u.e] ? v : 0; }
};

#define PG8_SA(b, h) (((b) * 2 + (h)) * HTB)
#define PG8_SB(b, h) ((4 + (b) * 2 + (h)) * HTB)
#define PG8_GLDS(src, dstoff) __builtin_amdgcn_global_load_lds((const unsigned*)(src), (LAS unsigned*)(lds + (dstoff)), 16, 0, 0)
#define PG8_STAGE_B(bufoff, nx, kb, h) do { _Pragma("unroll") for (int _i = 0; _i < 2; ++_i) \
        PG8_GLDS(((nx) ? nB : cB) + (kb) + (Epi::WIDE ? (size_t)voffBW[h][_i] : (size_t)(h) * hstep + voffB[_i]), (bufoff) + ldsw + _i * 8192); } while (0)
#define PG8_STAGE_A(bufoff, nx, kb, h) do { _Pragma("unroll") for (int _i = 0; _i < 2; ++_i) \
        PG8_GLDS(GATHER ? (const char*)g.A + (kb) + ((nx) ? voffN[h][_i] : voffC[h][_i]) : ((nx) ? nA : cA) + (kb) + (size_t)(h) * hstep + voffA[_i], (bufoff) + ldsw + _i * 8192); } while (0)
#define PG8_LDA8(dst, b, h) do { _Pragma("unroll") for (int m = 0; m < 4; ++m) { const v4i_t lo_ = *(const LAS v4i_t*)(lds + PG8_SA(b, h) + aoff + m * 2048), hi_ = *(const LAS v4i_t*)(lds + PG8_SA(b, h) + aoff + m * 2048 + 1024); dst[m] = __builtin_shufflevector(lo_, hi_, 0, 1, 2, 3, 4, 5, 6, 7); } } while (0)
#define PG8_LDB8(dst, b, h) do { _Pragma("unroll") for (int n = 0; n < 2; ++n) { const v4i_t lo_ = *(const LAS v4i_t*)(lds + PG8_SB(b, h) + boff + n * 2048), hi_ = *(const LAS v4i_t*)(lds + PG8_SB(b, h) + boff + n * 2048 + 1024); dst[n] = __builtin_shufflevector(lo_, hi_, 0, 1, 2, 3, 4, 5, 6, 7); } } while (0)
#define PG8_LDA(dst, b, h) do { _Pragma("unroll") for (int m = 0; m < 4; ++m) _Pragma("unroll") for (int k = 0; k < 2; ++k) dst[m][k] = *(const LAS bf16x8*)(lds + PG8_SA(b, h) + aoff + m * 2048 + k * 1024); } while (0)
#define PG8_LDB(dst, b, h) do { _Pragma("unroll") for (int n = 0; n < 2; ++n) _Pragma("unroll") for (int k = 0; k < 2; ++k) dst[n][k] = *(const LAS bf16x8*)(lds + PG8_SB(b, h) + boff + n * 2048 + k * 1024); } while (0)
#define PG8_MMA(ai, bj, At, Bt) do { __builtin_amdgcn_s_setprio(1); _Pragma("unroll") for (int m = 0; m < 4; ++m) _Pragma("unroll") for (int n = 0; n < 2; ++n) _Pragma("unroll") for (int k = 0; k < 2; ++k) \
        acc[ai][bj][m][n] = __builtin_amdgcn_mfma_f32_16x16x32_bf16(Bt[n][k], At[m][k], acc[ai][bj][m][n], 0, 0, 0); __builtin_amdgcn_s_setprio(0); } while (0)
#define PG8_MMA8(ai, bj, At, Bt) do { __builtin_amdgcn_s_setprio(1); _Pragma("unroll") for (int m = 0; m < 4; ++m) _Pragma("unroll") for (int n = 0; n < 2; ++n) \
        asm volatile("v_mfma_scale_f32_16x16x128_f8f6f4 %0, %1, %2, %0, %3, %4 op_sel_hi:[0,0,0]" : "+v"(acc[ai][bj][m][n]) : "v"(Bt[n]), "v"(At[m]), "v"(sc_w), "v"(sc_a)); __builtin_amdgcn_s_setprio(0); } while (0)
#define XLDA(b, h) do { if constexpr (FP8) PG8_LDA8(At8, b, h); else PG8_LDA(At, b, h); } while (0)
#define XLDB0(b, h) do { if constexpr (FP8) PG8_LDB8(B08, b, h); else PG8_LDB(B0, b, h); } while (0)
#define XLDB1(b, h) do { if constexpr (FP8) PG8_LDB8(B18, b, h); else PG8_LDB(B1, b, h); } while (0)
#define XMMA0(ai, bj) do { if constexpr (FP8) PG8_MMA8(ai, bj, At8, B08); else PG8_MMA(ai, bj, At, B0); } while (0)
#define XMMA1(ai, bj) do { if constexpr (FP8) PG8_MMA8(ai, bj, At8, B18); else PG8_MMA(ai, bj, At, B1); } while (0)
#define PG8_WAIT_V(n) asm volatile("s_waitcnt vmcnt(" #n ")" ::: "memory")
#define PG8_WAIT_L(n) asm volatile("s_waitcnt lgkmcnt(" #n ")" ::: "memory")
#define PG8_BAR __builtin_amdgcn_s_barrier()
#define PG8_SCHED __builtin_amdgcn_sched_barrier(0)

template <class Epi, class Sched, bool GATHER, bool ALIGN_EPI, bool FP8 = false, int KREP = 1>
__device__ __forceinline__ void gemm_phase(LAS unsigned char* lds, const Gemm g, const Sched& S, const Epi& E) {
    const int tid = threadIdx.x, wid = __builtin_amdgcn_readfirstlane(tid >> 6), lane = tid & 63, wr = wid >> 2, wc = wid & 3, fr = lane & 15, fq = lane >> 4;
    const int K = g.K, rowb = FP8 ? K : 2 * K, nt = rowb / 128;
    unsigned voffA[2], voffB[2], voffBW[2][2], voffC[2][2], voffN[2][2]; int RA[2], CA[2];
#pragma unroll
    for (int i = 0; i < 2; ++i) { int R, C; stage_rc(tid * 16 + i * 8192, R, C); const int Rb = Epi::PERM ? ((R & ~31) + perm32(R & 31)) : R;
        RA[i] = R; CA[i] = C; voffA[i] = (unsigned)(R * rowb + C * 2); voffB[i] = (unsigned)(Rb * rowb + C * 2);
        voffBW[0][i] = (unsigned)((64 * (R >> 5) + perm32(R & 31)) * rowb + C * 2); voffBW[1][i] = (unsigned)((64 * (R >> 5) + 32 + perm32(R & 31)) * rowb + C * 2); }
    const size_t kstep = (size_t)(BK * 2), hstep = (size_t)HALF * rowb, tstep = 2 * hstep;
    const unsigned ldsw = (unsigned)wid * 1024u;
    const int aoff = lds_byte(wr * 64 + fr, fq * 8), boff = lds_byte(wc * 32 + fr, fq * 8);
    Unit cur, nxt; int ui = 0;
    if (!S.next(0, cur)) return;
    f32x4 acc[2][2][4][2];
#pragma unroll
    for (int a = 0; a < 2; ++a)
#pragma unroll
        for (int b = 0; b < 2; ++b)
#pragma unroll
            for (int m = 0; m < 4; ++m)
#pragma unroll
                for (int n = 0; n < 2; ++n) acc[a][b][m][n] = (f32x4){0.f, 0.f, 0.f, 0.f};
    bf16x8 At[4][2], B0[2][2], B1[2][2]; v8i_t At8[4], B08[2], B18[2]; int sc_w = 0x7a7a7a7a, sc_a = 0x7f7f7f7f; asm volatile("" : "+v"(sc_w), "+v"(sc_a));
    const char* cA = (const char*)g.A + (size_t)cur.pm * tstep; const char* cB = (const char*)g.Bt + (size_t)cur.pb * tstep;
    if (GATHER) {
#pragma unroll
        for (int h = 0; h < 2; ++h)
#pragma unroll
            for (int i = 0; i < 2; ++i) { voffC[h][i] = (unsigned)(S.row_index(cur, RA[i] + 128 * h) * rowb + CA[i] * 2); voffN[h][i] = voffC[h][i]; }
    }
    const char* nA = cA; const char* nB = cB;
    E.prefetch(cur, 0, wid, lane);
    PG8_STAGE_B(PG8_SB(0, 0), false, 0, 0); PG8_STAGE_B(PG8_SB(0, 1), false, 0, 1); PG8_STAGE_A(PG8_SA(0, 0), false, 0, 0); PG8_STAGE_A(PG8_SA(0, 1), false, 0, 1);
    if (wr == 1) PG8_BAR;
    PG8_WAIT_V(2); PG8_BAR;
    PG8_STAGE_B(PG8_SB(1, 0), false, kstep, 0); PG8_STAGE_A(PG8_SA(1, 0), false, kstep, 0); PG8_STAGE_B(PG8_SB(1, 1), false, kstep, 1);
    PG8_WAIT_V(6); PG8_BAR;
    for (;;) {
        const bool has_next = S.next(ui + 1, nxt);
        if (has_next) E.prefetch(nxt, (ui + 1) % 3, wid, lane);
        nA = has_next ? (const char*)g.A + (size_t)nxt.pm * tstep : cA; nB = has_next ? (const char*)g.Bt + (size_t)nxt.pb * tstep : cB;
        if (GATHER) {
            if (has_next) { int ix[2][2];
#pragma unroll
                for (int h = 0; h < 2; ++h)
#pragma unroll
                    for (int i = 0; i < 2; ++i) ix[h][i] = S.row_index(nxt, RA[i] + 128 * h);
#pragma unroll
                for (int h = 0; h < 2; ++h)
#pragma unroll
                    for (int i = 0; i < 2; ++i) voffN[h][i] = (unsigned)(ix[h][i] * rowb + CA[i] * 2);
            } else {
#pragma unroll
                for (int h = 0; h < 2; ++h)
#pragma unroll
                    for (int i = 0; i < 2; ++i) voffN[h][i] = voffC[h][i]; }
        }
        for (int t = 0; t < nt * KREP; t += 2) {
            const bool last = (t == nt * KREP - 2);
            const int tm = t % nt; const size_t k1 = (size_t)(tm + 1) * kstep, k2 = last ? 0 : (size_t)((tm + 2) % nt) * kstep, k3 = k2 + kstep;
            XLDB0(0, 0); XLDB1(0, 1); PG8_SCHED; XLDA(0, 0); PG8_STAGE_A(PG8_SA(1, 1), false, k1, 1);
            PG8_WAIT_V(8); PG8_WAIT_L(0); PG8_BAR; XMMA0(0, 0); XMMA1(0, 1); PG8_BAR; PG8_SCHED;
            XLDA(0, 1); PG8_STAGE_B(PG8_SB(0, 0), last, k2, 0); PG8_STAGE_B(PG8_SB(0, 1), last, k2, 1); PG8_STAGE_A(PG8_SA(0, 0), last, k2, 0);
            PG8_WAIT_V(8); PG8_WAIT_L(0); PG8_BAR; XMMA0(1, 0); XMMA1(1, 1); PG8_BAR; PG8_SCHED;
            XLDB0(1, 0); XLDB1(1, 1); PG8_SCHED; XLDA(1, 0); PG8_STAGE_A(PG8_SA(0, 1), last, k2, 1);
            PG8_WAIT_V(8); PG8_WAIT_L(0); PG8_BAR; XMMA0(0, 0); XMMA1(0, 1); PG8_BAR; PG8_SCHED;
            XLDA(1, 1); PG8_STAGE_B(PG8_SB(1, 0), last, k3, 0); PG8_STAGE_B(PG8_SB(1, 1), last, k3, 1); PG8_STAGE_A(PG8_SA(1, 0), last, k3, 0);
            PG8_WAIT_V(8); PG8_WAIT_L(0); PG8_BAR; XMMA0(1, 0); XMMA1(1, 1); PG8_BAR; PG8_SCHED;
        }
        if constexpr (ALIGN_EPI) { if (wr == 0) PG8_BAR; }
        if constexpr (FP8) asm volatile("s_nop 15\n\ts_nop 15" ::: "memory");
        if constexpr (KREP > 1) {
#pragma unroll
            for (int a_ = 0; a_ < 2; ++a_)
#pragma unroll
                for (int b_ = 0; b_ < 2; ++b_)
#pragma unroll
                    for (int m_ = 0; m_ < 4; ++m_)
#pragma unroll
                        for (int n_ = 0; n_ < 2; ++n_) acc[a_][b_][m_][n_] = acc[a_][b_][m_][n_] * (1.f / KREP); }
        E(acc, cur, wr, wc, fr, fq, ui % 3);
        if (!has_next) break;
#pragma unroll
        for (int a = 0; a < 2; ++a)
#pragma unroll
            for (int b = 0; b < 2; ++b)
#pragma unroll
                for (int m = 0; m < 4; ++m)
#pragma unroll
                    for (int n = 0; n < 2; ++n) acc[a][b][m][n] = (f32x4){0.f, 0.f, 0.f, 0.f};
        cur = nxt; cA = nA; cB = nB; ++ui;
        if (GATHER) {
#pragma unroll
            for (int h = 0; h < 2; ++h)
#pragma unroll
                for (int i = 0; i < 2; ++i) voffC[h][i] = voffN[h][i];
        }
        if constexpr (ALIGN_EPI) { if (wr == 1) PG8_BAR; }
    }
    PG8_WAIT_V(0);
    if constexpr (!ALIGN_EPI) { if (wr == 0) PG8_BAR; }
    PG8_BAR;
}

struct EpiInProj {
    static constexpr bool PERM = true, WIDE = true;
    __device__ __forceinline__ void prefetch(const Unit&, int, int, int) const {}
    bf16* zg; bf16* qb; bf16* kb; bf16* vb; const float* qn; const float* kn; LAS unsigned char* stage; const float* gnw;
    __device__ __forceinline__ void operator()(const f32x4 (&acc)[2][2][4][2], const Unit& u, int wr, int wc, int fr, int fq, int) const {
        const int lane = fq * 16 + fr; LAS unsigned char* stg = stage + (wr * 4 + wc) * 3584;
        const bool swa = u.pn >= 8; const int sec = swa ? (u.pn - 8) >> 1 : 0, head = 4 * ((u.pn - 8) & 1) + wc; const bool gate = (u.pn == 6) || (u.pn == 7);
        bf16* dst = qb + (size_t)sec * ((WS_KB - WS_QB) / 2); const float* nw = (sec == 1) ? kn : qn;
        f32x4 wv[2][2];
#pragma unroll
        for (int bj = 0; bj < 2; ++bj)
#pragma unroll
            for (int n = 0; n < 2; ++n) { const f32x4 t_ = *(const f32x4*)(nw + 32 * bj + 8 * fq + 4 * n); const f32x4 g_ = *(const f32x4*)(gnw + ((wc & 1) * 64 + 32 * bj + 8 * fq + 4 * n));
                wv[bj][n] = (swa && sec < 2) ? t_ : (gate ? g_ : (f32x4){1.f, 1.f, 1.f, 1.f}); }
#pragma unroll
        for (int ai = 0; ai < 2; ++ai)
#pragma unroll
            for (int m = 0; m < 4; ++m) {
                float sc = 1.f;
                if (swa && sec < 2) { float ss = 0.f;
#pragma unroll
                    for (int bj = 0; bj < 2; ++bj)
#pragma unroll
                        for (int n = 0; n < 2; ++n) { const f32x4 x = acc[ai][bj][m][n]; ss += (x[0] * x[0] + x[1] * x[1]) + (x[2] * x[2] + x[3] * x[3]); }
                    ss = sum_xor32(sum_xor16(ss));
                    sc = rsqrtf(ss * (1.f / 64.f) + EPS) * (sec == 0 ? 0.125f * LOG2E : 1.f); }
#pragma unroll
                for (int bj = 0; bj < 2; ++bj) { f32x4 v0 = acc[ai][bj][m][0] * sc, v1 = acc[ai][bj][m][1] * sc;
                    if (gate) { v0 = (f32x4){silu_f(v0[0]), silu_f(v0[1]), silu_f(v0[2]), silu_f(v0[3])}; v1 = (f32x4){silu_f(v1[0]), silu_f(v1[1]), silu_f(v1[2]), silu_f(v1[3])}; }
                    v0 = v0 * wv[bj][0]; v1 = v1 * wv[bj][1];
                    u32x4 w; w.x = pk2(v0[0], v0[1]); w.y = pk2(v0[2], v0[3]); w.z = pk2(v1[0], v1[1]); w.w = pk2(v1[2], v1[3]); *(LAS u32x4*)(stg + fr * 144 + bj * 64 + fq * 16) = w; }
                asm volatile("s_waitcnt lgkmcnt(0)" ::: "memory");
                const int row0 = u.pm * BM + ai * HALF + wr * 64 + m * 16;
#pragma unroll
                for (int hf = 0; hf < 2; ++hf) { const int rr = hf * 8 + (lane >> 3), c16 = lane & 7, row_ = row0 + rr; const u32x4 w = *(const LAS u32x4*)(stg + rr * 144 + c16 * 16);
                    bf16* gp = swa ? dst + ((size_t)((row_ >> 12) * AH + head) * SEQ + (row_ & (SEQ - 1))) * 64 + 8 * c16 : zg + (size_t)row_ * 2048 + u.pn * BM + wc * 64 + 8 * c16;
                    *(u32x4*)gp = w; }
                asm volatile("s_waitcnt lgkmcnt(0)" ::: "memory"); }
    }
};
struct EpiOutProj {
    __device__ __forceinline__ void prefetch(const Unit&, int, int, int) const {}
    static constexpr bool PERM = true, WIDE = true;
    const float* x; bf16* h; unsigned char* hb; LAS unsigned char* stage;
    __device__ __forceinline__ void operator()(const f32x4 (&acc)[2][2][4][2], const Unit& u, int wr, int wc, int fr, int fq, int) const {
        const int lane = fq * 16 + fr; LAS unsigned char* stg = stage + (wr * 4 + wc) * 3584; const int colw = u.pn * BM + wc * 64;
        const int r8 = lane >> 3, c16 = lane & 7;
#pragma unroll
        for (int ai = 0; ai < 2; ++ai)
#pragma unroll
            for (int mp = 0; mp < 2; ++mp) {
                f32x4 xv[2][2][2];
#pragma unroll
                for (int mm = 0; mm < 2; ++mm) { const int row0 = u.pm * BM + ai * HALF + wr * 64 + (2 * mp + mm) * 16;
#pragma unroll
                    for (int bj = 0; bj < 2; ++bj)
#pragma unroll
                        for (int hf = 0; hf < 2; ++hf) xv[mm][bj][hf] = *(const f32x4*)(x + (size_t)(row0 + 8 * hf + r8) * D + colw + 32 * bj + 4 * c16); }
                unsigned h8[2][2][2];
#pragma unroll
                for (int mm = 0; mm < 2; ++mm) { const int m = 2 * mp + mm; const int row0 = u.pm * BM + ai * HALF + wr * 64 + m * 16; u32x4 hw[2];
#pragma unroll
                    for (int bj = 0; bj < 2; ++bj) {
#pragma unroll
                        for (int hf = 0; hf < 2; ++hf) *(LAS f32x4*)(stg + (8 * hf + r8) * 144 + c16 * 16) = xv[mm][bj][hf];
                        asm volatile("s_waitcnt lgkmcnt(0)" ::: "memory");
                        const f32x4 x0 = *(const LAS f32x4*)(stg + fr * 144 + fq * 32), x1 = *(const LAS f32x4*)(stg + fr * 144 + fq * 32 + 16);
                        const f32x4 v0 = acc[ai][bj][m][0] + x0, v1 = acc[ai][bj][m][1] + x1;
                        h8[mm][bj][0] = pk4_fp8(v0[0], v0[1], v0[2], v0[3]); h8[mm][bj][1] = pk4_fp8(v1[0], v1[1], v1[2], v1[3]);
                        hw[bj] = (u32x4){pk2(v0[0], v0[1]), pk2(v0[2], v0[3]), pk2(v1[0], v1[1]), pk2(v1[2], v1[3])};
                        asm volatile("s_waitcnt lgkmcnt(0)" ::: "memory"); }
#pragma unroll
                    for (int bj = 0; bj < 2; ++bj) *(LAS u32x4*)(stg + fr * 144 + bj * 64 + fq * 16) = hw[bj];
                    asm volatile("s_waitcnt lgkmcnt(0)" ::: "memory");
#pragma unroll
                    for (int hf = 0; hf < 2; ++hf) { const u32x4 w = *(const LAS u32x4*)(stg + (8 * hf + r8) * 144 + c16 * 16); *(u32x4*)(h + (size_t)(row0 + 8 * hf + r8) * D + colw + 8 * c16) = w; }
                    asm volatile("s_waitcnt lgkmcnt(0)" ::: "memory"); }
#pragma unroll
                for (int mm = 0; mm < 2; ++mm)
#pragma unroll
                    for (int bj = 0; bj < 2; ++bj) *(LAS u32x2*)(stg + (16 * mm + fr) * 80 + bj * 32 + fq * 8) = (u32x2){h8[mm][bj][0], h8[mm][bj][1]};
                asm volatile("s_waitcnt lgkmcnt(0)" ::: "memory");
                { const int rr = lane >> 2, q16 = lane & 3; const int rowa = u.pm * BM + ai * HALF + wr * 64 + (2 * mp) * 16;
                  const u32x4 w0 = *(const LAS u32x4*)(stg + rr * 80 + q16 * 16), w1 = *(const LAS u32x4*)(stg + (16 + rr) * 80 + q16 * 16);
                  *(u32x4*)(hb + (size_t)(rowa + rr) * D + colw + 16 * q16) = w0; *(u32x4*)(hb + (size_t)(rowa + 16 + rr) * D + colw + 16 * q16) = w1; }
                asm volatile("s_waitcnt lgkmcnt(0)" ::: "memory"); }
    }
};
struct EpiGateUp {
    static constexpr bool PERM = true, WIDE = false;
    unsigned char* act; const float* bgu; const float* lrs; const LAS int* lcnt; LAS unsigned char* stage;
    __device__ __forceinline__ void prefetch(const Unit& u, int slot, int wid, int lane) const {
        const unsigned l0 = (unsigned)(uintptr_t)stage;
        if (wid == 0) glds16_asm(bgu + (size_t)u.e * 2048 + (lane >> 5) * 1024 + 128 * u.pn + (lane & 31) * 4, (unsigned)__builtin_amdgcn_readfirstlane((int)(l0 + slot * 1024)));
        else if (wid == 1) glds16_asm(lrs + (size_t)u.e * LCAP + u.mt * 256 + lane * 4, (unsigned)__builtin_amdgcn_readfirstlane((int)(l0 + 3072 + slot * 1024)));
    }
    __device__ __forceinline__ void operator()(const f32x4 (&acc)[2][2][4][2], const Unit& u, int wr, int wc, int fr, int fq, int slot) const {
        const int cl = wc * 32 + 8 * fq; const LAS float* bl = (const LAS float*)(stage + slot * 1024); const LAS float* rl = (const LAS float*)(stage + 3072 + slot * 1024);
        f32x4 bgv[2], buv[2];
#pragma unroll
        for (int n = 0; n < 2; ++n) { bgv[n] = *(const LAS f32x4*)(bl + cl + 4 * n); buv[n] = *(const LAS f32x4*)(bl + 128 + cl + 4 * n); }
        const int cnt = lcnt[u.e];
#pragma unroll
        for (int ai = 0; ai < 2; ++ai)
#pragma unroll
            for (int m = 0; m < 4; ++m) { const int r = ai * HALF + wr * 64 + m * 16 + fr, rr = u.mt * 256 + r;
                const float rsv = rl[r]; const float rs = rr < cnt ? rsv : 0.f;
                unsigned wq[2];
#pragma unroll
                for (int n = 0; n < 2; ++n) { float a[4];
#pragma unroll
                    for (int i = 0; i < 4; ++i) { const float gt = fminf(acc[ai][0][m][n][i] * rs + bgv[n][i], 7.f); const float up = fminf(fmaxf(acc[ai][1][m][n][i] * rs + buv[n][i], -7.f), 7.f);
                        a[i] = (up + 1.f) * gt * sigmoid_f(1.702f * gt); }
                    wq[n] = pk4_fp8(a[0], a[1], a[2], a[3]); }
                *(u32x2*)(act + (size_t)(u.pm * BM + r) * FF + 128 * u.pn + cl) = (u32x2){wq[0], wq[1]}; }
    }
};
struct EpiDown {
    static constexpr bool PERM = true, WIDE = true;
    unsigned char* y; const float* bdn; LAS unsigned char* stage;
    __device__ __forceinline__ void prefetch(const Unit& u, int slot, int wid, int lane) const {
        if (wid == 0) glds16_asm(bdn + (size_t)u.e * D + u.pn * BM + lane * 4, (unsigned)__builtin_amdgcn_readfirstlane((int)((unsigned)(uintptr_t)stage + 20480 + slot * 1024)));
    }
    __device__ __forceinline__ void operator()(const f32x4 (&acc)[2][2][4][2], const Unit& u, int wr, int wc, int fr, int fq, int slot) const {
        const int colw = u.pn * BM + wc * 64; const LAS float* bp = (const LAS float*)(stage + 20480 + slot * 1024) + wc * 64 + 8 * fq;
        f32x4 bv[2][2];
#pragma unroll
        for (int bj = 0; bj < 2; ++bj)
#pragma unroll
            for (int n = 0; n < 2; ++n) bv[bj][n] = *(const LAS f32x4*)(bp + 32 * bj + 4 * n);
        const int lane = fq * 16 + fr; LAS unsigned char* stg = stage + (wr * 4 + wc) * 2560;
#pragma unroll
        for (int ai = 0; ai < 2; ++ai)
#pragma unroll
            for (int mp = 0; mp < 2; ++mp) {
#pragma unroll
                for (int mm = 0; mm < 2; ++mm) { const int m = 2 * mp + mm;
#pragma unroll
                    for (int bj = 0; bj < 2; ++bj) { const f32x4 v0 = acc[ai][bj][m][0] + bv[bj][0], v1 = acc[ai][bj][m][1] + bv[bj][1];
                        *(LAS u32x2*)(stg + (16 * mm + fr) * 80 + bj * 32 + fq * 8) = (u32x2){pk4_fp8(v0[0], v0[1], v0[2], v0[3]), pk4_fp8(v1[0], v1[1], v1[2], v1[3])}; } }
                asm volatile("s_waitcnt lgkmcnt(0)" ::: "memory");
                { const int rr = lane >> 2, c16 = lane & 3; const u32x4 w = *(const LAS u32x4*)(stg + rr * 80 + c16 * 16);
                  const int rowa = u.pm * BM + ai * HALF + wr * 64 + (2 * mp) * 16 + rr; *(u32x4*)(y + (size_t)rowa * D + colw + 16 * c16) = w;
                  const u32x4 w2 = *(const LAS u32x4*)(stg + (16 + rr) * 80 + c16 * 16); *(u32x4*)(y + (size_t)(rowa + 16) * D + colw + 16 * c16) = w2; }
                asm volatile("s_waitcnt lgkmcnt(0)" ::: "memory"); }
    }
};
}

#define XB_TMO      128
#define XB_XCNT(j)  (256  + 64 * (j))
#define XB_XSUB(j)  (1280 + 64 * (j))
#define XB_XGEN(j)  (2304 + 64 * (j))
#define XB_TOP      3328
#define XB_TOPGEN   3392
#define XCD_BAR_WORDS 3456
#define XB_SPIN_CAP (1u << 20)
__device__ __forceinline__ unsigned xb_ld(unsigned* p)              { return __hip_atomic_load(p, __ATOMIC_RELAXED, __HIP_MEMORY_SCOPE_AGENT); }
__device__ __forceinline__ unsigned xb_add(unsigned* p, unsigned v) { return __hip_atomic_fetch_add(p, v, __ATOMIC_RELAXED, __HIP_MEMORY_SCOPE_AGENT); }
__device__ __forceinline__ unsigned xb_xcc_id() { return (unsigned)__builtin_amdgcn_s_getreg((3 << 11) | 20) & 0xFu; }
#define XB_SPIN(cond, bar) do { unsigned _sp = 0; while (cond) { __builtin_amdgcn_s_sleep(1); \
    if ((++_sp & 255u) == 0u) { if (xb_ld(&(bar)[XB_TMO])) break; if (_sp > XB_SPIN_CAP) { atomicAdd(&(bar)[XB_TMO], 1u); break; } } } } while (0)
struct XcdBarrier { unsigned* bar; unsigned x; volatile LAS unsigned* st; };
__device__ __forceinline__ XcdBarrier xcd_barrier_post(unsigned* bar, volatile LAS unsigned* st) {
    XcdBarrier b; b.bar = bar; b.x = xb_xcc_id(); b.st = st;
    if (threadIdx.x == 0) (void)xb_add(&bar[XB_XCNT(b.x)], 1u);
    return b;
}
__device__ __forceinline__ void xcd_barrier_complete(unsigned* bar, unsigned x, unsigned& nloc, unsigned& nx) {
    const unsigned G = gridDim.x * gridDim.y * gridDim.z;
    unsigned sum, cnt, mine, sp = 0u;
    for (;;) {
        sum = 0u; cnt = 0u; mine = 0u;
#pragma unroll
        for (unsigned j = 0; j < 16; ++j) { const unsigned c = xb_ld(&bar[XB_XCNT(j)]); sum += c; cnt += (c > 0u) ? 1u : 0u; mine = (j == x) ? c : mine; }
        if (sum == G) break;
        __builtin_amdgcn_s_sleep(1);
        if ((++sp & 255u) == 0u) { if (xb_ld(&bar[XB_TMO])) break; if (sp > XB_SPIN_CAP) { atomicAdd(&bar[XB_TMO], 1u); break; } }
    }
    nloc = mine > 0u ? mine : 1u; nx = cnt > 0u ? cnt : 1u;
}
__device__ __forceinline__ void xcd_barrier(const XcdBarrier& b) {
    asm volatile("s_waitcnt vmcnt(0)" ::: "memory");
    __syncthreads();
    if (threadIdx.x == 0) {
        unsigned* bar = b.bar;
        __builtin_amdgcn_s_waitcnt(0);
        unsigned nloc = b.st[0], nx = b.st[1];
        if (nloc == 0u) { xcd_barrier_complete(bar, b.x, nloc, nx); b.st[0] = nloc; b.st[1] = nx; }
        const unsigned old = xb_add(&bar[XB_XSUB(b.x)], 1u);
        const unsigned gen = old / nloc;
        if (old + 1u == (gen + 1u) * nloc) {
            __builtin_amdgcn_fence(__ATOMIC_RELEASE, "agent");
            asm volatile("s_waitcnt vmcnt(0)" ::: "memory");
            const unsigned og = xb_add(&bar[XB_TOP], 1u);
            const unsigned tg = og / nx;
            if (og + 1u == (tg + 1u) * nx) xb_add(&bar[XB_TOPGEN], 1u);
            else XB_SPIN(xb_ld(&bar[XB_TOPGEN]) == tg, bar);
            __builtin_amdgcn_fence(__ATOMIC_ACQUIRE, "agent");
            xb_add(&bar[XB_XGEN(b.x)], 1u);
            asm volatile("s_waitcnt vmcnt(0)" ::: "memory");
        } else {
            XB_SPIN(xb_ld(&bar[XB_XGEN(b.x)]) == gen, bar);
            __builtin_amdgcn_fence(__ATOMIC_ACQUIRE, "agent");
            asm volatile("s_waitcnt vmcnt(0)" ::: "memory");
        }
    }
    __syncthreads();
}

struct Args { const float* in[18]; float* out; unsigned char* ws; int ph_lo, ph_hi, li, pad; };
struct Frame {
    LAS unsigned char* lds; unsigned char* ws; unsigned* ctl;
    int tid, lane, wave, G, vcu;
};

__device__ const unsigned char T5B[3][132] = {
{0,1,2,3,4,5,6,7,8,9,10,11,12,13,14,15,16,16,16,16,16,16,17,17,17,17,17,17,17,17,18,18,18,18,18,18,18,18,18,18,19,19,19,19,19,19,19,19,19,19,19,19,19,19,20,20,20,20,20,20,20,20,20,20,20,20,20,20,20,20,20,20,20,21,21,21,21,21,21,21,21,21,21,21,21,21,21,21,21,21,21,21,21,21,21,21,21,21,21,22,22,22,22,22,22,22,22,22,22,22,22,22,22,22,22,22,22,22,22,22,22,22,22,22,22,22,22,22,22,0,0,0},
{0,4,8,12,16,16,17,17,18,18,19,19,19,19,20,20,20,20,20,21,21,21,21,21,21,22,22,22,22,22,22,22,22,22,23,23,23,23,23,23,23,23,23,23,23,23,24,24,24,24,24,24,24,24,24,24,24,24,24,24,24,24,25,25,25,25,25,25,25,25,25,25,25,25,25,25,25,25,25,25,25,25,25,26,26,26,26,26,26,26,26,26,26,26,26,26,26,26,26,26,26,26,26,26,26,26,26,26,26,26,26,26,26,27,27,27,27,27,27,27,27,27,27,27,27,27,27,27,27,0,0,0},
{0,16,18,19,20,21,21,22,22,23,23,23,24,24,24,24,25,25,25,25,25,26,26,26,26,26,26,26,26,27,27,27,27,27,27,27,27,27,27,28,28,28,28,28,28,28,28,28,28,28,28,28,29,29,29,29,29,29,29,29,29,29,29,29,29,29,29,29,29,29,30,30,30,30,30,30,30,30,30,30,30,30,30,30,30,30,30,30,30,30,30,30,30,30,30,31,31,31,31,31,31,31,31,31,31,31,31,31,31,31,31,31,31,31,31,31,31,31,31,31,31,31,31,31,31,31,31,31,31,0,0,0}};

__device__ __forceinline__ void p0_load8(const float* W, size_t ldw, int src_col0, int k0, int lane, f32x4 (&v)[8]) {
    const int n4 = (lane & 7) * 4, kr = lane >> 3;
#pragma unroll
    for (int i = 0; i < 8; ++i) v[i] = *(const f32x4*)(W + (size_t)(k0 + 8 * i + kr) * ldw + src_col0 + n4);
}
template <bool SCALE, bool OUT8> __device__ __forceinline__ void p0_finish(const f32x4 (&v)[8], void* dstv, int k0, const float* kscale, LAS float* scr, int lane) {
    { const int n4 = (lane & 7) * 4, kr = lane >> 3;
#pragma unroll
        for (int i = 0; i < 8; ++i) { const int kk = 8 * i + kr; f32x4 x = v[i]; if (SCALE) x = x * kscale[k0 + kk]; if (OUT8) x = x * 32.f;
            scr[kk * 33 + n4] = x[0]; scr[kk * 33 + n4 + 1] = x[1]; scr[kk * 33 + n4 + 2] = x[2]; scr[kk * 33 + n4 + 3] = x[3]; } }
    LDS_WAIT(); asm volatile("" ::: "memory");
    if (OUT8) { unsigned char* dst = (unsigned char*)dstv; const int n = lane >> 1, kh = lane & 1; const LAS float* sp = scr + (32 * kh) * 33 + n; unsigned w[8];
#pragma unroll
        for (int q = 0; q < 8; ++q) w[q] = pk4_fp8(sp[(4 * q) * 33], sp[(4 * q + 1) * 33], sp[(4 * q + 2) * 33], sp[(4 * q + 3) * 33]);
        *(u32x4*)(dst + (size_t)n * 1024 + k0 + 32 * kh) = (u32x4){w[0], w[1], w[2], w[3]}; *(u32x4*)(dst + (size_t)n * 1024 + k0 + 32 * kh + 16) = (u32x4){w[4], w[5], w[6], w[7]};
    } else { bf16* dst = (bf16*)dstv; const int c = lane & 7;
#pragma unroll
        for (int j = 0; j < 4; ++j) { const int n = (lane >> 3) + 8 * j; const LAS float* sp = scr + (8 * c) * 33 + n;
            u32x4 o; o.x = pk2(sp[0 * 33], sp[1 * 33]); o.y = pk2(sp[2 * 33], sp[3 * 33]); o.z = pk2(sp[4 * 33], sp[5 * 33]); o.w = pk2(sp[6 * 33], sp[7 * 33]);
            *(u32x4*)(dst + (size_t)n * 1024 + k0 + 8 * c) = o; } }
    LDS_WAIT(); asm volatile("" ::: "memory");
}
template <bool SCALE, bool OUT8> __device__ __forceinline__ void p0_transpose_item(const float* W, size_t ldw, int src_col0, void* dstv, int k0, const float* kscale, LAS float* scr, int lane) {
    f32x4 v[8]; p0_load8(W, ldw, src_col0, k0, lane, v); p0_finish<SCALE, OUT8>(v, dstv, k0, kscale, scr, lane);
}
__device__ __forceinline__ void p0_experts(Frame& F, const Args& a, int gw, int NGW) {
    const float* n2 = a.in[11]; const float* w_gu = a.in[14]; const float* w_dn = a.in[16];
    unsigned char* Wgu8 = F.ws + WS_WGU; unsigned char* Wdn8 = F.ws + WS_WDN;
    LAS float* scr = (LAS float*)(F.lds + F.wave * 16896);
    constexpr int I_GU = NE * 8 * 64, I_DN = NE * 8 * 32, NI = I_GU + I_DN;
#define P0_X_ARGS(r_) const bool gu_ = (r_) < I_GU; const int r2_ = gu_ ? (r_) : (r_) - I_GU; const int e_ = gu_ ? (r2_ >> 9) : (r2_ >> 8), q_ = gu_ ? (r2_ & 511) : (r2_ & 255), nb_ = gu_ ? (q_ & 63) : (q_ & 31), kb_ = gu_ ? (q_ >> 6) : (q_ >> 5), \
        np_ = 32 * nb_, ntile_ = np_ >> 8, lc_ = np_ & 255; const int col_ = gu_ ? ((lc_ >> 7) * 1024 + 128 * ntile_ + (lc_ & 127)) : np_; const float* W_ = gu_ ? w_gu + (size_t)e_ * D * 2048 : w_dn + (size_t)e_ * FF * D; const size_t ldw_ = gu_ ? 2048 : D; \
        unsigned char* dst_ = gu_ ? Wgu8 + ((size_t)e_ * 2048 + np_) * 1024 : Wdn8 + ((size_t)e_ * 1024 + np_) * 1024; const int k0_ = 128 * kb_
#define P0_X_LOAD(r_, v_) do { P0_X_ARGS(r_); (void)dst_; const int n4 = (F.lane & 7) * 4, kr = F.lane >> 3; \
        _Pragma("unroll") for (int i = 0; i < 16; ++i) v_[i] = *(const f32x4*)(W_ + (size_t)(k0_ + 8 * i + kr) * ldw_ + col_ + n4); } while (0)
#define P0_X_FIN(r_, v_) do { P0_X_ARGS(r_); (void)W_; (void)ldw_; (void)col_; { const int n4 = (F.lane & 7) * 4, kr = F.lane >> 3; \
        _Pragma("unroll") for (int i = 0; i < 16; ++i) { const int kk = 8 * i + kr; f32x4 x = v_[i] * 32.f; if (gu_) x = x * n2[k0_ + kk]; \
            scr[kk * 33 + n4] = x[0]; scr[kk * 33 + n4 + 1] = x[1]; scr[kk * 33 + n4 + 2] = x[2]; scr[kk * 33 + n4 + 3] = x[3]; } } \
        LDS_WAIT(); asm volatile("" ::: "memory"); \
        { const int n = F.lane >> 1, kh = F.lane & 1; const LAS float* sp = scr + (64 * kh) * 33 + n; \
          _Pragma("unroll") for (int c = 0; c < 4; ++c) { unsigned w_[4]; _Pragma("unroll") for (int q = 0; q < 4; ++q) w_[q] = pk4_fp8(sp[(16 * c + 4 * q) * 33], sp[(16 * c + 4 * q + 1) * 33], sp[(16 * c + 4 * q + 2) * 33], sp[(16 * c + 4 * q + 3) * 33]); \
              *(u32x4*)(dst_ + (size_t)n * 1024 + k0_ + 64 * kh + 16 * c) = (u32x4){w_[0], w_[1], w_[2], w_[3]}; } } \
        LDS_WAIT(); asm volatile("" ::: "memory"); } while (0)
    { f32x4 va[16], vb2[16]; int it = gw;
        if (it < NI) P0_X_LOAD(it, va);
#pragma unroll 1
        for (; it < NI; it += 2 * NGW) { const int it2 = it + NGW, it3 = it + 2 * NGW;
            if (it2 < NI) P0_X_LOAD(it2, vb2);
            P0_X_FIN(it, va);
            if (it3 < NI) P0_X_LOAD(it3, va);
            if (it2 < NI) P0_X_FIN(it2, vb2); } }
#undef P0_X_LOAD
#undef P0_X_FIN
#undef P0_X_ARGS
}
__device__ __forceinline__ void phase0(Frame& F, const Args& a) {
    const float* x = a.in[0]; const float* n1 = a.in[1]; const float* w_in = a.in[2]; const float* w_out = a.in[10]; const float* n2 = a.in[11];
    const float* w_r = a.in[12]; const float* w_gu = a.in[14]; const float* w_dn = a.in[16];
    bf16* Win_t = (bf16*)(F.ws + WS_WIN); bf16* Wout_t = (bf16*)(F.ws + WS_WOUT); bf16* Wgu_t = (bf16*)(F.ws + WS_WGU); bf16* Wdn_t = (bf16*)(F.ws + WS_WDN);
    float* wrT = (float*)(F.ws + WS_WRT); bf16* XN = (bf16*)(F.ws + WS_XN); float* BA = (float*)(F.ws + WS_BA);
    LAS float* scr = (LAS float*)(F.lds + F.wave * 8448);
    const int gw = F.vcu * NWAVES + F.wave, NGW = F.G * NWAVES;
    { bf16* wrh = (bf16*)wrT; bf16* wrl = wrh + NE * D;
      for (int i = (F.vcu * NTHREADS + F.tid); i < NE * D; i += F.G * NTHREADS) { const int e = i >> 10, k = i & 1023; const float w = n2[k] * w_r[k * NE + e];
          const unsigned hi = pk2(w, 0.f) & 0xffffu; const float lo = w - __uint_as_float(hi << 16); wrh[i] = (bf16)hi; wrl[i] = (bf16)(pk2(lo, 0.f) & 0xffffu); } }
    constexpr int I_IN = 16 * (NIN / 32), I_OUT = 16 * 32;
    for (int it = gw; it < I_IN + I_OUT; it += NGW) {
        int r = it;
        if (r < I_IN) { const int nb = r % (NIN / 32), kb = r / (NIN / 32), np = 32 * nb; int src;
            src = np < 2048 ? np : np + 8;
            p0_transpose_item<false, false>(w_in, IN_DIM, src, Win_t + (size_t)np * 1024, 64 * kb, nullptr, scr, F.lane); continue; }
        r -= I_IN;
        { const int nb = r & 31, kb = r >> 5; p0_transpose_item<false, false>(w_out, D, 32 * nb, Wout_t + (size_t)(32 * nb) * 1024, 64 * kb, nullptr, scr, F.lane); }
    }
    __syncthreads();
    { LAS float* wb = (LAS float*)(F.lds + 69632);
        for (int k = F.tid; k < D; k += NTHREADS) { const float* wp = w_in + (size_t)k * IN_DIM + 2048; LAS float* dp = wb + (k >> 2) * 36 + (k & 3) * 8;
            *(LAS f32x4*)dp = *(const f32x4*)wp; *(LAS f32x4*)(dp + 4) = *(const f32x4*)(wp + 4); }
        __syncthreads();
        f32x4 n1v[4];
#pragma unroll
        for (int j = 0; j < 4; ++j) n1v[j] = *((const f32x4*)n1 + F.lane + 64 * j);
        for (int rep9 = 0; rep9 < (DUP == 9 ? 2 : 1); ++rep9)
        for (int m0 = gw * 4; m0 < T; m0 += NGW * 4) {
            f32x4 v[4][4]; float rs[4];
#pragma unroll
            for (int r = 0; r < 4; ++r)
#pragma unroll
                for (int j = 0; j < 4; ++j) v[r][j] = *((const f32x4*)(x + (size_t)(m0 + r) * D) + F.lane + 64 * j);
#pragma unroll
            for (int r = 0; r < 4; ++r) { float sq = 0.f;
#pragma unroll
                for (int j = 0; j < 4; ++j) sq += (v[r][j][0] * v[r][j][0] + v[r][j][1] * v[r][j][1]) + (v[r][j][2] * v[r][j][2] + v[r][j][3] * v[r][j][3]);
                rs[r] = rsqrtf(wave_sum(sq) * (1.f / D) + EPS); }
            float ba[4][8];
#pragma unroll
            for (int r = 0; r < 4; ++r)
#pragma unroll
                for (int c = 0; c < 8; ++c) ba[r][c] = 0.f;
#pragma unroll
            for (int j = 0; j < 4; ++j) {
#pragma unroll
                for (int r = 0; r < 4; ++r) { v[r][j] = v[r][j] * rs[r] * n1v[j];
                    *((unsigned long long*)(XN + (size_t)(m0 + r) * D) + F.lane + 64 * j) = (unsigned long long)pk2(v[r][j][0], v[r][j][1]) | ((unsigned long long)pk2(v[r][j][2], v[r][j][3]) << 32); }
#pragma unroll
                for (int i = 0; i < 4; ++i) { const LAS float* wp = wb + (F.lane + 64 * j) * 36 + i * 8; const f32x4 w0 = *(const LAS f32x4*)wp, w1 = *(const LAS f32x4*)(wp + 4);
#pragma unroll
                    for (int r = 0; r < 4; ++r) { const float xv = v[r][j][i];
                        ba[r][0] += xv * w0[0]; ba[r][1] += xv * w0[1]; ba[r][2] += xv * w0[2]; ba[r][3] += xv * w0[3];
                        ba[r][4] += xv * w1[0]; ba[r][5] += xv * w1[1]; ba[r][6] += xv * w1[2]; ba[r][7] += xv * w1[3]; } } }
#pragma unroll
            for (int r = 0; r < 4; ++r) {
#pragma unroll
                for (int c = 0; c < 8; ++c) ba[r][c] = wave_sum(ba[r][c]);
                if (F.lane == 0) { *(f32x4*)(BA + (size_t)(m0 + r) * 8) = (f32x4){ba[r][0], ba[r][1], ba[r][2], ba[r][3]}; *(f32x4*)(BA + (size_t)(m0 + r) * 8 + 4) = (f32x4){ba[r][4], ba[r][5], ba[r][6], ba[r][7]}; } }
        }
        __syncthreads();
    }
}

constexpr int GP = 132;
constexpr int GQ_OFF = 0, GK_OFF = 64 * GP * 4, GV_OFF = 2 * 64 * GP * 4, GW_OFF = 3 * 64 * GP * 4, GAT_OFF = 4 * 64 * GP * 4, GAT_P = 68;
constexpr int GRAW_OFF = GW_OFF, GRAW_BYTES = 67 * 768;
constexpr int GGC_OFF = GRAW_OFF + GRAW_BYTES, GBETA_OFF = GGC_OFF + 256, GDM_OFF = GBETA_OFF + 256, GEND = GDM_OFF + 4096;
static_assert(GAT_OFF + 64 * GAT_P * 4 <= GGC_OFF && GEND <= TOP_OFF, "gdn prep LDS");
__device__ __forceinline__ int permpos(int cc) { return 8 * ((cc & 15) >> 2) + (cc & 3) + 4 * (cc >> 4); }
__device__ __forceinline__ void gdn_prep_unit(Frame& F, const Args& a, int unit, int next_unit) {
    const bf16* zg = (const bf16*)(F.ws + WS_ZG); const float* BA = (const float*)(F.ws + WS_BA);
    const float* convw = a.in[3]; const float* a_log = a.in[4]; const float* dt_bias = a.in[5];
    const int b = unit >> 8, h = (unit >> 6) & 3, n = unit & 63; const int row0 = b * SEQ + n * CHUNK;
    unsigned char* rec = F.ws + WS_PREP + (size_t)unit * PREP_REC;
    LAS float* Qs = (LAS float*)(F.lds + GQ_OFF); LAS float* Ks = (LAS float*)(F.lds + GK_OFF); LAS float* Vs = (LAS float*)(F.lds + GV_OFF); LAS float* Ws = (LAS float*)(F.lds + GW_OFF);
    LAS float* AT = (LAS float*)(F.lds + GAT_OFF); LAS float* gcs = (LAS float*)(F.lds + GGC_OFF); LAS float* betas = (LAS float*)(F.lds + GBETA_OFF);
    LAS unsigned char* raw = F.lds + GRAW_OFF;
    const int tid = F.tid, lane = F.lane, wave = F.wave;
    for (int e = tid; e < 67 * 48; e += NTHREADS) { const int rr = e / 48, ch = e % 48; const int tt = n * CHUNK + rr - 3;
        u32x4 v = {0u, 0u, 0u, 0u}; if (tt >= 0) v = *(const u32x4*)(zg + (size_t)(row0 + rr - 3) * 2048 + (ch >> 4) * 512 + h * 128 + (ch & 15) * 8);
        *(LAS u32x4*)(raw + rr * 768 + ch * 16) = v; }
    if (wave == 0) {
        const float bl = BA[(size_t)(row0 + lane) * 8 + h], al = BA[(size_t)(row0 + lane) * 8 + 4 + h];
        const float xx = al + dt_bias[h]; const float sp = xx > 20.f ? xx : log1pf(__expf(xx));
        float g = -__expf(a_log[h]) * sp;
#pragma unroll
        for (int o = 1; o < 64; o <<= 1) { const float u = __shfl_up(g, o); if (lane >= o) g += u; }
        gcs[lane] = g; betas[lane] = sigmoid_f(bl);
    }
    LDS_BARRIER();
    { const int t0 = 8 * wave; float qv[8][2], kv[8][2];
#pragma unroll
        for (int ten = 0; ten < 3; ++ten) { const int cp = ten * 64 + lane, ch = ten * 512 + h * 128 + 2 * lane;
            f32x2 cw[4];
#pragma unroll
            for (int k = 0; k < 4; ++k) cw[k] = *(const f32x2*)(convw + k * 1536 + ch);
            float x0[11], x1[11];
#pragma unroll
            for (int k = 0; k < 11; ++k) { const unsigned w = *(const LAS unsigned*)(raw + (t0 + k) * 768 + cp * 4); x0[k] = bflo(w); x1[k] = bfhi(w); }
#pragma unroll
            for (int j = 0; j < 8; ++j) { float a0 = 0.f, a1 = 0.f;
#pragma unroll
                for (int k = 0; k < 4; ++k) { a0 += x0[j + k] * cw[k][0]; a1 += x1[j + k] * cw[k][1]; }
                a0 = silu_f(a0); a1 = silu_f(a1);
                if (ten == 0) { qv[j][0] = a0; qv[j][1] = a1; } else if (ten == 1) { kv[j][0] = a0; kv[j][1] = a1; } else { const float bt = betas[t0 + j]; *(LAS f32x2*)(Vs + (t0 + j) * GP + 2 * lane) = (f32x2){a0 * bt, a1 * bt}; } } }
#pragma unroll
        for (int j = 0; j < 8; ++j) { const float sq = wave_sum(qv[j][0] * qv[j][0] + qv[j][1] * qv[j][1]), sk = wave_sum(kv[j][0] * kv[j][0] + kv[j][1] * kv[j][1]);
            const float fq_ = rsqrtf(sq + EPS) * 0.08838834764831845f, fk_ = rsqrtf(sk + EPS);
            *(LAS f32x2*)(Qs + (t0 + j) * GP + 2 * lane) = (f32x2){qv[j][0] * fq_, qv[j][1] * fq_}; *(LAS f32x2*)(Ks + (t0 + j) * GP + 2 * lane) = (f32x2){kv[j][0] * fk_, kv[j][1] * fk_}; } }
    LDS_BARRIER();
    {
#pragma unroll
        for (int j = 0; j < 8; ++j) { const int t = 8 * wave + j; const float eg = betas[t] * __expf(gcs[t]); const f32x2 kk = *(LAS f32x2*)(Ks + t * GP + 2 * lane); *(LAS f32x2*)(Ws + t * GP + 2 * lane) = kk * eg; }
        const int which = wave >> 2, ti = (wave >> 1) & 1, tj = wave & 1, r32 = lane & 31, hh = lane >> 5;
        const LAS float* Xa = (which ? Ks + (32 * tj + r32) * GP : Ks + (32 * ti + r32) * GP) + 8 * hh; const LAS float* Xb = (which ? Qs + (32 * ti + r32) * GP : Ks + (32 * tj + r32) * GP) + 8 * hh;
        f32x16 acc = {};
#pragma unroll
        for (int ks = 0; ks < 8; ++ks) { const bf16x8 af = pack8(*(const LAS f32x4*)(Xa + 16 * ks), *(const LAS f32x4*)(Xa + 16 * ks + 4)), bf = pack8(*(const LAS f32x4*)(Xb + 16 * ks), *(const LAS f32x4*)(Xb + 16 * ks + 4));
            acc = __builtin_amdgcn_mfma_f32_32x32x16_bf16(af, bf, acc, 0, 0, 0); }
        if (which == 0) {
            const int j = 32 * tj + r32; const float gj = gcs[j];
#pragma unroll
            for (int q = 0; q < 4; ++q) { float vals[4];
#pragma unroll
                for (int rr = 0; rr < 4; ++rr) { const int i = 32 * ti + 8 * q + 4 * hh + rr; const float dec = __expf(fminf(gcs[i] - gj, 0.f)); vals[rr] = i > j ? betas[i] * acc[4 * q + rr] * dec : 0.f; }
                *(LAS f32x4*)(AT + j * GAT_P + 32 * ti + 8 * q + 4 * hh) = (f32x4){vals[0], vals[1], vals[2], vals[3]}; }
        } else {
            const int i = 32 * ti + r32; const float gi = gcs[i]; bf16* Af = (bf16*)(rec + PREP_AP) + (i >> 4) * 1024 + (i & 15) * 8 + tj * 512;
#pragma unroll
            for (int q = 0; q < 4; ++q) { float vals[4]; const int cc0 = 8 * q + 4 * hh;
#pragma unroll
                for (int rr = 0; rr < 4; ++rr) { const int j = 32 * tj + cc0 + rr; const float dec = __expf(fminf(gi - gcs[j], 0.f)); vals[rr] = i >= j ? acc[4 * q + rr] * dec : 0.f; }
                const int jpos = permpos(cc0); *(u32x2*)(Af + (jpos >> 3) * 128 + (jpos & 7)) = (u32x2){pk2(vals[0], vals[1]), pk2(vals[2], vals[3])}; }
        }
    }
    LDS_BARRIER();
    unsigned pfx = 0u;
    if (next_unit >= 0) { const int nb_ = next_unit >> 8, nh_ = (next_unit >> 6) & 3, nn_ = next_unit & 63; const int nrow0 = nb_ * SEQ + nn_ * CHUNK;
        if (tid < 402) { const int rr = tid / 6, sg = tid % 6; if (nn_ * CHUNK + rr - 3 >= 0) pfx = *(const unsigned*)(zg + (size_t)(nrow0 + rr - 3) * 2048 + (sg >> 1) * 512 + nh_ * 128 + (sg & 1) * 64); }
        else if (tid < 418) pfx = *(const unsigned*)(BA + (size_t)nrow0 * 8 + (tid - 402) * 32); }
    LAS float* Dm = (LAS float*)(F.lds + GDM_OFF);
    if (wave < 4) {
        if (lane < 16) { const int i0 = 16 * wave; float r[16];
#pragma unroll
            for (int ii = 0; ii < 16; ++ii) r[ii] = (ii == lane) ? 1.f : 0.f;
#pragma unroll
            for (int j = 0; j < 16; ++j) { const float xj = r[j]; const LAS f32x4* ap = (const LAS f32x4*)(AT + (i0 + j) * GAT_P + i0); float av[16];
#pragma unroll
                for (int q = 0; q < 4; ++q) { const f32x4 t4 = ap[q]; av[4 * q] = t4[0]; av[4 * q + 1] = t4[1]; av[4 * q + 2] = t4[2]; av[4 * q + 3] = t4[3]; }
#pragma unroll
                for (int ii = 0; ii < 16; ++ii) if (ii > j) r[ii] -= av[ii] * xj; }
#pragma unroll
            for (int ii = 0; ii < 16; ++ii) Dm[wave * 256 + ii * 16 + lane] = r[ii]; }
    } else {
        const int t2 = tid - 256; bf16* Qf = (bf16*)(rec + PREP_QP); bf16* Kf = (bf16*)(rec + PREP_KT); const float gl = gcs[63];
        for (int it = t2; it < 1024; it += 256) { const int blk = it >> 6, l = it & 63, mi = blk >> 2, ks = blk & 3, g = l >> 4, c = 16 * mi + (l & 15); const float eg = __expf(gcs[c]);
            const f32x4 lo = *(LAS f32x4*)(Qs + c * GP + 32 * ks + 4 * g) * eg, hi = *(LAS f32x4*)(Qs + c * GP + 32 * ks + 16 + 4 * g) * eg;
            *(bf16x8*)(Qf + it * 8) = pack8(lo, hi); }
        for (int it = t2; it < 1024; it += 256) { const int blk = it >> 6, l = it & 63, ti = blk >> 1, ks2 = blk & 1, g = l >> 4, dk = 16 * ti + (l & 15); float v[8];
#pragma unroll
            for (int j = 0; j < 8; ++j) { const int c = 32 * ks2 + (j < 4 ? 4 * g + j : 16 + 4 * g + (j - 4)); v[j] = Ks[c * GP + dk] * __expf(gl - gcs[c]); }
            *(bf16x8*)(Kf + it * 8) = pack8((f32x4){v[0], v[1], v[2], v[3]}, (f32x4){v[4], v[5], v[6], v[7]}); }
        if (t2 == 0) *(float*)(rec + PREP_CD) = __expf(gl);
    }
    LDS_BARRIER();
    {
        const int fr = lane & 15, g = lane >> 4;
#pragma unroll 1
        for (int bb = 0; bb < 4; ++bb) {
            const int i0 = 16 * bb;
            bf16x8 Af[2];
#pragma unroll
            for (int ks = 0; ks < 2; ++ks) { float av[8];
#pragma unroll
                for (int j = 0; j < 8; ++j) { const int kr = 32 * ks + 8 * g + j; av[j] = kr < i0 ? -AT[kr * GAT_P + i0 + fr] : 0.f; }
                Af[ks] = pack8((f32x4){av[0], av[1], av[2], av[3]}, (f32x4){av[4], av[5], av[6], av[7]}); }
            const f32x4 dv4 = *(const LAS f32x4*)(Dm + bb * 256 + fr * 16 + 4 * g);
            const bf16x8 Df = pack8(dv4, (f32x4){0.f, 0.f, 0.f, 0.f});
#pragma unroll
            for (int nt = 0; nt < 2; ++nt) { const int col = 32 * wave + 16 * nt + fr; LAS float* X = (col < 128 ? Vs + col : Ws + (col - 128));
                f32x4 acc;
#pragma unroll
                for (int rg = 0; rg < 4; ++rg) acc[rg] = X[(i0 + 4 * g + rg) * GP];
                if (bb > 0) {
#pragma unroll
                    for (int ks = 0; ks < 2; ++ks) { if (32 * ks < i0) { float xv[8];
#pragma unroll
                        for (int j = 0; j < 8; ++j) xv[j] = X[(32 * ks + 8 * g + j) * GP];
                        acc = __builtin_amdgcn_mfma_f32_16x16x32_bf16(Af[ks], pack8((f32x4){xv[0], xv[1], xv[2], xv[3]}, (f32x4){xv[4], xv[5], xv[6], xv[7]}), acc, 0, 0, 0); } } }
                const f32x4 xb = __builtin_amdgcn_mfma_f32_16x16x32_bf16(Df, pack8(acc, (f32x4){0.f, 0.f, 0.f, 0.f}), (f32x4){0.f, 0.f, 0.f, 0.f}, 0, 0, 0);
#pragma unroll
                for (int rg = 0; rg < 4; ++rg) X[(i0 + 4 * g + rg) * GP] = xb[rg]; }
        }
    }
    LDS_BARRIER();
    { float* Up = (float*)(rec + PREP_UP); bf16* Wf = (bf16*)(rec + PREP_WP);
        for (int it = tid; it < 2048; it += NTHREADS) { const int dv = it & 127, g = (it >> 7) & 3, mi = it >> 9; const int c0 = 16 * mi + 4 * g;
            *(f32x4*)(Up + (size_t)it * 4) = (f32x4){Vs[c0 * GP + dv], Vs[(c0 + 1) * GP + dv], Vs[(c0 + 2) * GP + dv], Vs[(c0 + 3) * GP + dv]}; }
        for (int it = tid; it < 1024; it += NTHREADS) { const int blk = it >> 6, l = it & 63, mi = blk >> 2, ks = blk & 3, g = l >> 4, c = 16 * mi + (l & 15);
            *(bf16x8*)(Wf + it * 8) = pack8(*(LAS f32x4*)(Ws + c * GP + 32 * ks + 4 * g), *(LAS f32x4*)(Ws + c * GP + 32 * ks + 16 + 4 * g)); }
    }
    asm volatile("" :: "v"(pfx));
    LDS_BARRIER();
}

constexpr int SC_BUFSZ = 57344, SC_OT = 2 * SC_BUFSZ, SC_OTSZ = 64 * 128 * 2, SC_END = SC_OT + 2 * SC_OTSZ;
static_assert(SC_END <= TOP_OFF, "scan LDS");
__device__ __forceinline__ void gdn_scan(Frame& F, const Args& a, int bh) {
    const int tid = F.tid, lane = F.lane, w = F.wave, fr = lane & 15, g = lane >> 4; const int b = bh >> 2, h = bh & 3;
    const unsigned char* rec0 = F.ws + WS_PREP + (size_t)bh * NCHUNK * PREP_REC;
    const float* gnw = a.in[6]; const bf16* zg = (const bf16*)(F.ws + WS_ZG); bf16* mix = (bf16*)(F.ws + WS_MIX);
    const size_t rowb = (size_t)b * SEQ; const unsigned lds0 = (unsigned)(uintptr_t)F.lds;
    if (w >= 4) {
        const int hw = w - 4, l16 = lane & 15, rq = lane >> 4;
#define SC_DMA(n_, buf_) do { const unsigned char* src_ = rec0 + (size_t)(n_) * PREP_REC + hw * 14336 + lane * 16; _Pragma("unroll") for (int r_ = 0; r_ < 14; ++r_) \
        glds16_asm(src_ + r_ * 1024, (unsigned)__builtin_amdgcn_readfirstlane((int)(lds0 + (buf_) * SC_BUFSZ + hw * 14336 + r_ * 1024))); } while (0)
#define SC_NORM(n_, gv) do { const LAS unsigned char* ot = F.lds + SC_OT + ((n_) & 1) * SC_OTSZ; _Pragma("unroll") for (int q_ = 0; q_ < 4; ++q_) { const int t = 16 * hw + 4 * q_ + rq; \
            const u32x4 ov = *(const LAS u32x4*)(ot + t * 256 + l16 * 16); const f32x4 xa = {bflo(ov.x), bfhi(ov.x), bflo(ov.y), bfhi(ov.y)}, xb = {bflo(ov.z), bfhi(ov.z), bflo(ov.w), bfhi(ov.w)}; \
            float ss_ = (xa[0] * xa[0] + xa[1] * xa[1]) + (xa[2] * xa[2] + xa[3] * xa[3]) + (xb[0] * xb[0] + xb[1] * xb[1]) + (xb[2] * xb[2] + xb[3] * xb[3]); \
            ss_ = sum_row16(ss_); const float sc = rsqrtf(ss_ * (1.f / 128.f) + EPS); \
            const u32x4 gz = gv[q_]; const f32x4 ga = {bflo(gz.x), bfhi(gz.x), bflo(gz.y), bfhi(gz.y)}, gb = {bflo(gz.z), bfhi(gz.z), bflo(gz.w), bfhi(gz.w)}; \
            *(bf16x8*)(mix + (rowb + (n_) * CHUNK + t) * 1024 + h * 128 + 8 * l16) = pack8(xa * sc * ga, xb * sc * gb); } } while (0)
        u32x4 gc_[4], gn_[4];
        SC_DMA(0, 0);
#pragma unroll
        for (int q = 0; q < 4; ++q) gc_[q] = (u32x4){0u, 0u, 0u, 0u};
        VM_WAIT(); __syncthreads();
#pragma unroll 1
        for (int n = 0; n < NCHUNK; ++n) {
#pragma unroll
            for (int q = 0; q < 4; ++q) gn_[q] = *(const u32x4*)(zg + (rowb + n * CHUNK + 16 * hw + 4 * q + rq) * 2048 + 1536 + h * 128 + 8 * l16);
            if (n + 1 < NCHUNK) SC_DMA(n + 1, (n + 1) & 1);
            if (n > 0) SC_NORM(n - 1, gc_);
            VM_WAIT(); __syncthreads();
#pragma unroll
            for (int q = 0; q < 4; ++q) gc_[q] = gn_[q];
        }
        SC_NORM(NCHUNK - 1, gc_);
#undef SC_DMA
#undef SC_NORM
    } else {
        f32x4 S[2][8];
#pragma unroll
        for (int sl = 0; sl < 2; ++sl)
#pragma unroll
            for (int i = 0; i < 8; ++i) S[sl][i] = (f32x4){0.f, 0.f, 0.f, 0.f};
        f32x4 Un[2][4]; float cd = *(const float*)(rec0 + PREP_CD), cdn;
#pragma unroll
        for (int sl = 0; sl < 2; ++sl)
#pragma unroll
            for (int mi = 0; mi < 4; ++mi) Un[sl][mi] = *(const f32x4*)((const float*)(rec0 + PREP_UP) + (size_t)((mi * 4 + g) * 128 + 32 * w + 16 * sl + fr) * 4);
        __syncthreads();
#pragma unroll 1
        for (int n = 0; n < NCHUNK; ++n) {
            const LAS unsigned char* B = F.lds + (n & 1) * SC_BUFSZ + lane * 16;
            f32x4 vn[2][4], o[2][4];
            { bf16x8 Sb[2][4];
#pragma unroll
                for (int sl = 0; sl < 2; ++sl)
#pragma unroll
                    for (int ks = 0; ks < 4; ++ks) Sb[sl][ks] = pack8(S[sl][2 * ks], S[sl][2 * ks + 1]);
#pragma unroll
                for (int mi = 0; mi < 4; ++mi) { f32x4 t1[2], oo[2];
#pragma unroll
                    for (int sl = 0; sl < 2; ++sl) { t1[sl] = (f32x4){0.f, 0.f, 0.f, 0.f}; oo[sl] = (f32x4){0.f, 0.f, 0.f, 0.f}; }
#pragma unroll
                    for (int ks = 0; ks < 4; ++ks) { const bf16x8 wf = *(const LAS bf16x8*)(B + PREP_WP + (mi * 4 + ks) * 1024), qf = *(const LAS bf16x8*)(B + PREP_QP + (mi * 4 + ks) * 1024);
#pragma unroll
                        for (int sl = 0; sl < 2; ++sl) { t1[sl] = __builtin_amdgcn_mfma_f32_16x16x32_bf16(wf, Sb[sl][ks], t1[sl], 0, 0, 0); oo[sl] = __builtin_amdgcn_mfma_f32_16x16x32_bf16(qf, Sb[sl][ks], oo[sl], 0, 0, 0); } }
#pragma unroll
                    for (int sl = 0; sl < 2; ++sl) { vn[sl][mi] = Un[sl][mi] - t1[sl]; o[sl][mi] = oo[sl]; } } }
            { const int nn = n + 1 < NCHUNK ? n + 1 : n; cdn = *(const float*)(rec0 + (size_t)nn * PREP_REC + PREP_CD);
#pragma unroll
                for (int sl = 0; sl < 2; ++sl)
#pragma unroll
                    for (int mi = 0; mi < 4; ++mi) Un[sl][mi] = *(const f32x4*)((const float*)(rec0 + (size_t)nn * PREP_REC + PREP_UP) + (size_t)((mi * 4 + g) * 128 + 32 * w + 16 * sl + fr) * 4); }
            bf16x8 Vb[2][2];
#pragma unroll
            for (int sl = 0; sl < 2; ++sl)
#pragma unroll
                for (int ks = 0; ks < 2; ++ks) Vb[sl][ks] = pack8(vn[sl][2 * ks], vn[sl][2 * ks + 1]);
#pragma unroll
            for (int mi = 0; mi < 4; ++mi) {
#pragma unroll
                for (int ks = 0; ks < 2; ++ks) { const bf16x8 af = *(const LAS bf16x8*)(B + PREP_AP + (mi * 2 + ks) * 1024);
#pragma unroll
                    for (int sl = 0; sl < 2; ++sl) o[sl][mi] = __builtin_amdgcn_mfma_f32_16x16x32_bf16(af, Vb[sl][ks], o[sl][mi], 0, 0, 0); }
#pragma unroll
                for (int sl = 0; sl < 2; ++sl) { LAS bf16* otw = (LAS bf16*)(F.lds + SC_OT + (n & 1) * SC_OTSZ) + 32 * w + 16 * sl + fr;
                    const unsigned p01 = pk2(o[sl][mi][0], o[sl][mi][1]), p23 = pk2(o[sl][mi][2], o[sl][mi][3]);
                    otw[(16 * mi + 4 * g) * 128] = (bf16)(p01 & 0xffffu); otw[(16 * mi + 4 * g + 1) * 128] = (bf16)(p01 >> 16); otw[(16 * mi + 4 * g + 2) * 128] = (bf16)(p23 & 0xffffu); otw[(16 * mi + 4 * g + 3) * 128] = (bf16)(p23 >> 16); } }
#pragma unroll
            for (int ti = 0; ti < 8; ++ti) { f32x4 s0 = S[0][ti] * cd, s1 = S[1][ti] * cd;
#pragma unroll
                for (int ks = 0; ks < 2; ++ks) { const bf16x8 kf = *(const LAS bf16x8*)(B + PREP_KT + (ti * 2 + ks) * 1024);
                    s0 = __builtin_amdgcn_mfma_f32_16x16x32_bf16(kf, Vb[0][ks], s0, 0, 0, 0); s1 = __builtin_amdgcn_mfma_f32_16x16x32_bf16(kf, Vb[1][ks], s1, 0, 0, 0); }
                S[0][ti] = s0; S[1][ti] = s1; }
            __syncthreads();
            cd = cdn;
        }
    }
    __syncthreads();
}

constexpr int AT_K = 0, AT_V = 49152, AT_BIAS = 98304, AT_LW = 98304 + 1024, AT_END = AT_LW + 1024;
constexpr size_t WS_P4 = 616 * MiB, WS_P16 = 648 * MiB, WS_L4 = 744 * MiB, WS_L16 = 745 * MiB;
static_assert(WS_P16 + (size_t)T * 512 * 2 <= WS_MIX && WS_L16 + (size_t)T * 8 * 4 <= WS_XN, "attention partial buffers");
__device__ __forceinline__ void attn_unit(Frame& F, const Args& a, int u) {
    int kind, b, h, r, q0;
    if (u < 1024) { kind = 2; b = u >> 7; h = (u >> 4) & 7; r = u & 15; q0 = 0; }
    else if (u < 2048) { const int v = u - 1024; kind = 1; b = v >> 7; h = (v >> 4) & 7; r = (v >> 2) & 3; q0 = (v & 3) * 256; }
    else { const int v = u - 2048; kind = 0; b = v >> 7; h = (v >> 4) & 7; r = 0; q0 = (v & 15) * 256; }
    const int dsh = 2 * kind, lmax = (SEQ >> dsh) - 1;
    const bf16* qb = (const bf16*)(F.ws + WS_QB); const bf16* kb = (const bf16*)(F.ws + WS_KB); const bf16* vb = (const bf16*)(F.ws + WS_VB); bf16* mix = (bf16*)(F.ws + WS_MIX);
    const float* relb = a.in[9];
    LAS float* biasL = (LAS float*)(F.lds + AT_BIAS); LAS float* lw = (LAS float*)(F.lds + AT_LW) + F.wave * 32;
    const int tid = F.tid, lane = F.lane, w = F.wave, c = lane & 31, hh = lane >> 5;
    const size_t hrow = (size_t)(b * AH + h) * SEQ; const unsigned lds0 = (unsigned)(uintptr_t)F.lds;
    { const int ro = lane >> 3, p = lane & 7;
#pragma unroll
        for (int i = 0; i < 6; ++i) { const int lr = 48 * w + 8 * i + ro; int pos = q0 - 128 + lr; pos = pos < 0 ? 0 : (pos > lmax ? lmax : pos);
            const size_t eo = (hrow + (size_t)(pos << dsh) + r) * 64 + (size_t)((p ^ (lr & 7)) * 8);
            glds16_asm(kb + eo, (unsigned)__builtin_amdgcn_readfirstlane((int)(lds0 + AT_K + (48 * w + 8 * i) * 128)));
            glds16_asm(vb + eo, (unsigned)__builtin_amdgcn_readfirstlane((int)(lds0 + AT_V + (48 * w + 8 * i) * 128))); } }
    if (tid < 132) biasL[tid] = relb[(int)T5B[kind][tid] * AH + h] * LOG2E;
    const int qi = q0 + 32 * w + c;
    bf16x8 Qf[4];
    { const bf16* qp = qb + (hrow + (size_t)(qi << dsh) + r) * 64 + 8 * hh;
#pragma unroll
        for (int ks = 0; ks < 4; ++ks) Qf[ks] = *(const bf16x8*)(qp + 16 * ks); }
    VM_WAIT(); __syncthreads();
    f32x16 O0 = {}, O1 = {}; float lsum = 0.f;
    const int kt0 = (128 - q0 - 32 * w) > 0 ? ((128 - q0 - 32 * w) >> 5) : 0;
    const int li = lane & 15, gq = lane >> 4;
#pragma unroll 1
    for (int kt = kt0; kt < 5; ++kt) {
        const int lr0 = 32 * (w + kt);
        f32x16 sT = {};
        { const int lr = lr0 + c; const LAS unsigned char* kp = F.lds + AT_K + lr * 128;
#pragma unroll
            for (int ks = 0; ks < 4; ++ks) { const bf16x8 kf = *(const LAS bf16x8*)(kp + (((2 * ks + hh) ^ (lr & 7)) * 16)); sT = __builtin_amdgcn_mfma_f32_32x32x16_bf16(kf, Qf[ks], sT, 0, 0, 0); } }
        float p[16];
#pragma unroll
        for (int reg = 0; reg < 16; ++reg) { const int kr = (reg & 3) + 8 * (reg >> 2) + 4 * hh; const int s = 128 + c - 32 * kt - kr; const int kpos = q0 - 128 + lr0 + kr;
            const bool ok = (s >= 0) && (s <= 128) && (kpos >= 0); const int sc_ = s < 0 ? 0 : (s > 128 ? 128 : s);
            const float e = __builtin_amdgcn_exp2f(sT[reg] + biasL[sc_]); p[reg] = ok ? e : 0.f; lsum += p[reg]; }
        bf16x8 Pf[2];
#pragma unroll
        for (int s2 = 0; s2 < 2; ++s2) { u32x4 wv; wv.x = pk2(p[8 * s2], p[8 * s2 + 1]); wv.y = pk2(p[8 * s2 + 2], p[8 * s2 + 3]); wv.z = pk2(p[8 * s2 + 4], p[8 * s2 + 5]); wv.w = pk2(p[8 * s2 + 6], p[8 * s2 + 7]); Pf[s2] = __builtin_bit_cast(bf16x8, wv); }
#pragma unroll
        for (int s2 = 0; s2 < 2; ++s2)
#pragma unroll
            for (int ntl = 0; ntl < 2; ++ntl) {
                const int rowl = lr0 + 16 * s2 + 4 * hh + (li >> 2), rowh = rowl + 8; const int ch = 4 * ntl + 2 * (gq & 1) + ((li & 3) >> 1), sub = (li & 1) * 8;
                const s16x4 lo = __builtin_bit_cast(s16x4, __builtin_amdgcn_ds_read_tr16_b64_v4i16((LAS s16x4*)(F.lds + AT_V + rowl * 128 + ((ch ^ (rowl & 7)) * 16) + sub)));
                const s16x4 hi = __builtin_bit_cast(s16x4, __builtin_amdgcn_ds_read_tr16_b64_v4i16((LAS s16x4*)(F.lds + AT_V + rowh * 128 + ((ch ^ (rowh & 7)) * 16) + sub)));
                const bf16x8 vf = (bf16x8){lo[0], lo[1], lo[2], lo[3], hi[0], hi[1], hi[2], hi[3]};
                if (ntl == 0) O0 = __builtin_amdgcn_mfma_f32_32x32x16_bf16(Pf[s2], vf, O0, 0, 0, 0); else O1 = __builtin_amdgcn_mfma_f32_32x32x16_bf16(Pf[s2], vf, O1, 0, 0, 0);
            }
    }
    lsum = sum_xor32(lsum);
    if (hh == 0) lw[c] = lsum;
    LDS_BARRIER();
    { LAS float* ost = (LAS float*)(F.lds + w * 8192);
#pragma unroll
        for (int reg = 0; reg < 16; ++reg) { const int qrow = (reg & 3) + 8 * (reg >> 2) + 4 * hh; ost[qrow * 64 + c] = O0[reg]; ost[qrow * 64 + 32 + c] = O1[reg]; }
        LDS_WAIT();
        const int row = lane >> 1, half = lane & 1; const float l1 = lw[row]; const LAS f32x4* op = (const LAS f32x4*)(ost + row * 64 + 32 * half);
        const size_t tok = (size_t)b * SEQ + (size_t)((q0 + 32 * w + row) << dsh) + r;
        if (kind != 0) {
            bf16* pp = (bf16*)(F.ws + (kind == 1 ? WS_P4 : WS_P16)) + (tok * 8 + h) * 64 + 32 * half; const float inv = 1.f / l1;
#pragma unroll
            for (int q = 0; q < 4; ++q) *(bf16x8*)(pp + 8 * q) = pack8(op[2 * q] * inv, op[2 * q + 1] * inv);
            if (half == 0) ((float*)(F.ws + (kind == 1 ? WS_L4 : WS_L16)))[tok * 8 + h] = l1;
        } else {
            const bf16* p4 = (const bf16*)(F.ws + WS_P4) + (tok * 8 + h) * 64 + 32 * half; const bf16* p16 = (const bf16*)(F.ws + WS_P16) + (tok * 8 + h) * 64 + 32 * half;
            const float l4 = ((const float*)(F.ws + WS_L4))[tok * 8 + h], l16 = ((const float*)(F.ws + WS_L16))[tok * 8 + h]; const float inv = 1.f / (l1 + l4 + l16);
            bf16* dst = mix + tok * 1024 + 512 + h * 64 + 32 * half;
#pragma unroll
            for (int q = 0; q < 4; ++q) { const u32x4 a4 = *(const u32x4*)(p4 + 8 * q), a16 = *(const u32x4*)(p16 + 8 * q);
                const f32x4 x0 = (op[2 * q] + (f32x4){bflo(a4.x), bfhi(a4.x), bflo(a4.y), bfhi(a4.y)} * l4 + (f32x4){bflo(a16.x), bfhi(a16.x), bflo(a16.y), bfhi(a16.y)} * l16) * inv;
                const f32x4 x1 = (op[2 * q + 1] + (f32x4){bflo(a4.z), bfhi(a4.z), bflo(a4.w), bfhi(a4.w)} * l4 + (f32x4){bflo(a16.z), bfhi(a16.z), bflo(a16.w), bfhi(a16.w)} * l16) * inv;
                *(bf16x8*)(dst + 8 * q) = pack8(x0, x1); }
        }
    }
    LDS_BARRIER();
}

constexpr int RT_LCNT = 0, RT_BASE = 256, RT_RANK = 512;
__device__ __forceinline__ void route_phase(Frame& F, const Args& a) {
    const bf16* hsrc = (const bf16*)(F.ws + WS_HBF); const bf16* wrT = (const bf16*)(F.ws + WS_WRT); const float* b_r = a.in[13];
    int* te = (int*)(F.ws + WS_TE); int* tslot = (int*)(F.ws + WS_TSLOT); float* tg = (float*)(F.ws + WS_TG); int* list = (int*)(F.ws + WS_LIST); float* lrs = (float*)(F.ws + WS_LRS);
    LAS int* lcnt = (LAS int*)(F.lds + RT_LCNT); LAS int* lbase = (LAS int*)(F.lds + RT_BASE); LAS int* lrank = (LAS int*)(F.lds + RT_RANK);
    const int lane = F.lane, c = lane & 31, hh = lane >> 5;
    for (int blk = F.vcu; blk < T / 128; blk += F.G) {
        if (F.tid < 32) lcnt[F.tid] = 0;
        __syncthreads();
        int e4[4] = {0, 0, 0, 0}, rk[4] = {0, 0, 0, 0}; float g4[4] = {0.f, 0.f, 0.f, 0.f}; float rs = 0.f; const int tok = blk * 128 + (F.wave & 3) * 32 + c;
        f32x16 acc = {}; float ss = 0.f;
        { const int kh = F.wave >> 2; const bf16* hp = hsrc + (size_t)tok * D + 8 * hh + 512 * kh; const bf16* wph = (const bf16*)wrT + (size_t)c * D + 8 * hh + 512 * kh; const bf16* wpl = wph + NE * D;
#pragma unroll 8
            for (int q = 0; q < 32; ++q) { const u32x4 hr = *(const u32x4*)(hp + 16 * q); const bf16x8 wh = *(const bf16x8*)(wph + 16 * q), wl = *(const bf16x8*)(wpl + 16 * q);
                const f32x4 ha = {bflo(hr.x), bfhi(hr.x), bflo(hr.y), bfhi(hr.y)}, hb2 = {bflo(hr.z), bfhi(hr.z), bflo(hr.w), bfhi(hr.w)};
                ss += (ha[0] * ha[0] + ha[1] * ha[1]) + (ha[2] * ha[2] + ha[3] * ha[3]) + (hb2[0] * hb2[0] + hb2[1] * hb2[1]) + (hb2[2] * hb2[2] + hb2[3] * hb2[3]);
                const bf16x8 hv = __builtin_bit_cast(bf16x8, hr);
                acc = __builtin_amdgcn_mfma_f32_32x32x16_bf16(wh, hv, acc, 0, 0, 0); acc = __builtin_amdgcn_mfma_f32_32x32x16_bf16(wl, hv, acc, 0, 0, 0); }
            LAS float* px = (LAS float*)(F.lds + 4096) + ((F.wave & 3) * 64 + lane) * 17;
            if (F.wave >= 4) {
#pragma unroll
                for (int r = 0; r < 16; ++r) px[r] = acc[r];
                px[16] = ss; }
            __syncthreads();
            if (F.wave < 4) {
#pragma unroll
                for (int r = 0; r < 16; ++r) acc[r] += px[r];
                ss += px[16]; } }
        if (F.wave < 4) {
            ss = sum_xor32(ss); rs = rsqrtf(ss * (1.f / D) + EPS);
            float tv[4] = {-3.0e38f, -3.0e38f, -3.0e38f, -3.0e38f}; int tix[4] = {0, 1, 2, 3};
            f32x4 brv[4];
#pragma unroll
            for (int q = 0; q < 4; ++q) brv[q] = *(const f32x4*)(b_r + 8 * q + 4 * hh);
#pragma unroll
            for (int reg = 0; reg < 16; ++reg) { const int e = (reg & 3) + 8 * (reg >> 2) + 4 * hh; float v = acc[reg] * rs + brv[reg >> 2][reg & 3]; int ix = e;
#pragma unroll
                for (int s = 0; s < 4; ++s) { const bool gt = (v > tv[s]) || (v == tv[s] && ix < tix[s]); const float ov = tv[s]; const int oi = tix[s]; tv[s] = gt ? v : ov; tix[s] = gt ? ix : oi; v = gt ? ov : v; ix = gt ? oi : ix; } }
            float pv[4]; int pi[4];
#pragma unroll
            for (int s = 0; s < 4; ++s) { pv[s] = __shfl_xor(tv[s], 32); pi[s] = __shfl_xor(tix[s], 32); }
#pragma unroll
            for (int t2 = 0; t2 < 4; ++t2) { float v = pv[t2]; int ix = pi[t2];
#pragma unroll
                for (int s = 0; s < 4; ++s) { const bool gt = (v > tv[s]) || (v == tv[s] && ix < tix[s]); const float ov = tv[s]; const int oi = tix[s]; tv[s] = gt ? v : ov; tix[s] = gt ? ix : oi; v = gt ? ov : v; ix = gt ? oi : ix; } }
            const float e0 = 1.f, e1 = __expf(tv[1] - tv[0]), e2 = __expf(tv[2] - tv[0]), e3 = __expf(tv[3] - tv[0]); const float inv = 1.f / (e0 + e1 + e2 + e3);
            g4[0] = e0 * inv; g4[1] = e1 * inv; g4[2] = e2 * inv; g4[3] = e3 * inv;
#pragma unroll
            for (int s = 0; s < 4; ++s) e4[s] = tix[s];
            if (hh == 0) {
#pragma unroll
                for (int s = 0; s < 4; ++s) rk[s] = atomicAdd((int*)(lcnt + e4[s]), 1);
            }
        }
        __syncthreads();
        if (F.tid < 32) lbase[F.tid] = (int)__hip_atomic_fetch_add(F.ctl + CW_GCNT + 64 * F.tid, (unsigned)lcnt[F.tid], RLX_AGENT);
        __syncthreads();
        if (F.wave < 4 && hh == 0) {
#pragma unroll
            for (int s = 0; s < 4; ++s) { const int slot = lbase[e4[s]] + rk[s]; te[tok * 4 + s] = e4[s]; tslot[tok * 4 + s] = slot; tg[tok * 4 + s] = g4[s];
                list[(size_t)e4[s] * LCAP + slot] = tok; lrs[(size_t)e4[s] * LCAP + slot] = rs; }
        }
        __syncthreads();
    }
}
__device__ __forceinline__ int moe_tables(Frame& F) {
    LAS int* tstart = (LAS int*)(F.lds + MOE_TSTART); LAS int* lcnt = (LAS int*)(F.lds + MOE_LCNT); LAS int* texp = (LAS int*)(F.lds + MOE_TEXP);
    if (F.tid < 64) {
        const int lane = F.lane; const int cnt = lane < NE ? (int)__hip_atomic_load(F.ctl + CW_GCNT + 64 * (lane & 31), RLX_AGENT) : 0; const int nt = (cnt + 255) >> 8;
        int inc = nt;
#pragma unroll
        for (int o = 1; o < 32; o <<= 1) { const int up = __shfl_up(inc, o); if (lane >= o) inc += up; }
        if (lane < NE) { const int start = inc - nt; lcnt[lane] = cnt; tstart[lane] = start; for (int i = 0; i < nt; ++i) texp[start + i] = lane; if (lane == NE - 1) tstart[NE] = inc; }
    }
    __syncthreads();
    return tstart[NE];
}
__device__ __forceinline__ void combine_phase(Frame& F, const Args& a, float* dst) {
    LAS int* tstart = (LAS int*)(F.lds + MOE_TSTART);
    const int* te = (const int*)(F.ws + WS_TE); const int* tslot = (const int*)(F.ws + WS_TSLOT); const float* tg = (const float*)(F.ws + WS_TG); const unsigned char* Y = F.ws + WS_Y;
    const bf16* hbf = (const bf16*)(F.ws + WS_HBF); const int gw = F.vcu * NWAVES + F.wave, NGW = F.G * NWAVES, lane = F.lane;
    for (int t0 = gw * 16; t0 < T; t0 += NGW * 16) {
        int pos[4]; float gt[4];
        { const int tl = t0 + (lane & 15);
#pragma unroll
            for (int s = 0; s < 4; ++s) { const int e = te[tl * 4 + s]; pos[s] = tstart[e] * 256 + tslot[tl * 4 + s]; gt[s] = tg[tl * 4 + s]; } }
#pragma unroll 1
        for (int i = 0; i < 16; i += 2) {
            f32x4 o[2][4]; u32x4 w[2][4];
#pragma unroll
            for (int q = 0; q < 2; ++q) { const bf16* hp = hbf + (size_t)(t0 + i + q) * D + 16 * lane;
#pragma unroll
                for (int j = 0; j < 2; ++j) { const u32x4 hr = *(const u32x4*)(hp + 8 * j); o[q][2 * j] = (f32x4){bflo(hr.x), bfhi(hr.x), bflo(hr.y), bfhi(hr.y)}; o[q][2 * j + 1] = (f32x4){bflo(hr.z), bfhi(hr.z), bflo(hr.w), bfhi(hr.w)}; }
#pragma unroll
                for (int s = 0; s < 4; ++s) { const size_t p = (size_t)__builtin_amdgcn_readlane(pos[s], i + q); w[q][s] = *(const u32x4*)(Y + p * D + 16 * lane); } }
#pragma unroll
            for (int q = 0; q < 2; ++q) { float* op = dst + (size_t)(t0 + i + q) * D + 16 * lane;
#pragma unroll
                for (int s = 0; s < 4; ++s) { const float g = __builtin_bit_cast(float, __builtin_amdgcn_readlane(__builtin_bit_cast(int, gt[s]), i + q));
#pragma unroll
                    for (int j = 0; j < 4; ++j) { const int ww = (int)w[q][s][j]; const f32x2 lo = __builtin_amdgcn_cvt_pk_f32_fp8(ww, false), hi = __builtin_amdgcn_cvt_pk_f32_fp8(ww, true);
                        o[q][j] += (f32x4){lo[0], lo[1], hi[0], hi[1]} * g; } }
#pragma unroll
                for (int j = 0; j < 4; ++j) *(f32x4*)(op + 4 * j) = o[q][j]; }
        }
    }
}

constexpr int NPHASE = 9;
__global__ void __launch_bounds__(NTHREADS, 2) hymba_fwd(Args args) {
    extern __shared__ __attribute__((aligned(16))) unsigned char lds_raw[];
    Frame F; F.lds = (LAS unsigned char*)lds_raw; F.ws = args.ws; F.ctl = (unsigned*)(args.ws + WS_CTL);
    F.tid = threadIdx.x; F.lane = F.tid & 63; F.wave = __builtin_amdgcn_readfirstlane(F.tid >> 6);
    F.G = gridDim.x; { const int bx = blockIdx.x; F.vcu = (F.G % 8 == 0) ? (bx % 8) * (F.G / 8) + bx / 8 : bx; }
    volatile LAS unsigned* MISC = (volatile LAS unsigned*)(F.lds + MISC_OFF);
    if (F.tid < 32) MISC[F.tid] = 0u;
    __syncthreads();
    XcdBarrier bar; bar.bar = F.ctl + CW_BAR; bar.x = 0; bar.st = nullptr;
    if (MK_N_LAUNCHES == 1) bar = xcd_barrier_post(F.ctl + CW_BAR, MISC + 8);
    const int lo = args.ph_lo, hi = args.ph_hi;
#define IN(k) (lo <= (k) && (k) < hi)
#define SEAM(k) do { if (IN(k) && IN((k) + 1)) xcd_barrier(bar); } while (0)

    if (IN(0)) { for (int rep = 0; rep < (DUP == 4 ? 2 : 1); ++rep) phase0(F, args); SEAM(0); }
    if (IN(1)) {
        pg8::Gemm g{(const bf16*)(F.ws + WS_XN), (const bf16*)(F.ws + WS_WIN), D}; pg8::StaticOrder S{T / 256, NIN / 256, F.G, (int)blockIdx.x};
        pg8::EpiInProj E{(bf16*)(F.ws + WS_ZG), (bf16*)(F.ws + WS_QB), (bf16*)(F.ws + WS_KB), (bf16*)(F.ws + WS_VB), args.in[7], args.in[8], F.lds + RING_BYTES, args.in[6]};
        pg8::gemm_phase<pg8::EpiInProj, pg8::StaticOrder, false, true, false, (DUP == 18 ? 2 : 1)>(F.lds, g, S, E);
#if DUP == 5
        __syncthreads(); pg8::gemm_phase<pg8::EpiInProj, pg8::StaticOrder, false, true>(F.lds, g, S, E);
#endif
        SEAM(1);
    }
    if (IN(2)) {
        for (int rep = 0; rep < (DUP == 1 ? 2 : 1); ++rep)
        for (int u = F.vcu; u < NBATCH * GH * NCHUNK; u += F.G) gdn_prep_unit(F, args, u, u + F.G < NBATCH * GH * NCHUNK ? u + F.G : -1);
        SEAM(2);
    }
    if (IN(3)) {
        const int nscan = NBATCH * GH;
        for (int rep3 = 0; rep3 < (DUP == 13 ? 2 : 1); ++rep3) {
        for (int bh = blockIdx.x; bh < nscan; bh += F.G) { gdn_scan(F, args, bh);
#if DUP == 3
            gdn_scan(F, args, bh);
#endif
        }
        if (rep3 == 0) { if (F.G > nscan) { if ((int)blockIdx.x >= nscan) { p0_experts(F, args, ((int)blockIdx.x - nscan) * NWAVES + F.wave, (F.G - nscan) * NWAVES);
#if DUP == 15
            __syncthreads(); p0_experts(F, args, ((int)blockIdx.x - nscan) * NWAVES + F.wave, (F.G - nscan) * NWAVES);
#endif
            } } else p0_experts(F, args, (int)blockIdx.x * NWAVES + F.wave, F.G * NWAVES); __syncthreads(); }
        for (int pass = 0; pass < 2; ++pass) {
            for (int rep = 0; rep < (DUP == 2 ? 2 : 1); ++rep)
            for (;;) {
                if (F.tid == 0) MISC[16] = __hip_atomic_fetch_add(F.ctl + CW_ATTQ + 64 * (pass + 2 * rep + 4 * rep3), 1u, RLX_AGENT);
                __syncthreads();
                const int u = (int)MISC[16] + (pass ? 2048 : 0);
                __syncthreads();
                if (u >= (pass ? 3072 : 2048)) break;
                attn_unit(F, args, u);
            }
            if (pass == 0 || DUP == 13) xcd_barrier(bar);
        } }
        SEAM(3);
    }
    if (IN(4)) {
        pg8::Gemm g{(const bf16*)(F.ws + WS_MIX), (const bf16*)(F.ws + WS_WOUT), D}; pg8::StaticOrder S{T / 256, D / 256, F.G, (int)blockIdx.x};
        pg8::EpiOutProj E{args.in[0], (bf16*)(F.ws + WS_HBF), F.ws + WS_HB, F.lds + RING_BYTES};
        pg8::gemm_phase<pg8::EpiOutProj, pg8::StaticOrder, false, true>(F.lds, g, S, E);
#if DUP == 6
        __syncthreads(); pg8::gemm_phase<pg8::EpiOutProj, pg8::StaticOrder, false, true>(F.lds, g, S, E);
#endif
        SEAM(4);
    }
#if !SKIP_MOE
    if (IN(5)) {
        if (DUP == 10) { route_phase(F, args); xcd_barrier(bar); if (blockIdx.x == 0 && F.tid < 32) __hip_atomic_store(F.ctl + CW_GCNT + 64 * F.tid, 0u, RLX_AGENT); xcd_barrier(bar); }
        route_phase(F, args); SEAM(5); }
    if (IN(6)) {
        const int nM = moe_tables(F);
        pg8::Gemm g{(const bf16*)(F.ws + WS_HB), (const bf16*)(F.ws + WS_WGU), D};
        pg8::MoeOrder S{nM, 8, F.G, (int)blockIdx.x, (const LAS int*)(F.lds + MOE_TSTART), (const LAS int*)(F.lds + MOE_LCNT), (const LAS int*)(F.lds + MOE_TEXP), (const int*)(F.ws + WS_LIST)};
        pg8::EpiGateUp E{F.ws + WS_ACT, args.in[15], (const float*)(F.ws + WS_LRS), (const LAS int*)(F.lds + MOE_LCNT), F.lds + RING_BYTES};
        pg8::gemm_phase<pg8::EpiGateUp, pg8::MoeOrder, true, true, true, (DUP == 17 ? 2 : 1)>(F.lds, g, S, E);
#if DUP == 7
        __syncthreads(); pg8::gemm_phase<pg8::EpiGateUp, pg8::MoeOrder, true, true, true>(F.lds, g, S, E);
#endif
        SEAM(6);
    }
    if (IN(7)) {
        const int nM = moe_tables(F);
        pg8::Gemm g{(const bf16*)(F.ws + WS_ACT), (const bf16*)(F.ws + WS_WDN), FF};
        pg8::MoeOrder S{nM, 4, F.G, (int)blockIdx.x, (const LAS int*)(F.lds + MOE_TSTART), (const LAS int*)(F.lds + MOE_LCNT), (const LAS int*)(F.lds + MOE_TEXP), (const int*)(F.ws + WS_LIST)};
        pg8::EpiDown E{F.ws + WS_Y, args.in[17], F.lds + RING_BYTES};
        pg8::gemm_phase<pg8::EpiDown, pg8::MoeOrder, false, true, true>(F.lds, g, S, E);
#if DUP == 8
        __syncthreads(); pg8::gemm_phase<pg8::EpiDown, pg8::MoeOrder, false, true, true>(F.lds, g, S, E);
#endif
        SEAM(7);
    }
#if DUP == 16
    if (IN(8)) { for (int i_ = 0; i_ < 8; ++i_) xcd_barrier(bar); }
#endif
    if (IN(8)) { (void)moe_tables(F); if (DUP == 11) combine_phase(F, args, (float*)(F.ws + WS_ZG)); combine_phase(F, args, args.out); }
#endif
#undef IN
#undef SEAM
}

extern "C" void kernel_launch(void* const* d_in, const int* in_sizes, int n_in, void* d_out, int out_size, void* d_ws, size_t ws_size, hipStream_t stream) {
    static int grid = 0;
    if (grid == 0) {
        if (n_in != 18 || in_sizes[0] != T * D || out_size != T * D || ws_size < WS_END) { fprintf(stderr, "kernel_launch: unexpected shapes (n_in %d, in0 %d, out %d, ws %zu)\n", n_in, n_in > 0 ? in_sizes[0] : -1, out_size, ws_size); grid = -1; return; }
        int dev = 0, cus = 0, per_cu = 0;
        if (hipGetDevice(&dev) != hipSuccess || hipDeviceGetAttribute(&cus, hipDeviceAttributeMultiprocessorCount, dev) != hipSuccess) { grid = -1; return; }
        if (hipFuncSetAttribute((const void*)hymba_fwd, hipFuncAttributeMaxDynamicSharedMemorySize, LDS_BYTES) != hipSuccess) { fprintf(stderr, "kernel_launch: hipFuncSetAttribute failed\n"); grid = -1; return; }
        if (hipOccupancyMaxActiveBlocksPerMultiprocessor(&per_cu, (const void*)hymba_fwd, NTHREADS, LDS_BYTES) != hipSuccess || per_cu < 1) { fprintf(stderr, "kernel_launch: occupancy query says %d\n", per_cu); per_cu = 1; }
        (void)hipGetLastError();
        grid = cus;
    }
    if (grid < 0) return;
    (void)hipMemsetAsync((char*)d_ws + WS_CTL, 0, CTL_ZERO_BYTES, stream);
    Args a{};
    for (int i = 0; i < 18; ++i) a.in[i] = (const float*)d_in[i];
    a.out = (float*)d_out; a.ws = (unsigned char*)d_ws;
    if (MK_N_LAUNCHES == 1) {
        a.ph_lo = 0; a.ph_hi = NPHASE; a.li = 0;
        void* kargs[] = {&a};
        hipError_t e = hipLaunchCooperativeKernel((const void*)hymba_fwd, dim3(grid), dim3(NTHREADS), kargs, LDS_BYTES, stream);
        if (e != hipSuccess) fprintf(stderr, "kernel_launch: cooperative launch failed: %s (grid %d)\n", hipGetErrorString(e), grid);
    } else {
        for (int p = 0; p < NPHASE; ++p) { a.ph_lo = p; a.ph_hi = p + 1; a.li = p; hipLaunchKernelGGL(hymba_fwd, dim3(grid), dim3(NTHREADS), LDS_BYTES, stream, a); }
    }
}
```

```cpp
#include <hip/hip_runtime.h>
#include <cstdio>
#include <cstdint>

#ifndef MK_N_LAUNCHES
#define MK_N_LAUNCHES 1
#endif
#ifndef SKIP_ATTN
#define SKIP_ATTN 0
#endif
#ifndef DUP
#define DUP 0
#endif
#ifndef ATT_JOBS
#define ATT_JOBS 32
#endif
#ifndef SKIP_MOE
#define SKIP_MOE 0
#endif

#define LAS __attribute__((address_space(3)))
#define GAS __attribute__((address_space(1)))
typedef unsigned short bf16;
typedef short bf16x8 __attribute__((ext_vector_type(8)));
typedef short s16x4 __attribute__((ext_vector_type(4)));
typedef float f32x2 __attribute__((ext_vector_type(2)));
typedef float f32x4 __attribute__((ext_vector_type(4)));
typedef float f32x16 __attribute__((ext_vector_type(16)));
typedef unsigned u32x2 __attribute__((ext_vector_type(2)));
typedef unsigned u32x4 __attribute__((ext_vector_type(4)));
typedef __bf16 bf16x2_t __attribute__((ext_vector_type(2)));
typedef int v4i_t __attribute__((ext_vector_type(4)));
typedef int v8i_t __attribute__((ext_vector_type(8)));

constexpr int NBATCH = 8, SEQ = 4096, D = 1024, T = NBATCH * SEQ;
constexpr int IN_DIM = 3592, NIN = 3584;
constexpr int GH = 4, DK = 128, CHUNK = 64, NCHUNK = SEQ / CHUNK;
constexpr int AH = 8, DH = 64;
constexpr int NE = 32, FF = 1024, LCAP = 32768;
constexpr float EPS = 1e-6f, LOG2E = 1.4426950408889634f;
constexpr int NWAVES = 8, NTHREADS = 512;

constexpr size_t MiB = 1u << 20;
constexpr size_t WS_CTL = 0, CTL_ZERO_BYTES = 64 * 1024;
constexpr size_t WS_WIN = 1 * MiB, WS_WOUT = 8 * MiB, WS_WGU = 10 * MiB, WS_WDN = 138 * MiB;
constexpr size_t WS_TE = 202 * MiB, WS_TSLOT = WS_TE + 512 * 1024, WS_TG = WS_TSLOT + 512 * 1024;
constexpr size_t WS_LIST = 204 * MiB, WS_LRS = 208 * MiB;
constexpr size_t WS_BA = 212 * MiB, WS_WRT = 213 * MiB;
constexpr size_t WS_ZG = 214 * MiB, WS_QB = 342 * MiB, WS_KB = 374 * MiB, WS_VB = 406 * MiB;
constexpr size_t WS_PREP = 438 * MiB;
constexpr int PREP_WP = 0, PREP_QP = 16384, PREP_AP = 32768, PREP_KT = 40960, PREP_UP = 57344, PREP_CD = 90112, PREP_REC = 90368;
constexpr size_t WS_OG = 616 * MiB, WS_MIX = 680 * MiB;
constexpr size_t WS_XN = 760 * MiB, WS_HB = 760 * MiB;
constexpr size_t WS_ACT = 214 * MiB, WS_Y = 352 * MiB, WS_HBF = 488 * MiB, WS_END = 824 * MiB;
static_assert(WS_VB - WS_KB == WS_KB - WS_QB, "q/k/v stride");
static_assert(WS_PREP + (size_t)NBATCH * GH * NCHUNK * PREP_REC <= WS_OG, "prep region");
static_assert(WS_ACT + (size_t)(T * 4 + NE * 256) * FF <= WS_Y && WS_Y + (size_t)(T * 4 + NE * 256) * D <= WS_HBF && WS_HBF + (size_t)T * D * 2 <= 616 * MiB, "act/y/h regions");
constexpr int CW_TMO = 0, CW_CODE = 1, CW_ATTQ = 512, CW_GCNT = 1024  , CW_BAR = 8192;
static_assert((CW_BAR + 3456) * 4 <= (int)CTL_ZERO_BYTES && CW_GCNT + 64 * 32 <= CW_BAR, "control words inside the zeroed region");

constexpr int LDS_BYTES = 160 * 1024;
constexpr int RING_BYTES = 131072;
constexpr int TOP_OFF = LDS_BYTES - 4096;
constexpr int MISC_OFF = TOP_OFF;
constexpr int MOE_TAB_OFF = TOP_OFF + 256;
constexpr int MOE_TSTART = MOE_TAB_OFF, MOE_LCNT = MOE_TAB_OFF + 256, MOE_TEXP = MOE_TAB_OFF + 512;

#define RLX_AGENT __ATOMIC_RELAXED, __HIP_MEMORY_SCOPE_AGENT
#define LDS_WAIT() asm volatile("s_waitcnt lgkmcnt(0)" ::: "memory")
#define VM_WAIT() asm volatile("s_waitcnt vmcnt(0)" ::: "memory")
#define LDS_BARRIER() do { asm volatile("s_waitcnt lgkmcnt(0)" ::: "memory"); __builtin_amdgcn_s_barrier(); asm volatile("" ::: "memory"); } while (0)
__device__ __forceinline__ unsigned pk2(float lo, float hi) { f32x2 v = {lo, hi}; bf16x2_t b = __builtin_convertvector(v, bf16x2_t); return __builtin_bit_cast(unsigned, b); }
__device__ __forceinline__ unsigned pk4_fp8(float a, float b, float c, float d) { int w = 0; w = __builtin_amdgcn_cvt_pk_fp8_f32(a, b, w, false); w = __builtin_amdgcn_cvt_pk_fp8_f32(c, d, w, true); return (unsigned)w; }
__device__ __forceinline__ float bf2f(unsigned short b) { return __uint_as_float((unsigned)b << 16); }
__device__ __forceinline__ float bflo(unsigned w) { return __uint_as_float(w << 16); }
__device__ __forceinline__ float bfhi(unsigned w) { return __uint_as_float(w & 0xffff0000u); }
template <int CTRL> __device__ __forceinline__ float dpp_mov(float v) { return __builtin_bit_cast(float, __builtin_amdgcn_update_dpp(0, __builtin_bit_cast(int, v), CTRL, 0xF, 0xF, true)); }
__device__ __forceinline__ float sum_row16(float v) {
    v += dpp_mov<0xB1>(v);
    v += dpp_mov<0x4E>(v);
    v += dpp_mov<0x141>(v);
    v += dpp_mov<0x140>(v);
    return v; }
__device__ __forceinline__ float sum_xor16(float v) { const unsigned u = __builtin_bit_cast(unsigned, v); auto r = __builtin_amdgcn_permlane16_swap(u, u, false, false); return __builtin_bit_cast(float, (unsigned)r[0]) + __builtin_bit_cast(float, (unsigned)r[1]); }
__device__ __forceinline__ float sum_xor32(float v) { const unsigned u = __builtin_bit_cast(unsigned, v); auto r = __builtin_amdgcn_permlane32_swap(u, u, false, false); return __builtin_bit_cast(float, (unsigned)r[0]) + __builtin_bit_cast(float, (unsigned)r[1]); }
__device__ __forceinline__ float wave_sum(float v) { return sum_xor32(sum_xor16(sum_row16(v))); }
__device__ __forceinline__ float silu_f(float x) { return x * __builtin_amdgcn_rcpf(1.f + __expf(-x)); }
__device__ __forceinline__ float sigmoid_f(float x) { return __builtin_amdgcn_rcpf(1.f + __expf(-x)); }
__device__ __forceinline__ f32x4 silu4(f32x4 v) {
    const f32x4 vc = __builtin_elementwise_max(v, (f32x4){-20.f, -20.f, -20.f, -20.f}); const f32x4 ea = vc * -1.4426950408889634f;
    const f32x4 d = (f32x4){__builtin_amdgcn_exp2f(ea[0]), __builtin_amdgcn_exp2f(ea[1]), __builtin_amdgcn_exp2f(ea[2]), __builtin_amdgcn_exp2f(ea[3])} + 1.f;
    const f32x2 dlo = {d[0], d[1]}, dhi = {d[2], d[3]}; const f32x2 q2 = dlo * dhi; const float rq = __builtin_amdgcn_rcpf(q2[0] * q2[1]); const f32x2 t2 = (f32x2){q2[1], q2[0]} * rq;
    const f32x2 rlo = t2 * dhi, rhi = t2 * dlo; return vc * (f32x4){rlo[0], rlo[1], rhi[0], rhi[1]};
}
__device__ __forceinline__ bf16x8 pack8(f32x4 a, f32x4 b) {
    u32x4 w; w.x = pk2(a[0], a[1]); w.y = pk2(a[2], a[3]); w.z = pk2(b[0], b[1]); w.w = pk2(b[2], b[3]); return __builtin_bit_cast(bf16x8, w);
}

__device__ __forceinline__ void glds16_asm(const void* gsrc, unsigned lds_dst) { unsigned keep;
    asm volatile("s_mov_b32 %0, m0\n\ts_mov_b32 m0, %2\n\ts_nop 0\n\tglobal_load_lds_dwordx4 %1, off\n\ts_mov_b32 m0, %0\n\ts_nop 0" : "=&s"(keep) : "v"(gsrc), "s"(lds_dst) : "memory"); }

namespace pg8 {
constexpr int BM = 256, BK = 64, HALF = 128, HTB = HALF * BK * 2, STAGE_BYTES = 8 * HTB, NXCD = 8, WGM = 8;
__host__ __device__ __forceinline__ int lds_byte(int r, int c) { const int st = (r >> 4) * 2 + (c >> 5), rr = r & 15, cc = c & 31, ob = rr * 64 + cc * 2; return st * 1024 + (ob ^ (((ob >> 9) & 1) << 5)); }
__host__ __device__ __forceinline__ void stage_rc(int b, int& R, int& C) { const int st = b / 1024, sb = b % 1024, swz = sb ^ (((sb >> 9) & 1) << 5); R = (st >> 1) * 16 + swz / 64; C = (st & 1) * 32 + (swz % 64) / 2; }
__host__ __device__ __forceinline__ int perm32(int rho) { const int n = rho >> 4, i = rho & 15; return 8 * (i >> 2) + 4 * n + (i & 3); }

struct Unit { int pm, pn, pb, e, mt; };
struct Gemm { const bf16* A; const bf16* Bt; int K; };

__device__ __forceinline__ bool static_tile(int i, int G, int c, int nM, int nN, int& pm, int& pn) {
    const int nwg = nM * nN; const long L = (long)i * G + c; if (L >= nwg) return false;
    int wgid = (int)L; { const int q = nwg / NXCD, r = nwg % NXCD, xcd = wgid % NXCD, off = wgid / NXCD; wgid = (xcd < r ? xcd * (q + 1) : r * (q + 1) + (xcd - r) * q) + off; }
    const int nig = WGM * nN, gid = wgid / nig, fm = gid * WGM, gsz = (nM - fm) < WGM ? (nM - fm) : WGM;
    pm = fm + ((wgid % nig) % gsz); pn = (wgid % nig) / gsz; return true;
}
struct StaticOrder {
    int nM, nN, G, c;
    __device__ __forceinline__ bool next(int i, Unit& u) const { int pm, pn; if (!static_tile(i, G, c, nM, nN, pm, pn)) return false; u.pm = pm; u.pn = pn; u.pb = pn; u.e = 0; u.mt = 0; return true; }
    __device__ __forceinline__ int row_index(const Unit&, int) const { return 0; }
};
struct MoeOrder {
    int nM, nN, G, c; const LAS int* tstart; const LAS int* lcnt; const LAS int* texp; const int* list;
    __device__ __forceinline__ bool next(int i, Unit& u) const {
        int pm, pn; if (!static_tile(i, G, c, nM, nN, pm, pn)) return false;
        const int e = texp[pm]; u.pm = pm; u.pn = pn; u.e = e; u.pb = e * nN + pn; u.mt = pm - tstart[e]; return true;
    }
    __device__ __forceinline__ int row_index(const Unit& u, int r) const { const int rr = u.mt * 256 + r; const int v = list[u.e * LCAP + rr]; return rr < lcnt[u.e] ? v : 0; }
};

#define PG8_SA(b, h) (((b) * 2 + (h)) * HTB)
#define PG8_SB(b, h) ((4 + (b) * 2 + (h)) * HTB)
#define PG8_GLDS(src, dstoff) __builtin_amdgcn_global_load_lds((const unsigned*)(src), (LAS unsigned*)(lds + (dstoff)), 16, 0, 0)
#define PG8_STAGE_B(bufoff, nx, kb, h) do { _Pragma("unroll") for (int _i = 0; _i < 2; ++_i) \
        PG8_GLDS(((nx) ? nB : cB) + (kb) + (Epi::WIDE ? (size_t)voffBW[h][_i] : (size_t)(h) * hstep + voffB[_i]), (bufoff) + ldsw + _i * 8192); } while (0)
#define PG8_STAGE_A(bufoff, nx, kb, h) do { _Pragma("unroll") for (int _i = 0; _i < 2; ++_i) \
        PG8_GLDS(GATHER ? (const char*)g.A + (kb) + ((nx) ? voffN[h][_i] : voffC[h][_i]) : ((nx) ? nA : cA) + (kb) + (size_t)(h) * hstep + voffA[_i], (bufoff) + ldsw + _i * 8192); } while (0)
#define PG8_LDA8(dst, b, h) do { _Pragma("unroll") for (int m = 0; m < 4; ++m) { const v4i_t lo_ = *(const LAS v4i_t*)(lds + PG8_SA(b, h) + aoff + m * 2048), hi_ = *(const LAS v4i_t*)(lds + PG8_SA(b, h) + aoff + m * 2048 + 1024); dst[m] = __builtin_shufflevector(lo_, hi_, 0, 1, 2, 3, 4, 5, 6, 7); } } while (0)
#define PG8_LDB8(dst, b, h) do { _Pragma("unroll") for (int n = 0; n < 2; ++n) { const v4i_t lo_ = *(const LAS v4i_t*)(lds + PG8_SB(b, h) + boff + n * 2048), hi_ = *(const LAS v4i_t*)(lds + PG8_SB(b, h) + boff + n * 2048 + 1024); dst[n] = __builtin_shufflevector(lo_, hi_, 0, 1, 2, 3, 4, 5, 6, 7); } } while (0)
#define PG8_LDA(dst, b, h) do { _Pragma("unroll") for (int m = 0; m < 4; ++m) _Pragma("unroll") for (int k = 0; k < 2; ++k) dst[m][k] = *(const LAS bf16x8*)(lds + PG8_SA(b, h) + aoff + m * 2048 + k * 1024); } while (0)
#define PG8_LDB(dst, b, h) do { _Pragma("unroll") for (int n = 0; n < 2; ++n) _Pragma("unroll") for (int k = 0; k < 2; ++k) dst[n][k] = *(const LAS bf16x8*)(lds + PG8_SB(b, h) + boff + n * 2048 + k * 1024); } while (0)
#define PG8_MMA(ai, bj, At, Bt) do { __builtin_amdgcn_s_setprio(1); _Pragma("unroll") for (int m = 0; m < 4; ++m) _Pragma("unroll") for (int n = 0; n < 2; ++n) _Pragma("unroll") for (int k = 0; k < 2; ++k) \
        acc[ai][bj][m][n] = __builtin_amdgcn_mfma_f32_16x16x32_bf16(Bt[n][k], At[m][k], acc[ai][bj][m][n], 0, 0, 0); __builtin_amdgcn_s_setprio(0); } while (0)
#define PG8_MMA8(ai, bj, At, Bt) do { __builtin_amdgcn_s_setprio(1); _Pragma("unroll") for (int m = 0; m < 4; ++m) _Pragma("unroll") for (int n = 0; n < 2; ++n) \
        asm volatile("v_mfma_scale_f32_16x16x128_f8f6f4 %0, %1, %2, %0, %3, %4 op_sel_hi:[0,0,0]" : "+v"(acc[ai][bj][m][n]) : "v"(Bt[n]), "v"(At[m]), "v"(sc_w), "v"(sc_a)); __builtin_amdgcn_s_setprio(0); } while (0)
#define PG8_MMAZ(ai, bj, At, Bt) do { __builtin_amdgcn_s_setprio(1); _Pragma("unroll") for (int m = 0; m < 4; ++m) _Pragma("unroll") for (int n = 0; n < 2; ++n) { \
        acc[ai][bj][m][n] = __builtin_amdgcn_mfma_f32_16x16x32_bf16(Bt[n][0], At[m][0], (f32x4){0.f, 0.f, 0.f, 0.f}, 0, 0, 0); \
        acc[ai][bj][m][n] = __builtin_amdgcn_mfma_f32_16x16x32_bf16(Bt[n][1], At[m][1], acc[ai][bj][m][n], 0, 0, 0); } __builtin_amdgcn_s_setprio(0); } while (0)
#define PG8_MMA8Z(ai, bj, At, Bt) do { __builtin_amdgcn_s_setprio(1); _Pragma("unroll") for (int m = 0; m < 4; ++m) _Pragma("unroll") for (int n = 0; n < 2; ++n) \
        asm volatile("v_mfma_scale_f32_16x16x128_f8f6f4 %0, %1, %2, 0, %3, %4 op_sel_hi:[0,0,0]" : "+v"(acc[ai][bj][m][n]) : "v"(Bt[n]), "v"(At[m]), "v"(sc_w), "v"(sc_a)); __builtin_amdgcn_s_setprio(0); } while (0)
#define XMMA0Z(ai, bj) do { if constexpr (FP8) PG8_MMA8Z(ai, bj, At8, B08); else PG8_MMAZ(ai, bj, At, B0); } while (0)
#define XMMA1Z(ai, bj) do { if constexpr (FP8) PG8_MMA8Z(ai, bj, At8, B18); else PG8_MMAZ(ai, bj, At, B1); } while (0)
#define XLDA(b, h) do { if constexpr (FP8) PG8_LDA8(At8, b, h); else PG8_LDA(At, b, h); } while (0)
#define XLDB0(b, h) do { if constexpr (FP8) PG8_LDB8(B08, b, h); else PG8_LDB(B0, b, h); } while (0)
#define XLDB1(b, h) do { if constexpr (FP8) PG8_LDB8(B18, b, h); else PG8_LDB(B1, b, h); } while (0)
#define XMMA0(ai, bj) do { if constexpr (FP8) PG8_MMA8(ai, bj, At8, B08); else PG8_MMA(ai, bj, At, B0); } while (0)
#define XMMA1(ai, bj) do { if constexpr (FP8) PG8_MMA8(ai, bj, At8, B18); else PG8_MMA(ai, bj, At, B1); } while (0)
#define PG8_WAIT_V(n) asm volatile("s_waitcnt vmcnt(" #n ")" ::: "memory")
#define PG8_WAIT_L(n) asm volatile("s_waitcnt lgkmcnt(" #n ")" ::: "memory")
#define PG8_BAR __builtin_amdgcn_s_barrier()
#define PG8_SCHED __builtin_amdgcn_sched_barrier(0)

template <class Epi, class Sched, bool GATHER, bool ALIGN_EPI, bool FP8 = false, int KREP = 1>
__device__ __forceinline__ void gemm_phase(LAS unsigned char* lds, const Gemm g, const Sched& S, const Epi& E) {
    const int tid = threadIdx.x, wid = __builtin_amdgcn_readfirstlane(tid >> 6), lane = tid & 63, wr = wid >> 2, wc = wid & 3, fr = lane & 15, fq = lane >> 4;
    const int K = g.K, rowb = FP8 ? K : 2 * K, nt = rowb / 128;
    unsigned voffA[2], voffB[2], voffBW[2][2], voffC[2][2], voffN[2][2]; int RA[2], CA[2];
#pragma unroll
    for (int i = 0; i < 2; ++i) { int R, C; stage_rc(tid * 16 + i * 8192, R, C); const int Rb = Epi::PERM ? ((R & ~31) + perm32(R & 31)) : R;
        RA[i] = R; CA[i] = C; voffA[i] = (unsigned)(R * rowb + C * 2); voffB[i] = (unsigned)(Rb * rowb + C * 2);
        voffBW[0][i] = (unsigned)((64 * (R >> 5) + perm32(R & 31)) * rowb + C * 2); voffBW[1][i] = (unsigned)((64 * (R >> 5) + 32 + perm32(R & 31)) * rowb + C * 2); }
    const size_t kstep = (size_t)(BK * 2), hstep = (size_t)HALF * rowb, tstep = 2 * hstep;
    const unsigned ldsw = (unsigned)wid * 1024u;
    const int aoff = lds_byte(wr * 64 + fr, fq * 8), boff = lds_byte(wc * 32 + fr, fq * 8);
    Unit cur, nxt; int ui = 0;
    if (!S.next(0, cur)) return;
    f32x4 acc[2][2][4][2];
#define PG8_ZERO_ACC() do { if constexpr (!FP8) { _Pragma("unroll") for (int a_ = 0; a_ < 2; ++a_) _Pragma("unroll") for (int b_ = 0; b_ < 2; ++b_) _Pragma("unroll") for (int m_ = 0; m_ < 4; ++m_) _Pragma("unroll") for (int n_ = 0; n_ < 2; ++n_) \
        acc[a_][b_][m_][n_] = (f32x4){0.f, 0.f, 0.f, 0.f}; } } while (0)
    PG8_ZERO_ACC();
    bf16x8 At[4][2], B0[2][2], B1[2][2]; v8i_t At8[4], B08[2], B18[2]; int sc_w = 0x7a7a7a7a, sc_a = 0x7f7f7f7f; asm volatile("" : "+v"(sc_w), "+v"(sc_a));
    const char* cA = (const char*)g.A + (size_t)cur.pm * tstep; const char* cB = (const char*)g.Bt + (size_t)cur.pb * tstep;
    if (GATHER) {
#pragma unroll
        for (int h = 0; h < 2; ++h)
#pragma unroll
            for (int i = 0; i < 2; ++i) { voffC[h][i] = (unsigned)(S.row_index(cur, RA[i] + 128 * h) * rowb + CA[i] * 2); voffN[h][i] = voffC[h][i]; }
    }
    const char* nA = cA; const char* nB = cB;
    E.prefetch(cur, 0, wid, lane);
    PG8_STAGE_B(PG8_SB(0, 0), false, 0, 0); PG8_STAGE_B(PG8_SB(0, 1), false, 0, 1); PG8_STAGE_A(PG8_SA(0, 0), false, 0, 0); PG8_STAGE_A(PG8_SA(0, 1), false, 0, 1);
    if (wr == 1) PG8_BAR;
    PG8_WAIT_V(2); PG8_BAR;
    PG8_STAGE_B(PG8_SB(1, 0), false, kstep, 0); PG8_STAGE_A(PG8_SA(1, 0), false, kstep, 0); PG8_STAGE_B(PG8_SB(1, 1), false, kstep, 1);
    PG8_WAIT_V(6); PG8_BAR;
    for (;;) {
        const bool has_next = S.next(ui + 1, nxt);
        if (has_next) E.prefetch(nxt, (ui + 1) % 3, wid, lane);
        nA = has_next ? (const char*)g.A + (size_t)nxt.pm * tstep : cA; nB = has_next ? (const char*)g.Bt + (size_t)nxt.pb * tstep : cB;
        if (GATHER) {
            if (has_next) { int ix[2][2];
#pragma unroll
                for (int h = 0; h < 2; ++h)
#pragma unroll
                    for (int i = 0; i < 2; ++i) ix[h][i] = S.row_index(nxt, RA[i] + 128 * h);
#pragma unroll
                for (int h = 0; h < 2; ++h)
#pragma unroll
                    for (int i = 0; i < 2; ++i) voffN[h][i] = (unsigned)(ix[h][i] * rowb + CA[i] * 2);
            } else {
#pragma unroll
                for (int h = 0; h < 2; ++h)
#pragma unroll
                    for (int i = 0; i < 2; ++i) voffN[h][i] = voffC[h][i]; }
        }
        for (int t = 0; t < nt * KREP; t += 2) {
            const bool last = (t == nt * KREP - 2);
            const int tm = t % nt; const size_t k1 = (size_t)(tm + 1) * kstep, k2 = last ? 0 : (size_t)((tm + 2) % nt) * kstep, k3 = k2 + kstep;
            XLDB0(0, 0); XLDB1(0, 1); PG8_SCHED; XLDA(0, 0); PG8_STAGE_A(PG8_SA(1, 1), false, k1, 1);
            PG8_WAIT_V(8); PG8_WAIT_L(0); PG8_BAR; if (FP8 && t == 0) { XMMA0Z(0, 0); XMMA1Z(0, 1); } else { XMMA0(0, 0); XMMA1(0, 1); } PG8_BAR; PG8_SCHED;
            XLDA(0, 1); PG8_STAGE_B(PG8_SB(0, 0), last, k2, 0); PG8_STAGE_B(PG8_SB(0, 1), last, k2, 1); PG8_STAGE_A(PG8_SA(0, 0), last, k2, 0);
            PG8_WAIT_V(8); PG8_WAIT_L(0); PG8_BAR; if (FP8 && t == 0) { XMMA0Z(1, 0); XMMA1Z(1, 1); } else { XMMA0(1, 0); XMMA1(1, 1); } PG8_BAR; PG8_SCHED;
            XLDB0(1, 0); XLDB1(1, 1); PG8_SCHED; XLDA(1, 0); PG8_STAGE_A(PG8_SA(0, 1), last, k2, 1);
            PG8_WAIT_V(8); PG8_WAIT_L(0); PG8_BAR; XMMA0(0, 0); XMMA1(0, 1); PG8_BAR; PG8_SCHED;
            XLDA(1, 1); PG8_STAGE_B(PG8_SB(1, 0), last, k3, 0); PG8_STAGE_B(PG8_SB(1, 1), last, k3, 1); PG8_STAGE_A(PG8_SA(1, 0), last, k3, 0);
            PG8_WAIT_V(8); PG8_WAIT_L(0); PG8_BAR; XMMA0(1, 0); XMMA1(1, 1); PG8_BAR; PG8_SCHED;
        }
        if constexpr (ALIGN_EPI) { if (wr == 0) PG8_BAR; }
        if constexpr (FP8) asm volatile("s_nop 15\n\ts_nop 15" ::: "memory");
        if constexpr (KREP > 1) {
#pragma unroll
            for (int a_ = 0; a_ < 2; ++a_)
#pragma unroll
                for (int b_ = 0; b_ < 2; ++b_)
#pragma unroll
                    for (int m_ = 0; m_ < 4; ++m_)
#pragma unroll
                        for (int n_ = 0; n_ < 2; ++n_) acc[a_][b_][m_][n_] = acc[a_][b_][m_][n_] * (1.f / KREP); }
        E(acc, cur, wr, wc, fr, fq, ui % 3);
        if (!has_next) break;
        PG8_ZERO_ACC();
        cur = nxt; cA = nA; cB = nB; ++ui;
        if (GATHER) {
#pragma unroll
            for (int h = 0; h < 2; ++h)
#pragma unroll
                for (int i = 0; i < 2; ++i) voffC[h][i] = voffN[h][i];
        }
        if constexpr (ALIGN_EPI) { if (wr == 1) PG8_BAR; }
    }
    PG8_WAIT_V(0);
    if constexpr (!ALIGN_EPI) { if (wr == 0) PG8_BAR; }
    PG8_BAR;
}

struct EpiInProj {
    static constexpr bool PERM = true, WIDE = true;
    __device__ __forceinline__ void prefetch(const Unit&, int, int, int) const {}
    bf16* zg; bf16* qb; bf16* kb; bf16* vb; const float* qn; const float* kn; LAS unsigned char* stage; const float* gnw;
    __device__ __forceinline__ void operator()(const f32x4 (&acc)[2][2][4][2], const Unit& u, int wr, int wc, int fr, int fq, int) const {
        const int lane = fq * 16 + fr; LAS unsigned char* stg = stage + (wr * 4 + wc) * 3584;
        const bool swa = u.pn >= 8; const int sec = swa ? (u.pn - 8) >> 1 : 0, head = 4 * ((u.pn - 8) & 1) + wc; const bool gate = (u.pn == 6) || (u.pn == 7);
        bf16* dst = qb + (size_t)sec * ((WS_KB - WS_QB) / 2); const float* nw = (sec == 1) ? kn : qn;
        f32x4 wv[2][2];
#pragma unroll
        for (int bj = 0; bj < 2; ++bj)
#pragma unroll
            for (int n = 0; n < 2; ++n) { const f32x4 t_ = *(const f32x4*)(nw + 32 * bj + 8 * fq + 4 * n); const f32x4 g_ = *(const f32x4*)(gnw + ((wc & 1) * 64 + 32 * bj + 8 * fq + 4 * n));
                wv[bj][n] = (swa && sec < 2) ? t_ : (gate ? g_ : (f32x4){1.f, 1.f, 1.f, 1.f}); }
#pragma unroll
        for (int ai = 0; ai < 2; ++ai)
#pragma unroll
            for (int m = 0; m < 4; ++m) {
                float sc = 1.f;
                if (swa && sec < 2) { float ss = 0.f;
#pragma unroll
                    for (int bj = 0; bj < 2; ++bj)
#pragma unroll
                        for (int n = 0; n < 2; ++n) { const f32x4 x = acc[ai][bj][m][n]; ss += (x[0] * x[0] + x[1] * x[1]) + (x[2] * x[2] + x[3] * x[3]); }
                    ss = sum_xor32(sum_xor16(ss));
                    sc = rsqrtf(ss * (1.f / 64.f) + EPS) * (sec == 0 ? 0.125f * LOG2E : 1.f); }
#pragma unroll
                for (int bj = 0; bj < 2; ++bj) { f32x4 v0 = acc[ai][bj][m][0] * sc, v1 = acc[ai][bj][m][1] * sc;
                    if (gate) { v0 = silu4(v0); v1 = silu4(v1); }
                    v0 = v0 * wv[bj][0]; v1 = v1 * wv[bj][1];
                    u32x4 w; w.x = pk2(v0[0], v0[1]); w.y = pk2(v0[2], v0[3]); w.z = pk2(v1[0], v1[1]); w.w = pk2(v1[2], v1[3]); *(LAS u32x4*)(stg + fr * 144 + bj * 64 + fq * 16) = w; }
                asm volatile("s_waitcnt lgkmcnt(0)" ::: "memory");
                const int row0 = u.pm * BM + ai * HALF + wr * 64 + m * 16;
#pragma unroll
                for (int hf = 0; hf < 2; ++hf) { const int rr = hf * 8 + (lane >> 3), c16 = lane & 7, row_ = row0 + rr; const u32x4 w = *(const LAS u32x4*)(stg + rr * 144 + c16 * 16);
                    bf16* gp = swa ? dst + ((size_t)((row_ >> 12) * AH + head) * SEQ + (row_ & (SEQ - 1))) * 64 + 8 * c16 : zg + (size_t)row_ * 2048 + u.pn * BM + wc * 64 + 8 * c16;
                    *(u32x4*)gp = w; }
                asm volatile("s_waitcnt lgkmcnt(0)" ::: "memory"); }
    }
};
struct EpiOutProj {
    __device__ __forceinline__ void prefetch(const Unit&, int, int, int) const {}
    static constexpr bool PERM = true, WIDE = true;
    const float* x; bf16* h; unsigned char* hb; LAS unsigned char* stage;
    __device__ __forceinline__ void operator()(const f32x4 (&acc)[2][2][4][2], const Unit& u, int wr, int wc, int fr, int fq, int) const {
        const int lane = fq * 16 + fr; LAS unsigned char* stg = stage + (wr * 4 + wc) * 3584; const int colw = u.pn * BM + wc * 64;
        const int r8 = lane >> 3, c16 = lane & 7;
#pragma unroll
        for (int ai = 0; ai < 2; ++ai)
#pragma unroll
            for (int mp = 0; mp < 2; ++mp) {
                f32x4 xv[2][2][2];
#pragma unroll
                for (int mm = 0; mm < 2; ++mm) { const int row0 = u.pm * BM + ai * HALF + wr * 64 + (2 * mp + mm) * 16;
#pragma unroll
                    for (int bj = 0; bj < 2; ++bj)
#pragma unroll
                        for (int hf = 0; hf < 2; ++hf) xv[mm][bj][hf] = *(const f32x4*)(x + (size_t)(row0 + 8 * hf + r8) * D + colw + 32 * bj + 4 * c16); }
                unsigned h8[2][2][2];
#pragma unroll
                for (int mm = 0; mm < 2; ++mm) { const int m = 2 * mp + mm; const int row0 = u.pm * BM + ai * HALF + wr * 64 + m * 16; u32x4 hw[2];
#pragma unroll
                    for (int bj = 0; bj < 2; ++bj) {
#pragma unroll
                        for (int hf = 0; hf < 2; ++hf) *(LAS f32x4*)(stg + (8 * hf + r8) * 144 + c16 * 16) = xv[mm][bj][hf];
                        asm volatile("s_waitcnt lgkmcnt(0)" ::: "memory");
                        const f32x4 x0 = *(const LAS f32x4*)(stg + fr * 144 + fq * 32), x1 = *(const LAS f32x4*)(stg + fr * 144 + fq * 32 + 16);
                        const f32x4 v0 = acc[ai][bj][m][0] + x0, v1 = acc[ai][bj][m][1] + x1;
                        h8[mm][bj][0] = pk4_fp8(v0[0], v0[1], v0[2], v0[3]); h8[mm][bj][1] = pk4_fp8(v1[0], v1[1], v1[2], v1[3]);
                        hw[bj] = (u32x4){pk2(v0[0], v0[1]), pk2(v0[2], v0[3]), pk2(v1[0], v1[1]), pk2(v1[2], v1[3])};
                        asm volatile("s_waitcnt lgkmcnt(0)" ::: "memory"); }
#pragma unroll
                    for (int bj = 0; bj < 2; ++bj) *(LAS u32x4*)(stg + fr * 144 + bj * 64 + fq * 16) = hw[bj];
                    asm volatile("s_waitcnt lgkmcnt(0)" ::: "memory");
#pragma unroll
                    for (int hf = 0; hf < 2; ++hf) { const u32x4 w = *(const LAS u32x4*)(stg + (8 * hf + r8) * 144 + c16 * 16); *(u32x4*)(h + (size_t)(row0 + 8 * hf + r8) * D + colw + 8 * c16) = w; }
                    asm volatile("s_waitcnt lgkmcnt(0)" ::: "memory"); }
#pragma unroll
                for (int mm = 0; mm < 2; ++mm)
#pragma unroll
                    for (int bj = 0; bj < 2; ++bj) *(LAS u32x2*)(stg + (16 * mm + fr) * 80 + bj * 32 + fq * 8) = (u32x2){h8[mm][bj][0], h8[mm][bj][1]};
                asm volatile("s_waitcnt lgkmcnt(0)" ::: "memory");
                { const int rr = lane >> 2, q16 = lane & 3; const int rowa = u.pm * BM + ai * HALF + wr * 64 + (2 * mp) * 16;
                  const u32x4 w0 = *(const LAS u32x4*)(stg + rr * 80 + q16 * 16), w1 = *(const LAS u32x4*)(stg + (16 + rr) * 80 + q16 * 16);
                  *(u32x4*)(hb + (size_t)(rowa + rr) * D + colw + 16 * q16) = w0; *(u32x4*)(hb + (size_t)(rowa + 16 + rr) * D + colw + 16 * q16) = w1; }
                asm volatile("s_waitcnt lgkmcnt(0)" ::: "memory"); }
    }
};
struct EpiGateUp {
    static constexpr bool PERM = true, WIDE = false;
    unsigned char* act; const float* bgu; const float* lrs; const LAS int* lcnt; LAS unsigned char* stage;
    __device__ __forceinline__ void prefetch(const Unit& u, int slot, int wid, int lane) const {
        const unsigned l0 = (unsigned)(uintptr_t)stage;
        if (wid == 0) glds16_asm(bgu + (size_t)u.e * 2048 + (lane >> 5) * 1024 + 128 * u.pn + (lane & 31) * 4, (unsigned)__builtin_amdgcn_readfirstlane((int)(l0 + slot * 1024)));
        else if (wid == 1) glds16_asm(lrs + (size_t)u.e * LCAP + u.mt * 256 + lane * 4, (unsigned)__builtin_amdgcn_readfirstlane((int)(l0 + 3072 + slot * 1024)));
    }
    __device__ __forceinline__ void operator()(const f32x4 (&acc)[2][2][4][2], const Unit& u, int wr, int wc, int fr, int fq, int slot) const {
        const int cl = wc * 32 + 8 * fq; const LAS float* bl = (const LAS float*)(stage + slot * 1024); const LAS float* rl = (const LAS float*)(stage + 3072 + slot * 1024);
        f32x4 bgv[2], buv[2];
#pragma unroll
        for (int n = 0; n < 2; ++n) { bgv[n] = *(const LAS f32x4*)(bl + cl + 4 * n); buv[n] = *(const LAS f32x4*)(bl + 128 + cl + 4 * n) + 1.f; }
        const int cnt = lcnt[u.e];
#pragma unroll
        for (int ai = 0; ai < 2; ++ai)
#pragma unroll
            for (int m = 0; m < 4; ++m) { const int r = ai * HALF + wr * 64 + m * 16 + fr, rr = u.mt * 256 + r;
                const float rsv = rl[r]; const float rs = rr < cnt ? rsv : 0.f;
                unsigned wq[2];
#pragma unroll
                for (int n = 0; n < 2; ++n) {
                    const f32x4 gt = __builtin_elementwise_min(__builtin_elementwise_max(acc[ai][0][m][n] * rs + bgv[n], (f32x4){-12.5f, -12.5f, -12.5f, -12.5f}), (f32x4){7.f, 7.f, 7.f, 7.f});
                    const f32x4 u1 = __builtin_elementwise_min(__builtin_elementwise_max(acc[ai][1][m][n] * rs + buv[n], (f32x4){-6.f, -6.f, -6.f, -6.f}), (f32x4){8.f, 8.f, 8.f, 8.f});
                    const f32x4 ea = gt * (-1.702f * LOG2E);
                    const f32x4 dn = (f32x4){__builtin_amdgcn_exp2f(ea[0]), __builtin_amdgcn_exp2f(ea[1]), __builtin_amdgcn_exp2f(ea[2]), __builtin_amdgcn_exp2f(ea[3])} + 1.f;
                    const f32x2 dlo = {dn[0], dn[1]}, dhi = {dn[2], dn[3]}; const f32x2 q2 = dlo * dhi;
                    const float rq = __builtin_amdgcn_rcpf(q2[0] * q2[1]); const f32x2 t2 = (f32x2){q2[1], q2[0]} * rq;
                    const f32x2 rlo = t2 * dhi, rhi = t2 * dlo;
                    const f32x4 a = (u1 * gt) * (f32x4){rlo[0], rlo[1], rhi[0], rhi[1]};
                    wq[n] = pk4_fp8(a[0], a[1], a[2], a[3]); }
                *(u32x2*)(act + (size_t)(u.pm * BM + r) * FF + 128 * u.pn + cl) = (u32x2){wq[0], wq[1]}; }
    }
};
struct EpiDown {
    static constexpr bool PERM = true, WIDE = true;
    unsigned char* y; const float* bdn; LAS unsigned char* stage;
    __device__ __forceinline__ void prefetch(const Unit& u, int slot, int wid, int lane) const {
        if (wid == 0) glds16_asm(bdn + (size_t)u.e * D + u.pn * BM + lane * 4, (unsigned)__builtin_amdgcn_readfirstlane((int)((unsigned)(uintptr_t)stage + 20480 + slot * 1024)));
    }
    __device__ __forceinline__ void operator()(const f32x4 (&acc)[2][2][4][2], const Unit& u, int wr, int wc, int fr, int fq, int slot) const {
        const int colw = u.pn * BM + wc * 64; const LAS float* bp = (const LAS float*)(stage + 20480 + slot * 1024) + wc * 64 + 8 * fq;
        f32x4 bv[2][2];
#pragma unroll
        for (int bj = 0; bj < 2; ++bj)
#pragma unroll
            for (int n = 0; n < 2; ++n) bv[bj][n] = *(const LAS f32x4*)(bp + 32 * bj + 4 * n);
        const int lane = fq * 16 + fr; LAS unsigned char* stg = stage + (wr * 4 + wc) * 2560;
#pragma unroll
        for (int ai = 0; ai < 2; ++ai)
#pragma unroll
            for (int mp = 0; mp < 2; ++mp) {
#pragma unroll
                for (int mm = 0; mm < 2; ++mm) { const int m = 2 * mp + mm;
#pragma unroll
                    for (int bj = 0; bj < 2; ++bj) { const f32x4 v0 = acc[ai][bj][m][0] + bv[bj][0], v1 = acc[ai][bj][m][1] + bv[bj][1];
                        *(LAS u32x2*)(stg + (16 * mm + fr) * 80 + bj * 32 + fq * 8) = (u32x2){pk4_fp8(v0[0], v0[1], v0[2], v0[3]), pk4_fp8(v1[0], v1[1], v1[2], v1[3])}; } }
                asm volatile("s_waitcnt lgkmcnt(0)" ::: "memory");
                { const int rr = lane >> 2, c16 = lane & 3; const u32x4 w = *(const LAS u32x4*)(stg + rr * 80 + c16 * 16);
                  const int rowa = u.pm * BM + ai * HALF + wr * 64 + (2 * mp) * 16 + rr; *(u32x4*)(y + (size_t)rowa * D + colw + 16 * c16) = w;
                  const u32x4 w2 = *(const LAS u32x4*)(stg + (16 + rr) * 80 + c16 * 16); *(u32x4*)(y + (size_t)(rowa + 16) * D + colw + 16 * c16) = w2; }
                asm volatile("s_waitcnt lgkmcnt(0)" ::: "memory"); }
    }
};
}

#define XB_TMO      128
#define XB_XCNT(j)  (256  + 64 * (j))
#define XB_XSUB(j)  (1280 + 64 * (j))
#define XB_XGEN(j)  (2304 + 64 * (j))
#define XB_TOP      3328
#define XB_TOPGEN   3392
#define XCD_BAR_WORDS 3456
#define XB_SPIN_CAP (1u << 20)
__device__ __forceinline__ unsigned xb_ld(unsigned* p)              { return __hip_atomic_load(p, __ATOMIC_RELAXED, __HIP_MEMORY_SCOPE_AGENT); }
__device__ __forceinline__ unsigned xb_add(unsigned* p, unsigned v) { return __hip_atomic_fetch_add(p, v, __ATOMIC_RELAXED, __HIP_MEMORY_SCOPE_AGENT); }
__device__ __forceinline__ unsigned xb_xcc_id() { return (unsigned)__builtin_amdgcn_s_getreg((3 << 11) | 20) & 0xFu; }
#define XB_SPIN(cond, bar) do { unsigned _sp = 0; while (cond) { __builtin_amdgcn_s_sleep(1); \
    if ((++_sp & 255u) == 0u) { if (xb_ld(&(bar)[XB_TMO])) break; if (_sp > XB_SPIN_CAP) { atomicAdd(&(bar)[XB_TMO], 1u); break; } } } } while (0)
struct XcdBarrier { unsigned* bar; unsigned x; volatile LAS unsigned* st; };
__device__ __forceinline__ XcdBarrier xcd_barrier_post(unsigned* bar, volatile LAS unsigned* st) {
    XcdBarrier b; b.bar = bar; b.x = xb_xcc_id(); b.st = st;
    if (threadIdx.x == 0) (void)xb_add(&bar[XB_XCNT(b.x)], 1u);
    return b;
}
__device__ __forceinline__ void xcd_barrier_complete(unsigned* bar, unsigned x, unsigned& nloc, unsigned& nx) {
    const unsigned G = gridDim.x * gridDim.y * gridDim.z;
    unsigned sum, cnt, mine, sp = 0u;
    for (;;) {
        sum = 0u; cnt = 0u; mine = 0u;
#pragma unroll
        for (unsigned j = 0; j < 16; ++j) { const unsigned c = xb_ld(&bar[XB_XCNT(j)]); sum += c; cnt += (c > 0u) ? 1u : 0u; mine = (j == x) ? c : mine; }
        if (sum == G) break;
        __builtin_amdgcn_s_sleep(1);
        if ((++sp & 255u) == 0u) { if (xb_ld(&bar[XB_TMO])) break; if (sp > XB_SPIN_CAP) { atomicAdd(&bar[XB_TMO], 1u); break; } }
    }
    nloc = mine > 0u ? mine : 1u; nx = cnt > 0u ? cnt : 1u;
}
__device__ __forceinline__ void xcd_barrier(const XcdBarrier& b) {
    asm volatile("s_waitcnt vmcnt(0)" ::: "memory");
    __syncthreads();
    if (threadIdx.x == 0) {
        unsigned* bar = b.bar;
        __builtin_amdgcn_s_waitcnt(0);
        unsigned nloc = b.st[0], nx = b.st[1];
        if (nloc == 0u) { xcd_barrier_complete(bar, b.x, nloc, nx); b.st[0] = nloc; b.st[1] = nx; }
        const unsigned old = xb_add(&bar[XB_XSUB(b.x)], 1u);
        const unsigned gen = old / nloc;
        if (old + 1u == (gen + 1u) * nloc) {
            __builtin_amdgcn_fence(__ATOMIC_RELEASE, "agent");
            asm volatile("s_waitcnt vmcnt(0)" ::: "memory");
            const unsigned og = xb_add(&bar[XB_TOP], 1u);
            const unsigned tg = og / nx;
            if (og + 1u == (tg + 1u) * nx) xb_add(&bar[XB_TOPGEN], 1u);
            else XB_SPIN(xb_ld(&bar[XB_TOPGEN]) == tg, bar);
            __builtin_amdgcn_fence(__ATOMIC_ACQUIRE, "agent");
            xb_add(&bar[XB_XGEN(b.x)], 1u);
            asm volatile("s_waitcnt vmcnt(0)" ::: "memory");
        } else {
            XB_SPIN(xb_ld(&bar[XB_XGEN(b.x)]) == gen, bar);
            __builtin_amdgcn_fence(__ATOMIC_ACQUIRE, "agent");
            asm volatile("s_waitcnt vmcnt(0)" ::: "memory");
        }
    }
    __syncthreads();
}

struct Args { const float* in[18]; float* out; unsigned char* ws; int ph_lo, ph_hi, li, pad; };
struct Frame {
    LAS unsigned char* lds; unsigned char* ws; unsigned* ctl;
    int tid, lane, wave, G, vcu;
};

__device__ const unsigned char T5B[3][132] = {
{0,1,2,3,4,5,6,7,8,9,10,11,12,13,14,15,16,16,16,16,16,16,17,17,17,17,17,17,17,17,18,18,18,18,18,18,18,18,18,18,19,19,19,19,19,19,19,19,19,19,19,19,19,19,20,20,20,20,20,20,20,20,20,20,20,20,20,20,20,20,20,20,20,21,21,21,21,21,21,21,21,21,21,21,21,21,21,21,21,21,21,21,21,21,21,21,21,21,21,22,22,22,22,22,22,22,22,22,22,22,22,22,22,22,22,22,22,22,22,22,22,22,22,22,22,22,22,22,22,0,0,0},
{0,4,8,12,16,16,17,17,18,18,19,19,19,19,20,20,20,20,20,21,21,21,21,21,21,22,22,22,22,22,22,22,22,22,23,23,23,23,23,23,23,23,23,23,23,23,24,24,24,24,24,24,24,24,24,24,24,24,24,24,24,24,25,25,25,25,25,25,25,25,25,25,25,25,25,25,25,25,25,25,25,25,25,26,26,26,26,26,26,26,26,26,26,26,26,26,26,26,26,26,26,26,26,26,26,26,26,26,26,26,26,26,26,27,27,27,27,27,27,27,27,27,27,27,27,27,27,27,27,0,0,0},
{0,16,18,19,20,21,21,22,22,23,23,23,24,24,24,24,25,25,25,25,25,26,26,26,26,26,26,26,26,27,27,27,27,27,27,27,27,27,27,28,28,28,28,28,28,28,28,28,28,28,28,28,29,29,29,29,29,29,29,29,29,29,29,29,29,29,29,29,29,29,30,30,30,30,30,30,30,30,30,30,30,30,30,30,30,30,30,30,30,30,30,30,30,30,30,31,31,31,31,31,31,31,31,31,31,31,31,31,31,31,31,31,31,31,31,31,31,31,31,31,31,31,31,31,31,31,31,31,31,0,0,0}};

__device__ __forceinline__ void p0_load8(const float* W, size_t ldw, int src_col0, int k0, int lane, f32x4 (&v)[8]) {
    const int n4 = (lane & 7) * 4, kr = lane >> 3;
#pragma unroll
    for (int i = 0; i < 8; ++i) v[i] = *(const f32x4*)(W + (size_t)(k0 + 8 * i + kr) * ldw + src_col0 + n4);
}
template <bool SCALE, bool OUT8> __device__ __forceinline__ void p0_finish(const f32x4 (&v)[8], void* dstv, int k0, const float* kscale, LAS float* scr, int lane) {
    { const int n4 = (lane & 7) * 4, kr = lane >> 3;
#pragma unroll
        for (int i = 0; i < 8; ++i) { const int kk = 8 * i + kr; f32x4 x = v[i]; if (SCALE) x = x * kscale[k0 + kk]; if (OUT8) x = x * 32.f;
            scr[kk * 33 + n4] = x[0]; scr[kk * 33 + n4 + 1] = x[1]; scr[kk * 33 + n4 + 2] = x[2]; scr[kk * 33 + n4 + 3] = x[3]; } }
    LDS_WAIT(); asm volatile("" ::: "memory");
    if (OUT8) { unsigned char* dst = (unsigned char*)dstv; const int n = lane >> 1, kh = lane & 1; const LAS float* sp = scr + (32 * kh) * 33 + n; unsigned w[8];
#pragma unroll
        for (int q = 0; q < 8; ++q) w[q] = pk4_fp8(sp[(4 * q) * 33], sp[(4 * q + 1) * 33], sp[(4 * q + 2) * 33], sp[(4 * q + 3) * 33]);
        *(u32x4*)(dst + (size_t)n * 1024 + k0 + 32 * kh) = (u32x4){w[0], w[1], w[2], w[3]}; *(u32x4*)(dst + (size_t)n * 1024 + k0 + 32 * kh + 16) = (u32x4){w[4], w[5], w[6], w[7]};
    } else { bf16* dst = (bf16*)dstv; const int c = lane & 7;
#pragma unroll
        for (int j = 0; j < 4; ++j) { const int n = (lane >> 3) + 8 * j; const LAS float* sp = scr + (8 * c) * 33 + n;
            u32x4 o; o.x = pk2(sp[0 * 33], sp[1 * 33]); o.y = pk2(sp[2 * 33], sp[3 * 33]); o.z = pk2(sp[4 * 33], sp[5 * 33]); o.w = pk2(sp[6 * 33], sp[7 * 33]);
            *(u32x4*)(dst + (size_t)n * 1024 + k0 + 8 * c) = o; } }
    LDS_WAIT(); asm volatile("" ::: "memory");
}
template <bool SCALE, bool OUT8> __device__ __forceinline__ void p0_transpose_item(const float* W, size_t ldw, int src_col0, void* dstv, int k0, const float* kscale, LAS float* scr, int lane) {
    f32x4 v[8]; p0_load8(W, ldw, src_col0, k0, lane, v); p0_finish<SCALE, OUT8>(v, dstv, k0, kscale, scr, lane);
}
__device__ __forceinline__ void p0_experts(Frame& F, const Args& a, int gw, int NGW) {
    const float* n2 = a.in[11]; const float* w_gu = a.in[14]; const float* w_dn = a.in[16];
    unsigned char* Wgu8 = F.ws + WS_WGU; unsigned char* Wdn8 = F.ws + WS_WDN;
    LAS float* scr = (LAS float*)(F.lds + F.wave * 16896);
    constexpr int I_GU = NE * 8 * 64, I_DN = NE * 8 * 32, NI = I_GU + I_DN;
#define P0_X_ARGS(r_) const bool gu_ = (r_) < I_GU; const int r2_ = gu_ ? (r_) : (r_) - I_GU; const int e_ = gu_ ? (r2_ >> 9) : (r2_ >> 8), q_ = gu_ ? (r2_ & 511) : (r2_ & 255), nb_ = gu_ ? (q_ & 63) : (q_ & 31), kb_ = gu_ ? (q_ >> 6) : (q_ >> 5), \
        np_ = 32 * nb_, ntile_ = np_ >> 8, lc_ = np_ & 255; const int col_ = gu_ ? ((lc_ >> 7) * 1024 + 128 * ntile_ + (lc_ & 127)) : np_; const float* W_ = gu_ ? w_gu + (size_t)e_ * D * 2048 : w_dn + (size_t)e_ * FF * D; const size_t ldw_ = gu_ ? 2048 : D; \
        unsigned char* dst_ = gu_ ? Wgu8 + ((size_t)e_ * 2048 + np_) * 1024 : Wdn8 + ((size_t)e_ * 1024 + np_) * 1024; const int k0_ = 128 * kb_
#define P0_X_LOAD(r_, v_) do { P0_X_ARGS(r_); (void)dst_; const int n4 = (F.lane & 7) * 4, kr = F.lane >> 3; \
        _Pragma("unroll") for (int i = 0; i < 16; ++i) v_[i] = *(const f32x4*)(W_ + (size_t)(k0_ + 8 * i + kr) * ldw_ + col_ + n4); } while (0)
#define P0_X_FIN(r_, v_) do { P0_X_ARGS(r_); (void)W_; (void)ldw_; (void)col_; { const int n4 = (F.lane & 7) * 4, kr = F.lane >> 3; \
        _Pragma("unroll") for (int i = 0; i < 16; ++i) { const int kk = 8 * i + kr; f32x4 x = v_[i] * 32.f; if (gu_) x = x * n2[k0_ + kk]; \
            scr[kk * 33 + n4] = x[0]; scr[kk * 33 + n4 + 1] = x[1]; scr[kk * 33 + n4 + 2] = x[2]; scr[kk * 33 + n4 + 3] = x[3]; } } \
        LDS_WAIT(); asm volatile("" ::: "memory"); \
        { const int n = F.lane >> 1, kh = F.lane & 1; const LAS float* sp = scr + (64 * kh) * 33 + n; \
          _Pragma("unroll") for (int c = 0; c < 4; ++c) { unsigned w_[4]; _Pragma("unroll") for (int q = 0; q < 4; ++q) w_[q] = pk4_fp8(sp[(16 * c + 4 * q) * 33], sp[(16 * c + 4 * q + 1) * 33], sp[(16 * c + 4 * q + 2) * 33], sp[(16 * c + 4 * q + 3) * 33]); \
              *(u32x4*)(dst_ + (size_t)n * 1024 + k0_ + 64 * kh + 16 * c) = (u32x4){w_[0], w_[1], w_[2], w_[3]}; } } \
        LDS_WAIT(); asm volatile("" ::: "memory"); } while (0)
    { f32x4 va[16], vb2[16]; int it = gw;
        if (it < NI) P0_X_LOAD(it, va);
#pragma unroll 1
        for (; it < NI; it += 2 * NGW) { const int it2 = it + NGW, it3 = it + 2 * NGW;
            if (it2 < NI) P0_X_LOAD(it2, vb2);
            P0_X_FIN(it, va);
            if (it3 < NI) P0_X_LOAD(it3, va);
            if (it2 < NI) P0_X_FIN(it2, vb2); } }
#undef P0_X_LOAD
#undef P0_X_FIN
#undef P0_X_ARGS
}
__device__ __forceinline__ void phase0(Frame& F, const Args& a) {
    const float* x = a.in[0]; const float* n1 = a.in[1]; const float* w_in = a.in[2]; const float* w_out = a.in[10]; const float* n2 = a.in[11];
    const float* w_r = a.in[12]; const float* w_gu = a.in[14]; const float* w_dn = a.in[16];
    bf16* Win_t = (bf16*)(F.ws + WS_WIN); bf16* Wout_t = (bf16*)(F.ws + WS_WOUT); bf16* Wgu_t = (bf16*)(F.ws + WS_WGU); bf16* Wdn_t = (bf16*)(F.ws + WS_WDN);
    float* wrT = (float*)(F.ws + WS_WRT); bf16* XN = (bf16*)(F.ws + WS_XN); float* BA = (float*)(F.ws + WS_BA);
    LAS float* scr = (LAS float*)(F.lds + F.wave * 8448);
    const int gw = F.vcu * NWAVES + F.wave, NGW = F.G * NWAVES;
    { bf16* wrh = (bf16*)wrT; bf16* wrl = wrh + NE * D;
      for (int i = (F.vcu * NTHREADS + F.tid); i < NE * D; i += F.G * NTHREADS) { const int e = i >> 10, k = i & 1023; const float w = n2[k] * w_r[k * NE + e];
          const unsigned hi = pk2(w, 0.f) & 0xffffu; const float lo = w - __uint_as_float(hi << 16); wrh[i] = (bf16)hi; wrl[i] = (bf16)(pk2(lo, 0.f) & 0xffffu); } }
    constexpr int I_IN = 16 * (NIN / 32), I_OUT = 16 * 32;
    for (int it = gw; it < I_IN + I_OUT; it += NGW) {
        int r = it;
        if (r < I_IN) { const int nb = r % (NIN / 32), kb = r / (NIN / 32), np = 32 * nb; int src;
            src = np < 2048 ? np : np + 8;
            p0_transpose_item<false, false>(w_in, IN_DIM, src, Win_t + (size_t)np * 1024, 64 * kb, nullptr, scr, F.lane); continue; }
        r -= I_IN;
        { const int nb = r & 31, kb = r >> 5; p0_transpose_item<false, false>(w_out, D, 32 * nb, Wout_t + (size_t)(32 * nb) * 1024, 64 * kb, nullptr, scr, F.lane); }
    }
    __syncthreads();
    { LAS float* wb = (LAS float*)(F.lds + 69632);
        for (int k = F.tid; k < D; k += NTHREADS) { const float* wp = w_in + (size_t)k * IN_DIM + 2048; LAS float* dp = wb + (k >> 2) * 36 + (k & 3) * 8;
            *(LAS f32x4*)dp = *(const f32x4*)wp; *(LAS f32x4*)(dp + 4) = *(const f32x4*)(wp + 4); }
        __syncthreads();
        f32x4 n1v[4];
#pragma unroll
        for (int j = 0; j < 4; ++j) n1v[j] = *((const f32x4*)n1 + F.lane + 64 * j);
        for (int rep9 = 0; rep9 < (DUP == 9 ? 2 : 1); ++rep9)
        for (int m0 = gw * 4; m0 < T; m0 += NGW * 4) {
            f32x4 v[4][4]; float rs[4];
#pragma unroll
            for (int r = 0; r < 4; ++r)
#pragma unroll
                for (int j = 0; j < 4; ++j) v[r][j] = *((const f32x4*)(x + (size_t)(m0 + r) * D) + F.lane + 64 * j);
#pragma unroll
            for (int r = 0; r < 4; ++r) { float sq = 0.f;
#pragma unroll
                for (int j = 0; j < 4; ++j) sq += (v[r][j][0] * v[r][j][0] + v[r][j][1] * v[r][j][1]) + (v[r][j][2] * v[r][j][2] + v[r][j][3] * v[r][j][3]);
                rs[r] = rsqrtf(wave_sum(sq) * (1.f / D) + EPS); }
            float ba[4][8];
#pragma unroll
            for (int r = 0; r < 4; ++r)
#pragma unroll
                for (int c = 0; c < 8; ++c) ba[r][c] = 0.f;
#pragma unroll
            for (int j = 0; j < 4; ++j) {
#pragma unroll
                for (int r = 0; r < 4; ++r) { v[r][j] = v[r][j] * rs[r] * n1v[j];
                    *((unsigned long long*)(XN + (size_t)(m0 + r) * D) + F.lane + 64 * j) = (unsigned long long)pk2(v[r][j][0], v[r][j][1]) | ((unsigned long long)pk2(v[r][j][2], v[r][j][3]) << 32); }
#pragma unroll
                for (int i = 0; i < 4; ++i) { const LAS float* wp = wb + (F.lane + 64 * j) * 36 + i * 8; const f32x4 w0 = *(const LAS f32x4*)wp, w1 = *(const LAS f32x4*)(wp + 4);
#pragma unroll
                    for (int r = 0; r < 4; ++r) { const float xv = v[r][j][i];
                        ba[r][0] += xv * w0[0]; ba[r][1] += xv * w0[1]; ba[r][2] += xv * w0[2]; ba[r][3] += xv * w0[3];
                        ba[r][4] += xv * w1[0]; ba[r][5] += xv * w1[1]; ba[r][6] += xv * w1[2]; ba[r][7] += xv * w1[3]; } } }
#pragma unroll
            for (int r = 0; r < 4; ++r) {
#pragma unroll
                for (int c = 0; c < 8; ++c) ba[r][c] = wave_sum(ba[r][c]);
                if (F.lane == 0) { *(f32x4*)(BA + (size_t)(m0 + r) * 8) = (f32x4){ba[r][0], ba[r][1], ba[r][2], ba[r][3]}; *(f32x4*)(BA + (size_t)(m0 + r) * 8 + 4) = (f32x4){ba[r][4], ba[r][5], ba[r][6], ba[r][7]}; } }
        }
        __syncthreads();
    }
}

constexpr int GP = 132;
constexpr int GQ_OFF = 0, GK_OFF = 64 * GP * 4, GV_OFF = 2 * 64 * GP * 4, GW_OFF = 3 * 64 * GP * 4, GAT_OFF = 4 * 64 * GP * 4, GAT_P = 68;
constexpr int GRAW_OFF = GW_OFF, GRAW_BYTES = 67 * 768;
constexpr int GGC_OFF = GRAW_OFF + GRAW_BYTES, GBETA_OFF = GGC_OFF + 256, GDM_OFF = GBETA_OFF + 256, GEND = GDM_OFF + 4096;
static_assert(GAT_OFF + 64 * GAT_P * 4 <= GGC_OFF && GEND <= TOP_OFF, "gdn prep LDS");
__device__ __forceinline__ int permpos(int cc) { return 8 * ((cc & 15) >> 2) + (cc & 3) + 4 * (cc >> 4); }
__device__ __forceinline__ void gdn_prep_unit(Frame& F, const Args& a, int unit, int next_unit) {
    const bf16* zg = (const bf16*)(F.ws + WS_ZG); const float* BA = (const float*)(F.ws + WS_BA);
    const float* convw = a.in[3]; const float* a_log = a.in[4]; const float* dt_bias = a.in[5];
    const int b = unit >> 8, h = (unit >> 6) & 3, n = unit & 63; const int row0 = b * SEQ + n * CHUNK;
    unsigned char* rec = F.ws + WS_PREP + (size_t)unit * PREP_REC;
    LAS float* Qs = (LAS float*)(F.lds + GQ_OFF); LAS float* Ks = (LAS float*)(F.lds + GK_OFF); LAS float* Vs = (LAS float*)(F.lds + GV_OFF); LAS float* Ws = (LAS float*)(F.lds + GW_OFF);
    LAS float* AT = (LAS float*)(F.lds + GAT_OFF); LAS float* gcs = (LAS float*)(F.lds + GGC_OFF); LAS float* betas = (LAS float*)(F.lds + GBETA_OFF);
    LAS unsigned char* raw = F.lds + GRAW_OFF;
    const int tid = F.tid, lane = F.lane, wave = F.wave;
    for (int e = tid; e < 67 * 48; e += NTHREADS) { const int rr = e / 48, ch = e % 48; const int tt = n * CHUNK + rr - 3;
        u32x4 v = {0u, 0u, 0u, 0u}; if (tt >= 0) v = *(const u32x4*)(zg + (size_t)(row0 + rr - 3) * 2048 + (ch >> 4) * 512 + h * 128 + (ch & 15) * 8);
        *(LAS u32x4*)(raw + rr * 768 + ch * 16) = v; }
    if (wave == 0) {
        const float bl = BA[(size_t)(row0 + lane) * 8 + h], al = BA[(size_t)(row0 + lane) * 8 + 4 + h];
        const float xx = al + dt_bias[h]; const float sp = xx > 20.f ? xx : log1pf(__expf(xx));
        float g = -__expf(a_log[h]) * sp;
#pragma unroll
        for (int o = 1; o < 64; o <<= 1) { const float u = __shfl_up(g, o); if (lane >= o) g += u; }
        gcs[lane] = g; betas[lane] = sigmoid_f(bl);
    }
    LDS_BARRIER();
    { const int t0 = 8 * wave; float qv[8][2], kv[8][2];
#pragma unroll
        for (int ten = 0; ten < 3; ++ten) { const int cp = ten * 64 + lane, ch = ten * 512 + h * 128 + 2 * lane;
            f32x2 cw[4];
#pragma unroll
            for (int k = 0; k < 4; ++k) cw[k] = *(const f32x2*)(convw + k * 1536 + ch);
            f32x2 xs[11];
#pragma unroll
            for (int k = 0; k < 11; ++k) { const unsigned w = *(const LAS unsigned*)(raw + (t0 + k) * 768 + cp * 4); xs[k] = (f32x2){bflo(w), bfhi(w)}; }
#pragma unroll
            for (int j = 0; j < 8; j += 2) { f32x2 c0 = xs[j] * cw[0], c1 = xs[j + 1] * cw[0];
#pragma unroll
                for (int k = 1; k < 4; ++k) { c0 += xs[j + k] * cw[k]; c1 += xs[j + 1 + k] * cw[k]; }
                const f32x4 sv = silu4((f32x4){c0[0], c0[1], c1[0], c1[1]});
#pragma unroll
                for (int jj = 0; jj < 2; ++jj) { const float a0 = sv[2 * jj], a1 = sv[2 * jj + 1];
                    if (ten == 0) { qv[j + jj][0] = a0; qv[j + jj][1] = a1; } else if (ten == 1) { kv[j + jj][0] = a0; kv[j + jj][1] = a1; }
                    else { const float bt = betas[t0 + j + jj]; *(LAS f32x2*)(Vs + (t0 + j + jj) * GP + 2 * lane) = (f32x2){a0 * bt, a1 * bt}; } } } }
#pragma unroll
        for (int j = 0; j < 8; ++j) { const float sq = wave_sum(qv[j][0] * qv[j][0] + qv[j][1] * qv[j][1]), sk = wave_sum(kv[j][0] * kv[j][0] + kv[j][1] * kv[j][1]);
            const float fq_ = rsqrtf(sq + EPS) * 0.08838834764831845f, fk_ = rsqrtf(sk + EPS);
            *(LAS f32x2*)(Qs + (t0 + j) * GP + 2 * lane) = (f32x2){qv[j][0] * fq_, qv[j][1] * fq_}; *(LAS f32x2*)(Ks + (t0 + j) * GP + 2 * lane) = (f32x2){kv[j][0] * fk_, kv[j][1] * fk_}; } }
    LDS_BARRIER();
    {
#pragma unroll
        for (int j = 0; j < 8; ++j) { const int t = 8 * wave + j; const float eg = betas[t] * __expf(gcs[t]); const f32x2 kk = *(LAS f32x2*)(Ks + t * GP + 2 * lane); *(LAS f32x2*)(Ws + t * GP + 2 * lane) = kk * eg; }
        const int which = wave >> 2, ti = (wave >> 1) & 1, tj = wave & 1, r32 = lane & 31, hh = lane >> 5;
        const LAS float* Xa = (which ? Ks + (32 * tj + r32) * GP : Ks + (32 * ti + r32) * GP) + 8 * hh; const LAS float* Xb = (which ? Qs + (32 * ti + r32) * GP : Ks + (32 * tj + r32) * GP) + 8 * hh;
        f32x16 acc = {};
#pragma unroll
        for (int ks = 0; ks < 8; ++ks) { const bf16x8 af = pack8(*(const LAS f32x4*)(Xa + 16 * ks), *(const LAS f32x4*)(Xa + 16 * ks + 4)), bf = pack8(*(const LAS f32x4*)(Xb + 16 * ks), *(const LAS f32x4*)(Xb + 16 * ks + 4));
            acc = __builtin_amdgcn_mfma_f32_32x32x16_bf16(af, bf, acc, 0, 0, 0); }
        if (which == 0) {
            const int j = 32 * tj + r32; const float gj = gcs[j];
#pragma unroll
            for (int q = 0; q < 4; ++q) { float vals[4];
#pragma unroll
                for (int rr = 0; rr < 4; ++rr) { const int i = 32 * ti + 8 * q + 4 * hh + rr; const float dec = __expf(fminf(gcs[i] - gj, 0.f)); vals[rr] = i > j ? betas[i] * acc[4 * q + rr] * dec : 0.f; }
                *(LAS f32x4*)(AT + j * GAT_P + 32 * ti + 8 * q + 4 * hh) = (f32x4){vals[0], vals[1], vals[2], vals[3]}; }
        } else {
            const int i = 32 * ti + r32; const float gi = gcs[i]; bf16* Af = (bf16*)(rec + PREP_AP) + (i >> 4) * 1024 + (i & 15) * 8 + tj * 512;
#pragma unroll
            for (int q = 0; q < 4; ++q) { float vals[4]; const int cc0 = 8 * q + 4 * hh;
#pragma unroll
                for (int rr = 0; rr < 4; ++rr) { const int j = 32 * tj + cc0 + rr; const float dec = __expf(fminf(gi - gcs[j], 0.f)); vals[rr] = i >= j ? acc[4 * q + rr] * dec : 0.f; }
                const int jpos = permpos(cc0); *(u32x2*)(Af + (jpos >> 3) * 128 + (jpos & 7)) = (u32x2){pk2(vals[0], vals[1]), pk2(vals[2], vals[3])}; }
        }
    }
    LDS_BARRIER();
    unsigned pfx = 0u;
    if (next_unit >= 0) { const int nb_ = next_unit >> 8, nh_ = (next_unit >> 6) & 3, nn_ = next_unit & 63; const int nrow0 = nb_ * SEQ + nn_ * CHUNK;
        if (tid < 402) { const int rr = tid / 6, sg = tid % 6; if (nn_ * CHUNK + rr - 3 >= 0) pfx = *(const unsigned*)(zg + (size_t)(nrow0 + rr - 3) * 2048 + (sg >> 1) * 512 + nh_ * 128 + (sg & 1) * 64); }
        else if (tid < 418) pfx = *(const unsigned*)(BA + (size_t)nrow0 * 8 + (tid - 402) * 32); }
    LAS float* Dm = (LAS float*)(F.lds + GDM_OFF);
    if (wave < 4) {
        if (lane < 16) { const int i0 = 16 * wave; float r[16];
#pragma unroll
            for (int ii = 0; ii < 16; ++ii) r[ii] = (ii == lane) ? 1.f : 0.f;
#pragma unroll
            for (int j = 0; j < 16; ++j) { const float xj = r[j]; const LAS f32x4* ap = (const LAS f32x4*)(AT + (i0 + j) * GAT_P + i0); float av[16];
#pragma unroll
                for (int q = 0; q < 4; ++q) { const f32x4 t4 = ap[q]; av[4 * q] = t4[0]; av[4 * q + 1] = t4[1]; av[4 * q + 2] = t4[2]; av[4 * q + 3] = t4[3]; }
#pragma unroll
                for (int ii = 0; ii < 16; ++ii) if (ii > j) r[ii] -= av[ii] * xj; }
#pragma unroll
            for (int ii = 0; ii < 16; ++ii) Dm[wave * 256 + ii * 16 + lane] = r[ii]; }
    } else {
        const int t2 = tid - 256; bf16* Qf = (bf16*)(rec + PREP_QP); bf16* Kf = (bf16*)(rec + PREP_KT); const float gl = gcs[63];
        for (int it = t2; it < 1024; it += 256) { const int blk = it >> 6, l = it & 63, mi = blk >> 2, ks = blk & 3, g = l >> 4, c = 16 * mi + (l & 15); const float eg = __expf(gcs[c]);
            const f32x4 lo = *(LAS f32x4*)(Qs + c * GP + 32 * ks + 4 * g) * eg, hi = *(LAS f32x4*)(Qs + c * GP + 32 * ks + 16 + 4 * g) * eg;
            *(bf16x8*)(Qf + it * 8) = pack8(lo, hi); }
        for (int it = t2; it < 1024; it += 256) { const int blk = it >> 6, l = it & 63, ti = blk >> 1, ks2 = blk & 1, g = l >> 4, dk = 16 * ti + (l & 15); float v[8];
#pragma unroll
            for (int j = 0; j < 8; ++j) { const int c = 32 * ks2 + (j < 4 ? 4 * g + j : 16 + 4 * g + (j - 4)); v[j] = Ks[c * GP + dk] * __expf(gl - gcs[c]); }
            *(bf16x8*)(Kf + it * 8) = pack8((f32x4){v[0], v[1], v[2], v[3]}, (f32x4){v[4], v[5], v[6], v[7]}); }
        if (t2 == 0) *(float*)(rec + PREP_CD) = __expf(gl);
    }
    LDS_BARRIER();
    {
        const int fr = lane & 15, g = lane >> 4;
#pragma unroll 1
        for (int bb = 0; bb < 4; ++bb) {
            const int i0 = 16 * bb;
            bf16x8 Af[2];
#pragma unroll
            for (int ks = 0; ks < 2; ++ks) { float av[8];
#pragma unroll
                for (int j = 0; j < 8; ++j) { const int kr = 32 * ks + 8 * g + j; av[j] = kr < i0 ? -AT[kr * GAT_P + i0 + fr] : 0.f; }
                Af[ks] = pack8((f32x4){av[0], av[1], av[2], av[3]}, (f32x4){av[4], av[5], av[6], av[7]}); }
            const f32x4 dv4 = *(const LAS f32x4*)(Dm + bb * 256 + fr * 16 + 4 * g);
            const bf16x8 Df = pack8(dv4, (f32x4){0.f, 0.f, 0.f, 0.f});
#pragma unroll
            for (int nt = 0; nt < 2; ++nt) { const int col = 32 * wave + 16 * nt + fr; LAS float* X = (col < 128 ? Vs + col : Ws + (col - 128));
                f32x4 acc;
#pragma unroll
                for (int rg = 0; rg < 4; ++rg) acc[rg] = X[(i0 + 4 * g + rg) * GP];
                if (bb > 0) {
#pragma unroll
                    for (int ks = 0; ks < 2; ++ks) { if (32 * ks < i0) { float xv[8];
#pragma unroll
                        for (int j = 0; j < 8; ++j) xv[j] = X[(32 * ks + 8 * g + j) * GP];
                        acc = __builtin_amdgcn_mfma_f32_16x16x32_bf16(Af[ks], pack8((f32x4){xv[0], xv[1], xv[2], xv[3]}, (f32x4){xv[4], xv[5], xv[6], xv[7]}), acc, 0, 0, 0); } } }
                const f32x4 xb = __builtin_amdgcn_mfma_f32_16x16x32_bf16(Df, pack8(acc, (f32x4){0.f, 0.f, 0.f, 0.f}), (f32x4){0.f, 0.f, 0.f, 0.f}, 0, 0, 0);
#pragma unroll
                for (int rg = 0; rg < 4; ++rg) X[(i0 + 4 * g + rg) * GP] = xb[rg]; }
        }
    }
    LDS_BARRIER();
    { float* Up = (float*)(rec + PREP_UP); bf16* Wf = (bf16*)(rec + PREP_WP);
        for (int it = tid; it < 2048; it += NTHREADS) { const int dv = it & 127, g = (it >> 7) & 3, mi = it >> 9; const int c0 = 16 * mi + 4 * g;
            *(f32x4*)(Up + (size_t)it * 4) = (f32x4){Vs[c0 * GP + dv], Vs[(c0 + 1) * GP + dv], Vs[(c0 + 2) * GP + dv], Vs[(c0 + 3) * GP + dv]}; }
        for (int it = tid; it < 1024; it += NTHREADS) { const int blk = it >> 6, l = it & 63, mi = blk >> 2, ks = blk & 3, g = l >> 4, c = 16 * mi + (l & 15);
            *(bf16x8*)(Wf + it * 8) = pack8(*(LAS f32x4*)(Ws + c * GP + 32 * ks + 4 * g), *(LAS f32x4*)(Ws + c * GP + 32 * ks + 16 + 4 * g)); }
    }
    asm volatile("" :: "v"(pfx));
    LDS_BARRIER();
}

constexpr int SC_BUFSZ = 57344, SC_OT = 2 * SC_BUFSZ, SC_OTSZ = 64 * 128 * 2, SC_END = SC_OT + 2 * SC_OTSZ;
static_assert(SC_END <= TOP_OFF, "scan LDS");
__device__ __forceinline__ void gdn_scan(Frame& F, const Args& a, int bh) {
    const int tid = F.tid, lane = F.lane, w = F.wave, fr = lane & 15, g = lane >> 4; const int b = bh >> 2, h = bh & 3;
    const unsigned char* rec0 = F.ws + WS_PREP + (size_t)bh * NCHUNK * PREP_REC;
    const float* gnw = a.in[6]; const bf16* zg = (const bf16*)(F.ws + WS_ZG); bf16* mix = (bf16*)(F.ws + WS_MIX);
    const size_t rowb = (size_t)b * SEQ; const unsigned lds0 = (unsigned)(uintptr_t)F.lds;
    if (w >= 4) {
        const int hw = w - 4, l16 = lane & 15, rq = lane >> 4;
#define SC_DMA(n_, buf_) do { const unsigned char* src_ = rec0 + (size_t)(n_) * PREP_REC + hw * 14336 + lane * 16; _Pragma("unroll") for (int r_ = 0; r_ < 14; ++r_) \
        glds16_asm(src_ + r_ * 1024, (unsigned)__builtin_amdgcn_readfirstlane((int)(lds0 + (buf_) * SC_BUFSZ + hw * 14336 + r_ * 1024))); } while (0)
#define SC_NORM(n_, gv) do { const LAS unsigned char* ot = F.lds + SC_OT + ((n_) & 1) * SC_OTSZ; _Pragma("unroll") for (int q_ = 0; q_ < 4; ++q_) { const int t = 16 * hw + 4 * q_ + rq; \
            const u32x4 ov = *(const LAS u32x4*)(ot + t * 256 + l16 * 16); const f32x4 xa = {bflo(ov.x), bfhi(ov.x), bflo(ov.y), bfhi(ov.y)}, xb = {bflo(ov.z), bfhi(ov.z), bflo(ov.w), bfhi(ov.w)}; \
            float ss_ = (xa[0] * xa[0] + xa[1] * xa[1]) + (xa[2] * xa[2] + xa[3] * xa[3]) + (xb[0] * xb[0] + xb[1] * xb[1]) + (xb[2] * xb[2] + xb[3] * xb[3]); \
            ss_ = sum_row16(ss_); const float sc = rsqrtf(ss_ * (1.f / 128.f) + EPS); \
            const u32x4 gz = gv[q_]; const f32x4 ga = {bflo(gz.x), bfhi(gz.x), bflo(gz.y), bfhi(gz.y)}, gb = {bflo(gz.z), bfhi(gz.z), bflo(gz.w), bfhi(gz.w)}; \
            *(bf16x8*)(mix + (rowb + (n_) * CHUNK + t) * 1024 + h * 128 + 8 * l16) = pack8(xa * sc * ga, xb * sc * gb); } } while (0)
        u32x4 gc_[4], gn_[4];
        SC_DMA(0, 0);
#pragma unroll
        for (int q = 0; q < 4; ++q) gc_[q] = (u32x4){0u, 0u, 0u, 0u};
        VM_WAIT(); __syncthreads();
#pragma unroll 1
        for (int n = 0; n < NCHUNK; ++n) {
#pragma unroll
            for (int q = 0; q < 4; ++q) gn_[q] = *(const u32x4*)(zg + (rowb + n * CHUNK + 16 * hw + 4 * q + rq) * 2048 + 1536 + h * 128 + 8 * l16);
            if (n + 1 < NCHUNK) SC_DMA(n + 1, (n + 1) & 1);
            if (n > 0) SC_NORM(n - 1, gc_);
            VM_WAIT(); __syncthreads();
#pragma unroll
            for (int q = 0; q < 4; ++q) gc_[q] = gn_[q];
        }
        SC_NORM(NCHUNK - 1, gc_);
#undef SC_DMA
#undef SC_NORM
    } else {
        f32x4 S[2][8];
#pragma unroll
        for (int sl = 0; sl < 2; ++sl)
#pragma unroll
            for (int i = 0; i < 8; ++i) S[sl][i] = (f32x4){0.f, 0.f, 0.f, 0.f};
        f32x4 Un[2][4]; float cd = *(const float*)(rec0 + PREP_CD), cdn;
#pragma unroll
        for (int sl = 0; sl < 2; ++sl)
#pragma unroll
            for (int mi = 0; mi < 4; ++mi) Un[sl][mi] = *(const f32x4*)((const float*)(rec0 + PREP_UP) + (size_t)((mi * 4 + g) * 128 + 32 * w + 16 * sl + fr) * 4);
        __syncthreads();
#pragma unroll 1
        for (int n = 0; n < NCHUNK; ++n) {
            const LAS unsigned char* B = F.lds + (n & 1) * SC_BUFSZ + lane * 16;
            f32x4 vn[2][4], o[2][4];
            { bf16x8 Sb[2][4];
#pragma unroll
                for (int sl = 0; sl < 2; ++sl)
#pragma unroll
                    for (int ks = 0; ks < 4; ++ks) Sb[sl][ks] = pack8(S[sl][2 * ks], S[sl][2 * ks + 1]);
#pragma unroll
                for (int mi = 0; mi < 4; ++mi) { f32x4 t1[2], oo[2];
#pragma unroll
                    for (int sl = 0; sl < 2; ++sl) { t1[sl] = (f32x4){0.f, 0.f, 0.f, 0.f}; oo[sl] = (f32x4){0.f, 0.f, 0.f, 0.f}; }
#pragma unroll
                    for (int ks = 0; ks < 4; ++ks) { const bf16x8 wf = *(const LAS bf16x8*)(B + PREP_WP + (mi * 4 + ks) * 1024), qf = *(const LAS bf16x8*)(B + PREP_QP + (mi * 4 + ks) * 1024);
#pragma unroll
                        for (int sl = 0; sl < 2; ++sl) { t1[sl] = __builtin_amdgcn_mfma_f32_16x16x32_bf16(wf, Sb[sl][ks], t1[sl], 0, 0, 0); oo[sl] = __builtin_amdgcn_mfma_f32_16x16x32_bf16(qf, Sb[sl][ks], oo[sl], 0, 0, 0); } }
#pragma unroll
                    for (int sl = 0; sl < 2; ++sl) { vn[sl][mi] = Un[sl][mi] - t1[sl]; o[sl][mi] = oo[sl]; } } }
            { const int nn = n + 1 < NCHUNK ? n + 1 : n; cdn = *(const float*)(rec0 + (size_t)nn * PREP_REC + PREP_CD);
#pragma unroll
                for (int sl = 0; sl < 2; ++sl)
#pragma unroll
                    for (int mi = 0; mi < 4; ++mi) Un[sl][mi] = *(const f32x4*)((const float*)(rec0 + (size_t)nn * PREP_REC + PREP_UP) + (size_t)((mi * 4 + g) * 128 + 32 * w + 16 * sl + fr) * 4); }
            bf16x8 Vb[2][2];
#pragma unroll
            for (int sl = 0; sl < 2; ++sl)
#pragma unroll
                for (int ks = 0; ks < 2; ++ks) Vb[sl][ks] = pack8(vn[sl][2 * ks], vn[sl][2 * ks + 1]);
#pragma unroll
            for (int mi = 0; mi < 4; ++mi) {
#pragma unroll
                for (int ks = 0; ks < 2; ++ks) { const bf16x8 af = *(const LAS bf16x8*)(B + PREP_AP + (mi * 2 + ks) * 1024);
#pragma unroll
                    for (int sl = 0; sl < 2; ++sl) o[sl][mi] = __builtin_amdgcn_mfma_f32_16x16x32_bf16(af, Vb[sl][ks], o[sl][mi], 0, 0, 0); }
#pragma unroll
                for (int sl = 0; sl < 2; ++sl) { LAS bf16* otw = (LAS bf16*)(F.lds + SC_OT + (n & 1) * SC_OTSZ) + 32 * w + 16 * sl + fr;
                    const unsigned p01 = pk2(o[sl][mi][0], o[sl][mi][1]), p23 = pk2(o[sl][mi][2], o[sl][mi][3]);
                    otw[(16 * mi + 4 * g) * 128] = (bf16)(p01 & 0xffffu); otw[(16 * mi + 4 * g + 1) * 128] = (bf16)(p01 >> 16); otw[(16 * mi + 4 * g + 2) * 128] = (bf16)(p23 & 0xffffu); otw[(16 * mi + 4 * g + 3) * 128] = (bf16)(p23 >> 16); } }
#pragma unroll
            for (int ti = 0; ti < 8; ++ti) { f32x4 s0 = S[0][ti] * cd, s1 = S[1][ti] * cd;
#pragma unroll
                for (int ks = 0; ks < 2; ++ks) { const bf16x8 kf = *(const LAS bf16x8*)(B + PREP_KT + (ti * 2 + ks) * 1024);
                    s0 = __builtin_amdgcn_mfma_f32_16x16x32_bf16(kf, Vb[0][ks], s0, 0, 0, 0); s1 = __builtin_amdgcn_mfma_f32_16x16x32_bf16(kf, Vb[1][ks], s1, 0, 0, 0); }
                S[0][ti] = s0; S[1][ti] = s1; }
            __syncthreads();
            cd = cdn;
        }
    }
    __syncthreads();
}

constexpr int AT_K = 0, AT_V = 49152, AT_BIAS = 98304, AT_LW = 98304 + 1024, AT_END = AT_LW + 1024;
constexpr size_t WS_P4 = 616 * MiB, WS_P16 = 648 * MiB, WS_L4 = 744 * MiB, WS_L16 = 745 * MiB;
static_assert(WS_P16 + (size_t)T * 512 * 2 <= WS_MIX && WS_L16 + (size_t)T * 8 * 4 <= WS_XN, "attention partial buffers");
__device__ __forceinline__ void attn_unit(Frame& F, const Args& a, int u) {
    int kind, b, h, r, q0;
    if (u < 1024) { kind = 2; b = u >> 7; h = (u >> 4) & 7; r = u & 15; q0 = 0; }
    else if (u < 2048) { const int v = u - 1024; kind = 1; b = v >> 7; h = (v >> 4) & 7; r = (v >> 2) & 3; q0 = (v & 3) * 256; }
    else { const int v = u - 2048; kind = 0; b = v >> 7; h = (v >> 4) & 7; r = 0; q0 = (v & 15) * 256; }
    const int dsh = 2 * kind, lmax = (SEQ >> dsh) - 1;
    const bf16* qb = (const bf16*)(F.ws + WS_QB); const bf16* kb = (const bf16*)(F.ws + WS_KB); const bf16* vb = (const bf16*)(F.ws + WS_VB); bf16* mix = (bf16*)(F.ws + WS_MIX);
    const float* relb = a.in[9];
    LAS float* biasL = (LAS float*)(F.lds + AT_BIAS); LAS float* lw = (LAS float*)(F.lds + AT_LW) + F.wave * 32;
    const int tid = F.tid, lane = F.lane, w = F.wave, c = lane & 31, hh = lane >> 5;
    const size_t hrow = (size_t)(b * AH + h) * SEQ; const unsigned lds0 = (unsigned)(uintptr_t)F.lds;
    { const int ro = lane >> 3, p = lane & 7;
#pragma unroll
        for (int i = 0; i < 6; ++i) { const int lr = 48 * w + 8 * i + ro; int pos = q0 - 128 + lr; pos = pos < 0 ? 0 : (pos > lmax ? lmax : pos);
            const size_t eo = (hrow + (size_t)(pos << dsh) + r) * 64 + (size_t)((p ^ (lr & 7)) * 8);
            glds16_asm(kb + eo, (unsigned)__builtin_amdgcn_readfirstlane((int)(lds0 + AT_K + (48 * w + 8 * i) * 128)));
            glds16_asm(vb + eo, (unsigned)__builtin_amdgcn_readfirstlane((int)(lds0 + AT_V + (48 * w + 8 * i) * 128))); } }
    if (tid < 132) biasL[tid] = relb[(int)T5B[kind][tid] * AH + h] * LOG2E;
    const int qi = q0 + 32 * w + c;
    bf16x8 Qf[4];
    { const bf16* qp = qb + (hrow + (size_t)(qi << dsh) + r) * 64 + 8 * hh;
#pragma unroll
        for (int ks = 0; ks < 4; ++ks) Qf[ks] = *(const bf16x8*)(qp + 16 * ks); }
    VM_WAIT(); __syncthreads();
    f32x16 O0 = {}, O1 = {}; float lsum = 0.f;
    const int kt0 = (128 - q0 - 32 * w) > 0 ? ((128 - q0 - 32 * w) >> 5) : 0;
    const int li = lane & 15, gq = lane >> 4;
#pragma unroll 1
    for (int kt = kt0; kt < 5; ++kt) {
        const int lr0 = 32 * (w + kt);
        f32x16 sT = {};
        { const int lr = lr0 + c; const LAS unsigned char* kp = F.lds + AT_K + lr * 128;
#pragma unroll
            for (int ks = 0; ks < 4; ++ks) { const bf16x8 kf = *(const LAS bf16x8*)(kp + (((2 * ks + hh) ^ (lr & 7)) * 16)); sT = __builtin_amdgcn_mfma_f32_32x32x16_bf16(kf, Qf[ks], sT, 0, 0, 0); } }
        float p[16];
#pragma unroll
        for (int reg = 0; reg < 16; ++reg) { const int kr = (reg & 3) + 8 * (reg >> 2) + 4 * hh; const int s = 128 + c - 32 * kt - kr; const int kpos = q0 - 128 + lr0 + kr;
            const bool ok = (s >= 0) && (s <= 128) && (kpos >= 0); const int sc_ = s < 0 ? 0 : (s > 128 ? 128 : s);
            const float e = __builtin_amdgcn_exp2f(sT[reg] + biasL[sc_]); p[reg] = ok ? e : 0.f; lsum += p[reg]; }
        bf16x8 Pf[2];
#pragma unroll
        for (int s2 = 0; s2 < 2; ++s2) { u32x4 wv; wv.x = pk2(p[8 * s2], p[8 * s2 + 1]); wv.y = pk2(p[8 * s2 + 2], p[8 * s2 + 3]); wv.z = pk2(p[8 * s2 + 4], p[8 * s2 + 5]); wv.w = pk2(p[8 * s2 + 6], p[8 * s2 + 7]); Pf[s2] = __builtin_bit_cast(bf16x8, wv); }
#pragma unroll
        for (int s2 = 0; s2 < 2; ++s2)
#pragma unroll
            for (int ntl = 0; ntl < 2; ++ntl) {
                const int rowl = lr0 + 16 * s2 + 4 * hh + (li >> 2), rowh = rowl + 8; const int ch = 4 * ntl + 2 * (gq & 1) + ((li & 3) >> 1), sub = (li & 1) * 8;
                const s16x4 lo = __builtin_bit_cast(s16x4, __builtin_amdgcn_ds_read_tr16_b64_v4i16((LAS s16x4*)(F.lds + AT_V + rowl * 128 + ((ch ^ (rowl & 7)) * 16) + sub)));
                const s16x4 hi = __builtin_bit_cast(s16x4, __builtin_amdgcn_ds_read_tr16_b64_v4i16((LAS s16x4*)(F.lds + AT_V + rowh * 128 + ((ch ^ (rowh & 7)) * 16) + sub)));
                const bf16x8 vf = (bf16x8){lo[0], lo[1], lo[2], lo[3], hi[0], hi[1], hi[2], hi[3]};
                if (ntl == 0) O0 = __builtin_amdgcn_mfma_f32_32x32x16_bf16(Pf[s2], vf, O0, 0, 0, 0); else O1 = __builtin_amdgcn_mfma_f32_32x32x16_bf16(Pf[s2], vf, O1, 0, 0, 0);
            }
    }
    lsum = sum_xor32(lsum);
    if (hh == 0) lw[c] = lsum;
    LDS_BARRIER();
    { LAS float* ost = (LAS float*)(F.lds + w * 8192);
#pragma unroll
        for (int reg = 0; reg < 16; ++reg) { const int qrow = (reg & 3) + 8 * (reg >> 2) + 4 * hh; ost[qrow * 64 + c] = O0[reg]; ost[qrow * 64 + 32 + c] = O1[reg]; }
        LDS_WAIT();
        const int row = lane >> 1, half = lane & 1; const float l1 = lw[row]; const LAS f32x4* op = (const LAS f32x4*)(ost + row * 64 + 32 * half);
        const size_t tok = (size_t)b * SEQ + (size_t)((q0 + 32 * w + row) << dsh) + r;
        if (kind != 0) {
            bf16* pp = (bf16*)(F.ws + (kind == 1 ? WS_P4 : WS_P16)) + (tok * 8 + h) * 64 + 32 * half; const float inv = 1.f / l1;
#pragma unroll
            for (int q = 0; q < 4; ++q) *(bf16x8*)(pp + 8 * q) = pack8(op[2 * q] * inv, op[2 * q + 1] * inv);
            if (half == 0) ((float*)(F.ws + (kind == 1 ? WS_L4 : WS_L16)))[tok * 8 + h] = l1;
        } else {
            const bf16* p4 = (const bf16*)(F.ws + WS_P4) + (tok * 8 + h) * 64 + 32 * half; const bf16* p16 = (const bf16*)(F.ws + WS_P16) + (tok * 8 + h) * 64 + 32 * half;
            const float l4 = ((const float*)(F.ws + WS_L4))[tok * 8 + h], l16 = ((const float*)(F.ws + WS_L16))[tok * 8 + h]; const float inv = 1.f / (l1 + l4 + l16);
            bf16* dst = mix + tok * 1024 + 512 + h * 64 + 32 * half;
#pragma unroll
            for (int q = 0; q < 4; ++q) { const u32x4 a4 = *(const u32x4*)(p4 + 8 * q), a16 = *(const u32x4*)(p16 + 8 * q);
                const f32x4 x0 = (op[2 * q] + (f32x4){bflo(a4.x), bfhi(a4.x), bflo(a4.y), bfhi(a4.y)} * l4 + (f32x4){bflo(a16.x), bfhi(a16.x), bflo(a16.y), bfhi(a16.y)} * l16) * inv;
                const f32x4 x1 = (op[2 * q + 1] + (f32x4){bflo(a4.z), bfhi(a4.z), bflo(a4.w), bfhi(a4.w)} * l4 + (f32x4){bflo(a16.z), bfhi(a16.z), bflo(a16.w), bfhi(a16.w)} * l16) * inv;
                *(bf16x8*)(dst + 8 * q) = pack8(x0, x1); }
        }
    }
    LDS_BARRIER();
}

constexpr int RT_LCNT = 0, RT_BASE = 256, RT_RANK = 512;
__device__ __forceinline__ void route_phase(Frame& F, const Args& a) {
    const bf16* hsrc = (const bf16*)(F.ws + WS_HBF); const bf16* wrT = (const bf16*)(F.ws + WS_WRT); const float* b_r = a.in[13];
    int* te = (int*)(F.ws + WS_TE); int* tslot = (int*)(F.ws + WS_TSLOT); float* tg = (float*)(F.ws + WS_TG); int* list = (int*)(F.ws + WS_LIST); float* lrs = (float*)(F.ws + WS_LRS);
    LAS int* lcnt = (LAS int*)(F.lds + RT_LCNT); LAS int* lbase = (LAS int*)(F.lds + RT_BASE); LAS int* lrank = (LAS int*)(F.lds + RT_RANK);
    const int lane = F.lane, c = lane & 31, hh = lane >> 5;
    for (int blk = F.vcu; blk < T / 128; blk += F.G) {
        if (F.tid < 32) lcnt[F.tid] = 0;
        __syncthreads();
        int e4[4] = {0, 0, 0, 0}, rk[4] = {0, 0, 0, 0}; float g4[4] = {0.f, 0.f, 0.f, 0.f}; float rs = 0.f; const int tok = blk * 128 + (F.wave & 3) * 32 + c;
        f32x16 acc = {}; float ss = 0.f;
        { const int kh = F.wave >> 2; const bf16* hp = hsrc + (size_t)tok * D + 8 * hh + 512 * kh; const bf16* wph = (const bf16*)wrT + (size_t)c * D + 8 * hh + 512 * kh; const bf16* wpl = wph + NE * D;
#pragma unroll 8
            for (int q = 0; q < 32; ++q) { const u32x4 hr = *(const u32x4*)(hp + 16 * q); const bf16x8 wh = *(const bf16x8*)(wph + 16 * q), wl = *(const bf16x8*)(wpl + 16 * q);
                const f32x4 ha = {bflo(hr.x), bfhi(hr.x), bflo(hr.y), bfhi(hr.y)}, hb2 = {bflo(hr.z), bfhi(hr.z), bflo(hr.w), bfhi(hr.w)};
                ss += (ha[0] * ha[0] + ha[1] * ha[1]) + (ha[2] * ha[2] + ha[3] * ha[3]) + (hb2[0] * hb2[0] + hb2[1] * hb2[1]) + (hb2[2] * hb2[2] + hb2[3] * hb2[3]);
                const bf16x8 hv = __builtin_bit_cast(bf16x8, hr);
                acc = __builtin_amdgcn_mfma_f32_32x32x16_bf16(wh, hv, acc, 0, 0, 0); acc = __builtin_amdgcn_mfma_f32_32x32x16_bf16(wl, hv, acc, 0, 0, 0); }
            LAS float* px = (LAS float*)(F.lds + 4096) + ((F.wave & 3) * 64 + lane) * 17;
            if (F.wave >= 4) {
#pragma unroll
                for (int r = 0; r < 16; ++r) px[r] = acc[r];
                px[16] = ss; }
            __syncthreads();
            if (F.wave < 4) {
#pragma unroll
                for (int r = 0; r < 16; ++r) acc[r] += px[r];
                ss += px[16]; } }
        if (F.wave < 4) {
            ss = sum_xor32(ss); rs = rsqrtf(ss * (1.f / D) + EPS);
            float tv[4] = {-3.0e38f, -3.0e38f, -3.0e38f, -3.0e38f}; int tix[4] = {0, 1, 2, 3};
            f32x4 brv[4];
#pragma unroll
            for (int q = 0; q < 4; ++q) brv[q] = *(const f32x4*)(b_r + 8 * q + 4 * hh);
#pragma unroll
            for (int reg = 0; reg < 16; ++reg) { const int e = (reg & 3) + 8 * (reg >> 2) + 4 * hh; float v = acc[reg] * rs + brv[reg >> 2][reg & 3]; int ix = e;
#pragma unroll
                for (int s = 0; s < 4; ++s) { const bool gt = (v > tv[s]) || (v == tv[s] && ix < tix[s]); const float ov = tv[s]; const int oi = tix[s]; tv[s] = gt ? v : ov; tix[s] = gt ? ix : oi; v = gt ? ov : v; ix = gt ? oi : ix; } }
            float pv[4]; int pi[4];
#pragma unroll
            for (int s = 0; s < 4; ++s) { pv[s] = __shfl_xor(tv[s], 32); pi[s] = __shfl_xor(tix[s], 32); }
#pragma unroll
            for (int t2 = 0; t2 < 4; ++t2) { float v = pv[t2]; int ix = pi[t2];
#pragma unroll
                for (int s = 0; s < 4; ++s) { const bool gt = (v > tv[s]) || (v == tv[s] && ix < tix[s]); const float ov = tv[s]; const int oi = tix[s]; tv[s] = gt ? v : ov; tix[s] = gt ? ix : oi; v = gt ? ov : v; ix = gt ? oi : ix; } }
            const float e0 = 1.f, e1 = __expf(tv[1] - tv[0]), e2 = __expf(tv[2] - tv[0]), e3 = __expf(tv[3] - tv[0]); const float inv = 1.f / (e0 + e1 + e2 + e3);
            g4[0] = e0 * inv; g4[1] = e1 * inv; g4[2] = e2 * inv; g4[3] = e3 * inv;
#pragma unroll
            for (int s = 0; s < 4; ++s) e4[s] = tix[s];
            if (hh == 0) {
#pragma unroll
                for (int s = 0; s < 4; ++s) rk[s] = atomicAdd((int*)(lcnt + e4[s]), 1);
            }
        }
        __syncthreads();
        if (F.tid < 32) lbase[F.tid] = (int)__hip_atomic_fetch_add(F.ctl + CW_GCNT + 64 * F.tid, (unsigned)lcnt[F.tid], RLX_AGENT);
        __syncthreads();
        if (F.wave < 4 && hh == 0) {
#pragma unroll
            for (int s = 0; s < 4; ++s) { const int slot = lbase[e4[s]] + rk[s]; te[tok * 4 + s] = e4[s]; tslot[tok * 4 + s] = slot; tg[tok * 4 + s] = g4[s];
                list[(size_t)e4[s] * LCAP + slot] = tok; lrs[(size_t)e4[s] * LCAP + slot] = rs; }
        }
        __syncthreads();
    }
}
__device__ __forceinline__ int moe_tables(Frame& F) {
    LAS int* tstart = (LAS int*)(F.lds + MOE_TSTART); LAS int* lcnt = (LAS int*)(F.lds + MOE_LCNT); LAS int* texp = (LAS int*)(F.lds + MOE_TEXP);
    if (F.tid < 64) {
        const int lane = F.lane; const int cnt = lane < NE ? (int)__hip_atomic_load(F.ctl + CW_GCNT + 64 * (lane & 31), RLX_AGENT) : 0; const int nt = (cnt + 255) >> 8;
        int inc = nt;
#pragma unroll
        for (int o = 1; o < 32; o <<= 1) { const int up = __shfl_up(inc, o); if (lane >= o) inc += up; }
        if (lane < NE) { const int start = inc - nt; lcnt[lane] = cnt; tstart[lane] = start; for (int i = 0; i < nt; ++i) texp[start + i] = lane; if (lane == NE - 1) tstart[NE] = inc; }
    }
    __syncthreads();
    return tstart[NE];
}
__device__ __forceinline__ void combine_phase(Frame& F, const Args& a, float* dst) {
    LAS int* tstart = (LAS int*)(F.lds + MOE_TSTART);
    const int* te = (const int*)(F.ws + WS_TE); const int* tslot = (const int*)(F.ws + WS_TSLOT); const float* tg = (const float*)(F.ws + WS_TG); const unsigned char* Y = F.ws + WS_Y;
    const bf16* hbf = (const bf16*)(F.ws + WS_HBF); const int gw = F.vcu * NWAVES + F.wave, NGW = F.G * NWAVES, lane = F.lane;
    for (int t0 = gw * 16; t0 < T; t0 += NGW * 16) {
        int pos[4]; float gt[4];
        { const int tl = t0 + (lane & 15);
#pragma unroll
            for (int s = 0; s < 4; ++s) { const int e = te[tl * 4 + s]; pos[s] = tstart[e] * 256 + tslot[tl * 4 + s]; gt[s] = tg[tl * 4 + s]; } }
#pragma unroll 1
        for (int i = 0; i < 16; i += 2) {
            f32x4 o[2][4]; u32x4 w[2][4];
#pragma unroll
            for (int q = 0; q < 2; ++q) { const bf16* hp = hbf + (size_t)(t0 + i + q) * D + 16 * lane;
#pragma unroll
                for (int j = 0; j < 2; ++j) { const u32x4 hr = *(const u32x4*)(hp + 8 * j); o[q][2 * j] = (f32x4){bflo(hr.x), bfhi(hr.x), bflo(hr.y), bfhi(hr.y)}; o[q][2 * j + 1] = (f32x4){bflo(hr.z), bfhi(hr.z), bflo(hr.w), bfhi(hr.w)}; }
#pragma unroll
                for (int s = 0; s < 4; ++s) { const size_t p = (size_t)__builtin_amdgcn_readlane(pos[s], i + q); w[q][s] = *(const u32x4*)(Y + p * D + 16 * lane); } }
#pragma unroll
            for (int q = 0; q < 2; ++q) { float* op = dst + (size_t)(t0 + i + q) * D + 16 * lane;
#pragma unroll
                for (int s = 0; s < 4; ++s) { const float g = __builtin_bit_cast(float, __builtin_amdgcn_readlane(__builtin_bit_cast(int, gt[s]), i + q));
#pragma unroll
                    for (int j = 0; j < 4; ++j) { const int ww = (int)w[q][s][j]; const f32x2 lo = __builtin_amdgcn_cvt_pk_f32_fp8(ww, false), hi = __builtin_amdgcn_cvt_pk_f32_fp8(ww, true);
                        o[q][j] += (f32x4){lo[0], lo[1], hi[0], hi[1]} * g; } }
#pragma unroll
                for (int j = 0; j < 4; ++j) *(f32x4*)(op + 4 * j) = o[q][j]; }
        }
    }
}

constexpr int NPHASE = 9;
__global__ void __launch_bounds__(NTHREADS, 2) hymba_fwd(Args args) {
    extern __shared__ __attribute__((aligned(16))) unsigned char lds_raw[];
    Frame F; F.lds = (LAS unsigned char*)lds_raw; F.ws = args.ws; F.ctl = (unsigned*)(args.ws + WS_CTL);
    F.tid = threadIdx.x; F.lane = F.tid & 63; F.wave = __builtin_amdgcn_readfirstlane(F.tid >> 6);
    F.G = gridDim.x; { const int bx = blockIdx.x; F.vcu = (F.G % 8 == 0) ? (bx % 8) * (F.G / 8) + bx / 8 : bx; }
    volatile LAS unsigned* MISC = (volatile LAS unsigned*)(F.lds + MISC_OFF);
    if (F.tid < 32) MISC[F.tid] = 0u;
    __syncthreads();
    XcdBarrier bar; bar.bar = F.ctl + CW_BAR; bar.x = 0; bar.st = nullptr;
    if (MK_N_LAUNCHES == 1) bar = xcd_barrier_post(F.ctl + CW_BAR, MISC + 8);
    const int lo = args.ph_lo, hi = args.ph_hi;
#define IN(k) (lo <= (k) && (k) < hi)
#define SEAM(k) do { if (IN(k) && IN((k) + 1)) xcd_barrier(bar); } while (0)

    if (IN(0)) { for (int rep = 0; rep < (DUP == 4 ? 2 : 1); ++rep) phase0(F, args); SEAM(0); }
    if (IN(1)) {
        pg8::Gemm g{(const bf16*)(F.ws + WS_XN), (const bf16*)(F.ws + WS_WIN), D}; pg8::StaticOrder S{T / 256, NIN / 256, F.G, (int)blockIdx.x};
        pg8::EpiInProj E{(bf16*)(F.ws + WS_ZG), (bf16*)(F.ws + WS_QB), (bf16*)(F.ws + WS_KB), (bf16*)(F.ws + WS_VB), args.in[7], args.in[8], F.lds + RING_BYTES, args.in[6]};
        pg8::gemm_phase<pg8::EpiInProj, pg8::StaticOrder, false, true, false, (DUP == 18 ? 2 : 1)>(F.lds, g, S, E);
#if DUP == 5
        __syncthreads(); pg8::gemm_phase<pg8::EpiInProj, pg8::StaticOrder, false, true>(F.lds, g, S, E);
#endif
        SEAM(1);
    }
    if (IN(2)) {
        for (int rep = 0; rep < (DUP == 1 ? 2 : 1); ++rep)
        for (int u = F.vcu; u < NBATCH * GH * NCHUNK; u += F.G) gdn_prep_unit(F, args, u, u + F.G < NBATCH * GH * NCHUNK ? u + F.G : -1);
        SEAM(2);
    }
    if (IN(3)) {
        const int nscan = NBATCH * GH;
        for (int rep3 = 0; rep3 < (DUP == 13 ? 2 : 1); ++rep3) {
        for (int bh = blockIdx.x; bh < nscan; bh += F.G) { gdn_scan(F, args, bh);
#if DUP == 3
            gdn_scan(F, args, bh);
#endif
        }
        if (rep3 == 0) { if (F.G > nscan) { if ((int)blockIdx.x >= nscan) { p0_experts(F, args, ((int)blockIdx.x - nscan) * NWAVES + F.wave, (F.G - nscan) * NWAVES);
#if DUP == 15
            __syncthreads(); p0_experts(F, args, ((int)blockIdx.x - nscan) * NWAVES + F.wave, (F.G - nscan) * NWAVES);
#endif
            } } else p0_experts(F, args, (int)blockIdx.x * NWAVES + F.wave, F.G * NWAVES); __syncthreads(); }
        for (int pass = 0; pass < 2; ++pass) {
            for (int rep = 0; rep < (DUP == 2 ? 2 : 1); ++rep)
            for (;;) {
                if (F.tid == 0) MISC[16] = __hip_atomic_fetch_add(F.ctl + CW_ATTQ + 64 * (pass + 2 * rep + 4 * rep3), 1u, RLX_AGENT);
                __syncthreads();
                const int u = (int)MISC[16] + (pass ? 2048 : 0);
                __syncthreads();
                if (u >= (pass ? 3072 : 2048)) break;
                attn_unit(F, args, u);
            }
            if (pass == 0 || DUP == 13) xcd_barrier(bar);
        } }
        SEAM(3);
    }
    if (IN(4)) {
        pg8::Gemm g{(const bf16*)(F.ws + WS_MIX), (const bf16*)(F.ws + WS_WOUT), D}; pg8::StaticOrder S{T / 256, D / 256, F.G, (int)blockIdx.x};
        pg8::EpiOutProj E{args.in[0], (bf16*)(F.ws + WS_HBF), F.ws + WS_HB, F.lds + RING_BYTES};
        pg8::gemm_phase<pg8::EpiOutProj, pg8::StaticOrder, false, true>(F.lds, g, S, E);
#if DUP == 6
        __syncthreads(); pg8::gemm_phase<pg8::EpiOutProj, pg8::StaticOrder, false, true>(F.lds, g, S, E);
#endif
        SEAM(4);
    }
#if !SKIP_MOE
    if (IN(5)) {
        if (DUP == 10) { route_phase(F, args); xcd_barrier(bar); if (blockIdx.x == 0 && F.tid < 32) __hip_atomic_store(F.ctl + CW_GCNT + 64 * F.tid, 0u, RLX_AGENT); xcd_barrier(bar); }
        route_phase(F, args); SEAM(5); }
    if (IN(6)) {
        const int nM = moe_tables(F);
        pg8::Gemm g{(const bf16*)(F.ws + WS_HB), (const bf16*)(F.ws + WS_WGU), D};
        pg8::MoeOrder S{nM, 8, F.G, (int)blockIdx.x, (const LAS int*)(F.lds + MOE_TSTART), (const LAS int*)(F.lds + MOE_LCNT), (const LAS int*)(F.lds + MOE_TEXP), (const int*)(F.ws + WS_LIST)};
        pg8::EpiGateUp E{F.ws + WS_ACT, args.in[15], (const float*)(F.ws + WS_LRS), (const LAS int*)(F.lds + MOE_LCNT), F.lds + RING_BYTES};
        pg8::gemm_phase<pg8::EpiGateUp, pg8::MoeOrder, true, true, true, (DUP == 17 ? 2 : 1)>(F.lds, g, S, E);
#if DUP == 7
        __syncthreads(); pg8::gemm_phase<pg8::EpiGateUp, pg8::MoeOrder, true, true, true>(F.lds, g, S, E);
#endif
        SEAM(6);
    }
    if (IN(7)) {
        const int nM = moe_tables(F);
        pg8::Gemm g{(const bf16*)(F.ws + WS_ACT), (const bf16*)(F.ws + WS_WDN), FF};
        pg8::MoeOrder S{nM, 4, F.G, (int)blockIdx.x, (const LAS int*)(F.lds + MOE_TSTART), (const LAS int*)(F.lds + MOE_LCNT), (const LAS int*)(F.lds + MOE_TEXP), (const int*)(F.ws + WS_LIST)};
        pg8::EpiDown E{F.ws + WS_Y, args.in[17], F.lds + RING_BYTES};
        pg8::gemm_phase<pg8::EpiDown, pg8::MoeOrder, false, true, true>(F.lds, g, S, E);
#if DUP == 8
        __syncthreads(); pg8::gemm_phase<pg8::EpiDown, pg8::MoeOrder, false, true, true>(F.lds, g, S, E);
#endif
        SEAM(7);
    }
#if DUP == 16
    if (IN(8)) { for (int i_ = 0; i_ < 8; ++i_) xcd_barrier(bar); }
#endif
    if (IN(8)) { (void)moe_tables(F); if (DUP == 11) combine_phase(F, args, (float*)(F.ws + WS_ZG)); combine_phase(F, args, args.out); }
#endif
#undef IN
#undef SEAM
}

extern "C" void kernel_launch(void* const* d_in, const int* in_sizes, int n_in, void* d_out, int out_size, void* d_ws, size_t ws_size, hipStream_t stream) {
    static int grid = 0;
    if (grid == 0) {
        if (n_in != 18 || in_sizes[0] != T * D || out_size != T * D || ws_size < WS_END) { fprintf(stderr, "kernel_launch: unexpected shapes (n_in %d, in0 %d, out %d, ws %zu)\n", n_in, n_in > 0 ? in_sizes[0] : -1, out_size, ws_size); grid = -1; return; }
        int dev = 0, cus = 0, per_cu = 0;
        if (hipGetDevice(&dev) != hipSuccess || hipDeviceGetAttribute(&cus, hipDeviceAttributeMultiprocessorCount, dev) != hipSuccess) { grid = -1; return; }
        if (hipFuncSetAttribute((const void*)hymba_fwd, hipFuncAttributeMaxDynamicSharedMemorySize, LDS_BYTES) != hipSuccess) { fprintf(stderr, "kernel_launch: hipFuncSetAttribute failed\n"); grid = -1; return; }
        if (hipOccupancyMaxActiveBlocksPerMultiprocessor(&per_cu, (const void*)hymba_fwd, NTHREADS, LDS_BYTES) != hipSuccess || per_cu < 1) { fprintf(stderr, "kernel_launch: occupancy query says %d\n", per_cu); per_cu = 1; }
        (void)hipGetLastError();
        grid = cus;
    }
    if (grid < 0) return;
    (void)hipMemsetAsync((char*)d_ws + WS_CTL, 0, CTL_ZERO_BYTES, stream);
    Args a{};
    for (int i = 0; i < 18; ++i) a.in[i] = (const float*)d_in[i];
    a.out = (float*)d_out; a.ws = (unsigned char*)d_ws;
    if (MK_N_LAUNCHES == 1) {
        a.ph_lo = 0; a.ph_hi = NPHASE; a.li = 0;
        void* kargs[] = {&a};
        hipError_t e = hipLaunchCooperativeKernel((const void*)hymba_fwd, dim3(grid), dim3(NTHREADS), kargs, LDS_BYTES, stream);
        if (e != hipSuccess) fprintf(stderr, "kernel_launch: cooperative launch failed: %s (grid %d)\n", hipGetErrorString(e), grid);
    } else {
        for (int p = 0; p < NPHASE; ++p) { a.ph_lo = p; a.ph_hi = p + 1; a.li = p; hipLaunchKernelGGL(hymba_fwd, dim3(grid), dim3(NTHREADS), LDS_BYTES, stream, a); }
    }
}
```

```cpp
#include <hip/hip_runtime.h>
#include <cstdio>
#include <cstdint>

#ifndef MK_N_LAUNCHES
#define MK_N_LAUNCHES 1
#endif
#ifndef SKIP_ATTN
#define SKIP_ATTN 0
#endif
#ifndef DUP
#define DUP 0
#endif
#ifndef ATT_JOBS
#define ATT_JOBS 32
#endif
#ifndef SKIP_MOE
#define SKIP_MOE 0
#endif

#define LAS __attribute__((address_space(3)))
#define GAS __attribute__((address_space(1)))
typedef unsigned short bf16;
typedef short bf16x8 __attribute__((ext_vector_type(8)));
typedef short s16x4 __attribute__((ext_vector_type(4)));
typedef float f32x2 __attribute__((ext_vector_type(2)));
typedef float f32x4 __attribute__((ext_vector_type(4)));
typedef float f32x16 __attribute__((ext_vector_type(16)));
typedef unsigned u32x2 __attribute__((ext_vector_type(2)));
typedef unsigned u32x4 __attribute__((ext_vector_type(4)));
typedef __bf16 bf16x2_t __attribute__((ext_vector_type(2)));
typedef int v4i_t __attribute__((ext_vector_type(4)));
typedef int v8i_t __attribute__((ext_vector_type(8)));

constexpr int NBATCH = 8, SEQ = 4096, D = 1024, T = NBATCH * SEQ;
constexpr int IN_DIM = 3592, NIN = 3584;
constexpr int GH = 4, DK = 128, CHUNK = 64, NCHUNK = SEQ / CHUNK;
constexpr int AH = 8, DH = 64;
constexpr int NE = 32, FF = 1024, LCAP = 32768;
constexpr float EPS = 1e-6f, LOG2E = 1.4426950408889634f;
constexpr int NWAVES = 8, NTHREADS = 512;

constexpr size_t MiB = 1u << 20;
constexpr size_t WS_CTL = 0, CTL_ZERO_BYTES = 64 * 1024;
constexpr size_t WS_WIN = 1 * MiB, WS_WOUT = 8 * MiB, WS_WGU = 10 * MiB, WS_WDN = 138 * MiB;
constexpr size_t WS_TE = 202 * MiB, WS_TSLOT = WS_TE + 512 * 1024, WS_TG = WS_TSLOT + 512 * 1024;
constexpr size_t WS_LIST = 204 * MiB, WS_LRS = 208 * MiB;
constexpr size_t WS_BA = 212 * MiB, WS_WRT = 213 * MiB;
constexpr size_t WS_ZG = 214 * MiB, WS_QB = 342 * MiB, WS_KB = 374 * MiB, WS_VB = 406 * MiB;
constexpr size_t WS_PREP = 438 * MiB;
constexpr int PREP_WP = 0, PREP_QP = 16384, PREP_AP = 32768, PREP_KT = 40960, PREP_UP = 57344, PREP_CD = 90112, PREP_REC = 90368;
constexpr size_t WS_OG = 616 * MiB, WS_MIX = 680 * MiB;
constexpr size_t WS_XN = 760 * MiB, WS_HB = 760 * MiB;
constexpr size_t WS_ACT = 214 * MiB, WS_Y = 352 * MiB, WS_HBF = 488 * MiB, WS_END = 824 * MiB;
static_assert(WS_VB - WS_KB == WS_KB - WS_QB, "q/k/v stride");
static_assert(WS_PREP + (size_t)NBATCH * GH * NCHUNK * PREP_REC <= WS_OG, "prep region");
static_assert(WS_ACT + (size_t)(T * 4 + NE * 256) * FF <= WS_Y && WS_Y + (size_t)(T * 4 + NE * 256) * D <= WS_HBF && WS_HBF + (size_t)T * D * 2 <= 616 * MiB, "act/y/h regions");
constexpr int CW_TMO = 0, CW_CODE = 1, CW_ATTQ = 512, CW_GCNT = 1024  , CW_BAR = 8192;
static_assert((CW_BAR + 3456) * 4 <= (int)CTL_ZERO_BYTES && CW_GCNT + 64 * 32 <= CW_BAR, "control words inside the zeroed region");

constexpr int LDS_BYTES = 160 * 1024;
constexpr int RING_BYTES = 131072;
constexpr int TOP_OFF = LDS_BYTES - 4096;
constexpr int MISC_OFF = TOP_OFF;
constexpr int MOE_TAB_OFF = TOP_OFF + 256;
constexpr int MOE_TSTART = MOE_TAB_OFF, MOE_LCNT = MOE_TAB_OFF + 256, MOE_TEXP = MOE_TAB_OFF + 512;

#define RLX_AGENT __ATOMIC_RELAXED, __HIP_MEMORY_SCOPE_AGENT
#define LDS_WAIT() asm volatile("s_waitcnt lgkmcnt(0)" ::: "memory")
#define VM_WAIT() asm volatile("s_waitcnt vmcnt(0)" ::: "memory")
#define WAVE_LDS_ORDER() asm volatile("" ::: "memory")
#define LDS_BARRIER() do { asm volatile("s_waitcnt lgkmcnt(0)" ::: "memory"); __builtin_amdgcn_s_barrier(); asm volatile("" ::: "memory"); } while (0)
__device__ __forceinline__ unsigned pk2(float lo, float hi) { f32x2 v = {lo, hi}; bf16x2_t b = __builtin_convertvector(v, bf16x2_t); return __builtin_bit_cast(unsigned, b); }
__device__ __forceinline__ unsigned pk4_fp8(float a, float b, float c, float d) { int w = 0; w = __builtin_amdgcn_cvt_pk_fp8_f32(a, b, w, false); w = __builtin_amdgcn_cvt_pk_fp8_f32(c, d, w, true); return (unsigned)w; }
__device__ __forceinline__ float bf2f(unsigned short b) { return __uint_as_float((unsigned)b << 16); }
__device__ __forceinline__ float bflo(unsigned w) { return __uint_as_float(w << 16); }
__device__ __forceinline__ float bfhi(unsigned w) { return __uint_as_float(w & 0xffff0000u); }
template <int CTRL> __device__ __forceinline__ float dpp_mov(float v) { return __builtin_bit_cast(float, __builtin_amdgcn_update_dpp(0, __builtin_bit_cast(int, v), CTRL, 0xF, 0xF, true)); }
__device__ __forceinline__ float sum_row16(float v) {
    v += dpp_mov<0xB1>(v);
    v += dpp_mov<0x4E>(v);
    v += dpp_mov<0x141>(v);
    v += dpp_mov<0x140>(v);
    return v; }
__device__ __forceinline__ float sum_xor16(float v) { const unsigned u = __builtin_bit_cast(unsigned, v); auto r = __builtin_amdgcn_permlane16_swap(u, u, false, false); return __builtin_bit_cast(float, (unsigned)r[0]) + __builtin_bit_cast(float, (unsigned)r[1]); }
__device__ __forceinline__ float sum_xor32(float v) { const unsigned u = __builtin_bit_cast(unsigned, v); auto r = __builtin_amdgcn_permlane32_swap(u, u, false, false); return __builtin_bit_cast(float, (unsigned)r[0]) + __builtin_bit_cast(float, (unsigned)r[1]); }
__device__ __forceinline__ float wave_sum(float v) { return sum_xor32(sum_xor16(sum_row16(v))); }
__device__ __forceinline__ float silu_f(float x) { return x * __builtin_amdgcn_rcpf(1.f + __expf(-x)); }
__device__ __forceinline__ float sigmoid_f(float x) { return __builtin_amdgcn_rcpf(1.f + __expf(-x)); }
__device__ __forceinline__ f32x4 silu4(f32x4 v) {
    const f32x4 vc = __builtin_elementwise_max(v, (f32x4){-20.f, -20.f, -20.f, -20.f}); const f32x4 ea = vc * -1.4426950408889634f;
    const f32x4 d = (f32x4){__builtin_amdgcn_exp2f(ea[0]), __builtin_amdgcn_exp2f(ea[1]), __builtin_amdgcn_exp2f(ea[2]), __builtin_amdgcn_exp2f(ea[3])} + 1.f;
    const f32x2 dlo = {d[0], d[1]}, dhi = {d[2], d[3]}; const f32x2 q2 = dlo * dhi; const float rq = __builtin_amdgcn_rcpf(q2[0] * q2[1]); const f32x2 t2 = (f32x2){q2[1], q2[0]} * rq;
    const f32x2 rlo = t2 * dhi, rhi = t2 * dlo; return vc * (f32x4){rlo[0], rlo[1], rhi[0], rhi[1]};
}
__device__ __forceinline__ bf16x8 pack8(f32x4 a, f32x4 b) {
    u32x4 w; w.x = pk2(a[0], a[1]); w.y = pk2(a[2], a[3]); w.z = pk2(b[0], b[1]); w.w = pk2(b[2], b[3]); return __builtin_bit_cast(bf16x8, w);
}

__device__ __forceinline__ void glds16_asm(const void* gsrc, unsigned lds_dst) { unsigned keep;
    asm volatile("s_mov_b32 %0, m0\n\ts_mov_b32 m0, %2\n\ts_nop 0\n\tglobal_load_lds_dwordx4 %1, off\n\ts_mov_b32 m0, %0\n\ts_nop 0" : "=&s"(keep) : "v"(gsrc), "s"(lds_dst) : "memory"); }

__device__ __forceinline__ void glds16_asm_nt(const void* gsrc, unsigned lds_dst) { unsigned keep;
    asm volatile("s_mov_b32 %0, m0\n\ts_mov_b32 m0, %2\n\ts_nop 0\n\tglobal_load_lds_dwordx4 %1, off nt\n\ts_mov_b32 m0, %0\n\ts_nop 0" : "=&s"(keep) : "v"(gsrc), "s"(lds_dst) : "memory"); }

namespace pg8 {
constexpr int BM = 256, BK = 64, HALF = 128, HTB = HALF * BK * 2, STAGE_BYTES = 8 * HTB, NXCD = 8, WGM = 8;
__host__ __device__ __forceinline__ int lds_byte(int r, int c) { const int st = (r >> 4) * 2 + (c >> 5), rr = r & 15, cc = c & 31, ob = rr * 64 + cc * 2; return st * 1024 + (ob ^ (((ob >> 9) & 1) << 5)); }
__host__ __device__ __forceinline__ void stage_rc(int b, int& R, int& C) { const int st = b / 1024, sb = b % 1024, swz = sb ^ (((sb >> 9) & 1) << 5); R = (st >> 1) * 16 + swz / 64; C = (st & 1) * 32 + (swz % 64) / 2; }
__host__ __device__ __forceinline__ int perm32(int rho) { const int n = rho >> 4, i = rho & 15; return 8 * (i >> 2) + 4 * n + (i & 3); }

struct Unit { int pm, pn, pb, e, mt; };
struct Gemm { const bf16* A; const bf16* Bt; int K; };

__device__ __forceinline__ bool static_tile(int i, int G, int c, int nM, int nN, int& pm, int& pn) {
    const int nwg = nM * nN; const long L = (long)i * G + c; if (L >= nwg) return false;
    int wgid = (int)L; { const int q = nwg / NXCD, r = nwg % NXCD, xcd = wgid % NXCD, off = wgid / NXCD; wgid = (xcd < r ? xcd * (q + 1) : r * (q + 1) + (xcd - r) * q) + off; }
    const int nig = WGM * nN, gid = wgid / nig, fm = gid * WGM, gsz = (nM - fm) < WGM ? (nM - fm) : WGM;
    pm = fm + ((wgid % nig) % gsz); pn = (wgid % nig) / gsz; return true;
}
struct StaticOrder {
    int nM, nN, G, c;
    __device__ __forceinline__ bool next(int i, Unit& u) const { int pm, pn; if (!static_tile(i, G, c, nM, nN, pm, pn)) return false; u.pm = pm; u.pn = pn; u.pb = pn; u.e = 0; u.mt = 0; return true; }
    __device__ __forceinline__ int row_index(const Unit&, int) const { return 0; }
};
struct MoeOrder {
    int nM, nN, G, c; const LAS int* tstart; const LAS int* lcnt; const LAS int* texp; const int* list;
    __device__ __forceinline__ bool next(int i, Unit& u) const {
        int pm, pn; if (!static_tile(i, G, c, nM, nN, pm, pn)) return false;
        const int e = texp[pm]; u.pm = pm; u.pn = pn; u.e = e; u.pb = e * nN + pn; u.mt = pm - tstart[e]; return true;
    }
    __device__ __forceinline__ int row_index(const Unit& u, int r) const { const int rr = u.mt * 256 + r; const int v = list[u.e * LCAP + rr]; return rr < lcnt[u.e] ? v : 0; }
};

#define PG8_SA(b, h) (((b) * 2 + (h)) * HTB)
#define PG8_SB(b, h) ((4 + (b) * 2 + (h)) * HTB)
#define PG8_GLDS(src, dstoff) __builtin_amdgcn_global_load_lds((const unsigned*)(src), (LAS unsigned*)(lds + (dstoff)), 16, 0, 0)
#define PG8_STAGE_B(bufoff, nx, kb, h) do { _Pragma("unroll") for (int _i = 0; _i < 2; ++_i) \
        PG8_GLDS(((nx) ? nB : cB) + (kb) + (Epi::WIDE ? (size_t)voffBW[h][_i] : (size_t)(h) * hstep + voffB[_i]), (bufoff) + ldsw + _i * 8192); } while (0)
#define PG8_STAGE_A(bufoff, nx, kb, h) do { _Pragma("unroll") for (int _i = 0; _i < 2; ++_i) \
        PG8_GLDS(GATHER ? (const char*)g.A + (kb) + ((nx) ? voffN[h][_i] : voffC[h][_i]) : ((nx) ? nA : cA) + (kb) + (size_t)(h) * hstep + voffA[_i], (bufoff) + ldsw + _i * 8192); } while (0)
#define PG8_LDA8(dst, b, h) do { _Pragma("unroll") for (int m = 0; m < 4; ++m) { const v4i_t lo_ = *(const LAS v4i_t*)(lds + PG8_SA(b, h) + aoff + m * 2048), hi_ = *(const LAS v4i_t*)(lds + PG8_SA(b, h) + aoff + m * 2048 + 1024); dst[m] = __builtin_shufflevector(lo_, hi_, 0, 1, 2, 3, 4, 5, 6, 7); } } while (0)
#define PG8_LDB8(dst, b, h) do { _Pragma("unroll") for (int n = 0; n < 2; ++n) { const v4i_t lo_ = *(const LAS v4i_t*)(lds + PG8_SB(b, h) + boff + n * 2048), hi_ = *(const LAS v4i_t*)(lds + PG8_SB(b, h) + boff + n * 2048 + 1024); dst[n] = __builtin_shufflevector(lo_, hi_, 0, 1, 2, 3, 4, 5, 6, 7); } } while (0)
#define PG8_LDA(dst, b, h) do { _Pragma("unroll") for (int m = 0; m < 4; ++m) _Pragma("unroll") for (int k = 0; k < 2; ++k) dst[m][k] = *(const LAS bf16x8*)(lds + PG8_SA(b, h) + aoff + m * 2048 + k * 1024); } while (0)
#define PG8_LDB(dst, b, h) do { _Pragma("unroll") for (int n = 0; n < 2; ++n) _Pragma("unroll") for (int k = 0; k < 2; ++k) dst[n][k] = *(const LAS bf16x8*)(lds + PG8_SB(b, h) + boff + n * 2048 + k * 1024); } while (0)
#define PG8_MMA(ai, bj, At, Bt) do { __builtin_amdgcn_s_setprio(1); _Pragma("unroll") for (int m = 0; m < 4; ++m) _Pragma("unroll") for (int n = 0; n < 2; ++n) _Pragma("unroll") for (int k = 0; k < 2; ++k) \
        acc[ai][bj][m][n] = __builtin_amdgcn_mfma_f32_16x16x32_bf16(Bt[n][k], At[m][k], acc[ai][bj][m][n], 0, 0, 0); __builtin_amdgcn_s_setprio(0); } while (0)
#define PG8_MMA8(ai, bj, At, Bt) do { __builtin_amdgcn_s_setprio(1); _Pragma("unroll") for (int m = 0; m < 4; ++m) _Pragma("unroll") for (int n = 0; n < 2; ++n) \
        asm volatile("v_mfma_scale_f32_16x16x128_f8f6f4 %0, %1, %2, %0, %3, %4 op_sel_hi:[0,0,0]" : "+v"(acc[ai][bj][m][n]) : "v"(Bt[n]), "v"(At[m]), "v"(sc_w), "v"(sc_a)); __builtin_amdgcn_s_setprio(0); } while (0)
#define PG8_MMAZ(ai, bj, At, Bt) do { __builtin_amdgcn_s_setprio(1); _Pragma("unroll") for (int m = 0; m < 4; ++m) _Pragma("unroll") for (int n = 0; n < 2; ++n) { \
        acc[ai][bj][m][n] = __builtin_amdgcn_mfma_f32_16x16x32_bf16(Bt[n][0], At[m][0], (f32x4){0.f, 0.f, 0.f, 0.f}, 0, 0, 0); \
        acc[ai][bj][m][n] = __builtin_amdgcn_mfma_f32_16x16x32_bf16(Bt[n][1], At[m][1], acc[ai][bj][m][n], 0, 0, 0); } __builtin_amdgcn_s_setprio(0); } while (0)
#define PG8_MMA8Z(ai, bj, At, Bt) do { __builtin_amdgcn_s_setprio(1); _Pragma("unroll") for (int m = 0; m < 4; ++m) _Pragma("unroll") for (int n = 0; n < 2; ++n) \
        asm volatile("v_mfma_scale_f32_16x16x128_f8f6f4 %0, %1, %2, 0, %3, %4 op_sel_hi:[0,0,0]" : "+v"(acc[ai][bj][m][n]) : "v"(Bt[n]), "v"(At[m]), "v"(sc_w), "v"(sc_a)); __builtin_amdgcn_s_setprio(0); } while (0)
#define XMMA0Z(ai, bj) do { if constexpr (FP8) PG8_MMA8Z(ai, bj, At8, B08); else PG8_MMAZ(ai, bj, At, B0); } while (0)
#define XMMA1Z(ai, bj) do { if constexpr (FP8) PG8_MMA8Z(ai, bj, At8, B18); else PG8_MMAZ(ai, bj, At, B1); } while (0)
#define XLDA(b, h) do { if constexpr (FP8) PG8_LDA8(At8, b, h); else PG8_LDA(At, b, h); } while (0)
#define XLDB0(b, h) do { if constexpr (FP8) PG8_LDB8(B08, b, h); else PG8_LDB(B0, b, h); } while (0)
#define XLDB1(b, h) do { if constexpr (FP8) PG8_LDB8(B18, b, h); else PG8_LDB(B1, b, h); } while (0)
#define XMMA0(ai, bj) do { if constexpr (FP8) PG8_MMA8(ai, bj, At8, B08); else PG8_MMA(ai, bj, At, B0); } while (0)
#define XMMA1(ai, bj) do { if constexpr (FP8) PG8_MMA8(ai, bj, At8, B18); else PG8_MMA(ai, bj, At, B1); } while (0)
#define PG8_WAIT_V(n) asm volatile("s_waitcnt vmcnt(" #n ")" ::: "memory")
#define PG8_WAIT_L(n) asm volatile("s_waitcnt lgkmcnt(" #n ")" ::: "memory")
#define PG8_BAR __builtin_amdgcn_s_barrier()
#define PG8_SCHED __builtin_amdgcn_sched_barrier(0)

template <class Epi, class Sched, bool GATHER, bool ALIGN_EPI, bool FP8 = false, int KREP = 1>
__device__ __forceinline__ void gemm_phase(LAS unsigned char* lds, const Gemm g, const Sched& S, const Epi& E) {
    const int tid = threadIdx.x, wid = __builtin_amdgcn_readfirstlane(tid >> 6), lane = tid & 63, wr = wid >> 2, wc = wid & 3, fr = lane & 15, fq = lane >> 4;
    const int K = g.K, rowb = FP8 ? K : 2 * K, nt = rowb / 128;
    unsigned voffA[2], voffB[2], voffBW[2][2], voffC[2][2], voffN[2][2]; int RA[2], CA[2];
#pragma unroll
    for (int i = 0; i < 2; ++i) { int R, C; stage_rc(tid * 16 + i * 8192, R, C); const int Rb = Epi::PERM ? ((R & ~31) + perm32(R & 31)) : R;
        RA[i] = R; CA[i] = C; voffA[i] = (unsigned)(R * rowb + C * 2); voffB[i] = (unsigned)(Rb * rowb + C * 2);
        voffBW[0][i] = (unsigned)((64 * (R >> 5) + perm32(R & 31)) * rowb + C * 2); voffBW[1][i] = (unsigned)((64 * (R >> 5) + 32 + perm32(R & 31)) * rowb + C * 2); }
    const size_t kstep = (size_t)(BK * 2), hstep = (size_t)HALF * rowb, tstep = 2 * hstep;
    const unsigned ldsw = (unsigned)wid * 1024u;
    const int aoff = lds_byte(wr * 64 + fr, fq * 8), boff = lds_byte(wc * 32 + fr, fq * 8);
    Unit cur, nxt; int ui = 0;
    if (!S.next(0, cur)) return;
    f32x4 acc[2][2][4][2];
#define PG8_ZERO_ACC() do { if constexpr (!FP8) { _Pragma("unroll") for (int a_ = 0; a_ < 2; ++a_) _Pragma("unroll") for (int b_ = 0; b_ < 2; ++b_) _Pragma("unroll") for (int m_ = 0; m_ < 4; ++m_) _Pragma("unroll") for (int n_ = 0; n_ < 2; ++n_) \
        acc[a_][b_][m_][n_] = (f32x4){0.f, 0.f, 0.f, 0.f}; } } while (0)
    PG8_ZERO_ACC();
    bf16x8 At[4][2], B0[2][2], B1[2][2]; v8i_t At8[4], B08[2], B18[2]; int sc_w = 0x7a7a7a7a, sc_a = 0x7f7f7f7f; asm volatile("" : "+v"(sc_w), "+v"(sc_a));
    const char* cA = (const char*)g.A + (size_t)cur.pm * tstep; const char* cB = (const char*)g.Bt + (size_t)cur.pb * tstep;
    if (GATHER) {
#pragma unroll
        for (int h = 0; h < 2; ++h)
#pragma unroll
            for (int i = 0; i < 2; ++i) { voffC[h][i] = (unsigned)(S.row_index(cur, RA[i] + 128 * h) * rowb + CA[i] * 2); voffN[h][i] = voffC[h][i]; }
    }
    const char* nA = cA; const char* nB = cB;
    E.prefetch(cur, 0, wid, lane);
    PG8_STAGE_B(PG8_SB(0, 0), false, 0, 0); PG8_STAGE_B(PG8_SB(0, 1), false, 0, 1); PG8_STAGE_A(PG8_SA(0, 0), false, 0, 0); PG8_STAGE_A(PG8_SA(0, 1), false, 0, 1);
    if (wr == 1) PG8_BAR;
    PG8_WAIT_V(2); PG8_BAR;
    PG8_STAGE_B(PG8_SB(1, 0), false, kstep, 0); PG8_STAGE_A(PG8_SA(1, 0), false, kstep, 0); PG8_STAGE_B(PG8_SB(1, 1), false, kstep, 1);
    PG8_WAIT_V(6); PG8_BAR;
    for (;;) {
        const bool has_next = S.next(ui + 1, nxt);
        if (has_next) E.prefetch(nxt, (ui + 1) % 3, wid, lane);
        nA = has_next ? (const char*)g.A + (size_t)nxt.pm * tstep : cA; nB = has_next ? (const char*)g.Bt + (size_t)nxt.pb * tstep : cB;
        if (GATHER) {
            if (has_next) { int ix[2][2];
#pragma unroll
                for (int h = 0; h < 2; ++h)
#pragma unroll
                    for (int i = 0; i < 2; ++i) ix[h][i] = S.row_index(nxt, RA[i] + 128 * h);
#pragma unroll
                for (int h = 0; h < 2; ++h)
#pragma unroll
                    for (int i = 0; i < 2; ++i) voffN[h][i] = (unsigned)(ix[h][i] * rowb + CA[i] * 2);
            } else {
#pragma unroll
                for (int h = 0; h < 2; ++h)
#pragma unroll
                    for (int i = 0; i < 2; ++i) voffN[h][i] = voffC[h][i]; }
        }
        for (int t = 0; t < nt * KREP; t += 2) {
            const bool last = (t == nt * KREP - 2);
            const int tm = t % nt; const size_t k1 = (size_t)(tm + 1) * kstep, k2 = last ? 0 : (size_t)((tm + 2) % nt) * kstep, k3 = k2 + kstep;
            XLDB0(0, 0); XLDB1(0, 1); PG8_SCHED; XLDA(0, 0); PG8_STAGE_A(PG8_SA(1, 1), false, k1, 1);
            PG8_WAIT_V(8); PG8_WAIT_L(0); PG8_BAR; if (FP8 && t == 0) { XMMA0Z(0, 0); XMMA1Z(0, 1); } else { XMMA0(0, 0); XMMA1(0, 1); } PG8_BAR; PG8_SCHED;
            XLDA(0, 1); PG8_STAGE_B(PG8_SB(0, 0), last, k2, 0); PG8_STAGE_B(PG8_SB(0, 1), last, k2, 1); PG8_STAGE_A(PG8_SA(0, 0), last, k2, 0);
            PG8_WAIT_V(8); PG8_WAIT_L(0); PG8_BAR; if (FP8 && t == 0) { XMMA0Z(1, 0); XMMA1Z(1, 1); } else { XMMA0(1, 0); XMMA1(1, 1); } PG8_BAR; PG8_SCHED;
            XLDB0(1, 0); XLDB1(1, 1); PG8_SCHED; XLDA(1, 0); PG8_STAGE_A(PG8_SA(0, 1), last, k2, 1);
            PG8_WAIT_V(8); PG8_WAIT_L(0); PG8_BAR; XMMA0(0, 0); XMMA1(0, 1); PG8_BAR; PG8_SCHED;
            XLDA(1, 1); PG8_STAGE_B(PG8_SB(1, 0), last, k3, 0); PG8_STAGE_B(PG8_SB(1, 1), last, k3, 1); PG8_STAGE_A(PG8_SA(1, 0), last, k3, 0);
            PG8_WAIT_V(8); PG8_WAIT_L(0); PG8_BAR; XMMA0(1, 0); XMMA1(1, 1); PG8_BAR; PG8_SCHED;
        }
        if constexpr (ALIGN_EPI) { if (wr == 0) PG8_BAR; }
        if constexpr (FP8) asm volatile("s_nop 15\n\ts_nop 15" ::: "memory");
        if constexpr (KREP > 1) {
#pragma unroll
            for (int a_ = 0; a_ < 2; ++a_)
#pragma unroll
                for (int b_ = 0; b_ < 2; ++b_)
#pragma unroll
                    for (int m_ = 0; m_ < 4; ++m_)
#pragma unroll
                        for (int n_ = 0; n_ < 2; ++n_) acc[a_][b_][m_][n_] = acc[a_][b_][m_][n_] * (1.f / KREP); }
        E(acc, cur, wr, wc, fr, fq, ui % 3);
        if (!has_next) break;
        PG8_ZERO_ACC();
        cur = nxt; cA = nA; cB = nB; ++ui;
        if (GATHER) {
#pragma unroll
            for (int h = 0; h < 2; ++h)
#pragma unroll
                for (int i = 0; i < 2; ++i) voffC[h][i] = voffN[h][i];
        }
        if constexpr (ALIGN_EPI) { if (wr == 1) PG8_BAR; }
    }
    PG8_WAIT_V(0);
    if constexpr (!ALIGN_EPI) { if (wr == 0) PG8_BAR; }
    PG8_BAR;
}

struct EpiInProj {
    static constexpr bool PERM = true, WIDE = true;
    __device__ __forceinline__ void prefetch(const Unit&, int, int, int) const {}
    bf16* zg; bf16* qb; bf16* kb; bf16* vb; const float* qn; const float* kn; LAS unsigned char* stage; const float* gnw;
    template <int MODE> __device__ __forceinline__ void body(const f32x4 (&acc)[2][2][4][2], const Unit& u, int wr, int wc, int fr, int fq) const {
        const int lane = fq * 16 + fr; LAS unsigned char* stg = stage + (wr * 4 + wc) * 3584;
        constexpr bool swa = MODE >= 2; const int sec = swa ? (u.pn - 8) >> 1 : 0, head = 4 * ((u.pn - 8) & 1) + wc;
        bf16* dst = qb + (size_t)sec * ((WS_KB - WS_QB) / 2); const float* nw = (sec == 1) ? kn : qn;
        f32x4 wv[2][2];
        if constexpr (MODE == 1 || MODE == 2) {
#pragma unroll
            for (int bj = 0; bj < 2; ++bj)
#pragma unroll
                for (int n = 0; n < 2; ++n) wv[bj][n] = MODE == 2 ? *(const f32x4*)(nw + 32 * bj + 8 * fq + 4 * n) : *(const f32x4*)(gnw + ((wc & 1) * 64 + 32 * bj + 8 * fq + 4 * n)); }
#pragma unroll
        for (int ai = 0; ai < 2; ++ai)
#pragma unroll
            for (int m = 0; m < 4; ++m) {
                float sc = 1.f;
                if constexpr (MODE == 2) { float ss = 0.f;
#pragma unroll
                    for (int bj = 0; bj < 2; ++bj)
#pragma unroll
                        for (int n = 0; n < 2; ++n) { const f32x4 x = acc[ai][bj][m][n]; ss += (x[0] * x[0] + x[1] * x[1]) + (x[2] * x[2] + x[3] * x[3]); }
                    ss = sum_xor32(sum_xor16(ss));
                    sc = rsqrtf(ss * (1.f / 64.f) + EPS) * (sec == 0 ? 0.125f * LOG2E : 1.f); }
#pragma unroll
                for (int bj = 0; bj < 2; ++bj) { f32x4 v0 = acc[ai][bj][m][0], v1 = acc[ai][bj][m][1];
                    if constexpr (MODE == 1) { v0 = silu4(v0) * wv[bj][0]; v1 = silu4(v1) * wv[bj][1]; }
                    if constexpr (MODE == 2) { v0 = (v0 * sc) * wv[bj][0]; v1 = (v1 * sc) * wv[bj][1]; }
                    u32x4 w; w.x = pk2(v0[0], v0[1]); w.y = pk2(v0[2], v0[3]); w.z = pk2(v1[0], v1[1]); w.w = pk2(v1[2], v1[3]); *(LAS u32x4*)(stg + fr * 144 + bj * 64 + fq * 16) = w; }
                WAVE_LDS_ORDER();
                const int row0 = u.pm * BM + ai * HALF + wr * 64 + m * 16;
                u32x4 wq[2];
#pragma unroll
                for (int hf = 0; hf < 2; ++hf) wq[hf] = *(const LAS u32x4*)(stg + (hf * 8 + (lane >> 3)) * 144 + (lane & 7) * 16);
                asm volatile("" :: "v"(wq[0]), "v"(wq[1]));
#pragma unroll
                for (int hf = 0; hf < 2; ++hf) { const int rr = hf * 8 + (lane >> 3), c16 = lane & 7, row_ = row0 + rr;
                    bf16* gp = swa ? dst + ((size_t)((row_ >> 12) * AH + head) * SEQ + (row_ & (SEQ - 1))) * 64 + 8 * c16 : zg + (size_t)row_ * 2048 + u.pn * BM + wc * 64 + 8 * c16;
                    __builtin_nontemporal_store(wq[hf], (u32x4*)gp); }
                WAVE_LDS_ORDER(); }
    }
    __device__ __forceinline__ void operator()(const f32x4 (&acc)[2][2][4][2], const Unit& u, int wr, int wc, int fr, int fq, int) const {
        if (u.pn < 6) body<0>(acc, u, wr, wc, fr, fq); else if (u.pn < 8) body<1>(acc, u, wr, wc, fr, fq); else if (u.pn < 12) body<2>(acc, u, wr, wc, fr, fq); else body<3>(acc, u, wr, wc, fr, fq);
    }
};
struct EpiOutProj {
    __device__ __forceinline__ void prefetch(const Unit&, int, int, int) const {}
    static constexpr bool PERM = true, WIDE = true;
    const float* x; bf16* h; unsigned char* hb; LAS unsigned char* stage;
    __device__ __forceinline__ void operator()(const f32x4 (&acc)[2][2][4][2], const Unit& u, int wr, int wc, int fr, int fq, int) const {
        const int lane = fq * 16 + fr; LAS unsigned char* stg = stage + (wr * 4 + wc) * 3584; const int colw = u.pn * BM + wc * 64;
        const int r8 = lane >> 3, c16 = lane & 7;
#pragma unroll
        for (int ai = 0; ai < 2; ++ai)
#pragma unroll
            for (int mp = 0; mp < 2; ++mp) {
                f32x4 xv[2][2][2];
#pragma unroll
                for (int mm = 0; mm < 2; ++mm) { const int row0 = u.pm * BM + ai * HALF + wr * 64 + (2 * mp + mm) * 16;
#pragma unroll
                    for (int bj = 0; bj < 2; ++bj)
#pragma unroll
                        for (int hf = 0; hf < 2; ++hf) xv[mm][bj][hf] = __builtin_nontemporal_load((const f32x4*)(x + (size_t)(row0 + 8 * hf + r8) * D + colw + 32 * bj + 4 * c16)); }
                unsigned h8[2][2][2];
#pragma unroll
                for (int mm = 0; mm < 2; ++mm) { const int m = 2 * mp + mm; const int row0 = u.pm * BM + ai * HALF + wr * 64 + m * 16; u32x4 hw[2];
#pragma unroll
                    for (int bj = 0; bj < 2; ++bj) {
#pragma unroll
                        for (int hf = 0; hf < 2; ++hf) *(LAS f32x4*)(stg + (8 * hf + r8) * 144 + c16 * 16) = xv[mm][bj][hf];
                        WAVE_LDS_ORDER();
                        const f32x4 x0 = *(const LAS f32x4*)(stg + fr * 144 + fq * 32), x1 = *(const LAS f32x4*)(stg + fr * 144 + fq * 32 + 16);
                        const f32x4 v0 = acc[ai][bj][m][0] + x0, v1 = acc[ai][bj][m][1] + x1;
                        h8[mm][bj][0] = pk4_fp8(v0[0], v0[1], v0[2], v0[3]); h8[mm][bj][1] = pk4_fp8(v1[0], v1[1], v1[2], v1[3]);
                        hw[bj] = (u32x4){pk2(v0[0], v0[1]), pk2(v0[2], v0[3]), pk2(v1[0], v1[1]), pk2(v1[2], v1[3])};
                        WAVE_LDS_ORDER(); }
#pragma unroll
                    for (int bj = 0; bj < 2; ++bj) *(LAS u32x4*)(stg + fr * 144 + bj * 64 + fq * 16) = hw[bj];
                    WAVE_LDS_ORDER();
#pragma unroll
                    for (int hf = 0; hf < 2; ++hf) { const u32x4 w = *(const LAS u32x4*)(stg + (8 * hf + r8) * 144 + c16 * 16); __builtin_nontemporal_store(w, (u32x4*)(h + (size_t)(row0 + 8 * hf + r8) * D + colw + 8 * c16)); }
                    WAVE_LDS_ORDER(); }
#pragma unroll
                for (int mm = 0; mm < 2; ++mm)
#pragma unroll
                    for (int bj = 0; bj < 2; ++bj) *(LAS u32x2*)(stg + (16 * mm + fr) * 80 + bj * 32 + fq * 8) = (u32x2){h8[mm][bj][0], h8[mm][bj][1]};
                WAVE_LDS_ORDER();
                { const int rr = lane >> 2, q16 = lane & 3; const int rowa = u.pm * BM + ai * HALF + wr * 64 + (2 * mp) * 16;
                  const u32x4 w0 = *(const LAS u32x4*)(stg + rr * 80 + q16 * 16), w1 = *(const LAS u32x4*)(stg + (16 + rr) * 80 + q16 * 16);
                  *(u32x4*)(hb + (size_t)(rowa + rr) * D + colw + 16 * q16) = w0; *(u32x4*)(hb + (size_t)(rowa + 16 + rr) * D + colw + 16 * q16) = w1; }
                WAVE_LDS_ORDER(); }
    }
};
struct EpiGateUp {
    static constexpr bool PERM = true, WIDE = false;
    unsigned char* act; const float* bgu; const float* lrs; const LAS int* lcnt; LAS unsigned char* stage;
    __device__ __forceinline__ void prefetch(const Unit& u, int slot, int wid, int lane) const {
        const unsigned l0 = (unsigned)(uintptr_t)stage;
        if (wid == 0) glds16_asm(bgu + (size_t)u.e * 2048 + (lane >> 5) * 1024 + 128 * u.pn + (lane & 31) * 4, (unsigned)__builtin_amdgcn_readfirstlane((int)(l0 + slot * 1024)));
        else if (wid == 1) glds16_asm(lrs + (size_t)u.e * LCAP + u.mt * 256 + lane * 4, (unsigned)__builtin_amdgcn_readfirstlane((int)(l0 + 3072 + slot * 1024)));
    }
    __device__ __forceinline__ void operator()(const f32x4 (&acc)[2][2][4][2], const Unit& u, int wr, int wc, int fr, int fq, int slot) const {
        const int cl = wc * 32 + 8 * fq; const LAS float* bl = (const LAS float*)(stage + slot * 1024); const LAS float* rl = (const LAS float*)(stage + 3072 + slot * 1024);
        f32x4 bgv[2], buv[2];
#pragma unroll
        for (int n = 0; n < 2; ++n) { bgv[n] = *(const LAS f32x4*)(bl + cl + 4 * n); buv[n] = *(const LAS f32x4*)(bl + 128 + cl + 4 * n) + 1.f; }
        const int cnt = lcnt[u.e];
#pragma unroll
        for (int ai = 0; ai < 2; ++ai)
#pragma unroll
            for (int m = 0; m < 4; ++m) { const int r = ai * HALF + wr * 64 + m * 16 + fr, rr = u.mt * 256 + r;
                const float rsv = rl[r]; const float rs = rr < cnt ? rsv : 0.f;
                unsigned wq[2];
#pragma unroll
                for (int n = 0; n < 2; ++n) {
                    const f32x4 gt = __builtin_elementwise_min(__builtin_elementwise_max(acc[ai][0][m][n] * rs + bgv[n], (f32x4){-12.5f, -12.5f, -12.5f, -12.5f}), (f32x4){7.f, 7.f, 7.f, 7.f});
                    const f32x4 u1 = __builtin_elementwise_min(__builtin_elementwise_max(acc[ai][1][m][n] * rs + buv[n], (f32x4){-6.f, -6.f, -6.f, -6.f}), (f32x4){8.f, 8.f, 8.f, 8.f});
                    const f32x4 ea = gt * (-1.702f * LOG2E);
                    const f32x4 dn = (f32x4){__builtin_amdgcn_exp2f(ea[0]), __builtin_amdgcn_exp2f(ea[1]), __builtin_amdgcn_exp2f(ea[2]), __builtin_amdgcn_exp2f(ea[3])} + 1.f;
                    const f32x2 dlo = {dn[0], dn[1]}, dhi = {dn[2], dn[3]}; const f32x2 q2 = dlo * dhi;
                    const float rq = __builtin_amdgcn_rcpf(q2[0] * q2[1]); const f32x2 t2 = (f32x2){q2[1], q2[0]} * rq;
                    const f32x2 rlo = t2 * dhi, rhi = t2 * dlo;
                    const f32x4 a = (u1 * gt) * (f32x4){rlo[0], rlo[1], rhi[0], rhi[1]};
                    wq[n] = pk4_fp8(a[0], a[1], a[2], a[3]); }
                *(u32x2*)(act + (size_t)(u.pm * BM + r) * FF + 128 * u.pn + cl) = (u32x2){wq[0], wq[1]}; }
    }
};
struct EpiDown {
    static constexpr bool PERM = true, WIDE = true;
    unsigned char* y; const float* bdn; LAS unsigned char* stage;
    __device__ __forceinline__ void prefetch(const Unit& u, int slot, int wid, int lane) const {
        if (wid == 0) glds16_asm(bdn + (size_t)u.e * D + u.pn * BM + lane * 4, (unsigned)__builtin_amdgcn_readfirstlane((int)((unsigned)(uintptr_t)stage + 20480 + slot * 1024)));
    }
    __device__ __forceinline__ void operator()(const f32x4 (&acc)[2][2][4][2], const Unit& u, int wr, int wc, int fr, int fq, int slot) const {
        const int colw = u.pn * BM + wc * 64; const LAS float* bp = (const LAS float*)(stage + 20480 + slot * 1024) + wc * 64 + 8 * fq;
        f32x4 bv[2][2];
#pragma unroll
        for (int bj = 0; bj < 2; ++bj)
#pragma unroll
            for (int n = 0; n < 2; ++n) bv[bj][n] = *(const LAS f32x4*)(bp + 32 * bj + 4 * n);
        const int lane = fq * 16 + fr; LAS unsigned char* stg = stage + (wr * 4 + wc) * 2560;
#pragma unroll
        for (int ai = 0; ai < 2; ++ai)
#pragma unroll
            for (int mp = 0; mp < 2; ++mp) {
#pragma unroll
                for (int mm = 0; mm < 2; ++mm) { const int m = 2 * mp + mm;
#pragma unroll
                    for (int bj = 0; bj < 2; ++bj) { const f32x4 v0 = acc[ai][bj][m][0] + bv[bj][0], v1 = acc[ai][bj][m][1] + bv[bj][1];
                        *(LAS u32x2*)(stg + (16 * mm + fr) * 80 + bj * 32 + fq * 8) = (u32x2){pk4_fp8(v0[0], v0[1], v0[2], v0[3]), pk4_fp8(v1[0], v1[1], v1[2], v1[3])}; } }
                WAVE_LDS_ORDER();
                { const int rr = lane >> 2, c16 = lane & 3; const u32x4 w = *(const LAS u32x4*)(stg + rr * 80 + c16 * 16);
                  const int rowa = u.pm * BM + ai * HALF + wr * 64 + (2 * mp) * 16 + rr; *(u32x4*)(y + (size_t)rowa * D + colw + 16 * c16) = w;
                  const u32x4 w2 = *(const LAS u32x4*)(stg + (16 + rr) * 80 + c16 * 16); *(u32x4*)(y + (size_t)(rowa + 16) * D + colw + 16 * c16) = w2; }
                WAVE_LDS_ORDER(); }
    }
};
}

#define XB_TMO      128
#define XB_XCNT(j)  (256  + 64 * (j))
#define XB_XSUB(j)  (1280 + 64 * (j))
#define XB_XGEN(j)  (2304 + 64 * (j))
#define XB_TOP      3328
#define XB_TOPGEN   3392
#define XCD_BAR_WORDS 3456
#define XB_SPIN_CAP (1u << 20)
__device__ __forceinline__ unsigned xb_ld(unsigned* p)              { return __hip_atomic_load(p, __ATOMIC_RELAXED, __HIP_MEMORY_SCOPE_AGENT); }
__device__ __forceinline__ unsigned xb_add(unsigned* p, unsigned v) { return __hip_atomic_fetch_add(p, v, __ATOMIC_RELAXED, __HIP_MEMORY_SCOPE_AGENT); }
__device__ __forceinline__ unsigned xb_xcc_id() { return (unsigned)__builtin_amdgcn_s_getreg((3 << 11) | 20) & 0xFu; }
#define XB_SPIN(cond, bar) do { unsigned _sp = 0; while (cond) { __builtin_amdgcn_s_sleep(1); \
    if ((++_sp & 255u) == 0u) { if (xb_ld(&(bar)[XB_TMO])) break; if (_sp > XB_SPIN_CAP) { atomicAdd(&(bar)[XB_TMO], 1u); break; } } } } while (0)
struct XcdBarrier { unsigned* bar; unsigned x; volatile LAS unsigned* st; };
__device__ __forceinline__ XcdBarrier xcd_barrier_post(unsigned* bar, volatile LAS unsigned* st) {
    XcdBarrier b; b.bar = bar; b.x = xb_xcc_id(); b.st = st;
    if (threadIdx.x == 0) (void)xb_add(&bar[XB_XCNT(b.x)], 1u);
    return b;
}
__device__ __forceinline__ void xcd_barrier_complete(unsigned* bar, unsigned x, unsigned& nloc, unsigned& nx) {
    const unsigned G = gridDim.x * gridDim.y * gridDim.z;
    unsigned sum, cnt, mine, sp = 0u;
    for (;;) {
        sum = 0u; cnt = 0u; mine = 0u;
#pragma unroll
        for (unsigned j = 0; j < 16; ++j) { const unsigned c = xb_ld(&bar[XB_XCNT(j)]); sum += c; cnt += (c > 0u) ? 1u : 0u; mine = (j == x) ? c : mine; }
        if (sum == G) break;
        __builtin_amdgcn_s_sleep(1);
        if ((++sp & 255u) == 0u) { if (xb_ld(&bar[XB_TMO])) break; if (sp > XB_SPIN_CAP) { atomicAdd(&bar[XB_TMO], 1u); break; } }
    }
    nloc = mine > 0u ? mine : 1u; nx = cnt > 0u ? cnt : 1u;
}
__device__ __forceinline__ void xcd_barrier(const XcdBarrier& b) {
    asm volatile("s_waitcnt vmcnt(0)" ::: "memory");
    __syncthreads();
    if (threadIdx.x == 0) {
        unsigned* bar = b.bar;
        __builtin_amdgcn_s_waitcnt(0);
        unsigned nloc = b.st[0], nx = b.st[1];
        if (nloc == 0u) { xcd_barrier_complete(bar, b.x, nloc, nx); b.st[0] = nloc; b.st[1] = nx; }
        const unsigned old = xb_add(&bar[XB_XSUB(b.x)], 1u);
        const unsigned gen = old / nloc;
        if (old + 1u == (gen + 1u) * nloc) {
            __builtin_amdgcn_fence(__ATOMIC_RELEASE, "agent");
            asm volatile("s_waitcnt vmcnt(0)" ::: "memory");
            const unsigned og = xb_add(&bar[XB_TOP], 1u);
            const unsigned tg = og / nx;
            if (og + 1u == (tg + 1u) * nx) xb_add(&bar[XB_TOPGEN], 1u);
            else XB_SPIN(xb_ld(&bar[XB_TOPGEN]) == tg, bar);
            __builtin_amdgcn_fence(__ATOMIC_ACQUIRE, "agent");
            xb_add(&bar[XB_XGEN(b.x)], 1u);
            asm volatile("s_waitcnt vmcnt(0)" ::: "memory");
        } else {
            XB_SPIN(xb_ld(&bar[XB_XGEN(b.x)]) == gen, bar);
            __builtin_amdgcn_fence(__ATOMIC_ACQUIRE, "agent");
            asm volatile("s_waitcnt vmcnt(0)" ::: "memory");
        }
    }
    __syncthreads();
}

struct Args { const float* in[18]; float* out; unsigned char* ws; int ph_lo, ph_hi, li, pad; };
struct Frame {
    LAS unsigned char* lds; unsigned char* ws; unsigned* ctl;
    int tid, lane, wave, G, vcu;
};

__device__ const unsigned char T5B[3][132] = {
{0,1,2,3,4,5,6,7,8,9,10,11,12,13,14,15,16,16,16,16,16,16,17,17,17,17,17,17,17,17,18,18,18,18,18,18,18,18,18,18,19,19,19,19,19,19,19,19,19,19,19,19,19,19,20,20,20,20,20,20,20,20,20,20,20,20,20,20,20,20,20,20,20,21,21,21,21,21,21,21,21,21,21,21,21,21,21,21,21,21,21,21,21,21,21,21,21,21,21,22,22,22,22,22,22,22,22,22,22,22,22,22,22,22,22,22,22,22,22,22,22,22,22,22,22,22,22,22,22,0,0,0},
{0,4,8,12,16,16,17,17,18,18,19,19,19,19,20,20,20,20,20,21,21,21,21,21,21,22,22,22,22,22,22,22,22,22,23,23,23,23,23,23,23,23,23,23,23,23,24,24,24,24,24,24,24,24,24,24,24,24,24,24,24,24,25,25,25,25,25,25,25,25,25,25,25,25,25,25,25,25,25,25,25,25,25,26,26,26,26,26,26,26,26,26,26,26,26,26,26,26,26,26,26,26,26,26,26,26,26,26,26,26,26,26,26,27,27,27,27,27,27,27,27,27,27,27,27,27,27,27,27,0,0,0},
{0,16,18,19,20,21,21,22,22,23,23,23,24,24,24,24,25,25,25,25,25,26,26,26,26,26,26,26,26,27,27,27,27,27,27,27,27,27,27,28,28,28,28,28,28,28,28,28,28,28,28,28,29,29,29,29,29,29,29,29,29,29,29,29,29,29,29,29,29,29,30,30,30,30,30,30,30,30,30,30,30,30,30,30,30,30,30,30,30,30,30,30,30,30,30,31,31,31,31,31,31,31,31,31,31,31,31,31,31,31,31,31,31,31,31,31,31,31,31,31,31,31,31,31,31,31,31,31,31,0,0,0}};

__device__ __forceinline__ void p0_load8(const float* W, size_t ldw, int src_col0, int k0, int lane, f32x4 (&v)[8]) {
    const int n4 = (lane & 7) * 4, kr = lane >> 3;
#pragma unroll
    for (int i = 0; i < 8; ++i) v[i] = __builtin_nontemporal_load((const f32x4*)(W + (size_t)(k0 + 8 * i + kr) * ldw + src_col0 + n4));
}
template <bool SCALE, bool OUT8> __device__ __forceinline__ void p0_finish(const f32x4 (&v)[8], void* dstv, int k0, const float* kscale, LAS float* scr, int lane) {
    { const int n4 = (lane & 7) * 4, kr = lane >> 3;
#pragma unroll
        for (int i = 0; i < 8; ++i) { const int kk = 8 * i + kr; f32x4 x = v[i]; if (SCALE) x = x * kscale[k0 + kk]; if (OUT8) x = x * 32.f;
            scr[kk * 33 + n4] = x[0]; scr[kk * 33 + n4 + 1] = x[1]; scr[kk * 33 + n4 + 2] = x[2]; scr[kk * 33 + n4 + 3] = x[3]; } }
    LDS_WAIT(); asm volatile("" ::: "memory");
    if (OUT8) { unsigned char* dst = (unsigned char*)dstv; const int n = lane >> 1, kh = lane & 1; const LAS float* sp = scr + (32 * kh) * 33 + n; unsigned w[8];
#pragma unroll
        for (int q = 0; q < 8; ++q) w[q] = pk4_fp8(sp[(4 * q) * 33], sp[(4 * q + 1) * 33], sp[(4 * q + 2) * 33], sp[(4 * q + 3) * 33]);
        *(u32x4*)(dst + (size_t)n * 1024 + k0 + 32 * kh) = (u32x4){w[0], w[1], w[2], w[3]}; *(u32x4*)(dst + (size_t)n * 1024 + k0 + 32 * kh + 16) = (u32x4){w[4], w[5], w[6], w[7]};
    } else { bf16* dst = (bf16*)dstv; const int c = lane & 7;
#pragma unroll
        for (int j = 0; j < 4; ++j) { const int n = (lane >> 3) + 8 * j; const LAS float* sp = scr + (8 * c) * 33 + n;
            u32x4 o; o.x = pk2(sp[0 * 33], sp[1 * 33]); o.y = pk2(sp[2 * 33], sp[3 * 33]); o.z = pk2(sp[4 * 33], sp[5 * 33]); o.w = pk2(sp[6 * 33], sp[7 * 33]);
            *(u32x4*)(dst + (size_t)n * 1024 + k0 + 8 * c) = o; } }
    LDS_WAIT(); asm volatile("" ::: "memory");
}
template <bool SCALE, bool OUT8> __device__ __forceinline__ void p0_transpose_item(const float* W, size_t ldw, int src_col0, void* dstv, int k0, const float* kscale, LAS float* scr, int lane) {
    f32x4 v[8]; p0_load8(W, ldw, src_col0, k0, lane, v); p0_finish<SCALE, OUT8>(v, dstv, k0, kscale, scr, lane);
}
__device__ __forceinline__ void p0_experts(Frame& F, const Args& a, int gw, int NGW) {
    const float* n2 = a.in[11]; const float* w_gu = a.in[14]; const float* w_dn = a.in[16];
    unsigned char* Wgu8 = F.ws + WS_WGU; unsigned char* Wdn8 = F.ws + WS_WDN;
    LAS float* scr = (LAS float*)(F.lds + F.wave * 16896);
    constexpr int I_GU = NE * 8 * 64, I_DN = NE * 8 * 32, NI = I_GU + I_DN;
#define P0_X_ARGS(r_) const bool gu_ = (r_) < I_GU; const int r2_ = gu_ ? (r_) : (r_) - I_GU; const int e_ = gu_ ? (r2_ >> 9) : (r2_ >> 8), q_ = gu_ ? (r2_ & 511) : (r2_ & 255), nb_ = gu_ ? (q_ & 63) : (q_ & 31), kb_ = gu_ ? (q_ >> 6) : (q_ >> 5), \
        np_ = 32 * nb_, ntile_ = np_ >> 8, lc_ = np_ & 255; const int col_ = gu_ ? ((lc_ >> 7) * 1024 + 128 * ntile_ + (lc_ & 127)) : np_; const float* W_ = gu_ ? w_gu + (size_t)e_ * D * 2048 : w_dn + (size_t)e_ * FF * D; const size_t ldw_ = gu_ ? 2048 : D; \
        unsigned char* dst_ = gu_ ? Wgu8 + ((size_t)e_ * 2048 + np_) * 1024 : Wdn8 + ((size_t)e_ * 1024 + np_) * 1024; const int k0_ = 128 * kb_
#define P0_X_LOAD(r_, v_) do { P0_X_ARGS(r_); (void)dst_; const int n4 = (F.lane & 7) * 4, kr = F.lane >> 3; \
        _Pragma("unroll") for (int i = 0; i < 16; ++i) v_[i] = *(const f32x4*)(W_ + (size_t)(k0_ + 8 * i + kr) * ldw_ + col_ + n4); } while (0)
#define P0_X_FIN(r_, v_) do { P0_X_ARGS(r_); (void)W_; (void)ldw_; (void)col_; { const int n4 = (F.lane & 7) * 4, kr = F.lane >> 3; \
        _Pragma("unroll") for (int i = 0; i < 16; ++i) { const int kk = 8 * i + kr; f32x4 x = v_[i] * 32.f; if (gu_) x = x * n2[k0_ + kk]; \
            scr[kk * 33 + n4] = x[0]; scr[kk * 33 + n4 + 1] = x[1]; scr[kk * 33 + n4 + 2] = x[2]; scr[kk * 33 + n4 + 3] = x[3]; } } \
        LDS_WAIT(); asm volatile("" ::: "memory"); \
        { const int n = F.lane >> 1, kh = F.lane & 1; const LAS float* sp = scr + (64 * kh) * 33 + n; \
          _Pragma("unroll") for (int c = 0; c < 4; ++c) { unsigned w_[4]; _Pragma("unroll") for (int q = 0; q < 4; ++q) w_[q] = pk4_fp8(sp[(16 * c + 4 * q) * 33], sp[(16 * c + 4 * q + 1) * 33], sp[(16 * c + 4 * q + 2) * 33], sp[(16 * c + 4 * q + 3) * 33]); \
              *(u32x4*)(dst_ + (size_t)n * 1024 + k0_ + 64 * kh + 16 * c) = (u32x4){w_[0], w_[1], w_[2], w_[3]}; } } \
        LDS_WAIT(); asm volatile("" ::: "memory"); } while (0)
    { f32x4 va[16], vb2[16]; int it = gw;
        if (it < NI) P0_X_LOAD(it, va);
#pragma unroll 1
        for (; it < NI; it += 2 * NGW) { const int it2 = it + NGW, it3 = it + 2 * NGW;
            if (it2 < NI) P0_X_LOAD(it2, vb2);
            P0_X_FIN(it, va);
            if (it3 < NI) P0_X_LOAD(it3, va);
            if (it2 < NI) P0_X_FIN(it2, vb2); } }
#undef P0_X_LOAD
#undef P0_X_FIN
#undef P0_X_ARGS
}
__device__ __forceinline__ void phase0(Frame& F, const Args& a) {
    const float* x = a.in[0]; const float* n1 = a.in[1]; const float* w_in = a.in[2]; const float* w_out = a.in[10]; const float* n2 = a.in[11];
    const float* w_r = a.in[12]; const float* w_gu = a.in[14]; const float* w_dn = a.in[16];
    bf16* Win_t = (bf16*)(F.ws + WS_WIN); bf16* Wout_t = (bf16*)(F.ws + WS_WOUT); bf16* Wgu_t = (bf16*)(F.ws + WS_WGU); bf16* Wdn_t = (bf16*)(F.ws + WS_WDN);
    float* wrT = (float*)(F.ws + WS_WRT); bf16* XN = (bf16*)(F.ws + WS_XN); float* BA = (float*)(F.ws + WS_BA);
    LAS float* scr = (LAS float*)(F.lds + F.wave * 8448);
    const int gw = F.vcu * NWAVES + F.wave, NGW = F.G * NWAVES;
    { bf16* wrh = (bf16*)wrT; bf16* wrl = wrh + NE * D;
      for (int i = (F.vcu * NTHREADS + F.tid); i < NE * D; i += F.G * NTHREADS) { const int e = i >> 10, k = i & 1023; const float w = n2[k] * w_r[k * NE + e];
          const unsigned hi = pk2(w, 0.f) & 0xffffu; const float lo = w - __uint_as_float(hi << 16); wrh[i] = (bf16)hi; wrl[i] = (bf16)(pk2(lo, 0.f) & 0xffffu); } }
    constexpr int I_IN = 16 * (NIN / 32), I_OUT = 16 * 32;
    for (int it = gw; it < I_IN + I_OUT; it += NGW) {
        int r = it;
        if (r < I_IN) { const int nb = r % (NIN / 32), kb = r / (NIN / 32), np = 32 * nb; int src;
            src = np < 2048 ? np : np + 8;
            p0_transpose_item<false, false>(w_in, IN_DIM, src, Win_t + (size_t)np * 1024, 64 * kb, nullptr, scr, F.lane); continue; }
        r -= I_IN;
        { const int nb = r & 31, kb = r >> 5; p0_transpose_item<false, false>(w_out, D, 32 * nb, Wout_t + (size_t)(32 * nb) * 1024, 64 * kb, nullptr, scr, F.lane); }
    }
    __syncthreads();
    { LAS float* wb = (LAS float*)(F.lds + 69632);
        for (int k = F.tid; k < D; k += NTHREADS) { const float* wp = w_in + (size_t)k * IN_DIM + 2048; LAS float* dp = wb + (k >> 2) * 36 + (k & 3) * 8;
            *(LAS f32x4*)dp = *(const f32x4*)wp; *(LAS f32x4*)(dp + 4) = *(const f32x4*)(wp + 4); }
        __syncthreads();
        f32x4 n1v[4];
#pragma unroll
        for (int j = 0; j < 4; ++j) n1v[j] = *((const f32x4*)n1 + F.lane + 64 * j);
        for (int rep9 = 0; rep9 < (DUP == 9 ? 2 : 1); ++rep9)
        for (int m0 = gw * 4; m0 < T; m0 += NGW * 4) {
            f32x4 v[4][4]; float rs[4];
#pragma unroll
            for (int r = 0; r < 4; ++r)
#pragma unroll
                for (int j = 0; j < 4; ++j) v[r][j] = __builtin_nontemporal_load((const f32x4*)(x + (size_t)(m0 + r) * D) + F.lane + 64 * j);
#pragma unroll
            for (int r = 0; r < 4; ++r) { float sq = 0.f;
#pragma unroll
                for (int j = 0; j < 4; ++j) sq += (v[r][j][0] * v[r][j][0] + v[r][j][1] * v[r][j][1]) + (v[r][j][2] * v[r][j][2] + v[r][j][3] * v[r][j][3]);
                rs[r] = rsqrtf(wave_sum(sq) * (1.f / D) + EPS); }
            float ba[4][8];
#pragma unroll
            for (int r = 0; r < 4; ++r)
#pragma unroll
                for (int c = 0; c < 8; ++c) ba[r][c] = 0.f;
#pragma unroll
            for (int j = 0; j < 4; ++j) {
#pragma unroll
                for (int r = 0; r < 4; ++r) { v[r][j] = v[r][j] * rs[r] * n1v[j];
                    *((unsigned long long*)(XN + (size_t)(m0 + r) * D) + F.lane + 64 * j) = (unsigned long long)pk2(v[r][j][0], v[r][j][1]) | ((unsigned long long)pk2(v[r][j][2], v[r][j][3]) << 32); }
#pragma unroll
                for (int i = 0; i < 4; ++i) { const LAS float* wp = wb + (F.lane + 64 * j) * 36 + i * 8; const f32x4 w0 = *(const LAS f32x4*)wp, w1 = *(const LAS f32x4*)(wp + 4);
#pragma unroll
                    for (int r = 0; r < 4; ++r) { const float xv = v[r][j][i];
                        ba[r][0] += xv * w0[0]; ba[r][1] += xv * w0[1]; ba[r][2] += xv * w0[2]; ba[r][3] += xv * w0[3];
                        ba[r][4] += xv * w1[0]; ba[r][5] += xv * w1[1]; ba[r][6] += xv * w1[2]; ba[r][7] += xv * w1[3]; } } }
#pragma unroll
            for (int r = 0; r < 4; ++r) {
#pragma unroll
                for (int c = 0; c < 8; ++c) ba[r][c] = wave_sum(ba[r][c]);
                if (F.lane == 0) { *(f32x4*)(BA + (size_t)(m0 + r) * 8) = (f32x4){ba[r][0], ba[r][1], ba[r][2], ba[r][3]}; *(f32x4*)(BA + (size_t)(m0 + r) * 8 + 4) = (f32x4){ba[r][4], ba[r][5], ba[r][6], ba[r][7]}; } }
        }
        __syncthreads();
    }
}

constexpr int GP = 132;
constexpr int GQ_OFF = 0, GK_OFF = 64 * GP * 4, GV_OFF = 2 * 64 * GP * 4, GW_OFF = 3 * 64 * GP * 4, GAT_OFF = 4 * 64 * GP * 4, GAT_P = 68;
constexpr int GRAW_OFF = GW_OFF, GRAW_BYTES = 67 * 768;
constexpr int GGC_OFF = GRAW_OFF + GRAW_BYTES, GBETA_OFF = GGC_OFF + 256, GDM_OFF = GBETA_OFF + 256, GEND = GDM_OFF + 4096;
static_assert(GAT_OFF + 64 * GAT_P * 4 <= GGC_OFF && GEND <= TOP_OFF, "gdn prep LDS");
__device__ __forceinline__ int permpos(int cc) { return 8 * ((cc & 15) >> 2) + (cc & 3) + 4 * (cc >> 4); }
__device__ __forceinline__ void gdn_prep_unit(Frame& F, const Args& a, int unit, int next_unit) {
    const bf16* zg = (const bf16*)(F.ws + WS_ZG); const float* BA = (const float*)(F.ws + WS_BA);
    const float* convw = a.in[3]; const float* a_log = a.in[4]; const float* dt_bias = a.in[5];
    const int b = unit >> 8, h = (unit >> 6) & 3, n = unit & 63; const int row0 = b * SEQ + n * CHUNK;
    unsigned char* rec = F.ws + WS_PREP + (size_t)unit * PREP_REC;
    LAS float* Qs = (LAS float*)(F.lds + GQ_OFF); LAS float* Ks = (LAS float*)(F.lds + GK_OFF); LAS float* Vs = (LAS float*)(F.lds + GV_OFF); LAS float* Ws = (LAS float*)(F.lds + GW_OFF);
    LAS float* AT = (LAS float*)(F.lds + GAT_OFF); LAS float* gcs = (LAS float*)(F.lds + GGC_OFF); LAS float* betas = (LAS float*)(F.lds + GBETA_OFF);
    LAS unsigned char* raw = F.lds + GRAW_OFF;
    const int tid = F.tid, lane = F.lane, wave = F.wave;
    for (int e = tid; e < 67 * 48; e += NTHREADS) { const int rr = e / 48, ch = e % 48; const int tt = n * CHUNK + rr - 3;
        u32x4 v = {0u, 0u, 0u, 0u}; if (tt >= 0) v = *(const u32x4*)(zg + (size_t)(row0 + rr - 3) * 2048 + (ch >> 4) * 512 + h * 128 + (ch & 15) * 8);
        *(LAS u32x4*)(raw + rr * 768 + ch * 16) = v; }
    if (wave == 0) {
        const float bl = BA[(size_t)(row0 + lane) * 8 + h], al = BA[(size_t)(row0 + lane) * 8 + 4 + h];
        const float xx = al + dt_bias[h]; const float sp = xx > 20.f ? xx : log1pf(__expf(xx));
        float g = -__expf(a_log[h]) * sp;
#pragma unroll
        for (int o = 1; o < 64; o <<= 1) { const float u = __shfl_up(g, o); if (lane >= o) g += u; }
        gcs[lane] = g; betas[lane] = sigmoid_f(bl);
    }
    LDS_BARRIER();
    { const int t0 = 8 * wave; float qv[8][2], kv[8][2];
#pragma unroll
        for (int ten = 0; ten < 3; ++ten) { const int cp = ten * 64 + lane, ch = ten * 512 + h * 128 + 2 * lane;
            f32x2 cw[4];
#pragma unroll
            for (int k = 0; k < 4; ++k) cw[k] = *(const f32x2*)(convw + k * 1536 + ch);
            f32x2 xs[11];
#pragma unroll
            for (int k = 0; k < 11; ++k) { const unsigned w = *(const LAS unsigned*)(raw + (t0 + k) * 768 + cp * 4); xs[k] = (f32x2){bflo(w), bfhi(w)}; }
#pragma unroll
            for (int j = 0; j < 8; j += 2) { f32x2 c0 = xs[j] * cw[0], c1 = xs[j + 1] * cw[0];
#pragma unroll
                for (int k = 1; k < 4; ++k) { c0 += xs[j + k] * cw[k]; c1 += xs[j + 1 + k] * cw[k]; }
                const f32x4 sv = silu4((f32x4){c0[0], c0[1], c1[0], c1[1]});
#pragma unroll
                for (int jj = 0; jj < 2; ++jj) { const float a0 = sv[2 * jj], a1 = sv[2 * jj + 1];
                    if (ten == 0) { qv[j + jj][0] = a0; qv[j + jj][1] = a1; } else if (ten == 1) { kv[j + jj][0] = a0; kv[j + jj][1] = a1; }
                    else { const float bt = betas[t0 + j + jj]; *(LAS f32x2*)(Vs + (t0 + j + jj) * GP + 2 * lane) = (f32x2){a0 * bt, a1 * bt}; } } } }
#pragma unroll
        for (int j = 0; j < 8; ++j) { const float sq = wave_sum(qv[j][0] * qv[j][0] + qv[j][1] * qv[j][1]), sk = wave_sum(kv[j][0] * kv[j][0] + kv[j][1] * kv[j][1]);
            const float fq_ = rsqrtf(sq + EPS) * 0.08838834764831845f, fk_ = rsqrtf(sk + EPS);
            *(LAS f32x2*)(Qs + (t0 + j) * GP + 2 * lane) = (f32x2){qv[j][0] * fq_, qv[j][1] * fq_}; *(LAS f32x2*)(Ks + (t0 + j) * GP + 2 * lane) = (f32x2){kv[j][0] * fk_, kv[j][1] * fk_}; } }
    LDS_BARRIER();
    {
#pragma unroll
        for (int j = 0; j < 8; ++j) { const int t = 8 * wave + j; const float eg = betas[t] * __expf(gcs[t]); const f32x2 kk = *(LAS f32x2*)(Ks + t * GP + 2 * lane); *(LAS f32x2*)(Ws + t * GP + 2 * lane) = kk * eg; }
        const int which = wave >> 2, ti = (wave >> 1) & 1, tj = wave & 1, r32 = lane & 31, hh = lane >> 5;
        const LAS float* Xa = (which ? Ks + (32 * tj + r32) * GP : Ks + (32 * ti + r32) * GP) + 8 * hh; const LAS float* Xb = (which ? Qs + (32 * ti + r32) * GP : Ks + (32 * tj + r32) * GP) + 8 * hh;
        f32x16 acc = {};
#pragma unroll
        for (int ks = 0; ks < 8; ++ks) { const bf16x8 af = pack8(*(const LAS f32x4*)(Xa + 16 * ks), *(const LAS f32x4*)(Xa + 16 * ks + 4)), bf = pack8(*(const LAS f32x4*)(Xb + 16 * ks), *(const LAS f32x4*)(Xb + 16 * ks + 4));
            acc = __builtin_amdgcn_mfma_f32_32x32x16_bf16(af, bf, acc, 0, 0, 0); }
        if (which == 0) {
            const int j = 32 * tj + r32; const float gj = gcs[j];
#pragma unroll
            for (int q = 0; q < 4; ++q) { float vals[4];
#pragma unroll
                for (int rr = 0; rr < 4; ++rr) { const int i = 32 * ti + 8 * q + 4 * hh + rr; const float dec = __expf(fminf(gcs[i] - gj, 0.f)); vals[rr] = i > j ? betas[i] * acc[4 * q + rr] * dec : 0.f; }
                *(LAS f32x4*)(AT + j * GAT_P + 32 * ti + 8 * q + 4 * hh) = (f32x4){vals[0], vals[1], vals[2], vals[3]}; }
        } else {
            const int i = 32 * ti + r32; const float gi = gcs[i]; bf16* Af = (bf16*)(rec + PREP_AP) + (i >> 4) * 1024 + (i & 15) * 8 + tj * 512;
#pragma unroll
            for (int q = 0; q < 4; ++q) { float vals[4]; const int cc0 = 8 * q + 4 * hh;
#pragma unroll
                for (int rr = 0; rr < 4; ++rr) { const int j = 32 * tj + cc0 + rr; const float dec = __expf(fminf(gi - gcs[j], 0.f)); vals[rr] = i >= j ? acc[4 * q + rr] * dec : 0.f; }
                const int jpos = permpos(cc0); *(u32x2*)(Af + (jpos >> 3) * 128 + (jpos & 7)) = (u32x2){pk2(vals[0], vals[1]), pk2(vals[2], vals[3])}; }
        }
    }
    LDS_BARRIER();
    unsigned pfx = 0u;
    if (next_unit >= 0) { const int nb_ = next_unit >> 8, nh_ = (next_unit >> 6) & 3, nn_ = next_unit & 63; const int nrow0 = nb_ * SEQ + nn_ * CHUNK;
        if (tid < 402) { const int rr = tid / 6, sg = tid % 6; if (nn_ * CHUNK + rr - 3 >= 0) pfx = *(const unsigned*)(zg + (size_t)(nrow0 + rr - 3) * 2048 + (sg >> 1) * 512 + nh_ * 128 + (sg & 1) * 64); }
        else if (tid < 418) pfx = *(const unsigned*)(BA + (size_t)nrow0 * 8 + (tid - 402) * 32); }
    LAS float* Dm = (LAS float*)(F.lds + GDM_OFF);
    if (wave < 4) {
        if (lane < 16) { const int i0 = 16 * wave; float r[16];
#pragma unroll
            for (int ii = 0; ii < 16; ++ii) r[ii] = (ii == lane) ? 1.f : 0.f;
#pragma unroll
            for (int j = 0; j < 16; ++j) { const float xj = r[j]; const LAS f32x4* ap = (const LAS f32x4*)(AT + (i0 + j) * GAT_P + i0); float av[16];
#pragma unroll
                for (int q = 0; q < 4; ++q) { const f32x4 t4 = ap[q]; av[4 * q] = t4[0]; av[4 * q + 1] = t4[1]; av[4 * q + 2] = t4[2]; av[4 * q + 3] = t4[3]; }
#pragma unroll
                for (int ii = 0; ii < 16; ++ii) if (ii > j) r[ii] -= av[ii] * xj; }
#pragma unroll
            for (int ii = 0; ii < 16; ++ii) Dm[wave * 256 + ii * 16 + lane] = r[ii]; }
    } else {
        const int t2 = tid - 256; bf16* Qf = (bf16*)(rec + PREP_QP); bf16* Kf = (bf16*)(rec + PREP_KT); const float gl = gcs[63];
        for (int it = t2; it < 1024; it += 256) { const int blk = it >> 6, l = it & 63, mi = blk >> 2, ks = blk & 3, g = l >> 4, c = 16 * mi + (l & 15); const float eg = __expf(gcs[c]);
            const f32x4 lo = *(LAS f32x4*)(Qs + c * GP + 32 * ks + 4 * g) * eg, hi = *(LAS f32x4*)(Qs + c * GP + 32 * ks + 16 + 4 * g) * eg;
            __builtin_nontemporal_store(pack8(lo, hi), (bf16x8*)(Qf + it * 8)); }
        for (int it = t2; it < 1024; it += 256) { const int blk = it >> 6, l = it & 63, ti = blk >> 1, ks2 = blk & 1, g = l >> 4, dk = 16 * ti + (l & 15); float v[8];
#pragma unroll
            for (int j = 0; j < 8; ++j) { const int c = 32 * ks2 + (j < 4 ? 4 * g + j : 16 + 4 * g + (j - 4)); v[j] = Ks[c * GP + dk] * __expf(gl - gcs[c]); }
            __builtin_nontemporal_store(pack8((f32x4){v[0], v[1], v[2], v[3]}, (f32x4){v[4], v[5], v[6], v[7]}), (bf16x8*)(Kf + it * 8)); }
        if (t2 == 0) *(float*)(rec + PREP_CD) = __expf(gl);
    }
    LDS_BARRIER();
    {
        const int fr = lane & 15, g = lane >> 4;
#pragma unroll 1
        for (int bb = 0; bb < 4; ++bb) {
            const int i0 = 16 * bb;
            bf16x8 Af[2];
#pragma unroll
            for (int ks = 0; ks < 2; ++ks) { float av[8];
#pragma unroll
                for (int j = 0; j < 8; ++j) { const int kr = 32 * ks + 8 * g + j; av[j] = kr < i0 ? -AT[kr * GAT_P + i0 + fr] : 0.f; }
                Af[ks] = pack8((f32x4){av[0], av[1], av[2], av[3]}, (f32x4){av[4], av[5], av[6], av[7]}); }
            const f32x4 dv4 = *(const LAS f32x4*)(Dm + bb * 256 + fr * 16 + 4 * g);
            const bf16x8 Df = pack8(dv4, (f32x4){0.f, 0.f, 0.f, 0.f});
#pragma unroll
            for (int nt = 0; nt < 2; ++nt) { const int col = 32 * wave + 16 * nt + fr; LAS float* X = (col < 128 ? Vs + col : Ws + (col - 128));
                f32x4 acc;
#pragma unroll
                for (int rg = 0; rg < 4; ++rg) acc[rg] = X[(i0 + 4 * g + rg) * GP];
                if (bb > 0) {
#pragma unroll
                    for (int ks = 0; ks < 2; ++ks) { if (32 * ks < i0) { float xv[8];
#pragma unroll
                        for (int j = 0; j < 8; ++j) xv[j] = X[(32 * ks + 8 * g + j) * GP];
                        acc = __builtin_amdgcn_mfma_f32_16x16x32_bf16(Af[ks], pack8((f32x4){xv[0], xv[1], xv[2], xv[3]}, (f32x4){xv[4], xv[5], xv[6], xv[7]}), acc, 0, 0, 0); } } }
                const f32x4 xb = __builtin_amdgcn_mfma_f32_16x16x32_bf16(Df, pack8(acc, (f32x4){0.f, 0.f, 0.f, 0.f}), (f32x4){0.f, 0.f, 0.f, 0.f}, 0, 0, 0);
#pragma unroll
                for (int rg = 0; rg < 4; ++rg) X[(i0 + 4 * g + rg) * GP] = xb[rg]; }
        }
    }
    LDS_BARRIER();
    { float* Up = (float*)(rec + PREP_UP); bf16* Wf = (bf16*)(rec + PREP_WP);
        for (int it = tid; it < 2048; it += NTHREADS) { const int dv = it & 127, g = (it >> 7) & 3, mi = it >> 9; const int c0 = 16 * mi + 4 * g;
            __builtin_nontemporal_store((f32x4){Vs[c0 * GP + dv], Vs[(c0 + 1) * GP + dv], Vs[(c0 + 2) * GP + dv], Vs[(c0 + 3) * GP + dv]}, (f32x4*)(Up + (size_t)it * 4)); }
        for (int it = tid; it < 1024; it += NTHREADS) { const int blk = it >> 6, l = it & 63, mi = blk >> 2, ks = blk & 3, g = l >> 4, c = 16 * mi + (l & 15);
            __builtin_nontemporal_store(pack8(*(LAS f32x4*)(Ws + c * GP + 32 * ks + 4 * g), *(LAS f32x4*)(Ws + c * GP + 32 * ks + 16 + 4 * g)), (bf16x8*)(Wf + it * 8)); }
    }
    asm volatile("" :: "v"(pfx));
    LDS_BARRIER();
}

constexpr int SC_BUFSZ = 57344, SC_OT = 2 * SC_BUFSZ, SC_OTSZ = 64 * 128 * 2, SC_END = SC_OT + 2 * SC_OTSZ;
static_assert(SC_END <= TOP_OFF, "scan LDS");
__device__ __forceinline__ void gdn_scan(Frame& F, const Args& a, int bh) {
    const int tid = F.tid, lane = F.lane, w = F.wave, fr = lane & 15, g = lane >> 4; const int b = bh >> 2, h = bh & 3;
    const unsigned char* rec0 = F.ws + WS_PREP + (size_t)bh * NCHUNK * PREP_REC;
    const float* gnw = a.in[6]; const bf16* zg = (const bf16*)(F.ws + WS_ZG); bf16* mix = (bf16*)(F.ws + WS_MIX);
    const size_t rowb = (size_t)b * SEQ; const unsigned lds0 = (unsigned)(uintptr_t)F.lds;
    if (w >= 4) {
        const int hw = w - 4, l16 = lane & 15, rq = lane >> 4;
#define SC_DMA(n_, buf_) do { const unsigned char* src_ = rec0 + (size_t)(n_) * PREP_REC + hw * 14336 + lane * 16; _Pragma("unroll") for (int r_ = 0; r_ < 14; ++r_) \
        glds16_asm_nt(src_ + r_ * 1024, (unsigned)__builtin_amdgcn_readfirstlane((int)(lds0 + (buf_) * SC_BUFSZ + hw * 14336 + r_ * 1024))); } while (0)
#define SC_NORM(n_, gv) do { const LAS unsigned char* ot = F.lds + SC_OT + ((n_) & 1) * SC_OTSZ; _Pragma("unroll") for (int q_ = 0; q_ < 4; ++q_) { const int t = 16 * hw + 4 * q_ + rq; \
            const u32x4 ov = *(const LAS u32x4*)(ot + t * 256 + l16 * 16); const f32x4 xa = {bflo(ov.x), bfhi(ov.x), bflo(ov.y), bfhi(ov.y)}, xb = {bflo(ov.z), bfhi(ov.z), bflo(ov.w), bfhi(ov.w)}; \
            float ss_ = (xa[0] * xa[0] + xa[1] * xa[1]) + (xa[2] * xa[2] + xa[3] * xa[3]) + (xb[0] * xb[0] + xb[1] * xb[1]) + (xb[2] * xb[2] + xb[3] * xb[3]); \
            ss_ = sum_row16(ss_); const float sc = rsqrtf(ss_ * (1.f / 128.f) + EPS); \
            const u32x4 gz = gv[q_]; const f32x4 ga = {bflo(gz.x), bfhi(gz.x), bflo(gz.y), bfhi(gz.y)}, gb = {bflo(gz.z), bfhi(gz.z), bflo(gz.w), bfhi(gz.w)}; \
            *(bf16x8*)(mix + (rowb + (n_) * CHUNK + t) * 1024 + h * 128 + 8 * l16) = pack8(xa * sc * ga, xb * sc * gb); } } while (0)
        u32x4 gc_[4], gn_[4];
        SC_DMA(0, 0);
#pragma unroll
        for (int q = 0; q < 4; ++q) gc_[q] = (u32x4){0u, 0u, 0u, 0u};
        VM_WAIT(); __syncthreads();
#pragma unroll 1
        for (int n = 0; n < NCHUNK; ++n) {
#pragma unroll
            for (int q = 0; q < 4; ++q) gn_[q] = *(const u32x4*)(zg + (rowb + n * CHUNK + 16 * hw + 4 * q + rq) * 2048 + 1536 + h * 128 + 8 * l16);
            if (n + 1 < NCHUNK) SC_DMA(n + 1, (n + 1) & 1);
            if (n > 0) SC_NORM(n - 1, gc_);
            VM_WAIT(); __syncthreads();
#pragma unroll
            for (int q = 0; q < 4; ++q) gc_[q] = gn_[q];
        }
        SC_NORM(NCHUNK - 1, gc_);
#undef SC_DMA
#undef SC_NORM
    } else {
        f32x4 S[2][8];
#pragma unroll
        for (int sl = 0; sl < 2; ++sl)
#pragma unroll
            for (int i = 0; i < 8; ++i) S[sl][i] = (f32x4){0.f, 0.f, 0.f, 0.f};
        f32x4 Un[2][4]; float cd = *(const float*)(rec0 + PREP_CD), cdn;
#pragma unroll
        for (int sl = 0; sl < 2; ++sl)
#pragma unroll
            for (int mi = 0; mi < 4; ++mi) Un[sl][mi] = __builtin_nontemporal_load((const f32x4*)((const float*)(rec0 + PREP_UP) + (size_t)((mi * 4 + g) * 128 + 32 * w + 16 * sl + fr) * 4));
        __syncthreads();
#pragma unroll 1
        for (int n = 0; n < NCHUNK; ++n) {
            const LAS unsigned char* B = F.lds + (n & 1) * SC_BUFSZ + lane * 16;
            f32x4 vn[2][4], o[2][4];
            { bf16x8 Sb[2][4];
#pragma unroll
                for (int sl = 0; sl < 2; ++sl)
#pragma unroll
                    for (int ks = 0; ks < 4; ++ks) Sb[sl][ks] = pack8(S[sl][2 * ks], S[sl][2 * ks + 1]);
#pragma unroll
                for (int mi = 0; mi < 4; ++mi) { f32x4 t1[2], oo[2];
#pragma unroll
                    for (int sl = 0; sl < 2; ++sl) { t1[sl] = (f32x4){0.f, 0.f, 0.f, 0.f}; oo[sl] = (f32x4){0.f, 0.f, 0.f, 0.f}; }
#pragma unroll
                    for (int ks = 0; ks < 4; ++ks) { const bf16x8 wf = *(const LAS bf16x8*)(B + PREP_WP + (mi * 4 + ks) * 1024), qf = *(const LAS bf16x8*)(B + PREP_QP + (mi * 4 + ks) * 1024);
#pragma unroll
                        for (int sl = 0; sl < 2; ++sl) { t1[sl] = __builtin_amdgcn_mfma_f32_16x16x32_bf16(wf, Sb[sl][ks], t1[sl], 0, 0, 0); oo[sl] = __builtin_amdgcn_mfma_f32_16x16x32_bf16(qf, Sb[sl][ks], oo[sl], 0, 0, 0); } }
#pragma unroll
                    for (int sl = 0; sl < 2; ++sl) { vn[sl][mi] = Un[sl][mi] - t1[sl]; o[sl][mi] = oo[sl]; } } }
            { const int nn = n + 1 < NCHUNK ? n + 1 : n; cdn = *(const float*)(rec0 + (size_t)nn * PREP_REC + PREP_CD);
#pragma unroll
                for (int sl = 0; sl < 2; ++sl)
#pragma unroll
                    for (int mi = 0; mi < 4; ++mi) Un[sl][mi] = __builtin_nontemporal_load((const f32x4*)((const float*)(rec0 + (size_t)nn * PREP_REC + PREP_UP) + (size_t)((mi * 4 + g) * 128 + 32 * w + 16 * sl + fr) * 4)); }
            bf16x8 Vb[2][2];
#pragma unroll
            for (int sl = 0; sl < 2; ++sl)
#pragma unroll
                for (int ks = 0; ks < 2; ++ks) Vb[sl][ks] = pack8(vn[sl][2 * ks], vn[sl][2 * ks + 1]);
#pragma unroll
            for (int mi = 0; mi < 4; ++mi) {
#pragma unroll
                for (int ks = 0; ks < 2; ++ks) { const bf16x8 af = *(const LAS bf16x8*)(B + PREP_AP + (mi * 2 + ks) * 1024);
#pragma unroll
                    for (int sl = 0; sl < 2; ++sl) o[sl][mi] = __builtin_amdgcn_mfma_f32_16x16x32_bf16(af, Vb[sl][ks], o[sl][mi], 0, 0, 0); }
#pragma unroll
                for (int sl = 0; sl < 2; ++sl) { LAS bf16* otw = (LAS bf16*)(F.lds + SC_OT + (n & 1) * SC_OTSZ) + 32 * w + 16 * sl + fr;
                    const unsigned p01 = pk2(o[sl][mi][0], o[sl][mi][1]), p23 = pk2(o[sl][mi][2], o[sl][mi][3]);
                    otw[(16 * mi + 4 * g) * 128] = (bf16)(p01 & 0xffffu); otw[(16 * mi + 4 * g + 1) * 128] = (bf16)(p01 >> 16); otw[(16 * mi + 4 * g + 2) * 128] = (bf16)(p23 & 0xffffu); otw[(16 * mi + 4 * g + 3) * 128] = (bf16)(p23 >> 16); } }
#pragma unroll
            for (int ti = 0; ti < 8; ++ti) { f32x4 s0 = S[0][ti] * cd, s1 = S[1][ti] * cd;
#pragma unroll
                for (int ks = 0; ks < 2; ++ks) { const bf16x8 kf = *(const LAS bf16x8*)(B + PREP_KT + (ti * 2 + ks) * 1024);
                    s0 = __builtin_amdgcn_mfma_f32_16x16x32_bf16(kf, Vb[0][ks], s0, 0, 0, 0); s1 = __builtin_amdgcn_mfma_f32_16x16x32_bf16(kf, Vb[1][ks], s1, 0, 0, 0); }
                S[0][ti] = s0; S[1][ti] = s1; }
            __syncthreads();
            cd = cdn;
        }
    }
    __syncthreads();
}

constexpr int AT_K = 0, AT_V = 49152, AT_BIAS = 98304, AT_LW = 98304 + 1024, AT_END = AT_LW + 1024;
constexpr size_t WS_P4 = 616 * MiB, WS_P16 = 648 * MiB, WS_L4 = 744 * MiB, WS_L16 = 745 * MiB;
static_assert(WS_P16 + (size_t)T * 512 * 2 <= WS_MIX && WS_L16 + (size_t)T * 8 * 4 <= WS_XN, "attention partial buffers");
__device__ __forceinline__ void attn_unit(Frame& F, const Args& a, int u) {
    int kind, b, h, r, q0;
    if (u < 1024) { kind = 2; b = u >> 7; h = (u >> 4) & 7; r = u & 15; q0 = 0; }
    else if (u < 2048) { const int v = u - 1024; kind = 1; b = v >> 7; h = (v >> 4) & 7; r = (v >> 2) & 3; q0 = (v & 3) * 256; }
    else { const int v = u - 2048; kind = 0; b = v >> 7; h = (v >> 4) & 7; r = 0; q0 = (v & 15) * 256; }
    const int dsh = 2 * kind, lmax = (SEQ >> dsh) - 1;
    const bf16* qb = (const bf16*)(F.ws + WS_QB); const bf16* kb = (const bf16*)(F.ws + WS_KB); const bf16* vb = (const bf16*)(F.ws + WS_VB); bf16* mix = (bf16*)(F.ws + WS_MIX);
    const float* relb = a.in[9];
    LAS float* biasL = (LAS float*)(F.lds + AT_BIAS); LAS float* lw = (LAS float*)(F.lds + AT_LW) + F.wave * 32;
    const int tid = F.tid, lane = F.lane, w = F.wave, c = lane & 31, hh = lane >> 5;
    const size_t hrow = (size_t)(b * AH + h) * SEQ; const unsigned lds0 = (unsigned)(uintptr_t)F.lds;
    { const int ro = lane >> 3, p = lane & 7;
#pragma unroll
        for (int i = 0; i < 6; ++i) { const int lr = 48 * w + 8 * i + ro; int pos = q0 - 128 + lr; pos = pos < 0 ? 0 : (pos > lmax ? lmax : pos);
            const size_t eo = (hrow + (size_t)(pos << dsh) + r) * 64 + (size_t)((p ^ (lr & 7)) * 8);
            glds16_asm(kb + eo, (unsigned)__builtin_amdgcn_readfirstlane((int)(lds0 + AT_K + (48 * w + 8 * i) * 128)));
            glds16_asm(vb + eo, (unsigned)__builtin_amdgcn_readfirstlane((int)(lds0 + AT_V + (48 * w + 8 * i) * 128))); } }
    if (tid < 132) biasL[tid] = relb[(int)T5B[kind][tid] * AH + h] * LOG2E;
    const int qi = q0 + 32 * w + c;
    bf16x8 Qf[4];
    { const bf16* qp = qb + (hrow + (size_t)(qi << dsh) + r) * 64 + 8 * hh;
#pragma unroll
        for (int ks = 0; ks < 4; ++ks) Qf[ks] = *(const bf16x8*)(qp + 16 * ks); }
    VM_WAIT(); __syncthreads();
    f32x16 O0 = {}, O1 = {}; float lsum = 0.f;
    const int kt0 = (128 - q0 - 32 * w) > 0 ? ((128 - q0 - 32 * w) >> 5) : 0;
    const int li = lane & 15, gq = lane >> 4;
#pragma unroll 1
    for (int kt = kt0; kt < 5; ++kt) {
        const int lr0 = 32 * (w + kt);
        f32x16 sT = {};
        { const int lr = lr0 + c; const LAS unsigned char* kp = F.lds + AT_K + lr * 128;
#pragma unroll
            for (int ks = 0; ks < 4; ++ks) { const bf16x8 kf = *(const LAS bf16x8*)(kp + (((2 * ks + hh) ^ (lr & 7)) * 16)); sT = __builtin_amdgcn_mfma_f32_32x32x16_bf16(kf, Qf[ks], sT, 0, 0, 0); } }
        float p[16];
#pragma unroll
        for (int reg = 0; reg < 16; ++reg) { const int kr = (reg & 3) + 8 * (reg >> 2) + 4 * hh; const int s = 128 + c - 32 * kt - kr; const int kpos = q0 - 128 + lr0 + kr;
            const bool ok = (s >= 0) && (s <= 128) && (kpos >= 0); const int sc_ = s < 0 ? 0 : (s > 128 ? 128 : s);
            const float e = __builtin_amdgcn_exp2f(sT[reg] + biasL[sc_]); p[reg] = ok ? e : 0.f; lsum += p[reg]; }
        bf16x8 Pf[2];
#pragma unroll
        for (int s2 = 0; s2 < 2; ++s2) { u32x4 wv; wv.x = pk2(p[8 * s2], p[8 * s2 + 1]); wv.y = pk2(p[8 * s2 + 2], p[8 * s2 + 3]); wv.z = pk2(p[8 * s2 + 4], p[8 * s2 + 5]); wv.w = pk2(p[8 * s2 + 6], p[8 * s2 + 7]); Pf[s2] = __builtin_bit_cast(bf16x8, wv); }
#pragma unroll
        for (int s2 = 0; s2 < 2; ++s2)
#pragma unroll
            for (int ntl = 0; ntl < 2; ++ntl) {
                const int rowl = lr0 + 16 * s2 + 4 * hh + (li >> 2), rowh = rowl + 8; const int ch = 4 * ntl + 2 * (gq & 1) + ((li & 3) >> 1), sub = (li & 1) * 8;
                const s16x4 lo = __builtin_bit_cast(s16x4, __builtin_amdgcn_ds_read_tr16_b64_v4i16((LAS s16x4*)(F.lds + AT_V + rowl * 128 + ((ch ^ (rowl & 7)) * 16) + sub)));
                const s16x4 hi = __builtin_bit_cast(s16x4, __builtin_amdgcn_ds_read_tr16_b64_v4i16((LAS s16x4*)(F.lds + AT_V + rowh * 128 + ((ch ^ (rowh & 7)) * 16) + sub)));
                const bf16x8 vf = (bf16x8){lo[0], lo[1], lo[2], lo[3], hi[0], hi[1], hi[2], hi[3]};
                if (ntl == 0) O0 = __builtin_amdgcn_mfma_f32_32x32x16_bf16(Pf[s2], vf, O0, 0, 0, 0); else O1 = __builtin_amdgcn_mfma_f32_32x32x16_bf16(Pf[s2], vf, O1, 0, 0, 0);
            }
    }
    lsum = sum_xor32(lsum);
    if (hh == 0) lw[c] = lsum;
    LDS_BARRIER();
    { LAS float* ost = (LAS float*)(F.lds + w * 8192);
#pragma unroll
        for (int reg = 0; reg < 16; ++reg) { const int qrow = (reg & 3) + 8 * (reg >> 2) + 4 * hh; ost[qrow * 64 + c] = O0[reg]; ost[qrow * 64 + 32 + c] = O1[reg]; }
        LDS_WAIT();
        const int row = lane >> 1, half = lane & 1; const float l1 = lw[row]; const LAS f32x4* op = (const LAS f32x4*)(ost + row * 64 + 32 * half);
        const size_t tok = (size_t)b * SEQ + (size_t)((q0 + 32 * w + row) << dsh) + r;
        if (kind != 0) {
            bf16* pp = (bf16*)(F.ws + (kind == 1 ? WS_P4 : WS_P16)) + (tok * 8 + h) * 64 + 32 * half; const float inv = 1.f / l1;
#pragma unroll
            for (int q = 0; q < 4; ++q) *(bf16x8*)(pp + 8 * q) = pack8(op[2 * q] * inv, op[2 * q + 1] * inv);
            if (half == 0) ((float*)(F.ws + (kind == 1 ? WS_L4 : WS_L16)))[tok * 8 + h] = l1;
        } else {
            const bf16* p4 = (const bf16*)(F.ws + WS_P4) + (tok * 8 + h) * 64 + 32 * half; const bf16* p16 = (const bf16*)(F.ws + WS_P16) + (tok * 8 + h) * 64 + 32 * half;
            const float l4 = ((const float*)(F.ws + WS_L4))[tok * 8 + h], l16 = ((const float*)(F.ws + WS_L16))[tok * 8 + h]; const float inv = 1.f / (l1 + l4 + l16);
            bf16* dst = mix + tok * 1024 + 512 + h * 64 + 32 * half;
#pragma unroll
            for (int q = 0; q < 4; ++q) { const u32x4 a4 = *(const u32x4*)(p4 + 8 * q), a16 = *(const u32x4*)(p16 + 8 * q);
                const f32x4 x0 = (op[2 * q] + (f32x4){bflo(a4.x), bfhi(a4.x), bflo(a4.y), bfhi(a4.y)} * l4 + (f32x4){bflo(a16.x), bfhi(a16.x), bflo(a16.y), bfhi(a16.y)} * l16) * inv;
                const f32x4 x1 = (op[2 * q + 1] + (f32x4){bflo(a4.z), bfhi(a4.z), bflo(a4.w), bfhi(a4.w)} * l4 + (f32x4){bflo(a16.z), bfhi(a16.z), bflo(a16.w), bfhi(a16.w)} * l16) * inv;
                *(bf16x8*)(dst + 8 * q) = pack8(x0, x1); }
        }
    }
    LDS_BARRIER();
}

constexpr int RT_LCNT = 0, RT_BASE = 256, RT_RANK = 512;
__device__ __forceinline__ void route_phase(Frame& F, const Args& a) {
    const bf16* hsrc = (const bf16*)(F.ws + WS_HBF); const bf16* wrT = (const bf16*)(F.ws + WS_WRT); const float* b_r = a.in[13];
    int* te = (int*)(F.ws + WS_TE); int* tslot = (int*)(F.ws + WS_TSLOT); float* tg = (float*)(F.ws + WS_TG); int* list = (int*)(F.ws + WS_LIST); float* lrs = (float*)(F.ws + WS_LRS);
    LAS int* lcnt = (LAS int*)(F.lds + RT_LCNT); LAS int* lbase = (LAS int*)(F.lds + RT_BASE); LAS int* lrank = (LAS int*)(F.lds + RT_RANK);
    const int lane = F.lane, c = lane & 31, hh = lane >> 5;
    for (int blk = F.vcu; blk < T / 128; blk += F.G) {
        if (F.tid < 32) lcnt[F.tid] = 0;
        __syncthreads();
        int e4[4] = {0, 0, 0, 0}, rk[4] = {0, 0, 0, 0}; float g4[4] = {0.f, 0.f, 0.f, 0.f}; float rs = 0.f; const int tok = blk * 128 + (F.wave & 3) * 32 + c;
        f32x16 acc = {}; float ss = 0.f;
        { const int kh = F.wave >> 2; const bf16* hp = hsrc + (size_t)tok * D + 8 * hh + 512 * kh; const bf16* wph = (const bf16*)wrT + (size_t)c * D + 8 * hh + 512 * kh; const bf16* wpl = wph + NE * D;
#pragma unroll 8
            for (int q = 0; q < 32; ++q) { const u32x4 hr = *(const u32x4*)(hp + 16 * q); const bf16x8 wh = *(const bf16x8*)(wph + 16 * q), wl = *(const bf16x8*)(wpl + 16 * q);
                const f32x4 ha = {bflo(hr.x), bfhi(hr.x), bflo(hr.y), bfhi(hr.y)}, hb2 = {bflo(hr.z), bfhi(hr.z), bflo(hr.w), bfhi(hr.w)};
                ss += (ha[0] * ha[0] + ha[1] * ha[1]) + (ha[2] * ha[2] + ha[3] * ha[3]) + (hb2[0] * hb2[0] + hb2[1] * hb2[1]) + (hb2[2] * hb2[2] + hb2[3] * hb2[3]);
                const bf16x8 hv = __builtin_bit_cast(bf16x8, hr);
                acc = __builtin_amdgcn_mfma_f32_32x32x16_bf16(wh, hv, acc, 0, 0, 0); acc = __builtin_amdgcn_mfma_f32_32x32x16_bf16(wl, hv, acc, 0, 0, 0); }
            LAS float* px = (LAS float*)(F.lds + 4096) + ((F.wave & 3) * 64 + lane) * 17;
            if (F.wave >= 4) {
#pragma unroll
                for (int r = 0; r < 16; ++r) px[r] = acc[r];
                px[16] = ss; }
            __syncthreads();
            if (F.wave < 4) {
#pragma unroll
                for (int r = 0; r < 16; ++r) acc[r] += px[r];
                ss += px[16]; } }
        if (F.wave < 4) {
            ss = sum_xor32(ss); rs = rsqrtf(ss * (1.f / D) + EPS);
            float tv[4] = {-3.0e38f, -3.0e38f, -3.0e38f, -3.0e38f}; int tix[4] = {0, 1, 2, 3};
            f32x4 brv[4];
#pragma unroll
            for (int q = 0; q < 4; ++q) brv[q] = *(const f32x4*)(b_r + 8 * q + 4 * hh);
#pragma unroll
            for (int reg = 0; reg < 16; ++reg) { const int e = (reg & 3) + 8 * (reg >> 2) + 4 * hh; float v = acc[reg] * rs + brv[reg >> 2][reg & 3]; int ix = e;
#pragma unroll
                for (int s = 0; s < 4; ++s) { const bool gt = (v > tv[s]) || (v == tv[s] && ix < tix[s]); const float ov = tv[s]; const int oi = tix[s]; tv[s] = gt ? v : ov; tix[s] = gt ? ix : oi; v = gt ? ov : v; ix = gt ? oi : ix; } }
            float pv[4]; int pi[4];
#pragma unroll
            for (int s = 0; s < 4; ++s) { pv[s] = __shfl_xor(tv[s], 32); pi[s] = __shfl_xor(tix[s], 32); }
#pragma unroll
            for (int t2 = 0; t2 < 4; ++t2) { float v = pv[t2]; int ix = pi[t2];
#pragma unroll
                for (int s = 0; s < 4; ++s) { const bool gt = (v > tv[s]) || (v == tv[s] && ix < tix[s]); const float ov = tv[s]; const int oi = tix[s]; tv[s] = gt ? v : ov; tix[s] = gt ? ix : oi; v = gt ? ov : v; ix = gt ? oi : ix; } }
            const float e0 = 1.f, e1 = __expf(tv[1] - tv[0]), e2 = __expf(tv[2] - tv[0]), e3 = __expf(tv[3] - tv[0]); const float inv = 1.f / (e0 + e1 + e2 + e3);
            g4[0] = e0 * inv; g4[1] = e1 * inv; g4[2] = e2 * inv; g4[3] = e3 * inv;
#pragma unroll
            for (int s = 0; s < 4; ++s) e4[s] = tix[s];
            if (hh == 0) {
#pragma unroll
                for (int s = 0; s < 4; ++s) rk[s] = atomicAdd((int*)(lcnt + e4[s]), 1);
            }
        }
        __syncthreads();
        if (F.tid < 32) lbase[F.tid] = (int)__hip_atomic_fetch_add(F.ctl + CW_GCNT + 64 * F.tid, (unsigned)lcnt[F.tid], RLX_AGENT);
        __syncthreads();
        if (F.wave < 4 && hh == 0) {
#pragma unroll
            for (int s = 0; s < 4; ++s) { const int slot = lbase[e4[s]] + rk[s]; te[tok * 4 + s] = e4[s]; tslot[tok * 4 + s] = slot; tg[tok * 4 + s] = g4[s];
                list[(size_t)e4[s] * LCAP + slot] = tok; lrs[(size_t)e4[s] * LCAP + slot] = rs; }
        }
        __syncthreads();
    }
}
__device__ __forceinline__ int moe_tables(Frame& F) {
    LAS int* tstart = (LAS int*)(F.lds + MOE_TSTART); LAS int* lcnt = (LAS int*)(F.lds + MOE_LCNT); LAS int* texp = (LAS int*)(F.lds + MOE_TEXP);
    if (F.tid < 64) {
        const int lane = F.lane; const int cnt = lane < NE ? (int)__hip_atomic_load(F.ctl + CW_GCNT + 64 * (lane & 31), RLX_AGENT) : 0; const int nt = (cnt + 255) >> 8;
        int inc = nt;
#pragma unroll
        for (int o = 1; o < 32; o <<= 1) { const int up = __shfl_up(inc, o); if (lane >= o) inc += up; }
        if (lane < NE) { const int start = inc - nt; lcnt[lane] = cnt; tstart[lane] = start; for (int i = 0; i < nt; ++i) texp[start + i] = lane; if (lane == NE - 1) tstart[NE] = inc; }
    }
    __syncthreads();
    return tstart[NE];
}
__device__ __forceinline__ void combine_phase(Frame& F, const Args& a, float* dst) {
    LAS int* tstart = (LAS int*)(F.lds + MOE_TSTART);
    const int* te = (const int*)(F.ws + WS_TE); const int* tslot = (const int*)(F.ws + WS_TSLOT); const float* tg = (const float*)(F.ws + WS_TG); const unsigned char* Y = F.ws + WS_Y;
    const bf16* hbf = (const bf16*)(F.ws + WS_HBF); const int gw = F.vcu * NWAVES + F.wave, NGW = F.G * NWAVES, lane = F.lane;
    for (int t0 = gw * 16; t0 < T; t0 += NGW * 16) {
        int pos[4]; float gt[4];
        { const int tl = t0 + (lane & 15);
#pragma unroll
            for (int s = 0; s < 4; ++s) { const int e = te[tl * 4 + s]; pos[s] = tstart[e] * 256 + tslot[tl * 4 + s]; gt[s] = tg[tl * 4 + s]; } }
#pragma unroll 1
        for (int i = 0; i < 16; i += 2) {
            u32x2 hv[2][4]; unsigned yv[2][4][4];
#pragma unroll
            for (int q = 0; q < 2; ++q) { const bf16* hp = hbf + (size_t)(t0 + i + q) * D + 4 * lane;
#pragma unroll
                for (int j = 0; j < 4; ++j) hv[q][j] = __builtin_nontemporal_load((const u32x2*)(hp + 256 * j));
#pragma unroll
                for (int s = 0; s < 4; ++s) { const size_t p = (size_t)__builtin_amdgcn_readlane(pos[s], i + q);
#pragma unroll
                    for (int j = 0; j < 4; ++j) yv[q][s][j] = __builtin_nontemporal_load((const unsigned*)(Y + p * D + 256 * j + 4 * lane)); } }
#pragma unroll
            for (int q = 0; q < 2; ++q) { float* op = dst + (size_t)(t0 + i + q) * D + 4 * lane; float g[4];
#pragma unroll
                for (int s = 0; s < 4; ++s) g[s] = __builtin_bit_cast(float, __builtin_amdgcn_readlane(__builtin_bit_cast(int, gt[s]), i + q));
#pragma unroll
                for (int j = 0; j < 4; ++j) { f32x4 o = {bflo(hv[q][j].x), bfhi(hv[q][j].x), bflo(hv[q][j].y), bfhi(hv[q][j].y)};
#pragma unroll
                    for (int s = 0; s < 4; ++s) { const int ww = (int)yv[q][s][j]; const f32x2 lo = __builtin_amdgcn_cvt_pk_f32_fp8(ww, false), hi = __builtin_amdgcn_cvt_pk_f32_fp8(ww, true);
                        o += (f32x4){lo[0], lo[1], hi[0], hi[1]} * g[s]; }
                    __builtin_nontemporal_store(o, (f32x4*)(op + 256 * j)); } }
        }
    }
}

constexpr int NPHASE = 9;
__global__ void __launch_bounds__(NTHREADS, 2) hymba_fwd(Args args) {
    extern __shared__ __attribute__((aligned(16))) unsigned char lds_raw[];
    Frame F; F.lds = (LAS unsigned char*)lds_raw; F.ws = args.ws; F.ctl = (unsigned*)(args.ws + WS_CTL);
    F.tid = threadIdx.x; F.lane = F.tid & 63; F.wave = __builtin_amdgcn_readfirstlane(F.tid >> 6);
    F.G = gridDim.x; { const int bx = blockIdx.x; F.vcu = (F.G % 8 == 0) ? (bx % 8) * (F.G / 8) + bx / 8 : bx; }
    volatile LAS unsigned* MISC = (volatile LAS unsigned*)(F.lds + MISC_OFF);
    if (F.tid < 32) MISC[F.tid] = 0u;
    __syncthreads();
    XcdBarrier bar; bar.bar = F.ctl + CW_BAR; bar.x = 0; bar.st = nullptr;
    if (MK_N_LAUNCHES == 1) bar = xcd_barrier_post(F.ctl + CW_BAR, MISC + 8);
    const int lo = args.ph_lo, hi = args.ph_hi;
#define IN(k) (lo <= (k) && (k) < hi)
#define SEAM(k) do { if (IN(k) && IN((k) + 1)) xcd_barrier(bar); } while (0)

    if (IN(0)) { for (int rep = 0; rep < (DUP == 4 ? 2 : 1); ++rep) phase0(F, args); SEAM(0); }
    if (IN(1)) {
        pg8::Gemm g{(const bf16*)(F.ws + WS_XN), (const bf16*)(F.ws + WS_WIN), D}; pg8::StaticOrder S{T / 256, NIN / 256, F.G, (int)blockIdx.x};
        pg8::EpiInProj E{(bf16*)(F.ws + WS_ZG), (bf16*)(F.ws + WS_QB), (bf16*)(F.ws + WS_KB), (bf16*)(F.ws + WS_VB), args.in[7], args.in[8], F.lds + RING_BYTES, args.in[6]};
        pg8::gemm_phase<pg8::EpiInProj, pg8::StaticOrder, false, true, false, (DUP == 18 ? 2 : 1)>(F.lds, g, S, E);
#if DUP == 5
        __syncthreads(); pg8::gemm_phase<pg8::EpiInProj, pg8::StaticOrder, false, true>(F.lds, g, S, E);
#endif
        SEAM(1);
    }
    if (IN(2)) {
        for (int rep = 0; rep < (DUP == 1 ? 2 : 1); ++rep)
        for (int u = F.vcu; u < NBATCH * GH * NCHUNK; u += F.G) gdn_prep_unit(F, args, u, u + F.G < NBATCH * GH * NCHUNK ? u + F.G : -1);
        SEAM(2);
    }
    if (IN(3)) {
        const int nscan = NBATCH * GH;
        for (int rep3 = 0; rep3 < (DUP == 13 ? 2 : 1); ++rep3) {
        for (int bh = blockIdx.x; bh < nscan; bh += F.G) { gdn_scan(F, args, bh);
#if DUP == 3
            gdn_scan(F, args, bh);
#endif
        }
        if (rep3 == 0) { if (F.G > nscan) { if ((int)blockIdx.x >= nscan) { p0_experts(F, args, ((int)blockIdx.x - nscan) * NWAVES + F.wave, (F.G - nscan) * NWAVES);
#if DUP == 15
            __syncthreads(); p0_experts(F, args, ((int)blockIdx.x - nscan) * NWAVES + F.wave, (F.G - nscan) * NWAVES);
#endif
            } } else p0_experts(F, args, (int)blockIdx.x * NWAVES + F.wave, F.G * NWAVES); __syncthreads(); }
        for (int pass = 0; pass < 2; ++pass) {
            for (int rep = 0; rep < (DUP == 2 ? 2 : 1); ++rep)
            for (;;) {
                if (F.tid == 0) MISC[16] = __hip_atomic_fetch_add(F.ctl + CW_ATTQ + 64 * (pass + 2 * rep + 4 * rep3), 1u, RLX_AGENT);
                __syncthreads();
                const int u = (int)MISC[16] + (pass ? 2048 : 0);
                __syncthreads();
                if (u >= (pass ? 3072 : 2048)) break;
                attn_unit(F, args, u);
            }
            if (pass == 0 || DUP == 13) xcd_barrier(bar);
        } }
        SEAM(3);
    }
    if (IN(4)) {
        pg8::Gemm g{(const bf16*)(F.ws + WS_MIX), (const bf16*)(F.ws + WS_WOUT), D}; pg8::StaticOrder S{T / 256, D / 256, F.G, (int)blockIdx.x};
        pg8::EpiOutProj E{args.in[0], (bf16*)(F.ws + WS_HBF), F.ws + WS_HB, F.lds + RING_BYTES};
        pg8::gemm_phase<pg8::EpiOutProj, pg8::StaticOrder, false, true>(F.lds, g, S, E);
#if DUP == 6
        __syncthreads(); pg8::gemm_phase<pg8::EpiOutProj, pg8::StaticOrder, false, true>(F.lds, g, S, E);
#endif
        SEAM(4);
    }
#if !SKIP_MOE
    if (IN(5)) {
        if (DUP == 10) { route_phase(F, args); xcd_barrier(bar); if (blockIdx.x == 0 && F.tid < 32) __hip_atomic_store(F.ctl + CW_GCNT + 64 * F.tid, 0u, RLX_AGENT); xcd_barrier(bar); }
        route_phase(F, args); SEAM(5); }
    if (IN(6)) {
        const int nM = moe_tables(F);
        pg8::Gemm g{(const bf16*)(F.ws + WS_HB), (const bf16*)(F.ws + WS_WGU), D};
        pg8::MoeOrder S{nM, 8, F.G, (int)blockIdx.x, (const LAS int*)(F.lds + MOE_TSTART), (const LAS int*)(F.lds + MOE_LCNT), (const LAS int*)(F.lds + MOE_TEXP), (const int*)(F.ws + WS_LIST)};
        pg8::EpiGateUp E{F.ws + WS_ACT, args.in[15], (const float*)(F.ws + WS_LRS), (const LAS int*)(F.lds + MOE_LCNT), F.lds + RING_BYTES};
        pg8::gemm_phase<pg8::EpiGateUp, pg8::MoeOrder, true, true, true, (DUP == 17 ? 2 : 1)>(F.lds, g, S, E);
#if DUP == 7
        __syncthreads(); pg8::gemm_phase<pg8::EpiGateUp, pg8::MoeOrder, true, true, true>(F.lds, g, S, E);
#endif
        SEAM(6);
    }
    if (IN(7)) {
        const int nM = moe_tables(F);
        pg8::Gemm g{(const bf16*)(F.ws + WS_ACT), (const bf16*)(F.ws + WS_WDN), FF};
        pg8::MoeOrder S{nM, 4, F.G, (int)blockIdx.x, (const LAS int*)(F.lds + MOE_TSTART), (const LAS int*)(F.lds + MOE_LCNT), (const LAS int*)(F.lds + MOE_TEXP), (const int*)(F.ws + WS_LIST)};
        pg8::EpiDown E{F.ws + WS_Y, args.in[17], F.lds + RING_BYTES};
        pg8::gemm_phase<pg8::EpiDown, pg8::MoeOrder, false, true, true>(F.lds, g, S, E);
#if DUP == 8
        __syncthreads(); pg8::gemm_phase<pg8::EpiDown, pg8::MoeOrder, false, true, true>(F.lds, g, S, E);
#endif
        SEAM(7);
    }
#if DUP == 16
    if (IN(8)) { for (int i_ = 0; i_ < 8; ++i_) xcd_barrier(bar); }
#endif
    if (IN(8)) { (void)moe_tables(F); if (DUP == 11) combine_phase(F, args, (float*)(F.ws + WS_ZG)); combine_phase(F, args, args.out); }
#endif
#undef IN
#undef SEAM
}

extern "C" void kernel_launch(void* const* d_in, const int* in_sizes, int n_in, void* d_out, int out_size, void* d_ws, size_t ws_size, hipStream_t stream) {
    static int grid = 0;
    if (grid == 0) {
        if (n_in != 18 || in_sizes[0] != T * D || out_size != T * D || ws_size < WS_END) { fprintf(stderr, "kernel_launch: unexpected shapes (n_in %d, in0 %d, out %d, ws %zu)\n", n_in, n_in > 0 ? in_sizes[0] : -1, out_size, ws_size); grid = -1; return; }
        int dev = 0, cus = 0, per_cu = 0;
        if (hipGetDevice(&dev) != hipSuccess || hipDeviceGetAttribute(&cus, hipDeviceAttributeMultiprocessorCount, dev) != hipSuccess) { grid = -1; return; }
        if (hipFuncSetAttribute((const void*)hymba_fwd, hipFuncAttributeMaxDynamicSharedMemorySize, LDS_BYTES) != hipSuccess) { fprintf(stderr, "kernel_launch: hipFuncSetAttribute failed\n"); grid = -1; return; }
        if (hipOccupancyMaxActiveBlocksPerMultiprocessor(&per_cu, (const void*)hymba_fwd, NTHREADS, LDS_BYTES) != hipSuccess || per_cu < 1) { fprintf(stderr, "kernel_launch: occupancy query says %d\n", per_cu); per_cu = 1; }
        (void)hipGetLastError();
        grid = cus;
    }
    if (grid < 0) return;
    (void)hipMemsetAsync((char*)d_ws + WS_CTL, 0, CTL_ZERO_BYTES, stream);
    Args a{};
    for (int i = 0; i < 18; ++i) a.in[i] = (const float*)d_in[i];
    a.out = (float*)d_out; a.ws = (unsigned char*)d_ws;
    if (MK_N_LAUNCHES == 1) {
        a.ph_lo = 0; a.ph_hi = NPHASE; a.li = 0;
        void* kargs[] = {&a};
        hipError_t e = hipLaunchCooperativeKernel((const void*)hymba_fwd, dim3(grid), dim3(NTHREADS), kargs, LDS_BYTES, stream);
        if (e != hipSuccess) fprintf(stderr, "kernel_launch: cooperative launch failed: %s (grid %d)\n", hipGetErrorString(e), grid);
    } else {
        for (int p = 0; p < NPHASE; ++p) { a.ph_lo = p; a.ph_hi = p + 1; a.li = p; hipLaunchKernelGGL(hymba_fwd, dim3(grid), dim3(NTHREADS), LDS_BYTES, stream, a); }
    }
}
```

```cpp
#include <hip/hip_runtime.h>
#include <cstdio>
#include <cstdint>

#ifndef MK_N_LAUNCHES
#define MK_N_LAUNCHES 1
#endif
#ifndef SKIP_ATTN
#define SKIP_ATTN 0
#endif
#ifndef DUP
#define DUP 0
#endif
#ifndef ATT_JOBS
#define ATT_JOBS 32
#endif
#ifndef SKIP_MOE
#define SKIP_MOE 0
#endif

#define LAS __attribute__((address_space(3)))
#define GAS __attribute__((address_space(1)))
typedef unsigned short bf16;
typedef short bf16x8 __attribute__((ext_vector_type(8)));
typedef short s16x4 __attribute__((ext_vector_type(4)));
typedef float f32x2 __attribute__((ext_vector_type(2)));
typedef float f32x4 __attribute__((ext_vector_type(4)));
typedef float f32x16 __attribute__((ext_vector_type(16)));
typedef unsigned u32x2 __attribute__((ext_vector_type(2)));
typedef unsigned u32x4 __attribute__((ext_vector_type(4)));
typedef __bf16 bf16x2_t __attribute__((ext_vector_type(2)));
typedef int v4i_t __attribute__((ext_vector_type(4)));
typedef int v8i_t __attribute__((ext_vector_type(8)));

constexpr int NBATCH = 8, SEQ = 4096, D = 1024, T = NBATCH * SEQ;
constexpr int IN_DIM = 3592, NIN = 3584;
constexpr int GH = 4, DK = 128, CHUNK = 64, NCHUNK = SEQ / CHUNK;
constexpr int AH = 8, DH = 64;
constexpr int NE = 32, FF = 1024, LCAP = 32768;
constexpr float EPS = 1e-6f, LOG2E = 1.4426950408889634f;
constexpr int NWAVES = 8, NTHREADS = 512;

constexpr size_t MiB = 1u << 20;
constexpr size_t WS_CTL = 0, CTL_ZERO_BYTES = 64 * 1024;
constexpr size_t WS_WIN = 1 * MiB, WS_WOUT = 8 * MiB, WS_WGU = 10 * MiB, WS_WDN = 138 * MiB;
constexpr size_t WS_TE = 202 * MiB, WS_TSLOT = WS_TE + 512 * 1024, WS_TG = WS_TSLOT + 512 * 1024;
constexpr size_t WS_LIST = 204 * MiB, WS_LRS = 208 * MiB;
constexpr size_t WS_BA = 212 * MiB, WS_WRT = 213 * MiB;
constexpr size_t WS_ZG = 214 * MiB, WS_QB = 342 * MiB, WS_KB = 374 * MiB, WS_VB = 406 * MiB;
constexpr size_t WS_PREP = 438 * MiB;
constexpr int PREP_WP = 0, PREP_QP = 16384, PREP_AP = 32768, PREP_KT = 40960, PREP_UP = 57344, PREP_CD = 90112, PREP_REC = 90368;
constexpr size_t WS_OG = 616 * MiB, WS_MIX = 680 * MiB;
constexpr size_t WS_XN = 760 * MiB, WS_HB = 760 * MiB;
constexpr size_t WS_ACT = 214 * MiB, WS_Y = 352 * MiB, WS_HBF = 488 * MiB, WS_END = 824 * MiB;
static_assert(WS_VB - WS_KB == WS_KB - WS_QB, "q/k/v stride");
static_assert(WS_PREP + (size_t)NBATCH * GH * NCHUNK * PREP_REC <= WS_OG, "prep region");
static_assert(WS_ACT + (size_t)(T * 4 + NE * 256) * FF <= WS_Y && WS_Y + (size_t)(T * 4 + NE * 256) * D <= WS_HBF && WS_HBF + (size_t)T * D * 2 <= 616 * MiB, "act/y/h regions");
constexpr int CW_TMO = 0, CW_CODE = 1, CW_ATTQ = 512, CW_GCNT = 1024  , CW_DONE0 = 4096  , CW_BAR = 8192;
static_assert((CW_BAR + 3456) * 4 <= (int)CTL_ZERO_BYTES && CW_GCNT + 64 * 32 <= CW_BAR, "control words inside the zeroed region");

constexpr int LDS_BYTES = 160 * 1024;
constexpr int RING_BYTES = 131072;
constexpr int TOP_OFF = LDS_BYTES - 4096;
constexpr int MISC_OFF = TOP_OFF;
constexpr int MOE_TAB_OFF = TOP_OFF + 256;
constexpr int MOE_TSTART = MOE_TAB_OFF, MOE_LCNT = MOE_TAB_OFF + 256, MOE_TEXP = MOE_TAB_OFF + 512;

#define RLX_AGENT __ATOMIC_RELAXED, __HIP_MEMORY_SCOPE_AGENT
#define LDS_WAIT() asm volatile("s_waitcnt lgkmcnt(0)" ::: "memory")
#define VM_WAIT() asm volatile("s_waitcnt vmcnt(0)" ::: "memory")
#define WAVE_LDS_ORDER() asm volatile("" ::: "memory")
#define LDS_BARRIER() do { asm volatile("s_waitcnt lgkmcnt(0)" ::: "memory"); __builtin_amdgcn_s_barrier(); asm volatile("" ::: "memory"); } while (0)
__device__ __forceinline__ unsigned pk2(float lo, float hi) { f32x2 v = {lo, hi}; bf16x2_t b = __builtin_convertvector(v, bf16x2_t); return __builtin_bit_cast(unsigned, b); }
__device__ __forceinline__ unsigned pk4_fp8(float a, float b, float c, float d) { int w = 0; w = __builtin_amdgcn_cvt_pk_fp8_f32(a, b, w, false); w = __builtin_amdgcn_cvt_pk_fp8_f32(c, d, w, true); return (unsigned)w; }
__device__ __forceinline__ float bf2f(unsigned short b) { return __uint_as_float((unsigned)b << 16); }
__device__ __forceinline__ float bflo(unsigned w) { return __uint_as_float(w << 16); }
__device__ __forceinline__ float bfhi(unsigned w) { return __uint_as_float(w & 0xffff0000u); }
template <int CTRL> __device__ __forceinline__ float dpp_mov(float v) { return __builtin_bit_cast(float, __builtin_amdgcn_update_dpp(0, __builtin_bit_cast(int, v), CTRL, 0xF, 0xF, true)); }
__device__ __forceinline__ float sum_row16(float v) {
    v += dpp_mov<0xB1>(v);
    v += dpp_mov<0x4E>(v);
    v += dpp_mov<0x141>(v);
    v += dpp_mov<0x140>(v);
    return v; }
__device__ __forceinline__ float sum_xor16(float v) { const unsigned u = __builtin_bit_cast(unsigned, v); auto r = __builtin_amdgcn_permlane16_swap(u, u, false, false); return __builtin_bit_cast(float, (unsigned)r[0]) + __builtin_bit_cast(float, (unsigned)r[1]); }
__device__ __forceinline__ float sum_xor32(float v) { const unsigned u = __builtin_bit_cast(unsigned, v); auto r = __builtin_amdgcn_permlane32_swap(u, u, false, false); return __builtin_bit_cast(float, (unsigned)r[0]) + __builtin_bit_cast(float, (unsigned)r[1]); }
__device__ __forceinline__ float wave_sum(float v) { return sum_xor32(sum_xor16(sum_row16(v))); }
__device__ __forceinline__ float silu_f(float x) { return x * __builtin_amdgcn_rcpf(1.f + __expf(-x)); }
__device__ __forceinline__ float sigmoid_f(float x) { return __builtin_amdgcn_rcpf(1.f + __expf(-x)); }
__device__ __forceinline__ f32x4 silu4(f32x4 v) {
    const f32x4 vc = __builtin_elementwise_max(v, (f32x4){-20.f, -20.f, -20.f, -20.f}); const f32x4 ea = vc * -1.4426950408889634f;
    const f32x4 d = (f32x4){__builtin_amdgcn_exp2f(ea[0]), __builtin_amdgcn_exp2f(ea[1]), __builtin_amdgcn_exp2f(ea[2]), __builtin_amdgcn_exp2f(ea[3])} + 1.f;
    const f32x2 dlo = {d[0], d[1]}, dhi = {d[2], d[3]}; const f32x2 q2 = dlo * dhi; const float rq = __builtin_amdgcn_rcpf(q2[0] * q2[1]); const f32x2 t2 = (f32x2){q2[1], q2[0]} * rq;
    const f32x2 rlo = t2 * dhi, rhi = t2 * dlo; return vc * (f32x4){rlo[0], rlo[1], rhi[0], rhi[1]};
}
__device__ __forceinline__ bf16x8 pack8(f32x4 a, f32x4 b) {
    u32x4 w; w.x = pk2(a[0], a[1]); w.y = pk2(a[2], a[3]); w.z = pk2(b[0], b[1]); w.w = pk2(b[2], b[3]); return __builtin_bit_cast(bf16x8, w);
}

__device__ __forceinline__ void glds16_asm(const void* gsrc, unsigned lds_dst) { unsigned keep;
    asm volatile("s_mov_b32 %0, m0\n\ts_mov_b32 m0, %2\n\ts_nop 0\n\tglobal_load_lds_dwordx4 %1, off\n\ts_mov_b32 m0, %0\n\ts_nop 0" : "=&s"(keep) : "v"(gsrc), "s"(lds_dst) : "memory"); }

__device__ __forceinline__ void glds16_asm_nt(const void* gsrc, unsigned lds_dst) { unsigned keep;
    asm volatile("s_mov_b32 %0, m0\n\ts_mov_b32 m0, %2\n\ts_nop 0\n\tglobal_load_lds_dwordx4 %1, off nt\n\ts_mov_b32 m0, %0\n\ts_nop 0" : "=&s"(keep) : "v"(gsrc), "s"(lds_dst) : "memory"); }

namespace pg8 {
constexpr int BM = 256, BK = 64, HALF = 128, HTB = HALF * BK * 2, STAGE_BYTES = 8 * HTB, NXCD = 8, WGM = 8;
__host__ __device__ __forceinline__ int lds_byte(int r, int c) { const int st = (r >> 4) * 2 + (c >> 5), rr = r & 15, cc = c & 31, ob = rr * 64 + cc * 2; return st * 1024 + (ob ^ (((ob >> 9) & 1) << 5)); }
__host__ __device__ __forceinline__ void stage_rc(int b, int& R, int& C) { const int st = b / 1024, sb = b % 1024, swz = sb ^ (((sb >> 9) & 1) << 5); R = (st >> 1) * 16 + swz / 64; C = (st & 1) * 32 + (swz % 64) / 2; }
__host__ __device__ __forceinline__ int perm32(int rho) { const int n = rho >> 4, i = rho & 15; return 8 * (i >> 2) + 4 * n + (i & 3); }

struct Unit { int pm, pn, pb, e, mt; };
struct Gemm { const bf16* A; const bf16* Bt; int K; };

__device__ __forceinline__ bool static_tile(int i, int G, int c, int nM, int nN, int& pm, int& pn) {
    const int nwg = nM * nN; const long L = (long)i * G + c; if (L >= nwg) return false;
    int wgid = (int)L; { const int q = nwg / NXCD, r = nwg % NXCD, xcd = wgid % NXCD, off = wgid / NXCD; wgid = (xcd < r ? xcd * (q + 1) : r * (q + 1) + (xcd - r) * q) + off; }
    const int nig = WGM * nN, gid = wgid / nig, fm = gid * WGM, gsz = (nM - fm) < WGM ? (nM - fm) : WGM;
    pm = fm + ((wgid % nig) % gsz); pn = (wgid % nig) / gsz; return true;
}
struct StaticOrder {
    int nM, nN, G, c;
    __device__ __forceinline__ bool next(int i, Unit& u) const { int pm, pn; if (!static_tile(i, G, c, nM, nN, pm, pn)) return false; u.pm = pm; u.pn = pn; u.pb = pn; u.e = 0; u.mt = 0; return true; }
    __device__ __forceinline__ int row_index(const Unit&, int) const { return 0; }
};
struct MoeOrder {
    int nM, nN, G, c; const LAS int* tstart; const LAS int* lcnt; const LAS int* texp; const int* list;
    __device__ __forceinline__ bool next(int i, Unit& u) const {
        int pm, pn; if (!static_tile(i, G, c, nM, nN, pm, pn)) return false;
        const int e = texp[pm]; u.pm = pm; u.pn = pn; u.e = e; u.pb = e * nN + pn; u.mt = pm - tstart[e]; return true;
    }
    __device__ __forceinline__ int row_index(const Unit& u, int r) const { const int rr = u.mt * 256 + r; const int v = list[u.e * LCAP + rr]; return rr < lcnt[u.e] ? v : 0; }
};

#define PG8_SA(b, h) (((b) * 2 + (h)) * HTB)
#define PG8_SB(b, h) ((4 + (b) * 2 + (h)) * HTB)
#define PG8_GLDS(src, dstoff) __builtin_amdgcn_global_load_lds((const unsigned*)(src), (LAS unsigned*)(lds + (dstoff)), 16, 0, 0)
#define PG8_STAGE_B(bufoff, nx, kb, h) do { _Pragma("unroll") for (int _i = 0; _i < 2; ++_i) \
        PG8_GLDS(((nx) ? nB : cB) + (kb) + (Epi::WIDE ? (size_t)voffBW[h][_i] : (size_t)(h) * hstep + voffB[_i]), (bufoff) + ldsw + _i * 8192); } while (0)
#define PG8_STAGE_A(bufoff, nx, kb, h) do { _Pragma("unroll") for (int _i = 0; _i < 2; ++_i) \
        PG8_GLDS(GATHER ? (const char*)g.A + (kb) + ((nx) ? voffN[h][_i] : voffC[h][_i]) : ((nx) ? nA : cA) + (kb) + (size_t)(h) * hstep + voffA[_i], (bufoff) + ldsw + _i * 8192); } while (0)
#define PG8_LDA8(dst, b, h) do { _Pragma("unroll") for (int m = 0; m < 4; ++m) { const v4i_t lo_ = *(const LAS v4i_t*)(lds + PG8_SA(b, h) + aoff + m * 2048), hi_ = *(const LAS v4i_t*)(lds + PG8_SA(b, h) + aoff + m * 2048 + 1024); dst[m] = __builtin_shufflevector(lo_, hi_, 0, 1, 2, 3, 4, 5, 6, 7); } } while (0)
#define PG8_LDB8(dst, b, h) do { _Pragma("unroll") for (int n = 0; n < 2; ++n) { const v4i_t lo_ = *(const LAS v4i_t*)(lds + PG8_SB(b, h) + boff + n * 2048), hi_ = *(const LAS v4i_t*)(lds + PG8_SB(b, h) + boff + n * 2048 + 1024); dst[n] = __builtin_shufflevector(lo_, hi_, 0, 1, 2, 3, 4, 5, 6, 7); } } while (0)
#define PG8_LDA(dst, b, h) do { _Pragma("unroll") for (int m = 0; m < 4; ++m) _Pragma("unroll") for (int k = 0; k < 2; ++k) dst[m][k] = *(const LAS bf16x8*)(lds + PG8_SA(b, h) + aoff + m * 2048 + k * 1024); } while (0)
#define PG8_LDB(dst, b, h) do { _Pragma("unroll") for (int n = 0; n < 2; ++n) _Pragma("unroll") for (int k = 0; k < 2; ++k) dst[n][k] = *(const LAS bf16x8*)(lds + PG8_SB(b, h) + boff + n * 2048 + k * 1024); } while (0)
#define PG8_MMA(ai, bj, At, Bt) do { __builtin_amdgcn_s_setprio(1); _Pragma("unroll") for (int m = 0; m < 4; ++m) _Pragma("unroll") for (int n = 0; n < 2; ++n) _Pragma("unroll") for (int k = 0; k < 2; ++k) \
        acc[ai][bj][m][n] = __builtin_amdgcn_mfma_f32_16x16x32_bf16(Bt[n][k], At[m][k], acc[ai][bj][m][n], 0, 0, 0); __builtin_amdgcn_s_setprio(0); } while (0)
#define PG8_MMA8(ai, bj, At, Bt) do { __builtin_amdgcn_s_setprio(1); _Pragma("unroll") for (int m = 0; m < 4; ++m) _Pragma("unroll") for (int n = 0; n < 2; ++n) \
        asm volatile("v_mfma_scale_f32_16x16x128_f8f6f4 %0, %1, %2, %0, %3, %4 op_sel_hi:[0,0,0]" : "+v"(acc[ai][bj][m][n]) : "v"(Bt[n]), "v"(At[m]), "v"(sc_w), "v"(sc_a)); __builtin_amdgcn_s_setprio(0); } while (0)
#define PG8_MMAZ(ai, bj, At, Bt) do { __builtin_amdgcn_s_setprio(1); _Pragma("unroll") for (int m = 0; m < 4; ++m) _Pragma("unroll") for (int n = 0; n < 2; ++n) { \
        acc[ai][bj][m][n] = __builtin_amdgcn_mfma_f32_16x16x32_bf16(Bt[n][0], At[m][0], (f32x4){0.f, 0.f, 0.f, 0.f}, 0, 0, 0); \
        acc[ai][bj][m][n] = __builtin_amdgcn_mfma_f32_16x16x32_bf16(Bt[n][1], At[m][1], acc[ai][bj][m][n], 0, 0, 0); } __builtin_amdgcn_s_setprio(0); } while (0)
#define PG8_MMA8Z(ai, bj, At, Bt) do { __builtin_amdgcn_s_setprio(1); _Pragma("unroll") for (int m = 0; m < 4; ++m) _Pragma("unroll") for (int n = 0; n < 2; ++n) \
        asm volatile("v_mfma_scale_f32_16x16x128_f8f6f4 %0, %1, %2, 0, %3, %4 op_sel_hi:[0,0,0]" : "+v"(acc[ai][bj][m][n]) : "v"(Bt[n]), "v"(At[m]), "v"(sc_w), "v"(sc_a)); __builtin_amdgcn_s_setprio(0); } while (0)
#define XMMA0Z(ai, bj) do { if constexpr (FP8) PG8_MMA8Z(ai, bj, At8, B08); else PG8_MMAZ(ai, bj, At, B0); } while (0)
#define XMMA1Z(ai, bj) do { if constexpr (FP8) PG8_MMA8Z(ai, bj, At8, B18); else PG8_MMAZ(ai, bj, At, B1); } while (0)
#define XLDA(b, h) do { if constexpr (FP8) PG8_LDA8(At8, b, h); else PG8_LDA(At, b, h); } while (0)
#define XLDB0(b, h) do { if constexpr (FP8) PG8_LDB8(B08, b, h); else PG8_LDB(B0, b, h); } while (0)
#define XLDB1(b, h) do { if constexpr (FP8) PG8_LDB8(B18, b, h); else PG8_LDB(B1, b, h); } while (0)
#define XMMA0(ai, bj) do { if constexpr (FP8) PG8_MMA8(ai, bj, At8, B08); else PG8_MMA(ai, bj, At, B0); } while (0)
#define XMMA1(ai, bj) do { if constexpr (FP8) PG8_MMA8(ai, bj, At8, B18); else PG8_MMA(ai, bj, At, B1); } while (0)
#define PG8_WAIT_V(n) asm volatile("s_waitcnt vmcnt(" #n ")" ::: "memory")
#define PG8_WAIT_L(n) asm volatile("s_waitcnt lgkmcnt(" #n ")" ::: "memory")
#define PG8_BAR __builtin_amdgcn_s_barrier()
#define PG8_SCHED __builtin_amdgcn_sched_barrier(0)

template <class Epi, class Sched, bool GATHER, bool ALIGN_EPI, bool FP8 = false, int KREP = 1>
__device__ __forceinline__ void gemm_phase(LAS unsigned char* lds, const Gemm g, const Sched& S, const Epi& E) {
    const int tid = threadIdx.x, wid = __builtin_amdgcn_readfirstlane(tid >> 6), lane = tid & 63, wr = wid >> 2, wc = wid & 3, fr = lane & 15, fq = lane >> 4;
    const int K = g.K, rowb = FP8 ? K : 2 * K, nt = rowb / 128;
    unsigned voffA[2], voffB[2], voffBW[2][2], voffC[2][2], voffN[2][2]; int RA[2], CA[2];
#pragma unroll
    for (int i = 0; i < 2; ++i) { int R, C; stage_rc(tid * 16 + i * 8192, R, C); const int Rb = Epi::PERM ? ((R & ~31) + perm32(R & 31)) : R;
        RA[i] = R; CA[i] = C; voffA[i] = (unsigned)(R * rowb + C * 2); voffB[i] = (unsigned)(Rb * rowb + C * 2);
        voffBW[0][i] = (unsigned)((64 * (R >> 5) + perm32(R & 31)) * rowb + C * 2); voffBW[1][i] = (unsigned)((64 * (R >> 5) + 32 + perm32(R & 31)) * rowb + C * 2); }
    const size_t kstep = (size_t)(BK * 2), hstep = (size_t)HALF * rowb, tstep = 2 * hstep;
    const unsigned ldsw = (unsigned)wid * 1024u;
    const int aoff = lds_byte(wr * 64 + fr, fq * 8), boff = lds_byte(wc * 32 + fr, fq * 8);
    Unit cur, nxt; int ui = 0;
    if (!S.next(0, cur)) return;
    f32x4 acc[2][2][4][2];
#define PG8_ZERO_ACC() do { if constexpr (!FP8) { _Pragma("unroll") for (int a_ = 0; a_ < 2; ++a_) _Pragma("unroll") for (int b_ = 0; b_ < 2; ++b_) _Pragma("unroll") for (int m_ = 0; m_ < 4; ++m_) _Pragma("unroll") for (int n_ = 0; n_ < 2; ++n_) \
        acc[a_][b_][m_][n_] = (f32x4){0.f, 0.f, 0.f, 0.f}; } } while (0)
    PG8_ZERO_ACC();
    bf16x8 At[4][2], B0[2][2], B1[2][2]; v8i_t At8[4], B08[2], B18[2]; int sc_w = 0x7a7a7a7a, sc_a = 0x7f7f7f7f; asm volatile("" : "+v"(sc_w), "+v"(sc_a));
    const char* cA = (const char*)g.A + (size_t)cur.pm * tstep; const char* cB = (const char*)g.Bt + (size_t)cur.pb * tstep;
    if (GATHER) {
#pragma unroll
        for (int h = 0; h < 2; ++h)
#pragma unroll
            for (int i = 0; i < 2; ++i) { voffC[h][i] = (unsigned)(S.row_index(cur, RA[i] + 128 * h) * rowb + CA[i] * 2); voffN[h][i] = voffC[h][i]; }
    }
    const char* nA = cA; const char* nB = cB;
    E.prefetch(cur, 0, wid, lane);
    PG8_STAGE_B(PG8_SB(0, 0), false, 0, 0); PG8_STAGE_B(PG8_SB(0, 1), false, 0, 1); PG8_STAGE_A(PG8_SA(0, 0), false, 0, 0); PG8_STAGE_A(PG8_SA(0, 1), false, 0, 1);
    if (wr == 1) PG8_BAR;
    PG8_WAIT_V(2); PG8_BAR;
    PG8_STAGE_B(PG8_SB(1, 0), false, kstep, 0); PG8_STAGE_A(PG8_SA(1, 0), false, kstep, 0); PG8_STAGE_B(PG8_SB(1, 1), false, kstep, 1);
    PG8_WAIT_V(6); PG8_BAR;
    for (;;) {
        const bool has_next = S.next(ui + 1, nxt);
        if (has_next) E.prefetch(nxt, (ui + 1) % 3, wid, lane);
        nA = has_next ? (const char*)g.A + (size_t)nxt.pm * tstep : cA; nB = has_next ? (const char*)g.Bt + (size_t)nxt.pb * tstep : cB;
        if (GATHER) {
            if (has_next) { int ix[2][2];
#pragma unroll
                for (int h = 0; h < 2; ++h)
#pragma unroll
                    for (int i = 0; i < 2; ++i) ix[h][i] = S.row_index(nxt, RA[i] + 128 * h);
#pragma unroll
                for (int h = 0; h < 2; ++h)
#pragma unroll
                    for (int i = 0; i < 2; ++i) voffN[h][i] = (unsigned)(ix[h][i] * rowb + CA[i] * 2);
            } else {
#pragma unroll
                for (int h = 0; h < 2; ++h)
#pragma unroll
                    for (int i = 0; i < 2; ++i) voffN[h][i] = voffC[h][i]; }
        }
        for (int t = 0; t < nt * KREP; t += 2) {
            const bool last = (t == nt * KREP - 2);
            const int tm = t % nt; const size_t k1 = (size_t)(tm + 1) * kstep, k2 = last ? 0 : (size_t)((tm + 2) % nt) * kstep, k3 = k2 + kstep;
            XLDB0(0, 0); XLDB1(0, 1); PG8_SCHED; XLDA(0, 0); PG8_STAGE_A(PG8_SA(1, 1), false, k1, 1);
            PG8_WAIT_V(8); PG8_WAIT_L(0); PG8_BAR; if (FP8 && t == 0) { XMMA0Z(0, 0); XMMA1Z(0, 1); } else { XMMA0(0, 0); XMMA1(0, 1); } PG8_BAR; PG8_SCHED;
            XLDA(0, 1); PG8_STAGE_B(PG8_SB(0, 0), last, k2, 0); PG8_STAGE_B(PG8_SB(0, 1), last, k2, 1); PG8_STAGE_A(PG8_SA(0, 0), last, k2, 0);
            PG8_WAIT_V(8); PG8_WAIT_L(0); PG8_BAR; if (FP8 && t == 0) { XMMA0Z(1, 0); XMMA1Z(1, 1); } else { XMMA0(1, 0); XMMA1(1, 1); } PG8_BAR; PG8_SCHED;
            XLDB0(1, 0); XLDB1(1, 1); PG8_SCHED; XLDA(1, 0); PG8_STAGE_A(PG8_SA(0, 1), last, k2, 1);
            PG8_WAIT_V(8); PG8_WAIT_L(0); PG8_BAR; XMMA0(0, 0); XMMA1(0, 1); PG8_BAR; PG8_SCHED;
            XLDA(1, 1); PG8_STAGE_B(PG8_SB(1, 0), last, k3, 0); PG8_STAGE_B(PG8_SB(1, 1), last, k3, 1); PG8_STAGE_A(PG8_SA(1, 0), last, k3, 0);
            PG8_WAIT_V(8); PG8_WAIT_L(0); PG8_BAR; XMMA0(1, 0); XMMA1(1, 1); PG8_BAR; PG8_SCHED;
        }
        if constexpr (ALIGN_EPI) { if (wr == 0) PG8_BAR; }
        if constexpr (FP8) asm volatile("s_nop 15\n\ts_nop 15" ::: "memory");
        if constexpr (KREP > 1) {
#pragma unroll
            for (int a_ = 0; a_ < 2; ++a_)
#pragma unroll
                for (int b_ = 0; b_ < 2; ++b_)
#pragma unroll
                    for (int m_ = 0; m_ < 4; ++m_)
#pragma unroll
                        for (int n_ = 0; n_ < 2; ++n_) acc[a_][b_][m_][n_] = acc[a_][b_][m_][n_] * (1.f / KREP); }
        E(acc, cur, wr, wc, fr, fq, ui % 3);
        if (!has_next) break;
        PG8_ZERO_ACC();
        cur = nxt; cA = nA; cB = nB; ++ui;
        if (GATHER) {
#pragma unroll
            for (int h = 0; h < 2; ++h)
#pragma unroll
                for (int i = 0; i < 2; ++i) voffC[h][i] = voffN[h][i];
        }
        if constexpr (ALIGN_EPI) { if (wr == 1) PG8_BAR; }
    }
    PG8_WAIT_V(0);
    if constexpr (!ALIGN_EPI) { if (wr == 0) PG8_BAR; }
    PG8_BAR;
}

struct EpiInProj {
    static constexpr bool PERM = true, WIDE = true;
    __device__ __forceinline__ void prefetch(const Unit&, int, int, int) const {}
    bf16* zg; bf16* qb; bf16* kb; bf16* vb; const float* qn; const float* kn; LAS unsigned char* stage; const float* gnw;
    template <int MODE> __device__ __forceinline__ void body(const f32x4 (&acc)[2][2][4][2], const Unit& u, int wr, int wc, int fr, int fq) const {
        const int lane = fq * 16 + fr; LAS unsigned char* stg = stage + (wr * 4 + wc) * 3584;
        constexpr bool swa = MODE >= 2; const int sec = swa ? (u.pn - 8) >> 1 : 0, head = 4 * ((u.pn - 8) & 1) + wc;
        bf16* dst = qb + (size_t)sec * ((WS_KB - WS_QB) / 2); const float* nw = (sec == 1) ? kn : qn;
        f32x4 wv[2][2];
        if constexpr (MODE == 1 || MODE == 2) {
#pragma unroll
            for (int bj = 0; bj < 2; ++bj)
#pragma unroll
                for (int n = 0; n < 2; ++n) wv[bj][n] = MODE == 2 ? *(const f32x4*)(nw + 32 * bj + 8 * fq + 4 * n) : *(const f32x4*)(gnw + ((wc & 1) * 64 + 32 * bj + 8 * fq + 4 * n)); }
#pragma unroll
        for (int ai = 0; ai < 2; ++ai)
#pragma unroll
            for (int m = 0; m < 4; ++m) {
                float sc = 1.f;
                if constexpr (MODE == 2) { float ss = 0.f;
#pragma unroll
                    for (int bj = 0; bj < 2; ++bj)
#pragma unroll
                        for (int n = 0; n < 2; ++n) { const f32x4 x = acc[ai][bj][m][n]; ss += (x[0] * x[0] + x[1] * x[1]) + (x[2] * x[2] + x[3] * x[3]); }
                    ss = sum_xor32(sum_xor16(ss));
                    sc = rsqrtf(ss * (1.f / 64.f) + EPS) * (sec == 0 ? 0.125f * LOG2E : 1.f); }
#pragma unroll
                for (int bj = 0; bj < 2; ++bj) { f32x4 v0 = acc[ai][bj][m][0], v1 = acc[ai][bj][m][1];
                    if constexpr (MODE == 1) { v0 = silu4(v0) * wv[bj][0]; v1 = silu4(v1) * wv[bj][1]; }
                    if constexpr (MODE == 2) { v0 = (v0 * sc) * wv[bj][0]; v1 = (v1 * sc) * wv[bj][1]; }
                    u32x4 w; w.x = pk2(v0[0], v0[1]); w.y = pk2(v0[2], v0[3]); w.z = pk2(v1[0], v1[1]); w.w = pk2(v1[2], v1[3]); *(LAS u32x4*)(stg + fr * 144 + bj * 64 + fq * 16) = w; }
                WAVE_LDS_ORDER();
                const int row0 = u.pm * BM + ai * HALF + wr * 64 + m * 16;
                u32x4 wq[2];
#pragma unroll
                for (int hf = 0; hf < 2; ++hf) wq[hf] = *(const LAS u32x4*)(stg + (hf * 8 + (lane >> 3)) * 144 + (lane & 7) * 16);
                asm volatile("" :: "v"(wq[0]), "v"(wq[1]));
#pragma unroll
                for (int hf = 0; hf < 2; ++hf) { const int rr = hf * 8 + (lane >> 3), c16 = lane & 7, row_ = row0 + rr;
                    bf16* gp = swa ? dst + ((size_t)((row_ >> 12) * AH + head) * SEQ + (row_ & (SEQ - 1))) * 64 + 8 * c16 : zg + (size_t)row_ * 2048 + u.pn * BM + wc * 64 + 8 * c16;
                    __builtin_nontemporal_store(wq[hf], (u32x4*)gp); }
                WAVE_LDS_ORDER(); }
    }
    __device__ __forceinline__ void operator()(const f32x4 (&acc)[2][2][4][2], const Unit& u, int wr, int wc, int fr, int fq, int) const {
        if (u.pn < 6) body<0>(acc, u, wr, wc, fr, fq); else if (u.pn < 8) body<1>(acc, u, wr, wc, fr, fq); else if (u.pn < 12) body<2>(acc, u, wr, wc, fr, fq); else body<3>(acc, u, wr, wc, fr, fq);
    }
};
struct EpiOutProj {
    __device__ __forceinline__ void prefetch(const Unit&, int, int, int) const {}
    static constexpr bool PERM = true, WIDE = true;
    const float* x; bf16* h; unsigned char* hb; LAS unsigned char* stage;
    __device__ __forceinline__ void operator()(const f32x4 (&acc)[2][2][4][2], const Unit& u, int wr, int wc, int fr, int fq, int) const {
        const int lane = fq * 16 + fr; LAS unsigned char* stg = stage + (wr * 4 + wc) * 3584; const int colw = u.pn * BM + wc * 64;
        const int r8 = lane >> 3, c16 = lane & 7;
#pragma unroll
        for (int ai = 0; ai < 2; ++ai)
#pragma unroll
            for (int mp = 0; mp < 2; ++mp) {
                f32x4 xv[2][2][2];
#pragma unroll
                for (int mm = 0; mm < 2; ++mm) { const int row0 = u.pm * BM + ai * HALF + wr * 64 + (2 * mp + mm) * 16;
#pragma unroll
                    for (int bj = 0; bj < 2; ++bj)
#pragma unroll
                        for (int hf = 0; hf < 2; ++hf) xv[mm][bj][hf] = __builtin_nontemporal_load((const f32x4*)(x + (size_t)(row0 + 8 * hf + r8) * D + colw + 32 * bj + 4 * c16)); }
                unsigned h8[2][2][2];
#pragma unroll
                for (int mm = 0; mm < 2; ++mm) { const int m = 2 * mp + mm; const int row0 = u.pm * BM + ai * HALF + wr * 64 + m * 16; u32x4 hw[2];
#pragma unroll
                    for (int bj = 0; bj < 2; ++bj) {
#pragma unroll
                        for (int hf = 0; hf < 2; ++hf) *(LAS f32x4*)(stg + (8 * hf + r8) * 144 + c16 * 16) = xv[mm][bj][hf];
                        WAVE_LDS_ORDER();
                        const f32x4 x0 = *(const LAS f32x4*)(stg + fr * 144 + fq * 32), x1 = *(const LAS f32x4*)(stg + fr * 144 + fq * 32 + 16);
                        const f32x4 v0 = acc[ai][bj][m][0] + x0, v1 = acc[ai][bj][m][1] + x1;
                        h8[mm][bj][0] = pk4_fp8(v0[0], v0[1], v0[2], v0[3]); h8[mm][bj][1] = pk4_fp8(v1[0], v1[1], v1[2], v1[3]);
                        hw[bj] = (u32x4){pk2(v0[0], v0[1]), pk2(v0[2], v0[3]), pk2(v1[0], v1[1]), pk2(v1[2], v1[3])};
                        WAVE_LDS_ORDER(); }
#pragma unroll
                    for (int bj = 0; bj < 2; ++bj) *(LAS u32x4*)(stg + fr * 144 + bj * 64 + fq * 16) = hw[bj];
                    WAVE_LDS_ORDER();
#pragma unroll
                    for (int hf = 0; hf < 2; ++hf) { const u32x4 w = *(const LAS u32x4*)(stg + (8 * hf + r8) * 144 + c16 * 16); __builtin_nontemporal_store(w, (u32x4*)(h + (size_t)(row0 + 8 * hf + r8) * D + colw + 8 * c16)); }
                    WAVE_LDS_ORDER(); }
#pragma unroll
                for (int mm = 0; mm < 2; ++mm)
#pragma unroll
                    for (int bj = 0; bj < 2; ++bj) *(LAS u32x2*)(stg + (16 * mm + fr) * 80 + bj * 32 + fq * 8) = (u32x2){h8[mm][bj][0], h8[mm][bj][1]};
                WAVE_LDS_ORDER();
                { const int rr = lane >> 2, q16 = lane & 3; const int rowa = u.pm * BM + ai * HALF + wr * 64 + (2 * mp) * 16;
                  const u32x4 w0 = *(const LAS u32x4*)(stg + rr * 80 + q16 * 16), w1 = *(const LAS u32x4*)(stg + (16 + rr) * 80 + q16 * 16);
                  *(u32x4*)(hb + (size_t)(rowa + rr) * D + colw + 16 * q16) = w0; *(u32x4*)(hb + (size_t)(rowa + 16 + rr) * D + colw + 16 * q16) = w1; }
                WAVE_LDS_ORDER(); }
    }
};
struct EpiGateUp {
    static constexpr bool PERM = true, WIDE = false;
    unsigned char* act; const float* bgu; const float* lrs; const LAS int* lcnt; LAS unsigned char* stage;
    __device__ __forceinline__ void prefetch(const Unit& u, int slot, int wid, int lane) const {
        const unsigned l0 = (unsigned)(uintptr_t)stage;
        if (wid == 0) glds16_asm(bgu + (size_t)u.e * 2048 + (lane >> 5) * 1024 + 128 * u.pn + (lane & 31) * 4, (unsigned)__builtin_amdgcn_readfirstlane((int)(l0 + slot * 1024)));
        else if (wid == 1) glds16_asm(lrs + (size_t)u.e * LCAP + u.mt * 256 + lane * 4, (unsigned)__builtin_amdgcn_readfirstlane((int)(l0 + 3072 + slot * 1024)));
    }
    __device__ __forceinline__ void operator()(const f32x4 (&acc)[2][2][4][2], const Unit& u, int wr, int wc, int fr, int fq, int slot) const {
        const int cl = wc * 32 + 8 * fq; const LAS float* bl = (const LAS float*)(stage + slot * 1024); const LAS float* rl = (const LAS float*)(stage + 3072 + slot * 1024);
        f32x4 bgv[2], buv[2];
#pragma unroll
        for (int n = 0; n < 2; ++n) { bgv[n] = *(const LAS f32x4*)(bl + cl + 4 * n); buv[n] = *(const LAS f32x4*)(bl + 128 + cl + 4 * n) + 1.f; }
        const int cnt = lcnt[u.e];
#pragma unroll
        for (int ai = 0; ai < 2; ++ai)
#pragma unroll
            for (int m = 0; m < 4; ++m) { const int r = ai * HALF + wr * 64 + m * 16 + fr, rr = u.mt * 256 + r;
                const float rsv = rl[r]; const float rs = rr < cnt ? rsv : 0.f;
                unsigned wq[2];
#pragma unroll
                for (int n = 0; n < 2; ++n) {
                    const f32x4 gt = __builtin_elementwise_min(__builtin_elementwise_max(acc[ai][0][m][n] * rs + bgv[n], (f32x4){-12.5f, -12.5f, -12.5f, -12.5f}), (f32x4){7.f, 7.f, 7.f, 7.f});
                    const f32x4 u1 = __builtin_elementwise_min(__builtin_elementwise_max(acc[ai][1][m][n] * rs + buv[n], (f32x4){-6.f, -6.f, -6.f, -6.f}), (f32x4){8.f, 8.f, 8.f, 8.f});
                    const f32x4 ea = gt * (-1.702f * LOG2E);
                    const f32x4 dn = (f32x4){__builtin_amdgcn_exp2f(ea[0]), __builtin_amdgcn_exp2f(ea[1]), __builtin_amdgcn_exp2f(ea[2]), __builtin_amdgcn_exp2f(ea[3])} + 1.f;
                    const f32x2 dlo = {dn[0], dn[1]}, dhi = {dn[2], dn[3]}; const f32x2 q2 = dlo * dhi;
                    const float rq = __builtin_amdgcn_rcpf(q2[0] * q2[1]); const f32x2 t2 = (f32x2){q2[1], q2[0]} * rq;
                    const f32x2 rlo = t2 * dhi, rhi = t2 * dlo;
                    const f32x4 a = (u1 * gt) * (f32x4){rlo[0], rlo[1], rhi[0], rhi[1]};
                    wq[n] = pk4_fp8(a[0], a[1], a[2], a[3]); }
                *(u32x2*)(act + (size_t)(u.pm * BM + r) * FF + 128 * u.pn + cl) = (u32x2){wq[0], wq[1]}; }
    }
};
struct EpiDown {
    static constexpr bool PERM = true, WIDE = true;
    unsigned char* y; const float* bdn; LAS unsigned char* stage;
    __device__ __forceinline__ void prefetch(const Unit& u, int slot, int wid, int lane) const {
        if (wid == 0) glds16_asm(bdn + (size_t)u.e * D + u.pn * BM + lane * 4, (unsigned)__builtin_amdgcn_readfirstlane((int)((unsigned)(uintptr_t)stage + 20480 + slot * 1024)));
    }
    __device__ __forceinline__ void operator()(const f32x4 (&acc)[2][2][4][2], const Unit& u, int wr, int wc, int fr, int fq, int slot) const {
        const int colw = u.pn * BM + wc * 64; const LAS float* bp = (const LAS float*)(stage + 20480 + slot * 1024) + wc * 64 + 8 * fq;
        f32x4 bv[2][2];
#pragma unroll
        for (int bj = 0; bj < 2; ++bj)
#pragma unroll
            for (int n = 0; n < 2; ++n) bv[bj][n] = *(const LAS f32x4*)(bp + 32 * bj + 4 * n);
        const int lane = fq * 16 + fr; LAS unsigned char* stg = stage + (wr * 4 + wc) * 2560;
#pragma unroll
        for (int ai = 0; ai < 2; ++ai)
#pragma unroll
            for (int mp = 0; mp < 2; ++mp) {
#pragma unroll
                for (int mm = 0; mm < 2; ++mm) { const int m = 2 * mp + mm;
#pragma unroll
                    for (int bj = 0; bj < 2; ++bj) { const f32x4 v0 = acc[ai][bj][m][0] + bv[bj][0], v1 = acc[ai][bj][m][1] + bv[bj][1];
                        *(LAS u32x2*)(stg + (16 * mm + fr) * 80 + bj * 32 + fq * 8) = (u32x2){pk4_fp8(v0[0], v0[1], v0[2], v0[3]), pk4_fp8(v1[0], v1[1], v1[2], v1[3])}; } }
                WAVE_LDS_ORDER();
                { const int rr = lane >> 2, c16 = lane & 3; const u32x4 w = *(const LAS u32x4*)(stg + rr * 80 + c16 * 16);
                  const int rowa = u.pm * BM + ai * HALF + wr * 64 + (2 * mp) * 16 + rr; *(u32x4*)(y + (size_t)rowa * D + colw + 16 * c16) = w;
                  const u32x4 w2 = *(const LAS u32x4*)(stg + (16 + rr) * 80 + c16 * 16); *(u32x4*)(y + (size_t)(rowa + 16) * D + colw + 16 * c16) = w2; }
                WAVE_LDS_ORDER(); }
    }
};
}

#define XB_TMO      128
#define XB_XCNT(j)  (256  + 64 * (j))
#define XB_XSUB(j)  (1280 + 64 * (j))
#define XB_XGEN(j)  (2304 + 64 * (j))
#define XB_TOP      3328
#define XB_TOPGEN   3392
#define XCD_BAR_WORDS 3456
#define XB_SPIN_CAP (1u << 20)
__device__ __forceinline__ unsigned xb_ld(unsigned* p)              { return __hip_atomic_load(p, __ATOMIC_RELAXED, __HIP_MEMORY_SCOPE_AGENT); }
__device__ __forceinline__ unsigned xb_add(unsigned* p, unsigned v) { return __hip_atomic_fetch_add(p, v, __ATOMIC_RELAXED, __HIP_MEMORY_SCOPE_AGENT); }
__device__ __forceinline__ unsigned xb_xcc_id() { return (unsigned)__builtin_amdgcn_s_getreg((3 << 11) | 20) & 0xFu; }
#define XB_SPIN(cond, bar) do { unsigned _sp = 0; while (cond) { __builtin_amdgcn_s_sleep(1); \
    if ((++_sp & 255u) == 0u) { if (xb_ld(&(bar)[XB_TMO])) break; if (_sp > XB_SPIN_CAP) { atomicAdd(&(bar)[XB_TMO], 1u); break; } } } } while (0)
struct XcdBarrier { unsigned* bar; unsigned x; volatile LAS unsigned* st; };
__device__ __forceinline__ XcdBarrier xcd_barrier_post(unsigned* bar, volatile LAS unsigned* st) {
    XcdBarrier b; b.bar = bar; b.x = xb_xcc_id(); b.st = st;
    if (threadIdx.x == 0) (void)xb_add(&bar[XB_XCNT(b.x)], 1u);
    return b;
}
__device__ __forceinline__ void xcd_barrier_complete(unsigned* bar, unsigned x, unsigned& nloc, unsigned& nx) {
    const unsigned G = gridDim.x * gridDim.y * gridDim.z;
    unsigned sum, cnt, mine, sp = 0u;
    for (;;) {
        sum = 0u; cnt = 0u; mine = 0u;
#pragma unroll
        for (unsigned j = 0; j < 16; ++j) { const unsigned c = xb_ld(&bar[XB_XCNT(j)]); sum += c; cnt += (c > 0u) ? 1u : 0u; mine = (j == x) ? c : mine; }
        if (sum == G) break;
        __builtin_amdgcn_s_sleep(1);
        if ((++sp & 255u) == 0u) { if (xb_ld(&bar[XB_TMO])) break; if (sp > XB_SPIN_CAP) { atomicAdd(&bar[XB_TMO], 1u); break; } }
    }
    nloc = mine > 0u ? mine : 1u; nx = cnt > 0u ? cnt : 1u;
}
__device__ __forceinline__ void xcd_barrier(const XcdBarrier& b) {
    asm volatile("s_waitcnt vmcnt(0)" ::: "memory");
    __syncthreads();
    if (threadIdx.x == 0) {
        unsigned* bar = b.bar;
        __builtin_amdgcn_s_waitcnt(0);
        unsigned nloc = b.st[0], nx = b.st[1];
        if (nloc == 0u) { xcd_barrier_complete(bar, b.x, nloc, nx); b.st[0] = nloc; b.st[1] = nx; }
        const unsigned old = xb_add(&bar[XB_XSUB(b.x)], 1u);
        const unsigned gen = old / nloc;
        if (old + 1u == (gen + 1u) * nloc) {
            __builtin_amdgcn_fence(__ATOMIC_RELEASE, "agent");
            asm volatile("s_waitcnt vmcnt(0)" ::: "memory");
            const unsigned og = xb_add(&bar[XB_TOP], 1u);
            const unsigned tg = og / nx;
            if (og + 1u == (tg + 1u) * nx) xb_add(&bar[XB_TOPGEN], 1u);
            else XB_SPIN(xb_ld(&bar[XB_TOPGEN]) == tg, bar);
            __builtin_amdgcn_fence(__ATOMIC_ACQUIRE, "agent");
            xb_add(&bar[XB_XGEN(b.x)], 1u);
            asm volatile("s_waitcnt vmcnt(0)" ::: "memory");
        } else {
            XB_SPIN(xb_ld(&bar[XB_XGEN(b.x)]) == gen, bar);
            __builtin_amdgcn_fence(__ATOMIC_ACQUIRE, "agent");
            asm volatile("s_waitcnt vmcnt(0)" ::: "memory");
        }
    }
    __syncthreads();
}

struct Args { const float* in[18]; float* out; unsigned char* ws; int ph_lo, ph_hi, li, pad; };
struct Frame {
    LAS unsigned char* lds; unsigned char* ws; unsigned* ctl;
    int tid, lane, wave, G, vcu;
};

__device__ const unsigned char T5B[3][132] = {
{0,1,2,3,4,5,6,7,8,9,10,11,12,13,14,15,16,16,16,16,16,16,17,17,17,17,17,17,17,17,18,18,18,18,18,18,18,18,18,18,19,19,19,19,19,19,19,19,19,19,19,19,19,19,20,20,20,20,20,20,20,20,20,20,20,20,20,20,20,20,20,20,20,21,21,21,21,21,21,21,21,21,21,21,21,21,21,21,21,21,21,21,21,21,21,21,21,21,21,22,22,22,22,22,22,22,22,22,22,22,22,22,22,22,22,22,22,22,22,22,22,22,22,22,22,22,22,22,22,0,0,0},
{0,4,8,12,16,16,17,17,18,18,19,19,19,19,20,20,20,20,20,21,21,21,21,21,21,22,22,22,22,22,22,22,22,22,23,23,23,23,23,23,23,23,23,23,23,23,24,24,24,24,24,24,24,24,24,24,24,24,24,24,24,24,25,25,25,25,25,25,25,25,25,25,25,25,25,25,25,25,25,25,25,25,25,26,26,26,26,26,26,26,26,26,26,26,26,26,26,26,26,26,26,26,26,26,26,26,26,26,26,26,26,26,26,27,27,27,27,27,27,27,27,27,27,27,27,27,27,27,27,0,0,0},
{0,16,18,19,20,21,21,22,22,23,23,23,24,24,24,24,25,25,25,25,25,26,26,26,26,26,26,26,26,27,27,27,27,27,27,27,27,27,27,28,28,28,28,28,28,28,28,28,28,28,28,28,29,29,29,29,29,29,29,29,29,29,29,29,29,29,29,29,29,29,30,30,30,30,30,30,30,30,30,30,30,30,30,30,30,30,30,30,30,30,30,30,30,30,30,31,31,31,31,31,31,31,31,31,31,31,31,31,31,31,31,31,31,31,31,31,31,31,31,31,31,31,31,31,31,31,31,31,31,0,0,0}};

__device__ __forceinline__ void p0_load8(const float* W, size_t ldw, int src_col0, int k0, int lane, f32x4 (&v)[8]) {
    const int n4 = (lane & 7) * 4, kr = lane >> 3;
#pragma unroll
    for (int i = 0; i < 8; ++i) v[i] = __builtin_nontemporal_load((const f32x4*)(W + (size_t)(k0 + 8 * i + kr) * ldw + src_col0 + n4));
}
template <bool SCALE, bool OUT8> __device__ __forceinline__ void p0_finish(const f32x4 (&v)[8], void* dstv, int k0, const float* kscale, LAS float* scr, int lane) {
    { const int n4 = (lane & 7) * 4, kr = lane >> 3;
#pragma unroll
        for (int i = 0; i < 8; ++i) { const int kk = 8 * i + kr; f32x4 x = v[i]; if (SCALE) x = x * kscale[k0 + kk]; if (OUT8) x = x * 32.f;
            scr[kk * 33 + n4] = x[0]; scr[kk * 33 + n4 + 1] = x[1]; scr[kk * 33 + n4 + 2] = x[2]; scr[kk * 33 + n4 + 3] = x[3]; } }
    LDS_WAIT(); asm volatile("" ::: "memory");
    if (OUT8) { unsigned char* dst = (unsigned char*)dstv; const int n = lane >> 1, kh = lane & 1; const LAS float* sp = scr + (32 * kh) * 33 + n; unsigned w[8];
#pragma unroll
        for (int q = 0; q < 8; ++q) w[q] = pk4_fp8(sp[(4 * q) * 33], sp[(4 * q + 1) * 33], sp[(4 * q + 2) * 33], sp[(4 * q + 3) * 33]);
        *(u32x4*)(dst + (size_t)n * 1024 + k0 + 32 * kh) = (u32x4){w[0], w[1], w[2], w[3]}; *(u32x4*)(dst + (size_t)n * 1024 + k0 + 32 * kh + 16) = (u32x4){w[4], w[5], w[6], w[7]};
    } else { bf16* dst = (bf16*)dstv; const int c = lane & 7;
#pragma unroll
        for (int j = 0; j < 4; ++j) { const int n = (lane >> 3) + 8 * j; const LAS float* sp = scr + (8 * c) * 33 + n;
            u32x4 o; o.x = pk2(sp[0 * 33], sp[1 * 33]); o.y = pk2(sp[2 * 33], sp[3 * 33]); o.z = pk2(sp[4 * 33], sp[5 * 33]); o.w = pk2(sp[6 * 33], sp[7 * 33]);
            *(u32x4*)(dst + (size_t)n * 1024 + k0 + 8 * c) = o; } }
    LDS_WAIT(); asm volatile("" ::: "memory");
}
template <bool SCALE, bool OUT8> __device__ __forceinline__ void p0_transpose_item(const float* W, size_t ldw, int src_col0, void* dstv, int k0, const float* kscale, LAS float* scr, int lane) {
    f32x4 v[8]; p0_load8(W, ldw, src_col0, k0, lane, v); p0_finish<SCALE, OUT8>(v, dstv, k0, kscale, scr, lane);
}
__device__ __forceinline__ void p0_experts(Frame& F, const Args& a, int gw, int NGW) {
    const float* n2 = a.in[11]; const float* w_gu = a.in[14]; const float* w_dn = a.in[16];
    unsigned char* Wgu8 = F.ws + WS_WGU; unsigned char* Wdn8 = F.ws + WS_WDN;
    LAS float* scr = (LAS float*)(F.lds + F.wave * 16896);
    constexpr int I_GU = NE * 8 * 64, I_DN = NE * 8 * 32, NI = I_GU + I_DN;
#define P0_X_ARGS(r_) const bool gu_ = (r_) < I_GU; const int r2_ = gu_ ? (r_) : (r_) - I_GU; const int e_ = gu_ ? (r2_ >> 9) : (r2_ >> 8), q_ = gu_ ? (r2_ & 511) : (r2_ & 255), nb_ = gu_ ? (q_ & 63) : (q_ & 31), kb_ = gu_ ? (q_ >> 6) : (q_ >> 5), \
        np_ = 32 * nb_, ntile_ = np_ >> 8, lc_ = np_ & 255; const int col_ = gu_ ? ((lc_ >> 7) * 1024 + 128 * ntile_ + (lc_ & 127)) : np_; const float* W_ = gu_ ? w_gu + (size_t)e_ * D * 2048 : w_dn + (size_t)e_ * FF * D; const size_t ldw_ = gu_ ? 2048 : D; \
        unsigned char* dst_ = gu_ ? Wgu8 + ((size_t)e_ * 2048 + np_) * 1024 : Wdn8 + ((size_t)e_ * 1024 + np_) * 1024; const int k0_ = 128 * kb_
#define P0_X_LOAD(r_, v_) do { P0_X_ARGS(r_); (void)dst_; const int n4 = (F.lane & 7) * 4, kr = F.lane >> 3; \
        _Pragma("unroll") for (int i = 0; i < 16; ++i) v_[i] = *(const f32x4*)(W_ + (size_t)(k0_ + 8 * i + kr) * ldw_ + col_ + n4); } while (0)
#define P0_X_FIN(r_, v_) do { P0_X_ARGS(r_); (void)W_; (void)ldw_; (void)col_; { const int n4 = (F.lane & 7) * 4, kr = F.lane >> 3; \
        _Pragma("unroll") for (int i = 0; i < 16; ++i) { const int kk = 8 * i + kr; f32x4 x = v_[i] * 32.f; if (gu_) x = x * n2[k0_ + kk]; \
            scr[kk * 33 + n4] = x[0]; scr[kk * 33 + n4 + 1] = x[1]; scr[kk * 33 + n4 + 2] = x[2]; scr[kk * 33 + n4 + 3] = x[3]; } } \
        LDS_WAIT(); asm volatile("" ::: "memory"); \
        { const int n = F.lane >> 1, kh = F.lane & 1; const LAS float* sp = scr + (64 * kh) * 33 + n; \
          _Pragma("unroll") for (int c = 0; c < 4; ++c) { unsigned w_[4]; _Pragma("unroll") for (int q = 0; q < 4; ++q) w_[q] = pk4_fp8(sp[(16 * c + 4 * q) * 33], sp[(16 * c + 4 * q + 1) * 33], sp[(16 * c + 4 * q + 2) * 33], sp[(16 * c + 4 * q + 3) * 33]); \
              *(u32x4*)(dst_ + (size_t)n * 1024 + k0_ + 64 * kh + 16 * c) = (u32x4){w_[0], w_[1], w_[2], w_[3]}; } } \
        LDS_WAIT(); asm volatile("" ::: "memory"); } while (0)
    { f32x4 va[16], vb2[16]; int it = gw;
        if (it < NI) P0_X_LOAD(it, va);
#pragma unroll 1
        for (; it < NI; it += 2 * NGW) { const int it2 = it + NGW, it3 = it + 2 * NGW;
            if (it2 < NI) P0_X_LOAD(it2, vb2);
            P0_X_FIN(it, va);
            if (it3 < NI) P0_X_LOAD(it3, va);
            if (it2 < NI) P0_X_FIN(it2, vb2); } }
#undef P0_X_LOAD
#undef P0_X_FIN
#undef P0_X_ARGS
}
__device__ __forceinline__ void phase0(Frame& F, const Args& a) {
    const float* x = a.in[0]; const float* n1 = a.in[1]; const float* w_in = a.in[2]; const float* w_out = a.in[10]; const float* n2 = a.in[11];
    const float* w_r = a.in[12]; const float* w_gu = a.in[14]; const float* w_dn = a.in[16];
    bf16* Win_t = (bf16*)(F.ws + WS_WIN); bf16* Wout_t = (bf16*)(F.ws + WS_WOUT); bf16* Wgu_t = (bf16*)(F.ws + WS_WGU); bf16* Wdn_t = (bf16*)(F.ws + WS_WDN);
    float* wrT = (float*)(F.ws + WS_WRT); bf16* XN = (bf16*)(F.ws + WS_XN); float* BA = (float*)(F.ws + WS_BA);
    LAS float* scr = (LAS float*)(F.lds + F.wave * 8448);
    const int gw = F.vcu * NWAVES + F.wave, NGW = F.G * NWAVES;
    { bf16* wrh = (bf16*)wrT; bf16* wrl = wrh + NE * D;
      for (int i = (F.vcu * NTHREADS + F.tid); i < NE * D; i += F.G * NTHREADS) { const int e = i >> 10, k = i & 1023; const float w = n2[k] * w_r[k * NE + e];
          const unsigned hi = pk2(w, 0.f) & 0xffffu; const float lo = w - __uint_as_float(hi << 16); wrh[i] = (bf16)hi; wrl[i] = (bf16)(pk2(lo, 0.f) & 0xffffu); } }
    constexpr int I_IN = 16 * (NIN / 32), I_OUT = 16 * 32;
    for (int it = gw; it < I_IN + I_OUT; it += NGW) {
        int r = it;
        if (r < I_IN) { const int nb = r % (NIN / 32), kb = r / (NIN / 32), np = 32 * nb; int src;
            src = np < 2048 ? np : np + 8;
            p0_transpose_item<false, false>(w_in, IN_DIM, src, Win_t + (size_t)np * 1024, 64 * kb, nullptr, scr, F.lane); continue; }
        r -= I_IN;
        { const int nb = r & 31, kb = r >> 5; p0_transpose_item<false, false>(w_out, D, 32 * nb, Wout_t + (size_t)(32 * nb) * 1024, 64 * kb, nullptr, scr, F.lane); }
    }
    __syncthreads();
    { LAS float* wb = (LAS float*)(F.lds + 69632);
        for (int k = F.tid; k < D; k += NTHREADS) { const float* wp = w_in + (size_t)k * IN_DIM + 2048; LAS float* dp = wb + (k >> 2) * 36 + (k & 3) * 8;
            *(LAS f32x4*)dp = *(const f32x4*)wp; *(LAS f32x4*)(dp + 4) = *(const f32x4*)(wp + 4); }
        __syncthreads();
        f32x4 n1v[4];
#pragma unroll
        for (int j = 0; j < 4; ++j) n1v[j] = *((const f32x4*)n1 + F.lane + 64 * j);
        for (int rep9 = 0; rep9 < (DUP == 9 ? 2 : 1); ++rep9)
        for (int m0 = gw * 4; m0 < T; m0 += NGW * 4) {
            f32x4 v[4][4]; float rs[4];
#pragma unroll
            for (int r = 0; r < 4; ++r)
#pragma unroll
                for (int j = 0; j < 4; ++j) v[r][j] = __builtin_nontemporal_load((const f32x4*)(x + (size_t)(m0 + r) * D) + F.lane + 64 * j);
#pragma unroll
            for (int r = 0; r < 4; ++r) { float sq = 0.f;
#pragma unroll
                for (int j = 0; j < 4; ++j) sq += (v[r][j][0] * v[r][j][0] + v[r][j][1] * v[r][j][1]) + (v[r][j][2] * v[r][j][2] + v[r][j][3] * v[r][j][3]);
                rs[r] = rsqrtf(wave_sum(sq) * (1.f / D) + EPS); }
            float ba[4][8];
#pragma unroll
            for (int r = 0; r < 4; ++r)
#pragma unroll
                for (int c = 0; c < 8; ++c) ba[r][c] = 0.f;
#pragma unroll
            for (int j = 0; j < 4; ++j) {
#pragma unroll
                for (int r = 0; r < 4; ++r) { v[r][j] = v[r][j] * rs[r] * n1v[j];
                    *((unsigned long long*)(XN + (size_t)(m0 + r) * D) + F.lane + 64 * j) = (unsigned long long)pk2(v[r][j][0], v[r][j][1]) | ((unsigned long long)pk2(v[r][j][2], v[r][j][3]) << 32); }
#pragma unroll
                for (int i = 0; i < 4; ++i) { const LAS float* wp = wb + (F.lane + 64 * j) * 36 + i * 8; const f32x4 w0 = *(const LAS f32x4*)wp, w1 = *(const LAS f32x4*)(wp + 4);
#pragma unroll
                    for (int r = 0; r < 4; ++r) { const float xv = v[r][j][i];
                        ba[r][0] += xv * w0[0]; ba[r][1] += xv * w0[1]; ba[r][2] += xv * w0[2]; ba[r][3] += xv * w0[3];
                        ba[r][4] += xv * w1[0]; ba[r][5] += xv * w1[1]; ba[r][6] += xv * w1[2]; ba[r][7] += xv * w1[3]; } } }
#pragma unroll
            for (int r = 0; r < 4; ++r) {
#pragma unroll
                for (int c = 0; c < 8; ++c) ba[r][c] = wave_sum(ba[r][c]);
                if (F.lane == 0) { *(f32x4*)(BA + (size_t)(m0 + r) * 8) = (f32x4){ba[r][0], ba[r][1], ba[r][2], ba[r][3]}; *(f32x4*)(BA + (size_t)(m0 + r) * 8 + 4) = (f32x4){ba[r][4], ba[r][5], ba[r][6], ba[r][7]}; } }
        }
        __syncthreads();
    }
}

constexpr int GP = 132;
constexpr int GQ_OFF = 0, GK_OFF = 64 * GP * 4, GV_OFF = 2 * 64 * GP * 4, GW_OFF = 3 * 64 * GP * 4, GAT_OFF = 4 * 64 * GP * 4, GAT_P = 68;
constexpr int GRAW_OFF = GW_OFF, GRAW_BYTES = 67 * 768;
constexpr int GGC_OFF = GRAW_OFF + GRAW_BYTES, GBETA_OFF = GGC_OFF + 256, GDM_OFF = GBETA_OFF + 256, GEND = GDM_OFF + 4096;
static_assert(GAT_OFF + 64 * GAT_P * 4 <= GGC_OFF && GEND <= TOP_OFF, "gdn prep LDS");
__device__ __forceinline__ int permpos(int cc) { return 8 * ((cc & 15) >> 2) + (cc & 3) + 4 * (cc >> 4); }
constexpr int GRAWN_OFF = 0, GRAW_BLOCKS = 51, GCWL_OFF = GRAW_BLOCKS * 1024, GCWL_BLOCKS = 6;
static_assert(GCWL_OFF + GCWL_BLOCKS * 1024 <= GV_OFF && 49152 + 1024 <= (int)CTL_ZERO_BYTES && (CW_BAR + XCD_BAR_WORDS) * 4 <= 49152, "prep staging regions");
__device__ __forceinline__ void gdn_prep_stage(Frame& F, const Args& a, int nu) {
    const bf16* zg = (const bf16*)(F.ws + WS_ZG); const float* convw = a.in[3]; const unsigned char* zero16 = (const unsigned char*)F.ctl + 49152 + F.lane * 16;
    const int nb = nu >> 8, nh = (nu >> 6) & 3, nn = nu & 63; const int nrow0 = nb * SEQ + nn * CHUNK, lane = F.lane; const unsigned lds0 = (unsigned)(uintptr_t)F.lds;
    for (int d = F.wave; d < GRAW_BLOCKS + GCWL_BLOCKS; d += NWAVES) {
        if (d < GRAW_BLOCKS) { int e = 64 * d + lane; e = e < 67 * 48 ? e : 67 * 48 - 1; const int rr = e / 48, ch = e % 48; const bool z = nn * CHUNK + rr - 3 < 0;
            const unsigned char* src = (const unsigned char*)(zg + (size_t)(z ? nrow0 : nrow0 + rr - 3) * 2048 + (ch >> 4) * 512 + nh * 128 + (ch & 15) * 8);
            glds16_asm(z ? zero16 : src, (unsigned)__builtin_amdgcn_readfirstlane((int)(lds0 + GRAWN_OFF + d * 1024)));
        } else { const int c = d - GRAW_BLOCKS, sg = 2 * c + (lane >> 5), ten = sg >> 2, k = sg & 3;
            glds16_asm(convw + k * 1536 + ten * 512 + nh * 128 + (lane & 31) * 4, (unsigned)__builtin_amdgcn_readfirstlane((int)(lds0 + GCWL_OFF + c * 1024))); }
    }
}
__device__ __forceinline__ void gdn_prep_gates(Frame& F, const Args& a, int h, float gate_bl, float gate_al) {
    const float* a_log = a.in[4]; const float* dt_bias = a.in[5]; LAS float* gcs = (LAS float*)(F.lds + GGC_OFF); LAS float* betas = (LAS float*)(F.lds + GBETA_OFF); const int lane = F.lane;
    const float xx = gate_al + dt_bias[h]; const float sp = xx > 20.f ? xx : log1pf(__expf(xx));
    float g = -__expf(a_log[h]) * sp;
    g += dpp_mov<0x111>(g); g += dpp_mov<0x112>(g); g += dpp_mov<0x114>(g); g += dpp_mov<0x118>(g);
    const int gi_ = __builtin_bit_cast(int, g); const float t0_ = __builtin_bit_cast(float, __builtin_amdgcn_readlane(gi_, 15)), t1_ = __builtin_bit_cast(float, __builtin_amdgcn_readlane(gi_, 31)), t2_ = __builtin_bit_cast(float, __builtin_amdgcn_readlane(gi_, 47)); const int rw = lane >> 4;
    g += (rw >= 1 ? t0_ : 0.f) + (rw >= 2 ? t1_ : 0.f) + (rw >= 3 ? t2_ : 0.f);
    gcs[lane] = g; betas[lane] = sigmoid_f(gate_bl);
}
__device__ __forceinline__ void gdn_prep_unit(Frame& F, const Args& a, int unit, int next_unit, bool first) {
    const float* BA = (const float*)(F.ws + WS_BA);
    const int b = unit >> 8, h = (unit >> 6) & 3, n = unit & 63; const int row0 = b * SEQ + n * CHUNK;
    unsigned char* rec = F.ws + WS_PREP + (size_t)unit * PREP_REC;
    LAS float* Qs = (LAS float*)(F.lds + GQ_OFF); LAS float* Ks = (LAS float*)(F.lds + GK_OFF); LAS float* Vs = (LAS float*)(F.lds + GV_OFF); LAS float* Ws = (LAS float*)(F.lds + GW_OFF);
    LAS float* AT = (LAS float*)(F.lds + GAT_OFF); LAS float* gcs = (LAS float*)(F.lds + GGC_OFF); LAS float* betas = (LAS float*)(F.lds + GBETA_OFF);
    const LAS unsigned char* raw = F.lds + GRAWN_OFF; const LAS float* cwl = (const LAS float*)(F.lds + GCWL_OFF);
    const int tid = F.tid, lane = F.lane, wave = F.wave;
    if (first) { gdn_prep_stage(F, a, unit); if (wave == 0) gdn_prep_gates(F, a, h, BA[(size_t)(row0 + lane) * 8 + h], BA[(size_t)(row0 + lane) * 8 + 4 + h]); }
    VM_WAIT(); LDS_BARRIER();
    float qv[8][2], kv[8][2]; const int t0 = 8 * wave;
    {
#pragma unroll
        for (int ten = 0; ten < 3; ++ten) { const int cp = ten * 64 + lane;
            f32x2 cw[4];
#pragma unroll
            for (int k = 0; k < 4; ++k) cw[k] = *(const LAS f32x2*)(cwl + (ten * 4 + k) * 128 + 2 * lane);
            f32x2 xs[11];
#pragma unroll
            for (int k = 0; k < 11; ++k) { const unsigned w = *(const LAS unsigned*)(raw + (t0 + k) * 768 + cp * 4); xs[k] = (f32x2){bflo(w), bfhi(w)}; }
#pragma unroll
            for (int j = 0; j < 8; j += 2) { f32x2 c0 = xs[j] * cw[0], c1 = xs[j + 1] * cw[0];
#pragma unroll
                for (int k = 1; k < 4; ++k) { c0 += xs[j + k] * cw[k]; c1 += xs[j + 1 + k] * cw[k]; }
                const f32x4 sv = silu4((f32x4){c0[0], c0[1], c1[0], c1[1]});
#pragma unroll
                for (int jj = 0; jj < 2; ++jj) { const float a0 = sv[2 * jj], a1 = sv[2 * jj + 1];
                    if (ten == 0) { qv[j + jj][0] = a0; qv[j + jj][1] = a1; } else if (ten == 1) { kv[j + jj][0] = a0; kv[j + jj][1] = a1; }
                    else { const float bt = betas[t0 + j + jj]; *(LAS f32x2*)(Vs + (t0 + j + jj) * GP + 2 * lane) = (f32x2){a0 * bt, a1 * bt}; } } } }
    }
    LDS_BARRIER();
    {
        float ssum[16];
#pragma unroll
        for (int j = 0; j < 8; ++j) { ssum[j] = qv[j][0] * qv[j][0] + qv[j][1] * qv[j][1]; ssum[8 + j] = kv[j][0] * kv[j][0] + kv[j][1] * kv[j][1]; }
#pragma unroll
        for (int i = 0; i < 16; ++i) ssum[i] += dpp_mov<0xB1>(ssum[i]);
#pragma unroll
        for (int i = 0; i < 16; ++i) ssum[i] += dpp_mov<0x4E>(ssum[i]);
#pragma unroll
        for (int i = 0; i < 16; ++i) ssum[i] += dpp_mov<0x141>(ssum[i]);
#pragma unroll
        for (int i = 0; i < 16; ++i) ssum[i] += dpp_mov<0x140>(ssum[i]);
#pragma unroll
        for (int i = 0; i < 16; ++i) ssum[i] = sum_xor16(ssum[i]);
#pragma unroll
        for (int i = 0; i < 16; ++i) ssum[i] = sum_xor32(ssum[i]);
#pragma unroll
        for (int j = 0; j < 8; ++j) { const int t = t0 + j; const float fq_ = rsqrtf(ssum[j] + EPS) * 0.08838834764831845f, fk_ = rsqrtf(ssum[8 + j] + EPS); const float eg = betas[t] * __expf(gcs[t]);
            const f32x2 kk = (f32x2){kv[j][0] * fk_, kv[j][1] * fk_};
            *(LAS f32x2*)(Qs + t * GP + 2 * lane) = (f32x2){qv[j][0] * fq_, qv[j][1] * fq_}; *(LAS f32x2*)(Ks + t * GP + 2 * lane) = kk; *(LAS f32x2*)(Ws + t * GP + 2 * lane) = kk * eg; }
    }
    LDS_BARRIER();
    {
        const int which = wave >> 2, ti = (wave >> 1) & 1, tj = wave & 1, r32 = lane & 31, hh = lane >> 5;
        const LAS float* Xa = (which ? Ks + (32 * tj + r32) * GP : Ks + (32 * ti + r32) * GP) + 8 * hh; const LAS float* Xb = (which ? Qs + (32 * ti + r32) * GP : Ks + (32 * tj + r32) * GP) + 8 * hh;
        f32x16 acc = {};
#pragma unroll
        for (int ks = 0; ks < 8; ++ks) { const bf16x8 af = pack8(*(const LAS f32x4*)(Xa + 16 * ks), *(const LAS f32x4*)(Xa + 16 * ks + 4)), bf = pack8(*(const LAS f32x4*)(Xb + 16 * ks), *(const LAS f32x4*)(Xb + 16 * ks + 4));
            acc = __builtin_amdgcn_mfma_f32_32x32x16_bf16(af, bf, acc, 0, 0, 0); }
        if (which == 0) {
            const int j = 32 * tj + r32; const float gj = gcs[j];
#pragma unroll
            for (int q = 0; q < 4; ++q) { float vals[4];
#pragma unroll
                for (int rr = 0; rr < 4; ++rr) { const int i = 32 * ti + 8 * q + 4 * hh + rr; const float dec = __expf(fminf(gcs[i] - gj, 0.f)); vals[rr] = i > j ? betas[i] * acc[4 * q + rr] * dec : 0.f; }
                *(LAS f32x4*)(AT + j * GAT_P + 32 * ti + 8 * q + 4 * hh) = (f32x4){vals[0], vals[1], vals[2], vals[3]}; }
        } else {
            const int i = 32 * ti + r32; const float gi = gcs[i]; bf16* Af = (bf16*)(rec + PREP_AP) + (i >> 4) * 1024 + (i & 15) * 8 + tj * 512;
#pragma unroll
            for (int q = 0; q < 4; ++q) { float vals[4]; const int cc0 = 8 * q + 4 * hh;
#pragma unroll
                for (int rr = 0; rr < 4; ++rr) { const int j = 32 * tj + cc0 + rr; const float dec = __expf(fminf(gi - gcs[j], 0.f)); vals[rr] = i >= j ? acc[4 * q + rr] * dec : 0.f; }
                const int jpos = permpos(cc0); *(u32x2*)(Af + (jpos >> 3) * 128 + (jpos & 7)) = (u32x2){pk2(vals[0], vals[1]), pk2(vals[2], vals[3])}; }
        }
    }
    LDS_BARRIER();
    LAS float* Dm = (LAS float*)(F.lds + GDM_OFF);
    if (wave < 4) {
        if (lane < 16) { const int i0 = 16 * wave; float r[16];
#pragma unroll
            for (int ii = 0; ii < 16; ++ii) r[ii] = (ii == lane) ? 1.f : 0.f;
#pragma unroll
            for (int j = 0; j < 16; ++j) { const float xj = r[j]; const LAS f32x4* ap = (const LAS f32x4*)(AT + (i0 + j) * GAT_P + i0); float av[16];
#pragma unroll
                for (int q = 0; q < 4; ++q) { const f32x4 t4 = ap[q]; av[4 * q] = t4[0]; av[4 * q + 1] = t4[1]; av[4 * q + 2] = t4[2]; av[4 * q + 3] = t4[3]; }
#pragma unroll
                for (int ii = 0; ii < 16; ++ii) if (ii > j) r[ii] -= av[ii] * xj; }
#pragma unroll
            for (int ii = 0; ii < 16; ++ii) Dm[wave * 256 + ii * 16 + lane] = r[ii]; }
    } else {
        const int t2 = tid - 256; bf16* Qf = (bf16*)(rec + PREP_QP); bf16* Kf = (bf16*)(rec + PREP_KT); const float gl = gcs[63];
        for (int it = t2; it < 1024; it += 256) { const int blk = it >> 6, l = it & 63, mi = blk >> 2, ks = blk & 3, g = l >> 4, c = 16 * mi + (l & 15); const float eg = __expf(gcs[c]);
            const f32x4 lo = *(LAS f32x4*)(Qs + c * GP + 32 * ks + 4 * g) * eg, hi = *(LAS f32x4*)(Qs + c * GP + 32 * ks + 16 + 4 * g) * eg;
            __builtin_nontemporal_store(pack8(lo, hi), (bf16x8*)(Qf + it * 8)); }
        for (int it = t2; it < 1024; it += 256) { const int blk = it >> 6, l = it & 63, ti = blk >> 1, ks2 = blk & 1, g = l >> 4, dk = 16 * ti + (l & 15); float v[8];
#pragma unroll
            for (int j = 0; j < 8; ++j) { const int c = 32 * ks2 + (j < 4 ? 4 * g + j : 16 + 4 * g + (j - 4)); v[j] = Ks[c * GP + dk] * __expf(gl - gcs[c]); }
            __builtin_nontemporal_store(pack8((f32x4){v[0], v[1], v[2], v[3]}, (f32x4){v[4], v[5], v[6], v[7]}), (bf16x8*)(Kf + it * 8)); }
        if (t2 == 0) *(float*)(rec + PREP_CD) = __expf(gl);
    }
    LDS_BARRIER();
    float ngl = 0.f, nal = 0.f; const int nh_ = (next_unit >> 6) & 3;
    if (next_unit >= 0) { gdn_prep_stage(F, a, next_unit);
        if (wave == 0) { const int nrow0 = (next_unit >> 8) * SEQ + (next_unit & 63) * CHUNK; ngl = BA[(size_t)(nrow0 + lane) * 8 + nh_]; nal = BA[(size_t)(nrow0 + lane) * 8 + 4 + nh_]; } }
    {
        const int fr = lane & 15, g = lane >> 4;
#pragma unroll 1
        for (int bb = 0; bb < 4; ++bb) {
            const int i0 = 16 * bb;
            bf16x8 Af[2];
#pragma unroll
            for (int ks = 0; ks < 2; ++ks) { float av[8];
#pragma unroll
                for (int j = 0; j < 8; ++j) { const int kr = 32 * ks + 8 * g + j; av[j] = kr < i0 ? -AT[kr * GAT_P + i0 + fr] : 0.f; }
                Af[ks] = pack8((f32x4){av[0], av[1], av[2], av[3]}, (f32x4){av[4], av[5], av[6], av[7]}); }
            const f32x4 dv4 = *(const LAS f32x4*)(Dm + bb * 256 + fr * 16 + 4 * g);
            const bf16x8 Df = pack8(dv4, (f32x4){0.f, 0.f, 0.f, 0.f});
#pragma unroll
            for (int nt = 0; nt < 2; ++nt) { const int col = 32 * wave + 16 * nt + fr; LAS float* X = (col < 128 ? Vs + col : Ws + (col - 128));
                f32x4 acc;
#pragma unroll
                for (int rg = 0; rg < 4; ++rg) acc[rg] = X[(i0 + 4 * g + rg) * GP];
                if (bb > 0) {
#pragma unroll
                    for (int ks = 0; ks < 2; ++ks) { if (32 * ks < i0) { float xv[8];
#pragma unroll
                        for (int j = 0; j < 8; ++j) xv[j] = X[(32 * ks + 8 * g + j) * GP];
                        acc = __builtin_amdgcn_mfma_f32_16x16x32_bf16(Af[ks], pack8((f32x4){xv[0], xv[1], xv[2], xv[3]}, (f32x4){xv[4], xv[5], xv[6], xv[7]}), acc, 0, 0, 0); } } }
                const f32x4 xb = __builtin_amdgcn_mfma_f32_16x16x32_bf16(Df, pack8(acc, (f32x4){0.f, 0.f, 0.f, 0.f}), (f32x4){0.f, 0.f, 0.f, 0.f}, 0, 0, 0);
#pragma unroll
                for (int rg = 0; rg < 4; ++rg) X[(i0 + 4 * g + rg) * GP] = xb[rg]; }
        }
    }
    LDS_BARRIER();
    { float* Up = (float*)(rec + PREP_UP); bf16* Wf = (bf16*)(rec + PREP_WP);
        for (int it = tid; it < 2048; it += NTHREADS) { const int dv = it & 127, g = (it >> 7) & 3, mi = it >> 9; const int c0 = 16 * mi + 4 * g;
            __builtin_nontemporal_store((f32x4){Vs[c0 * GP + dv], Vs[(c0 + 1) * GP + dv], Vs[(c0 + 2) * GP + dv], Vs[(c0 + 3) * GP + dv]}, (f32x4*)(Up + (size_t)it * 4)); }
        for (int it = tid; it < 1024; it += NTHREADS) { const int blk = it >> 6, l = it & 63, mi = blk >> 2, ks = blk & 3, g = l >> 4, c = 16 * mi + (l & 15);
            __builtin_nontemporal_store(pack8(*(LAS f32x4*)(Ws + c * GP + 32 * ks + 4 * g), *(LAS f32x4*)(Ws + c * GP + 32 * ks + 16 + 4 * g)), (bf16x8*)(Wf + it * 8)); }
    }
    if (next_unit >= 0 && wave == 0) gdn_prep_gates(F, a, nh_, ngl, nal);
}

constexpr int SC_BUFSZ = 57344, SC_OT = 2 * SC_BUFSZ, SC_OTSZ = 64 * 128 * 2, SC_END = SC_OT + 2 * SC_OTSZ;
static_assert(SC_END <= TOP_OFF, "scan LDS");
__device__ __forceinline__ void gdn_scan(Frame& F, const Args& a, int bh) {
    const int tid = F.tid, lane = F.lane, w = F.wave, fr = lane & 15, g = lane >> 4; const int b = bh >> 2, h = bh & 3;
    const unsigned char* rec0 = F.ws + WS_PREP + (size_t)bh * NCHUNK * PREP_REC;
    const float* gnw = a.in[6]; const bf16* zg = (const bf16*)(F.ws + WS_ZG); bf16* mix = (bf16*)(F.ws + WS_MIX);
    const size_t rowb = (size_t)b * SEQ; const unsigned lds0 = (unsigned)(uintptr_t)F.lds;
    if (w >= 4) {
        const int hw = w - 4, l16 = lane & 15, rq = lane >> 4;
#define SC_DMA(n_, buf_) do { const unsigned char* src_ = rec0 + (size_t)(n_) * PREP_REC + hw * 14336 + lane * 16; _Pragma("unroll") for (int r_ = 0; r_ < 14; ++r_) \
        glds16_asm_nt(src_ + r_ * 1024, (unsigned)__builtin_amdgcn_readfirstlane((int)(lds0 + (buf_) * SC_BUFSZ + hw * 14336 + r_ * 1024))); } while (0)
#define SC_NORM(n_, gv) do { const LAS unsigned char* ot = F.lds + SC_OT + ((n_) & 1) * SC_OTSZ; _Pragma("unroll") for (int q_ = 0; q_ < 4; ++q_) { const int t = 16 * hw + 4 * q_ + rq; \
            const u32x4 ov = *(const LAS u32x4*)(ot + t * 256 + l16 * 16); const f32x4 xa = {bflo(ov.x), bfhi(ov.x), bflo(ov.y), bfhi(ov.y)}, xb = {bflo(ov.z), bfhi(ov.z), bflo(ov.w), bfhi(ov.w)}; \
            float ss_ = (xa[0] * xa[0] + xa[1] * xa[1]) + (xa[2] * xa[2] + xa[3] * xa[3]) + (xb[0] * xb[0] + xb[1] * xb[1]) + (xb[2] * xb[2] + xb[3] * xb[3]); \
            ss_ = sum_row16(ss_); const float sc = rsqrtf(ss_ * (1.f / 128.f) + EPS); \
            const u32x4 gz = gv[q_]; const f32x4 ga = {bflo(gz.x), bfhi(gz.x), bflo(gz.y), bfhi(gz.y)}, gb = {bflo(gz.z), bfhi(gz.z), bflo(gz.w), bfhi(gz.w)}; \
            *(bf16x8*)(mix + (rowb + (n_) * CHUNK + t) * 1024 + h * 128 + 8 * l16) = pack8(xa * sc * ga, xb * sc * gb); } } while (0)
        u32x4 gc_[4], gn_[4];
        SC_DMA(0, 0);
#pragma unroll
        for (int q = 0; q < 4; ++q) gc_[q] = (u32x4){0u, 0u, 0u, 0u};
        VM_WAIT(); __syncthreads();
#pragma unroll 1
        for (int n = 0; n < NCHUNK; ++n) {
#pragma unroll
            for (int q = 0; q < 4; ++q) gn_[q] = *(const u32x4*)(zg + (rowb + n * CHUNK + 16 * hw + 4 * q + rq) * 2048 + 1536 + h * 128 + 8 * l16);
            if (n + 1 < NCHUNK) SC_DMA(n + 1, (n + 1) & 1);
            if (n > 0) SC_NORM(n - 1, gc_);
            VM_WAIT(); __syncthreads();
#pragma unroll
            for (int q = 0; q < 4; ++q) gc_[q] = gn_[q];
        }
        SC_NORM(NCHUNK - 1, gc_);
#undef SC_DMA
#undef SC_NORM
    } else {
        f32x4 S[2][8];
#pragma unroll
        for (int sl = 0; sl < 2; ++sl)
#pragma unroll
            for (int i = 0; i < 8; ++i) S[sl][i] = (f32x4){0.f, 0.f, 0.f, 0.f};
        f32x4 Un[2][4]; float cd = *(const float*)(rec0 + PREP_CD), cdn;
#pragma unroll
        for (int sl = 0; sl < 2; ++sl)
#pragma unroll
            for (int mi = 0; mi < 4; ++mi) Un[sl][mi] = __builtin_nontemporal_load((const f32x4*)((const float*)(rec0 + PREP_UP) + (size_t)((mi * 4 + g) * 128 + 32 * w + 16 * sl + fr) * 4));
        __syncthreads();
#pragma unroll 1
        for (int n = 0; n < NCHUNK; ++n) {
            const LAS unsigned char* B = F.lds + (n & 1) * SC_BUFSZ + lane * 16;
            f32x4 vn[2][4], o[2][4];
            { bf16x8 Sb[2][4];
#pragma unroll
                for (int sl = 0; sl < 2; ++sl)
#pragma unroll
                    for (int ks = 0; ks < 4; ++ks) Sb[sl][ks] = pack8(S[sl][2 * ks], S[sl][2 * ks + 1]);
#pragma unroll
                for (int mi = 0; mi < 4; ++mi) { f32x4 t1[2], oo[2];
#pragma unroll
                    for (int sl = 0; sl < 2; ++sl) { t1[sl] = (f32x4){0.f, 0.f, 0.f, 0.f}; oo[sl] = (f32x4){0.f, 0.f, 0.f, 0.f}; }
#pragma unroll
                    for (int ks = 0; ks < 4; ++ks) { const bf16x8 wf = *(const LAS bf16x8*)(B + PREP_WP + (mi * 4 + ks) * 1024), qf = *(const LAS bf16x8*)(B + PREP_QP + (mi * 4 + ks) * 1024);
#pragma unroll
                        for (int sl = 0; sl < 2; ++sl) { t1[sl] = __builtin_amdgcn_mfma_f32_16x16x32_bf16(wf, Sb[sl][ks], t1[sl], 0, 0, 0); oo[sl] = __builtin_amdgcn_mfma_f32_16x16x32_bf16(qf, Sb[sl][ks], oo[sl], 0, 0, 0); } }
#pragma unroll
                    for (int sl = 0; sl < 2; ++sl) { vn[sl][mi] = Un[sl][mi] - t1[sl]; o[sl][mi] = oo[sl]; } } }
            { const int nn = n + 1 < NCHUNK ? n + 1 : n; cdn = *(const float*)(rec0 + (size_t)nn * PREP_REC + PREP_CD);
#pragma unroll
                for (int sl = 0; sl < 2; ++sl)
#pragma unroll
                    for (int mi = 0; mi < 4; ++mi) Un[sl][mi] = __builtin_nontemporal_load((const f32x4*)((const float*)(rec0 + (size_t)nn * PREP_REC + PREP_UP) + (size_t)((mi * 4 + g) * 128 + 32 * w + 16 * sl + fr) * 4)); }
            bf16x8 Vb[2][2];
#pragma unroll
            for (int sl = 0; sl < 2; ++sl)
#pragma unroll
                for (int ks = 0; ks < 2; ++ks) Vb[sl][ks] = pack8(vn[sl][2 * ks], vn[sl][2 * ks + 1]);
#pragma unroll
            for (int mi = 0; mi < 4; ++mi) {
#pragma unroll
                for (int ks = 0; ks < 2; ++ks) { const bf16x8 af = *(const LAS bf16x8*)(B + PREP_AP + (mi * 2 + ks) * 1024);
#pragma unroll
                    for (int sl = 0; sl < 2; ++sl) o[sl][mi] = __builtin_amdgcn_mfma_f32_16x16x32_bf16(af, Vb[sl][ks], o[sl][mi], 0, 0, 0); }
#pragma unroll
                for (int sl = 0; sl < 2; ++sl) { LAS bf16* otw = (LAS bf16*)(F.lds + SC_OT + (n & 1) * SC_OTSZ) + 32 * w + 16 * sl + fr;
                    const unsigned p01 = pk2(o[sl][mi][0], o[sl][mi][1]), p23 = pk2(o[sl][mi][2], o[sl][mi][3]);
                    otw[(16 * mi + 4 * g) * 128] = (bf16)(p01 & 0xffffu); otw[(16 * mi + 4 * g + 1) * 128] = (bf16)(p01 >> 16); otw[(16 * mi + 4 * g + 2) * 128] = (bf16)(p23 & 0xffffu); otw[(16 * mi + 4 * g + 3) * 128] = (bf16)(p23 >> 16); } }
#pragma unroll
            for (int ti = 0; ti < 8; ++ti) { f32x4 s0 = S[0][ti] * cd, s1 = S[1][ti] * cd;
#pragma unroll
                for (int ks = 0; ks < 2; ++ks) { const bf16x8 kf = *(const LAS bf16x8*)(B + PREP_KT + (ti * 2 + ks) * 1024);
                    s0 = __builtin_amdgcn_mfma_f32_16x16x32_bf16(kf, Vb[0][ks], s0, 0, 0, 0); s1 = __builtin_amdgcn_mfma_f32_16x16x32_bf16(kf, Vb[1][ks], s1, 0, 0, 0); }
                S[0][ti] = s0; S[1][ti] = s1; }
            __syncthreads();
            cd = cdn;
        }
    }
    __syncthreads();
}

constexpr int AT_K = 0, AT_V = 49152, AT_BIAS = 98304, AT_LW = 98304 + 1024, AT_END = AT_LW + 1024;
constexpr size_t WS_P4 = 616 * MiB, WS_P16 = 648 * MiB, WS_L4 = 744 * MiB, WS_L16 = 745 * MiB;
static_assert(WS_P16 + (size_t)T * 512 * 2 <= WS_MIX && WS_L16 + (size_t)T * 8 * 4 <= WS_XN, "attention partial buffers");
__device__ __forceinline__ void attn_unit(Frame& F, const Args& a, int u) {
    int kind, b, h, r, q0;
    if (u < 1024) { kind = 2; b = u >> 7; h = (u >> 4) & 7; r = u & 15; q0 = 0; }
    else if (u < 2048) { const int v = u - 1024; kind = 1; b = v >> 7; h = (v >> 4) & 7; r = (v >> 2) & 3; q0 = (v & 3) * 256; }
    else { const int v = u - 2048; kind = 0; b = v >> 7; h = (v >> 4) & 7; r = 0; q0 = (v & 15) * 256; }
    const int dsh = 2 * kind, lmax = (SEQ >> dsh) - 1;
    const bf16* qb = (const bf16*)(F.ws + WS_QB); const bf16* kb = (const bf16*)(F.ws + WS_KB); const bf16* vb = (const bf16*)(F.ws + WS_VB); bf16* mix = (bf16*)(F.ws + WS_MIX);
    const float* relb = a.in[9];
    LAS float* biasL = (LAS float*)(F.lds + AT_BIAS); LAS float* lw = (LAS float*)(F.lds + AT_LW) + F.wave * 32;
    const int tid = F.tid, lane = F.lane, w = F.wave, c = lane & 31, hh = lane >> 5;
    const size_t hrow = (size_t)(b * AH + h) * SEQ; const unsigned lds0 = (unsigned)(uintptr_t)F.lds;
    { const int ro = lane >> 3, p = lane & 7;
#pragma unroll
        for (int i = 0; i < 6; ++i) { const int lr = 48 * w + 8 * i + ro; int pos = q0 - 128 + lr; pos = pos < 0 ? 0 : (pos > lmax ? lmax : pos);
            const size_t eo = (hrow + (size_t)(pos << dsh) + r) * 64 + (size_t)((p ^ (lr & 7)) * 8);
            glds16_asm(kb + eo, (unsigned)__builtin_amdgcn_readfirstlane((int)(lds0 + AT_K + (48 * w + 8 * i) * 128)));
            glds16_asm(vb + eo, (unsigned)__builtin_amdgcn_readfirstlane((int)(lds0 + AT_V + (48 * w + 8 * i) * 128))); } }
    if (tid < 132) biasL[tid] = relb[(int)T5B[kind][tid] * AH + h] * LOG2E;
    const int qi = q0 + 32 * w + c;
    bf16x8 Qf[4];
    { const bf16* qp = qb + (hrow + (size_t)(qi << dsh) + r) * 64 + 8 * hh;
#pragma unroll
        for (int ks = 0; ks < 4; ++ks) Qf[ks] = *(const bf16x8*)(qp + 16 * ks); }
    VM_WAIT(); __syncthreads();
    f32x16 O0 = {}, O1 = {}; float lsum = 0.f;
    const int kt0 = (128 - q0 - 32 * w) > 0 ? ((128 - q0 - 32 * w) >> 5) : 0;
    const int li = lane & 15, gq = lane >> 4;
#pragma unroll 1
    for (int kt = kt0; kt < 5; ++kt) {
        const int lr0 = 32 * (w + kt);
        f32x16 sT = {};
        { const int lr = lr0 + c; const LAS unsigned char* kp = F.lds + AT_K + lr * 128;
#pragma unroll
            for (int ks = 0; ks < 4; ++ks) { const bf16x8 kf = *(const LAS bf16x8*)(kp + (((2 * ks + hh) ^ (lr & 7)) * 16)); sT = __builtin_amdgcn_mfma_f32_32x32x16_bf16(kf, Qf[ks], sT, 0, 0, 0); } }
        float p[16];
#pragma unroll
        for (int reg = 0; reg < 16; ++reg) { const int kr = (reg & 3) + 8 * (reg >> 2) + 4 * hh; const int s = 128 + c - 32 * kt - kr; const int kpos = q0 - 128 + lr0 + kr;
            const bool ok = (s >= 0) && (s <= 128) && (kpos >= 0); const int sc_ = s < 0 ? 0 : (s > 128 ? 128 : s);
            const float e = __builtin_amdgcn_exp2f(sT[reg] + biasL[sc_]); p[reg] = ok ? e : 0.f; lsum += p[reg]; }
        bf16x8 Pf[2];
#pragma unroll
        for (int s2 = 0; s2 < 2; ++s2) { u32x4 wv; wv.x = pk2(p[8 * s2], p[8 * s2 + 1]); wv.y = pk2(p[8 * s2 + 2], p[8 * s2 + 3]); wv.z = pk2(p[8 * s2 + 4], p[8 * s2 + 5]); wv.w = pk2(p[8 * s2 + 6], p[8 * s2 + 7]); Pf[s2] = __builtin_bit_cast(bf16x8, wv); }
#pragma unroll
        for (int s2 = 0; s2 < 2; ++s2)
#pragma unroll
            for (int ntl = 0; ntl < 2; ++ntl) {
                const int rowl = lr0 + 16 * s2 + 4 * hh + (li >> 2), rowh = rowl + 8; const int ch = 4 * ntl + 2 * (gq & 1) + ((li & 3) >> 1), sub = (li & 1) * 8;
                const s16x4 lo = __builtin_bit_cast(s16x4, __builtin_amdgcn_ds_read_tr16_b64_v4i16((LAS s16x4*)(F.lds + AT_V + rowl * 128 + ((ch ^ (rowl & 7)) * 16) + sub)));
                const s16x4 hi = __builtin_bit_cast(s16x4, __builtin_amdgcn_ds_read_tr16_b64_v4i16((LAS s16x4*)(F.lds + AT_V + rowh * 128 + ((ch ^ (rowh & 7)) * 16) + sub)));
                const bf16x8 vf = (bf16x8){lo[0], lo[1], lo[2], lo[3], hi[0], hi[1], hi[2], hi[3]};
                if (ntl == 0) O0 = __builtin_amdgcn_mfma_f32_32x32x16_bf16(Pf[s2], vf, O0, 0, 0, 0); else O1 = __builtin_amdgcn_mfma_f32_32x32x16_bf16(Pf[s2], vf, O1, 0, 0, 0);
            }
    }
    lsum = sum_xor32(lsum);
    if (hh == 0) lw[c] = lsum;
    LDS_BARRIER();
    { LAS float* ost = (LAS float*)(F.lds + w * 8192);
#pragma unroll
        for (int reg = 0; reg < 16; ++reg) { const int qrow = (reg & 3) + 8 * (reg >> 2) + 4 * hh; ost[qrow * 64 + c] = O0[reg]; ost[qrow * 64 + 32 + c] = O1[reg]; }
        LDS_WAIT();
        const int row = lane >> 1, half = lane & 1; const float l1 = lw[row]; const LAS f32x4* op = (const LAS f32x4*)(ost + row * 64 + 32 * half);
        const size_t tok = (size_t)b * SEQ + (size_t)((q0 + 32 * w + row) << dsh) + r;
        if (kind != 0) {
            bf16* pp = (bf16*)(F.ws + (kind == 1 ? WS_P4 : WS_P16)) + (tok * 8 + h) * 64 + 32 * half; const float inv = 1.f / l1;
#pragma unroll
            for (int q = 0; q < 4; ++q) *(bf16x8*)(pp + 8 * q) = pack8(op[2 * q] * inv, op[2 * q + 1] * inv);
            if (half == 0) ((float*)(F.ws + (kind == 1 ? WS_L4 : WS_L16)))[tok * 8 + h] = l1;
        } else {
            const bf16* p4 = (const bf16*)(F.ws + WS_P4) + (tok * 8 + h) * 64 + 32 * half; const bf16* p16 = (const bf16*)(F.ws + WS_P16) + (tok * 8 + h) * 64 + 32 * half;
            const float l4 = ((const float*)(F.ws + WS_L4))[tok * 8 + h], l16 = ((const float*)(F.ws + WS_L16))[tok * 8 + h]; const float inv = 1.f / (l1 + l4 + l16);
            bf16* dst = mix + tok * 1024 + 512 + h * 64 + 32 * half;
#pragma unroll
            for (int q = 0; q < 4; ++q) { const u32x4 a4 = *(const u32x4*)(p4 + 8 * q), a16 = *(const u32x4*)(p16 + 8 * q);
                const f32x4 x0 = (op[2 * q] + (f32x4){bflo(a4.x), bfhi(a4.x), bflo(a4.y), bfhi(a4.y)} * l4 + (f32x4){bflo(a16.x), bfhi(a16.x), bflo(a16.y), bfhi(a16.y)} * l16) * inv;
                const f32x4 x1 = (op[2 * q + 1] + (f32x4){bflo(a4.z), bfhi(a4.z), bflo(a4.w), bfhi(a4.w)} * l4 + (f32x4){bflo(a16.z), bfhi(a16.z), bflo(a16.w), bfhi(a16.w)} * l16) * inv;
                *(bf16x8*)(dst + 8 * q) = pack8(x0, x1); }
        }
    }
    LDS_BARRIER();
}

constexpr int RT_LCNT = 0, RT_BASE = 256, RT_RANK = 512;
__device__ __forceinline__ void route_phase(Frame& F, const Args& a) {
    const bf16* hsrc = (const bf16*)(F.ws + WS_HBF); const bf16* wrT = (const bf16*)(F.ws + WS_WRT); const float* b_r = a.in[13];
    int* te = (int*)(F.ws + WS_TE); int* tslot = (int*)(F.ws + WS_TSLOT); float* tg = (float*)(F.ws + WS_TG); int* list = (int*)(F.ws + WS_LIST); float* lrs = (float*)(F.ws + WS_LRS);
    LAS int* lcnt = (LAS int*)(F.lds + RT_LCNT); LAS int* lbase = (LAS int*)(F.lds + RT_BASE); LAS int* lrank = (LAS int*)(F.lds + RT_RANK);
    const int lane = F.lane, c = lane & 31, hh = lane >> 5;
    for (int blk = F.vcu; blk < T / 128; blk += F.G) {
        if (F.tid < 32) lcnt[F.tid] = 0;
        __syncthreads();
        int e4[4] = {0, 0, 0, 0}, rk[4] = {0, 0, 0, 0}; float g4[4] = {0.f, 0.f, 0.f, 0.f}; float rs = 0.f; const int tok = blk * 128 + (F.wave & 3) * 32 + c;
        f32x16 acc = {}; float ss = 0.f;
        { const int kh = F.wave >> 2; const bf16* hp = hsrc + (size_t)tok * D + 8 * hh + 512 * kh; const bf16* wph = (const bf16*)wrT + (size_t)c * D + 8 * hh + 512 * kh; const bf16* wpl = wph + NE * D;
#pragma unroll 8
            for (int q = 0; q < 32; ++q) { const u32x4 hr = *(const u32x4*)(hp + 16 * q); const bf16x8 wh = *(const bf16x8*)(wph + 16 * q), wl = *(const bf16x8*)(wpl + 16 * q);
                const f32x4 ha = {bflo(hr.x), bfhi(hr.x), bflo(hr.y), bfhi(hr.y)}, hb2 = {bflo(hr.z), bfhi(hr.z), bflo(hr.w), bfhi(hr.w)};
                ss += (ha[0] * ha[0] + ha[1] * ha[1]) + (ha[2] * ha[2] + ha[3] * ha[3]) + (hb2[0] * hb2[0] + hb2[1] * hb2[1]) + (hb2[2] * hb2[2] + hb2[3] * hb2[3]);
                const bf16x8 hv = __builtin_bit_cast(bf16x8, hr);
                acc = __builtin_amdgcn_mfma_f32_32x32x16_bf16(wh, hv, acc, 0, 0, 0); acc = __builtin_amdgcn_mfma_f32_32x32x16_bf16(wl, hv, acc, 0, 0, 0); }
            LAS float* px = (LAS float*)(F.lds + 4096) + ((F.wave & 3) * 64 + lane) * 17;
            if (F.wave >= 4) {
#pragma unroll
                for (int r = 0; r < 16; ++r) px[r] = acc[r];
                px[16] = ss; }
            __syncthreads();
            if (F.wave < 4) {
#pragma unroll
                for (int r = 0; r < 16; ++r) acc[r] += px[r];
                ss += px[16]; } }
        if (F.wave < 4) {
            ss = sum_xor32(ss); rs = rsqrtf(ss * (1.f / D) + EPS);
            float tv[4] = {-3.0e38f, -3.0e38f, -3.0e38f, -3.0e38f}; int tix[4] = {0, 1, 2, 3};
            f32x4 brv[4];
#pragma unroll
            for (int q = 0; q < 4; ++q) brv[q] = *(const f32x4*)(b_r + 8 * q + 4 * hh);
#pragma unroll
            for (int reg = 0; reg < 16; ++reg) { const int e = (reg & 3) + 8 * (reg >> 2) + 4 * hh; float v = acc[reg] * rs + brv[reg >> 2][reg & 3]; int ix = e;
#pragma unroll
                for (int s = 0; s < 4; ++s) { const bool gt = (v > tv[s]) || (v == tv[s] && ix < tix[s]); const float ov = tv[s]; const int oi = tix[s]; tv[s] = gt ? v : ov; tix[s] = gt ? ix : oi; v = gt ? ov : v; ix = gt ? oi : ix; } }
            float pv[4]; int pi[4];
#pragma unroll
            for (int s = 0; s < 4; ++s) { pv[s] = __shfl_xor(tv[s], 32); pi[s] = __shfl_xor(tix[s], 32); }
#pragma unroll
            for (int t2 = 0; t2 < 4; ++t2) { float v = pv[t2]; int ix = pi[t2];
#pragma unroll
                for (int s = 0; s < 4; ++s) { const bool gt = (v > tv[s]) || (v == tv[s] && ix < tix[s]); const float ov = tv[s]; const int oi = tix[s]; tv[s] = gt ? v : ov; tix[s] = gt ? ix : oi; v = gt ? ov : v; ix = gt ? oi : ix; } }
            const float e0 = 1.f, e1 = __expf(tv[1] - tv[0]), e2 = __expf(tv[2] - tv[0]), e3 = __expf(tv[3] - tv[0]); const float inv = 1.f / (e0 + e1 + e2 + e3);
            g4[0] = e0 * inv; g4[1] = e1 * inv; g4[2] = e2 * inv; g4[3] = e3 * inv;
#pragma unroll
            for (int s = 0; s < 4; ++s) e4[s] = tix[s];
            if (hh == 0) {
#pragma unroll
                for (int s = 0; s < 4; ++s) rk[s] = atomicAdd((int*)(lcnt + e4[s]), 1);
            }
        }
        __syncthreads();
        if (F.tid < 32) lbase[F.tid] = (int)__hip_atomic_fetch_add(F.ctl + CW_GCNT + 64 * F.tid, (unsigned)lcnt[F.tid], RLX_AGENT);
        __syncthreads();
        if (F.wave < 4 && hh == 0) {
#pragma unroll
            for (int s = 0; s < 4; ++s) { const int slot = lbase[e4[s]] + rk[s]; te[tok * 4 + s] = e4[s]; tslot[tok * 4 + s] = slot; tg[tok * 4 + s] = g4[s];
                list[(size_t)e4[s] * LCAP + slot] = tok; lrs[(size_t)e4[s] * LCAP + slot] = rs; }
        }
        __syncthreads();
    }
}
__device__ __forceinline__ int moe_tables(Frame& F) {
    LAS int* tstart = (LAS int*)(F.lds + MOE_TSTART); LAS int* lcnt = (LAS int*)(F.lds + MOE_LCNT); LAS int* texp = (LAS int*)(F.lds + MOE_TEXP);
    if (F.tid < 64) {
        const int lane = F.lane; const int cnt = lane < NE ? (int)__hip_atomic_load(F.ctl + CW_GCNT + 64 * (lane & 31), RLX_AGENT) : 0; const int nt = (cnt + 255) >> 8;
        int inc = nt;
#pragma unroll
        for (int o = 1; o < 32; o <<= 1) { const int up = __shfl_up(inc, o); if (lane >= o) inc += up; }
        if (lane < NE) { const int start = inc - nt; lcnt[lane] = cnt; tstart[lane] = start; for (int i = 0; i < nt; ++i) texp[start + i] = lane; if (lane == NE - 1) tstart[NE] = inc; }
    }
    __syncthreads();
    return tstart[NE];
}
__device__ __forceinline__ void combine_phase(Frame& F, const Args& a, float* dst) {
    LAS int* tstart = (LAS int*)(F.lds + MOE_TSTART);
    const int* te = (const int*)(F.ws + WS_TE); const int* tslot = (const int*)(F.ws + WS_TSLOT); const float* tg = (const float*)(F.ws + WS_TG); const unsigned char* Y = F.ws + WS_Y;
    const bf16* hbf = (const bf16*)(F.ws + WS_HBF); const int gw = F.vcu * NWAVES + F.wave, NGW = F.G * NWAVES, lane = F.lane;
    for (int t0 = gw * 16; t0 < T; t0 += NGW * 16) {
        int pos[4]; float gt[4];
        { const int tl = t0 + (lane & 15);
#pragma unroll
            for (int s = 0; s < 4; ++s) { const int e = te[tl * 4 + s]; pos[s] = tstart[e] * 256 + tslot[tl * 4 + s]; gt[s] = tg[tl * 4 + s]; } }
#pragma unroll 1
        for (int i = 0; i < 16; i += 2) {
            u32x2 hv[2][4]; unsigned yv[2][4][4];
#pragma unroll
            for (int q = 0; q < 2; ++q) { const bf16* hp = hbf + (size_t)(t0 + i + q) * D + 4 * lane;
#pragma unroll
                for (int j = 0; j < 4; ++j) hv[q][j] = __builtin_nontemporal_load((const u32x2*)(hp + 256 * j));
#pragma unroll
                for (int s = 0; s < 4; ++s) { const size_t p = (size_t)__builtin_amdgcn_readlane(pos[s], i + q);
#pragma unroll
                    for (int j = 0; j < 4; ++j) yv[q][s][j] = __builtin_nontemporal_load((const unsigned*)(Y + p * D + 256 * j + 4 * lane)); } }
#pragma unroll
            for (int q = 0; q < 2; ++q) { float* op = dst + (size_t)(t0 + i + q) * D + 4 * lane; float g[4];
#pragma unroll
                for (int s = 0; s < 4; ++s) g[s] = __builtin_bit_cast(float, __builtin_amdgcn_readlane(__builtin_bit_cast(int, gt[s]), i + q));
#pragma unroll
                for (int j = 0; j < 4; ++j) { f32x4 o = {bflo(hv[q][j].x), bfhi(hv[q][j].x), bflo(hv[q][j].y), bfhi(hv[q][j].y)};
#pragma unroll
                    for (int s = 0; s < 4; ++s) { const int ww = (int)yv[q][s][j]; const f32x2 lo = __builtin_amdgcn_cvt_pk_f32_fp8(ww, false), hi = __builtin_amdgcn_cvt_pk_f32_fp8(ww, true);
                        o += (f32x4){lo[0], lo[1], hi[0], hi[1]} * g[s]; }
                    __builtin_nontemporal_store(o, (f32x4*)(op + 256 * j)); } }
        }
    }
}

constexpr int NPHASE = 9;
__global__ void __launch_bounds__(NTHREADS, 2) hymba_fwd(Args args) {
    extern __shared__ __attribute__((aligned(16))) unsigned char lds_raw[];
    Frame F; F.lds = (LAS unsigned char*)lds_raw; F.ws = args.ws; F.ctl = (unsigned*)(args.ws + WS_CTL);
    F.tid = threadIdx.x; F.lane = F.tid & 63; F.wave = __builtin_amdgcn_readfirstlane(F.tid >> 6);
    F.G = gridDim.x; { const int bx = blockIdx.x; F.vcu = (F.G % 8 == 0) ? (bx % 8) * (F.G / 8) + bx / 8 : bx; }
    volatile LAS unsigned* MISC = (volatile LAS unsigned*)(F.lds + MISC_OFF);
    if (F.tid < 32) MISC[F.tid] = 0u;
    __syncthreads();
    XcdBarrier bar; bar.bar = F.ctl + CW_BAR; bar.x = 0; bar.st = nullptr;
    if (MK_N_LAUNCHES == 1) bar = xcd_barrier_post(F.ctl + CW_BAR, MISC + 8);
    const int lo = args.ph_lo, hi = args.ph_hi;
#define IN(k) (lo <= (k) && (k) < hi)
#define SEAM(k) do { if (IN(k) && IN((k) + 1)) xcd_barrier(bar); } while (0)

    if (IN(0)) { for (int rep = 0; rep < (DUP == 4 ? 2 : 1); ++rep) phase0(F, args); SEAM(0); }
    if (IN(1)) {
        pg8::Gemm g{(const bf16*)(F.ws + WS_XN), (const bf16*)(F.ws + WS_WIN), D}; pg8::StaticOrder S{T / 256, NIN / 256, F.G, (int)blockIdx.x};
        pg8::EpiInProj E{(bf16*)(F.ws + WS_ZG), (bf16*)(F.ws + WS_QB), (bf16*)(F.ws + WS_KB), (bf16*)(F.ws + WS_VB), args.in[7], args.in[8], F.lds + RING_BYTES, args.in[6]};
        pg8::gemm_phase<pg8::EpiInProj, pg8::StaticOrder, false, true, false, (DUP == 18 ? 2 : 1)>(F.lds, g, S, E);
#if DUP == 5
        __syncthreads(); pg8::gemm_phase<pg8::EpiInProj, pg8::StaticOrder, false, true>(F.lds, g, S, E);
#endif
        SEAM(1);
    }
    if (IN(2)) {
        for (int rep = 0; rep < (DUP == 1 ? 2 : 1); ++rep)
        for (int u = F.vcu; u < NBATCH * GH * NCHUNK; u += F.G) gdn_prep_unit(F, args, u, u + F.G < NBATCH * GH * NCHUNK ? u + F.G : -1, u == F.vcu);
        SEAM(2);
    }
    if (IN(3)) {
        const int nscan = NBATCH * GH;
        for (int rep3 = 0; rep3 < (DUP == 13 ? 2 : 1); ++rep3) {
        for (int bh = blockIdx.x; bh < nscan; bh += F.G) { gdn_scan(F, args, bh);
#if DUP == 3
            gdn_scan(F, args, bh);
#endif
        }
        if (rep3 == 0) { if (F.G > nscan) { if ((int)blockIdx.x >= nscan) { p0_experts(F, args, ((int)blockIdx.x - nscan) * NWAVES + F.wave, (F.G - nscan) * NWAVES);
#if DUP == 15
            __syncthreads(); p0_experts(F, args, ((int)blockIdx.x - nscan) * NWAVES + F.wave, (F.G - nscan) * NWAVES);
#endif
            } } else p0_experts(F, args, (int)blockIdx.x * NWAVES + F.wave, F.G * NWAVES); __syncthreads(); }
        int done_units = 0;
        for (int pass = 0; pass < 2; ++pass) {
            for (int rep = 0; rep < (DUP == 2 ? 2 : 1); ++rep)
            for (;;) {
                if (F.tid == 0) MISC[16] = __hip_atomic_fetch_add(F.ctl + CW_ATTQ + 64 * (pass + 2 * rep + 4 * rep3), 1u, RLX_AGENT);
                __syncthreads();
                const int u = (int)MISC[16] + (pass ? 2048 : 0);
                __syncthreads();
                if (u >= (pass ? 3072 : 2048)) break;
                attn_unit(F, args, u); if (pass == 0) ++done_units;
            }
            if (DUP == 13) xcd_barrier(bar);
            else if (pass == 0) {
                asm volatile("s_waitcnt vmcnt(0)" ::: "memory"); __syncthreads();
                if (F.tid == 0) { unsigned* dn = F.ctl + CW_DONE0;
                    if (done_units) { __builtin_amdgcn_fence(__ATOMIC_RELEASE, "agent"); asm volatile("s_waitcnt vmcnt(0)" ::: "memory"); (void)xb_add(dn, (unsigned)done_units); }
                    const unsigned target = 2048u * (DUP == 2 ? 2u : 1u);
                    XB_SPIN(xb_ld(dn) < target, bar.bar);
                    __builtin_amdgcn_fence(__ATOMIC_ACQUIRE, "agent"); asm volatile("s_waitcnt vmcnt(0)" ::: "memory"); }
                __syncthreads(); }
        } }
        SEAM(3);
    }
    if (IN(4)) {
        pg8::Gemm g{(const bf16*)(F.ws + WS_MIX), (const bf16*)(F.ws + WS_WOUT), D}; pg8::StaticOrder S{T / 256, D / 256, F.G, (int)blockIdx.x};
        pg8::EpiOutProj E{args.in[0], (bf16*)(F.ws + WS_HBF), F.ws + WS_HB, F.lds + RING_BYTES};
        pg8::gemm_phase<pg8::EpiOutProj, pg8::StaticOrder, false, true>(F.lds, g, S, E);
#if DUP == 6
        __syncthreads(); pg8::gemm_phase<pg8::EpiOutProj, pg8::StaticOrder, false, true>(F.lds, g, S, E);
#endif
        SEAM(4);
    }
#if !SKIP_MOE
    if (IN(5)) {
        if (DUP == 10) { route_phase(F, args); xcd_barrier(bar); if (blockIdx.x == 0 && F.tid < 32) __hip_atomic_store(F.ctl + CW_GCNT + 64 * F.tid, 0u, RLX_AGENT); xcd_barrier(bar); }
        route_phase(F, args); SEAM(5); }
    if (IN(6)) {
        const int nM = moe_tables(F);
        pg8::Gemm g{(const bf16*)(F.ws + WS_HB), (const bf16*)(F.ws + WS_WGU), D};
        pg8::MoeOrder S{nM, 8, F.G, (int)blockIdx.x, (const LAS int*)(F.lds + MOE_TSTART), (const LAS int*)(F.lds + MOE_LCNT), (const LAS int*)(F.lds + MOE_TEXP), (const int*)(F.ws + WS_LIST)};
        pg8::EpiGateUp E{F.ws + WS_ACT, args.in[15], (const float*)(F.ws + WS_LRS), (const LAS int*)(F.lds + MOE_LCNT), F.lds + RING_BYTES};
        pg8::gemm_phase<pg8::EpiGateUp, pg8::MoeOrder, true, true, true, (DUP == 17 ? 2 : 1)>(F.lds, g, S, E);
#if DUP == 7
        __syncthreads(); pg8::gemm_phase<pg8::EpiGateUp, pg8::MoeOrder, true, true, true>(F.lds, g, S, E);
#endif
        SEAM(6);
    }
    if (IN(7)) {
        const int nM = moe_tables(F);
        pg8::Gemm g{(const bf16*)(F.ws + WS_ACT), (const bf16*)(F.ws + WS_WDN), FF};
        pg8::MoeOrder S{nM, 4, F.G, (int)blockIdx.x, (const LAS int*)(F.lds + MOE_TSTART), (const LAS int*)(F.lds + MOE_LCNT), (const LAS int*)(F.lds + MOE_TEXP), (const int*)(F.ws + WS_LIST)};
        pg8::EpiDown E{F.ws + WS_Y, args.in[17], F.lds + RING_BYTES};
        pg8::gemm_phase<pg8::EpiDown, pg8::MoeOrder, false, true, true>(F.lds, g, S, E);
#if DUP == 8
        __syncthreads(); pg8::gemm_phase<pg8::EpiDown, pg8::MoeOrder, false, true, true>(F.lds, g, S, E);
#endif
        SEAM(7);
    }
#if DUP == 16
    if (IN(8)) { for (int i_ = 0; i_ < 8; ++i_) xcd_barrier(bar); }
#endif
    if (IN(8)) { (void)moe_tables(F); if (DUP == 11) combine_phase(F, args, (float*)(F.ws + WS_ZG)); combine_phase(F, args, args.out); }
#endif
#undef IN
#undef SEAM
}

extern "C" void kernel_launch(void* const* d_in, const int* in_sizes, int n_in, void* d_out, int out_size, void* d_ws, size_t ws_size, hipStream_t stream) {
    static int grid = 0;
    if (grid == 0) {
        if (n_in != 18 || in_sizes[0] != T * D || out_size != T * D || ws_size < WS_END) { fprintf(stderr, "kernel_launch: unexpected shapes (n_in %d, in0 %d, out %d, ws %zu)\n", n_in, n_in > 0 ? in_sizes[0] : -1, out_size, ws_size); grid = -1; return; }
        int dev = 0, cus = 0, per_cu = 0;
        if (hipGetDevice(&dev) != hipSuccess || hipDeviceGetAttribute(&cus, hipDeviceAttributeMultiprocessorCount, dev) != hipSuccess) { grid = -1; return; }
        if (hipFuncSetAttribute((const void*)hymba_fwd, hipFuncAttributeMaxDynamicSharedMemorySize, LDS_BYTES) != hipSuccess) { fprintf(stderr, "kernel_launch: hipFuncSetAttribute failed\n"); grid = -1; return; }
        if (hipOccupancyMaxActiveBlocksPerMultiprocessor(&per_cu, (const void*)hymba_fwd, NTHREADS, LDS_BYTES) != hipSuccess || per_cu < 1) { fprintf(stderr, "kernel_launch: occupancy query says %d\n", per_cu); per_cu = 1; }
        (void)hipGetLastError();
        grid = cus;
    }
    if (grid < 0) return;
    (void)hipMemsetAsync((char*)d_ws + WS_CTL, 0, CTL_ZERO_BYTES, stream);
    Args a{};
    for (int i = 0; i < 18; ++i) a.in[i] = (const float*)d_in[i];
    a.out = (float*)d_out; a.ws = (unsigned char*)d_ws;
    if (MK_N_LAUNCHES == 1) {
        a.ph_lo = 0; a.ph_hi = NPHASE; a.li = 0;
        void* kargs[] = {&a};
        hipError_t e = hipLaunchCooperativeKernel((const void*)hymba_fwd, dim3(grid), dim3(NTHREADS), kargs, LDS_BYTES, stream);
        if (e != hipSuccess) fprintf(stderr, "kernel_launch: cooperative launch failed: %s (grid %d)\n", hipGetErrorString(e), grid);
    } else {
        for (int p = 0; p < NPHASE; ++p) { a.ph_lo = p; a.ph_hi = p + 1; a.li = p; hipLaunchKernelGGL(hymba_fwd, dim3(grid), dim3(NTHREADS), LDS_BYTES, stream, a); }
    }
}
```

```cpp
#include <hip/hip_runtime.h>
#include <cstdio>
#include <cstdint>

#ifndef MK_N_LAUNCHES
#define MK_N_LAUNCHES 1
#endif
#ifndef WGM_IN
#define WGM_IN 4
#endif
#ifndef WGM_OUT
#define WGM_OUT 4
#endif
#ifndef WGM_GU
#define WGM_GU 8
#endif
#ifndef WGM_DN
#define WGM_DN 4
#endif
#ifndef SKIP_ATTN
#define SKIP_ATTN 0
#endif
#ifndef DUP
#define DUP 0
#endif
#ifndef ATT_JOBS
#define ATT_JOBS 32
#endif
#ifndef SKIP_MOE
#define SKIP_MOE 0
#endif

#define LAS __attribute__((address_space(3)))
#define GAS __attribute__((address_space(1)))
typedef unsigned short bf16;
typedef short bf16x8 __attribute__((ext_vector_type(8)));
typedef short s16x4 __attribute__((ext_vector_type(4)));
typedef float f32x2 __attribute__((ext_vector_type(2)));
typedef float f32x4 __attribute__((ext_vector_type(4)));
typedef float f32x16 __attribute__((ext_vector_type(16)));
typedef unsigned u32x2 __attribute__((ext_vector_type(2)));
typedef unsigned u32x4 __attribute__((ext_vector_type(4)));
typedef __bf16 bf16x2_t __attribute__((ext_vector_type(2)));
typedef int v4i_t __attribute__((ext_vector_type(4)));
typedef int v8i_t __attribute__((ext_vector_type(8)));

constexpr int NBATCH = 8, SEQ = 4096, D = 1024, T = NBATCH * SEQ;
constexpr int IN_DIM = 3592, NIN = 3584;
constexpr int GH = 4, DK = 128, CHUNK = 64, NCHUNK = SEQ / CHUNK;
constexpr int AH = 8, DH = 64;
constexpr int NE = 32, FF = 1024, LCAP = 32768;
constexpr float EPS = 1e-6f, LOG2E = 1.4426950408889634f;
constexpr int NWAVES = 8, NTHREADS = 512;

constexpr size_t MiB = 1u << 20;
constexpr size_t WS_CTL = 0, CTL_ZERO_BYTES = 64 * 1024;
constexpr size_t WS_WIN = 1 * MiB, WS_WOUT = 8 * MiB, WS_WGU = 10 * MiB, WS_WDN = 138 * MiB;
constexpr size_t WS_TE = 202 * MiB, WS_TSLOT = WS_TE + 512 * 1024, WS_TG = WS_TSLOT + 512 * 1024;
constexpr size_t WS_LIST = 204 * MiB, WS_LRS = 208 * MiB;
constexpr size_t WS_BA = 212 * MiB, WS_WRT = 213 * MiB;
constexpr size_t WS_ZG = 214 * MiB, WS_QB = 342 * MiB, WS_KB = 374 * MiB, WS_VB = 406 * MiB;
constexpr size_t WS_PREP = 438 * MiB;
constexpr int PREP_WP = 0, PREP_QP = 16384, PREP_AP = 32768, PREP_KT = 40960, PREP_UP = 57344, PREP_CD = 90112, PREP_REC = 90368;
constexpr size_t WS_OG = 616 * MiB, WS_MIX = 680 * MiB;
constexpr size_t WS_XN = 760 * MiB, WS_HB = 760 * MiB;
constexpr size_t WS_ACT = 214 * MiB, WS_Y = 352 * MiB, WS_HBF = 488 * MiB, WS_XN8 = 824 * MiB  , WS_WIN8 = 856 * MiB  , WS_END = 858 * MiB;
static_assert(WS_VB - WS_KB == WS_KB - WS_QB, "q/k/v stride");
static_assert(WS_PREP + (size_t)NBATCH * GH * NCHUNK * PREP_REC <= WS_OG, "prep region");
static_assert(WS_ACT + (size_t)(T * 4 + NE * 256) * FF <= WS_Y && WS_Y + (size_t)(T * 4 + NE * 256) * D <= WS_HBF && WS_HBF + (size_t)T * D * 2 <= 616 * MiB, "act/y/h regions");
constexpr int CW_TMO = 0, CW_CODE = 1, CW_ATTQ = 512, CW_GCNT = 1024  , CW_DONE0 = 4096  , CW_BAR = 8192;
static_assert((CW_BAR + 3456) * 4 <= (int)CTL_ZERO_BYTES && CW_GCNT + 64 * 32 <= CW_BAR, "control words inside the zeroed region");

constexpr int LDS_BYTES = 160 * 1024;
constexpr int RING_BYTES = 131072;
constexpr int TOP_OFF = LDS_BYTES - 4096;
constexpr int MISC_OFF = TOP_OFF;
constexpr int MOE_TAB_OFF = TOP_OFF + 256;
constexpr int MOE_TSTART = MOE_TAB_OFF, MOE_LCNT = MOE_TAB_OFF + 256, MOE_TEXP = MOE_TAB_OFF + 512;

#define RLX_AGENT __ATOMIC_RELAXED, __HIP_MEMORY_SCOPE_AGENT
#define LDS_WAIT() asm volatile("s_waitcnt lgkmcnt(0)" ::: "memory")
#define VM_WAIT() asm volatile("s_waitcnt vmcnt(0)" ::: "memory")
#define WAVE_LDS_ORDER() asm volatile("" ::: "memory")
#define LDS_BARRIER() do { asm volatile("s_waitcnt lgkmcnt(0)" ::: "memory"); __builtin_amdgcn_s_barrier(); asm volatile("" ::: "memory"); } while (0)
__device__ __forceinline__ unsigned pk2(float lo, float hi) { f32x2 v = {lo, hi}; bf16x2_t b = __builtin_convertvector(v, bf16x2_t); return __builtin_bit_cast(unsigned, b); }
__device__ __forceinline__ unsigned pk4_fp8(float a, float b, float c, float d) { int w = 0; w = __builtin_amdgcn_cvt_pk_fp8_f32(a, b, w, false); w = __builtin_amdgcn_cvt_pk_fp8_f32(c, d, w, true); return (unsigned)w; }
__device__ __forceinline__ float bf2f(unsigned short b) { return __uint_as_float((unsigned)b << 16); }
__device__ __forceinline__ float bflo(unsigned w) { return __uint_as_float(w << 16); }
__device__ __forceinline__ float bfhi(unsigned w) { return __uint_as_float(w & 0xffff0000u); }
template <int CTRL> __device__ __forceinline__ float dpp_mov(float v) { return __builtin_bit_cast(float, __builtin_amdgcn_update_dpp(0, __builtin_bit_cast(int, v), CTRL, 0xF, 0xF, true)); }
__device__ __forceinline__ float sum_row16(float v) {
    v += dpp_mov<0xB1>(v);
    v += dpp_mov<0x4E>(v);
    v += dpp_mov<0x141>(v);
    v += dpp_mov<0x140>(v);
    return v; }
__device__ __forceinline__ float sum_xor16(float v) { const unsigned u = __builtin_bit_cast(unsigned, v); auto r = __builtin_amdgcn_permlane16_swap(u, u, false, false); return __builtin_bit_cast(float, (unsigned)r[0]) + __builtin_bit_cast(float, (unsigned)r[1]); }
__device__ __forceinline__ float sum_xor32(float v) { const unsigned u = __builtin_bit_cast(unsigned, v); auto r = __builtin_amdgcn_permlane32_swap(u, u, false, false); return __builtin_bit_cast(float, (unsigned)r[0]) + __builtin_bit_cast(float, (unsigned)r[1]); }
__device__ __forceinline__ float wave_sum(float v) { return sum_xor32(sum_xor16(sum_row16(v))); }
__device__ __forceinline__ float silu_f(float x) { return x * __builtin_amdgcn_rcpf(1.f + __expf(-x)); }
__device__ __forceinline__ float sigmoid_f(float x) { return __builtin_amdgcn_rcpf(1.f + __expf(-x)); }
__device__ __forceinline__ f32x4 silu4(f32x4 v) {
    const f32x4 vc = __builtin_elementwise_max(v, (f32x4){-20.f, -20.f, -20.f, -20.f}); const f32x4 ea = vc * -1.4426950408889634f;
    const f32x4 d = (f32x4){__builtin_amdgcn_exp2f(ea[0]), __builtin_amdgcn_exp2f(ea[1]), __builtin_amdgcn_exp2f(ea[2]), __builtin_amdgcn_exp2f(ea[3])} + 1.f;
    const f32x2 dlo = {d[0], d[1]}, dhi = {d[2], d[3]}; const f32x2 q2 = dlo * dhi; const float rq = __builtin_amdgcn_rcpf(q2[0] * q2[1]); const f32x2 t2 = (f32x2){q2[1], q2[0]} * rq;
    const f32x2 rlo = t2 * dhi, rhi = t2 * dlo; return vc * (f32x4){rlo[0], rlo[1], rhi[0], rhi[1]};
}
__device__ __forceinline__ bf16x8 pack8(f32x4 a, f32x4 b) {
    u32x4 w; w.x = pk2(a[0], a[1]); w.y = pk2(a[2], a[3]); w.z = pk2(b[0], b[1]); w.w = pk2(b[2], b[3]); return __builtin_bit_cast(bf16x8, w);
}

__device__ __forceinline__ void glds16_asm(const void* gsrc, unsigned lds_dst) { unsigned keep;
    asm volatile("s_mov_b32 %0, m0\n\ts_mov_b32 m0, %2\n\ts_nop 0\n\tglobal_load_lds_dwordx4 %1, off\n\ts_mov_b32 m0, %0\n\ts_nop 0" : "=&s"(keep) : "v"(gsrc), "s"(lds_dst) : "memory"); }

__device__ __forceinline__ void glds16_asm_nt(const void* gsrc, unsigned lds_dst) { unsigned keep;
    asm volatile("s_mov_b32 %0, m0\n\ts_mov_b32 m0, %2\n\ts_nop 0\n\tglobal_load_lds_dwordx4 %1, off nt\n\ts_mov_b32 m0, %0\n\ts_nop 0" : "=&s"(keep) : "v"(gsrc), "s"(lds_dst) : "memory"); }

namespace pg8 {
constexpr int BM = 256, BK = 64, HALF = 128, HTB = HALF * BK * 2, STAGE_BYTES = 8 * HTB, NXCD = 8;
__host__ __device__ __forceinline__ int lds_byte(int r, int c) { const int st = (r >> 4) * 2 + (c >> 5), rr = r & 15, cc = c & 31, ob = rr * 64 + cc * 2; return st * 1024 + (ob ^ (((ob >> 9) & 1) << 5)); }
__host__ __device__ __forceinline__ void stage_rc(int b, int& R, int& C) { const int st = b / 1024, sb = b % 1024, swz = sb ^ (((sb >> 9) & 1) << 5); R = (st >> 1) * 16 + swz / 64; C = (st & 1) * 32 + (swz % 64) / 2; }
__host__ __device__ __forceinline__ int perm32(int rho) { const int n = rho >> 4, i = rho & 15; return 8 * (i >> 2) + 4 * n + (i & 3); }

struct Unit { int pm, pn, pb, e, mt; };
struct Gemm { const bf16* A; const bf16* Bt; int K; };

__device__ __forceinline__ bool static_tile(int i, int G, int c, int nM, int nN, int& pm, int& pn, int WGM = 8) {
    const int nwg = nM * nN; const long L = (long)i * G + c; if (L >= nwg) return false;
    int wgid = (int)L; { const int q = nwg / NXCD, r = nwg % NXCD, xcd = wgid % NXCD, off = wgid / NXCD; wgid = (xcd < r ? xcd * (q + 1) : r * (q + 1) + (xcd - r) * q) + off; }
    const int nig = WGM * nN, gid = wgid / nig, fm = gid * WGM, gsz = (nM - fm) < WGM ? (nM - fm) : WGM;
    pm = fm + ((wgid % nig) % gsz); pn = (wgid % nig) / gsz; return true;
}
struct StaticOrder {
    int nM, nN, G, c, wgm, pnofs;
    __device__ __forceinline__ bool next(int i, Unit& u) const { int pm, pn; if (!static_tile(i, G, c, nM, nN, pm, pn, wgm)) return false; u.pm = pm; u.pn = pn + pnofs; u.pb = pn; u.e = 0; u.mt = 0; return true; }
    __device__ __forceinline__ int row_index(const Unit&, int) const { return 0; }
};
struct MoeOrder {
    int nM, nN, G, c, wgm; const LAS int* tstart; const LAS int* lcnt; const LAS int* texp; const int* list;
    __device__ __forceinline__ bool next(int i, Unit& u) const {
        int pm, pn; if (!static_tile(i, G, c, nM, nN, pm, pn, wgm)) return false;
        const int e = texp[pm]; u.pm = pm; u.pn = pn; u.e = e; u.pb = e * nN + pn; u.mt = pm - tstart[e]; return true;
    }
    __device__ __forceinline__ int row_index(const Unit& u, int r) const { const int rr = u.mt * 256 + r; const int v = list[u.e * LCAP + rr]; return rr < lcnt[u.e] ? v : 0; }
};

#define PG8_SA(b, h) (((b) * 2 + (h)) * HTB)
#define PG8_SB(b, h) ((4 + (b) * 2 + (h)) * HTB)
#define PG8_GLDS(src, dstoff) __builtin_amdgcn_global_load_lds((const unsigned*)(src), (LAS unsigned*)(lds + (dstoff)), 16, 0, 0)
#define PG8_STAGE_B(bufoff, nx, kb, h) do { _Pragma("unroll") for (int _i = 0; _i < 2; ++_i) \
        PG8_GLDS(((nx) ? nB : cB) + (kb) + (Epi::WIDE ? (size_t)voffBW[h][_i] : (size_t)(h) * hstep + voffB[_i]), (bufoff) + ldsw + _i * 8192); } while (0)
#define PG8_STAGE_A(bufoff, nx, kb, h) do { _Pragma("unroll") for (int _i = 0; _i < 2; ++_i) \
        PG8_GLDS(GATHER ? (const char*)g.A + (kb) + ((nx) ? voffN[h][_i] : voffC[h][_i]) : ((nx) ? nA : cA) + (kb) + (size_t)(h) * hstep + voffA[_i], (bufoff) + ldsw + _i * 8192); } while (0)
#define PG8_LDA8(dst, b, h) do { _Pragma("unroll") for (int m = 0; m < 4; ++m) { const v4i_t lo_ = *(const LAS v4i_t*)(lds + PG8_SA(b, h) + aoff + m * 2048), hi_ = *(const LAS v4i_t*)(lds + PG8_SA(b, h) + aoff + m * 2048 + 1024); dst[m] = __builtin_shufflevector(lo_, hi_, 0, 1, 2, 3, 4, 5, 6, 7); } } while (0)
#define PG8_LDB8(dst, b, h) do { _Pragma("unroll") for (int n = 0; n < 2; ++n) { const v4i_t lo_ = *(const LAS v4i_t*)(lds + PG8_SB(b, h) + boff + n * 2048), hi_ = *(const LAS v4i_t*)(lds + PG8_SB(b, h) + boff + n * 2048 + 1024); dst[n] = __builtin_shufflevector(lo_, hi_, 0, 1, 2, 3, 4, 5, 6, 7); } } while (0)
#define PG8_LDA(dst, b, h) do { _Pragma("unroll") for (int m = 0; m < 4; ++m) _Pragma("unroll") for (int k = 0; k < 2; ++k) dst[m][k] = *(const LAS bf16x8*)(lds + PG8_SA(b, h) + aoff + m * 2048 + k * 1024); } while (0)
#define PG8_LDB(dst, b, h) do { _Pragma("unroll") for (int n = 0; n < 2; ++n) _Pragma("unroll") for (int k = 0; k < 2; ++k) dst[n][k] = *(const LAS bf16x8*)(lds + PG8_SB(b, h) + boff + n * 2048 + k * 1024); } while (0)
#define PG8_MMA(ai, bj, At, Bt) do { __builtin_amdgcn_s_setprio(1); _Pragma("unroll") for (int m = 0; m < 4; ++m) _Pragma("unroll") for (int n = 0; n < 2; ++n) _Pragma("unroll") for (int k = 0; k < 2; ++k) \
        acc[ai][bj][m][n] = __builtin_amdgcn_mfma_f32_16x16x32_bf16(Bt[n][k], At[m][k], acc[ai][bj][m][n], 0, 0, 0); __builtin_amdgcn_s_setprio(0); } while (0)
#define PG8_MMA8(ai, bj, At, Bt) do { __builtin_amdgcn_s_setprio(1); _Pragma("unroll") for (int m = 0; m < 4; ++m) _Pragma("unroll") for (int n = 0; n < 2; ++n) \
        asm volatile("v_mfma_scale_f32_16x16x128_f8f6f4 %0, %1, %2, %0, %3, %4 op_sel_hi:[0,0,0]" : "+v"(acc[ai][bj][m][n]) : "v"(Bt[n]), "v"(At[m]), "v"(sc_w), "v"(sc_a)); __builtin_amdgcn_s_setprio(0); } while (0)
#define PG8_MMAZ(ai, bj, At, Bt) do { __builtin_amdgcn_s_setprio(1); _Pragma("unroll") for (int m = 0; m < 4; ++m) _Pragma("unroll") for (int n = 0; n < 2; ++n) { \
        acc[ai][bj][m][n] = __builtin_amdgcn_mfma_f32_16x16x32_bf16(Bt[n][0], At[m][0], (f32x4){0.f, 0.f, 0.f, 0.f}, 0, 0, 0); \
        acc[ai][bj][m][n] = __builtin_amdgcn_mfma_f32_16x16x32_bf16(Bt[n][1], At[m][1], acc[ai][bj][m][n], 0, 0, 0); } __builtin_amdgcn_s_setprio(0); } while (0)
#define PG8_MMA8Z(ai, bj, At, Bt) do { __builtin_amdgcn_s_setprio(1); _Pragma("unroll") for (int m = 0; m < 4; ++m) _Pragma("unroll") for (int n = 0; n < 2; ++n) \
        asm volatile("v_mfma_scale_f32_16x16x128_f8f6f4 %0, %1, %2, 0, %3, %4 op_sel_hi:[0,0,0]" : "+v"(acc[ai][bj][m][n]) : "v"(Bt[n]), "v"(At[m]), "v"(sc_w), "v"(sc_a)); __builtin_amdgcn_s_setprio(0); } while (0)
#define XMMA0Z(ai, bj) do { if constexpr (FP8) PG8_MMA8Z(ai, bj, At8, B08); else PG8_MMAZ(ai, bj, At, B0); } while (0)
#define XMMA1Z(ai, bj) do { if constexpr (FP8) PG8_MMA8Z(ai, bj, At8, B18); else PG8_MMAZ(ai, bj, At, B1); } while (0)
#define XLDA(b, h) do { if constexpr (FP8) PG8_LDA8(At8, b, h); else PG8_LDA(At, b, h); } while (0)
#define XLDB0(b, h) do { if constexpr (FP8) PG8_LDB8(B08, b, h); else PG8_LDB(B0, b, h); } while (0)
#define XLDB1(b, h) do { if constexpr (FP8) PG8_LDB8(B18, b, h); else PG8_LDB(B1, b, h); } while (0)
#define XMMA0(ai, bj) do { if constexpr (FP8) PG8_MMA8(ai, bj, At8, B08); else PG8_MMA(ai, bj, At, B0); } while (0)
#define XMMA1(ai, bj) do { if constexpr (FP8) PG8_MMA8(ai, bj, At8, B18); else PG8_MMA(ai, bj, At, B1); } while (0)
#define PG8_WAIT_V(n) asm volatile("s_waitcnt vmcnt(" #n ")" ::: "memory")
#define PG8_WAIT_L(n) asm volatile("s_waitcnt lgkmcnt(" #n ")" ::: "memory")
#define PG8_BAR __builtin_amdgcn_s_barrier()
#define PG8_SCHED __builtin_amdgcn_sched_barrier(0)

template <class Epi, class Sched, bool GATHER, bool ALIGN_EPI, bool FP8 = false, int KREP = 1>
__device__ __forceinline__ void gemm_phase(LAS unsigned char* lds, const Gemm g, const Sched& S, const Epi& E) {
    int tid = threadIdx.x; asm volatile("" : "+v"(tid));
    const int wid = __builtin_amdgcn_readfirstlane(tid >> 6), lane = tid & 63, wr = wid >> 2, wc = wid & 3, fr = lane & 15, fq = lane >> 4;
    const int K = g.K, rowb = FP8 ? K : 2 * K, nt = rowb / 128;
    unsigned voffA[2], voffB[2], voffBW[2][2], voffC[2][2], voffN[2][2]; int RA[2], CA[2];
#pragma unroll
    for (int i = 0; i < 2; ++i) { int R, C; stage_rc(tid * 16 + i * 8192, R, C); const int Rb = Epi::PERM ? ((R & ~31) + perm32(R & 31)) : R;
        RA[i] = R; CA[i] = C; voffA[i] = (unsigned)(R * rowb + C * 2); voffB[i] = (unsigned)(Rb * rowb + C * 2);
        voffBW[0][i] = (unsigned)((64 * (R >> 5) + perm32(R & 31)) * rowb + C * 2); voffBW[1][i] = (unsigned)((64 * (R >> 5) + 32 + perm32(R & 31)) * rowb + C * 2); }
    const size_t kstep = (size_t)(BK * 2), hstep = (size_t)HALF * rowb, tstep = 2 * hstep;
    const unsigned ldsw = (unsigned)wid * 1024u;
    const int aoff = lds_byte(wr * 64 + fr, fq * 8), boff = lds_byte(wc * 32 + fr, fq * 8);
    Unit cur, nxt; int ui = 0;
    if (!S.next(0, cur)) return;
    f32x4 acc[2][2][4][2];
#define PG8_ZERO_ACC() do { if constexpr (!FP8) { _Pragma("unroll") for (int a_ = 0; a_ < 2; ++a_) _Pragma("unroll") for (int b_ = 0; b_ < 2; ++b_) _Pragma("unroll") for (int m_ = 0; m_ < 4; ++m_) _Pragma("unroll") for (int n_ = 0; n_ < 2; ++n_) \
        acc[a_][b_][m_][n_] = (f32x4){0.f, 0.f, 0.f, 0.f}; } } while (0)
    PG8_ZERO_ACC();
    bf16x8 At[4][2], B0[2][2], B1[2][2]; v8i_t At8[4], B08[2], B18[2]; int sc_w = 0x7a7a7a7a, sc_a = 0x7f7f7f7f; asm volatile("" : "+v"(sc_w), "+v"(sc_a));
    const char* cA = (const char*)g.A + (size_t)cur.pm * tstep; const char* cB = (const char*)g.Bt + (size_t)cur.pb * tstep;
    if (GATHER) {
#pragma unroll
        for (int h = 0; h < 2; ++h)
#pragma unroll
            for (int i = 0; i < 2; ++i) { voffC[h][i] = (unsigned)(S.row_index(cur, RA[i] + 128 * h) * rowb + CA[i] * 2); voffN[h][i] = voffC[h][i]; }
    }
    const char* nA = cA; const char* nB = cB;
    E.prefetch(cur, 0, wid, lane);
    PG8_STAGE_B(PG8_SB(0, 0), false, 0, 0); PG8_STAGE_B(PG8_SB(0, 1), false, 0, 1); PG8_STAGE_A(PG8_SA(0, 0), false, 0, 0); PG8_STAGE_A(PG8_SA(0, 1), false, 0, 1);
    if (wr == 1) PG8_BAR;
    PG8_WAIT_V(2); PG8_BAR;
    PG8_STAGE_B(PG8_SB(1, 0), false, kstep, 0); PG8_STAGE_A(PG8_SA(1, 0), false, kstep, 0); PG8_STAGE_B(PG8_SB(1, 1), false, kstep, 1);
    PG8_WAIT_V(6); PG8_BAR;
    for (;;) {
        const bool has_next = S.next(ui + 1, nxt);
        if (has_next) E.prefetch(nxt, (ui + 1) % 3, wid, lane);
        nA = has_next ? (const char*)g.A + (size_t)nxt.pm * tstep : cA; nB = has_next ? (const char*)g.Bt + (size_t)nxt.pb * tstep : cB;
        if (GATHER) {
            if (has_next) { int ix[2][2];
#pragma unroll
                for (int h = 0; h < 2; ++h)
#pragma unroll
                    for (int i = 0; i < 2; ++i) ix[h][i] = S.row_index(nxt, RA[i] + 128 * h);
#pragma unroll
                for (int h = 0; h < 2; ++h)
#pragma unroll
                    for (int i = 0; i < 2; ++i) voffN[h][i] = (unsigned)(ix[h][i] * rowb + CA[i] * 2);
            } else {
#pragma unroll
                for (int h = 0; h < 2; ++h)
#pragma unroll
                    for (int i = 0; i < 2; ++i) voffN[h][i] = voffC[h][i]; }
        }
        for (int t = 0; t < nt * KREP; t += 2) {
            const bool last = (t == nt * KREP - 2);
            const int tm = t % nt; const size_t k1 = (size_t)(tm + 1) * kstep, k2 = last ? 0 : (size_t)((tm + 2) % nt) * kstep, k3 = k2 + kstep;
            XLDB0(0, 0); XLDB1(0, 1); PG8_SCHED; XLDA(0, 0); PG8_STAGE_A(PG8_SA(1, 1), false, k1, 1);
            PG8_WAIT_V(8); PG8_WAIT_L(0); PG8_BAR; if (FP8 && t == 0) { XMMA0Z(0, 0); XMMA1Z(0, 1); } else { XMMA0(0, 0); XMMA1(0, 1); } PG8_BAR; PG8_SCHED;
            XLDA(0, 1); PG8_STAGE_B(PG8_SB(0, 0), last, k2, 0); PG8_STAGE_B(PG8_SB(0, 1), last, k2, 1); PG8_STAGE_A(PG8_SA(0, 0), last, k2, 0);
            PG8_WAIT_V(8); PG8_WAIT_L(0); PG8_BAR; if (FP8 && t == 0) { XMMA0Z(1, 0); XMMA1Z(1, 1); } else { XMMA0(1, 0); XMMA1(1, 1); } PG8_BAR; PG8_SCHED;
            XLDB0(1, 0); XLDB1(1, 1); PG8_SCHED; XLDA(1, 0); PG8_STAGE_A(PG8_SA(0, 1), last, k2, 1);
            PG8_WAIT_V(8); PG8_WAIT_L(0); PG8_BAR; XMMA0(0, 0); XMMA1(0, 1); PG8_BAR; PG8_SCHED;
            XLDA(1, 1); PG8_STAGE_B(PG8_SB(1, 0), last, k3, 0); PG8_STAGE_B(PG8_SB(1, 1), last, k3, 1); PG8_STAGE_A(PG8_SA(1, 0), last, k3, 0);
            PG8_WAIT_V(8); PG8_WAIT_L(0); PG8_BAR; XMMA0(1, 0); XMMA1(1, 1); PG8_BAR; PG8_SCHED;
        }
        if constexpr (ALIGN_EPI) { if (wr == 0) PG8_BAR; }
        if constexpr (FP8) asm volatile("s_nop 15\n\ts_nop 15" ::: "memory");
        if constexpr (KREP > 1) {
#pragma unroll
            for (int a_ = 0; a_ < 2; ++a_)
#pragma unroll
                for (int b_ = 0; b_ < 2; ++b_)
#pragma unroll
                    for (int m_ = 0; m_ < 4; ++m_)
#pragma unroll
                        for (int n_ = 0; n_ < 2; ++n_) acc[a_][b_][m_][n_] = acc[a_][b_][m_][n_] * (1.f / KREP); }
        E(acc, cur, wr, wc, fr, fq, ui % 3);
        if (!has_next) break;
        PG8_ZERO_ACC();
        cur = nxt; cA = nA; cB = nB; ++ui;
        if (GATHER) {
#pragma unroll
            for (int h = 0; h < 2; ++h)
#pragma unroll
                for (int i = 0; i < 2; ++i) voffC[h][i] = voffN[h][i];
        }
        if constexpr (ALIGN_EPI) { if (wr == 1) PG8_BAR; }
    }
    PG8_WAIT_V(0);
    if constexpr (!ALIGN_EPI) { if (wr == 0) PG8_BAR; }
    PG8_BAR;
}

struct EpiInProj {
    static constexpr bool PERM = true, WIDE = true;
    __device__ __forceinline__ void prefetch(const Unit&, int, int, int) const {}
    bf16* zg; bf16* qb; bf16* kb; bf16* vb; const float* qn; const float* kn; LAS unsigned char* stage; const float* gnw;
    template <int MODE> __device__ __forceinline__ void body(const f32x4 (&acc)[2][2][4][2], const Unit& u, int wr, int wc, int fr, int fq) const {
        const int lane = fq * 16 + fr; LAS unsigned char* stg = stage + (wr * 4 + wc) * 3584;
        constexpr bool swa = MODE >= 2; const int sec = swa ? (u.pn - 8) >> 1 : 0, head = 4 * ((u.pn - 8) & 1) + wc;
        bf16* dst = qb + (size_t)sec * ((WS_KB - WS_QB) / 2); const float* nw = (sec == 1) ? kn : qn;
        f32x4 wv[2][2];
        if constexpr (MODE == 1 || MODE == 2) {
#pragma unroll
            for (int bj = 0; bj < 2; ++bj)
#pragma unroll
                for (int n = 0; n < 2; ++n) wv[bj][n] = MODE == 2 ? *(const f32x4*)(nw + 32 * bj + 8 * fq + 4 * n) : *(const f32x4*)(gnw + ((wc & 1) * 64 + 32 * bj + 8 * fq + 4 * n)); }
#pragma unroll
        for (int ai = 0; ai < 2; ++ai)
#pragma unroll
            for (int m = 0; m < 4; ++m) {
                float sc = 1.f;
                if constexpr (MODE == 2) { float ss = 0.f;
#pragma unroll
                    for (int bj = 0; bj < 2; ++bj)
#pragma unroll
                        for (int n = 0; n < 2; ++n) { const f32x4 x = acc[ai][bj][m][n]; ss += (x[0] * x[0] + x[1] * x[1]) + (x[2] * x[2] + x[3] * x[3]); }
                    ss = sum_xor32(sum_xor16(ss));
                    sc = __builtin_amdgcn_rsqf(ss * (1.f / 64.f) + EPS) * (sec == 0 ? 0.125f * LOG2E : 1.f); }
#pragma unroll
                for (int bj = 0; bj < 2; ++bj) { f32x4 v0 = acc[ai][bj][m][0], v1 = acc[ai][bj][m][1];
                    if constexpr (MODE == 1) { v0 = silu4(v0) * wv[bj][0]; v1 = silu4(v1) * wv[bj][1]; }
                    if constexpr (MODE == 2) { v0 = (v0 * sc) * wv[bj][0]; v1 = (v1 * sc) * wv[bj][1]; }
                    u32x4 w; w.x = pk2(v0[0], v0[1]); w.y = pk2(v0[2], v0[3]); w.z = pk2(v1[0], v1[1]); w.w = pk2(v1[2], v1[3]); *(LAS u32x4*)(stg + fr * 144 + bj * 64 + fq * 16) = w; }
                WAVE_LDS_ORDER();
                const int row0 = u.pm * BM + ai * HALF + wr * 64 + m * 16;
                u32x4 wq[2];
#pragma unroll
                for (int hf = 0; hf < 2; ++hf) wq[hf] = *(const LAS u32x4*)(stg + (hf * 8 + (lane >> 3)) * 144 + (lane & 7) * 16);
                asm volatile("" :: "v"(wq[0]), "v"(wq[1]));
#pragma unroll
                for (int hf = 0; hf < 2; ++hf) { const int rr = hf * 8 + (lane >> 3), c16 = lane & 7, row_ = row0 + rr;
                    bf16* gp = swa ? dst + ((size_t)((row_ >> 12) * AH + head) * SEQ + (row_ & (SEQ - 1))) * 64 + 8 * c16 : zg + (size_t)row_ * 2048 + u.pn * BM + wc * 64 + 8 * c16;
                    __builtin_nontemporal_store(wq[hf], (u32x4*)gp); }
                WAVE_LDS_ORDER(); }
    }
    __device__ __forceinline__ void operator()(const f32x4 (&acc)[2][2][4][2], const Unit& u, int wr, int wc, int fr, int fq, int) const {
        if (u.pn < 6) body<0>(acc, u, wr, wc, fr, fq); else if (u.pn < 8) body<1>(acc, u, wr, wc, fr, fq); else if (u.pn < 12) body<2>(acc, u, wr, wc, fr, fq); else body<3>(acc, u, wr, wc, fr, fq);
    }
};
struct EpiOutProj {
    __device__ __forceinline__ void prefetch(const Unit&, int, int, int) const {}
    static constexpr bool PERM = true, WIDE = true;
    const float* x; bf16* h; unsigned char* hb; LAS unsigned char* stage;
    __device__ __forceinline__ void operator()(const f32x4 (&acc)[2][2][4][2], const Unit& u, int wr, int wc, int fr, int fq, int) const {
        const int lane = fq * 16 + fr; LAS unsigned char* stg = stage + (wr * 4 + wc) * 3584; const int colw = u.pn * BM + wc * 64;
        const int r8 = lane >> 3, c16 = lane & 7;
#pragma unroll
        for (int ai = 0; ai < 2; ++ai)
#pragma unroll
            for (int mp = 0; mp < 2; ++mp) {
                f32x4 xv[2][2][2];
#pragma unroll
                for (int mm = 0; mm < 2; ++mm) { const int row0 = u.pm * BM + ai * HALF + wr * 64 + (2 * mp + mm) * 16;
#pragma unroll
                    for (int bj = 0; bj < 2; ++bj)
#pragma unroll
                        for (int hf = 0; hf < 2; ++hf) xv[mm][bj][hf] = __builtin_nontemporal_load((const f32x4*)(x + (size_t)(row0 + 8 * hf + r8) * D + colw + 32 * bj + 4 * c16)); }
                unsigned h8[2][2][2];
#pragma unroll
                for (int mm = 0; mm < 2; ++mm) { const int m = 2 * mp + mm; const int row0 = u.pm * BM + ai * HALF + wr * 64 + m * 16; u32x4 hw[2];
#pragma unroll
                    for (int bj = 0; bj < 2; ++bj) {
#pragma unroll
                        for (int hf = 0; hf < 2; ++hf) *(LAS f32x4*)(stg + (8 * hf + r8) * 144 + c16 * 16) = xv[mm][bj][hf];
                        WAVE_LDS_ORDER();
                        const f32x4 x0 = *(const LAS f32x4*)(stg + fr * 144 + fq * 32), x1 = *(const LAS f32x4*)(stg + fr * 144 + fq * 32 + 16);
                        const f32x4 v0 = acc[ai][bj][m][0] + x0, v1 = acc[ai][bj][m][1] + x1;
                        h8[mm][bj][0] = pk4_fp8(v0[0], v0[1], v0[2], v0[3]); h8[mm][bj][1] = pk4_fp8(v1[0], v1[1], v1[2], v1[3]);
                        hw[bj] = (u32x4){pk2(v0[0], v0[1]), pk2(v0[2], v0[3]), pk2(v1[0], v1[1]), pk2(v1[2], v1[3])};
                        WAVE_LDS_ORDER(); }
#pragma unroll
                    for (int bj = 0; bj < 2; ++bj) *(LAS u32x4*)(stg + fr * 144 + bj * 64 + fq * 16) = hw[bj];
                    WAVE_LDS_ORDER();
#pragma unroll
                    for (int hf = 0; hf < 2; ++hf) { const u32x4 w = *(const LAS u32x4*)(stg + (8 * hf + r8) * 144 + c16 * 16); __builtin_nontemporal_store(w, (u32x4*)(h + (size_t)(row0 + 8 * hf + r8) * D + colw + 8 * c16)); }
                    WAVE_LDS_ORDER(); }
#pragma unroll
                for (int mm = 0; mm < 2; ++mm)
#pragma unroll
                    for (int bj = 0; bj < 2; ++bj) *(LAS u32x2*)(stg + (16 * mm + fr) * 80 + bj * 32 + fq * 8) = (u32x2){h8[mm][bj][0], h8[mm][bj][1]};
                WAVE_LDS_ORDER();
                { const int rr = lane >> 2, q16 = lane & 3; const int rowa = u.pm * BM + ai * HALF + wr * 64 + (2 * mp) * 16;
                  const u32x4 w0 = *(const LAS u32x4*)(stg + rr * 80 + q16 * 16), w1 = *(const LAS u32x4*)(stg + (16 + rr) * 80 + q16 * 16);
                  *(u32x4*)(hb + (size_t)(rowa + rr) * D + colw + 16 * q16) = w0; *(u32x4*)(hb + (size_t)(rowa + 16 + rr) * D + colw + 16 * q16) = w1; }
                WAVE_LDS_ORDER(); }
    }
};
struct EpiGateUp {
    static constexpr bool PERM = true, WIDE = false;
    unsigned char* act; const float* bgu; const float* lrs; const LAS int* lcnt; LAS unsigned char* stage;
    __device__ __forceinline__ void prefetch(const Unit& u, int slot, int wid, int lane) const {
        const unsigned l0 = (unsigned)(uintptr_t)stage;
        if (wid == 0) glds16_asm(bgu + (size_t)u.e * 2048 + (lane >> 5) * 1024 + 128 * u.pn + (lane & 31) * 4, (unsigned)__builtin_amdgcn_readfirstlane((int)(l0 + slot * 1024)));
        else if (wid == 1) glds16_asm(lrs + (size_t)u.e * LCAP + u.mt * 256 + lane * 4, (unsigned)__builtin_amdgcn_readfirstlane((int)(l0 + 3072 + slot * 1024)));
    }
    __device__ __forceinline__ void operator()(const f32x4 (&acc)[2][2][4][2], const Unit& u, int wr, int wc, int fr, int fq, int slot) const {
        const int cl = wc * 32 + 8 * fq; const LAS float* bl = (const LAS float*)(stage + slot * 1024); const LAS float* rl = (const LAS float*)(stage + 3072 + slot * 1024);
        f32x4 bgv[2], buv[2];
#pragma unroll
        for (int n = 0; n < 2; ++n) { bgv[n] = *(const LAS f32x4*)(bl + cl + 4 * n); buv[n] = *(const LAS f32x4*)(bl + 128 + cl + 4 * n) + 1.f; }
        const int cnt = lcnt[u.e];
#pragma unroll
        for (int ai = 0; ai < 2; ++ai)
#pragma unroll
            for (int m = 0; m < 4; ++m) { const int r = ai * HALF + wr * 64 + m * 16 + fr, rr = u.mt * 256 + r;
                const float rsv = rl[r]; const float rs = rr < cnt ? rsv : 0.f;
                unsigned wq[2];
#pragma unroll
                for (int n = 0; n < 2; ++n) {
                    const f32x4 gt = __builtin_elementwise_min(__builtin_elementwise_max(acc[ai][0][m][n] * rs + bgv[n], (f32x4){-12.5f, -12.5f, -12.5f, -12.5f}), (f32x4){7.f, 7.f, 7.f, 7.f});
                    const f32x4 u1 = __builtin_elementwise_min(__builtin_elementwise_max(acc[ai][1][m][n] * rs + buv[n], (f32x4){-6.f, -6.f, -6.f, -6.f}), (f32x4){8.f, 8.f, 8.f, 8.f});
                    const f32x4 ea = gt * (-1.702f * LOG2E);
                    const f32x4 dn = (f32x4){__builtin_amdgcn_exp2f(ea[0]), __builtin_amdgcn_exp2f(ea[1]), __builtin_amdgcn_exp2f(ea[2]), __builtin_amdgcn_exp2f(ea[3])} + 1.f;
                    const f32x2 dlo = {dn[0], dn[1]}, dhi = {dn[2], dn[3]}; const f32x2 q2 = dlo * dhi;
                    const float rq = __builtin_amdgcn_rcpf(q2[0] * q2[1]); const f32x2 t2 = (f32x2){q2[1], q2[0]} * rq;
                    const f32x2 rlo = t2 * dhi, rhi = t2 * dlo;
                    const f32x4 a = (u1 * gt) * (f32x4){rlo[0], rlo[1], rhi[0], rhi[1]};
                    wq[n] = pk4_fp8(a[0], a[1], a[2], a[3]); }
                *(u32x2*)(act + (size_t)(u.pm * BM + r) * FF + 128 * u.pn + cl) = (u32x2){wq[0], wq[1]}; }
    }
};
struct EpiDown {
    static constexpr bool PERM = true, WIDE = true;
    unsigned char* y; const float* bdn; LAS unsigned char* stage;
    __device__ __forceinline__ void prefetch(const Unit& u, int slot, int wid, int lane) const {
        if (wid == 0) glds16_asm(bdn + (size_t)u.e * D + u.pn * BM + lane * 4, (unsigned)__builtin_amdgcn_readfirstlane((int)((unsigned)(uintptr_t)stage + 20480 + slot * 1024)));
    }
    __device__ __forceinline__ void operator()(const f32x4 (&acc)[2][2][4][2], const Unit& u, int wr, int wc, int fr, int fq, int slot) const {
        const int colw = u.pn * BM + wc * 64; const LAS float* bp = (const LAS float*)(stage + 20480 + slot * 1024) + wc * 64 + 8 * fq;
        f32x4 bv[2][2];
#pragma unroll
        for (int bj = 0; bj < 2; ++bj)
#pragma unroll
            for (int n = 0; n < 2; ++n) bv[bj][n] = *(const LAS f32x4*)(bp + 32 * bj + 4 * n);
        const int lane = fq * 16 + fr; LAS unsigned char* stg = stage + (wr * 4 + wc) * 2560;
#pragma unroll
        for (int ai = 0; ai < 2; ++ai)
#pragma unroll
            for (int mp = 0; mp < 2; ++mp) {
#pragma unroll
                for (int mm = 0; mm < 2; ++mm) { const int m = 2 * mp + mm;
#pragma unroll
                    for (int bj = 0; bj < 2; ++bj) { const f32x4 v0 = acc[ai][bj][m][0] + bv[bj][0], v1 = acc[ai][bj][m][1] + bv[bj][1];
                        *(LAS u32x2*)(stg + (16 * mm + fr) * 80 + bj * 32 + fq * 8) = (u32x2){pk4_fp8(v0[0], v0[1], v0[2], v0[3]), pk4_fp8(v1[0], v1[1], v1[2], v1[3])}; } }
                WAVE_LDS_ORDER();
                { const int rr = lane >> 2, c16 = lane & 3; const u32x4 w = *(const LAS u32x4*)(stg + rr * 80 + c16 * 16);
                  const int rowa = u.pm * BM + ai * HALF + wr * 64 + (2 * mp) * 16 + rr; *(u32x4*)(y + (size_t)rowa * D + colw + 16 * c16) = w;
                  const u32x4 w2 = *(const LAS u32x4*)(stg + (16 + rr) * 80 + c16 * 16); *(u32x4*)(y + (size_t)(rowa + 16) * D + colw + 16 * c16) = w2; }
                WAVE_LDS_ORDER(); }
    }
};
}

#define XB_TMO      128
#define XB_XCNT(j)  (256  + 64 * (j))
#define XB_XSUB(j)  (1280 + 64 * (j))
#define XB_XGEN(j)  (2304 + 64 * (j))
#define XB_TOP      3328
#define XB_TOPGEN   3392
#define XCD_BAR_WORDS 3456
#define XB_SPIN_CAP (1u << 20)
__device__ __forceinline__ unsigned xb_ld(unsigned* p)              { return __hip_atomic_load(p, __ATOMIC_RELAXED, __HIP_MEMORY_SCOPE_AGENT); }
__device__ __forceinline__ unsigned xb_add(unsigned* p, unsigned v) { return __hip_atomic_fetch_add(p, v, __ATOMIC_RELAXED, __HIP_MEMORY_SCOPE_AGENT); }
__device__ __forceinline__ unsigned xb_xcc_id() { return (unsigned)__builtin_amdgcn_s_getreg((3 << 11) | 20) & 0xFu; }
#define XB_SPIN(cond, bar) do { unsigned _sp = 0; while (cond) { __builtin_amdgcn_s_sleep(1); \
    if ((++_sp & 255u) == 0u) { if (xb_ld(&(bar)[XB_TMO])) break; if (_sp > XB_SPIN_CAP) { atomicAdd(&(bar)[XB_TMO], 1u); break; } } } } while (0)
struct XcdBarrier { unsigned* bar; unsigned x; volatile LAS unsigned* st; };
__device__ __forceinline__ XcdBarrier xcd_barrier_post(unsigned* bar, volatile LAS unsigned* st) {
    XcdBarrier b; b.bar = bar; b.x = xb_xcc_id(); b.st = st;
    if (threadIdx.x == 0) (void)xb_add(&bar[XB_XCNT(b.x)], 1u);
    return b;
}
__device__ __forceinline__ void xcd_barrier_complete(unsigned* bar, unsigned x, unsigned& nloc, unsigned& nx) {
    const unsigned G = gridDim.x * gridDim.y * gridDim.z;
    unsigned sum, cnt, mine, sp = 0u;
    for (;;) {
        sum = 0u; cnt = 0u; mine = 0u;
#pragma unroll
        for (unsigned j = 0; j < 16; ++j) { const unsigned c = xb_ld(&bar[XB_XCNT(j)]); sum += c; cnt += (c > 0u) ? 1u : 0u; mine = (j == x) ? c : mine; }
        if (sum == G) break;
        __builtin_amdgcn_s_sleep(1);
        if ((++sp & 255u) == 0u) { if (xb_ld(&bar[XB_TMO])) break; if (sp > XB_SPIN_CAP) { atomicAdd(&bar[XB_TMO], 1u); break; } }
    }
    nloc = mine > 0u ? mine : 1u; nx = cnt > 0u ? cnt : 1u;
}
__device__ __forceinline__ void xcd_barrier(const XcdBarrier& b) {
    asm volatile("s_waitcnt vmcnt(0)" ::: "memory");
    __syncthreads();
    if (threadIdx.x == 0) {
        unsigned* bar = b.bar;
        __builtin_amdgcn_s_waitcnt(0);
        unsigned nloc = b.st[0], nx = b.st[1];
        if (nloc == 0u) { xcd_barrier_complete(bar, b.x, nloc, nx); b.st[0] = nloc; b.st[1] = nx; }
        const unsigned old = xb_add(&bar[XB_XSUB(b.x)], 1u);
        const unsigned gen = old / nloc;
        if (old + 1u == (gen + 1u) * nloc) {
            __builtin_amdgcn_fence(__ATOMIC_RELEASE, "agent");
            asm volatile("s_waitcnt vmcnt(0)" ::: "memory");
            const unsigned og = xb_add(&bar[XB_TOP], 1u);
            const unsigned tg = og / nx;
            if (og + 1u == (tg + 1u) * nx) xb_add(&bar[XB_TOPGEN], 1u);
            else XB_SPIN(xb_ld(&bar[XB_TOPGEN]) == tg, bar);
            __builtin_amdgcn_fence(__ATOMIC_ACQUIRE, "agent");
            xb_add(&bar[XB_XGEN(b.x)], 1u);
            asm volatile("s_waitcnt vmcnt(0)" ::: "memory");
        } else {
            XB_SPIN(xb_ld(&bar[XB_XGEN(b.x)]) == gen, bar);
            __builtin_amdgcn_fence(__ATOMIC_ACQUIRE, "agent");
            asm volatile("s_waitcnt vmcnt(0)" ::: "memory");
        }
    }
    __syncthreads();
}

struct Args { const float* in[18]; float* out; unsigned char* ws; int ph_lo, ph_hi, li, pad; };
struct Frame {
    LAS unsigned char* lds; unsigned char* ws; unsigned* ctl;
    int tid, lane, wave, G, vcu;
};

__device__ const unsigned char T5B[3][132] = {
{0,1,2,3,4,5,6,7,8,9,10,11,12,13,14,15,16,16,16,16,16,16,17,17,17,17,17,17,17,17,18,18,18,18,18,18,18,18,18,18,19,19,19,19,19,19,19,19,19,19,19,19,19,19,20,20,20,20,20,20,20,20,20,20,20,20,20,20,20,20,20,20,20,21,21,21,21,21,21,21,21,21,21,21,21,21,21,21,21,21,21,21,21,21,21,21,21,21,21,22,22,22,22,22,22,22,22,22,22,22,22,22,22,22,22,22,22,22,22,22,22,22,22,22,22,22,22,22,22,0,0,0},
{0,4,8,12,16,16,17,17,18,18,19,19,19,19,20,20,20,20,20,21,21,21,21,21,21,22,22,22,22,22,22,22,22,22,23,23,23,23,23,23,23,23,23,23,23,23,24,24,24,24,24,24,24,24,24,24,24,24,24,24,24,24,25,25,25,25,25,25,25,25,25,25,25,25,25,25,25,25,25,25,25,25,25,26,26,26,26,26,26,26,26,26,26,26,26,26,26,26,26,26,26,26,26,26,26,26,26,26,26,26,26,26,26,27,27,27,27,27,27,27,27,27,27,27,27,27,27,27,27,0,0,0},
{0,16,18,19,20,21,21,22,22,23,23,23,24,24,24,24,25,25,25,25,25,26,26,26,26,26,26,26,26,27,27,27,27,27,27,27,27,27,27,28,28,28,28,28,28,28,28,28,28,28,28,28,29,29,29,29,29,29,29,29,29,29,29,29,29,29,29,29,29,29,30,30,30,30,30,30,30,30,30,30,30,30,30,30,30,30,30,30,30,30,30,30,30,30,30,31,31,31,31,31,31,31,31,31,31,31,31,31,31,31,31,31,31,31,31,31,31,31,31,31,31,31,31,31,31,31,31,31,31,0,0,0}};

__device__ __forceinline__ void p0_load8(const float* W, size_t ldw, int src_col0, int k0, int lane, f32x4 (&v)[8]) {
    const int n4 = (lane & 7) * 4, kr = lane >> 3;
#pragma unroll
    for (int i = 0; i < 8; ++i) v[i] = __builtin_nontemporal_load((const f32x4*)(W + (size_t)(k0 + 8 * i + kr) * ldw + src_col0 + n4));
}
template <bool SCALE, bool OUT8> __device__ __forceinline__ void p0_finish(const f32x4 (&v)[8], void* dstv, int k0, const float* kscale, LAS float* scr, int lane) {
    { const int n4 = (lane & 7) * 4, kr = lane >> 3;
#pragma unroll
        for (int i = 0; i < 8; ++i) { const int kk = 8 * i + kr; f32x4 x = v[i]; if (SCALE) x = x * kscale[k0 + kk]; if (OUT8) x = x * 32.f;
            scr[kk * 33 + n4] = x[0]; scr[kk * 33 + n4 + 1] = x[1]; scr[kk * 33 + n4 + 2] = x[2]; scr[kk * 33 + n4 + 3] = x[3]; } }
    LDS_WAIT(); asm volatile("" ::: "memory");
    if (OUT8) { unsigned char* dst = (unsigned char*)dstv; const int n = lane >> 1, kh = lane & 1; const LAS float* sp = scr + (32 * kh) * 33 + n; unsigned w[8];
#pragma unroll
        for (int q = 0; q < 8; ++q) w[q] = pk4_fp8(sp[(4 * q) * 33], sp[(4 * q + 1) * 33], sp[(4 * q + 2) * 33], sp[(4 * q + 3) * 33]);
        *(u32x4*)(dst + (size_t)n * 1024 + k0 + 32 * kh) = (u32x4){w[0], w[1], w[2], w[3]}; *(u32x4*)(dst + (size_t)n * 1024 + k0 + 32 * kh + 16) = (u32x4){w[4], w[5], w[6], w[7]};
    } else { bf16* dst = (bf16*)dstv; const int c = lane & 7;
#pragma unroll
        for (int j = 0; j < 4; ++j) { const int n = (lane >> 3) + 8 * j; const LAS float* sp = scr + (8 * c) * 33 + n;
            u32x4 o; o.x = pk2(sp[0 * 33], sp[1 * 33]); o.y = pk2(sp[2 * 33], sp[3 * 33]); o.z = pk2(sp[4 * 33], sp[5 * 33]); o.w = pk2(sp[6 * 33], sp[7 * 33]);
            *(u32x4*)(dst + (size_t)n * 1024 + k0 + 8 * c) = o; } }
    LDS_WAIT(); asm volatile("" ::: "memory");
}
template <bool SCALE, bool OUT8> __device__ __forceinline__ void p0_transpose_item(const float* W, size_t ldw, int src_col0, void* dstv, int k0, const float* kscale, LAS float* scr, int lane) {
    f32x4 v[8]; p0_load8(W, ldw, src_col0, k0, lane, v); p0_finish<SCALE, OUT8>(v, dstv, k0, kscale, scr, lane);
}
__device__ __forceinline__ void p0_experts(Frame& F, const Args& a, int gw, int NGW) {
    const float* n2 = a.in[11]; const float* w_gu = a.in[14]; const float* w_dn = a.in[16];
    unsigned char* Wgu8 = F.ws + WS_WGU; unsigned char* Wdn8 = F.ws + WS_WDN;
    LAS float* scr = (LAS float*)(F.lds + F.wave * 16896);
    constexpr int I_GU = NE * 8 * 64, I_DN = NE * 8 * 32, NI = I_GU + I_DN;
#define P0_X_ARGS(r_) const bool gu_ = (r_) < I_GU; const int r2_ = gu_ ? (r_) : (r_) - I_GU; const int e_ = gu_ ? (r2_ >> 9) : (r2_ >> 8), q_ = gu_ ? (r2_ & 511) : (r2_ & 255), nb_ = gu_ ? (q_ & 63) : (q_ & 31), kb_ = gu_ ? (q_ >> 6) : (q_ >> 5), \
        np_ = 32 * nb_, ntile_ = np_ >> 8, lc_ = np_ & 255; const int col_ = gu_ ? ((lc_ >> 7) * 1024 + 128 * ntile_ + (lc_ & 127)) : np_; const float* W_ = gu_ ? w_gu + (size_t)e_ * D * 2048 : w_dn + (size_t)e_ * FF * D; const size_t ldw_ = gu_ ? 2048 : D; \
        unsigned char* dst_ = gu_ ? Wgu8 + ((size_t)e_ * 2048 + np_) * 1024 : Wdn8 + ((size_t)e_ * 1024 + np_) * 1024; const int k0_ = 128 * kb_
#define P0_X_LOAD(r_, v_) do { P0_X_ARGS(r_); (void)dst_; const int n4 = (F.lane & 7) * 4, kr = F.lane >> 3; \
        _Pragma("unroll") for (int i = 0; i < 16; ++i) v_[i] = *(const f32x4*)(W_ + (size_t)(k0_ + 8 * i + kr) * ldw_ + col_ + n4); } while (0)
#define P0_X_FIN(r_, v_) do { P0_X_ARGS(r_); (void)W_; (void)ldw_; (void)col_; { const int n4 = (F.lane & 7) * 4, kr = F.lane >> 3; \
        _Pragma("unroll") for (int i = 0; i < 16; ++i) { const int kk = 8 * i + kr; f32x4 x = v_[i] * 32.f; if (gu_) x = x * n2[k0_ + kk]; \
            scr[kk * 33 + n4] = x[0]; scr[kk * 33 + n4 + 1] = x[1]; scr[kk * 33 + n4 + 2] = x[2]; scr[kk * 33 + n4 + 3] = x[3]; } } \
        LDS_WAIT(); asm volatile("" ::: "memory"); \
        { const int n = F.lane >> 1, kh = F.lane & 1; const LAS float* sp = scr + (64 * kh) * 33 + n; \
          _Pragma("unroll") for (int c = 0; c < 4; ++c) { unsigned w_[4]; _Pragma("unroll") for (int q = 0; q < 4; ++q) w_[q] = pk4_fp8(sp[(16 * c + 4 * q) * 33], sp[(16 * c + 4 * q + 1) * 33], sp[(16 * c + 4 * q + 2) * 33], sp[(16 * c + 4 * q + 3) * 33]); \
              *(u32x4*)(dst_ + (size_t)n * 1024 + k0_ + 64 * kh + 16 * c) = (u32x4){w_[0], w_[1], w_[2], w_[3]}; } } \
        LDS_WAIT(); asm volatile("" ::: "memory"); } while (0)
    { f32x4 va[16], vb2[16]; int it = gw;
        if (it < NI) P0_X_LOAD(it, va);
#pragma unroll 1
        for (; it < NI; it += 2 * NGW) { const int it2 = it + NGW, it3 = it + 2 * NGW;
            if (it2 < NI) P0_X_LOAD(it2, vb2);
            P0_X_FIN(it, va);
            if (it3 < NI) P0_X_LOAD(it3, va);
            if (it2 < NI) P0_X_FIN(it2, vb2); } }
#undef P0_X_LOAD
#undef P0_X_FIN
#undef P0_X_ARGS
}
__device__ __forceinline__ void phase0(Frame& F, const Args& a) {
    const float* x = a.in[0]; const float* n1 = a.in[1]; const float* w_in = a.in[2]; const float* w_out = a.in[10]; const float* n2 = a.in[11];
    const float* w_r = a.in[12]; const float* w_gu = a.in[14]; const float* w_dn = a.in[16];
    bf16* Win_t = (bf16*)(F.ws + WS_WIN); bf16* Wout_t = (bf16*)(F.ws + WS_WOUT); bf16* Wgu_t = (bf16*)(F.ws + WS_WGU); bf16* Wdn_t = (bf16*)(F.ws + WS_WDN);
    float* wrT = (float*)(F.ws + WS_WRT); bf16* XN = (bf16*)(F.ws + WS_XN); float* BA = (float*)(F.ws + WS_BA);
    LAS float* scr = (LAS float*)(F.lds + F.wave * 8448);
    const int gw = F.vcu * NWAVES + F.wave, NGW = F.G * NWAVES;
    { bf16* wrh = (bf16*)wrT; bf16* wrl = wrh + NE * D;
      for (int i = (F.vcu * NTHREADS + F.tid); i < NE * D; i += F.G * NTHREADS) { const int e = i >> 10, k = i & 1023; const float w = n2[k] * w_r[k * NE + e];
          const unsigned hi = pk2(w, 0.f) & 0xffffu; const float lo = w - __uint_as_float(hi << 16); wrh[i] = (bf16)hi; wrl[i] = (bf16)(pk2(lo, 0.f) & 0xffffu); } }
    constexpr int I_IN = 16 * (NIN / 32), I_OUT = 16 * 32;
    for (int it = gw; it < I_IN + I_OUT; it += NGW) {
        int r = it;
        if (r < I_IN) { const int nb = r % (NIN / 32), kb = r / (NIN / 32), np = 32 * nb; int src;
            src = np < 2048 ? np : np + 8;
            if (np < 2048) p0_transpose_item<false, false>(w_in, IN_DIM, src, Win_t + (size_t)np * 1024, 64 * kb, nullptr, scr, F.lane);
            else p0_transpose_item<false, true>(w_in, IN_DIM, src, F.ws + WS_WIN8 + (size_t)(np - 2048) * 1024, 64 * kb, nullptr, scr, F.lane);
            continue; }
        r -= I_IN;
        { const int nb = r & 31, kb = r >> 5; p0_transpose_item<false, false>(w_out, D, 32 * nb, Wout_t + (size_t)(32 * nb) * 1024, 64 * kb, nullptr, scr, F.lane); }
    }
    __syncthreads();
    { LAS float* wb = (LAS float*)(F.lds + 69632);
        for (int k = F.tid; k < D; k += NTHREADS) { const float* wp = w_in + (size_t)k * IN_DIM + 2048; LAS float* dp = wb + (k >> 2) * 36 + (k & 3) * 8;
            *(LAS f32x4*)dp = *(const f32x4*)wp; *(LAS f32x4*)(dp + 4) = *(const f32x4*)(wp + 4); }
        __syncthreads();
        f32x4 n1v[4];
#pragma unroll
        for (int j = 0; j < 4; ++j) n1v[j] = *((const f32x4*)n1 + F.lane + 64 * j);
        for (int rep9 = 0; rep9 < (DUP == 9 ? 2 : 1); ++rep9)
        for (int m0 = gw * 4; m0 < T; m0 += NGW * 4) {
            f32x4 v[4][4]; float rs[4];
#pragma unroll
            for (int r = 0; r < 4; ++r)
#pragma unroll
                for (int j = 0; j < 4; ++j) v[r][j] = __builtin_nontemporal_load((const f32x4*)(x + (size_t)(m0 + r) * D) + F.lane + 64 * j);
#pragma unroll
            for (int r = 0; r < 4; ++r) { float sq = 0.f;
#pragma unroll
                for (int j = 0; j < 4; ++j) sq += (v[r][j][0] * v[r][j][0] + v[r][j][1] * v[r][j][1]) + (v[r][j][2] * v[r][j][2] + v[r][j][3] * v[r][j][3]);
                rs[r] = __builtin_amdgcn_rsqf(wave_sum(sq) * (1.f / D) + EPS); }
            float ba[4][8];
#pragma unroll
            for (int r = 0; r < 4; ++r)
#pragma unroll
                for (int c = 0; c < 8; ++c) ba[r][c] = 0.f;
#pragma unroll
            for (int j = 0; j < 4; ++j) {
#pragma unroll
                for (int r = 0; r < 4; ++r) { v[r][j] = v[r][j] * rs[r] * n1v[j];
                    *((unsigned long long*)(XN + (size_t)(m0 + r) * D) + F.lane + 64 * j) = (unsigned long long)pk2(v[r][j][0], v[r][j][1]) | ((unsigned long long)pk2(v[r][j][2], v[r][j][3]) << 32);
                    *((unsigned*)(F.ws + WS_XN8 + (size_t)(m0 + r) * D) + F.lane + 64 * j) = pk4_fp8(v[r][j][0], v[r][j][1], v[r][j][2], v[r][j][3]); }
#pragma unroll
                for (int i = 0; i < 4; ++i) { const LAS float* wp = wb + (F.lane + 64 * j) * 36 + i * 8; const f32x4 w0 = *(const LAS f32x4*)wp, w1 = *(const LAS f32x4*)(wp + 4);
#pragma unroll
                    for (int r = 0; r < 4; ++r) { const float xv = v[r][j][i];
                        ba[r][0] += xv * w0[0]; ba[r][1] += xv * w0[1]; ba[r][2] += xv * w0[2]; ba[r][3] += xv * w0[3];
                        ba[r][4] += xv * w1[0]; ba[r][5] += xv * w1[1]; ba[r][6] += xv * w1[2]; ba[r][7] += xv * w1[3]; } } }
#pragma unroll
            for (int r = 0; r < 4; ++r) {
#pragma unroll
                for (int c = 0; c < 8; ++c) ba[r][c] = wave_sum(ba[r][c]);
                if (F.lane == 0) { *(f32x4*)(BA + (size_t)(m0 + r) * 8) = (f32x4){ba[r][0], ba[r][1], ba[r][2], ba[r][3]}; *(f32x4*)(BA + (size_t)(m0 + r) * 8 + 4) = (f32x4){ba[r][4], ba[r][5], ba[r][6], ba[r][7]}; } }
        }
        __syncthreads();
    }
}

constexpr int GP = 132;
constexpr int XP = 68;
constexpr int GQ_OFF = 0, GK_OFF = 64 * GP * 4, GV_OFF = 2 * 64 * GP * 4, GW_OFF = GV_OFF + 128 * XP * 4, GAT_OFF = GW_OFF + 128 * XP * 4, GAT_P = 68;
constexpr int GRAW_OFF = GW_OFF, GRAW_BYTES = 67 * 768;
constexpr int GGC_OFF = GAT_OFF + 64 * GAT_P * 4, GBETA_OFF = GGC_OFF + 256, GDM_OFF = GBETA_OFF + 256, GEND = GDM_OFF + 4096;
static_assert(GAT_OFF + 64 * GAT_P * 4 <= GGC_OFF && GEND <= TOP_OFF, "gdn prep LDS");
__device__ __forceinline__ int permpos(int cc) { return 8 * ((cc & 15) >> 2) + (cc & 3) + 4 * (cc >> 4); }
constexpr int GBAL_OFF = 57 * 1024, GBAL_BLOCKS = 2;
constexpr int GRAWN_OFF = 0, GRAW_BLOCKS = 51, GCWL_OFF = GRAW_BLOCKS * 1024, GCWL_BLOCKS = 6;
static_assert(GBAL_OFF == GCWL_OFF + GCWL_BLOCKS * 1024 && GBAL_OFF + GBAL_BLOCKS * 1024 <= GV_OFF && 49152 + 1024 <= (int)CTL_ZERO_BYTES && (CW_BAR + XCD_BAR_WORDS) * 4 <= 49152, "prep staging regions");
__device__ __forceinline__ void gdn_prep_stage(Frame& F, const Args& a, int nu) {
    const bf16* zg = (const bf16*)(F.ws + WS_ZG); const float* convw = a.in[3]; const unsigned char* zero16 = (const unsigned char*)F.ctl + 49152 + F.lane * 16;
    const int nb = nu >> 8, nh = (nu >> 6) & 3, nn = nu & 63; const int nrow0 = nb * SEQ + nn * CHUNK, lane = F.lane; const unsigned lds0 = (unsigned)(uintptr_t)F.lds;
    const float* BA = (const float*)(F.ws + WS_BA);
    for (int d = F.wave; d < GRAW_BLOCKS + GCWL_BLOCKS + GBAL_BLOCKS; d += NWAVES) {
        if (d >= GRAW_BLOCKS + GCWL_BLOCKS) { const int c2 = d - GRAW_BLOCKS - GCWL_BLOCKS;
            glds16_asm(BA + (size_t)nrow0 * 8 + c2 * 256 + lane * 4, (unsigned)__builtin_amdgcn_readfirstlane((int)(lds0 + GBAL_OFF + c2 * 1024))); continue; }
        if (d < GRAW_BLOCKS) { int e = 64 * d + lane; e = e < 67 * 48 ? e : 67 * 48 - 1; const int rr = e / 48, ch = e % 48; const bool z = nn * CHUNK + rr - 3 < 0;
            const unsigned char* src = (const unsigned char*)(zg + (size_t)(z ? nrow0 : nrow0 + rr - 3) * 2048 + (ch >> 4) * 512 + nh * 128 + (ch & 15) * 8);
            glds16_asm(z ? zero16 : src, (unsigned)__builtin_amdgcn_readfirstlane((int)(lds0 + GRAWN_OFF + d * 1024)));
        } else { const int c = d - GRAW_BLOCKS, sg = 2 * c + (lane >> 5), ten = sg >> 2, k = sg & 3;
            glds16_asm(convw + k * 1536 + ten * 512 + nh * 128 + (lane & 31) * 4, (unsigned)__builtin_amdgcn_readfirstlane((int)(lds0 + GCWL_OFF + c * 1024))); }
    }
}
__device__ __forceinline__ void gdn_prep_gates(Frame& F, const Args& a, int h, float gate_bl, float gate_al) {
    const float* a_log = a.in[4]; const float* dt_bias = a.in[5]; LAS float* gcs = (LAS float*)(F.lds + GGC_OFF); LAS float* betas = (LAS float*)(F.lds + GBETA_OFF); const int lane = F.lane;
    const float xx = gate_al + dt_bias[h]; const float sp = xx > 20.f ? xx : log1pf(__expf(xx));
    float g = -__expf(a_log[h]) * sp;
    g += dpp_mov<0x111>(g); g += dpp_mov<0x112>(g); g += dpp_mov<0x114>(g); g += dpp_mov<0x118>(g);
    const int gi_ = __builtin_bit_cast(int, g); const float t0_ = __builtin_bit_cast(float, __builtin_amdgcn_readlane(gi_, 15)), t1_ = __builtin_bit_cast(float, __builtin_amdgcn_readlane(gi_, 31)), t2_ = __builtin_bit_cast(float, __builtin_amdgcn_readlane(gi_, 47)); const int rw = lane >> 4;
    g += (rw >= 1 ? t0_ : 0.f) + (rw >= 2 ? t1_ : 0.f) + (rw >= 3 ? t2_ : 0.f);
    gcs[lane] = g; betas[lane] = sigmoid_f(gate_bl);
}
__device__ __forceinline__ void gdn_prep_unit(Frame& F, const Args& a, int unit, int next_unit, bool first) {
    const float* BA = (const float*)(F.ws + WS_BA);
    const int b = unit >> 8, h = (unit >> 6) & 3, n = unit & 63; const int row0 = b * SEQ + n * CHUNK;
    unsigned char* rec = F.ws + WS_PREP + (size_t)unit * PREP_REC;
    LAS float* Qs = (LAS float*)(F.lds + GQ_OFF); LAS float* Ks = (LAS float*)(F.lds + GK_OFF); LAS float* Vs = (LAS float*)(F.lds + GV_OFF); LAS float* Ws = (LAS float*)(F.lds + GW_OFF);
    LAS float* AT = (LAS float*)(F.lds + GAT_OFF); LAS float* gcs = (LAS float*)(F.lds + GGC_OFF); LAS float* betas = (LAS float*)(F.lds + GBETA_OFF);
    const LAS unsigned char* raw = F.lds + GRAWN_OFF; const LAS float* cwl = (const LAS float*)(F.lds + GCWL_OFF);
    const int tid = F.tid, lane = F.lane, wave = F.wave;
    if (first) { gdn_prep_stage(F, a, unit); if (wave == 0) gdn_prep_gates(F, a, h, BA[(size_t)(row0 + lane) * 8 + h], BA[(size_t)(row0 + lane) * 8 + 4 + h]); }
    if (first) VM_WAIT(); else asm volatile("s_waitcnt vmcnt(6)" ::: "memory");
    LDS_BARRIER();
    float qv[8][2], kv[8][2], vv[8][2]; const int t0 = 8 * wave;
    {
#pragma unroll
        for (int ten = 0; ten < 3; ++ten) { const int cp = ten * 64 + lane;
            f32x2 cw[4];
#pragma unroll
            for (int k = 0; k < 4; ++k) cw[k] = *(const LAS f32x2*)(cwl + (ten * 4 + k) * 128 + 2 * lane);
            f32x2 xs[11];
#pragma unroll
            for (int k = 0; k < 11; ++k) { const unsigned w = *(const LAS unsigned*)(raw + (t0 + k) * 768 + cp * 4); xs[k] = (f32x2){bflo(w), bfhi(w)}; }
#pragma unroll
            for (int j = 0; j < 8; j += 2) { f32x2 c0 = xs[j] * cw[0], c1 = xs[j + 1] * cw[0];
#pragma unroll
                for (int k = 1; k < 4; ++k) { c0 += xs[j + k] * cw[k]; c1 += xs[j + 1 + k] * cw[k]; }
                const f32x4 sv = silu4((f32x4){c0[0], c0[1], c1[0], c1[1]});
#pragma unroll
                for (int jj = 0; jj < 2; ++jj) { const float a0 = sv[2 * jj], a1 = sv[2 * jj + 1];
                    if (ten == 0) { qv[j + jj][0] = a0; qv[j + jj][1] = a1; } else if (ten == 1) { kv[j + jj][0] = a0; kv[j + jj][1] = a1; }
                    else { const float bt = betas[t0 + j + jj]; vv[j + jj][0] = a0 * bt; vv[j + jj][1] = a1 * bt; } } } }
#pragma unroll
        for (int ch = 0; ch < 2; ++ch) { LAS float* xc = Vs + (2 * lane + ch) * XP + t0;
            *(LAS f32x4*)xc = (f32x4){vv[0][ch], vv[1][ch], vv[2][ch], vv[3][ch]}; *(LAS f32x4*)(xc + 4) = (f32x4){vv[4][ch], vv[5][ch], vv[6][ch], vv[7][ch]}; }
    }
    LDS_BARRIER();
    {
        float ssum[16];
#pragma unroll
        for (int j = 0; j < 8; ++j) { ssum[j] = qv[j][0] * qv[j][0] + qv[j][1] * qv[j][1]; ssum[8 + j] = kv[j][0] * kv[j][0] + kv[j][1] * kv[j][1]; }
        float z8[8], w4[4];
#pragma unroll
        for (int i = 0; i < 8; ++i) { auto r_ = __builtin_amdgcn_permlane32_swap(__builtin_bit_cast(unsigned, ssum[i]), __builtin_bit_cast(unsigned, ssum[i + 8]), false, false);
            z8[i] = __builtin_bit_cast(float, (unsigned)r_[0]) + __builtin_bit_cast(float, (unsigned)r_[1]); }
#pragma unroll
        for (int i = 0; i < 4; ++i) { auto r_ = __builtin_amdgcn_permlane16_swap(__builtin_bit_cast(unsigned, z8[i]), __builtin_bit_cast(unsigned, z8[i + 4]), false, false);
            w4[i] = __builtin_bit_cast(float, (unsigned)r_[0]) + __builtin_bit_cast(float, (unsigned)r_[1]); }
#pragma unroll
        for (int i = 0; i < 4; ++i) w4[i] += dpp_mov<0xB1>(w4[i]);
#pragma unroll
        for (int i = 0; i < 4; ++i) w4[i] += dpp_mov<0x4E>(w4[i]);
#pragma unroll
        for (int i = 0; i < 4; ++i) w4[i] += dpp_mov<0x141>(w4[i]);
#pragma unroll
        for (int i = 0; i < 4; ++i) w4[i] += dpp_mov<0x140>(w4[i]);
        { const float rscale = lane < 32 ? 0.08838834764831845f : 1.f;
#pragma unroll
          for (int i = 0; i < 4; ++i) w4[i] = __builtin_amdgcn_rsqf(w4[i] + EPS) * rscale; }
#pragma unroll
        for (int j = 0; j < 8; ++j) { ssum[j] = __builtin_bit_cast(float, __builtin_amdgcn_readlane(__builtin_bit_cast(int, w4[j & 3]), 16 * (j >> 2)));
            ssum[8 + j] = __builtin_bit_cast(float, __builtin_amdgcn_readlane(__builtin_bit_cast(int, w4[j & 3]), 32 + 16 * (j >> 2))); }
#pragma unroll
        for (int j = 0; j < 8; ++j) { const int t = t0 + j; const float fq_ = ssum[j], fk_ = ssum[8 + j]; const float eg = betas[t] * __expf(gcs[t]);
            const f32x2 kk = (f32x2){kv[j][0] * fk_, kv[j][1] * fk_};
            *(LAS f32x2*)(Qs + t * GP + 2 * lane) = (f32x2){qv[j][0] * fq_, qv[j][1] * fq_}; *(LAS f32x2*)(Ks + t * GP + 2 * lane) = kk; vv[j][0] = kk[0] * eg; vv[j][1] = kk[1] * eg; }
#pragma unroll
        for (int ch = 0; ch < 2; ++ch) { LAS float* xc = Ws + (2 * lane + ch) * XP + t0;
            *(LAS f32x4*)xc = (f32x4){vv[0][ch], vv[1][ch], vv[2][ch], vv[3][ch]}; *(LAS f32x4*)(xc + 4) = (f32x4){vv[4][ch], vv[5][ch], vv[6][ch], vv[7][ch]}; }
    }
    LDS_BARRIER();
    {
        const int which = wave >> 2, ti = (wave >> 1) & 1, tj = wave & 1, r32 = lane & 31, hh = lane >> 5;
        const LAS float* Xa = (which ? Ks + (32 * tj + r32) * GP : Ks + (32 * ti + r32) * GP) + 8 * hh; const LAS float* Xb = (which ? Qs + (32 * ti + r32) * GP : Ks + (32 * tj + r32) * GP) + 8 * hh;
        f32x16 acc = {};
#pragma unroll
        for (int ks = 0; ks < 8; ++ks) { const bf16x8 af = pack8(*(const LAS f32x4*)(Xa + 16 * ks), *(const LAS f32x4*)(Xa + 16 * ks + 4)), bf = pack8(*(const LAS f32x4*)(Xb + 16 * ks), *(const LAS f32x4*)(Xb + 16 * ks + 4));
            acc = __builtin_amdgcn_mfma_f32_32x32x16_bf16(af, bf, acc, 0, 0, 0); }
        if (which == 0) {
            const int j = 32 * tj + r32; const float gj = gcs[j];
#pragma unroll
            for (int q = 0; q < 4; ++q) { float vals[4];
#pragma unroll
                for (int rr = 0; rr < 4; ++rr) { const int i = 32 * ti + 8 * q + 4 * hh + rr; const float bi_ = betas[i]; const float dec = __expf(fminf(gcs[i] - gj, 0.f)); const float v_ = bi_ * acc[4 * q + rr] * dec; vals[rr] = i > j ? v_ : 0.f; }
                *(LAS f32x4*)(AT + j * GAT_P + 32 * ti + 8 * q + 4 * hh) = (f32x4){vals[0], vals[1], vals[2], vals[3]}; }
        } else {
            const int i = 32 * ti + r32; const float gi = gcs[i]; bf16* Af = (bf16*)(rec + PREP_AP) + (i >> 4) * 1024 + (i & 15) * 8 + tj * 512;
#pragma unroll
            for (int q = 0; q < 4; ++q) { float vals[4]; const int cc0 = 8 * q + 4 * hh;
#pragma unroll
                for (int rr = 0; rr < 4; ++rr) { const int j = 32 * tj + cc0 + rr; const float dec = __expf(fminf(gi - gcs[j], 0.f)); vals[rr] = i >= j ? acc[4 * q + rr] * dec : 0.f; }
                const int jpos = permpos(cc0); *(u32x2*)(Af + (jpos >> 3) * 128 + (jpos & 7)) = (u32x2){pk2(vals[0], vals[1]), pk2(vals[2], vals[3])}; }
        }
    }
    LDS_BARRIER();
    LAS float* Dm = (LAS float*)(F.lds + GDM_OFF);
    if (wave < 4) {
        if (lane < 16) { const int i0 = 16 * wave; float r[16];
#pragma unroll
            for (int ii = 0; ii < 16; ++ii) r[ii] = (ii == lane) ? 1.f : 0.f;
#pragma unroll
            for (int j = 0; j < 16; ++j) { const float xj = r[j]; const LAS f32x4* ap = (const LAS f32x4*)(AT + (i0 + j) * GAT_P + i0); float av[16];
#pragma unroll
                for (int q = 0; q < 4; ++q) { const f32x4 t4 = ap[q]; av[4 * q] = t4[0]; av[4 * q + 1] = t4[1]; av[4 * q + 2] = t4[2]; av[4 * q + 3] = t4[3]; }
#pragma unroll
                for (int ii = 0; ii < 16; ++ii) if (ii > j) r[ii] -= av[ii] * xj; }
#pragma unroll
            for (int ii = 0; ii < 16; ++ii) Dm[wave * 256 + ii * 16 + lane] = r[ii]; }
    } else {
        const int t2 = tid - 256; bf16* Qf = (bf16*)(rec + PREP_QP); bf16* Kf = (bf16*)(rec + PREP_KT); const float gl = gcs[63];
#pragma unroll
        for (int it = t2; it < 1024; it += 256) { const int blk = it >> 6, l = it & 63, mi = blk >> 2, ks = blk & 3, g = l >> 4, c = 16 * mi + (l & 15); const float eg = __expf(gcs[c]);
            const f32x4 lo = *(LAS f32x4*)(Qs + c * GP + 32 * ks + 4 * g) * eg, hi = *(LAS f32x4*)(Qs + c * GP + 32 * ks + 16 + 4 * g) * eg;
            __builtin_nontemporal_store(pack8(lo, hi), (bf16x8*)(Qf + it * 8)); }
#pragma unroll
        for (int it = t2; it < 1024; it += 256) { const int blk = it >> 6, l = it & 63, ti = blk >> 1, ks2 = blk & 1, g = l >> 4, dk = 16 * ti + (l & 15); float v[8];
#pragma unroll
            for (int j = 0; j < 8; ++j) { const int c = 32 * ks2 + (j < 4 ? 4 * g + j : 16 + 4 * g + (j - 4)); v[j] = Ks[c * GP + dk] * __expf(gl - gcs[c]); }
            __builtin_nontemporal_store(pack8((f32x4){v[0], v[1], v[2], v[3]}, (f32x4){v[4], v[5], v[6], v[7]}), (bf16x8*)(Kf + it * 8)); }
        if (t2 == 0) *(float*)(rec + PREP_CD) = __expf(gl);
    }
    LDS_BARRIER();
    const int nh_ = (next_unit >> 6) & 3;
    if (next_unit >= 0) gdn_prep_stage(F, a, next_unit);
    {
        const int fr = lane & 15, g = lane >> 4;
#pragma unroll
        for (int bb = 0; bb < 4; ++bb) {
            const int i0 = 16 * bb;
            bf16x8 Af[2];
            float at_[2][8];
#pragma unroll
            for (int ks = 0; ks < 2; ++ks)
#pragma unroll
                for (int j = 0; j < 8; ++j) at_[ks][j] = AT[(32 * ks + 8 * g + j) * GAT_P + i0 + fr];
#pragma unroll
            for (int ks = 0; ks < 2; ++ks) { float av[8];
#pragma unroll
                for (int j = 0; j < 8; ++j) { const int kr = 32 * ks + 8 * g + j; av[j] = kr < i0 ? -at_[ks][j] : 0.f; }
                Af[ks] = pack8((f32x4){av[0], av[1], av[2], av[3]}, (f32x4){av[4], av[5], av[6], av[7]}); }
            const f32x4 dv4 = *(const LAS f32x4*)(Dm + bb * 256 + fr * 16 + 4 * g);
            const bf16x8 Df = pack8(dv4, (f32x4){0.f, 0.f, 0.f, 0.f});
#pragma unroll
            for (int nt = 0; nt < 2; ++nt) { const int col = 32 * wave + 16 * nt + fr; LAS float* X = (col < 128 ? Vs + col * XP : Ws + (col - 128) * XP);
                f32x4 acc = *(const LAS f32x4*)(X + i0 + 4 * g);
                if (bb > 0) {
#pragma unroll
                    for (int ks = 0; ks < 2; ++ks) { if (32 * ks < i0) {
                        acc = __builtin_amdgcn_mfma_f32_16x16x32_bf16(Af[ks], pack8(*(const LAS f32x4*)(X + 32 * ks + 8 * g), *(const LAS f32x4*)(X + 32 * ks + 8 * g + 4)), acc, 0, 0, 0); } } }
                const f32x4 xb = __builtin_amdgcn_mfma_f32_16x16x32_bf16(Df, pack8(acc, (f32x4){0.f, 0.f, 0.f, 0.f}), (f32x4){0.f, 0.f, 0.f, 0.f}, 0, 0, 0);
                *(LAS f32x4*)(X + i0 + 4 * g) = xb; }
        }
    }
    if (next_unit >= 0 && (wave == 1 || wave == 2)) VM_WAIT();
    LDS_BARRIER();
    { float* Up = (float*)(rec + PREP_UP); bf16* Wf = (bf16*)(rec + PREP_WP);
#pragma unroll
        for (int it = tid; it < 2048; it += NTHREADS) { const int dv = it & 127, g = (it >> 7) & 3, mi = it >> 9; const int c0 = 16 * mi + 4 * g;
            __builtin_nontemporal_store(*(const LAS f32x4*)(Vs + dv * XP + c0), (f32x4*)(Up + (size_t)it * 4)); }
#pragma unroll
        for (int it = tid; it < 1024; it += NTHREADS) { const int blk = it >> 6, l = it & 63, mi = blk >> 2, ks = blk & 3, g = l >> 4, c = 16 * mi + (l & 15);
            const LAS float* wc_ = Ws + (32 * ks + 4 * g) * XP + c;
            __builtin_nontemporal_store(pack8((f32x4){wc_[0], wc_[XP], wc_[2 * XP], wc_[3 * XP]}, (f32x4){wc_[16 * XP], wc_[17 * XP], wc_[18 * XP], wc_[19 * XP]}), (bf16x8*)(Wf + it * 8)); }
    }
    if (next_unit >= 0 && wave == 0) { const LAS float* bal = (const LAS float*)(F.lds + GBAL_OFF); gdn_prep_gates(F, a, nh_, bal[lane * 8 + nh_], bal[lane * 8 + 4 + nh_]); }
}

constexpr int SC_BUFSZ = 57344, SC_OT = 2 * SC_BUFSZ, SC_OTSZ = 64 * 128 * 2, SC_END = SC_OT + 2 * SC_OTSZ;
static_assert(SC_END <= TOP_OFF, "scan LDS");
__device__ __forceinline__ void gdn_scan(Frame& F, const Args& a, int bh) {
    const int tid = F.tid, lane = F.lane, w = F.wave, fr = lane & 15, g = lane >> 4; const int b = bh >> 2, h = bh & 3;
    const unsigned char* rec0 = F.ws + WS_PREP + (size_t)bh * NCHUNK * PREP_REC;
    const float* gnw = a.in[6]; const bf16* zg = (const bf16*)(F.ws + WS_ZG); bf16* mix = (bf16*)(F.ws + WS_MIX);
    const size_t rowb = (size_t)b * SEQ; const unsigned lds0 = (unsigned)(uintptr_t)F.lds;
    if (w >= 4) {
        const int hw = w - 4, l16 = lane & 15, rq = lane >> 4;
#define SC_DMA(n_, buf_) do { const unsigned char* src_ = rec0 + (size_t)(n_) * PREP_REC + hw * 14336 + lane * 16; _Pragma("unroll") for (int r_ = 0; r_ < 14; ++r_) \
        glds16_asm_nt(src_ + r_ * 1024, (unsigned)__builtin_amdgcn_readfirstlane((int)(lds0 + (buf_) * SC_BUFSZ + hw * 14336 + r_ * 1024))); } while (0)
#define SC_NORM(n_, gv) do { const LAS unsigned char* ot = F.lds + SC_OT + ((n_) & 1) * SC_OTSZ; _Pragma("unroll") for (int q_ = 0; q_ < 4; ++q_) { const int t = 16 * hw + 4 * q_ + rq; \
            const u32x4 ov = *(const LAS u32x4*)(ot + t * 256 + l16 * 16); const f32x4 xa = {bflo(ov.x), bfhi(ov.x), bflo(ov.y), bfhi(ov.y)}, xb = {bflo(ov.z), bfhi(ov.z), bflo(ov.w), bfhi(ov.w)}; \
            float ss_ = (xa[0] * xa[0] + xa[1] * xa[1]) + (xa[2] * xa[2] + xa[3] * xa[3]) + (xb[0] * xb[0] + xb[1] * xb[1]) + (xb[2] * xb[2] + xb[3] * xb[3]); \
            ss_ = sum_row16(ss_); const float sc = __builtin_amdgcn_rsqf(ss_ * (1.f / 128.f) + EPS); \
            const u32x4 gz = gv[q_]; const f32x4 ga = {bflo(gz.x), bfhi(gz.x), bflo(gz.y), bfhi(gz.y)}, gb = {bflo(gz.z), bfhi(gz.z), bflo(gz.w), bfhi(gz.w)}; \
            *(bf16x8*)(mix + (rowb + (n_) * CHUNK + t) * 1024 + h * 128 + 8 * l16) = pack8(xa * sc * ga, xb * sc * gb); } } while (0)
        u32x4 gc_[4], gn_[4];
        SC_DMA(0, 0);
#pragma unroll
        for (int q = 0; q < 4; ++q) gc_[q] = (u32x4){0u, 0u, 0u, 0u};
        VM_WAIT(); __syncthreads();
#pragma unroll 1
        for (int n = 0; n < NCHUNK; ++n) {
#pragma unroll
            for (int q = 0; q < 4; ++q) gn_[q] = *(const u32x4*)(zg + (rowb + n * CHUNK + 16 * hw + 4 * q + rq) * 2048 + 1536 + h * 128 + 8 * l16);
            if (n + 1 < NCHUNK) SC_DMA(n + 1, (n + 1) & 1);
            if (n > 0) SC_NORM(n - 1, gc_);
            if (n > 0) asm volatile("s_waitcnt vmcnt(4)" ::: "memory"); else VM_WAIT();
            LDS_BARRIER();
#pragma unroll
            for (int q = 0; q < 4; ++q) gc_[q] = gn_[q];
        }
        SC_NORM(NCHUNK - 1, gc_);
#undef SC_DMA
#undef SC_NORM
    } else {
        f32x4 S[2][8];
#pragma unroll
        for (int sl = 0; sl < 2; ++sl)
#pragma unroll
            for (int i = 0; i < 8; ++i) S[sl][i] = (f32x4){0.f, 0.f, 0.f, 0.f};
        f32x4 Un[2][4]; float cd = *(const float*)(rec0 + PREP_CD), cdn;
#pragma unroll
        for (int sl = 0; sl < 2; ++sl)
#pragma unroll
            for (int mi = 0; mi < 4; ++mi) Un[sl][mi] = __builtin_nontemporal_load((const f32x4*)((const float*)(rec0 + PREP_UP) + (size_t)((mi * 4 + g) * 128 + 32 * w + 16 * sl + fr) * 4));
        __syncthreads();
#pragma unroll 1
        for (int n = 0; n < NCHUNK; ++n) {
            const LAS unsigned char* B = F.lds + (n & 1) * SC_BUFSZ + lane * 16;
            f32x4 vn[2][4], o[2][4];
            { bf16x8 Sb[2][4];
#pragma unroll
                for (int sl = 0; sl < 2; ++sl)
#pragma unroll
                    for (int ks = 0; ks < 4; ++ks) Sb[sl][ks] = pack8(S[sl][2 * ks], S[sl][2 * ks + 1]);
                bf16x8 wfa[2][4], qfa[2][4];
#pragma unroll
                for (int ks = 0; ks < 4; ++ks) { wfa[0][ks] = *(const LAS bf16x8*)(B + PREP_WP + ks * 1024); qfa[0][ks] = *(const LAS bf16x8*)(B + PREP_QP + ks * 1024); }
#pragma unroll
                for (int mi = 0; mi < 4; ++mi) { f32x4 t1[2], oo[2];
                    if (mi < 3) {
#pragma unroll
                        for (int ks = 0; ks < 4; ++ks) { wfa[(mi + 1) & 1][ks] = *(const LAS bf16x8*)(B + PREP_WP + ((mi + 1) * 4 + ks) * 1024); qfa[(mi + 1) & 1][ks] = *(const LAS bf16x8*)(B + PREP_QP + ((mi + 1) * 4 + ks) * 1024); } }
#pragma unroll
                    for (int sl = 0; sl < 2; ++sl) { t1[sl] = (f32x4){0.f, 0.f, 0.f, 0.f}; oo[sl] = (f32x4){0.f, 0.f, 0.f, 0.f}; }
#pragma unroll
                    for (int ks = 0; ks < 4; ++ks) { const bf16x8 wf = wfa[mi & 1][ks], qf = qfa[mi & 1][ks];
#pragma unroll
                        for (int sl = 0; sl < 2; ++sl) { t1[sl] = __builtin_amdgcn_mfma_f32_16x16x32_bf16(wf, Sb[sl][ks], t1[sl], 0, 0, 0); oo[sl] = __builtin_amdgcn_mfma_f32_16x16x32_bf16(qf, Sb[sl][ks], oo[sl], 0, 0, 0); } }
#pragma unroll
                    for (int sl = 0; sl < 2; ++sl) { vn[sl][mi] = Un[sl][mi] - t1[sl]; o[sl][mi] = oo[sl]; } } }
            { const int nn = n + 1 < NCHUNK ? n + 1 : n; cdn = *(const float*)(rec0 + (size_t)nn * PREP_REC + PREP_CD);
#pragma unroll
                for (int sl = 0; sl < 2; ++sl)
#pragma unroll
                    for (int mi = 0; mi < 4; ++mi) Un[sl][mi] = __builtin_nontemporal_load((const f32x4*)((const float*)(rec0 + (size_t)nn * PREP_REC + PREP_UP) + (size_t)((mi * 4 + g) * 128 + 32 * w + 16 * sl + fr) * 4)); }
            bf16x8 Vb[2][2];
#pragma unroll
            for (int sl = 0; sl < 2; ++sl)
#pragma unroll
                for (int ks = 0; ks < 2; ++ks) Vb[sl][ks] = pack8(vn[sl][2 * ks], vn[sl][2 * ks + 1]);
#pragma unroll
            for (int mi = 0; mi < 4; ++mi) {
#pragma unroll
                for (int ks = 0; ks < 2; ++ks) { const bf16x8 af = *(const LAS bf16x8*)(B + PREP_AP + (mi * 2 + ks) * 1024);
#pragma unroll
                    for (int sl = 0; sl < 2; ++sl) o[sl][mi] = __builtin_amdgcn_mfma_f32_16x16x32_bf16(af, Vb[sl][ks], o[sl][mi], 0, 0, 0); }
#pragma unroll
                for (int sl = 0; sl < 2; ++sl) { LAS bf16* otw = (LAS bf16*)(F.lds + SC_OT + (n & 1) * SC_OTSZ) + 32 * w + 16 * sl + fr;
                    const unsigned p01 = pk2(o[sl][mi][0], o[sl][mi][1]), p23 = pk2(o[sl][mi][2], o[sl][mi][3]);
                    otw[(16 * mi + 4 * g) * 128] = (bf16)(p01 & 0xffffu); otw[(16 * mi + 4 * g + 1) * 128] = (bf16)(p01 >> 16); otw[(16 * mi + 4 * g + 2) * 128] = (bf16)(p23 & 0xffffu); otw[(16 * mi + 4 * g + 3) * 128] = (bf16)(p23 >> 16); } }
#pragma unroll
            for (int ti = 0; ti < 8; ++ti) { f32x4 s0 = S[0][ti] * cd, s1 = S[1][ti] * cd;
#pragma unroll
                for (int ks = 0; ks < 2; ++ks) { const bf16x8 kf = *(const LAS bf16x8*)(B + PREP_KT + (ti * 2 + ks) * 1024);
                    s0 = __builtin_amdgcn_mfma_f32_16x16x32_bf16(kf, Vb[0][ks], s0, 0, 0, 0); s1 = __builtin_amdgcn_mfma_f32_16x16x32_bf16(kf, Vb[1][ks], s1, 0, 0, 0); }
                S[0][ti] = s0; S[1][ti] = s1; }
            LDS_BARRIER();
            cd = cdn;
        }
    }
    __syncthreads();
}

constexpr int AT_K = 0, AT_V = 49152, AT_BIAS = 98304, AT_LW = 98304 + 1024, AT_END = AT_LW + 1024;
constexpr size_t WS_P4 = 616 * MiB, WS_P16 = 648 * MiB, WS_L4 = 744 * MiB, WS_L16 = 745 * MiB;
static_assert(WS_P16 + (size_t)T * 512 * 2 <= WS_MIX && WS_L16 + (size_t)T * 8 * 4 <= WS_XN, "attention partial buffers");
__device__ __forceinline__ void attn_unit(Frame& F, const Args& a, int u) {
    int kind, b, h, r, q0;
    if (u < 1024) { kind = 2; b = u >> 7; h = (u >> 4) & 7; r = u & 15; q0 = 0; }
    else if (u < 2048) { const int v = u - 1024; kind = 1; b = v >> 7; h = (v >> 4) & 7; r = (v >> 2) & 3; q0 = (v & 3) * 256; }
    else { const int v = u - 2048; kind = 0; b = v >> 7; h = (v >> 4) & 7; r = 0; q0 = (v & 15) * 256; }
    const int dsh = 2 * kind, lmax = (SEQ >> dsh) - 1;
    const bf16* qb = (const bf16*)(F.ws + WS_QB); const bf16* kb = (const bf16*)(F.ws + WS_KB); const bf16* vb = (const bf16*)(F.ws + WS_VB); bf16* mix = (bf16*)(F.ws + WS_MIX);
    const float* relb = a.in[9];
    LAS float* biasL = (LAS float*)(F.lds + AT_BIAS); LAS float* lw = (LAS float*)(F.lds + AT_LW) + F.wave * 32;
    const int tid = F.tid, lane = F.lane, w = F.wave, c = lane & 31, hh = lane >> 5;
    const size_t hrow = (size_t)(b * AH + h) * SEQ; const unsigned lds0 = (unsigned)(uintptr_t)F.lds;
    { const int ro = lane >> 3, p = lane & 7;
#pragma unroll
        for (int i = 0; i < 6; ++i) { const int lr = 48 * w + 8 * i + ro; int pos = q0 - 128 + lr; pos = pos < 0 ? 0 : (pos > lmax ? lmax : pos);
            const size_t eo = (hrow + (size_t)(pos << dsh) + r) * 64 + (size_t)((p ^ (lr & 7)) * 8);
            glds16_asm(kb + eo, (unsigned)__builtin_amdgcn_readfirstlane((int)(lds0 + AT_K + (48 * w + 8 * i) * 128)));
            glds16_asm(vb + eo, (unsigned)__builtin_amdgcn_readfirstlane((int)(lds0 + AT_V + (48 * w + 8 * i) * 128))); } }
    if (tid < 192) { const int s_ = tid - 32, sc_ = s_ < 0 ? 0 : (s_ > 128 ? 128 : s_); biasL[tid] = relb[(int)T5B[kind][sc_] * AH + h] * LOG2E; }
    const int qi = q0 + 32 * w + c;
    bf16x8 Qf[4];
    { const bf16* qp = qb + (hrow + (size_t)(qi << dsh) + r) * 64 + 8 * hh;
#pragma unroll
        for (int ks = 0; ks < 4; ++ks) Qf[ks] = *(const bf16x8*)(qp + 16 * ks); }
    u32x4 m4[4], m16[4]; float ml4 = 0.f, ml16 = 0.f;
    { const int row_ = lane >> 1, half_ = lane & 1; const size_t tok_ = (size_t)b * SEQ + (size_t)((q0 + 32 * w + row_) << dsh) + r;
      if (kind == 0) { const bf16* p4 = (const bf16*)(F.ws + WS_P4) + (tok_ * 8 + h) * 64 + 32 * half_; const bf16* p16 = (const bf16*)(F.ws + WS_P16) + (tok_ * 8 + h) * 64 + 32 * half_;
#pragma unroll
          for (int q = 0; q < 4; ++q) { m4[q] = *(const u32x4*)(p4 + 8 * q); m16[q] = *(const u32x4*)(p16 + 8 * q); }
          ml4 = ((const float*)(F.ws + WS_L4))[tok_ * 8 + h]; ml16 = ((const float*)(F.ws + WS_L16))[tok_ * 8 + h]; }
      else {
#pragma unroll
          for (int q = 0; q < 4; ++q) { m4[q] = (u32x4){0u, 0u, 0u, 0u}; m16[q] = (u32x4){0u, 0u, 0u, 0u}; } } }
    VM_WAIT(); __syncthreads();
    f32x16 O0 = {}, O1 = {}; float lsum = 0.f;
    const int kt0 = (128 - q0 - 32 * w) > 0 ? ((128 - q0 - 32 * w) >> 5) : 0;
    const int li = lane & 15, gq = lane >> 4;
    int kofs[4];
#pragma unroll
    for (int ks = 0; ks < 4; ++ks) kofs[ks] = c * 128 + (((2 * ks + hh) ^ (c & 7)) * 16);
    int vofs[2];
#pragma unroll
    for (int ntl = 0; ntl < 2; ++ntl) { const int rl = 4 * hh + (li >> 2), ch = 4 * ntl + 2 * (gq & 1) + ((li & 3) >> 1); vofs[ntl] = rl * 128 + ((ch ^ (rl & 7)) * 16) + (li & 1) * 8; }
    const int sb0 = 128 + 32 + c - 4 * hh;
#pragma unroll 1
    for (int kt = kt0; kt < 5; ++kt) {
        const int lr0 = 32 * (w + kt);
        f32x16 sT = {};
        { const LAS unsigned char* kp = F.lds + AT_K + lr0 * 128;
#pragma unroll
            for (int ks = 0; ks < 4; ++ks) { const bf16x8 kf = *(const LAS bf16x8*)(kp + kofs[ks]); sT = __builtin_amdgcn_mfma_f32_32x32x16_bf16(kf, Qf[ks], sT, 0, 0, 0); } }
        float p[16]; const int sb = sb0 - 32 * kt; const LAS float* bl = biasL + sb;
        if (kt == 0) {
#pragma unroll
            for (int reg = 0; reg < 16; ++reg) { const int krr = (reg & 3) + 8 * (reg >> 2); const float e = __builtin_amdgcn_exp2f(sT[reg] + bl[-krr]); p[reg] = (sb - krr <= 128 + 32) ? e : 0.f; lsum += p[reg]; }
        } else if (kt == 4) {
#pragma unroll
            for (int reg = 0; reg < 16; ++reg) { const int krr = (reg & 3) + 8 * (reg >> 2); const float e = __builtin_amdgcn_exp2f(sT[reg] + bl[-krr]); p[reg] = (sb - krr >= 32) ? e : 0.f; lsum += p[reg]; }
        } else {
#pragma unroll
            for (int reg = 0; reg < 16; ++reg) { p[reg] = __builtin_amdgcn_exp2f(sT[reg] + bl[-((reg & 3) + 8 * (reg >> 2))]); lsum += p[reg]; }
        }
        bf16x8 Pf[2];
#pragma unroll
        for (int s2 = 0; s2 < 2; ++s2) { u32x4 wv; wv.x = pk2(p[8 * s2], p[8 * s2 + 1]); wv.y = pk2(p[8 * s2 + 2], p[8 * s2 + 3]); wv.z = pk2(p[8 * s2 + 4], p[8 * s2 + 5]); wv.w = pk2(p[8 * s2 + 6], p[8 * s2 + 7]); Pf[s2] = __builtin_bit_cast(bf16x8, wv); }
        const LAS unsigned char* vp = F.lds + AT_V + lr0 * 128;
#pragma unroll
        for (int s2 = 0; s2 < 2; ++s2)
#pragma unroll
            for (int ntl = 0; ntl < 2; ++ntl) {
                const s16x4 lo = __builtin_bit_cast(s16x4, __builtin_amdgcn_ds_read_tr16_b64_v4i16((LAS s16x4*)(vp + vofs[ntl] + s2 * 2048)));
                const s16x4 hi = __builtin_bit_cast(s16x4, __builtin_amdgcn_ds_read_tr16_b64_v4i16((LAS s16x4*)(vp + vofs[ntl] + s2 * 2048 + 1024)));
                const bf16x8 vf = (bf16x8){lo[0], lo[1], lo[2], lo[3], hi[0], hi[1], hi[2], hi[3]};
                if (ntl == 0) O0 = __builtin_amdgcn_mfma_f32_32x32x16_bf16(Pf[s2], vf, O0, 0, 0, 0); else O1 = __builtin_amdgcn_mfma_f32_32x32x16_bf16(Pf[s2], vf, O1, 0, 0, 0);
            }
    }
    lsum = sum_xor32(lsum);
    if (hh == 0) lw[c] = lsum;
    LDS_BARRIER();
    { LAS float* ost = (LAS float*)(F.lds + w * 8192);
#pragma unroll
        for (int reg = 0; reg < 16; ++reg) { const int qrow = (reg & 3) + 8 * (reg >> 2) + 4 * hh; ost[qrow * 64 + c] = O0[reg]; ost[qrow * 64 + 32 + c] = O1[reg]; }
        LDS_WAIT();
        const int row = lane >> 1, half = lane & 1; const float l1 = lw[row]; const LAS f32x4* op = (const LAS f32x4*)(ost + row * 64 + 32 * half);
        const size_t tok = (size_t)b * SEQ + (size_t)((q0 + 32 * w + row) << dsh) + r;
        if (kind != 0) {
            bf16* pp = (bf16*)(F.ws + (kind == 1 ? WS_P4 : WS_P16)) + (tok * 8 + h) * 64 + 32 * half; const float inv = __builtin_amdgcn_rcpf(l1);
#pragma unroll
            for (int q = 0; q < 4; ++q) *(bf16x8*)(pp + 8 * q) = pack8(op[2 * q] * inv, op[2 * q + 1] * inv);
            if (half == 0) ((float*)(F.ws + (kind == 1 ? WS_L4 : WS_L16)))[tok * 8 + h] = l1;
        } else {
            const float l4 = ml4, l16 = ml16; const float inv = __builtin_amdgcn_rcpf(l1 + l4 + l16);
            bf16* dst = mix + tok * 1024 + 512 + h * 64 + 32 * half;
#pragma unroll
            for (int q = 0; q < 4; ++q) { const u32x4 a4 = m4[q], a16 = m16[q];
                const f32x4 x0 = (op[2 * q] + (f32x4){bflo(a4.x), bfhi(a4.x), bflo(a4.y), bfhi(a4.y)} * l4 + (f32x4){bflo(a16.x), bfhi(a16.x), bflo(a16.y), bfhi(a16.y)} * l16) * inv;
                const f32x4 x1 = (op[2 * q + 1] + (f32x4){bflo(a4.z), bfhi(a4.z), bflo(a4.w), bfhi(a4.w)} * l4 + (f32x4){bflo(a16.z), bfhi(a16.z), bflo(a16.w), bfhi(a16.w)} * l16) * inv;
                *(bf16x8*)(dst + 8 * q) = pack8(x0, x1); }
        }
    }
    LDS_BARRIER();
}

constexpr int RT_LCNT = 0, RT_BASE = 256, RT_RANK = 512;
__device__ __forceinline__ void route_phase(Frame& F, const Args& a) {
    const bf16* hsrc = (const bf16*)(F.ws + WS_HBF); const bf16* wrT = (const bf16*)(F.ws + WS_WRT); const float* b_r = a.in[13];
    int* te = (int*)(F.ws + WS_TE); int* tslot = (int*)(F.ws + WS_TSLOT); float* tg = (float*)(F.ws + WS_TG); int* list = (int*)(F.ws + WS_LIST); float* lrs = (float*)(F.ws + WS_LRS);
    LAS int* lcnt = (LAS int*)(F.lds + RT_LCNT); LAS int* lbase = (LAS int*)(F.lds + RT_BASE); LAS int* lrank = (LAS int*)(F.lds + RT_RANK);
    const int lane = F.lane, c = lane & 31, hh = lane >> 5;
    for (int blk = F.vcu; blk < T / 128; blk += F.G) {
        if (F.tid < 32) lcnt[F.tid] = 0;
        __syncthreads();
        int e4[4] = {0, 0, 0, 0}, rk[4] = {0, 0, 0, 0}; float g4[4] = {0.f, 0.f, 0.f, 0.f}; float rs = 0.f; const int tok = blk * 128 + (F.wave & 3) * 32 + c;
        f32x16 acc = {}; float ss = 0.f;
        { const int kh = F.wave >> 2; const bf16* hp = hsrc + (size_t)tok * D + 8 * hh + 512 * kh; const bf16* wph = (const bf16*)wrT + (size_t)c * D + 8 * hh + 512 * kh; const bf16* wpl = wph + NE * D;
#pragma unroll 8
            for (int q = 0; q < 32; ++q) { const u32x4 hr = *(const u32x4*)(hp + 16 * q); const bf16x8 wh = *(const bf16x8*)(wph + 16 * q), wl = *(const bf16x8*)(wpl + 16 * q);
                const f32x4 ha = {bflo(hr.x), bfhi(hr.x), bflo(hr.y), bfhi(hr.y)}, hb2 = {bflo(hr.z), bfhi(hr.z), bflo(hr.w), bfhi(hr.w)};
                ss += (ha[0] * ha[0] + ha[1] * ha[1]) + (ha[2] * ha[2] + ha[3] * ha[3]) + (hb2[0] * hb2[0] + hb2[1] * hb2[1]) + (hb2[2] * hb2[2] + hb2[3] * hb2[3]);
                const bf16x8 hv = __builtin_bit_cast(bf16x8, hr);
                acc = __builtin_amdgcn_mfma_f32_32x32x16_bf16(wh, hv, acc, 0, 0, 0); acc = __builtin_amdgcn_mfma_f32_32x32x16_bf16(wl, hv, acc, 0, 0, 0); }
            LAS float* px = (LAS float*)(F.lds + 4096) + ((F.wave & 3) * 64 + lane) * 17;
            if (F.wave >= 4) {
#pragma unroll
                for (int r = 0; r < 16; ++r) px[r] = acc[r];
                px[16] = ss; }
            __syncthreads();
            if (F.wave < 4) {
#pragma unroll
                for (int r = 0; r < 16; ++r) acc[r] += px[r];
                ss += px[16]; } }
        if (F.wave < 4) {
            ss = sum_xor32(ss); rs = __builtin_amdgcn_rsqf(ss * (1.f / D) + EPS);
            float tv[4] = {-3.0e38f, -3.0e38f, -3.0e38f, -3.0e38f}; int tix[4] = {0, 1, 2, 3};
            f32x4 brv[4];
#pragma unroll
            for (int q = 0; q < 4; ++q) brv[q] = *(const f32x4*)(b_r + 8 * q + 4 * hh);
#pragma unroll
            for (int reg = 0; reg < 16; ++reg) { const int e = (reg & 3) + 8 * (reg >> 2) + 4 * hh; float v = acc[reg] * rs + brv[reg >> 2][reg & 3]; int ix = e;
#pragma unroll
                for (int s = 0; s < 4; ++s) { const bool gt = (v > tv[s]) || (v == tv[s] && ix < tix[s]); const float ov = tv[s]; const int oi = tix[s]; tv[s] = gt ? v : ov; tix[s] = gt ? ix : oi; v = gt ? ov : v; ix = gt ? oi : ix; } }
            float pv[4]; int pi[4];
#pragma unroll
            for (int s = 0; s < 4; ++s) { pv[s] = __shfl_xor(tv[s], 32); pi[s] = __shfl_xor(tix[s], 32); }
#pragma unroll
            for (int t2 = 0; t2 < 4; ++t2) { float v = pv[t2]; int ix = pi[t2];
#pragma unroll
                for (int s = 0; s < 4; ++s) { const bool gt = (v > tv[s]) || (v == tv[s] && ix < tix[s]); const float ov = tv[s]; const int oi = tix[s]; tv[s] = gt ? v : ov; tix[s] = gt ? ix : oi; v = gt ? ov : v; ix = gt ? oi : ix; } }
            const float e0 = 1.f, e1 = __expf(tv[1] - tv[0]), e2 = __expf(tv[2] - tv[0]), e3 = __expf(tv[3] - tv[0]); const float inv = 1.f / (e0 + e1 + e2 + e3);
            g4[0] = e0 * inv; g4[1] = e1 * inv; g4[2] = e2 * inv; g4[3] = e3 * inv;
#pragma unroll
            for (int s = 0; s < 4; ++s) e4[s] = tix[s];
            if (hh == 0) {
#pragma unroll
                for (int s = 0; s < 4; ++s) rk[s] = atomicAdd((int*)(lcnt + e4[s]), 1);
            }
        }
        __syncthreads();
        if (F.tid < 32) lbase[F.tid] = (int)__hip_atomic_fetch_add(F.ctl + CW_GCNT + 64 * F.tid, (unsigned)lcnt[F.tid], RLX_AGENT);
        __syncthreads();
        if (F.wave < 4 && hh == 0) {
#pragma unroll
            for (int s = 0; s < 4; ++s) { const int slot = lbase[e4[s]] + rk[s]; te[tok * 4 + s] = e4[s]; tslot[tok * 4 + s] = slot; tg[tok * 4 + s] = g4[s];
                list[(size_t)e4[s] * LCAP + slot] = tok; lrs[(size_t)e4[s] * LCAP + slot] = rs; }
        }
        __syncthreads();
    }
}
__device__ __forceinline__ int moe_tables(Frame& F) {
    LAS int* tstart = (LAS int*)(F.lds + MOE_TSTART); LAS int* lcnt = (LAS int*)(F.lds + MOE_LCNT); LAS int* texp = (LAS int*)(F.lds + MOE_TEXP);
    if (F.tid < 64) {
        const int lane = F.lane; const int cnt = lane < NE ? (int)__hip_atomic_load(F.ctl + CW_GCNT + 64 * (lane & 31), RLX_AGENT) : 0; const int nt = (cnt + 255) >> 8;
        int inc = nt;
#pragma unroll
        for (int o = 1; o < 32; o <<= 1) { const int up = __shfl_up(inc, o); if (lane >= o) inc += up; }
        if (lane < NE) { const int start = inc - nt; lcnt[lane] = cnt; tstart[lane] = start; for (int i = 0; i < nt; ++i) texp[start + i] = lane; if (lane == NE - 1) tstart[NE] = inc; }
    }
    __syncthreads();
    return tstart[NE];
}
__device__ __forceinline__ void combine_phase(Frame& F, const Args& a, float* dst) {
    LAS int* tstart = (LAS int*)(F.lds + MOE_TSTART);
    const int* te = (const int*)(F.ws + WS_TE); const int* tslot = (const int*)(F.ws + WS_TSLOT); const float* tg = (const float*)(F.ws + WS_TG); const unsigned char* Y = F.ws + WS_Y;
    const bf16* hbf = (const bf16*)(F.ws + WS_HBF); const int gw = F.vcu * NWAVES + F.wave, NGW = F.G * NWAVES, lane = F.lane;
    for (int t0 = gw * 16; t0 < T; t0 += NGW * 16) {
        int pos[4]; float gt[4];
        { const int tl = t0 + (lane & 15);
#pragma unroll
            for (int s = 0; s < 4; ++s) { const int e = te[tl * 4 + s]; pos[s] = tstart[e] * 256 + tslot[tl * 4 + s]; gt[s] = tg[tl * 4 + s]; } }
#pragma unroll 1
        for (int i = 0; i < 16; i += 2) {
            u32x2 hv[2][4]; unsigned yv[2][4][4];
#pragma unroll
            for (int q = 0; q < 2; ++q) { const bf16* hp = hbf + (size_t)(t0 + i + q) * D + 4 * lane;
#pragma unroll
                for (int j = 0; j < 4; ++j) hv[q][j] = __builtin_nontemporal_load((const u32x2*)(hp + 256 * j));
#pragma unroll
                for (int s = 0; s < 4; ++s) { const size_t p = (size_t)__builtin_amdgcn_readlane(pos[s], i + q);
#pragma unroll
                    for (int j = 0; j < 4; ++j) yv[q][s][j] = __builtin_nontemporal_load((const unsigned*)(Y + p * D + 256 * j + 4 * lane)); } }
#pragma unroll
            for (int q = 0; q < 2; ++q) { float* op = dst + (size_t)(t0 + i + q) * D + 4 * lane; float g[4];
#pragma unroll
                for (int s = 0; s < 4; ++s) g[s] = __builtin_bit_cast(float, __builtin_amdgcn_readlane(__builtin_bit_cast(int, gt[s]), i + q));
#pragma unroll
                for (int j = 0; j < 4; ++j) { f32x4 o = {bflo(hv[q][j].x), bfhi(hv[q][j].x), bflo(hv[q][j].y), bfhi(hv[q][j].y)};
#pragma unroll
                    for (int s = 0; s < 4; ++s) { const int ww = (int)yv[q][s][j]; const f32x2 lo = __builtin_amdgcn_cvt_pk_f32_fp8(ww, false), hi = __builtin_amdgcn_cvt_pk_f32_fp8(ww, true);
                        o += (f32x4){lo[0], lo[1], hi[0], hi[1]} * g[s]; }
                    __builtin_nontemporal_store(o, (f32x4*)(op + 256 * j)); } }
        }
    }
}

constexpr int NPHASE = 9;
__global__ void __launch_bounds__(NTHREADS, 2) hymba_fwd(Args args) {
    extern __shared__ __attribute__((aligned(16))) unsigned char lds_raw[];
    Frame F; F.lds = (LAS unsigned char*)lds_raw; F.ws = args.ws; F.ctl = (unsigned*)(args.ws + WS_CTL);
    F.tid = threadIdx.x; F.lane = F.tid & 63; F.wave = __builtin_amdgcn_readfirstlane(F.tid >> 6);
    F.G = gridDim.x; { const int bx = blockIdx.x; F.vcu = (F.G % 8 == 0) ? (bx % 8) * (F.G / 8) + bx / 8 : bx; }
    volatile LAS unsigned* MISC = (volatile LAS unsigned*)(F.lds + MISC_OFF);
    if (F.tid < 32) MISC[F.tid] = 0u;
    __syncthreads();
    XcdBarrier bar; bar.bar = F.ctl + CW_BAR; bar.x = 0; bar.st = nullptr;
    if (MK_N_LAUNCHES == 1) bar = xcd_barrier_post(F.ctl + CW_BAR, MISC + 8);
    const int lo = args.ph_lo, hi = args.ph_hi;
#define IN(k) (lo <= (k) && (k) < hi)
#define SEAM(k) do { if (IN(k) && IN((k) + 1)) xcd_barrier(bar); } while (0)

    if (IN(0)) { for (int rep = 0; rep < (DUP == 4 ? 2 : 1); ++rep) phase0(F, args); SEAM(0); }
    if (IN(1)) {
        pg8::EpiInProj E{(bf16*)(F.ws + WS_ZG), (bf16*)(F.ws + WS_QB), (bf16*)(F.ws + WS_KB), (bf16*)(F.ws + WS_VB), args.in[7], args.in[8], F.lds + RING_BYTES, args.in[6]};
        for (int rep = 0; rep < (DUP == 5 ? 2 : 1); ++rep) {
        { pg8::Gemm g{(const bf16*)(F.ws + WS_XN), (const bf16*)(F.ws + WS_WIN), D}; pg8::StaticOrder S{T / 256, 8, F.G, (int)blockIdx.x, WGM_IN, 0};
          pg8::gemm_phase<pg8::EpiInProj, pg8::StaticOrder, false, true, false>(F.lds, g, S, E); }
        { pg8::Gemm g{(const bf16*)(F.ws + WS_XN8), (const bf16*)(F.ws + WS_WIN8), D}; pg8::StaticOrder S{T / 256, 6, F.G, (int)blockIdx.x, WGM_IN, 8};
          pg8::gemm_phase<pg8::EpiInProj, pg8::StaticOrder, false, true, true>(F.lds, g, S, E); }
        }
        SEAM(1);
    }
    if (IN(2)) {
        for (int rep = 0; rep < (DUP == 1 ? 2 : 1); ++rep)
        for (int u = F.vcu; u < NBATCH * GH * NCHUNK; u += F.G) gdn_prep_unit(F, args, u, u + F.G < NBATCH * GH * NCHUNK ? u + F.G : -1, u == F.vcu);
        SEAM(2);
    }
    if (IN(3)) {
        const int nscan = NBATCH * GH;
        for (int rep3 = 0; rep3 < (DUP == 13 ? 2 : 1); ++rep3) {
        for (int bh = blockIdx.x; bh < nscan; bh += F.G) { gdn_scan(F, args, bh);
#if DUP == 3
            gdn_scan(F, args, bh);
#endif
        }
        if (rep3 == 0) { if (F.G > nscan) { if ((int)blockIdx.x >= nscan) { p0_experts(F, args, ((int)blockIdx.x - nscan) * NWAVES + F.wave, (F.G - nscan) * NWAVES);
#if DUP == 15
            __syncthreads(); p0_experts(F, args, ((int)blockIdx.x - nscan) * NWAVES + F.wave, (F.G - nscan) * NWAVES);
#endif
            } } else p0_experts(F, args, (int)blockIdx.x * NWAVES + F.wave, F.G * NWAVES); __syncthreads(); }
        int done_units = 0;
        for (int pass = 0; pass < 2; ++pass) {
            for (int rep = 0; rep < (DUP == 2 ? 2 : 1); ++rep)
            for (;;) {
                if (F.tid == 0) MISC[16] = __hip_atomic_fetch_add(F.ctl + CW_ATTQ + 64 * (pass + 2 * rep + 4 * rep3), 1u, RLX_AGENT);
                __syncthreads();
                const int u = (int)MISC[16] + (pass ? 2048 : 0);
                __syncthreads();
                if (u >= (pass ? 3072 : 2048)) break;
                attn_unit(F, args, u); if (pass == 0) ++done_units;
            }
            if (DUP == 13) xcd_barrier(bar);
            else if (pass == 0) {
                asm volatile("s_waitcnt vmcnt(0)" ::: "memory"); __syncthreads();
                if (F.tid == 0) { unsigned* dn = F.ctl + CW_DONE0;
                    if (done_units) { __builtin_amdgcn_fence(__ATOMIC_RELEASE, "agent"); asm volatile("s_waitcnt vmcnt(0)" ::: "memory"); (void)xb_add(dn, (unsigned)done_units); }
                    const unsigned target = 2048u * (DUP == 2 ? 2u : 1u);
                    XB_SPIN(xb_ld(dn) < target, bar.bar);
                    __builtin_amdgcn_fence(__ATOMIC_ACQUIRE, "agent"); asm volatile("s_waitcnt vmcnt(0)" ::: "memory"); }
                __syncthreads(); }
        } }
        SEAM(3);
    }
    if (IN(4)) {
        pg8::Gemm g{(const bf16*)(F.ws + WS_MIX), (const bf16*)(F.ws + WS_WOUT), D}; pg8::StaticOrder S{T / 256, D / 256, F.G, (int)blockIdx.x, WGM_OUT, 0};
        pg8::EpiOutProj E{args.in[0], (bf16*)(F.ws + WS_HBF), F.ws + WS_HB, F.lds + RING_BYTES};
        pg8::gemm_phase<pg8::EpiOutProj, pg8::StaticOrder, false, true>(F.lds, g, S, E);
#if DUP == 6
        __syncthreads(); pg8::gemm_phase<pg8::EpiOutProj, pg8::StaticOrder, false, true>(F.lds, g, S, E);
#endif
        SEAM(4);
    }
#if !SKIP_MOE
    if (IN(5)) {
        if (DUP == 10) { route_phase(F, args); xcd_barrier(bar); if (blockIdx.x == 0 && F.tid < 32) __hip_atomic_store(F.ctl + CW_GCNT + 64 * F.tid, 0u, RLX_AGENT); xcd_barrier(bar); }
        route_phase(F, args); SEAM(5); }
    if (IN(6)) {
        const int nM = moe_tables(F);
        pg8::Gemm g{(const bf16*)(F.ws + WS_HB), (const bf16*)(F.ws + WS_WGU), D};
        pg8::MoeOrder S{nM, 8, F.G, (int)blockIdx.x, WGM_GU, (const LAS int*)(F.lds + MOE_TSTART), (const LAS int*)(F.lds + MOE_LCNT), (const LAS int*)(F.lds + MOE_TEXP), (const int*)(F.ws + WS_LIST)};
        pg8::EpiGateUp E{F.ws + WS_ACT, args.in[15], (const float*)(F.ws + WS_LRS), (const LAS int*)(F.lds + MOE_LCNT), F.lds + RING_BYTES};
        pg8::gemm_phase<pg8::EpiGateUp, pg8::MoeOrder, true, true, true, (DUP == 17 ? 2 : 1)>(F.lds, g, S, E);
#if DUP == 7
        __syncthreads(); pg8::gemm_phase<pg8::EpiGateUp, pg8::MoeOrder, true, true, true>(F.lds, g, S, E);
#endif
        SEAM(6);
    }
    if (IN(7)) {
        const int nM = moe_tables(F);
        pg8::Gemm g{(const bf16*)(F.ws + WS_ACT), (const bf16*)(F.ws + WS_WDN), FF};
        pg8::MoeOrder S{nM, 4, F.G, (int)blockIdx.x, WGM_DN, (const LAS int*)(F.lds + MOE_TSTART), (const LAS int*)(F.lds + MOE_LCNT), (const LAS int*)(F.lds + MOE_TEXP), (const int*)(F.ws + WS_LIST)};
        pg8::EpiDown E{F.ws + WS_Y, args.in[17], F.lds + RING_BYTES};
        pg8::gemm_phase<pg8::EpiDown, pg8::MoeOrder, false, true, true>(F.lds, g, S, E);
#if DUP == 8
        __syncthreads(); pg8::gemm_phase<pg8::EpiDown, pg8::MoeOrder, false, true, true>(F.lds, g, S, E);
#endif
        SEAM(7);
    }
#if DUP == 16
    if (IN(8)) { for (int i_ = 0; i_ < 8; ++i_) xcd_barrier(bar); }
#endif
    if (IN(8)) { (void)moe_tables(F); if (DUP == 11) combine_phase(F, args, (float*)(F.ws + WS_ZG)); combine_phase(F, args, args.out); }
#endif
#undef IN
#undef SEAM
}

extern "C" void kernel_launch(void* const* d_in, const int* in_sizes, int n_in, void* d_out, int out_size, void* d_ws, size_t ws_size, hipStream_t stream) {
    static int grid = 0;
    if (grid == 0) {
        if (n_in != 18 || in_sizes[0] != T * D || out_size != T * D || ws_size < WS_END) { fprintf(stderr, "kernel_launch: unexpected shapes (n_in %d, in0 %d, out %d, ws %zu)\n", n_in, n_in > 0 ? in_sizes[0] : -1, out_size, ws_size); grid = -1; return; }
        int dev = 0, cus = 0, per_cu = 0;
        if (hipGetDevice(&dev) != hipSuccess || hipDeviceGetAttribute(&cus, hipDeviceAttributeMultiprocessorCount, dev) != hipSuccess) { grid = -1; return; }
        if (hipFuncSetAttribute((const void*)hymba_fwd, hipFuncAttributeMaxDynamicSharedMemorySize, LDS_BYTES) != hipSuccess) { fprintf(stderr, "kernel_launch: hipFuncSetAttribute failed\n"); grid = -1; return; }
        if (hipOccupancyMaxActiveBlocksPerMultiprocessor(&per_cu, (const void*)hymba_fwd, NTHREADS, LDS_BYTES) != hipSuccess || per_cu < 1) { fprintf(stderr, "kernel_launch: occupancy query says %d\n", per_cu); per_cu = 1; }
        (void)hipGetLastError();
        grid = cus;
    }
    if (grid < 0) return;
    (void)hipMemsetAsync((char*)d_ws + WS_CTL, 0, CTL_ZERO_BYTES, stream);
    Args a{};
    for (int i = 0; i < 18; ++i) a.in[i] = (const float*)d_in[i];
    a.out = (float*)d_out; a.ws = (unsigned char*)d_ws;
    if (MK_N_LAUNCHES == 1) {
        a.ph_lo = 0; a.ph_hi = NPHASE; a.li = 0;
        void* kargs[] = {&a};
        hipError_t e = hipLaunchCooperativeKernel((const void*)hymba_fwd, dim3(grid), dim3(NTHREADS), kargs, LDS_BYTES, stream);
        if (e != hipSuccess) fprintf(stderr, "kernel_launch: cooperative launch failed: %s (grid %d)\n", hipGetErrorString(e), grid);
    } else {
        for (int p = 0; p < NPHASE; ++p) { a.ph_lo = p; a.ph_hi = p + 1; a.li = p; hipLaunchKernelGGL(hymba_fwd, dim3(grid), dim3(NTHREADS), LDS_BYTES, stream, a); }
    }
}
```
